# Optimizing an MI355X kernel written in HIP

```python
import math
import jax, jax.numpy as jnp
from jax import lax
import numpy as np


D_MODEL = 1024
BATCH = 8
SEQ = 4096
DEPTH = 1
DEC_BATCH = 32
DEC_SEQ = 4
PAST_LEN = 16384
PAGE_SIZE = 128

A_WINDOWS = (128, 512, 2048)
A_DILATIONS = (1, 4, 16)
A_GROUPS = 3
A_HEADS = 8
A_HEAD_DIM = 64
A_WIDTH = A_GROUPS * A_HEADS * A_HEAD_DIM
A_OUT = A_HEADS * A_HEAD_DIM
A_BLOCK = 128

GLA_HEADS = 4
GLA_DK = 128
GLA_DV = 256
GLA_QK = GLA_HEADS * GLA_DK
GLA_V = GLA_HEADS * GLA_DV
GLA_RANK = 16
GLA_NORMALIZER = 16.0
GLA_CHUNK = 64

PEER_HEADS = 8
PEER_NKEYS = 128
PEER_EXPERTS = PEER_NKEYS * PEER_NKEYS
PEER_DQ = 256
PEER_TOPK = 16
PEER_BLOCK = 128

REL_BUCKETS = 32
REL_MAX_DIST = 2048
REL_HEADS = A_GROUPS * A_HEADS

IN_SPLITS = (A_WIDTH, A_WIDTH, A_WIDTH, GLA_QK, GLA_QK, GLA_V, GLA_RANK, GLA_V, D_MODEL, D_MODEL)
IN_WIDTH = 3 * A_WIDTH + 2 * GLA_QK + 2 * GLA_V + GLA_RANK + 2 * D_MODEL

DEEPNORM_ALPHA = (2.0 * DEPTH) ** 0.25
DEEPNORM_BETA = (8.0 * DEPTH) ** -0.25
LN_EPS = 1e-5
NEG_INF = -1e30

kernel_name = 'hybrid_dilated_gla_peer_step'


def layer_norm(x, g, b):
    xf = x.astype(jnp.float32)
    mu = xf.mean(-1, keepdims=True)
    var = jnp.square(xf - mu).mean(-1, keepdims=True)
    return ((xf - mu) * lax.rsqrt(var + LN_EPS) * g.astype(jnp.float32) + b.astype(jnp.float32)).astype(x.dtype)


def rel_bucket(dist):
    exact = REL_BUCKETS // 2
    d = jnp.maximum(dist, 1).astype(jnp.float32)
    large = exact + (jnp.log(d / exact) / math.log(REL_MAX_DIST / exact) * (REL_BUCKETS - exact)).astype(jnp.int32)
    large = jnp.minimum(large, REL_BUCKETS - 1)
    return jnp.where(dist < exact, dist, large)


def dilated_window_prompt(q, k, v, bias_table, window, dil):
    B, T, H, dh = q.shape
    band = window // dil
    c = A_BLOCK
    span = c * dil
    T_pad = -(-T // span) * span
    L = T_pad // dil
    nb = L // c

    def to_blocks(a):
        a = jnp.pad(a, ((0, 0), (0, T_pad - T), (0, 0), (0, 0))).reshape(B, L, dil, H, dh)
        return a.transpose(0, 2, 1, 3, 4).reshape(B, dil, nb, c, H, dh)

    def with_prev(a):
        prev = jnp.concatenate([jnp.zeros_like(a[:, :, :1]), a[:, :, :-1]], axis=2)
        return jnp.concatenate([prev, a], axis=3)

    qb = to_blocks(q)
    kk = with_prev(to_blocks(k))
    vv = with_prev(to_blocks(v))
    s = jnp.einsum('brnqhd,brnkhd->brnhqk', qb, kk).astype(jnp.float32) * (dh ** -0.5)
    qi = jnp.arange(c)[:, None]
    kj = jnp.arange(2 * c)[None, :]
    rel = c + qi - kj
    bias = bias_table[rel_bucket(jnp.clip(rel, 0, band) * dil)].transpose(2, 0, 1).astype(jnp.float32)
    in_band = (rel >= 0) & (rel <= band)
    first = (jnp.arange(nb) == 0)[:, None, None] & (kj < c)[None]
    valid = in_band[None] & ~first
    s = jnp.where(valid[:, None], s + bias, NEG_INF)
    lse = jax.nn.logsumexp(s, axis=-1)
    p = jnp.exp(s - lse[..., None])
    o = jnp.einsum('brnhqk,brnkhd->brnqhd', p.astype(v.dtype), vv)

    def from_blocks(a):
        a = a.reshape((B, dil, L) + a.shape[4:])
        a = jnp.moveaxis(a, 1, 2).reshape((B, T_pad) + a.shape[3:])
        return a[:, :T]

    return from_blocks(o), from_blocks(lse.transpose(0, 1, 2, 4, 3))


def dilated_window_sample(q, k, v, buf, bias_table, window, dil):
    B, S, H, dh = q.shape
    Wb = buf.shape[1]
    band = window // dil
    ext_k = jnp.concatenate([buf[:, :, 0], k], axis=1)
    ext_v = jnp.concatenate([buf[:, :, 1], v], axis=1)
    j = jnp.arange(band + 1)
    idx = Wb + jnp.arange(S)[:, None] - j[None, :] * dil
    valid = idx >= 0
    idx = jnp.maximum(idx, 0)
    kg = ext_k[:, idx]
    vg = ext_v[:, idx]
    s = jnp.einsum('bshd,bsjhd->bhsj', q, kg).astype(jnp.float32) * (dh ** -0.5)
    bias = bias_table[rel_bucket(j * dil)].T.astype(jnp.float32)
    s = jnp.where(valid[None, None], s + bias[None, :, None, :], NEG_INF)
    lse = jax.nn.logsumexp(s, axis=-1)
    p = jnp.exp(s - lse[..., None])
    o = jnp.einsum('bhsj,bsjhd->bshd', p.astype(v.dtype), vg)
    new_buf = jnp.stack([ext_k[:, -Wb:], ext_v[:, -Wb:]], axis=2)
    return o, lse.transpose(0, 2, 1), new_buf


def gla_recurrence(q, k, v, log_a, state):
    B, T, H, dk = q.shape
    dv = v.shape[-1]
    c = GLA_CHUNK if T % GLA_CHUNK == 0 else T
    n = T // c

    def chunks(a):
        return a.reshape(B, n, c, H, a.shape[-1]).transpose(1, 0, 3, 2, 4).astype(jnp.float32)

    qc, kc, vc, ac = chunks(q * (dk ** -0.5)), chunks(k), chunks(v), chunks(log_a)
    causal = jnp.tril(jnp.ones((c, c), dtype=bool))

    def step(S, xs):
        qi, ki, vi, ai = xs
        b = jnp.cumsum(ai, axis=-2)
        b_last = b[..., -1:, :]
        qe = qi * jnp.exp(b)
        ke = ki * jnp.exp(-b)
        att = jnp.where(causal, jnp.einsum('bhid,bhjd->bhij', qe, ke), 0.0)
        o = jnp.einsum('bhij,bhje->bhie', att, vi) + jnp.einsum('bhid,bhde->bhie', qe, S)
        S = jnp.exp(b_last)[..., 0, :, None] * S + jnp.einsum('bhjd,bhje->bhde', ki * jnp.exp(b_last - b), vi)
        return S, o

    S, o = lax.scan(step, state.astype(jnp.float32), (qc, kc, vc, ac))
    o = o.transpose(1, 0, 3, 2, 4).reshape(B, T, H, dv)
    return o, S


def peer_ffn(x, w_query, sub_keys, u_table, v_table):
    B, T, D = x.shape
    N = B * T
    n_blocks = -(-N // PEER_BLOCK)
    xf = jnp.pad(x.reshape(N, D), ((0, n_blocks * PEER_BLOCK - N), (0, 0))).reshape(n_blocks, PEER_BLOCK, D)
    half = PEER_DQ // 2
    k1 = sub_keys[:, 0].astype(jnp.float32)
    k2 = sub_keys[:, 1].astype(jnp.float32)

    def block(xb):
        q = (xb @ w_query).reshape(-1, PEER_HEADS, PEER_DQ).astype(jnp.float32)
        q = (q - q.mean(-1, keepdims=True)) * lax.rsqrt(q.var(-1, keepdims=True) + LN_EPS)
        s1 = jnp.einsum('nhd,hkd->nhk', q[..., :half], k1)
        s2 = jnp.einsum('nhd,hkd->nhk', q[..., half:], k2)
        v1, i1 = lax.top_k(s1, PEER_TOPK)
        v2, i2 = lax.top_k(s2, PEER_TOPK)
        cand = (v1[..., :, None] + v2[..., None, :]).reshape(-1, PEER_HEADS, PEER_TOPK * PEER_TOPK)
        sv, si = lax.top_k(cand, PEER_TOPK)
        e1 = jnp.take_along_axis(i1, si // PEER_TOPK, axis=-1)
        e2 = jnp.take_along_axis(i2, si % PEER_TOPK, axis=-1)
        expert = e1 * PEER_NKEYS + e2
        gate = jax.nn.softmax(sv, axis=-1)
        act = jax.nn.gelu(jnp.einsum('nd,nhkd->nhk', xb, u_table[expert]).astype(jnp.float32), approximate=False)
        return jnp.einsum('nhk,nhkd->nd', (gate * act).astype(x.dtype), v_table[expert])

    out = lax.map(block, xf)
    return out.reshape(-1, D)[:N].reshape(B, T, D)


def trunk_layer(x, kv_bufs, gla_state, rel_bias, w_in, w_gla_gate2, b_gla_gate, g_gla_norm,
                w_branch_a, w_branch_b, w_out, ln1_g, ln1_b, w_peer_query, peer_sub_keys,
                peer_u, peer_v, ln2_g, ln2_b):
    B, T, _ = x.shape
    proj = x @ w_in
    offs = np.cumsum(IN_SPLITS)[:-1].tolist()
    qa, ka, va, qb, kb, vb, ab, rb, ga, gb = jnp.split(proj, offs, axis=-1)

    qa = qa.reshape(B, T, A_GROUPS, A_HEADS, A_HEAD_DIM)
    ka = ka.reshape(B, T, A_GROUPS, A_HEADS, A_HEAD_DIM)
    va = va.reshape(B, T, A_GROUPS, A_HEADS, A_HEAD_DIM)
    outs, lses, new_bufs = [], [], []
    for g in range(A_GROUPS):
        bias_g = rel_bias[:, g * A_HEADS:(g + 1) * A_HEADS]
        if kv_bufs is None:
            o, lse = dilated_window_prompt(qa[:, :, g], ka[:, :, g], va[:, :, g], bias_g, A_WINDOWS[g], A_DILATIONS[g])
            wb = min(A_WINDOWS[g], T)
            nbuf = jnp.stack([ka[:, T - wb:, g], va[:, T - wb:, g]], axis=2)
        else:
            o, lse, nbuf = dilated_window_sample(qa[:, :, g], ka[:, :, g], va[:, :, g], kv_bufs[g], bias_g, A_WINDOWS[g], A_DILATIONS[g])
        outs.append(o)
        lses.append(lse)
        new_bufs.append(nbuf)
    w_mix = jax.nn.softmax(jnp.stack(lses, 0), axis=0)
    o_a = jnp.sum(w_mix[..., None] * jnp.stack(outs, 0).astype(jnp.float32), axis=0)
    o_a = o_a.astype(x.dtype).reshape(B, T, A_OUT)

    log_a = jax.nn.log_sigmoid((ab @ w_gla_gate2 + b_gla_gate).astype(jnp.float32)) / GLA_NORMALIZER
    state0 = jnp.zeros((B, GLA_HEADS, GLA_DK, GLA_DV), jnp.float32) if gla_state is None else gla_state
    o_b, new_state = gla_recurrence(qb.reshape(B, T, GLA_HEADS, GLA_DK), kb.reshape(B, T, GLA_HEADS, GLA_DK),
                                    vb.reshape(B, T, GLA_HEADS, GLA_DV), log_a.reshape(B, T, GLA_HEADS, GLA_DK), state0)
    o_b = o_b * lax.rsqrt(jnp.mean(jnp.square(o_b), -1, keepdims=True) + LN_EPS)
    o_b = o_b.reshape(B, T, GLA_V) * g_gla_norm.astype(jnp.float32) * jax.nn.silu(rb.astype(jnp.float32))
    o_b = o_b.astype(x.dtype)
    new_state = new_state.astype(x.dtype if gla_state is None else gla_state.dtype)

    mixed = jax.nn.sigmoid(ga) * (o_a @ w_branch_a) + jax.nn.sigmoid(gb) * (o_b @ w_branch_b)
    x = layer_norm(DEEPNORM_ALPHA * x + mixed @ w_out, ln1_g, ln1_b)
    x = layer_norm(DEEPNORM_ALPHA * x + peer_ffn(x, w_peer_query, peer_sub_keys, peer_u, peer_v), ln2_g, ln2_b)
    return x, new_bufs, new_state


def setup_inputs(seed: int = 0) -> dict:
    key = jax.random.key(seed)
    ks = jax.random.split(key, 24)
    f32 = jnp.float32
    nrm = lambda k, s: jax.random.normal(k, s, f32)
    wb = [min(w, PAST_LEN) for w in A_WINDOWS]
    return {
        'x_prompt': nrm(ks[0], (BATCH, SEQ, D_MODEL)),
        'x_sample': nrm(ks[1], (DEC_BATCH, DEC_SEQ, D_MODEL)),
        'cache_kv_a1': nrm(ks[2], (DEPTH, DEC_BATCH, wb[0], 2, A_HEADS, A_HEAD_DIM)),
        'cache_kv_a2': nrm(ks[3], (DEPTH, DEC_BATCH, wb[1], 2, A_HEADS, A_HEAD_DIM)),
        'cache_kv_a3': nrm(ks[4], (DEPTH, DEC_BATCH, wb[2], 2, A_HEADS, A_HEAD_DIM)),
        'state_gla': 0.3 * nrm(ks[5], (DEPTH, DEC_BATCH, GLA_HEADS, GLA_DK, GLA_DV)),
        'rel_bias': 0.1 * nrm(ks[6], (REL_BUCKETS, REL_HEADS)),
        'w_in': nrm(ks[7], (DEPTH, D_MODEL, IN_WIDTH)) * D_MODEL ** -0.5,
        'w_gla_gate2': nrm(ks[8], (DEPTH, GLA_RANK, GLA_QK)) * GLA_RANK ** -0.5,
        'b_gla_gate': 0.1 * nrm(ks[9], (DEPTH, GLA_QK)),
        'g_gla_norm': 1.0 + 0.02 * nrm(ks[10], (DEPTH, GLA_V)),
        'w_branch_a': nrm(ks[11], (DEPTH, A_OUT, D_MODEL)) * A_OUT ** -0.5,
        'w_branch_b': nrm(ks[12], (DEPTH, GLA_V, D_MODEL)) * GLA_V ** -0.5,
        'w_out': nrm(ks[13], (DEPTH, D_MODEL, D_MODEL)) * (D_MODEL ** -0.5 * DEEPNORM_BETA),
        'ln1_g': 1.0 + 0.02 * nrm(ks[14], (DEPTH, D_MODEL)),
        'ln1_b': 0.02 * nrm(ks[15], (DEPTH, D_MODEL)),
        'w_peer_query': nrm(ks[16], (DEPTH, D_MODEL, PEER_HEADS * PEER_DQ)) * D_MODEL ** -0.5,
        'peer_sub_keys': nrm(ks[17], (DEPTH, PEER_HEADS, 2, PEER_NKEYS, PEER_DQ // 2)) * (PEER_DQ // 2) ** -0.5,
        'peer_u': nrm(ks[18], (DEPTH, PEER_EXPERTS, D_MODEL)) * D_MODEL ** -0.5,
        'peer_v': nrm(ks[19], (DEPTH, PEER_EXPERTS, D_MODEL)) * (PEER_HEADS ** -0.5 * DEEPNORM_BETA),
        'ln2_g': 1.0 + 0.02 * nrm(ks[20], (DEPTH, D_MODEL)),
        'ln2_b': 0.02 * nrm(ks[21], (DEPTH, D_MODEL)),
    }


def reference(x_prompt, x_sample, cache_kv_a1, cache_kv_a2, cache_kv_a3, state_gla, rel_bias,
              w_in, w_gla_gate2, b_gla_gate, g_gla_norm, w_branch_a, w_branch_b, w_out,
              ln1_g, ln1_b, w_peer_query, peer_sub_keys, peer_u, peer_v, ln2_g, ln2_b):
    y_p, y_s = x_prompt, x_sample
    caches = (cache_kv_a1, cache_kv_a2, cache_kv_a3)
    new_p = [[] for _ in range(A_GROUPS)]
    new_s = [[] for _ in range(A_GROUPS)]
    st_p, st_s = [], []
    for l in range(DEPTH):
        lw = (w_in[l], w_gla_gate2[l], b_gla_gate[l], g_gla_norm[l], w_branch_a[l], w_branch_b[l], w_out[l],
              ln1_g[l], ln1_b[l], w_peer_query[l], peer_sub_keys[l], peer_u[l], peer_v[l], ln2_g[l], ln2_b[l])
        y_p, bufs_p, s_p = trunk_layer(y_p, None, None, rel_bias, *lw)
        y_s, bufs_s, s_s = trunk_layer(y_s, [c[l] for c in caches], state_gla[l], rel_bias, *lw)
        for g in range(A_GROUPS):
            new_p[g].append(bufs_p[g])
            new_s[g].append(bufs_s[g])
        st_p.append(s_p)
        st_s.append(s_s)
    return (y_p, y_s,
            jnp.stack(new_p[0]), jnp.stack(new_p[1]), jnp.stack(new_p[2]), jnp.stack(st_p),
            jnp.stack(new_s[0]), jnp.stack(new_s[1]), jnp.stack(new_s[2]), jnp.stack(st_s))
```

```cpp
#include <hip/hip_runtime.h>
#include <hip/hip_cooperative_groups.h>
#include <cstdio>
#include <cstdint>
#ifndef MK_SINGLE
#define MK_SINGLE 0
#endif
namespace pg8 {
#define PG8_LAS __attribute__((address_space(3)))
typedef unsigned short bf16_t;
typedef short bf16x8 __attribute__((ext_vector_type(8)));
typedef float f32x4 __attribute__((ext_vector_type(4)));
typedef unsigned u32x4 __attribute__((ext_vector_type(4)));
constexpr int BM = 256, BK = 64, HALF = 128, HTB = HALF * BK * 2  , STAGE_BYTES = 8 * HTB, NXCD = 8, WGM = 8;

__host__ __device__ __forceinline__ int lds_byte(int r, int c) { const int st = (r >> 4) * 2 + (c >> 5), rr = r & 15, cc = c & 31, ob = rr * 64 + cc * 2; return st * 1024 + (ob ^ (((ob >> 9) & 1) << 5)); }
__host__ __device__ __forceinline__ void stage_rc(int b, int& R, int& C) { const int st = b / 1024, sb = b % 1024, swz = sb ^ (((sb >> 9) & 1) << 5); R = (st >> 1) * 16 + swz / 64; C = (st & 1) * 32 + (swz % 64) / 2; }
__host__ __device__ __forceinline__ int perm32(int rho) { const int n = rho >> 4, i = rho & 15; return 8 * (i >> 2) + 4 * n + (i & 3); }

struct Unit { int pm, pn; };
struct Gemm { const bf16_t* A; const bf16_t* Bt; int M, N, K; };

struct StaticOrder {
    int nM, nN, nwg, G, c;
    __host__ __device__ void init(int M, int N, int G_, int c_) { nM = M / BM; nN = N / BM; nwg = nM * nN; G = G_; c = c_; }
    __host__ __device__ bool next(int i, Unit& u) const {
        const long L = (long)i * G + c; if (L >= nwg) return false;
        int wgid = (int)L; { const int q = nwg / NXCD, r = nwg % NXCD, xcd = wgid % NXCD, off = wgid / NXCD; wgid = (xcd < r ? xcd * (q + 1) : r * (q + 1) + (xcd - r) * q) + off; }
        const int nig = WGM * nN, gid = wgid / nig, fm = gid * WGM, gsz = (nM - fm) < WGM ? (nM - fm) : WGM;
        u.pm = fm + ((wgid % nig) % gsz); u.pn = (wgid % nig) / gsz; return true;
    }
    __device__ __forceinline__ void a_ready(const Unit&) const {}
    __device__ __forceinline__ void done(const Unit&) const {}
};


typedef float f32x2 __attribute__((ext_vector_type(2)));
typedef __bf16 bf16x2_t __attribute__((ext_vector_type(2)));
__device__ __forceinline__ unsigned cvt_pk_bf16(float lo, float hi) { f32x2 v = {lo, hi}; bf16x2_t b = __builtin_convertvector(v, bf16x2_t); return __builtin_bit_cast(unsigned, b); }
__device__ __forceinline__ float bf_lo(unsigned w) { return __uint_as_float(w << 16); }
__device__ __forceinline__ float bf_hi(unsigned w) { return __uint_as_float(w & 0xffff0000u); }
__device__ __forceinline__ float sigmoidf_(float x) { return 1.0f / (1.0f + __expf(-x)); }

struct EpiProj {
    static constexpr bool PERM = true, AFTER_DRAIN = false;
    bf16_t *qa, *ka, *va, *qb, *kb, *vb, *rb, *ga, *gb;
    __device__ __forceinline__ void operator()(const f32x4 (&acc)[2][2][4][2], const Unit& u, int wr, int wc, int fr, int fq) const {
        const int pn = u.pn; bf16_t* base; int ldc, ct; float sc = 1.f;
        if (pn < 6) { base = qa; ldc = 1536; ct = pn; sc = 0.125f; }
        else if (pn < 12) { base = ka; ldc = 1536; ct = pn - 6; }
        else if (pn < 18) { base = va; ldc = 1536; ct = pn - 12; }
        else if (pn < 20) { base = qb; ldc = 512; ct = pn - 18; }
        else if (pn < 22) { base = kb; ldc = 512; ct = pn - 20; }
        else if (pn < 26) { base = vb; ldc = 1024; ct = pn - 22; }
        else if (pn < 30) { base = rb; ldc = 1024; ct = pn - 26; }
        else if (pn < 34) { base = ga; ldc = 1024; ct = pn - 30; }
        else { base = gb; ldc = 1024; ct = pn - 34; }
        const int row0 = u.pm * BM + wr * 64 + fr, col0 = ct * BM + wc * 32 + 8 * fq;
#pragma unroll
        for (int ai = 0; ai < 2; ++ai)
#pragma unroll
            for (int m = 0; m < 4; ++m) { bf16_t* rowp = base + (size_t)(row0 + ai * HALF + m * 16) * ldc + col0;
#pragma unroll
                for (int bj = 0; bj < 2; ++bj) { const f32x4 v0 = acc[ai][bj][m][0] * sc, v1 = acc[ai][bj][m][1] * sc;
                    u32x4 w; w.x = cvt_pk_bf16(v0[0], v0[1]); w.y = cvt_pk_bf16(v0[2], v0[3]); w.z = cvt_pk_bf16(v1[0], v1[1]); w.w = cvt_pk_bf16(v1[2], v1[3]);
                    *(u32x4*)(rowp + bj * HALF) = w; } }
    }
};
template <bool ADD> struct EpiGate {
    static constexpr bool PERM = true, AFTER_DRAIN = false;
    const bf16_t* G; const bf16_t* T1; bf16_t* O;
    __device__ __forceinline__ void operator()(const f32x4 (&acc)[2][2][4][2], const Unit& u, int wr, int wc, int fr, int fq) const {
        const int row0 = u.pm * BM + wr * 64 + fr, col0 = u.pn * BM + wc * 32 + 8 * fq;
#pragma unroll
        for (int ai = 0; ai < 2; ++ai)
#pragma unroll
            for (int m = 0; m < 4; ++m) { const size_t off = (size_t)(row0 + ai * HALF + m * 16) * 1024 + col0;
#pragma unroll
                for (int bj = 0; bj < 2; ++bj) {
                    const u32x4 g = *(const u32x4*)(G + off + bj * HALF);
                    f32x4 v0 = acc[ai][bj][m][0], v1 = acc[ai][bj][m][1];
                    v0[0] *= sigmoidf_(bf_lo(g.x)); v0[1] *= sigmoidf_(bf_hi(g.x)); v0[2] *= sigmoidf_(bf_lo(g.y)); v0[3] *= sigmoidf_(bf_hi(g.y));
                    v1[0] *= sigmoidf_(bf_lo(g.z)); v1[1] *= sigmoidf_(bf_hi(g.z)); v1[2] *= sigmoidf_(bf_lo(g.w)); v1[3] *= sigmoidf_(bf_hi(g.w));
                    if (ADD) { const u32x4 t = *(const u32x4*)(T1 + off + bj * HALF);
                        v0[0] += bf_lo(t.x); v0[1] += bf_hi(t.x); v0[2] += bf_lo(t.y); v0[3] += bf_hi(t.y);
                        v1[0] += bf_lo(t.z); v1[1] += bf_hi(t.z); v1[2] += bf_lo(t.w); v1[3] += bf_hi(t.w); }
                    u32x4 w; w.x = cvt_pk_bf16(v0[0], v0[1]); w.y = cvt_pk_bf16(v0[2], v0[3]); w.z = cvt_pk_bf16(v1[0], v1[1]); w.w = cvt_pk_bf16(v1[2], v1[3]);
                    *(u32x4*)(O + off + bj * HALF) = w; } }
    }
};
struct EpiOut {
    static constexpr bool PERM = false, AFTER_DRAIN = false;
    const float* xp; const float* xs; float* H; int np, ntok; float alpha;
    __device__ __forceinline__ void operator()(const f32x4 (&acc)[2][2][4][2], const Unit& u, int wr, int wc, int fr, int fq) const {
        const int row0 = u.pm * BM + wr * 64 + fr, col0 = u.pn * BM + wc * 32 + 4 * fq;
#pragma unroll
        for (int ai = 0; ai < 2; ++ai)
#pragma unroll
            for (int m = 0; m < 4; ++m) { const int r = row0 + ai * HALF + m * 16;
                const float* xr = r < np ? xp + (size_t)r * 1024 : xs + (size_t)(r < ntok ? r - np : 0) * 1024; const bool real = r < ntok;
#pragma unroll
                for (int bj = 0; bj < 2; ++bj)
#pragma unroll
                    for (int n = 0; n < 2; ++n) { const int c = col0 + bj * HALF + n * 16;
                        f32x4 xv = *(const f32x4*)(xr + c); if (!real) xv = (f32x4){0.f, 0.f, 0.f, 0.f};
                        *(f32x4*)(H + (size_t)r * 1024 + c) = xv * alpha + acc[ai][bj][m][n]; } }
    }
};
struct EpiHeadNorm {
    static constexpr bool PERM = true, AFTER_DRAIN = false;
    bf16_t* O; int ldc; PG8_LAS unsigned char* st; float eps;
    __device__ __forceinline__ void operator()(const f32x4 (&acc)[2][2][4][2], const Unit& u, int wr, int wc, int fr, int fq) const {
        PG8_LAS f32x2* P = (PG8_LAS f32x2*)st; PG8_LAS f32x2* S = (PG8_LAS f32x2*)(st + 8192);
        const int lane = fq * 16 + fr, wid = wr * 4 + wc;
#pragma unroll
        for (int ai = 0; ai < 2; ++ai)
#pragma unroll
            for (int m = 0; m < 4; ++m) {
                float s = 0.f;
#pragma unroll
                for (int bj = 0; bj < 2; ++bj)
#pragma unroll
                    for (int n = 0; n < 2; ++n) { const f32x4 x = acc[ai][bj][m][n]; s += (x[0] + x[1]) + (x[2] + x[3]); }
                s += __shfl_xor(s, 16); s += __shfl_xor(s, 32);
                const float mw = s * (1.0f / 64.0f); float q = 0.f;
#pragma unroll
                for (int bj = 0; bj < 2; ++bj)
#pragma unroll
                    for (int n = 0; n < 2; ++n) { const f32x4 d = acc[ai][bj][m][n] - mw; q += (d[0] * d[0] + d[1] * d[1]) + (d[2] * d[2] + d[3] * d[3]); }
                q += __shfl_xor(q, 16); q += __shfl_xor(q, 32);
                if (fq == 0) P[(ai * HALF + wr * 64 + m * 16 + fr) * 4 + wc] = (f32x2){mw, q};
            }
        asm volatile("s_waitcnt lgkmcnt(0)" ::: "memory"); __builtin_amdgcn_s_barrier(); asm volatile("" ::: "memory");
        const int row = wid * 32 + (lane & 31);
        if (lane < 32) {
            const f32x2 a = P[row * 4 + 0], b = P[row * 4 + 1], c = P[row * 4 + 2], d = P[row * 4 + 3];
            const float mt = (a.x + b.x + c.x + d.x) * 0.25f;
            const float da = a.x - mt, db = b.x - mt, dc = c.x - mt, dd = d.x - mt;
            const float m2 = (a.y + b.y) + (c.y + d.y) + 64.0f * ((da * da + db * db) + (dc * dc + dd * dd));
            S[row] = (f32x2){mt, 1.0f / sqrtf(m2 * (1.0f / 256.0f) + eps)};
        }
        asm volatile("s_waitcnt lgkmcnt(0)" ::: "memory"); __builtin_amdgcn_s_barrier(); asm volatile("" ::: "memory");
        const int row0 = u.pm * BM + wr * 64 + fr, col0 = u.pn * BM + wc * 32 + 8 * fq;
#pragma unroll
        for (int ai = 0; ai < 2; ++ai)
#pragma unroll
            for (int m = 0; m < 4; ++m) { const f32x2 sr = S[ai * HALF + wr * 64 + m * 16 + fr]; bf16_t* rowp = O + (size_t)(row0 + ai * HALF + m * 16) * ldc + col0;
#pragma unroll
                for (int bj = 0; bj < 2; ++bj) { const f32x4 v0 = (acc[ai][bj][m][0] - sr.x) * sr.y, v1 = (acc[ai][bj][m][1] - sr.x) * sr.y;
                    u32x4 w; w.x = cvt_pk_bf16(v0[0], v0[1]); w.y = cvt_pk_bf16(v0[2], v0[3]); w.z = cvt_pk_bf16(v1[0], v1[1]); w.w = cvt_pk_bf16(v1[2], v1[3]);
                    *(u32x4*)(rowp + bj * HALF) = w; } }
    }
};

template <class Epi, class Sched, bool ALIGN_EPI = false, bool SP2 = false>
__device__ __forceinline__ void gemm_phase(PG8_LAS unsigned char* lds, const Gemm g, const Sched& S, const Epi& E) {
    const int tid = threadIdx.x, wid = __builtin_amdgcn_readfirstlane(tid >> 6), lane = tid & 63, wr = wid >> 2, wc = wid & 3, fr = lane & 15, fq = lane >> 4;
    const int K = g.K, nt = K / BK;
    unsigned voffA[2], voffB[2];
#pragma unroll
    for (int i = 0; i < 2; ++i) { int R, C; stage_rc(tid * 16 + i * 8192, R, C); const int Rb = Epi::PERM ? ((R & ~31) + perm32(R & 31)) : R;
        voffA[i] = (unsigned)(R * K + C) * 2u; voffB[i] = (unsigned)(Rb * K + C) * 2u; }
    const size_t kstep = (size_t)(BK * 2);
    const size_t hstep = (size_t)HALF * K * 2;
    const size_t tstep = 2 * hstep;
    const unsigned ldsw = (unsigned)wid * 1024u;
    const int aoff = lds_byte(wr * 64 + fr, fq * 8), boff = lds_byte(wc * 32 + fr, fq * 8);
#define PG8_SA(b, h) (((b) * 2 + (h)) * HTB)
#define PG8_SB(b, h) ((4 + (b) * 2 + (h)) * HTB)
#define PG8_STAGE(bufoff, gbase, voff) do { _Pragma("unroll") for (int _i = 0; _i < 2; ++_i) \
        __builtin_amdgcn_global_load_lds((const unsigned*)((const char*)(gbase) + (voff)[_i]), (PG8_LAS unsigned*)(lds + (bufoff) + ldsw + _i * 8192), 16, 0, 0); } while (0)
#define PG8_LDA(dst, b, h) do { _Pragma("unroll") for (int m = 0; m < 4; ++m) _Pragma("unroll") for (int k = 0; k < 2; ++k) dst[m][k] = *(const PG8_LAS bf16x8*)(lds + PG8_SA(b, h) + aoff + m * 2048 + k * 1024); } while (0)
#define PG8_LDB(dst, b, h) do { _Pragma("unroll") for (int n = 0; n < 2; ++n) _Pragma("unroll") for (int k = 0; k < 2; ++k) dst[n][k] = *(const PG8_LAS bf16x8*)(lds + PG8_SB(b, h) + boff + n * 2048 + k * 1024); } while (0)
#define PG8_MMA(ai, bj, At, Bt) do { __builtin_amdgcn_s_setprio(1); _Pragma("unroll") for (int m = 0; m < 4; ++m) _Pragma("unroll") for (int n = 0; n < 2; ++n) _Pragma("unroll") for (int k = 0; k < 2; ++k) \
        acc[ai][bj][m][n] = __builtin_amdgcn_mfma_f32_16x16x32_bf16(Bt[n][k], At[m][k], acc[ai][bj][m][n], 0, 0, 0); __builtin_amdgcn_s_setprio(0); } while (0)
#define PG8_WAIT_V(n) asm volatile("s_waitcnt vmcnt(" #n ")" ::: "memory")
#define PG8_WAIT_L(n) asm volatile("s_waitcnt lgkmcnt(" #n ")" ::: "memory")
#define PG8_BAR __builtin_amdgcn_s_barrier()
#define PG8_SCHED __builtin_amdgcn_sched_barrier(0)
    Unit cur, nxt; int ui = 0;
    if (!S.next(0, cur)) return;
    f32x4 acc[2][2][4][2];
#pragma unroll
    for (int a = 0; a < 2; ++a)
#pragma unroll
        for (int b = 0; b < 2; ++b)
#pragma unroll
            for (int m = 0; m < 4; ++m)
#pragma unroll
                for (int n = 0; n < 2; ++n) acc[a][b][m][n] = (f32x4){0.f, 0.f, 0.f, 0.f};
    bf16x8 At[4][2], B0[2][2], B1[2][2];
    const char* cA = (const char*)g.A + (size_t)cur.pm * tstep; const char* cB = (const char*)g.Bt + (size_t)cur.pn * tstep;
    S.a_ready(cur);
    if constexpr (SP2) {
        PG8_STAGE(PG8_SB(0, 0), cB, voffB); PG8_STAGE(PG8_SB(0, 1), cB + hstep, voffB); PG8_STAGE(PG8_SA(0, 0), cA, voffA); PG8_STAGE(PG8_SA(0, 1), cA + hstep, voffA);
        if (wr == 1) PG8_BAR;
        PG8_WAIT_V(2); PG8_BAR;
        PG8_STAGE(PG8_SB(1, 0), cB + kstep, voffB); PG8_STAGE(PG8_SA(1, 0), cA + kstep, voffA); PG8_STAGE(PG8_SB(1, 1), cB + hstep + kstep, voffB);
        PG8_WAIT_V(6); PG8_BAR;
    } else {
        PG8_STAGE(PG8_SB(0, 0), cB, voffB); PG8_STAGE(PG8_SA(0, 0), cA, voffA); PG8_STAGE(PG8_SB(0, 1), cB + hstep, voffB); PG8_STAGE(PG8_SA(0, 1), cA + hstep, voffA);
        if (wr == 1) PG8_BAR;
        PG8_WAIT_V(4); PG8_BAR;
        PG8_STAGE(PG8_SB(1, 0), cB + kstep, voffB); PG8_STAGE(PG8_SA(1, 0), cA + kstep, voffA); PG8_STAGE(PG8_SB(1, 1), cB + hstep + kstep, voffB);
        PG8_WAIT_V(6); PG8_BAR;
    }
    for (;;) {
        const bool has_next = S.next(ui + 1, nxt);
        const char* nA = has_next ? (const char*)g.A + (size_t)nxt.pm * tstep : cA; const char* nB = has_next ? (const char*)g.Bt + (size_t)nxt.pn * tstep : cB;
        for (int t = 0; t < nt; t += 2) {
            const bool last = (t == nt - 2);
            const char* a1 = cA + (size_t)(t + 1) * kstep;
            const char* a2 = last ? nA : cA + (size_t)(t + 2) * kstep; const char* b2 = last ? nB : cB + (size_t)(t + 2) * kstep;
            const char* a3 = a2 + kstep; const char* b3 = b2 + kstep;
            if (last && has_next) S.a_ready(nxt);
            if constexpr (SP2) {
            PG8_LDB(B0, 0, 0); PG8_LDB(B1, 0, 1); PG8_SCHED; PG8_LDA(At, 0, 0); PG8_STAGE(PG8_SA(1, 1), a1 + hstep, voffA);
            PG8_WAIT_V(8); PG8_WAIT_L(0); PG8_BAR; PG8_MMA(0, 0, At, B0); PG8_MMA(0, 1, At, B1); PG8_BAR; PG8_SCHED;
            PG8_LDA(At, 0, 1); PG8_STAGE(PG8_SB(0, 0), b2, voffB); PG8_STAGE(PG8_SB(0, 1), b2 + hstep, voffB); PG8_STAGE(PG8_SA(0, 0), a2, voffA);
            PG8_WAIT_V(8); PG8_WAIT_L(0); PG8_BAR; PG8_MMA(1, 0, At, B0); PG8_MMA(1, 1, At, B1); PG8_BAR; PG8_SCHED;
            PG8_LDB(B0, 1, 0); PG8_LDB(B1, 1, 1); PG8_SCHED; PG8_LDA(At, 1, 0); PG8_STAGE(PG8_SA(0, 1), a2 + hstep, voffA);
            PG8_WAIT_V(8); PG8_WAIT_L(0); PG8_BAR; PG8_MMA(0, 0, At, B0); PG8_MMA(0, 1, At, B1); PG8_BAR; PG8_SCHED;
            PG8_LDA(At, 1, 1); PG8_STAGE(PG8_SB(1, 0), b3, voffB); PG8_STAGE(PG8_SB(1, 1), b3 + hstep, voffB); PG8_STAGE(PG8_SA(1, 0), a3, voffA);
            PG8_WAIT_V(8); PG8_WAIT_L(0); PG8_BAR; PG8_MMA(1, 0, At, B0); PG8_MMA(1, 1, At, B1); PG8_BAR; PG8_SCHED;
            } else {
            PG8_LDB(B0, 0, 0); PG8_SCHED; PG8_LDA(At, 0, 0); PG8_STAGE(PG8_SA(1, 1), a1 + hstep, voffA);
            PG8_WAIT_L(8); PG8_BAR; PG8_WAIT_L(0); PG8_MMA(0, 0, At, B0); PG8_BAR; PG8_SCHED;
            PG8_LDB(B1, 0, 1); PG8_STAGE(PG8_SB(0, 0), b2, voffB);
            PG8_BAR; PG8_WAIT_L(0); PG8_MMA(0, 1, At, B1); PG8_BAR;
            PG8_LDA(At, 0, 1); PG8_STAGE(PG8_SA(0, 0), a2, voffA);
            PG8_BAR; PG8_WAIT_L(0); PG8_MMA(1, 0, At, B0); PG8_BAR; PG8_SCHED;
            PG8_STAGE(PG8_SB(0, 1), b2 + hstep, voffB);
            PG8_WAIT_V(6); PG8_BAR; PG8_MMA(1, 1, At, B1); PG8_BAR;
            PG8_LDB(B0, 1, 0); PG8_SCHED; PG8_LDA(At, 1, 0); PG8_STAGE(PG8_SA(0, 1), a2 + hstep, voffA);
            PG8_WAIT_L(8); PG8_BAR; PG8_WAIT_L(0); PG8_MMA(0, 0, At, B0); PG8_BAR; PG8_SCHED;
            PG8_LDB(B1, 1, 1); PG8_STAGE(PG8_SB(1, 0), b3, voffB);
            PG8_BAR; PG8_WAIT_L(0); PG8_MMA(0, 1, At, B1); PG8_BAR;
            PG8_LDA(At, 1, 1); PG8_STAGE(PG8_SA(1, 0), a3, voffA);
            PG8_BAR; PG8_WAIT_L(0); PG8_MMA(1, 0, At, B0); PG8_BAR; PG8_SCHED;
            PG8_STAGE(PG8_SB(1, 1), b3 + hstep, voffB);
            PG8_WAIT_V(6); PG8_BAR; PG8_MMA(1, 1, At, B1); PG8_BAR;
            }
        }
        if constexpr (ALIGN_EPI) { if (wr == 0) PG8_BAR; }
        if constexpr (!Epi::AFTER_DRAIN) { E(acc, cur, wr, wc, fr, fq); S.done(cur); }
        if (!has_next) break;
#pragma unroll
        for (int a = 0; a < 2; ++a)
#pragma unroll
            for (int b = 0; b < 2; ++b)
#pragma unroll
                for (int m = 0; m < 4; ++m)
#pragma unroll
                    for (int n = 0; n < 2; ++n) acc[a][b][m][n] = (f32x4){0.f, 0.f, 0.f, 0.f};
        cur = nxt; cA = nA; cB = nB; ++ui;
        if constexpr (ALIGN_EPI) { if (wr == 1) PG8_BAR; }
    }
    PG8_WAIT_V(0);
    if constexpr (!ALIGN_EPI) { if (wr == 0) PG8_BAR; }
    PG8_BAR;
    if constexpr (Epi::AFTER_DRAIN) { E.fused(acc, cur, wr, wc, fr, fq, lds, wid, lane); S.done(cur); }
#undef PG8_SA
#undef PG8_SB
#undef PG8_STAGE
#undef PG8_LDA
#undef PG8_LDB
#undef PG8_MMA
#undef PG8_WAIT_V
#undef PG8_WAIT_L
#undef PG8_BAR
#undef PG8_SCHED
}
}

constexpr int NWAVES = 8, NTHR = 512;
constexpr int DM = 1024, TSEQ = 4096, NP = 32768, NS = 128, NTOK = NP + NS, MPAD = 33024;
constexpr int INW = 9744, NPROJ = 9728, ABCOL = 6656;
constexpr float LN_EPS = 1e-5f, ALPHA = 1.189207115002721f, GLA_QSCALE = 0.08838834764831845f, NEG_BIG = -1e30f;
constexpr size_t OUT_YP = 0, OUT_YS = 33554432, OUT_KVP1 = 33685504, OUT_KVP2 = 34734080, OUT_KVP3 = 38928384, OUT_STP = 55705600,
                 OUT_KVS1 = 56754176, OUT_KVS2 = 60948480, OUT_KVS3 = 77725696, OUT_STS = 144834560, OUT_TOTAL = 149028864;
constexpr size_t MiB = 1u << 20;
constexpr size_t WS_CTL = 0, CTL_ZERO_BYTES = 1 * MiB;
constexpr size_t WS_KEYS = 1 * MiB, WS_LUT = WS_KEYS + 512 * 1024;
constexpr size_t WS_WA = 2 * MiB, WS_WB = 3 * MiB, WS_WO = 5 * MiB, WS_WQ = 7 * MiB, WS_WIN = 11 * MiB;
constexpr size_t WS_AB = 31 * MiB, WS_UT = 34 * MiB, WS_VT = 66 * MiB, WS_XB = 98 * MiB;
constexpr size_t WS_QA = 163 * MiB, WS_KA = 260 * MiB, WS_VA = 357 * MiB, WS_QB = 454 * MiB, WS_KB = 487 * MiB, WS_VB = 520 * MiB;
constexpr size_t WS_RB = 585 * MiB, WS_GA = 650 * MiB, WS_GB = 715 * MiB, WS_LSE = 780 * MiB, WS_OAM = 784 * MiB, WS_OBN = 817 * MiB, WS_H = 882 * MiB, WS_END = 1011 * MiB;
constexpr size_t WS_T1 = WS_KA, WS_MIX = WS_VA, WS_X1B = WS_QA, WS_QN = WS_RB, WS_EIDX = WS_GB, WS_GATE = WS_GB + 17 * MiB;
static_assert(WS_WIN + (size_t)NPROJ * 1024 * 2 <= WS_AB && WS_AB + (size_t)MPAD * 16 * 4 <= WS_UT && WS_XB + (size_t)MPAD * 1024 * 2 <= WS_QA, "ws map 1");
static_assert(WS_QA + (size_t)MPAD * 1536 * 2 <= WS_KA && WS_QB + (size_t)MPAD * 512 * 2 <= WS_KB && WS_VB + (size_t)MPAD * 1024 * 2 <= WS_RB, "ws map 2");
static_assert(WS_LSE + (size_t)3 * MPAD * 8 * 4 <= WS_OAM && WS_OAM + (size_t)MPAD * 512 * 2 <= WS_OBN && WS_OBN + (size_t)MPAD * 1024 * 2 <= WS_H && WS_H + (size_t)MPAD * 1024 * 4 <= WS_END, "ws map 3");
static_assert(WS_QN + (size_t)MPAD * 2048 * 2 <= WS_GB && WS_EIDX + (size_t)MPAD * 128 * 4 <= WS_GATE && WS_GATE + (size_t)MPAD * 128 * 4 <= WS_LSE, "ws map 4");
constexpr int CW_QUEUE = 64;
constexpr int CW_BAR = 4096;
constexpr int RING_BYTES = 131072, STATS_OFF = RING_BYTES, MISC_OFF = STATS_OFF + 10240 + 320, LDS_BYTES = 147456;
static_assert(MISC_OFF + 128 + 22 * 8 <= LDS_BYTES, "LDS map");

#define GAS __attribute__((address_space(1)))
#define LAS __attribute__((address_space(3)))
typedef unsigned short bf16;
typedef unsigned v4u __attribute__((ext_vector_type(4)));
typedef unsigned v2u __attribute__((ext_vector_type(2)));
typedef float f32x4 __attribute__((ext_vector_type(4)));
typedef float f32x16 __attribute__((ext_vector_type(16)));
typedef short bf16x8 __attribute__((ext_vector_type(8)));
typedef short s16x4 __attribute__((ext_vector_type(4)));
typedef GAS unsigned gu32;
#define RLX_AGENT __ATOMIC_RELAXED, __HIP_MEMORY_SCOPE_AGENT
#define LDS_WAIT() asm volatile("s_waitcnt lgkmcnt(0)" ::: "memory")
#define VM_WAIT() asm volatile("s_waitcnt vmcnt(0)" ::: "memory")
#define MFMA32(a, b, c) __builtin_amdgcn_mfma_f32_32x32x16_bf16((a), (b), (c), 0, 0, 0)
using pg8::cvt_pk_bf16; using pg8::bf_lo; using pg8::bf_hi;
__device__ __forceinline__ unsigned short f2bf(float f) { return (unsigned short)(cvt_pk_bf16(f, 0.f) & 0xffffu); }
__device__ __forceinline__ float bf2f(unsigned short h) { return __uint_as_float((unsigned)h << 16); }
__device__ __forceinline__ int crow(int reg, int hh) { return (reg & 3) + 8 * (reg >> 2) + 4 * hh; }
__device__ __forceinline__ float wave_sum(float v) {
#pragma unroll
    for (int o = 1; o < 64; o <<= 1) v += __shfl_xor(v, o);
    return v;
}
__device__ __forceinline__ float wave_max(float v) {
#pragma unroll
    for (int o = 1; o < 64; o <<= 1) v = fmaxf(v, __shfl_xor(v, o));
    return v;
}
__device__ __forceinline__ bf16x8 frag_row(const LAS unsigned char* T, int stride, int r0, int k0, int lane) {
    return *(const LAS bf16x8*)(T + (r0 + (lane & 31)) * stride + (k0 + 8 * (lane >> 5)) * 2);
}
typedef short v4i16_t __attribute__((ext_vector_type(4)));
template <bool PERM> __device__ __forceinline__ bf16x8 frag_tr(const LAS unsigned char* X, int stride, int k0, int c0, int lane) {
    const int i = lane & 15, g = (lane >> 4) & 1, hh = lane >> 5, q = i >> 2, p = i & 3;
    const int rA = PERM ? (k0 + 4 * hh + q) : (k0 + 8 * hh + q), rB = PERM ? (k0 + 8 + 4 * hh + q) : (k0 + 8 * hh + 4 + q);
    const int cb = (c0 + 16 * g + 4 * p) * 2;
    const s16x4 lo = __builtin_bit_cast(s16x4, __builtin_amdgcn_ds_read_tr16_b64_v4i16((LAS v4i16_t*)(X + rA * stride + cb)));
    const s16x4 hi = __builtin_bit_cast(s16x4, __builtin_amdgcn_ds_read_tr16_b64_v4i16((LAS v4i16_t*)(X + rB * stride + cb)));
    return __builtin_shufflevector(lo, hi, 0, 1, 2, 3, 4, 5, 6, 7);
}
__device__ __forceinline__ bf16x8 pack_acc(const f32x16& x, int s) {
    v4u p; p.x = cvt_pk_bf16(x[8 * s], x[8 * s + 1]); p.y = cvt_pk_bf16(x[8 * s + 2], x[8 * s + 3]); p.z = cvt_pk_bf16(x[8 * s + 4], x[8 * s + 5]); p.w = cvt_pk_bf16(x[8 * s + 6], x[8 * s + 7]);
    return __builtin_bit_cast(bf16x8, p);
}

#define XB_TMO      128
#define XB_XCNT(j)  (256  + 64 * (j))
#define XB_XSUB(j)  (1280 + 64 * (j))
#define XB_XGEN(j)  (2304 + 64 * (j))
#define XB_TOP      3328
#define XB_TOPGEN   3392
#define XCD_BAR_WORDS 3456
#define XB_SPIN_CAP (1u << 22)
__device__ __forceinline__ unsigned xb_ld(unsigned* p)              { return __hip_atomic_load(p, __ATOMIC_RELAXED, __HIP_MEMORY_SCOPE_AGENT); }
__device__ __forceinline__ unsigned xb_add(unsigned* p, unsigned v) { return __hip_atomic_fetch_add(p, v, __ATOMIC_RELAXED, __HIP_MEMORY_SCOPE_AGENT); }
__device__ __forceinline__ unsigned xb_xcc_id() { return (unsigned)__builtin_amdgcn_s_getreg((3 << 11) | 20) & 0xFu; }
#define XB_SPIN(cond, bar) do { unsigned _sp = 0; while (cond) { __builtin_amdgcn_s_sleep(1); \
    if ((++_sp & 255u) == 0u) { if (xb_ld(&(bar)[XB_TMO])) break; if (_sp > XB_SPIN_CAP) { atomicAdd(&(bar)[XB_TMO], 1u); break; } } } } while (0)
struct XcdBarrier { unsigned* bar; unsigned x; volatile LAS unsigned* st; };
__device__ __forceinline__ XcdBarrier xcd_barrier_post(unsigned* bar, volatile LAS unsigned* st) {
    XcdBarrier b; b.bar = bar; b.x = xb_xcc_id(); b.st = st;
    if (threadIdx.x == 0) (void)xb_add(&bar[XB_XCNT(b.x)], 1u);
    return b;
}
__device__ __forceinline__ void xcd_barrier_complete(unsigned* bar, unsigned x, unsigned& nloc, unsigned& nx) {
    const unsigned G = gridDim.x * gridDim.y * gridDim.z;
    unsigned sum, cnt, mine, sp = 0u;
    for (;;) {
        sum = 0u; cnt = 0u; mine = 0u;
#pragma unroll
        for (unsigned j = 0; j < 16; ++j) { const unsigned c = xb_ld(&bar[XB_XCNT(j)]); sum += c; cnt += (c > 0u) ? 1u : 0u; mine = (j == x) ? c : mine; }
        if (sum == G) break;
        __builtin_amdgcn_s_sleep(1);
        if ((++sp & 255u) == 0u) { if (xb_ld(&bar[XB_TMO])) break; if (sp > XB_SPIN_CAP) { atomicAdd(&bar[XB_TMO], 1u); break; } }
    }
    nloc = mine > 0u ? mine : 1u; nx = cnt > 0u ? cnt : 1u;
}
__device__ __forceinline__ void xcd_barrier(const XcdBarrier& b) {
    asm volatile("s_waitcnt vmcnt(0)" ::: "memory");
    __syncthreads();
    if (threadIdx.x == 0) {
        unsigned* bar = b.bar;
        __builtin_amdgcn_s_waitcnt(0);
        unsigned nloc = b.st[0], nx = b.st[1];
        if (nloc == 0u) { xcd_barrier_complete(bar, b.x, nloc, nx); b.st[0] = nloc; b.st[1] = nx; }
        const unsigned old = xb_add(&bar[XB_XSUB(b.x)], 1u);
        const unsigned gen = old / nloc;
        if (old + 1u == (gen + 1u) * nloc) {
            __builtin_amdgcn_fence(__ATOMIC_RELEASE, "agent");
            asm volatile("s_waitcnt vmcnt(0)" ::: "memory");
            const unsigned og = xb_add(&bar[XB_TOP], 1u);
            const unsigned tg = og / nx;
            if (og + 1u == (tg + 1u) * nx) xb_add(&bar[XB_TOPGEN], 1u);
            else XB_SPIN(xb_ld(&bar[XB_TOPGEN]) == tg, bar);
            __builtin_amdgcn_fence(__ATOMIC_ACQUIRE, "agent");
            xb_add(&bar[XB_XGEN(b.x)], 1u);
            asm volatile("s_waitcnt vmcnt(0)" ::: "memory");
        } else {
            XB_SPIN(xb_ld(&bar[XB_XGEN(b.x)]) == gen, bar);
            __builtin_amdgcn_fence(__ATOMIC_ACQUIRE, "agent");
            asm volatile("s_waitcnt vmcnt(0)" ::: "memory");
        }
    }
    __syncthreads();
}

struct Frame {
    LAS unsigned char* lds;
    volatile LAS unsigned* MISC;
    gu32* ctl;
    int tid, lane, wave, G;
    float* out; unsigned char* ws;
};
#define WSP(T, off) ((T*)(F.ws + (off)))
#define WSL(T, off) ((T*)(ws_ + (off)))
#define LAUNDER_WS() unsigned char* ws_ = F.ws; asm volatile("" : "+s"(ws_))
constexpr int PTR_OFF = MISC_OFF + 128;
enum { I_XP = 0, I_XS, I_C1, I_C2, I_C3, I_ST0, I_RELB, I_WIN, I_WG2, I_BG, I_GN, I_WA, I_WB, I_WO, I_L1G, I_L1B, I_WQ, I_KEYS, I_PU, I_PV, I_L2G, I_L2B };
__device__ __forceinline__ const float* inptr(const Frame& F, int i) {
    const unsigned long long v = ((volatile LAS unsigned long long*)(F.lds + PTR_OFF))[i];
    const unsigned lo = __builtin_amdgcn_readfirstlane((unsigned)v), hi = __builtin_amdgcn_readfirstlane((unsigned)(v >> 32));
    return (const float*)(((unsigned long long)hi << 32) | lo);
}

__device__ __forceinline__ void p0_transpose_item(const float* W, int K, int N, int nsrc0, bf16* WT, int ndst0, int k0, LAS float* scr, int lane) {
#pragma unroll 8
    for (int i = 0; i < 32; ++i) { const int kk = 2 * i + (lane >> 5); scr[kk * 33 + (lane & 31)] = W[(size_t)(k0 + kk) * N + nsrc0 + (lane & 31)]; }
    LDS_WAIT(); asm volatile("" ::: "memory");
    const int c = lane & 7;
#pragma unroll
    for (int j = 0; j < 4; ++j) { const int n = (lane >> 3) + 8 * j; const LAS float* s = scr + (8 * c) * 33 + n;
        v4u o; o.x = cvt_pk_bf16(s[0 * 33], s[1 * 33]); o.y = cvt_pk_bf16(s[2 * 33], s[3 * 33]); o.z = cvt_pk_bf16(s[4 * 33], s[5 * 33]); o.w = cvt_pk_bf16(s[6 * 33], s[7 * 33]);
        *(GAS v4u*)(WT + (size_t)(ndst0 + n) * K + k0 + 8 * c) = o; }
    LDS_WAIT(); asm volatile("" ::: "memory");
}
__device__ __forceinline__ void p0_cvt8(const float* src, bf16* dst, size_t n8, size_t gt, size_t ngt) {
    for (size_t i = gt; i < n8; i += ngt) { const f32x4 a = *(const f32x4*)(src + i * 8), b = *(const f32x4*)(src + i * 8 + 4);
        v4u o; o.x = cvt_pk_bf16(a[0], a[1]); o.y = cvt_pk_bf16(a[2], a[3]); o.z = cvt_pk_bf16(b[0], b[1]); o.w = cvt_pk_bf16(b[2], b[3]); *(v4u*)(dst + i * 8) = o; }
}
__device__ __forceinline__ void p0_kvshift(const float* src, float* dst, int Wb, size_t gt, size_t ngt) {
    const size_t n4 = (size_t)(Wb - 4) * 256, tot = n4 * 32;
    for (size_t i = gt; i < tot; i += ngt) { const size_t b = i / n4, r = i - b * n4;
        ((f32x4*)dst)[b * (size_t)Wb * 256 + r] = ((const f32x4*)src)[b * (size_t)Wb * 256 + 1024 + r]; }
}
__device__ __forceinline__ void p0_prologue(Frame& F) {
    const int gw = blockIdx.x * NWAVES + F.wave, NGW = F.G * NWAVES;
    const size_t gt = (size_t)blockIdx.x * NTHR + F.tid, ngt = (size_t)F.G * NTHR;
    const float* win = inptr(F, I_WIN); const float* xp = inptr(F, I_XP); const float* xs = inptr(F, I_XS);
    LAS float* wab = (LAS float*)F.lds;
    for (int i = F.tid; i < 16384; i += NTHR) { const int ln = i & 63, e = (i >> 6) & 3, j = (i >> 8) & 3, c = i >> 10; const int k = 4 * (ln + 64 * j) + e; wab[i] = win[(size_t)k * INW + ABCOL + c]; }
    __syncthreads();
    bf16* XB = WSP(bf16, WS_XB); float* AB = WSP(float, WS_AB);
    for (int m = gw; m < MPAD; m += NGW) {
        GAS unsigned long long* o8 = (GAS unsigned long long*)(XB + (size_t)m * 1024) + F.lane;
        if (m >= NTOK) {
#pragma unroll
            for (int j = 0; j < 4; ++j) o8[64 * j] = 0ull;
            if (F.lane < 16) AB[(size_t)m * 16 + F.lane] = 0.f;
            continue; }
        const float* xr = m < NP ? xp + (size_t)m * 1024 : xs + (size_t)(m - NP) * 1024;
        f32x4 v[4];
#pragma unroll
        for (int j = 0; j < 4; ++j) v[j] = ((const f32x4*)xr)[F.lane + 64 * j];
#pragma unroll
        for (int j = 0; j < 4; ++j) o8[64 * j] = (unsigned long long)cvt_pk_bf16(v[j][0], v[j][1]) | ((unsigned long long)cvt_pk_bf16(v[j][2], v[j][3]) << 32);
        float mine = 0.f;
#pragma unroll
        for (int c = 0; c < 16; ++c) { float a = 0.f;
#pragma unroll
            for (int j = 0; j < 4; ++j)
#pragma unroll
                for (int e = 0; e < 4; ++e) a += v[j][e] * wab[((c * 4 + j) * 4 + e) * 64 + F.lane];
            a = wave_sum(a); mine = (F.lane == c) ? a : mine; }
        if (F.lane < 16) AB[(size_t)m * 16 + F.lane] = mine;
    }
    __syncthreads();
    LAS float* scr = (LAS float*)(F.lds + F.wave * 16384);
    const float* wa = inptr(F, I_WA); const float* wb = inptr(F, I_WB); const float* wo = inptr(F, I_WO); const float* wq = inptr(F, I_WQ);
    constexpr int I_IN = 16 * (NPROJ / 32), I_A = 8 * 32, I_B = 16 * 32, I_O = 16 * 32, I_Q = 16 * 64, NIT = I_IN + I_A + I_B + I_O + I_Q;
    for (int it = gw; it < NIT; it += NGW) {
        int r = it;
        if (r < I_IN) { const int nb = r % (NPROJ / 32), kb = r / (NPROJ / 32), nd = 32 * nb; p0_transpose_item(win, 1024, INW, nd + (nd >= ABCOL ? 16 : 0), WSP(bf16, WS_WIN), nd, 64 * kb, scr, F.lane); continue; } r -= I_IN;
        if (r < I_A) { p0_transpose_item(wa, 512, 1024, 32 * (r % 32), WSP(bf16, WS_WA), 32 * (r % 32), 64 * (r / 32), scr, F.lane); continue; } r -= I_A;
        if (r < I_B) { p0_transpose_item(wb, 1024, 1024, 32 * (r % 32), WSP(bf16, WS_WB), 32 * (r % 32), 64 * (r / 32), scr, F.lane); continue; } r -= I_B;
        if (r < I_O) { p0_transpose_item(wo, 1024, 1024, 32 * (r % 32), WSP(bf16, WS_WO), 32 * (r % 32), 64 * (r / 32), scr, F.lane); continue; } r -= I_O;
        p0_transpose_item(wq, 1024, 2048, 32 * (r % 64), WSP(bf16, WS_WQ), 32 * (r % 64), 64 * (r / 64), scr, F.lane);
    }
    p0_cvt8(inptr(F, I_PU), WSP(bf16, WS_UT), (size_t)16384 * 1024 / 8, gt, ngt);
    p0_cvt8(inptr(F, I_PV), WSP(bf16, WS_VT), (size_t)16384 * 1024 / 8, gt, ngt);
    p0_cvt8(inptr(F, I_KEYS), WSP(bf16, WS_KEYS), (size_t)8 * 2 * 128 * 128 / 8, gt, ngt);
    if (gt < 3 * 8 * 129) { const int g = (int)gt / (8 * 129), h = ((int)gt / 129) % 8, rel = (int)gt % 129; const int dil = g == 0 ? 1 : (g == 1 ? 4 : 16), dist = rel * dil;
        int bucket = dist;
        if (dist >= 16) { const float dd = (float)dist; int lg = 16 + (int)(logf(dd / 16.0f) / 4.852030263919617f * 16.0f); bucket = lg < 31 ? lg : 31; }
        WSP(float, WS_LUT)[gt] = inptr(F, I_RELB)[bucket * 24 + g * 8 + h]; }
    p0_kvshift(inptr(F, I_C1), F.out + OUT_KVS1, 128, gt, ngt);
    p0_kvshift(inptr(F, I_C2), F.out + OUT_KVS2, 512, gt, ngt);
    p0_kvshift(inptr(F, I_C3), F.out + OUT_KVS3, 2048, gt, ngt);
}

__device__ __forceinline__ void gla_prompt_unit(Frame& F, int b, int h, int sl) {
    LAUNDER_WS();
    LAS unsigned char* L = F.lds;
    constexpr int O_QE = 0, O_KE = 17408, O_KD = 34816, O_VT = 55296, O_SB = 67584, O_GT = 92160, O_AB = 94208, O_DEC = 98304;
    const int tid = F.tid, lane = F.lane, w = F.wave, hh = lane >> 5;
    const int d = tid & 127, ig = tid >> 7;
    const bf16* QB = WSL(bf16, WS_QB); const bf16* KB = WSL(bf16, WS_KB); bf16* VB = WSL(bf16, WS_VB); const float* AB = WSL(float, WS_AB);
    float wg[16];
    { const float* wg2 = inptr(F, I_WG2);
#pragma unroll
    for (int r = 0; r < 16; ++r) wg[r] = wg2[r * 512 + h * 128 + d]; }
    const float bgd = inptr(F, I_BG)[h * 128 + d];
    for (int i = tid; i < 128 * 192 / 4; i += NTHR) ((LAS unsigned*)(L + O_SB))[i] = 0u;
    f32x16 S;
#pragma unroll
    for (int r = 0; r < 16; ++r) S[r] = 0.f;
    const int dt = w >> 1, et = w & 1;
    for (int n = 0; n < 64; ++n) {
        const size_t m0 = (size_t)b * TSEQ + (size_t)n * 64;
        unsigned short qv[16], kv[16];
#pragma unroll
        for (int ii = 0; ii < 16; ++ii) { const size_t row = m0 + 16 * ig + ii; qv[ii] = QB[row * 512 + h * 128 + d]; kv[ii] = KB[row * 512 + h * 128 + d]; }
        const v4u vv = *(const v4u*)(VB + (m0 + (tid >> 3)) * 1024 + h * 256 + sl * 64 + (tid & 7) * 8);
        if (tid < 256) *(LAS f32x4*)(L + O_AB + tid * 16) = *(const f32x4*)(AB + (m0 + (tid >> 2)) * 16 + (tid & 3) * 4);
        *(LAS v4u*)(L + O_VT + (tid >> 3) * 192 + (tid & 7) * 16) = vv;
        __syncthreads();
        float c[16]; float run = 0.f;
#pragma unroll
        for (int ii = 0; ii < 16; ++ii) {
            const LAS f32x4* ar = (const LAS f32x4*)(L + O_AB + (16 * ig + ii) * 64);
            const f32x4 a0 = ar[0], a1 = ar[1], a2 = ar[2], a3 = ar[3];
            float x = bgd;
            x += a0[0] * wg[0] + a0[1] * wg[1] + a0[2] * wg[2] + a0[3] * wg[3];
            x += a1[0] * wg[4] + a1[1] * wg[5] + a1[2] * wg[6] + a1[3] * wg[7];
            x += a2[0] * wg[8] + a2[1] * wg[9] + a2[2] * wg[10] + a2[3] * wg[11];
            x += a3[0] * wg[12] + a3[1] * wg[13] + a3[2] * wg[14] + a3[3] * wg[15];
            const float ls = fminf(x, 0.f) - log1pf(expf(-fabsf(x)));
            run += ls * (1.0f / 16.0f); c[ii] = run;
        }
        ((LAS float*)(L + O_GT))[ig * 128 + d] = run;
        __syncthreads();
        const float g0 = ((LAS float*)(L + O_GT))[d], g1 = ((LAS float*)(L + O_GT))[128 + d], g2 = ((LAS float*)(L + O_GT))[256 + d], g3 = ((LAS float*)(L + O_GT))[384 + d];
        const float offs = (ig > 0 ? g0 : 0.f) + (ig > 1 ? g1 : 0.f) + (ig > 2 ? g2 : 0.f), bl = (g0 + g1) + (g2 + g3);
        const float ebl = expf(bl);
#pragma unroll
        for (int ii = 0; ii < 16; ++ii) {
            const float bb = offs + c[ii], eb = expf(bb), ieb = expf(-bb);
            const float q = bf2f(qv[ii]), k = bf2f(kv[ii]);
            const int rowo = (16 * ig + ii);
            *(LAS unsigned short*)(L + O_QE + rowo * 272 + d * 2) = f2bf(q * GLA_QSCALE * eb);
            *(LAS unsigned short*)(L + O_KE + rowo * 272 + d * 2) = f2bf(k * ieb);
            *(LAS unsigned short*)(L + O_KD + rowo * 320 + d * 2) = f2bf(k * (ieb * ebl));
        }
        if (ig == 0) ((LAS float*)(L + O_DEC))[d] = ebl;
        __syncthreads();
        if (w < 4) {
            const int it = w >> 1;
            f32x16 o;
#pragma unroll
            for (int r = 0; r < 16; ++r) o[r] = 0.f;
            for (int jt = 0; jt <= it; ++jt) {
                f32x16 X;
#pragma unroll
                for (int r = 0; r < 16; ++r) X[r] = 0.f;
#pragma unroll
                for (int s = 0; s < 8; ++s) X = MFMA32(frag_row(L + O_KE, 272, 32 * jt, 16 * s, lane), frag_row(L + O_QE, 272, 32 * it, 16 * s, lane), X);
                if (jt == it) {
#pragma unroll
                    for (int r = 0; r < 16; ++r) if (crow(r, hh) > (lane & 31)) X[r] = 0.f;
                }
#pragma unroll
                for (int s2 = 0; s2 < 2; ++s2) o = MFMA32(pack_acc(X, s2), frag_tr<true>(L + O_VT, 192, 32 * jt + 16 * s2, 32 * et, lane), o);
            }
#pragma unroll
            for (int s = 0; s < 8; ++s) o = MFMA32(frag_row(L + O_QE, 272, 32 * it, 16 * s, lane), frag_tr<false>(L + O_SB, 192, 16 * s, 32 * et, lane), o);
            bf16* op = VB + (m0 + 32 * it) * 1024 + h * 256 + sl * 64 + 32 * et + (lane & 31);
#pragma unroll
            for (int r = 0; r < 16; ++r) op[(size_t)crow(r, hh) * 1024] = f2bf(o[r]);
        }
        {
#pragma unroll
            for (int r = 0; r < 16; ++r) S[r] *= ((LAS float*)(L + O_DEC))[32 * dt + crow(r, hh)];
#pragma unroll
            for (int s = 0; s < 4; ++s) S = MFMA32(frag_tr<false>(L + O_KD, 320, 16 * s, 32 * dt, lane), frag_tr<false>(L + O_VT, 192, 16 * s, 32 * et, lane), S);
        }
        __syncthreads();
#pragma unroll
        for (int r = 0; r < 16; ++r) *(LAS unsigned short*)(L + O_SB + (32 * dt + crow(r, hh)) * 192 + (32 * et + (lane & 31)) * 2) = f2bf(S[r]);
    }
    float* so = F.out + OUT_STP + ((size_t)(b * 4 + h) * 128 + 32 * dt) * 256 + sl * 64 + 32 * et + (lane & 31);
#pragma unroll
    for (int r = 0; r < 16; ++r) so[(size_t)crow(r, hh) * 256] = S[r];
    __syncthreads();
}

__device__ __forceinline__ void attn_prompt_item(Frame& F, int item) {
    LAUNDER_WS();
    LAS unsigned char* L = F.lds;
    constexpr int O_V = 0, O_LUT = 384 * 192;
    const int tid = F.tid, lane = F.lane, w = F.wave, hh = lane >> 5, il = lane & 31;
    const int bh = item / 48, sub = item % 48, b = bh >> 3, h = bh & 7;
    int g, r, ibg;
    if (sub < 16) { g = 0; r = 0; ibg = sub; } else if (sub < 32) { g = 1; r = (sub - 16) >> 2; ibg = (sub - 16) & 3; } else { g = 2; r = sub - 32; ibg = 0; }
    const int dil = g == 0 ? 1 : (g == 1 ? 4 : 16), i0 = 256 * ibg;
    bf16* QA = WSL(bf16, WS_QA); const bf16* KA = WSL(bf16, WS_KA); const bf16* VA = WSL(bf16, WS_VA); float* LSE = WSL(float, WS_LSE);
    const size_t tok0 = (size_t)b * TSEQ + r; const int cb = g * 512 + h * 64;
#pragma unroll
    for (int p = 0; p < 6; ++p) { const int idx = tid + NTHR * p, rr = idx >> 3, ch = idx & 7, j = i0 - 128 + rr;
        if (j >= 0) *(LAS v4u*)(L + O_V + rr * 192 + ch * 16) = *(const v4u*)(VA + (tok0 + (size_t)dil * j) * 1536 + cb + ch * 8); }
    if (tid < 129) ((LAS float*)(L + O_LUT))[tid] = WSL(float, WS_LUT)[(g * 8 + h) * 129 + tid];
    __syncthreads();
    const size_t qtok = tok0 + (size_t)dil * (i0 + 32 * w + il);
    bf16x8 qf[4];
#pragma unroll
    for (int s = 0; s < 4; ++s) qf[s] = *(const bf16x8*)(QA + qtok * 1536 + cb + 16 * s + 8 * hh);
    float mrun = NEG_BIG, lrun = 0.f;
    f32x16 O0, O1;
#pragma unroll
    for (int x = 0; x < 16; ++x) { O0[x] = 0.f; O1[x] = 0.f; }
#pragma unroll 1
    for (int kt = 0; kt < 5; ++kt) {
        const int jb = i0 + 32 * (w + kt) - 128;
        if (jb < 0) continue;
        const size_t ktok = tok0 + (size_t)dil * (jb + il);
        f32x16 ST;
#pragma unroll
        for (int x = 0; x < 16; ++x) ST[x] = 0.f;
#pragma unroll
        for (int s = 0; s < 4; ++s) { const bf16x8 kf = *(const bf16x8*)(KA + ktok * 1536 + cb + 16 * s + 8 * hh); ST = MFMA32(kf, qf[s], ST); }
        const int relb = 128 - 32 * kt + il;
        float tmax = NEG_BIG;
#pragma unroll
        for (int x = 0; x < 16; ++x) { const int rel = relb - crow(x, hh); const bool ok = rel >= 0 && rel <= 128; const int rc = rel < 0 ? 0 : (rel > 128 ? 128 : rel);
            const float sc = ok ? ST[x] + ((LAS float*)(L + O_LUT))[rc] : NEG_BIG; ST[x] = sc; tmax = fmaxf(tmax, sc); }
        tmax = fmaxf(tmax, __shfl_xor(tmax, 32));
        const float mnew = fmaxf(mrun, tmax), alpha = __expf(mrun - mnew);
        float ps = 0.f;
#pragma unroll
        for (int x = 0; x < 16; ++x) { const float p = __expf(ST[x] - mnew); ST[x] = p; ps += p; }
        lrun = lrun * alpha + ps; mrun = mnew;
#pragma unroll
        for (int x = 0; x < 16; ++x) { O0[x] *= alpha; O1[x] *= alpha; }
#pragma unroll
        for (int s2 = 0; s2 < 2; ++s2) { const bf16x8 pf = pack_acc(ST, s2);
            O0 = MFMA32(frag_tr<true>(L + O_V, 192, 32 * (w + kt) + 16 * s2, 0, lane), pf, O0);
            O1 = MFMA32(frag_tr<true>(L + O_V, 192, 32 * (w + kt) + 16 * s2, 32, lane), pf, O1); }
    }
    const float ltot = lrun + __shfl_xor(lrun, 32), inv = 1.0f / ltot;
    bf16* op = QA + qtok * 1536 + cb;
#pragma unroll
    for (int k4 = 0; k4 < 4; ++k4) { v2u a, c2;
        a.x = cvt_pk_bf16(O0[4 * k4] * inv, O0[4 * k4 + 1] * inv); a.y = cvt_pk_bf16(O0[4 * k4 + 2] * inv, O0[4 * k4 + 3] * inv);
        c2.x = cvt_pk_bf16(O1[4 * k4] * inv, O1[4 * k4 + 1] * inv); c2.y = cvt_pk_bf16(O1[4 * k4 + 2] * inv, O1[4 * k4 + 3] * inv);
        *(v2u*)(op + 8 * k4 + 4 * hh) = a; *(v2u*)(op + 32 + 8 * k4 + 4 * hh) = c2; }
    if (hh == 0) LSE[((size_t)g * MPAD + qtok) * 8 + h] = mrun + __logf(ltot);
    __syncthreads();
}

template <int G_> __device__ __forceinline__ void attn_sample_waveitem_g(Frame& F, int wi, const float* cache) {
    LAUNDER_WS();
    const int lane = F.lane;
    LAS float* pl = (LAS float*)(F.lds + F.wave * 1024);
    constexpr int g = G_; const int h = (wi / 3) & 7, s = (wi / 24) & 3, b = wi / 96;
    constexpr int dil = g == 0 ? 1 : (g == 1 ? 4 : 16), Wb = 128 * dil;
    bf16* QA = WSL(bf16, WS_QA); const bf16* KA = WSL(bf16, WS_KA); const bf16* VA = WSL(bf16, WS_VA); float* LSE = WSL(float, WS_LSE);
    const size_t qrow = (size_t)NP + b * 4 + s; const int cb = g * 512 + h * 64;
    float q[64];
#pragma unroll
    for (int c = 0; c < 8; ++c) { const v4u u = *(const v4u*)(QA + qrow * 1536 + cb + 8 * c);
        q[8 * c] = bf_lo(u.x); q[8 * c + 1] = bf_hi(u.x); q[8 * c + 2] = bf_lo(u.y); q[8 * c + 3] = bf_hi(u.y); q[8 * c + 4] = bf_lo(u.z); q[8 * c + 5] = bf_hi(u.z); q[8 * c + 6] = bf_lo(u.w); q[8 * c + 7] = bf_hi(u.w); }
    const float* lut = WSL(float, WS_LUT) + (g * 8 + h) * 129;
    float sc[3];
#pragma unroll
    for (int p = 0; p < 3; ++p) { const int j = lane + 64 * p; float a = NEG_BIG;
        if (j <= 128) { const int idx = Wb + s - j * dil; a = 0.f;
            if (idx >= Wb) { const bf16* kr = KA + ((size_t)NP + b * 4 + (idx - Wb)) * 1536 + cb;
#pragma unroll
                for (int c = 0; c < 8; ++c) { const v4u u = *(const v4u*)(kr + 8 * c);
                    a += q[8 * c] * bf_lo(u.x) + q[8 * c + 1] * bf_hi(u.x) + q[8 * c + 2] * bf_lo(u.y) + q[8 * c + 3] * bf_hi(u.y) + q[8 * c + 4] * bf_lo(u.z) + q[8 * c + 5] * bf_hi(u.z) + q[8 * c + 6] * bf_lo(u.w) + q[8 * c + 7] * bf_hi(u.w); }
            } else { const float* kr = cache + (((size_t)b * Wb + idx) * 2 + 0) * 512 + h * 64;
#pragma unroll
                for (int c = 0; c < 16; ++c) { const f32x4 u = *(const f32x4*)(kr + 4 * c); a += q[4 * c] * u[0] + q[4 * c + 1] * u[1] + q[4 * c + 2] * u[2] + q[4 * c + 3] * u[3]; }
            }
            a += lut[j]; }
        sc[p] = a; }
    const float mx = wave_max(fmaxf(fmaxf(sc[0], sc[1]), sc[2]));
    float ps = 0.f;
#pragma unroll
    for (int p = 0; p < 3; ++p) { const float e = __expf(sc[p] - mx); ps += e; pl[lane + 64 * p] = e; }
    const float ltot = wave_sum(ps);
    LDS_WAIT(); asm volatile("" ::: "memory");
    float o = 0.f;
    for (int j = 0; j <= 128; ++j) { const int idx = Wb + s - j * dil; const float p = pl[j];
        const float v = idx >= Wb ? bf2f(VA[((size_t)NP + b * 4 + (idx - Wb)) * 1536 + cb + lane]) : cache[(((size_t)b * Wb + idx) * 2 + 1) * 512 + h * 64 + lane];
        o += p * v; }
    QA[qrow * 1536 + cb + lane] = f2bf(o / ltot);
    if (lane == 0) LSE[((size_t)g * MPAD + qrow) * 8 + h] = mx + __logf(ltot);
    LDS_WAIT(); asm volatile("" ::: "memory");
}

__device__ __forceinline__ void attn_sample_waveitem(Frame& F, int wi) {
    const int g = wi % 3;
    if (g == 0) attn_sample_waveitem_g<0>(F, wi, inptr(F, I_C1)); else if (g == 1) attn_sample_waveitem_g<1>(F, wi, inptr(F, I_C2)); else attn_sample_waveitem_g<2>(F, wi, inptr(F, I_C3));
}
__device__ __forceinline__ void gla_sample_item(Frame& F, int item) {
    LAUNDER_WS();
    LAS float* L = (LAS float*)F.lds;
    constexpr int O_LA = 0, O_QE = 512, O_KE = 1024, O_KD = 1536, O_DEC = 2048, O_ATT = 2176, O_PART = 2304;
    const int tid = F.tid, b = item >> 2, h = item & 3;
    const bf16* QB = WSL(bf16, WS_QB); const bf16* KB = WSL(bf16, WS_KB); bf16* VB = WSL(bf16, WS_VB); const float* AB = WSL(float, WS_AB);
    const size_t row0 = (size_t)NP + b * 4;
    { const int i = tid >> 7, d = tid & 127; float x = inptr(F, I_BG)[h * 128 + d]; const float* wg2 = inptr(F, I_WG2);
#pragma unroll
      for (int r = 0; r < 16; ++r) x += AB[(row0 + i) * 16 + r] * wg2[r * 512 + h * 128 + d];
      L[O_LA + i * 128 + d] = (fminf(x, 0.f) - log1pf(expf(-fabsf(x)))) * (1.0f / 16.0f); }
    __syncthreads();
    if (tid < 128) { const int d = tid; float bb[4]; float run = 0.f;
#pragma unroll
        for (int i = 0; i < 4; ++i) { run += L[O_LA + i * 128 + d]; bb[i] = run; }
        const float ebl = expf(run); L[O_DEC + d] = ebl;
#pragma unroll
        for (int i = 0; i < 4; ++i) { const float q = bf2f(QB[(row0 + i) * 512 + h * 128 + d]), k = bf2f(KB[(row0 + i) * 512 + h * 128 + d]);
            L[O_QE + i * 128 + d] = q * GLA_QSCALE * expf(bb[i]); L[O_KE + i * 128 + d] = k * expf(-bb[i]); L[O_KD + i * 128 + d] = k * expf(run - bb[i]); } }
    __syncthreads();
    if (tid < 16) { const int i = tid >> 2, j = tid & 3; float a = 0.f;
        if (j <= i) for (int d = 0; d < 128; ++d) a += L[O_QE + i * 128 + d] * L[O_KE + j * 128 + d];
        L[O_ATT + tid] = a; }
    const int e = tid & 255, dh = tid >> 8;
    float v[4];
#pragma unroll
    for (int j = 0; j < 4; ++j) v[j] = bf2f(VB[(row0 + j) * 1024 + h * 256 + e]);
    const float* Sin = inptr(F, I_ST0) + ((size_t)(b * 4 + h) * 128) * 256 + e; float* Sout = F.out + OUT_STS + ((size_t)(b * 4 + h) * 128) * 256 + e;
    float acc[4] = {0.f, 0.f, 0.f, 0.f};
#pragma unroll 4
    for (int dd = 0; dd < 64; ++dd) { const int d = dh * 64 + dd; const float sv = Sin[(size_t)d * 256];
#pragma unroll
        for (int i = 0; i < 4; ++i) acc[i] += L[O_QE + i * 128 + d] * sv;
        float sn = L[O_DEC + d] * sv;
#pragma unroll
        for (int j = 0; j < 4; ++j) sn += L[O_KD + j * 128 + d] * v[j];
        Sout[(size_t)d * 256] = sn; }
#pragma unroll
    for (int i = 0; i < 4; ++i) L[O_PART + (dh * 4 + i) * 256 + e] = acc[i];
    __syncthreads();
    if (tid < 256) {
#pragma unroll
        for (int i = 0; i < 4; ++i) { float o = L[O_PART + i * 256 + e] + L[O_PART + (4 + i) * 256 + e];
#pragma unroll
            for (int j = 0; j < 4; ++j) o += L[O_ATT + i * 4 + j] * v[j];
            VB[(row0 + i) * 1024 + h * 256 + e] = f2bf(o); } }
    __syncthreads();
}

constexpr int P2_ATT = 3072, P2_DEC = 384, P2_GLS = 128, P2_ITEMS = P2_ATT + P2_DEC + P2_GLS;
__device__ __forceinline__ void p2_mixers(Frame& F) {
#ifndef P2_SKIP_GLAP
    if (blockIdx.x < 128) gla_prompt_unit(F, blockIdx.x >> 4, (blockIdx.x >> 2) & 3, blockIdx.x & 3);
#endif
    for (;;) {
        if (F.tid == 0) F.MISC[0] = __hip_atomic_fetch_add(F.ctl + CW_QUEUE, 1u, RLX_AGENT);
        __syncthreads();
        const int it = (int)F.MISC[0];
        __syncthreads();
        if (it >= P2_ITEMS) break;
        if (it < P2_GLS) {
#ifndef P2_SKIP_GLAS
            gla_sample_item(F, it);
#endif
        } else if (it < P2_GLS + P2_DEC) {
#ifndef P2_SKIP_DEC
            attn_sample_waveitem(F, (it - P2_GLS) * 8 + F.wave); __syncthreads();
#endif
        } else {
#ifndef P2_SKIP_ATT
            attn_prompt_item(F, it - P2_GLS - P2_DEC);
#endif
        }
    }
}

__device__ __forceinline__ void p3_kvout(const bf16* K, const bf16* V, float* dst, int g, int W, int nb, size_t rowbase, int rows_per_b, int first, int pos0, int Wdst, size_t gt, size_t ngt) {
    const size_t per_b = (size_t)W * 2 * 64, tot = per_b * nb;
    for (size_t i = gt; i < tot; i += ngt) { const size_t b = i / per_b, r = i - b * per_b; const int p = (int)(r >> 7), c = (int)(r >> 6) & 1, ch = (int)r & 63;
        const v4u u = *(const v4u*)((c ? V : K) + (rowbase + b * rows_per_b + first + p) * 1536 + g * 512 + ch * 8);
        float* o = dst + ((b * Wdst + pos0 + p) * 2 + c) * 512 + ch * 8;
        *(f32x4*)o = (f32x4){bf_lo(u.x), bf_hi(u.x), bf_lo(u.y), bf_hi(u.y)}; *(f32x4*)(o + 4) = (f32x4){bf_lo(u.z), bf_hi(u.z), bf_lo(u.w), bf_hi(u.w)}; }
}
__device__ __forceinline__ void p3_merge(Frame& F) {
    const int gw = blockIdx.x * NWAVES + F.wave, NGW = F.G * NWAVES, lane = F.lane;
    const size_t gt = (size_t)blockIdx.x * NTHR + F.tid, ngt = (size_t)F.G * NTHR;
    const bf16* OA = WSP(bf16, WS_QA); const bf16* OB = WSP(bf16, WS_VB); const bf16* RB = WSP(bf16, WS_RB); const float* LSE = WSP(float, WS_LSE);
    bf16* OAM = WSP(bf16, WS_OAM); bf16* OBN = WSP(bf16, WS_OBN); const float* gn = inptr(F, I_GN);
    for (int m = gw; m < MPAD; m += NGW) {
        if (m >= NTOK) { *(v4u*)(OAM + (size_t)m * 512 + lane * 8) = (v4u){0u, 0u, 0u, 0u}; *(v4u*)(OBN + (size_t)m * 1024 + lane * 16) = (v4u){0u, 0u, 0u, 0u}; *(v4u*)(OBN + (size_t)m * 1024 + lane * 16 + 8) = (v4u){0u, 0u, 0u, 0u}; continue; }
        {
            const int hd = lane >> 3, c8 = (lane & 7) * 8;
            const float l0 = LSE[((size_t)0 * MPAD + m) * 8 + hd], l1 = LSE[((size_t)1 * MPAD + m) * 8 + hd], l2 = LSE[((size_t)2 * MPAD + m) * 8 + hd];
            const float mx = fmaxf(l0, fmaxf(l1, l2)); float w0 = __expf(l0 - mx), w1 = __expf(l1 - mx), w2 = __expf(l2 - mx); const float iw = 1.0f / (w0 + w1 + w2); w0 *= iw; w1 *= iw; w2 *= iw;
            const v4u a = *(const v4u*)(OA + (size_t)m * 1536 + hd * 64 + c8), b2 = *(const v4u*)(OA + (size_t)m * 1536 + 512 + hd * 64 + c8), c = *(const v4u*)(OA + (size_t)m * 1536 + 1024 + hd * 64 + c8);
            v4u o;
            o.x = cvt_pk_bf16(w0 * bf_lo(a.x) + w1 * bf_lo(b2.x) + w2 * bf_lo(c.x), w0 * bf_hi(a.x) + w1 * bf_hi(b2.x) + w2 * bf_hi(c.x));
            o.y = cvt_pk_bf16(w0 * bf_lo(a.y) + w1 * bf_lo(b2.y) + w2 * bf_lo(c.y), w0 * bf_hi(a.y) + w1 * bf_hi(b2.y) + w2 * bf_hi(c.y));
            o.z = cvt_pk_bf16(w0 * bf_lo(a.z) + w1 * bf_lo(b2.z) + w2 * bf_lo(c.z), w0 * bf_hi(a.z) + w1 * bf_hi(b2.z) + w2 * bf_hi(c.z));
            o.w = cvt_pk_bf16(w0 * bf_lo(a.w) + w1 * bf_lo(b2.w) + w2 * bf_lo(c.w), w0 * bf_hi(a.w) + w1 * bf_hi(b2.w) + w2 * bf_hi(c.w));
            *(v4u*)(OAM + (size_t)m * 512 + hd * 64 + c8) = o;
        }
        {
            const int c0 = lane * 16;
            const v4u u0 = *(const v4u*)(OB + (size_t)m * 1024 + c0), u1 = *(const v4u*)(OB + (size_t)m * 1024 + c0 + 8);
            const v4u r0 = *(const v4u*)(RB + (size_t)m * 1024 + c0), r1 = *(const v4u*)(RB + (size_t)m * 1024 + c0 + 8);
            float x[16] = {bf_lo(u0.x), bf_hi(u0.x), bf_lo(u0.y), bf_hi(u0.y), bf_lo(u0.z), bf_hi(u0.z), bf_lo(u0.w), bf_hi(u0.w), bf_lo(u1.x), bf_hi(u1.x), bf_lo(u1.y), bf_hi(u1.y), bf_lo(u1.z), bf_hi(u1.z), bf_lo(u1.w), bf_hi(u1.w)};
            float rr[16] = {bf_lo(r0.x), bf_hi(r0.x), bf_lo(r0.y), bf_hi(r0.y), bf_lo(r0.z), bf_hi(r0.z), bf_lo(r0.w), bf_hi(r0.w), bf_lo(r1.x), bf_hi(r1.x), bf_lo(r1.y), bf_hi(r1.y), bf_lo(r1.z), bf_hi(r1.z), bf_lo(r1.w), bf_hi(r1.w)};
            float ss = 0.f;
#pragma unroll
            for (int i = 0; i < 16; ++i) ss += x[i] * x[i];
            ss += __shfl_xor(ss, 1); ss += __shfl_xor(ss, 2); ss += __shfl_xor(ss, 4); ss += __shfl_xor(ss, 8);
            const float rs = 1.0f / sqrtf(ss * (1.0f / 256.0f) + LN_EPS);
            float y[16];
#pragma unroll
            for (int i = 0; i < 16; ++i) { const float gte = rr[i] / (1.0f + __expf(-rr[i])); y[i] = x[i] * rs * gn[c0 + i] * gte; }
            v4u o0, o1; o0.x = cvt_pk_bf16(y[0], y[1]); o0.y = cvt_pk_bf16(y[2], y[3]); o0.z = cvt_pk_bf16(y[4], y[5]); o0.w = cvt_pk_bf16(y[6], y[7]);
            o1.x = cvt_pk_bf16(y[8], y[9]); o1.y = cvt_pk_bf16(y[10], y[11]); o1.z = cvt_pk_bf16(y[12], y[13]); o1.w = cvt_pk_bf16(y[14], y[15]);
            *(v4u*)(OBN + (size_t)m * 1024 + c0) = o0; *(v4u*)(OBN + (size_t)m * 1024 + c0 + 8) = o1;
        }
    }
    const bf16* KA = WSP(bf16, WS_KA); const bf16* VA = WSP(bf16, WS_VA);
    p3_kvout(KA, VA, F.out + OUT_KVP1, 0, 128, 8, 0, TSEQ, TSEQ - 128, 0, 128, gt, ngt);
    p3_kvout(KA, VA, F.out + OUT_KVP2, 1, 512, 8, 0, TSEQ, TSEQ - 512, 0, 512, gt, ngt);
    p3_kvout(KA, VA, F.out + OUT_KVP3, 2, 2048, 8, 0, TSEQ, TSEQ - 2048, 0, 2048, gt, ngt);
    p3_kvout(KA, VA, F.out + OUT_KVS1, 0, 4, 32, NP, 4, 0, 124, 128, gt, ngt);
    p3_kvout(KA, VA, F.out + OUT_KVS2, 1, 4, 32, NP, 4, 0, 508, 512, gt, ngt);
    p3_kvout(KA, VA, F.out + OUT_KVS3, 2, 4, 32, NP, 4, 0, 2044, 2048, gt, ngt);
}

__device__ __forceinline__ void p6_ln1(Frame& F) {
    const int gw = blockIdx.x * NWAVES + F.wave, NGW = F.G * NWAVES, lane = F.lane;
    float* H = WSP(float, WS_H); bf16* X1B = WSP(bf16, WS_X1B); const float* l1g = inptr(F, I_L1G); const float* l1b = inptr(F, I_L1B);
    for (int m = gw; m < MPAD; m += NGW) {
        f32x4* hr = (f32x4*)(H + (size_t)m * 1024) + lane;
        f32x4 v[4]; float s = 0.f;
#pragma unroll
        for (int j = 0; j < 4; ++j) { v[j] = hr[64 * j]; s += (v[j][0] + v[j][1]) + (v[j][2] + v[j][3]); }
        const float mean = wave_sum(s) * (1.f / 1024.f); float s2 = 0.f;
#pragma unroll
        for (int j = 0; j < 4; ++j) { v[j] = v[j] - mean; s2 += (v[j][0] * v[j][0] + v[j][1] * v[j][1]) + (v[j][2] * v[j][2] + v[j][3] * v[j][3]); }
        const float rstd = 1.f / sqrtf(wave_sum(s2) * (1.f / 1024.f) + LN_EPS);
        unsigned long long* o8 = (unsigned long long*)(X1B + (size_t)m * 1024) + lane;
#pragma unroll
        for (int j = 0; j < 4; ++j) { const f32x4 gg = ((const f32x4*)l1g)[lane + 64 * j], bb = ((const f32x4*)l1b)[lane + 64 * j];
            const f32x4 y = v[j] * rstd * gg + bb; hr[64 * j] = y;
            o8[64 * j] = (unsigned long long)cvt_pk_bf16(y[0], y[1]) | ((unsigned long long)cvt_pk_bf16(y[2], y[3]) << 32); }
    }
}

__device__ __forceinline__ unsigned mono_key(float f) { const unsigned u = __float_as_uint(f); return u ^ ((unsigned)((int)u >> 31) | 0x80000000u); }
__device__ __forceinline__ float mono_inv(unsigned k) { return __uint_as_float((k & 0x80000000u) ? (k ^ 0x80000000u) : ~k); }
#define CE_DESC(a, b) do { const unsigned _mx = (a) > (b) ? (a) : (b), _mn = (a) > (b) ? (b) : (a); (a) = _mx; (b) = _mn; } while (0)
__device__ __forceinline__ void ins16(unsigned (&T)[16], unsigned x) {
#pragma unroll
    for (int k = 0; k < 16; ++k) CE_DESC(T[k], x);
}
__device__ __forceinline__ void merge_partner16(unsigned (&T)[16]) {
    unsigned P[16];
#pragma unroll
    for (int k = 0; k < 16; ++k) P[k] = (unsigned)__shfl_xor((int)T[k], 32);
#pragma unroll
    for (int k = 0; k < 16; ++k) T[k] = T[k] > P[15 - k] ? T[k] : P[15 - k];
#pragma unroll
    for (int st = 8; st >= 1; st >>= 1)
#pragma unroll
        for (int k = 0; k < 16; ++k) if ((k & st) == 0) CE_DESC(T[k], T[k + st]);
}
__device__ __forceinline__ void p8_topk_item(Frame& F, int item) {
    const int lane = F.lane, hh = lane >> 5, il = lane & 31;
    const int tb = item >> 3, hd = item & 7; const int row = 32 * tb + il;
    const bf16* QN = WSP(bf16, WS_QN); const bf16* KEYS = WSP(bf16, WS_KEYS); int* EIDX = WSP(int, WS_EIDX); float* GATE = WSP(float, WS_GATE);
    LAS unsigned* LK = (LAS unsigned*)(F.lds + F.wave * 8192);
    unsigned T1[16], T2[16];
#pragma unroll
    for (int half = 0; half < 2; ++half) {
        bf16x8 bq[8];
#pragma unroll
        for (int s = 0; s < 8; ++s) bq[s] = *(const bf16x8*)(QN + (size_t)row * 2048 + hd * 256 + half * 128 + 16 * s + 8 * hh);
        unsigned T[16];
#pragma unroll
        for (int k = 0; k < 16; ++k) T[k] = 0u;
#pragma unroll 1
        for (int kt = 0; kt < 4; ++kt) {
            f32x16 acc;
#pragma unroll
            for (int x = 0; x < 16; ++x) acc[x] = 0.f;
#pragma unroll
            for (int s = 0; s < 8; ++s) { const bf16x8 kf = *(const bf16x8*)(KEYS + ((size_t)(hd * 2 + half) * 128 + 32 * kt + il) * 128 + 16 * s + 8 * hh); acc = MFMA32(kf, bq[s], acc); }
#pragma unroll
            for (int x = 0; x < 16; ++x) { const int idx = 32 * kt + crow(x, hh); ins16(T, (mono_key(acc[x]) & ~127u) | (unsigned)(127 - idx)); }
        }
        merge_partner16(T);
#pragma unroll
        for (int k = 0; k < 16; ++k) { LK[(half * 16 + k) * 64 + lane] = T[k]; if (half == 0) T1[k] = T[k]; else T2[k] = T[k]; }
    }
    float v1[16], v2[16];
#pragma unroll
    for (int k = 0; k < 16; ++k) { v1[k] = mono_inv(T1[k] & ~127u); v2[k] = mono_inv(T2[k] & ~127u); }
    unsigned C[16];
#pragma unroll
    for (int k = 0; k < 16; ++k) C[k] = 0u;
#pragma unroll
    for (int a = 0; a < 16; ++a)
#pragma unroll
        for (int c = 0; c < 16; ++c) if ((a + 1) * (c + 1) <= 16) ins16(C, (mono_key(v1[a] + v2[c]) & ~255u) | (unsigned)(255 - (16 * a + c)));
    LDS_WAIT(); asm volatile("" ::: "memory");
    float sv[16]; int ex[16]; float mx = NEG_BIG;
#pragma unroll
    for (int k = 0; k < 16; ++k) { const int si = 255 - (int)(C[k] & 255u), a = si >> 4, c = si & 15;
        const unsigned k1 = LK[a * 64 + lane], k2 = LK[(16 + c) * 64 + lane];
        ex[k] = (127 - (int)(k1 & 127u)) * 128 + (127 - (int)(k2 & 127u)); sv[k] = mono_inv(k1 & ~127u) + mono_inv(k2 & ~127u); mx = fmaxf(mx, sv[k]); }
    float den = 0.f;
#pragma unroll
    for (int k = 0; k < 16; ++k) { sv[k] = __expf(sv[k] - mx); den += sv[k]; }
    const float iden = 1.0f / den;
    if (hh == 0 && row < NTOK) {
#pragma unroll
        for (int k4 = 0; k4 < 4; ++k4) { *(int4*)(EIDX + (size_t)row * 128 + hd * 16 + 4 * k4) = make_int4(ex[4 * k4], ex[4 * k4 + 1], ex[4 * k4 + 2], ex[4 * k4 + 3]);
            *(f32x4*)(GATE + (size_t)row * 128 + hd * 16 + 4 * k4) = (f32x4){sv[4 * k4] * iden, sv[4 * k4 + 1] * iden, sv[4 * k4 + 2] * iden, sv[4 * k4 + 3] * iden}; } }
    LDS_WAIT(); asm volatile("" ::: "memory");
}

__device__ __forceinline__ float gelu_erf(float x) { return 0.5f * x * (1.0f + erff(x * 0.70710678118654752f)); }
__device__ __forceinline__ void p9_token(Frame& F, int m, const float* l2g, const float* l2b) {
    const int lane = F.lane;
    const float* X1 = WSP(float, WS_H); const int* EIDX = WSP(int, WS_EIDX); const float* GATE = WSP(float, WS_GATE); const bf16* UT = WSP(bf16, WS_UT); const bf16* VT = WSP(bf16, WS_VT);
    float x[16];
    { const f32x4 a = *(const f32x4*)(X1 + (size_t)m * 1024 + 8 * lane), b = *(const f32x4*)(X1 + (size_t)m * 1024 + 8 * lane + 4), c = *(const f32x4*)(X1 + (size_t)m * 1024 + 512 + 8 * lane), d = *(const f32x4*)(X1 + (size_t)m * 1024 + 512 + 8 * lane + 4);
      x[0] = a[0]; x[1] = a[1]; x[2] = a[2]; x[3] = a[3]; x[4] = b[0]; x[5] = b[1]; x[6] = b[2]; x[7] = b[3]; x[8] = c[0]; x[9] = c[1]; x[10] = c[2]; x[11] = c[3]; x[12] = d[0]; x[13] = d[1]; x[14] = d[2]; x[15] = d[3]; }
    float acc[16];
#pragma unroll
    for (int i = 0; i < 16; ++i) acc[i] = 0.f;
    for (int hd = 0; hd < 8; ++hd) {
        const int ev = EIDX[(size_t)m * 128 + hd * 16 + (lane & 15)];
        const float gv = GATE[(size_t)m * 128 + hd * 16 + (lane >> 2)];
        float part[16];
#pragma unroll
        for (int k = 0; k < 16; ++k) { const int e = __builtin_amdgcn_readlane(ev, k);
            const v4u u0 = *(const v4u*)(UT + (size_t)e * 1024 + 8 * lane), u1 = *(const v4u*)(UT + (size_t)e * 1024 + 512 + 8 * lane);
            part[k] = x[0] * bf_lo(u0.x) + x[1] * bf_hi(u0.x) + x[2] * bf_lo(u0.y) + x[3] * bf_hi(u0.y) + x[4] * bf_lo(u0.z) + x[5] * bf_hi(u0.z) + x[6] * bf_lo(u0.w) + x[7] * bf_hi(u0.w)
                    + x[8] * bf_lo(u1.x) + x[9] * bf_hi(u1.x) + x[10] * bf_lo(u1.y) + x[11] * bf_hi(u1.y) + x[12] * bf_lo(u1.z) + x[13] * bf_hi(u1.z) + x[14] * bf_lo(u1.w) + x[15] * bf_hi(u1.w); }
        float p8[8], p4[4], p2[2], p1;
        { const bool up = (lane & 32) != 0;
#pragma unroll
          for (int k = 0; k < 8; ++k) { const float send = up ? part[k] : part[k + 8], keep = up ? part[k + 8] : part[k]; p8[k] = keep + __shfl_xor(send, 32); } }
        { const bool up = (lane & 16) != 0;
#pragma unroll
          for (int k = 0; k < 4; ++k) { const float send = up ? p8[k] : p8[k + 4], keep = up ? p8[k + 4] : p8[k]; p4[k] = keep + __shfl_xor(send, 16); } }
        { const bool up = (lane & 8) != 0;
#pragma unroll
          for (int k = 0; k < 2; ++k) { const float send = up ? p4[k] : p4[k + 2], keep = up ? p4[k + 2] : p4[k]; p2[k] = keep + __shfl_xor(send, 8); } }
        { const bool up = (lane & 4) != 0; const float send = up ? p2[0] : p2[1], keep = up ? p2[1] : p2[0]; p1 = keep + __shfl_xor(send, 4); }
        p1 += __shfl_xor(p1, 2); p1 += __shfl_xor(p1, 1);
        const float coefv = gv * gelu_erf(p1);
#pragma unroll
        for (int k = 0; k < 16; ++k) { const int e = __builtin_amdgcn_readlane(ev, k); const float cf = __uint_as_float((unsigned)__builtin_amdgcn_readlane((int)__float_as_uint(coefv), 4 * k));
            const v4u u0 = *(const v4u*)(VT + (size_t)e * 1024 + 8 * lane), u1 = *(const v4u*)(VT + (size_t)e * 1024 + 512 + 8 * lane);
            acc[0] += cf * bf_lo(u0.x); acc[1] += cf * bf_hi(u0.x); acc[2] += cf * bf_lo(u0.y); acc[3] += cf * bf_hi(u0.y); acc[4] += cf * bf_lo(u0.z); acc[5] += cf * bf_hi(u0.z); acc[6] += cf * bf_lo(u0.w); acc[7] += cf * bf_hi(u0.w);
            acc[8] += cf * bf_lo(u1.x); acc[9] += cf * bf_hi(u1.x); acc[10] += cf * bf_lo(u1.y); acc[11] += cf * bf_hi(u1.y); acc[12] += cf * bf_lo(u1.z); acc[13] += cf * bf_hi(u1.z); acc[14] += cf * bf_lo(u1.w); acc[15] += cf * bf_hi(u1.w); }
    }
    float s = 0.f;
#pragma unroll
    for (int i = 0; i < 16; ++i) { acc[i] += ALPHA * x[i]; s += acc[i]; }
    const float mean = wave_sum(s) * (1.f / 1024.f); float s2 = 0.f;
#pragma unroll
    for (int i = 0; i < 16; ++i) { acc[i] -= mean; s2 += acc[i] * acc[i]; }
    const float rstd = 1.f / sqrtf(wave_sum(s2) * (1.f / 1024.f) + LN_EPS);
    float* yo = m < NP ? F.out + OUT_YP + (size_t)m * 1024 : F.out + OUT_YS + (size_t)(m - NP) * 1024;
#pragma unroll
    for (int q4 = 0; q4 < 4; ++q4) { const int c = (q4 >> 1) * 512 + 8 * lane + (q4 & 1) * 4; const f32x4 gg = *(const f32x4*)(l2g + c), bb = *(const f32x4*)(l2b + c);
        *(f32x4*)(yo + c) = (f32x4){acc[4 * q4] * rstd * gg[0] + bb[0], acc[4 * q4 + 1] * rstd * gg[1] + bb[1], acc[4 * q4 + 2] * rstd * gg[2] + bb[2], acc[4 * q4 + 3] * rstd * gg[3] + bb[3]}; }
}

struct Args { const float* in[22]; float* out; unsigned char* ws; int ph_lo, ph_hi; };
constexpr int NPHASE = 10;
__global__ void __launch_bounds__(NTHR, 2) mk_fwd(Args args) {
    extern __shared__ __attribute__((aligned(16))) unsigned char lds[];
    Frame F;
    F.lds = (LAS unsigned char*)lds; F.MISC = (volatile LAS unsigned*)(F.lds + MISC_OFF);
    F.tid = threadIdx.x; F.lane = F.tid & 63; F.wave = __builtin_amdgcn_readfirstlane(F.tid >> 6); F.G = gridDim.x;
    F.ws = args.ws; F.out = args.out; F.ctl = (gu32*)(args.ws + WS_CTL);
    for (int u = F.tid; u < (LDS_BYTES - MISC_OFF) / 4; u += NTHR) ((LAS unsigned*)(F.lds + MISC_OFF))[u] = 0u;
    __syncthreads();
    if (F.tid < 22) ((LAS unsigned long long*)(F.lds + PTR_OFF))[F.tid] = (unsigned long long)args.in[F.tid];
    __syncthreads();
    const int lo = args.ph_lo, hi = args.ph_hi;
    const bool multi = (hi - lo) > 1;
    XcdBarrier bar; bar.bar = (unsigned*)(F.ctl + CW_BAR); bar.x = 0; bar.st = nullptr;
    if (multi) bar = xcd_barrier_post((unsigned*)(F.ctl + CW_BAR), F.MISC + 8);
#ifdef ONLY_PHASE
#define IN(k) ((k) == ONLY_PHASE && lo <= (k) && (k) < hi)
#else
#define IN(k) (lo <= (k) && (k) < hi)
#endif
#define SEAM(k) do { if (IN(k) && IN((k) + 1)) xcd_barrier(bar); } while (0)
    if (IN(0)) { p0_prologue(F); } SEAM(0);
    if (IN(1)) {
        pg8::Gemm g{WSP(bf16, WS_XB), WSP(bf16, WS_WIN), MPAD, NPROJ, 1024}; pg8::StaticOrder S; S.init(MPAD, NPROJ, F.G, (int)blockIdx.x);
        pg8::EpiProj E{WSP(bf16, WS_QA), WSP(bf16, WS_KA), WSP(bf16, WS_VA), WSP(bf16, WS_QB), WSP(bf16, WS_KB), WSP(bf16, WS_VB), WSP(bf16, WS_RB), WSP(bf16, WS_GA), WSP(bf16, WS_GB)};
        pg8::gemm_phase<pg8::EpiProj, pg8::StaticOrder, true, true>(F.lds, g, S, E);
    } SEAM(1);
    if (IN(2)) { p2_mixers(F); } SEAM(2);
    if (IN(3)) { p3_merge(F); } SEAM(3);
    if (IN(4)) {
        { pg8::Gemm g{WSP(bf16, WS_OAM), WSP(bf16, WS_WA), MPAD, 1024, 512}; pg8::StaticOrder S; S.init(MPAD, 1024, F.G, (int)blockIdx.x);
          pg8::EpiGate<false> E{WSP(bf16, WS_GA), nullptr, WSP(bf16, WS_T1)};
          pg8::gemm_phase<pg8::EpiGate<false>, pg8::StaticOrder, true, true>(F.lds, g, S, E); }
        VM_WAIT(); __syncthreads();
        { pg8::Gemm g{WSP(bf16, WS_OBN), WSP(bf16, WS_WB), MPAD, 1024, 1024}; pg8::StaticOrder S; S.init(MPAD, 1024, F.G, (int)blockIdx.x);
          pg8::EpiGate<true> E{WSP(bf16, WS_GB), WSP(bf16, WS_T1), WSP(bf16, WS_MIX)};
          pg8::gemm_phase<pg8::EpiGate<true>, pg8::StaticOrder, true, true>(F.lds, g, S, E); }
    } SEAM(4);
    if (IN(5)) {
        pg8::Gemm g{WSP(bf16, WS_MIX), WSP(bf16, WS_WO), MPAD, 1024, 1024}; pg8::StaticOrder S; S.init(MPAD, 1024, F.G, (int)blockIdx.x);
        pg8::EpiOut E{inptr(F, I_XP), inptr(F, I_XS), WSP(float, WS_H), NP, NTOK, ALPHA};
        pg8::gemm_phase<pg8::EpiOut, pg8::StaticOrder, true, true>(F.lds, g, S, E);
    } SEAM(5);
    if (IN(6)) { p6_ln1(F); } SEAM(6);
    if (IN(7)) {
        pg8::Gemm g{WSP(bf16, WS_X1B), WSP(bf16, WS_WQ), MPAD, 2048, 1024}; pg8::StaticOrder S; S.init(MPAD, 2048, F.G, (int)blockIdx.x);
        pg8::EpiHeadNorm E{WSP(bf16, WS_QN), 2048, F.lds + STATS_OFF, LN_EPS};
        pg8::gemm_phase<pg8::EpiHeadNorm, pg8::StaticOrder, true, true>(F.lds, g, S, E);
    } SEAM(7);
    if (IN(8)) { const int gw = blockIdx.x * NWAVES + F.wave, NGW = F.G * NWAVES; for (int it = gw; it < (MPAD / 32) * 8; it += NGW) p8_topk_item(F, it); } SEAM(8);
    if (IN(9)) { const int gw = blockIdx.x * NWAVES + F.wave, NGW = F.G * NWAVES; const float* l2g = inptr(F, I_L2G); const float* l2b = inptr(F, I_L2B); for (int m = gw; m < NTOK; m += NGW) p9_token(F, m, l2g, l2b); }
#undef IN
#undef SEAM
}

extern "C" void kernel_launch(void* const* d_in, const int* in_sizes, int n_in, void* d_out, int out_size, void* d_ws, size_t ws_size, hipStream_t stream) {
    static int grid = 0;
    if (grid == 0) {
        if (n_in != 22 || (size_t)out_size != OUT_TOTAL || ws_size < WS_END) { fprintf(stderr, "kernel_launch: unexpected shapes: n_in %d out %d ws %zu (need >= %zu)\n", n_in, out_size, ws_size, (size_t)WS_END); grid = -1; return; }
        int dev = 0, cus = 0, per_cu = 0;
        if (hipGetDevice(&dev) != hipSuccess || hipDeviceGetAttribute(&cus, hipDeviceAttributeMultiprocessorCount, dev) != hipSuccess) { grid = -1; return; }
        if (hipFuncSetAttribute((const void*)mk_fwd, hipFuncAttributeMaxDynamicSharedMemorySize, LDS_BYTES) != hipSuccess) { fprintf(stderr, "kernel_launch: hipFuncSetAttribute failed\n"); grid = -1; return; }
        if (hipOccupancyMaxActiveBlocksPerMultiprocessor(&per_cu, (const void*)mk_fwd, NTHR, LDS_BYTES) != hipSuccess || per_cu < 1) fprintf(stderr, "kernel_launch: occupancy query reports %d blocks per CU\n", per_cu);
        (void)hipGetLastError();
        grid = cus;
    }
    if (grid < 0) return;
    (void)hipMemsetAsync((char*)d_ws + WS_CTL, 0, CTL_ZERO_BYTES, stream);
    Args a{};
    for (int i = 0; i < 22; ++i) a.in[i] = (const float*)d_in[i];
    a.out = (float*)d_out; a.ws = (unsigned char*)d_ws;
#if MK_SINGLE
    a.ph_lo = 0; a.ph_hi = NPHASE;
    void* kargs[] = {&a};
    hipError_t e = hipLaunchCooperativeKernel((const void*)mk_fwd, dim3(grid), dim3(NTHR), kargs, LDS_BYTES, stream);
    if (e != hipSuccess) fprintf(stderr, "kernel_launch: cooperative launch failed: %s\n", hipGetErrorString(e));
#else
    for (int p = 0; p < NPHASE; ++p) { a.ph_lo = p; a.ph_hi = p + 1; hipLaunchKernelGGL(mk_fwd, dim3(grid), dim3(NTHR), LDS_BYTES, stream, a); }
#endif
}
```

```cpp
#include <hip/hip_runtime.h>
#include <hip/hip_cooperative_groups.h>
#include <cstdio>
#include <cstdint>
#ifndef MK_SINGLE
#define MK_SINGLE 1
#endif
namespace pg8 {
#define PG8_LAS __attribute__((address_space(3)))
typedef unsigned short bf16_t;
typedef short bf16x8 __attribute__((ext_vector_type(8)));
typedef float f32x4 __attribute__((ext_vector_type(4)));
typedef unsigned u32x4 __attribute__((ext_vector_type(4)));
constexpr int BM = 256, BK = 64, HALF = 128, HTB = HALF * BK * 2  , STAGE_BYTES = 8 * HTB, NXCD = 8, WGM = 8;

__host__ __device__ __forceinline__ int lds_byte(int r, int c) { const int st = (r >> 4) * 2 + (c >> 5), rr = r & 15, cc = c & 31, ob = rr * 64 + cc * 2; return st * 1024 + (ob ^ (((ob >> 9) & 1) << 5)); }
__host__ __device__ __forceinline__ void stage_rc(int b, int& R, int& C) { const int st = b / 1024, sb = b % 1024, swz = sb ^ (((sb >> 9) & 1) << 5); R = (st >> 1) * 16 + swz / 64; C = (st & 1) * 32 + (swz % 64) / 2; }
__host__ __device__ __forceinline__ int perm32(int rho) { const int n = rho >> 4, i = rho & 15; return 8 * (i >> 2) + 4 * n + (i & 3); }

struct Unit { int pm, pn; };
struct Gemm { const bf16_t* A; const bf16_t* Bt; int M, N, K; };

struct StaticOrder {
    int nM, nN, nwg, G, c;
    __host__ __device__ void init(int M, int N, int G_, int c_) { nM = M / BM; nN = N / BM; nwg = nM * nN; G = G_; c = c_; }
    __host__ __device__ bool next(int i, Unit& u) const {
        const long L = (long)i * G + c; if (L >= nwg) return false;
        int wgid = (int)L; { const int q = nwg / NXCD, r = nwg % NXCD, xcd = wgid % NXCD, off = wgid / NXCD; wgid = (xcd < r ? xcd * (q + 1) : r * (q + 1) + (xcd - r) * q) + off; }
        const int nig = WGM * nN, gid = wgid / nig, fm = gid * WGM, gsz = (nM - fm) < WGM ? (nM - fm) : WGM;
        u.pm = fm + ((wgid % nig) % gsz); u.pn = (wgid % nig) / gsz; return true;
    }
    __device__ __forceinline__ void a_ready(const Unit&) const {}
    __device__ __forceinline__ void done(const Unit&) const {}
};


typedef float f32x2 __attribute__((ext_vector_type(2)));
typedef __bf16 bf16x2_t __attribute__((ext_vector_type(2)));
__device__ __forceinline__ unsigned cvt_pk_bf16(float lo, float hi) { f32x2 v = {lo, hi}; bf16x2_t b = __builtin_convertvector(v, bf16x2_t); return __builtin_bit_cast(unsigned, b); }
__device__ __forceinline__ float bf_lo(unsigned w) { return __uint_as_float(w << 16); }
__device__ __forceinline__ float bf_hi(unsigned w) { return __uint_as_float(w & 0xffff0000u); }
__device__ __forceinline__ float sigmoidf_(float x) { return 1.0f / (1.0f + __expf(-x)); }

struct EpiProj {
    static constexpr bool PERM = true, AFTER_DRAIN = false;
    bf16_t *qa, *ka, *va, *qb, *kb, *vb, *rb, *ga, *gb;
    __device__ __forceinline__ void operator()(const f32x4 (&acc)[2][2][4][2], const Unit& u, int wr, int wc, int fr, int fq) const {
        const int pn = u.pn; bf16_t* base; int ldc, ct; float sc = 1.f;
        if (pn < 6) { base = qa; ldc = 1536; ct = pn; sc = 0.125f; }
        else if (pn < 12) { base = ka; ldc = 1536; ct = pn - 6; }
        else if (pn < 18) { base = va; ldc = 1536; ct = pn - 12; }
        else if (pn < 20) { base = qb; ldc = 512; ct = pn - 18; }
        else if (pn < 22) { base = kb; ldc = 512; ct = pn - 20; }
        else if (pn < 26) { base = vb; ldc = 1024; ct = pn - 22; }
        else if (pn < 30) { base = rb; ldc = 1024; ct = pn - 26; }
        else if (pn < 34) { base = ga; ldc = 1024; ct = pn - 30; }
        else { base = gb; ldc = 1024; ct = pn - 34; }
        const int row0 = u.pm * BM + wr * 64 + fr, col0 = ct * BM + wc * 32 + 8 * fq;
#pragma unroll
        for (int ai = 0; ai < 2; ++ai)
#pragma unroll
            for (int m = 0; m < 4; ++m) { bf16_t* rowp = base + (size_t)(row0 + ai * HALF + m * 16) * ldc + col0;
#pragma unroll
                for (int bj = 0; bj < 2; ++bj) { const f32x4 v0 = acc[ai][bj][m][0] * sc, v1 = acc[ai][bj][m][1] * sc;
                    u32x4 w; w.x = cvt_pk_bf16(v0[0], v0[1]); w.y = cvt_pk_bf16(v0[2], v0[3]); w.z = cvt_pk_bf16(v1[0], v1[1]); w.w = cvt_pk_bf16(v1[2], v1[3]);
                    *(u32x4*)(rowp + bj * HALF) = w; } }
    }
};
template <bool ADD> struct EpiGate {
    static constexpr bool PERM = true, AFTER_DRAIN = false;
    const bf16_t* G; const bf16_t* T1; bf16_t* O;
    __device__ __forceinline__ void operator()(const f32x4 (&acc)[2][2][4][2], const Unit& u, int wr, int wc, int fr, int fq) const {
        const int row0 = u.pm * BM + wr * 64 + fr, col0 = u.pn * BM + wc * 32 + 8 * fq;
#pragma unroll
        for (int ai = 0; ai < 2; ++ai)
#pragma unroll
            for (int m = 0; m < 4; ++m) { const size_t off = (size_t)(row0 + ai * HALF + m * 16) * 1024 + col0;
#pragma unroll
                for (int bj = 0; bj < 2; ++bj) {
                    const u32x4 g = *(const u32x4*)(G + off + bj * HALF);
                    f32x4 v0 = acc[ai][bj][m][0], v1 = acc[ai][bj][m][1];
                    v0[0] *= sigmoidf_(bf_lo(g.x)); v0[1] *= sigmoidf_(bf_hi(g.x)); v0[2] *= sigmoidf_(bf_lo(g.y)); v0[3] *= sigmoidf_(bf_hi(g.y));
                    v1[0] *= sigmoidf_(bf_lo(g.z)); v1[1] *= sigmoidf_(bf_hi(g.z)); v1[2] *= sigmoidf_(bf_lo(g.w)); v1[3] *= sigmoidf_(bf_hi(g.w));
                    if (ADD) { const u32x4 t = *(const u32x4*)(T1 + off + bj * HALF);
                        v0[0] += bf_lo(t.x); v0[1] += bf_hi(t.x); v0[2] += bf_lo(t.y); v0[3] += bf_hi(t.y);
                        v1[0] += bf_lo(t.z); v1[1] += bf_hi(t.z); v1[2] += bf_lo(t.w); v1[3] += bf_hi(t.w); }
                    u32x4 w; w.x = cvt_pk_bf16(v0[0], v0[1]); w.y = cvt_pk_bf16(v0[2], v0[3]); w.z = cvt_pk_bf16(v1[0], v1[1]); w.w = cvt_pk_bf16(v1[2], v1[3]);
                    *(u32x4*)(O + off + bj * HALF) = w; } }
    }
};
struct EpiOut {
    static constexpr bool PERM = false, AFTER_DRAIN = false;
    const float* xp; const float* xs; float* H; int np, ntok; float alpha;
    __device__ __forceinline__ void operator()(const f32x4 (&acc)[2][2][4][2], const Unit& u, int wr, int wc, int fr, int fq) const {
        const int row0 = u.pm * BM + wr * 64 + fr, col0 = u.pn * BM + wc * 32 + 4 * fq;
#pragma unroll
        for (int ai = 0; ai < 2; ++ai)
#pragma unroll
            for (int m = 0; m < 4; ++m) { const int r = row0 + ai * HALF + m * 16;
                const float* xr = r < np ? xp + (size_t)r * 1024 : xs + (size_t)(r < ntok ? r - np : 0) * 1024; const bool real = r < ntok;
#pragma unroll
                for (int bj = 0; bj < 2; ++bj)
#pragma unroll
                    for (int n = 0; n < 2; ++n) { const int c = col0 + bj * HALF + n * 16;
                        f32x4 xv = *(const f32x4*)(xr + c); if (!real) xv = (f32x4){0.f, 0.f, 0.f, 0.f};
                        *(f32x4*)(H + (size_t)r * 1024 + c) = xv * alpha + acc[ai][bj][m][n]; } }
    }
};
struct EpiHeadNorm {
    static constexpr bool PERM = true, AFTER_DRAIN = false;
    bf16_t* O; int ldc; PG8_LAS unsigned char* st; float eps;
    __device__ __forceinline__ void operator()(const f32x4 (&acc)[2][2][4][2], const Unit& u, int wr, int wc, int fr, int fq) const {
        PG8_LAS f32x2* P = (PG8_LAS f32x2*)st; PG8_LAS f32x2* S = (PG8_LAS f32x2*)(st + 8192);
        const int lane = fq * 16 + fr, wid = wr * 4 + wc;
#pragma unroll
        for (int ai = 0; ai < 2; ++ai)
#pragma unroll
            for (int m = 0; m < 4; ++m) {
                float s = 0.f;
#pragma unroll
                for (int bj = 0; bj < 2; ++bj)
#pragma unroll
                    for (int n = 0; n < 2; ++n) { const f32x4 x = acc[ai][bj][m][n]; s += (x[0] + x[1]) + (x[2] + x[3]); }
                s += __shfl_xor(s, 16); s += __shfl_xor(s, 32);
                const float mw = s * (1.0f / 64.0f); float q = 0.f;
#pragma unroll
                for (int bj = 0; bj < 2; ++bj)
#pragma unroll
                    for (int n = 0; n < 2; ++n) { const f32x4 d = acc[ai][bj][m][n] - mw; q += (d[0] * d[0] + d[1] * d[1]) + (d[2] * d[2] + d[3] * d[3]); }
                q += __shfl_xor(q, 16); q += __shfl_xor(q, 32);
                if (fq == 0) P[(ai * HALF + wr * 64 + m * 16 + fr) * 4 + wc] = (f32x2){mw, q};
            }
        asm volatile("s_waitcnt lgkmcnt(0)" ::: "memory"); __builtin_amdgcn_s_barrier(); asm volatile("" ::: "memory");
        const int row = wid * 32 + (lane & 31);
        if (lane < 32) {
            const f32x2 a = P[row * 4 + 0], b = P[row * 4 + 1], c = P[row * 4 + 2], d = P[row * 4 + 3];
            const float mt = (a.x + b.x + c.x + d.x) * 0.25f;
            const float da = a.x - mt, db = b.x - mt, dc = c.x - mt, dd = d.x - mt;
            const float m2 = (a.y + b.y) + (c.y + d.y) + 64.0f * ((da * da + db * db) + (dc * dc + dd * dd));
            S[row] = (f32x2){mt, 1.0f / sqrtf(m2 * (1.0f / 256.0f) + eps)};
        }
        asm volatile("s_waitcnt lgkmcnt(0)" ::: "memory"); __builtin_amdgcn_s_barrier(); asm volatile("" ::: "memory");
        const int row0 = u.pm * BM + wr * 64 + fr, col0 = u.pn * BM + wc * 32 + 8 * fq;
#pragma unroll
        for (int ai = 0; ai < 2; ++ai)
#pragma unroll
            for (int m = 0; m < 4; ++m) { const f32x2 sr = S[ai * HALF + wr * 64 + m * 16 + fr]; bf16_t* rowp = O + (size_t)(row0 + ai * HALF + m * 16) * ldc + col0;
#pragma unroll
                for (int bj = 0; bj < 2; ++bj) { const f32x4 v0 = (acc[ai][bj][m][0] - sr.x) * sr.y, v1 = (acc[ai][bj][m][1] - sr.x) * sr.y;
                    u32x4 w; w.x = cvt_pk_bf16(v0[0], v0[1]); w.y = cvt_pk_bf16(v0[2], v0[3]); w.z = cvt_pk_bf16(v1[0], v1[1]); w.w = cvt_pk_bf16(v1[2], v1[3]);
                    *(u32x4*)(rowp + bj * HALF) = w; } }
    }
};

template <class Epi, class Sched, bool ALIGN_EPI = false, bool SP2 = false>
__device__ __forceinline__ void gemm_phase(PG8_LAS unsigned char* lds, const Gemm g, const Sched& S, const Epi& E) {
    const int tid = threadIdx.x, wid = __builtin_amdgcn_readfirstlane(tid >> 6), lane = tid & 63, wr = wid >> 2, wc = wid & 3, fr = lane & 15, fq = lane >> 4;
    const int K = g.K, nt = K / BK;
    unsigned voffA[2], voffB[2];
#pragma unroll
    for (int i = 0; i < 2; ++i) { int R, C; stage_rc(tid * 16 + i * 8192, R, C); const int Rb = Epi::PERM ? ((R & ~31) + perm32(R & 31)) : R;
        voffA[i] = (unsigned)(R * K + C) * 2u; voffB[i] = (unsigned)(Rb * K + C) * 2u; }
    const size_t kstep = (size_t)(BK * 2);
    const size_t hstep = (size_t)HALF * K * 2;
    const size_t tstep = 2 * hstep;
    const unsigned ldsw = (unsigned)wid * 1024u;
    const int aoff = lds_byte(wr * 64 + fr, fq * 8), boff = lds_byte(wc * 32 + fr, fq * 8);
#define PG8_SA(b, h) (((b) * 2 + (h)) * HTB)
#define PG8_SB(b, h) ((4 + (b) * 2 + (h)) * HTB)
#define PG8_STAGE(bufoff, gbase, voff) do { _Pragma("unroll") for (int _i = 0; _i < 2; ++_i) \
        __builtin_amdgcn_global_load_lds((const unsigned*)((const char*)(gbase) + (voff)[_i]), (PG8_LAS unsigned*)(lds + (bufoff) + ldsw + _i * 8192), 16, 0, 0); } while (0)
#define PG8_LDA(dst, b, h) do { _Pragma("unroll") for (int m = 0; m < 4; ++m) _Pragma("unroll") for (int k = 0; k < 2; ++k) dst[m][k] = *(const PG8_LAS bf16x8*)(lds + PG8_SA(b, h) + aoff + m * 2048 + k * 1024); } while (0)
#define PG8_LDB(dst, b, h) do { _Pragma("unroll") for (int n = 0; n < 2; ++n) _Pragma("unroll") for (int k = 0; k < 2; ++k) dst[n][k] = *(const PG8_LAS bf16x8*)(lds + PG8_SB(b, h) + boff + n * 2048 + k * 1024); } while (0)
#define PG8_MMA(ai, bj, At, Bt) do { __builtin_amdgcn_s_setprio(1); _Pragma("unroll") for (int m = 0; m < 4; ++m) _Pragma("unroll") for (int n = 0; n < 2; ++n) _Pragma("unroll") for (int k = 0; k < 2; ++k) \
        acc[ai][bj][m][n] = __builtin_amdgcn_mfma_f32_16x16x32_bf16(Bt[n][k], At[m][k], acc[ai][bj][m][n], 0, 0, 0); __builtin_amdgcn_s_setprio(0); } while (0)
#define PG8_WAIT_V(n) asm volatile("s_waitcnt vmcnt(" #n ")" ::: "memory")
#define PG8_WAIT_L(n) asm volatile("s_waitcnt lgkmcnt(" #n ")" ::: "memory")
#define PG8_BAR __builtin_amdgcn_s_barrier()
#define PG8_SCHED __builtin_amdgcn_sched_barrier(0)
    Unit cur, nxt; int ui = 0;
    if (!S.next(0, cur)) return;
    f32x4 acc[2][2][4][2];
#pragma unroll
    for (int a = 0; a < 2; ++a)
#pragma unroll
        for (int b = 0; b < 2; ++b)
#pragma unroll
            for (int m = 0; m < 4; ++m)
#pragma unroll
                for (int n = 0; n < 2; ++n) acc[a][b][m][n] = (f32x4){0.f, 0.f, 0.f, 0.f};
    bf16x8 At[4][2], B0[2][2], B1[2][2];
    const char* cA = (const char*)g.A + (size_t)cur.pm * tstep; const char* cB = (const char*)g.Bt + (size_t)cur.pn * tstep;
    S.a_ready(cur);
    if constexpr (SP2) {
        PG8_STAGE(PG8_SB(0, 0), cB, voffB); PG8_STAGE(PG8_SB(0, 1), cB + hstep, voffB); PG8_STAGE(PG8_SA(0, 0), cA, voffA); PG8_STAGE(PG8_SA(0, 1), cA + hstep, voffA);
        if (wr == 1) PG8_BAR;
        PG8_WAIT_V(2); PG8_BAR;
        PG8_STAGE(PG8_SB(1, 0), cB + kstep, voffB); PG8_STAGE(PG8_SA(1, 0), cA + kstep, voffA); PG8_STAGE(PG8_SB(1, 1), cB + hstep + kstep, voffB);
        PG8_WAIT_V(6); PG8_BAR;
    } else {
        PG8_STAGE(PG8_SB(0, 0), cB, voffB); PG8_STAGE(PG8_SA(0, 0), cA, voffA); PG8_STAGE(PG8_SB(0, 1), cB + hstep, voffB); PG8_STAGE(PG8_SA(0, 1), cA + hstep, voffA);
        if (wr == 1) PG8_BAR;
        PG8_WAIT_V(4); PG8_BAR;
        PG8_STAGE(PG8_SB(1, 0), cB + kstep, voffB); PG8_STAGE(PG8_SA(1, 0), cA + kstep, voffA); PG8_STAGE(PG8_SB(1, 1), cB + hstep + kstep, voffB);
        PG8_WAIT_V(6); PG8_BAR;
    }
    for (;;) {
        const bool has_next = S.next(ui + 1, nxt);
        const char* nA = has_next ? (const char*)g.A + (size_t)nxt.pm * tstep : cA; const char* nB = has_next ? (const char*)g.Bt + (size_t)nxt.pn * tstep : cB;
        for (int t = 0; t < nt; t += 2) {
            const bool last = (t == nt - 2);
            const char* a1 = cA + (size_t)(t + 1) * kstep;
            const char* a2 = last ? nA : cA + (size_t)(t + 2) * kstep; const char* b2 = last ? nB : cB + (size_t)(t + 2) * kstep;
            const char* a3 = a2 + kstep; const char* b3 = b2 + kstep;
            if (last && has_next) S.a_ready(nxt);
            if constexpr (SP2) {
            PG8_LDB(B0, 0, 0); PG8_LDB(B1, 0, 1); PG8_SCHED; PG8_LDA(At, 0, 0); PG8_STAGE(PG8_SA(1, 1), a1 + hstep, voffA);
            PG8_WAIT_V(8); PG8_WAIT_L(0); PG8_BAR; PG8_MMA(0, 0, At, B0); PG8_MMA(0, 1, At, B1); PG8_BAR; PG8_SCHED;
            PG8_LDA(At, 0, 1); PG8_STAGE(PG8_SB(0, 0), b2, voffB); PG8_STAGE(PG8_SB(0, 1), b2 + hstep, voffB); PG8_STAGE(PG8_SA(0, 0), a2, voffA);
            PG8_WAIT_V(8); PG8_WAIT_L(0); PG8_BAR; PG8_MMA(1, 0, At, B0); PG8_MMA(1, 1, At, B1); PG8_BAR; PG8_SCHED;
            PG8_LDB(B0, 1, 0); PG8_LDB(B1, 1, 1); PG8_SCHED; PG8_LDA(At, 1, 0); PG8_STAGE(PG8_SA(0, 1), a2 + hstep, voffA);
            PG8_WAIT_V(8); PG8_WAIT_L(0); PG8_BAR; PG8_MMA(0, 0, At, B0); PG8_MMA(0, 1, At, B1); PG8_BAR; PG8_SCHED;
            PG8_LDA(At, 1, 1); PG8_STAGE(PG8_SB(1, 0), b3, voffB); PG8_STAGE(PG8_SB(1, 1), b3 + hstep, voffB); PG8_STAGE(PG8_SA(1, 0), a3, voffA);
            PG8_WAIT_V(8); PG8_WAIT_L(0); PG8_BAR; PG8_MMA(1, 0, At, B0); PG8_MMA(1, 1, At, B1); PG8_BAR; PG8_SCHED;
            } else {
            PG8_LDB(B0, 0, 0); PG8_SCHED; PG8_LDA(At, 0, 0); PG8_STAGE(PG8_SA(1, 1), a1 + hstep, voffA);
            PG8_WAIT_L(8); PG8_BAR; PG8_WAIT_L(0); PG8_MMA(0, 0, At, B0); PG8_BAR; PG8_SCHED;
            PG8_LDB(B1, 0, 1); PG8_STAGE(PG8_SB(0, 0), b2, voffB);
            PG8_BAR; PG8_WAIT_L(0); PG8_MMA(0, 1, At, B1); PG8_BAR;
            PG8_LDA(At, 0, 1); PG8_STAGE(PG8_SA(0, 0), a2, voffA);
            PG8_BAR; PG8_WAIT_L(0); PG8_MMA(1, 0, At, B0); PG8_BAR; PG8_SCHED;
            PG8_STAGE(PG8_SB(0, 1), b2 + hstep, voffB);
            PG8_WAIT_V(6); PG8_BAR; PG8_MMA(1, 1, At, B1); PG8_BAR;
            PG8_LDB(B0, 1, 0); PG8_SCHED; PG8_LDA(At, 1, 0); PG8_STAGE(PG8_SA(0, 1), a2 + hstep, voffA);
            PG8_WAIT_L(8); PG8_BAR; PG8_WAIT_L(0); PG8_MMA(0, 0, At, B0); PG8_BAR; PG8_SCHED;
            PG8_LDB(B1, 1, 1); PG8_STAGE(PG8_SB(1, 0), b3, voffB);
            PG8_BAR; PG8_WAIT_L(0); PG8_MMA(0, 1, At, B1); PG8_BAR;
            PG8_LDA(At, 1, 1); PG8_STAGE(PG8_SA(1, 0), a3, voffA);
            PG8_BAR; PG8_WAIT_L(0); PG8_MMA(1, 0, At, B0); PG8_BAR; PG8_SCHED;
            PG8_STAGE(PG8_SB(1, 1), b3 + hstep, voffB);
            PG8_WAIT_V(6); PG8_BAR; PG8_MMA(1, 1, At, B1); PG8_BAR;
            }
        }
        if constexpr (ALIGN_EPI) { if (wr == 0) PG8_BAR; }
        if constexpr (!Epi::AFTER_DRAIN) { E(acc, cur, wr, wc, fr, fq); S.done(cur); }
        if (!has_next) break;
#pragma unroll
        for (int a = 0; a < 2; ++a)
#pragma unroll
            for (int b = 0; b < 2; ++b)
#pragma unroll
                for (int m = 0; m < 4; ++m)
#pragma unroll
                    for (int n = 0; n < 2; ++n) acc[a][b][m][n] = (f32x4){0.f, 0.f, 0.f, 0.f};
        cur = nxt; cA = nA; cB = nB; ++ui;
        if constexpr (ALIGN_EPI) { if (wr == 1) PG8_BAR; }
    }
    PG8_WAIT_V(0);
    if constexpr (!ALIGN_EPI) { if (wr == 0) PG8_BAR; }
    PG8_BAR;
    if constexpr (Epi::AFTER_DRAIN) { E.fused(acc, cur, wr, wc, fr, fq, lds, wid, lane); S.done(cur); }
#undef PG8_SA
#undef PG8_SB
#undef PG8_STAGE
#undef PG8_LDA
#undef PG8_LDB
#undef PG8_MMA
#undef PG8_WAIT_V
#undef PG8_WAIT_L
#undef PG8_BAR
#undef PG8_SCHED
}
}

constexpr int NWAVES = 8, NTHR = 512;
constexpr int DM = 1024, TSEQ = 4096, NP = 32768, NS = 128, NTOK = NP + NS, MPAD = 33024;
constexpr int INW = 9744, NPROJ = 9728, ABCOL = 6656;
constexpr float LN_EPS = 1e-5f, ALPHA = 1.189207115002721f, GLA_QSCALE = 0.08838834764831845f, NEG_BIG = -1e30f;
constexpr size_t OUT_YP = 0, OUT_YS = 33554432, OUT_KVP1 = 33685504, OUT_KVP2 = 34734080, OUT_KVP3 = 38928384, OUT_STP = 55705600,
                 OUT_KVS1 = 56754176, OUT_KVS2 = 60948480, OUT_KVS3 = 77725696, OUT_STS = 144834560, OUT_TOTAL = 149028864;
constexpr size_t MiB = 1u << 20;
constexpr size_t WS_CTL = 0, CTL_ZERO_BYTES = 1 * MiB;
constexpr size_t WS_KEYS = 1 * MiB, WS_LUT = WS_KEYS + 512 * 1024;
constexpr size_t WS_WA = 2 * MiB, WS_WB = 3 * MiB, WS_WO = 5 * MiB, WS_WQ = 7 * MiB, WS_WIN = 11 * MiB;
constexpr size_t WS_AB = 31 * MiB, WS_UT = 34 * MiB, WS_VT = 66 * MiB, WS_XB = 98 * MiB;
constexpr size_t WS_QA = 163 * MiB, WS_KA = 260 * MiB, WS_VA = 357 * MiB, WS_QB = 454 * MiB, WS_KB = 487 * MiB, WS_VB = 520 * MiB;
constexpr size_t WS_RB = 585 * MiB, WS_GA = 650 * MiB, WS_GB = 715 * MiB, WS_LSE = 780 * MiB, WS_OAM = 784 * MiB, WS_OBN = 817 * MiB, WS_H = 882 * MiB, WS_END = 1011 * MiB;
constexpr size_t WS_T1 = WS_KA, WS_MIX = WS_VA, WS_X1B = WS_QA, WS_QN = WS_RB, WS_EIDX = WS_GB, WS_GATE = WS_GB + 17 * MiB;
static_assert(WS_WIN + (size_t)NPROJ * 1024 * 2 <= WS_AB && WS_AB + (size_t)MPAD * 16 * 4 <= WS_UT && WS_XB + (size_t)MPAD * 1024 * 2 <= WS_QA, "ws map 1");
static_assert(WS_QA + (size_t)MPAD * 1536 * 2 <= WS_KA && WS_QB + (size_t)MPAD * 512 * 2 <= WS_KB && WS_VB + (size_t)MPAD * 1024 * 2 <= WS_RB, "ws map 2");
static_assert(WS_LSE + (size_t)3 * MPAD * 8 * 4 <= WS_OAM && WS_OAM + (size_t)MPAD * 512 * 2 <= WS_OBN && WS_OBN + (size_t)MPAD * 1024 * 2 <= WS_H && WS_H + (size_t)MPAD * 1024 * 4 <= WS_END, "ws map 3");
static_assert(WS_QN + (size_t)MPAD * 2048 * 2 <= WS_GB && WS_EIDX + (size_t)MPAD * 128 * 4 <= WS_GATE && WS_GATE + (size_t)MPAD * 128 * 4 <= WS_LSE, "ws map 4");
constexpr int CW_QUEUE = 64;
constexpr int CW_BAR = 4096;
constexpr int RING_BYTES = 131072, STATS_OFF = RING_BYTES, MISC_OFF = STATS_OFF + 10240 + 320, LDS_BYTES = 147456;
static_assert(MISC_OFF + 128 + 22 * 8 <= LDS_BYTES, "LDS map");

#define GAS __attribute__((address_space(1)))
#define LAS __attribute__((address_space(3)))
typedef unsigned short bf16;
typedef unsigned v4u __attribute__((ext_vector_type(4)));
typedef unsigned v2u __attribute__((ext_vector_type(2)));
typedef float f32x4 __attribute__((ext_vector_type(4)));
typedef float f32x16 __attribute__((ext_vector_type(16)));
typedef short bf16x8 __attribute__((ext_vector_type(8)));
typedef short s16x4 __attribute__((ext_vector_type(4)));
typedef GAS unsigned gu32;
#define RLX_AGENT __ATOMIC_RELAXED, __HIP_MEMORY_SCOPE_AGENT
#define LDS_WAIT() asm volatile("s_waitcnt lgkmcnt(0)" ::: "memory")
#define VM_WAIT() asm volatile("s_waitcnt vmcnt(0)" ::: "memory")
#define MFMA32(a, b, c) __builtin_amdgcn_mfma_f32_32x32x16_bf16((a), (b), (c), 0, 0, 0)
using pg8::cvt_pk_bf16; using pg8::bf_lo; using pg8::bf_hi;
__device__ __forceinline__ unsigned short f2bf(float f) { return (unsigned short)(cvt_pk_bf16(f, 0.f) & 0xffffu); }
__device__ __forceinline__ float bf2f(unsigned short h) { return __uint_as_float((unsigned)h << 16); }
__device__ __forceinline__ int crow(int reg, int hh) { return (reg & 3) + 8 * (reg >> 2) + 4 * hh; }
__device__ __forceinline__ float wave_sum(float v) {
#pragma unroll
    for (int o = 1; o < 64; o <<= 1) v += __shfl_xor(v, o);
    return v;
}
__device__ __forceinline__ float wave_max(float v) {
#pragma unroll
    for (int o = 1; o < 64; o <<= 1) v = fmaxf(v, __shfl_xor(v, o));
    return v;
}
__device__ __forceinline__ bf16x8 frag_row(const LAS unsigned char* T, int stride, int r0, int k0, int lane) {
    return *(const LAS bf16x8*)(T + (r0 + (lane & 31)) * stride + (k0 + 8 * (lane >> 5)) * 2);
}
typedef short v4i16_t __attribute__((ext_vector_type(4)));
template <bool PERM> __device__ __forceinline__ bf16x8 frag_tr(const LAS unsigned char* X, int stride, int k0, int c0, int lane) {
    const int i = lane & 15, g = (lane >> 4) & 1, hh = lane >> 5, q = i >> 2, p = i & 3;
    const int rA = PERM ? (k0 + 4 * hh + q) : (k0 + 8 * hh + q), rB = PERM ? (k0 + 8 + 4 * hh + q) : (k0 + 8 * hh + 4 + q);
    const int cb = (c0 + 16 * g + 4 * p) * 2;
    const s16x4 lo = __builtin_bit_cast(s16x4, __builtin_amdgcn_ds_read_tr16_b64_v4i16((LAS v4i16_t*)(X + rA * stride + cb)));
    const s16x4 hi = __builtin_bit_cast(s16x4, __builtin_amdgcn_ds_read_tr16_b64_v4i16((LAS v4i16_t*)(X + rB * stride + cb)));
    return __builtin_shufflevector(lo, hi, 0, 1, 2, 3, 4, 5, 6, 7);
}
__device__ __forceinline__ bf16x8 pack_acc(const f32x16& x, int s) {
    v4u p; p.x = cvt_pk_bf16(x[8 * s], x[8 * s + 1]); p.y = cvt_pk_bf16(x[8 * s + 2], x[8 * s + 3]); p.z = cvt_pk_bf16(x[8 * s + 4], x[8 * s + 5]); p.w = cvt_pk_bf16(x[8 * s + 6], x[8 * s + 7]);
    return __builtin_bit_cast(bf16x8, p);
}

#define XB_TMO      128
#define XB_XCNT(j)  (256  + 64 * (j))
#define XB_XSUB(j)  (1280 + 64 * (j))
#define XB_XGEN(j)  (2304 + 64 * (j))
#define XB_TOP      3328
#define XB_TOPGEN   3392
#define XCD_BAR_WORDS 3456
#define XB_SPIN_CAP (1u << 22)
__device__ __forceinline__ unsigned xb_ld(unsigned* p)              { return __hip_atomic_load(p, __ATOMIC_RELAXED, __HIP_MEMORY_SCOPE_AGENT); }
__device__ __forceinline__ unsigned xb_add(unsigned* p, unsigned v) { return __hip_atomic_fetch_add(p, v, __ATOMIC_RELAXED, __HIP_MEMORY_SCOPE_AGENT); }
__device__ __forceinline__ unsigned xb_xcc_id() { return (unsigned)__builtin_amdgcn_s_getreg((3 << 11) | 20) & 0xFu; }
#define XB_SPIN(cond, bar) do { unsigned _sp = 0; while (cond) { __builtin_amdgcn_s_sleep(1); \
    if ((++_sp & 255u) == 0u) { if (xb_ld(&(bar)[XB_TMO])) break; if (_sp > XB_SPIN_CAP) { atomicAdd(&(bar)[XB_TMO], 1u); break; } } } } while (0)
struct XcdBarrier { unsigned* bar; unsigned x; volatile LAS unsigned* st; };
__device__ __forceinline__ XcdBarrier xcd_barrier_post(unsigned* bar, volatile LAS unsigned* st) {
    XcdBarrier b; b.bar = bar; b.x = xb_xcc_id(); b.st = st;
    if (threadIdx.x == 0) (void)xb_add(&bar[XB_XCNT(b.x)], 1u);
    return b;
}
__device__ __forceinline__ void xcd_barrier_complete(unsigned* bar, unsigned x, unsigned& nloc, unsigned& nx) {
    const unsigned G = gridDim.x * gridDim.y * gridDim.z;
    unsigned sum, cnt, mine, sp = 0u;
    for (;;) {
        sum = 0u; cnt = 0u; mine = 0u;
#pragma unroll
        for (unsigned j = 0; j < 16; ++j) { const unsigned c = xb_ld(&bar[XB_XCNT(j)]); sum += c; cnt += (c > 0u) ? 1u : 0u; mine = (j == x) ? c : mine; }
        if (sum == G) break;
        __builtin_amdgcn_s_sleep(1);
        if ((++sp & 255u) == 0u) { if (xb_ld(&bar[XB_TMO])) break; if (sp > XB_SPIN_CAP) { atomicAdd(&bar[XB_TMO], 1u); break; } }
    }
    nloc = mine > 0u ? mine : 1u; nx = cnt > 0u ? cnt : 1u;
}
__device__ __forceinline__ void xcd_barrier(const XcdBarrier& b) {
    asm volatile("s_waitcnt vmcnt(0)" ::: "memory");
    __syncthreads();
    if (threadIdx.x == 0) {
        unsigned* bar = b.bar;
        __builtin_amdgcn_s_waitcnt(0);
        unsigned nloc = b.st[0], nx = b.st[1];
        if (nloc == 0u) { xcd_barrier_complete(bar, b.x, nloc, nx); b.st[0] = nloc; b.st[1] = nx; }
        const unsigned old = xb_add(&bar[XB_XSUB(b.x)], 1u);
        const unsigned gen = old / nloc;
        if (old + 1u == (gen + 1u) * nloc) {
            __builtin_amdgcn_fence(__ATOMIC_RELEASE, "agent");
            asm volatile("s_waitcnt vmcnt(0)" ::: "memory");
            const unsigned og = xb_add(&bar[XB_TOP], 1u);
            const unsigned tg = og / nx;
            if (og + 1u == (tg + 1u) * nx) xb_add(&bar[XB_TOPGEN], 1u);
            else XB_SPIN(xb_ld(&bar[XB_TOPGEN]) == tg, bar);
            __builtin_amdgcn_fence(__ATOMIC_ACQUIRE, "agent");
            xb_add(&bar[XB_XGEN(b.x)], 1u);
            asm volatile("s_waitcnt vmcnt(0)" ::: "memory");
        } else {
            XB_SPIN(xb_ld(&bar[XB_XGEN(b.x)]) == gen, bar);
            __builtin_amdgcn_fence(__ATOMIC_ACQUIRE, "agent");
            asm volatile("s_waitcnt vmcnt(0)" ::: "memory");
        }
    }
    __syncthreads();
}

struct Frame {
    LAS unsigned char* lds;
    volatile LAS unsigned* MISC;
    gu32* ctl;
    int tid, lane, wave, G;
    float* out; unsigned char* ws;
};
#define WSP(T, off) ((T*)(F.ws + (off)))
#define WSL(T, off) ((T*)(ws_ + (off)))
#define LAUNDER_WS() unsigned char* ws_ = F.ws; asm volatile("" : "+s"(ws_))
constexpr int PTR_OFF = MISC_OFF + 128;
enum { I_XP = 0, I_XS, I_C1, I_C2, I_C3, I_ST0, I_RELB, I_WIN, I_WG2, I_BG, I_GN, I_WA, I_WB, I_WO, I_L1G, I_L1B, I_WQ, I_KEYS, I_PU, I_PV, I_L2G, I_L2B };
__device__ __forceinline__ const float* inptr(const Frame& F, int i) {
    const unsigned long long v = ((volatile LAS unsigned long long*)(F.lds + PTR_OFF))[i];
    const unsigned lo = __builtin_amdgcn_readfirstlane((unsigned)v), hi = __builtin_amdgcn_readfirstlane((unsigned)(v >> 32));
    return (const float*)(((unsigned long long)hi << 32) | lo);
}

__device__ __forceinline__ void p0_transpose_item(const float* W, int K, int N, int nsrc0, bf16* WT, int ndst0, int k0, LAS float* scr, int lane) {
#pragma unroll 8
    for (int i = 0; i < 32; ++i) { const int kk = 2 * i + (lane >> 5); scr[kk * 33 + (lane & 31)] = W[(size_t)(k0 + kk) * N + nsrc0 + (lane & 31)]; }
    LDS_WAIT(); asm volatile("" ::: "memory");
    const int c = lane & 7;
#pragma unroll
    for (int j = 0; j < 4; ++j) { const int n = (lane >> 3) + 8 * j; const LAS float* s = scr + (8 * c) * 33 + n;
        v4u o; o.x = cvt_pk_bf16(s[0 * 33], s[1 * 33]); o.y = cvt_pk_bf16(s[2 * 33], s[3 * 33]); o.z = cvt_pk_bf16(s[4 * 33], s[5 * 33]); o.w = cvt_pk_bf16(s[6 * 33], s[7 * 33]);
        *(GAS v4u*)(WT + (size_t)(ndst0 + n) * K + k0 + 8 * c) = o; }
    LDS_WAIT(); asm volatile("" ::: "memory");
}
__device__ __forceinline__ void p0_cvt8(const float* src, bf16* dst, size_t n8, size_t gt, size_t ngt) {
    for (size_t i = gt; i < n8; i += ngt) { const f32x4 a = *(const f32x4*)(src + i * 8), b = *(const f32x4*)(src + i * 8 + 4);
        v4u o; o.x = cvt_pk_bf16(a[0], a[1]); o.y = cvt_pk_bf16(a[2], a[3]); o.z = cvt_pk_bf16(b[0], b[1]); o.w = cvt_pk_bf16(b[2], b[3]); *(v4u*)(dst + i * 8) = o; }
}
__device__ __forceinline__ void p0_kvshift(const float* src, float* dst, int Wb, size_t gt, size_t ngt) {
    const size_t n4 = (size_t)(Wb - 4) * 256, tot = n4 * 32;
    for (size_t i = gt; i < tot; i += ngt) { const size_t b = i / n4, r = i - b * n4;
        ((f32x4*)dst)[b * (size_t)Wb * 256 + r] = ((const f32x4*)src)[b * (size_t)Wb * 256 + 1024 + r]; }
}
__device__ __forceinline__ void p0_prologue(Frame& F) {
    const int gw = blockIdx.x * NWAVES + F.wave, NGW = F.G * NWAVES;
    const size_t gt = (size_t)blockIdx.x * NTHR + F.tid, ngt = (size_t)F.G * NTHR;
    const float* win = inptr(F, I_WIN); const float* xp = inptr(F, I_XP); const float* xs = inptr(F, I_XS);
    LAS float* wab = (LAS float*)F.lds;
    for (int i = F.tid; i < 16384; i += NTHR) { const int ln = i & 63, e = (i >> 6) & 3, j = (i >> 8) & 3, c = i >> 10; const int k = 4 * (ln + 64 * j) + e; wab[i] = win[(size_t)k * INW + ABCOL + c]; }
    __syncthreads();
    bf16* XB = WSP(bf16, WS_XB); float* AB = WSP(float, WS_AB);
    for (int m = gw; m < MPAD; m += NGW) {
        GAS unsigned long long* o8 = (GAS unsigned long long*)(XB + (size_t)m * 1024) + F.lane;
        if (m >= NTOK) {
#pragma unroll
            for (int j = 0; j < 4; ++j) o8[64 * j] = 0ull;
            if (F.lane < 16) AB[(size_t)m * 16 + F.lane] = 0.f;
            continue; }
        const float* xr = m < NP ? xp + (size_t)m * 1024 : xs + (size_t)(m - NP) * 1024;
        f32x4 v[4];
#pragma unroll
        for (int j = 0; j < 4; ++j) v[j] = ((const f32x4*)xr)[F.lane + 64 * j];
#pragma unroll
        for (int j = 0; j < 4; ++j) o8[64 * j] = (unsigned long long)cvt_pk_bf16(v[j][0], v[j][1]) | ((unsigned long long)cvt_pk_bf16(v[j][2], v[j][3]) << 32);
        float mine = 0.f;
#pragma unroll
        for (int c = 0; c < 16; ++c) { float a = 0.f;
#pragma unroll
            for (int j = 0; j < 4; ++j)
#pragma unroll
                for (int e = 0; e < 4; ++e) a += v[j][e] * wab[((c * 4 + j) * 4 + e) * 64 + F.lane];
            a = wave_sum(a); mine = (F.lane == c) ? a : mine; }
        if (F.lane < 16) AB[(size_t)m * 16 + F.lane] = mine;
    }
    __syncthreads();
    LAS float* scr = (LAS float*)(F.lds + F.wave * 16384);
    const float* wa = inptr(F, I_WA); const float* wb = inptr(F, I_WB); const float* wo = inptr(F, I_WO); const float* wq = inptr(F, I_WQ);
    constexpr int I_IN = 16 * (NPROJ / 32), I_A = 8 * 32, I_B = 16 * 32, I_O = 16 * 32, I_Q = 16 * 64, NIT = I_IN + I_A + I_B + I_O + I_Q;
    for (int it = gw; it < NIT; it += NGW) {
        int r = it;
        if (r < I_IN) { const int nb = r % (NPROJ / 32), kb = r / (NPROJ / 32), nd = 32 * nb; p0_transpose_item(win, 1024, INW, nd + (nd >= ABCOL ? 16 : 0), WSP(bf16, WS_WIN), nd, 64 * kb, scr, F.lane); continue; } r -= I_IN;
        if (r < I_A) { p0_transpose_item(wa, 512, 1024, 32 * (r % 32), WSP(bf16, WS_WA), 32 * (r % 32), 64 * (r / 32), scr, F.lane); continue; } r -= I_A;
        if (r < I_B) { p0_transpose_item(wb, 1024, 1024, 32 * (r % 32), WSP(bf16, WS_WB), 32 * (r % 32), 64 * (r / 32), scr, F.lane); continue; } r -= I_B;
        if (r < I_O) { p0_transpose_item(wo, 1024, 1024, 32 * (r % 32), WSP(bf16, WS_WO), 32 * (r % 32), 64 * (r / 32), scr, F.lane); continue; } r -= I_O;
        p0_transpose_item(wq, 1024, 2048, 32 * (r % 64), WSP(bf16, WS_WQ), 32 * (r % 64), 64 * (r / 64), scr, F.lane);
    }
    p0_cvt8(inptr(F, I_PU), WSP(bf16, WS_UT), (size_t)16384 * 1024 / 8, gt, ngt);
    p0_cvt8(inptr(F, I_PV), WSP(bf16, WS_VT), (size_t)16384 * 1024 / 8, gt, ngt);
    p0_cvt8(inptr(F, I_KEYS), WSP(bf16, WS_KEYS), (size_t)8 * 2 * 128 * 128 / 8, gt, ngt);
    if (gt < 3 * 8 * 129) { const int g = (int)gt / (8 * 129), h = ((int)gt / 129) % 8, rel = (int)gt % 129; const int dil = g == 0 ? 1 : (g == 1 ? 4 : 16), dist = rel * dil;
        int bucket = dist;
        if (dist >= 16) { const float dd = (float)dist; int lg = 16 + (int)(logf(dd / 16.0f) / 4.852030263919617f * 16.0f); bucket = lg < 31 ? lg : 31; }
        WSP(float, WS_LUT)[gt] = inptr(F, I_RELB)[bucket * 24 + g * 8 + h]; }
    p0_kvshift(inptr(F, I_C1), F.out + OUT_KVS1, 128, gt, ngt);
    p0_kvshift(inptr(F, I_C2), F.out + OUT_KVS2, 512, gt, ngt);
    p0_kvshift(inptr(F, I_C3), F.out + OUT_KVS3, 2048, gt, ngt);
}

__device__ __forceinline__ void gla_prompt_unit(Frame& F, int b, int h, int sl) {
    LAUNDER_WS();
    LAS unsigned char* L = F.lds;
    constexpr int O_QE = 0, O_KE = 17408, O_KD = 34816, O_VT = 55296, O_SB = 67584, O_GT = 92160, O_AB = 94208, O_DEC = 98304;
    const int tid = F.tid, lane = F.lane, w = F.wave, hh = lane >> 5;
    const int d = tid & 127, ig = tid >> 7;
    const bf16* QB = WSL(bf16, WS_QB); const bf16* KB = WSL(bf16, WS_KB); bf16* VB = WSL(bf16, WS_VB); const float* AB = WSL(float, WS_AB);
    float wg[16];
    { const float* wg2 = inptr(F, I_WG2);
#pragma unroll
    for (int r = 0; r < 16; ++r) wg[r] = wg2[r * 512 + h * 128 + d]; }
    const float bgd = inptr(F, I_BG)[h * 128 + d];
    for (int i = tid; i < 128 * 192 / 4; i += NTHR) ((LAS unsigned*)(L + O_SB))[i] = 0u;
    f32x16 S;
#pragma unroll
    for (int r = 0; r < 16; ++r) S[r] = 0.f;
    const int dt = w >> 1, et = w & 1;
    for (int n = 0; n < 64; ++n) {
        const size_t m0 = (size_t)b * TSEQ + (size_t)n * 64;
        unsigned short qv[16], kv[16];
#pragma unroll
        for (int ii = 0; ii < 16; ++ii) { const size_t row = m0 + 16 * ig + ii; qv[ii] = QB[row * 512 + h * 128 + d]; kv[ii] = KB[row * 512 + h * 128 + d]; }
        const v4u vv = *(const v4u*)(VB + (m0 + (tid >> 3)) * 1024 + h * 256 + sl * 64 + (tid & 7) * 8);
        if (tid < 256) *(LAS f32x4*)(L + O_AB + tid * 16) = *(const f32x4*)(AB + (m0 + (tid >> 2)) * 16 + (tid & 3) * 4);
        *(LAS v4u*)(L + O_VT + (tid >> 3) * 192 + (tid & 7) * 16) = vv;
        __syncthreads();
        float c[16]; float run = 0.f;
#pragma unroll
        for (int ii = 0; ii < 16; ++ii) {
            const LAS f32x4* ar = (const LAS f32x4*)(L + O_AB + (16 * ig + ii) * 64);
            const f32x4 a0 = ar[0], a1 = ar[1], a2 = ar[2], a3 = ar[3];
            float x = bgd;
            x += a0[0] * wg[0] + a0[1] * wg[1] + a0[2] * wg[2] + a0[3] * wg[3];
            x += a1[0] * wg[4] + a1[1] * wg[5] + a1[2] * wg[6] + a1[3] * wg[7];
            x += a2[0] * wg[8] + a2[1] * wg[9] + a2[2] * wg[10] + a2[3] * wg[11];
            x += a3[0] * wg[12] + a3[1] * wg[13] + a3[2] * wg[14] + a3[3] * wg[15];
            const float ls = fminf(x, 0.f) - log1pf(expf(-fabsf(x)));
            run += ls * (1.0f / 16.0f); c[ii] = run;
        }
        ((LAS float*)(L + O_GT))[ig * 128 + d] = run;
        __syncthreads();
        const float g0 = ((LAS float*)(L + O_GT))[d], g1 = ((LAS float*)(L + O_GT))[128 + d], g2 = ((LAS float*)(L + O_GT))[256 + d], g3 = ((LAS float*)(L + O_GT))[384 + d];
        const float offs = (ig > 0 ? g0 : 0.f) + (ig > 1 ? g1 : 0.f) + (ig > 2 ? g2 : 0.f), bl = (g0 + g1) + (g2 + g3);
        const float ebl = expf(bl);
#pragma unroll
        for (int ii = 0; ii < 16; ++ii) {
            const float bb = offs + c[ii], eb = expf(bb), ieb = expf(-bb);
            const float q = bf2f(qv[ii]), k = bf2f(kv[ii]);
            const int rowo = (16 * ig + ii);
            *(LAS unsigned short*)(L + O_QE + rowo * 272 + d * 2) = f2bf(q * GLA_QSCALE * eb);
            *(LAS unsigned short*)(L + O_KE + rowo * 272 + d * 2) = f2bf(k * ieb);
            *(LAS unsigned short*)(L + O_KD + rowo * 320 + d * 2) = f2bf(k * (ieb * ebl));
        }
        if (ig == 0) ((LAS float*)(L + O_DEC))[d] = ebl;
        __syncthreads();
        if (w < 4) {
            const int it = w >> 1;
            f32x16 o;
#pragma unroll
            for (int r = 0; r < 16; ++r) o[r] = 0.f;
            for (int jt = 0; jt <= it; ++jt) {
                f32x16 X;
#pragma unroll
                for (int r = 0; r < 16; ++r) X[r] = 0.f;
#pragma unroll
                for (int s = 0; s < 8; ++s) X = MFMA32(frag_row(L + O_KE, 272, 32 * jt, 16 * s, lane), frag_row(L + O_QE, 272, 32 * it, 16 * s, lane), X);
                if (jt == it) {
#pragma unroll
                    for (int r = 0; r < 16; ++r) if (crow(r, hh) > (lane & 31)) X[r] = 0.f;
                }
#pragma unroll
                for (int s2 = 0; s2 < 2; ++s2) o = MFMA32(pack_acc(X, s2), frag_tr<true>(L + O_VT, 192, 32 * jt + 16 * s2, 32 * et, lane), o);
            }
#pragma unroll
            for (int s = 0; s < 8; ++s) o = MFMA32(frag_row(L + O_QE, 272, 32 * it, 16 * s, lane), frag_tr<false>(L + O_SB, 192, 16 * s, 32 * et, lane), o);
            bf16* op = VB + (m0 + 32 * it) * 1024 + h * 256 + sl * 64 + 32 * et + (lane & 31);
#pragma unroll
            for (int r = 0; r < 16; ++r) op[(size_t)crow(r, hh) * 1024] = f2bf(o[r]);
        }
        {
#pragma unroll
            for (int r = 0; r < 16; ++r) S[r] *= ((LAS float*)(L + O_DEC))[32 * dt + crow(r, hh)];
#pragma unroll
            for (int s = 0; s < 4; ++s) S = MFMA32(frag_tr<false>(L + O_KD, 320, 16 * s, 32 * dt, lane), frag_tr<false>(L + O_VT, 192, 16 * s, 32 * et, lane), S);
        }
        __syncthreads();
#pragma unroll
        for (int r = 0; r < 16; ++r) *(LAS unsigned short*)(L + O_SB + (32 * dt + crow(r, hh)) * 192 + (32 * et + (lane & 31)) * 2) = f2bf(S[r]);
    }
    float* so = F.out + OUT_STP + ((size_t)(b * 4 + h) * 128 + 32 * dt) * 256 + sl * 64 + 32 * et + (lane & 31);
#pragma unroll
    for (int r = 0; r < 16; ++r) so[(size_t)crow(r, hh) * 256] = S[r];
    __syncthreads();
}

__device__ __forceinline__ void attn_prompt_item(Frame& F, int item) {
    LAUNDER_WS();
    LAS unsigned char* L = F.lds;
    constexpr int O_V = 0, O_LUT = 384 * 192;
    const int tid = F.tid, lane = F.lane, w = F.wave, hh = lane >> 5, il = lane & 31;
    const int bh = item / 48, sub = item % 48, b = bh >> 3, h = bh & 7;
    int g, r, ibg;
    if (sub < 16) { g = 0; r = 0; ibg = sub; } else if (sub < 32) { g = 1; r = (sub - 16) >> 2; ibg = (sub - 16) & 3; } else { g = 2; r = sub - 32; ibg = 0; }
    const int dil = g == 0 ? 1 : (g == 1 ? 4 : 16), i0 = 256 * ibg;
    bf16* QA = WSL(bf16, WS_QA); const bf16* KA = WSL(bf16, WS_KA); const bf16* VA = WSL(bf16, WS_VA); float* LSE = WSL(float, WS_LSE);
    const size_t tok0 = (size_t)b * TSEQ + r; const int cb = g * 512 + h * 64;
#pragma unroll
    for (int p = 0; p < 6; ++p) { const int idx = tid + NTHR * p, rr = idx >> 3, ch = idx & 7, j = i0 - 128 + rr;
        if (j >= 0) *(LAS v4u*)(L + O_V + rr * 192 + ch * 16) = *(const v4u*)(VA + (tok0 + (size_t)dil * j) * 1536 + cb + ch * 8); }
    if (tid < 129) ((LAS float*)(L + O_LUT))[tid] = WSL(float, WS_LUT)[(g * 8 + h) * 129 + tid];
    __syncthreads();
    const size_t qtok = tok0 + (size_t)dil * (i0 + 32 * w + il);
    bf16x8 qf[4];
#pragma unroll
    for (int s = 0; s < 4; ++s) qf[s] = *(const bf16x8*)(QA + qtok * 1536 + cb + 16 * s + 8 * hh);
    float mrun = NEG_BIG, lrun = 0.f;
    f32x16 O0, O1;
#pragma unroll
    for (int x = 0; x < 16; ++x) { O0[x] = 0.f; O1[x] = 0.f; }
#pragma unroll 1
    for (int kt = 0; kt < 5; ++kt) {
        const int jb = i0 + 32 * (w + kt) - 128;
        if (jb < 0) continue;
        const size_t ktok = tok0 + (size_t)dil * (jb + il);
        f32x16 ST;
#pragma unroll
        for (int x = 0; x < 16; ++x) ST[x] = 0.f;
#pragma unroll
        for (int s = 0; s < 4; ++s) { const bf16x8 kf = *(const bf16x8*)(KA + ktok * 1536 + cb + 16 * s + 8 * hh); ST = MFMA32(kf, qf[s], ST); }
        const int relb = 128 - 32 * kt + il;
        float tmax = NEG_BIG;
#pragma unroll
        for (int x = 0; x < 16; ++x) { const int rel = relb - crow(x, hh); const bool ok = rel >= 0 && rel <= 128; const int rc = rel < 0 ? 0 : (rel > 128 ? 128 : rel);
            const float sc = ok ? ST[x] + ((LAS float*)(L + O_LUT))[rc] : NEG_BIG; ST[x] = sc; tmax = fmaxf(tmax, sc); }
        tmax = fmaxf(tmax, __shfl_xor(tmax, 32));
        const float mnew = fmaxf(mrun, tmax), alpha = __expf(mrun - mnew);
        float ps = 0.f;
#pragma unroll
        for (int x = 0; x < 16; ++x) { const float p = __expf(ST[x] - mnew); ST[x] = p; ps += p; }
        lrun = lrun * alpha + ps; mrun = mnew;
#pragma unroll
        for (int x = 0; x < 16; ++x) { O0[x] *= alpha; O1[x] *= alpha; }
#pragma unroll
        for (int s2 = 0; s2 < 2; ++s2) { const bf16x8 pf = pack_acc(ST, s2);
            O0 = MFMA32(frag_tr<true>(L + O_V, 192, 32 * (w + kt) + 16 * s2, 0, lane), pf, O0);
            O1 = MFMA32(frag_tr<true>(L + O_V, 192, 32 * (w + kt) + 16 * s2, 32, lane), pf, O1); }
    }
    const float ltot = lrun + __shfl_xor(lrun, 32), inv = 1.0f / ltot;
    bf16* op = QA + qtok * 1536 + cb;
#pragma unroll
    for (int k4 = 0; k4 < 4; ++k4) { v2u a, c2;
        a.x = cvt_pk_bf16(O0[4 * k4] * inv, O0[4 * k4 + 1] * inv); a.y = cvt_pk_bf16(O0[4 * k4 + 2] * inv, O0[4 * k4 + 3] * inv);
        c2.x = cvt_pk_bf16(O1[4 * k4] * inv, O1[4 * k4 + 1] * inv); c2.y = cvt_pk_bf16(O1[4 * k4 + 2] * inv, O1[4 * k4 + 3] * inv);
        *(v2u*)(op + 8 * k4 + 4 * hh) = a; *(v2u*)(op + 32 + 8 * k4 + 4 * hh) = c2; }
    if (hh == 0) LSE[((size_t)g * MPAD + qtok) * 8 + h] = mrun + __logf(ltot);
    __syncthreads();
}

template <int G_> __device__ __forceinline__ void attn_sample_waveitem_g(Frame& F, int wi, const float* cache) {
    LAUNDER_WS();
    const int lane = F.lane;
    LAS float* pl = (LAS float*)(F.lds + F.wave * 1024);
    constexpr int g = G_; const int h = (wi / 3) & 7, s = (wi / 24) & 3, b = wi / 96;
    constexpr int dil = g == 0 ? 1 : (g == 1 ? 4 : 16), Wb = 128 * dil;
    bf16* QA = WSL(bf16, WS_QA); const bf16* KA = WSL(bf16, WS_KA); const bf16* VA = WSL(bf16, WS_VA); float* LSE = WSL(float, WS_LSE);
    const size_t qrow = (size_t)NP + b * 4 + s; const int cb = g * 512 + h * 64;
    float q[64];
#pragma unroll
    for (int c = 0; c < 8; ++c) { const v4u u = *(const v4u*)(QA + qrow * 1536 + cb + 8 * c);
        q[8 * c] = bf_lo(u.x); q[8 * c + 1] = bf_hi(u.x); q[8 * c + 2] = bf_lo(u.y); q[8 * c + 3] = bf_hi(u.y); q[8 * c + 4] = bf_lo(u.z); q[8 * c + 5] = bf_hi(u.z); q[8 * c + 6] = bf_lo(u.w); q[8 * c + 7] = bf_hi(u.w); }
    const float* lut = WSL(float, WS_LUT) + (g * 8 + h) * 129;
    float sc[3];
#pragma unroll
    for (int p = 0; p < 3; ++p) { const int j = lane + 64 * p; float a = NEG_BIG;
        if (j <= 128) { const int idx = Wb + s - j * dil; a = 0.f;
            if (idx >= Wb) { const bf16* kr = KA + ((size_t)NP + b * 4 + (idx - Wb)) * 1536 + cb;
#pragma unroll
                for (int c = 0; c < 8; ++c) { const v4u u = *(const v4u*)(kr + 8 * c);
                    a += q[8 * c] * bf_lo(u.x) + q[8 * c + 1] * bf_hi(u.x) + q[8 * c + 2] * bf_lo(u.y) + q[8 * c + 3] * bf_hi(u.y) + q[8 * c + 4] * bf_lo(u.z) + q[8 * c + 5] * bf_hi(u.z) + q[8 * c + 6] * bf_lo(u.w) + q[8 * c + 7] * bf_hi(u.w); }
            } else { const float* kr = cache + (((size_t)b * Wb + idx) * 2 + 0) * 512 + h * 64;
#pragma unroll
                for (int c = 0; c < 16; ++c) { const f32x4 u = *(const f32x4*)(kr + 4 * c); a += q[4 * c] * u[0] + q[4 * c + 1] * u[1] + q[4 * c + 2] * u[2] + q[4 * c + 3] * u[3]; }
            }
            a += lut[j]; }
        sc[p] = a; }
    const float mx = wave_max(fmaxf(fmaxf(sc[0], sc[1]), sc[2]));
    float ps = 0.f;
#pragma unroll
    for (int p = 0; p < 3; ++p) { const float e = __expf(sc[p] - mx); ps += e; pl[lane + 64 * p] = e; }
    const float ltot = wave_sum(ps);
    LDS_WAIT(); asm volatile("" ::: "memory");
    float o = 0.f;
    for (int j = 0; j <= 128; ++j) { const int idx = Wb + s - j * dil; const float p = pl[j];
        const float v = idx >= Wb ? bf2f(VA[((size_t)NP + b * 4 + (idx - Wb)) * 1536 + cb + lane]) : cache[(((size_t)b * Wb + idx) * 2 + 1) * 512 + h * 64 + lane];
        o += p * v; }
    QA[qrow * 1536 + cb + lane] = f2bf(o / ltot);
    if (lane == 0) LSE[((size_t)g * MPAD + qrow) * 8 + h] = mx + __logf(ltot);
    LDS_WAIT(); asm volatile("" ::: "memory");
}

__device__ __forceinline__ void attn_sample_waveitem(Frame& F, int wi) {
    const int g = wi % 3;
    if (g == 0) attn_sample_waveitem_g<0>(F, wi, inptr(F, I_C1)); else if (g == 1) attn_sample_waveitem_g<1>(F, wi, inptr(F, I_C2)); else attn_sample_waveitem_g<2>(F, wi, inptr(F, I_C3));
}
__device__ __forceinline__ void gla_sample_item(Frame& F, int item) {
    LAUNDER_WS();
    LAS float* L = (LAS float*)F.lds;
    constexpr int O_LA = 0, O_QE = 512, O_KE = 1024, O_KD = 1536, O_DEC = 2048, O_ATT = 2176, O_PART = 2304;
    const int tid = F.tid, b = item >> 2, h = item & 3;
    const bf16* QB = WSL(bf16, WS_QB); const bf16* KB = WSL(bf16, WS_KB); bf16* VB = WSL(bf16, WS_VB); const float* AB = WSL(float, WS_AB);
    const size_t row0 = (size_t)NP + b * 4;
    { const int i = tid >> 7, d = tid & 127; float x = inptr(F, I_BG)[h * 128 + d]; const float* wg2 = inptr(F, I_WG2);
#pragma unroll
      for (int r = 0; r < 16; ++r) x += AB[(row0 + i) * 16 + r] * wg2[r * 512 + h * 128 + d];
      L[O_LA + i * 128 + d] = (fminf(x, 0.f) - log1pf(expf(-fabsf(x)))) * (1.0f / 16.0f); }
    __syncthreads();
    if (tid < 128) { const int d = tid; float bb[4]; float run = 0.f;
#pragma unroll
        for (int i = 0; i < 4; ++i) { run += L[O_LA + i * 128 + d]; bb[i] = run; }
        const float ebl = expf(run); L[O_DEC + d] = ebl;
#pragma unroll
        for (int i = 0; i < 4; ++i) { const float q = bf2f(QB[(row0 + i) * 512 + h * 128 + d]), k = bf2f(KB[(row0 + i) * 512 + h * 128 + d]);
            L[O_QE + i * 128 + d] = q * GLA_QSCALE * expf(bb[i]); L[O_KE + i * 128 + d] = k * expf(-bb[i]); L[O_KD + i * 128 + d] = k * expf(run - bb[i]); } }
    __syncthreads();
    if (tid < 16) { const int i = tid >> 2, j = tid & 3; float a = 0.f;
        if (j <= i) for (int d = 0; d < 128; ++d) a += L[O_QE + i * 128 + d] * L[O_KE + j * 128 + d];
        L[O_ATT + tid] = a; }
    const int e = tid & 255, dh = tid >> 8;
    float v[4];
#pragma unroll
    for (int j = 0; j < 4; ++j) v[j] = bf2f(VB[(row0 + j) * 1024 + h * 256 + e]);
    const float* Sin = inptr(F, I_ST0) + ((size_t)(b * 4 + h) * 128) * 256 + e; float* Sout = F.out + OUT_STS + ((size_t)(b * 4 + h) * 128) * 256 + e;
    float acc[4] = {0.f, 0.f, 0.f, 0.f};
#pragma unroll 4
    for (int dd = 0; dd < 64; ++dd) { const int d = dh * 64 + dd; const float sv = Sin[(size_t)d * 256];
#pragma unroll
        for (int i = 0; i < 4; ++i) acc[i] += L[O_QE + i * 128 + d] * sv;
        float sn = L[O_DEC + d] * sv;
#pragma unroll
        for (int j = 0; j < 4; ++j) sn += L[O_KD + j * 128 + d] * v[j];
        Sout[(size_t)d * 256] = sn; }
#pragma unroll
    for (int i = 0; i < 4; ++i) L[O_PART + (dh * 4 + i) * 256 + e] = acc[i];
    __syncthreads();
    if (tid < 256) {
#pragma unroll
        for (int i = 0; i < 4; ++i) { float o = L[O_PART + i * 256 + e] + L[O_PART + (4 + i) * 256 + e];
#pragma unroll
            for (int j = 0; j < 4; ++j) o += L[O_ATT + i * 4 + j] * v[j];
            VB[(row0 + i) * 1024 + h * 256 + e] = f2bf(o); } }
    __syncthreads();
}

constexpr int P2_ATT = 3072, P2_DEC = 384, P2_GLS = 128, P2_ITEMS = P2_ATT + P2_DEC + P2_GLS;
__device__ __forceinline__ void p2_mixers(Frame& F) {
#ifndef P2_SKIP_GLAP
    if (blockIdx.x < 128) gla_prompt_unit(F, blockIdx.x >> 4, (blockIdx.x >> 2) & 3, blockIdx.x & 3);
#endif
    for (;;) {
        if (F.tid == 0) F.MISC[0] = __hip_atomic_fetch_add(F.ctl + CW_QUEUE, 1u, RLX_AGENT);
        __syncthreads();
        const int it = (int)F.MISC[0];
        __syncthreads();
        if (it >= P2_ITEMS) break;
        if (it < P2_GLS) {
#ifndef P2_SKIP_GLAS
            gla_sample_item(F, it);
#endif
        } else if (it < P2_GLS + P2_DEC) {
#ifndef P2_SKIP_DEC
            attn_sample_waveitem(F, (it - P2_GLS) * 8 + F.wave); __syncthreads();
#endif
        } else {
#ifndef P2_SKIP_ATT
            attn_prompt_item(F, it - P2_GLS - P2_DEC);
#endif
        }
    }
}

__device__ __forceinline__ void p3_kvout(const bf16* K, const bf16* V, float* dst, int g, int W, int nb, size_t rowbase, int rows_per_b, int first, int pos0, int Wdst, size_t gt, size_t ngt) {
    const size_t per_b = (size_t)W * 2 * 64, tot = per_b * nb;
    for (size_t i = gt; i < tot; i += ngt) { const size_t b = i / per_b, r = i - b * per_b; const int p = (int)(r >> 7), c = (int)(r >> 6) & 1, ch = (int)r & 63;
        const v4u u = *(const v4u*)((c ? V : K) + (rowbase + b * rows_per_b + first + p) * 1536 + g * 512 + ch * 8);
        float* o = dst + ((b * Wdst + pos0 + p) * 2 + c) * 512 + ch * 8;
        *(f32x4*)o = (f32x4){bf_lo(u.x), bf_hi(u.x), bf_lo(u.y), bf_hi(u.y)}; *(f32x4*)(o + 4) = (f32x4){bf_lo(u.z), bf_hi(u.z), bf_lo(u.w), bf_hi(u.w)}; }
}
__device__ __forceinline__ void p3_merge(Frame& F) {
    const int gw = blockIdx.x * NWAVES + F.wave, NGW = F.G * NWAVES, lane = F.lane;
    const size_t gt = (size_t)blockIdx.x * NTHR + F.tid, ngt = (size_t)F.G * NTHR;
    const bf16* OA = WSP(bf16, WS_QA); const bf16* OB = WSP(bf16, WS_VB); const bf16* RB = WSP(bf16, WS_RB); const float* LSE = WSP(float, WS_LSE);
    bf16* OAM = WSP(bf16, WS_OAM); bf16* OBN = WSP(bf16, WS_OBN); const float* gn = inptr(F, I_GN);
    for (int m = gw; m < MPAD; m += NGW) {
        if (m >= NTOK) { *(v4u*)(OAM + (size_t)m * 512 + lane * 8) = (v4u){0u, 0u, 0u, 0u}; *(v4u*)(OBN + (size_t)m * 1024 + lane * 16) = (v4u){0u, 0u, 0u, 0u}; *(v4u*)(OBN + (size_t)m * 1024 + lane * 16 + 8) = (v4u){0u, 0u, 0u, 0u}; continue; }
        {
            const int hd = lane >> 3, c8 = (lane & 7) * 8;
            const float l0 = LSE[((size_t)0 * MPAD + m) * 8 + hd], l1 = LSE[((size_t)1 * MPAD + m) * 8 + hd], l2 = LSE[((size_t)2 * MPAD + m) * 8 + hd];
            const float mx = fmaxf(l0, fmaxf(l1, l2)); float w0 = __expf(l0 - mx), w1 = __expf(l1 - mx), w2 = __expf(l2 - mx); const float iw = 1.0f / (w0 + w1 + w2); w0 *= iw; w1 *= iw; w2 *= iw;
            const v4u a = *(const v4u*)(OA + (size_t)m * 1536 + hd * 64 + c8), b2 = *(const v4u*)(OA + (size_t)m * 1536 + 512 + hd * 64 + c8), c = *(const v4u*)(OA + (size_t)m * 1536 + 1024 + hd * 64 + c8);
            v4u o;
            o.x = cvt_pk_bf16(w0 * bf_lo(a.x) + w1 * bf_lo(b2.x) + w2 * bf_lo(c.x), w0 * bf_hi(a.x) + w1 * bf_hi(b2.x) + w2 * bf_hi(c.x));
            o.y = cvt_pk_bf16(w0 * bf_lo(a.y) + w1 * bf_lo(b2.y) + w2 * bf_lo(c.y), w0 * bf_hi(a.y) + w1 * bf_hi(b2.y) + w2 * bf_hi(c.y));
            o.z = cvt_pk_bf16(w0 * bf_lo(a.z) + w1 * bf_lo(b2.z) + w2 * bf_lo(c.z), w0 * bf_hi(a.z) + w1 * bf_hi(b2.z) + w2 * bf_hi(c.z));
            o.w = cvt_pk_bf16(w0 * bf_lo(a.w) + w1 * bf_lo(b2.w) + w2 * bf_lo(c.w), w0 * bf_hi(a.w) + w1 * bf_hi(b2.w) + w2 * bf_hi(c.w));
            *(v4u*)(OAM + (size_t)m * 512 + hd * 64 + c8) = o;
        }
        {
            const int c0 = lane * 16;
            const v4u u0 = *(const v4u*)(OB + (size_t)m * 1024 + c0), u1 = *(const v4u*)(OB + (size_t)m * 1024 + c0 + 8);
            const v4u r0 = *(const v4u*)(RB + (size_t)m * 1024 + c0), r1 = *(const v4u*)(RB + (size_t)m * 1024 + c0 + 8);
            float x[16] = {bf_lo(u0.x), bf_hi(u0.x), bf_lo(u0.y), bf_hi(u0.y), bf_lo(u0.z), bf_hi(u0.z), bf_lo(u0.w), bf_hi(u0.w), bf_lo(u1.x), bf_hi(u1.x), bf_lo(u1.y), bf_hi(u1.y), bf_lo(u1.z), bf_hi(u1.z), bf_lo(u1.w), bf_hi(u1.w)};
            float rr[16] = {bf_lo(r0.x), bf_hi(r0.x), bf_lo(r0.y), bf_hi(r0.y), bf_lo(r0.z), bf_hi(r0.z), bf_lo(r0.w), bf_hi(r0.w), bf_lo(r1.x), bf_hi(r1.x), bf_lo(r1.y), bf_hi(r1.y), bf_lo(r1.z), bf_hi(r1.z), bf_lo(r1.w), bf_hi(r1.w)};
            float ss = 0.f;
#pragma unroll
            for (int i = 0; i < 16; ++i) ss += x[i] * x[i];
            ss += __shfl_xor(ss, 1); ss += __shfl_xor(ss, 2); ss += __shfl_xor(ss, 4); ss += __shfl_xor(ss, 8);
            const float rs = 1.0f / sqrtf(ss * (1.0f / 256.0f) + LN_EPS);
            float y[16];
#pragma unroll
            for (int i = 0; i < 16; ++i) { const float gte = rr[i] / (1.0f + __expf(-rr[i])); y[i] = x[i] * rs * gn[c0 + i] * gte; }
            v4u o0, o1; o0.x = cvt_pk_bf16(y[0], y[1]); o0.y = cvt_pk_bf16(y[2], y[3]); o0.z = cvt_pk_bf16(y[4], y[5]); o0.w = cvt_pk_bf16(y[6], y[7]);
            o1.x = cvt_pk_bf16(y[8], y[9]); o1.y = cvt_pk_bf16(y[10], y[11]); o1.z = cvt_pk_bf16(y[12], y[13]); o1.w = cvt_pk_bf16(y[14], y[15]);
            *(v4u*)(OBN + (size_t)m * 1024 + c0) = o0; *(v4u*)(OBN + (size_t)m * 1024 + c0 + 8) = o1;
        }
    }
    const bf16* KA = WSP(bf16, WS_KA); const bf16* VA = WSP(bf16, WS_VA);
    p3_kvout(KA, VA, F.out + OUT_KVP1, 0, 128, 8, 0, TSEQ, TSEQ - 128, 0, 128, gt, ngt);
    p3_kvout(KA, VA, F.out + OUT_KVP2, 1, 512, 8, 0, TSEQ, TSEQ - 512, 0, 512, gt, ngt);
    p3_kvout(KA, VA, F.out + OUT_KVP3, 2, 2048, 8, 0, TSEQ, TSEQ - 2048, 0, 2048, gt, ngt);
    p3_kvout(KA, VA, F.out + OUT_KVS1, 0, 4, 32, NP, 4, 0, 124, 128, gt, ngt);
    p3_kvout(KA, VA, F.out + OUT_KVS2, 1, 4, 32, NP, 4, 0, 508, 512, gt, ngt);
    p3_kvout(KA, VA, F.out + OUT_KVS3, 2, 4, 32, NP, 4, 0, 2044, 2048, gt, ngt);
}

__device__ __forceinline__ void p6_ln1(Frame& F) {
    const int gw = blockIdx.x * NWAVES + F.wave, NGW = F.G * NWAVES, lane = F.lane;
    float* H = WSP(float, WS_H); bf16* X1B = WSP(bf16, WS_X1B); const float* l1g = inptr(F, I_L1G); const float* l1b = inptr(F, I_L1B);
    for (int m = gw; m < MPAD; m += NGW) {
        f32x4* hr = (f32x4*)(H + (size_t)m * 1024) + lane;
        f32x4 v[4]; float s = 0.f;
#pragma unroll
        for (int j = 0; j < 4; ++j) { v[j] = hr[64 * j]; s += (v[j][0] + v[j][1]) + (v[j][2] + v[j][3]); }
        const float mean = wave_sum(s) * (1.f / 1024.f); float s2 = 0.f;
#pragma unroll
        for (int j = 0; j < 4; ++j) { v[j] = v[j] - mean; s2 += (v[j][0] * v[j][0] + v[j][1] * v[j][1]) + (v[j][2] * v[j][2] + v[j][3] * v[j][3]); }
        const float rstd = 1.f / sqrtf(wave_sum(s2) * (1.f / 1024.f) + LN_EPS);
        unsigned long long* o8 = (unsigned long long*)(X1B + (size_t)m * 1024) + lane;
#pragma unroll
        for (int j = 0; j < 4; ++j) { const f32x4 gg = ((const f32x4*)l1g)[lane + 64 * j], bb = ((const f32x4*)l1b)[lane + 64 * j];
            const f32x4 y = v[j] * rstd * gg + bb; hr[64 * j] = y;
            o8[64 * j] = (unsigned long long)cvt_pk_bf16(y[0], y[1]) | ((unsigned long long)cvt_pk_bf16(y[2], y[3]) << 32); }
    }
}

__device__ __forceinline__ unsigned mono_key(float f) { const unsigned u = __float_as_uint(f); return u ^ ((unsigned)((int)u >> 31) | 0x80000000u); }
__device__ __forceinline__ float mono_inv(unsigned k) { return __uint_as_float((k & 0x80000000u) ? (k ^ 0x80000000u) : ~k); }
#define CE_DESC(a, b) do { const unsigned _mx = (a) > (b) ? (a) : (b), _mn = (a) > (b) ? (b) : (a); (a) = _mx; (b) = _mn; } while (0)
__device__ __forceinline__ void ins16(unsigned (&T)[16], unsigned x) {
#pragma unroll
    for (int k = 0; k < 16; ++k) CE_DESC(T[k], x);
}
__device__ __forceinline__ void merge_partner16(unsigned (&T)[16]) {
    unsigned P[16];
#pragma unroll
    for (int k = 0; k < 16; ++k) P[k] = (unsigned)__shfl_xor((int)T[k], 32);
#pragma unroll
    for (int k = 0; k < 16; ++k) T[k] = T[k] > P[15 - k] ? T[k] : P[15 - k];
#pragma unroll
    for (int st = 8; st >= 1; st >>= 1)
#pragma unroll
        for (int k = 0; k < 16; ++k) if ((k & st) == 0) CE_DESC(T[k], T[k + st]);
}
__device__ __forceinline__ void p8_topk_item(Frame& F, int item) {
    const int lane = F.lane, hh = lane >> 5, il = lane & 31;
    const int tb = item >> 3, hd = item & 7; const int row = 32 * tb + il;
    const bf16* QN = WSP(bf16, WS_QN); const bf16* KEYS = WSP(bf16, WS_KEYS); int* EIDX = WSP(int, WS_EIDX); float* GATE = WSP(float, WS_GATE);
    LAS unsigned* LK = (LAS unsigned*)(F.lds + F.wave * 8192);
    unsigned T1[16], T2[16];
#pragma unroll
    for (int half = 0; half < 2; ++half) {
        bf16x8 bq[8];
#pragma unroll
        for (int s = 0; s < 8; ++s) bq[s] = *(const bf16x8*)(QN + (size_t)row * 2048 + hd * 256 + half * 128 + 16 * s + 8 * hh);
        unsigned T[16];
#pragma unroll
        for (int k = 0; k < 16; ++k) T[k] = 0u;
#pragma unroll 1
        for (int kt = 0; kt < 4; ++kt) {
            f32x16 acc;
#pragma unroll
            for (int x = 0; x < 16; ++x) acc[x] = 0.f;
#pragma unroll
            for (int s = 0; s < 8; ++s) { const bf16x8 kf = *(const bf16x8*)(KEYS + ((size_t)(hd * 2 + half) * 128 + 32 * kt + il) * 128 + 16 * s + 8 * hh); acc = MFMA32(kf, bq[s], acc); }
#pragma unroll
            for (int x = 0; x < 16; ++x) { const int idx = 32 * kt + crow(x, hh); ins16(T, (mono_key(acc[x]) & ~127u) | (unsigned)(127 - idx)); }
        }
        merge_partner16(T);
#pragma unroll
        for (int k = 0; k < 16; ++k) { LK[(half * 16 + k) * 64 + lane] = T[k]; if (half == 0) T1[k] = T[k]; else T2[k] = T[k]; }
    }
    float v1[16], v2[16];
#pragma unroll
    for (int k = 0; k < 16; ++k) { v1[k] = mono_inv(T1[k] & ~127u); v2[k] = mono_inv(T2[k] & ~127u); }
    unsigned C[16];
#pragma unroll
    for (int k = 0; k < 16; ++k) C[k] = 0u;
#pragma unroll
    for (int a = 0; a < 16; ++a)
#pragma unroll
        for (int c = 0; c < 16; ++c) if ((a + 1) * (c + 1) <= 16) ins16(C, (mono_key(v1[a] + v2[c]) & ~255u) | (unsigned)(255 - (16 * a + c)));
    LDS_WAIT(); asm volatile("" ::: "memory");
    float sv[16]; int ex[16]; float mx = NEG_BIG;
#pragma unroll
    for (int k = 0; k < 16; ++k) { const int si = 255 - (int)(C[k] & 255u), a = si >> 4, c = si & 15;
        const unsigned k1 = LK[a * 64 + lane], k2 = LK[(16 + c) * 64 + lane];
        ex[k] = (127 - (int)(k1 & 127u)) * 128 + (127 - (int)(k2 & 127u)); sv[k] = mono_inv(k1 & ~127u) + mono_inv(k2 & ~127u); mx = fmaxf(mx, sv[k]); }
    float den = 0.f;
#pragma unroll
    for (int k = 0; k < 16; ++k) { sv[k] = __expf(sv[k] - mx); den += sv[k]; }
    const float iden = 1.0f / den;
    if (hh == 0 && row < NTOK) {
#pragma unroll
        for (int k4 = 0; k4 < 4; ++k4) { *(int4*)(EIDX + (size_t)row * 128 + hd * 16 + 4 * k4) = make_int4(ex[4 * k4], ex[4 * k4 + 1], ex[4 * k4 + 2], ex[4 * k4 + 3]);
            *(f32x4*)(GATE + (size_t)row * 128 + hd * 16 + 4 * k4) = (f32x4){sv[4 * k4] * iden, sv[4 * k4 + 1] * iden, sv[4 * k4 + 2] * iden, sv[4 * k4 + 3] * iden}; } }
    LDS_WAIT(); asm volatile("" ::: "memory");
}

__device__ __forceinline__ float gelu_erf(float x) { return 0.5f * x * (1.0f + erff(x * 0.70710678118654752f)); }
__device__ __forceinline__ void p9_token(Frame& F, int m, const float* l2g, const float* l2b) {
    const int lane = F.lane;
    const float* X1 = WSP(float, WS_H); const int* EIDX = WSP(int, WS_EIDX); const float* GATE = WSP(float, WS_GATE); const bf16* UT = WSP(bf16, WS_UT); const bf16* VT = WSP(bf16, WS_VT);
    float x[16];
    { const f32x4 a = *(const f32x4*)(X1 + (size_t)m * 1024 + 8 * lane), b = *(const f32x4*)(X1 + (size_t)m * 1024 + 8 * lane + 4), c = *(const f32x4*)(X1 + (size_t)m * 1024 + 512 + 8 * lane), d = *(const f32x4*)(X1 + (size_t)m * 1024 + 512 + 8 * lane + 4);
      x[0] = a[0]; x[1] = a[1]; x[2] = a[2]; x[3] = a[3]; x[4] = b[0]; x[5] = b[1]; x[6] = b[2]; x[7] = b[3]; x[8] = c[0]; x[9] = c[1]; x[10] = c[2]; x[11] = c[3]; x[12] = d[0]; x[13] = d[1]; x[14] = d[2]; x[15] = d[3]; }
    float acc[16];
#pragma unroll
    for (int i = 0; i < 16; ++i) acc[i] = 0.f;
    for (int hd = 0; hd < 8; ++hd) {
        const int ev = EIDX[(size_t)m * 128 + hd * 16 + (lane & 15)];
        const float gv = GATE[(size_t)m * 128 + hd * 16 + (lane >> 2)];
        float part[16];
#pragma unroll
        for (int k = 0; k < 16; ++k) { const int e = __builtin_amdgcn_readlane(ev, k);
            const v4u u0 = *(const v4u*)(UT + (size_t)e * 1024 + 8 * lane), u1 = *(const v4u*)(UT + (size_t)e * 1024 + 512 + 8 * lane);
            part[k] = x[0] * bf_lo(u0.x) + x[1] * bf_hi(u0.x) + x[2] * bf_lo(u0.y) + x[3] * bf_hi(u0.y) + x[4] * bf_lo(u0.z) + x[5] * bf_hi(u0.z) + x[6] * bf_lo(u0.w) + x[7] * bf_hi(u0.w)
                    + x[8] * bf_lo(u1.x) + x[9] * bf_hi(u1.x) + x[10] * bf_lo(u1.y) + x[11] * bf_hi(u1.y) + x[12] * bf_lo(u1.z) + x[13] * bf_hi(u1.z) + x[14] * bf_lo(u1.w) + x[15] * bf_hi(u1.w); }
        float p8[8], p4[4], p2[2], p1;
        { const bool up = (lane & 32) != 0;
#pragma unroll
          for (int k = 0; k < 8; ++k) { const float send = up ? part[k] : part[k + 8], keep = up ? part[k + 8] : part[k]; p8[k] = keep + __shfl_xor(send, 32); } }
        { const bool up = (lane & 16) != 0;
#pragma unroll
          for (int k = 0; k < 4; ++k) { const float send = up ? p8[k] : p8[k + 4], keep = up ? p8[k + 4] : p8[k]; p4[k] = keep + __shfl_xor(send, 16); } }
        { const bool up = (lane & 8) != 0;
#pragma unroll
          for (int k = 0; k < 2; ++k) { const float send = up ? p4[k] : p4[k + 2], keep = up ? p4[k + 2] : p4[k]; p2[k] = keep + __shfl_xor(send, 8); } }
        { const bool up = (lane & 4) != 0; const float send = up ? p2[0] : p2[1], keep = up ? p2[1] : p2[0]; p1 = keep + __shfl_xor(send, 4); }
        p1 += __shfl_xor(p1, 2); p1 += __shfl_xor(p1, 1);
        const float coefv = gv * gelu_erf(p1);
#pragma unroll
        for (int k = 0; k < 16; ++k) { const int e = __builtin_amdgcn_readlane(ev, k); const float cf = __uint_as_float((unsigned)__builtin_amdgcn_readlane((int)__float_as_uint(coefv), 4 * k));
            const v4u u0 = *(const v4u*)(VT + (size_t)e * 1024 + 8 * lane), u1 = *(const v4u*)(VT + (size_t)e * 1024 + 512 + 8 * lane);
            acc[0] += cf * bf_lo(u0.x); acc[1] += cf * bf_hi(u0.x); acc[2] += cf * bf_lo(u0.y); acc[3] += cf * bf_hi(u0.y); acc[4] += cf * bf_lo(u0.z); acc[5] += cf * bf_hi(u0.z); acc[6] += cf * bf_lo(u0.w); acc[7] += cf * bf_hi(u0.w);
            acc[8] += cf * bf_lo(u1.x); acc[9] += cf * bf_hi(u1.x); acc[10] += cf * bf_lo(u1.y); acc[11] += cf * bf_hi(u1.y); acc[12] += cf * bf_lo(u1.z); acc[13] += cf * bf_hi(u1.z); acc[14] += cf * bf_lo(u1.w); acc[15] += cf * bf_hi(u1.w); }
    }
    float s = 0.f;
#pragma unroll
    for (int i = 0; i < 16; ++i) { acc[i] += ALPHA * x[i]; s += acc[i]; }
    const float mean = wave_sum(s) * (1.f / 1024.f); float s2 = 0.f;
#pragma unroll
    for (int i = 0; i < 16; ++i) { acc[i] -= mean; s2 += acc[i] * acc[i]; }
    const float rstd = 1.f / sqrtf(wave_sum(s2) * (1.f / 1024.f) + LN_EPS);
    float* yo = m < NP ? F.out + OUT_YP + (size_t)m * 1024 : F.out + OUT_YS + (size_t)(m - NP) * 1024;
#pragma unroll
    for (int q4 = 0; q4 < 4; ++q4) { const int c = (q4 >> 1) * 512 + 8 * lane + (q4 & 1) * 4; const f32x4 gg = *(const f32x4*)(l2g + c), bb = *(const f32x4*)(l2b + c);
        *(f32x4*)(yo + c) = (f32x4){acc[4 * q4] * rstd * gg[0] + bb[0], acc[4 * q4 + 1] * rstd * gg[1] + bb[1], acc[4 * q4 + 2] * rstd * gg[2] + bb[2], acc[4 * q4 + 3] * rstd * gg[3] + bb[3]}; }
}

struct Args { const float* in[22]; float* out; unsigned char* ws; int ph_lo, ph_hi; };
constexpr int NPHASE = 10;
__global__ void __launch_bounds__(NTHR, 2) mk_fwd(Args args) {
    extern __shared__ __attribute__((aligned(16))) unsigned char lds[];
    Frame F;
    F.lds = (LAS unsigned char*)lds; F.MISC = (volatile LAS unsigned*)(F.lds + MISC_OFF);
    F.tid = threadIdx.x; F.lane = F.tid & 63; F.wave = __builtin_amdgcn_readfirstlane(F.tid >> 6); F.G = gridDim.x;
    F.ws = args.ws; F.out = args.out; F.ctl = (gu32*)(args.ws + WS_CTL);
    for (int u = F.tid; u < (LDS_BYTES - MISC_OFF) / 4; u += NTHR) ((LAS unsigned*)(F.lds + MISC_OFF))[u] = 0u;
    __syncthreads();
    if (F.tid < 22) ((LAS unsigned long long*)(F.lds + PTR_OFF))[F.tid] = (unsigned long long)args.in[F.tid];
    __syncthreads();
    const int lo = args.ph_lo, hi = args.ph_hi;
    const bool multi = (hi - lo) > 1;
    XcdBarrier bar; bar.bar = (unsigned*)(F.ctl + CW_BAR); bar.x = 0; bar.st = nullptr;
    if (multi) bar = xcd_barrier_post((unsigned*)(F.ctl + CW_BAR), F.MISC + 8);
#ifdef ONLY_PHASE
#define IN(k) ((k) == ONLY_PHASE && lo <= (k) && (k) < hi)
#else
#define IN(k) (lo <= (k) && (k) < hi)
#endif
#define SEAM(k) do { if (IN(k) && IN((k) + 1)) xcd_barrier(bar); } while (0)
    if (IN(0)) { p0_prologue(F); }
    if (IN(0) && IN(1)) { cooperative_groups::this_grid().sync(); }
    if (IN(1)) {
        pg8::Gemm g{WSP(bf16, WS_XB), WSP(bf16, WS_WIN), MPAD, NPROJ, 1024}; pg8::StaticOrder S; S.init(MPAD, NPROJ, F.G, (int)blockIdx.x);
        pg8::EpiProj E{WSP(bf16, WS_QA), WSP(bf16, WS_KA), WSP(bf16, WS_VA), WSP(bf16, WS_QB), WSP(bf16, WS_KB), WSP(bf16, WS_VB), WSP(bf16, WS_RB), WSP(bf16, WS_GA), WSP(bf16, WS_GB)};
        pg8::gemm_phase<pg8::EpiProj, pg8::StaticOrder, true, true>(F.lds, g, S, E);
    } SEAM(1);
    if (IN(2)) { p2_mixers(F); } SEAM(2);
    if (IN(3)) { p3_merge(F); } SEAM(3);
    if (IN(4)) {
        { pg8::Gemm g{WSP(bf16, WS_OAM), WSP(bf16, WS_WA), MPAD, 1024, 512}; pg8::StaticOrder S; S.init(MPAD, 1024, F.G, (int)blockIdx.x);
          pg8::EpiGate<false> E{WSP(bf16, WS_GA), nullptr, WSP(bf16, WS_T1)};
          pg8::gemm_phase<pg8::EpiGate<false>, pg8::StaticOrder, true, true>(F.lds, g, S, E); }
        VM_WAIT(); __syncthreads();
        { pg8::Gemm g{WSP(bf16, WS_OBN), WSP(bf16, WS_WB), MPAD, 1024, 1024}; pg8::StaticOrder S; S.init(MPAD, 1024, F.G, (int)blockIdx.x);
          pg8::EpiGate<true> E{WSP(bf16, WS_GB), WSP(bf16, WS_T1), WSP(bf16, WS_MIX)};
          pg8::gemm_phase<pg8::EpiGate<true>, pg8::StaticOrder, true, true>(F.lds, g, S, E); }
    } SEAM(4);
    if (IN(5)) {
        pg8::Gemm g{WSP(bf16, WS_MIX), WSP(bf16, WS_WO), MPAD, 1024, 1024}; pg8::StaticOrder S; S.init(MPAD, 1024, F.G, (int)blockIdx.x);
        pg8::EpiOut E{inptr(F, I_XP), inptr(F, I_XS), WSP(float, WS_H), NP, NTOK, ALPHA};
        pg8::gemm_phase<pg8::EpiOut, pg8::StaticOrder, true, true>(F.lds, g, S, E);
    } SEAM(5);
    if (IN(6)) { p6_ln1(F); } SEAM(6);
    if (IN(7)) {
        pg8::Gemm g{WSP(bf16, WS_X1B), WSP(bf16, WS_WQ), MPAD, 2048, 1024}; pg8::StaticOrder S; S.init(MPAD, 2048, F.G, (int)blockIdx.x);
        pg8::EpiHeadNorm E{WSP(bf16, WS_QN), 2048, F.lds + STATS_OFF, LN_EPS};
        pg8::gemm_phase<pg8::EpiHeadNorm, pg8::StaticOrder, true, true>(F.lds, g, S, E);
    } SEAM(7);
    if (IN(8)) { const int gw = blockIdx.x * NWAVES + F.wave, NGW = F.G * NWAVES; for (int it = gw; it < (MPAD / 32) * 8; it += NGW) p8_topk_item(F, it); } SEAM(8);
    if (IN(9)) { const int gw = blockIdx.x * NWAVES + F.wave, NGW = F.G * NWAVES; const float* l2g = inptr(F, I_L2G); const float* l2b = inptr(F, I_L2B); for (int m = gw; m < NTOK; m += NGW) p9_token(F, m, l2g, l2b); }
#undef IN
#undef SEAM
}

extern "C" void kernel_launch(void* const* d_in, const int* in_sizes, int n_in, void* d_out, int out_size, void* d_ws, size_t ws_size, hipStream_t stream) {
    static int grid = 0;
    if (grid == 0) {
        if (n_in != 22 || (size_t)out_size != OUT_TOTAL || ws_size < WS_END) { fprintf(stderr, "kernel_launch: unexpected shapes: n_in %d out %d ws %zu (need >= %zu)\n", n_in, out_size, ws_size, (size_t)WS_END); grid = -1; return; }
        int dev = 0, cus = 0, per_cu = 0;
        if (hipGetDevice(&dev) != hipSuccess || hipDeviceGetAttribute(&cus, hipDeviceAttributeMultiprocessorCount, dev) != hipSuccess) { grid = -1; return; }
        if (hipFuncSetAttribute((const void*)mk_fwd, hipFuncAttributeMaxDynamicSharedMemorySize, LDS_BYTES) != hipSuccess) { fprintf(stderr, "kernel_launch: hipFuncSetAttribute failed\n"); grid = -1; return; }
        if (hipOccupancyMaxActiveBlocksPerMultiprocessor(&per_cu, (const void*)mk_fwd, NTHR, LDS_BYTES) != hipSuccess || per_cu < 1) fprintf(stderr, "kernel_launch: occupancy query reports %d blocks per CU\n", per_cu);
        (void)hipGetLastError();
        grid = cus;
    }
    if (grid < 0) return;
    (void)hipMemsetAsync((char*)d_ws + WS_CTL, 0, CTL_ZERO_BYTES, stream);
    Args a{};
    for (int i = 0; i < 22; ++i) a.in[i] = (const float*)d_in[i];
    a.out = (float*)d_out; a.ws = (unsigned char*)d_ws;
#if MK_SINGLE
    a.ph_lo = 0; a.ph_hi = NPHASE;
    void* kargs[] = {&a};
    hipError_t e = hipLaunchCooperativeKernel((const void*)mk_fwd, dim3(grid), dim3(NTHR), kargs, LDS_BYTES, stream);
    if (e != hipSuccess) fprintf(stderr, "kernel_launch: cooperative launch failed: %s\n", hipGetErrorString(e));
#else
    for (int p = 0; p < NPHASE; ++p) { a.ph_lo = p; a.ph_hi = p + 1; hipLaunchKernelGGL(mk_fwd, dim3(grid), dim3(NTHR), LDS_BYTES, stream, a); }
#endif
}
```

```cpp
#include <hip/hip_runtime.h>
#include <hip/hip_cooperative_groups.h>
#include <cstdio>
#include <cstdint>
#ifndef MK_SINGLE
#define MK_SINGLE 1
#endif
namespace pg8 {
#define PG8_LAS __attribute__((address_space(3)))
typedef unsigned short bf16_t;
typedef short bf16x8 __attribute__((ext_vector_type(8)));
typedef float f32x4 __attribute__((ext_vector_type(4)));
typedef unsigned u32x4 __attribute__((ext_vector_type(4)));
constexpr int BM = 256, BK = 64, HALF = 128, HTB = HALF * BK * 2  , STAGE_BYTES = 8 * HTB, NXCD = 8, WGM = 8;

__host__ __device__ __forceinline__ int lds_byte(int r, int c) { const int st = (r >> 4) * 2 + (c >> 5), rr = r & 15, cc = c & 31, ob = rr * 64 + cc * 2; return st * 1024 + (ob ^ (((ob >> 9) & 1) << 5)); }
__host__ __device__ __forceinline__ void stage_rc(int b, int& R, int& C) { const int st = b / 1024, sb = b % 1024, swz = sb ^ (((sb >> 9) & 1) << 5); R = (st >> 1) * 16 + swz / 64; C = (st & 1) * 32 + (swz % 64) / 2; }
__host__ __device__ __forceinline__ int perm32(int rho) { const int n = rho >> 4, i = rho & 15; return 8 * (i >> 2) + 4 * n + (i & 3); }

struct Unit { int pm, pn; };
struct Gemm { const bf16_t* A; const bf16_t* Bt; int M, N, K; int half_pm = -1; };

struct StaticOrder {
    int nM, nN, nwg, G, c, nfull;
    __host__ __device__ void init(int M, int N, int G_, int c_, bool half = true) { nM = half ? M / BM - 1 : M / BM; nN = N / BM; nfull = nM * nN; nwg = half ? nfull + nN : nfull; G = G_; c = c_; }
    __host__ __device__ bool next(int i, Unit& u) const {
        const long L = (long)i * G + c; if (L >= nwg) return false;
        if (L >= nfull) { u.pm = nM; u.pn = (int)(L - nfull); return true; }
        int wgid = (int)L; { const int q = nfull / NXCD, r = nfull % NXCD, xcd = wgid % NXCD, off = wgid / NXCD; wgid = (xcd < r ? xcd * (q + 1) : r * (q + 1) + (xcd - r) * q) + off; }
        const int nig = WGM * nN, gid = wgid / nig, fm = gid * WGM, gsz = (nM - fm) < WGM ? (nM - fm) : WGM;
        u.pm = fm + ((wgid % nig) % gsz); u.pn = (wgid % nig) / gsz; return true;
    }
    __device__ __forceinline__ void a_ready(const Unit&) const {}
    __device__ __forceinline__ void done(const Unit&) const {}
};


typedef float f32x2 __attribute__((ext_vector_type(2)));
typedef __bf16 bf16x2_t __attribute__((ext_vector_type(2)));
__device__ __forceinline__ unsigned cvt_pk_bf16(float lo, float hi) { f32x2 v = {lo, hi}; bf16x2_t b = __builtin_convertvector(v, bf16x2_t); return __builtin_bit_cast(unsigned, b); }
__device__ __forceinline__ float bf_lo(unsigned w) { return __uint_as_float(w << 16); }
__device__ __forceinline__ float bf_hi(unsigned w) { return __uint_as_float(w & 0xffff0000u); }
__device__ __forceinline__ float sigmoidf_(float x) { return __builtin_amdgcn_rcpf(1.0f + __expf(-x)); }

struct EpiProj {
    static constexpr bool PERM = true, AFTER_DRAIN = false;
    bf16_t *qa, *ka, *va, *qb, *kb, *vb, *rb, *ga, *gb;
    __device__ __forceinline__ void operator()(const f32x4 (&acc)[2][2][4][2], const Unit& u, int wr, int wc, int fr, int fq) const {
        const int pn = u.pn; bf16_t* base; int ldc, ct; float sc = 1.f;
        if (pn < 6) { base = qa; ldc = 1536; ct = pn; sc = 0.125f; }
        else if (pn < 12) { base = ka; ldc = 1536; ct = pn - 6; }
        else if (pn < 18) { base = va; ldc = 1536; ct = pn - 12; }
        else if (pn < 20) { base = qb; ldc = 512; ct = pn - 18; }
        else if (pn < 22) { base = kb; ldc = 512; ct = pn - 20; }
        else if (pn < 26) { base = vb; ldc = 1024; ct = pn - 22; }
        else if (pn < 30) { base = rb; ldc = 1024; ct = pn - 26; }
        else if (pn < 34) { base = ga; ldc = 1024; ct = pn - 30; }
        else { base = gb; ldc = 1024; ct = pn - 34; }
        const int row0 = u.pm * BM + wr * 64 + fr, col0 = ct * BM + wc * 32 + 8 * fq;
#pragma unroll
        for (int ai = 0; ai < 2; ++ai)
#pragma unroll
            for (int m = 0; m < 4; ++m) { bf16_t* rowp = base + (size_t)(row0 + ai * HALF + m * 16) * ldc + col0;
#pragma unroll
                for (int bj = 0; bj < 2; ++bj) { const f32x4 v0 = acc[ai][bj][m][0] * sc, v1 = acc[ai][bj][m][1] * sc;
                    u32x4 w; w.x = cvt_pk_bf16(v0[0], v0[1]); w.y = cvt_pk_bf16(v0[2], v0[3]); w.z = cvt_pk_bf16(v1[0], v1[1]); w.w = cvt_pk_bf16(v1[2], v1[3]);
                    *(u32x4*)(rowp + bj * HALF) = w; } }
    }
};
template <bool ADD> struct EpiGate {
    static constexpr bool PERM = true, AFTER_DRAIN = false;
    const bf16_t* G; const bf16_t* T1; bf16_t* O;
    __device__ __forceinline__ void operator()(const f32x4 (&acc)[2][2][4][2], const Unit& u, int wr, int wc, int fr, int fq) const {
        const int row0 = u.pm * BM + wr * 64 + fr, col0 = u.pn * BM + wc * 32 + 8 * fq;
#pragma unroll
        for (int ai = 0; ai < 2; ++ai)
#pragma unroll
            for (int m = 0; m < 4; ++m) { const size_t off = (size_t)(row0 + ai * HALF + m * 16) * 1024 + col0;
#pragma unroll
                for (int bj = 0; bj < 2; ++bj) {
                    const u32x4 g = *(const u32x4*)(G + off + bj * HALF);
                    f32x4 v0 = acc[ai][bj][m][0], v1 = acc[ai][bj][m][1];
                    v0[0] *= sigmoidf_(bf_lo(g.x)); v0[1] *= sigmoidf_(bf_hi(g.x)); v0[2] *= sigmoidf_(bf_lo(g.y)); v0[3] *= sigmoidf_(bf_hi(g.y));
                    v1[0] *= sigmoidf_(bf_lo(g.z)); v1[1] *= sigmoidf_(bf_hi(g.z)); v1[2] *= sigmoidf_(bf_lo(g.w)); v1[3] *= sigmoidf_(bf_hi(g.w));
                    if (ADD) { const u32x4 t = *(const u32x4*)(T1 + off + bj * HALF);
                        v0[0] += bf_lo(t.x); v0[1] += bf_hi(t.x); v0[2] += bf_lo(t.y); v0[3] += bf_hi(t.y);
                        v1[0] += bf_lo(t.z); v1[1] += bf_hi(t.z); v1[2] += bf_lo(t.w); v1[3] += bf_hi(t.w); }
                    u32x4 w; w.x = cvt_pk_bf16(v0[0], v0[1]); w.y = cvt_pk_bf16(v0[2], v0[3]); w.z = cvt_pk_bf16(v1[0], v1[1]); w.w = cvt_pk_bf16(v1[2], v1[3]);
                    *(u32x4*)(O + off + bj * HALF) = w; } }
    }
};
struct EpiOut {
    static constexpr bool PERM = false, AFTER_DRAIN = false;
    const float* xp; const float* xs; float* H; int np, ntok; float alpha;
    __device__ __forceinline__ void operator()(const f32x4 (&acc)[2][2][4][2], const Unit& u, int wr, int wc, int fr, int fq) const {
        const int row0 = u.pm * BM + wr * 64 + fr, col0 = u.pn * BM + wc * 32 + 4 * fq;
#pragma unroll
        for (int ai = 0; ai < 2; ++ai)
#pragma unroll
            for (int m = 0; m < 4; ++m) { const int r = row0 + ai * HALF + m * 16;
                const float* xr = r < np ? xp + (size_t)r * 1024 : xs + (size_t)(r < ntok ? r - np : 0) * 1024; const bool real = r < ntok;
#pragma unroll
                for (int bj = 0; bj < 2; ++bj)
#pragma unroll
                    for (int n = 0; n < 2; ++n) { const int c = col0 + bj * HALF + n * 16;
                        f32x4 xv = *(const f32x4*)(xr + c); if (!real) xv = (f32x4){0.f, 0.f, 0.f, 0.f};
                        *(f32x4*)(H + (size_t)r * 1024 + c) = xv * alpha + acc[ai][bj][m][n]; } }
    }
};
struct EpiHeadNorm {
    static constexpr bool PERM = true, AFTER_DRAIN = false;
    bf16_t* O; int ldc; PG8_LAS unsigned char* st; float eps;
    __device__ __forceinline__ void operator()(const f32x4 (&acc)[2][2][4][2], const Unit& u, int wr, int wc, int fr, int fq) const {
        PG8_LAS f32x2* P = (PG8_LAS f32x2*)st; PG8_LAS f32x2* S = (PG8_LAS f32x2*)(st + 8192);
        const int lane = fq * 16 + fr, wid = wr * 4 + wc;
#pragma unroll
        for (int ai = 0; ai < 2; ++ai)
#pragma unroll
            for (int m = 0; m < 4; ++m) {
                float s = 0.f;
#pragma unroll
                for (int bj = 0; bj < 2; ++bj)
#pragma unroll
                    for (int n = 0; n < 2; ++n) { const f32x4 x = acc[ai][bj][m][n]; s += (x[0] + x[1]) + (x[2] + x[3]); }
                s += __shfl_xor(s, 16); s += __shfl_xor(s, 32);
                const float mw = s * (1.0f / 64.0f); float q = 0.f;
#pragma unroll
                for (int bj = 0; bj < 2; ++bj)
#pragma unroll
                    for (int n = 0; n < 2; ++n) { const f32x4 d = acc[ai][bj][m][n] - mw; q += (d[0] * d[0] + d[1] * d[1]) + (d[2] * d[2] + d[3] * d[3]); }
                q += __shfl_xor(q, 16); q += __shfl_xor(q, 32);
                if (fq == 0) P[(ai * HALF + wr * 64 + m * 16 + fr) * 4 + wc] = (f32x2){mw, q};
            }
        asm volatile("s_waitcnt lgkmcnt(0)" ::: "memory"); __builtin_amdgcn_s_barrier(); asm volatile("" ::: "memory");
        const int row = wid * 32 + (lane & 31);
        if (lane < 32) {
            const f32x2 a = P[row * 4 + 0], b = P[row * 4 + 1], c = P[row * 4 + 2], d = P[row * 4 + 3];
            const float mt = (a.x + b.x + c.x + d.x) * 0.25f;
            const float da = a.x - mt, db = b.x - mt, dc = c.x - mt, dd = d.x - mt;
            const float m2 = (a.y + b.y) + (c.y + d.y) + 64.0f * ((da * da + db * db) + (dc * dc + dd * dd));
            S[row] = (f32x2){mt, 1.0f / sqrtf(m2 * (1.0f / 256.0f) + eps)};
        }
        asm volatile("s_waitcnt lgkmcnt(0)" ::: "memory"); __builtin_amdgcn_s_barrier(); asm volatile("" ::: "memory");
        const int row0 = u.pm * BM + wr * 64 + fr, col0 = u.pn * BM + wc * 32 + 8 * fq;
#pragma unroll
        for (int ai = 0; ai < 2; ++ai)
#pragma unroll
            for (int m = 0; m < 4; ++m) { const f32x2 sr = S[ai * HALF + wr * 64 + m * 16 + fr]; bf16_t* rowp = O + (size_t)(row0 + ai * HALF + m * 16) * ldc + col0;
#pragma unroll
                for (int bj = 0; bj < 2; ++bj) { const f32x4 v0 = (acc[ai][bj][m][0] - sr.x) * sr.y, v1 = (acc[ai][bj][m][1] - sr.x) * sr.y;
                    u32x4 w; w.x = cvt_pk_bf16(v0[0], v0[1]); w.y = cvt_pk_bf16(v0[2], v0[3]); w.z = cvt_pk_bf16(v1[0], v1[1]); w.w = cvt_pk_bf16(v1[2], v1[3]);
                    *(u32x4*)(rowp + bj * HALF) = w; } }
    }
};

template <class Epi, class Sched, bool ALIGN_EPI = false, bool SP2 = false>
__device__ __forceinline__ void gemm_phase(PG8_LAS unsigned char* lds, const Gemm g, const Sched& S, const Epi& E) {
    const int tid = threadIdx.x, wid = __builtin_amdgcn_readfirstlane(tid >> 6), lane = tid & 63, wr = wid >> 2, wc = wid & 3, fr = lane & 15, fq = lane >> 4;
    const int K = g.K, nt = K / BK;
    unsigned voffA[2], voffB[2];
#pragma unroll
    for (int i = 0; i < 2; ++i) { int R, C; stage_rc(tid * 16 + i * 8192, R, C); const int Rb = Epi::PERM ? ((R & ~31) + perm32(R & 31)) : R;
        voffA[i] = (unsigned)(R * K + C) * 2u; voffB[i] = (unsigned)(Rb * K + C) * 2u; }
    const size_t kstep = (size_t)(BK * 2);
    const size_t hstep = (size_t)HALF * K * 2;
    const size_t tstep = 2 * hstep;
    const unsigned ldsw = (unsigned)wid * 1024u;
    const int aoff = lds_byte(wr * 64 + fr, fq * 8), boff = lds_byte(wc * 32 + fr, fq * 8);
#define PG8_SA(b, h) (((b) * 2 + (h)) * HTB)
#define PG8_SB(b, h) ((4 + (b) * 2 + (h)) * HTB)
#define PG8_STAGE(bufoff, gbase, voff) do { _Pragma("unroll") for (int _i = 0; _i < 2; ++_i) \
        __builtin_amdgcn_global_load_lds((const unsigned*)((const char*)(gbase) + (voff)[_i]), (PG8_LAS unsigned*)(lds + (bufoff) + ldsw + _i * 8192), 16, 0, 0); } while (0)
#define PG8_LDA(dst, b, h) do { _Pragma("unroll") for (int m = 0; m < 4; ++m) _Pragma("unroll") for (int k = 0; k < 2; ++k) dst[m][k] = *(const PG8_LAS bf16x8*)(lds + PG8_SA(b, h) + aoff + m * 2048 + k * 1024); } while (0)
#define PG8_LDB(dst, b, h) do { _Pragma("unroll") for (int n = 0; n < 2; ++n) _Pragma("unroll") for (int k = 0; k < 2; ++k) dst[n][k] = *(const PG8_LAS bf16x8*)(lds + PG8_SB(b, h) + boff + n * 2048 + k * 1024); } while (0)
#define PG8_MMA(ai, bj, At, Bt) do { __builtin_amdgcn_s_setprio(1); _Pragma("unroll") for (int m = 0; m < 4; ++m) _Pragma("unroll") for (int n = 0; n < 2; ++n) _Pragma("unroll") for (int k = 0; k < 2; ++k) \
        acc[ai][bj][m][n] = __builtin_amdgcn_mfma_f32_16x16x32_bf16(Bt[n][k], At[m][k], acc[ai][bj][m][n], 0, 0, 0); __builtin_amdgcn_s_setprio(0); } while (0)
#define PG8_WAIT_V(n) asm volatile("s_waitcnt vmcnt(" #n ")" ::: "memory")
#define PG8_WAIT_L(n) asm volatile("s_waitcnt lgkmcnt(" #n ")" ::: "memory")
#define PG8_BAR __builtin_amdgcn_s_barrier()
#define PG8_SCHED __builtin_amdgcn_sched_barrier(0)
    Unit cur, nxt; int ui = 0;
    if (!S.next(0, cur)) return;
    f32x4 acc[2][2][4][2];
#pragma unroll
    for (int a = 0; a < 2; ++a)
#pragma unroll
        for (int b = 0; b < 2; ++b)
#pragma unroll
            for (int m = 0; m < 4; ++m)
#pragma unroll
                for (int n = 0; n < 2; ++n) acc[a][b][m][n] = (f32x4){0.f, 0.f, 0.f, 0.f};
    bf16x8 At[4][2], B0[2][2], B1[2][2];
    const char* cA = (const char*)g.A + (size_t)cur.pm * tstep; const char* cB = (const char*)g.Bt + (size_t)cur.pn * tstep;
    S.a_ready(cur);
    if constexpr (SP2) {
        PG8_STAGE(PG8_SB(0, 0), cB, voffB); PG8_STAGE(PG8_SB(0, 1), cB + hstep, voffB); PG8_STAGE(PG8_SA(0, 0), cA, voffA); PG8_STAGE(PG8_SA(0, 1), cA + hstep, voffA);
        if (wr == 1) PG8_BAR;
        PG8_WAIT_V(2); PG8_BAR;
        PG8_STAGE(PG8_SB(1, 0), cB + kstep, voffB); PG8_STAGE(PG8_SA(1, 0), cA + kstep, voffA); PG8_STAGE(PG8_SB(1, 1), cB + hstep + kstep, voffB);
        PG8_WAIT_V(6); PG8_BAR;
    } else {
        PG8_STAGE(PG8_SB(0, 0), cB, voffB); PG8_STAGE(PG8_SA(0, 0), cA, voffA); PG8_STAGE(PG8_SB(0, 1), cB + hstep, voffB); PG8_STAGE(PG8_SA(0, 1), cA + hstep, voffA);
        if (wr == 1) PG8_BAR;
        PG8_WAIT_V(4); PG8_BAR;
        PG8_STAGE(PG8_SB(1, 0), cB + kstep, voffB); PG8_STAGE(PG8_SA(1, 0), cA + kstep, voffA); PG8_STAGE(PG8_SB(1, 1), cB + hstep + kstep, voffB);
        PG8_WAIT_V(6); PG8_BAR;
    }
    for (;;) {
        const bool has_next = S.next(ui + 1, nxt);
        const bool skip1 = __builtin_amdgcn_readfirstlane((int)(cur.pm == g.half_pm)) != 0;
        const char* nA = has_next ? (const char*)g.A + (size_t)nxt.pm * tstep : cA; const char* nB = has_next ? (const char*)g.Bt + (size_t)nxt.pn * tstep : cB;
        for (int t = 0; t < nt; t += 2) {
            const bool last = (t == nt - 2);
            const char* a1 = cA + (size_t)(t + 1) * kstep;
            const char* a2 = last ? nA : cA + (size_t)(t + 2) * kstep; const char* b2 = last ? nB : cB + (size_t)(t + 2) * kstep;
            const char* a3 = a2 + kstep; const char* b3 = b2 + kstep;
            if (last && has_next) S.a_ready(nxt);
            if constexpr (SP2) {
            PG8_LDB(B0, 0, 0); PG8_LDB(B1, 0, 1); PG8_SCHED; PG8_LDA(At, 0, 0); PG8_STAGE(PG8_SA(1, 1), a1 + hstep, voffA);
            PG8_WAIT_V(8); PG8_WAIT_L(0); PG8_BAR; PG8_MMA(0, 0, At, B0); PG8_MMA(0, 1, At, B1); PG8_BAR; PG8_SCHED;
            PG8_LDA(At, 0, 1); PG8_STAGE(PG8_SB(0, 0), b2, voffB); PG8_STAGE(PG8_SB(0, 1), b2 + hstep, voffB); PG8_STAGE(PG8_SA(0, 0), a2, voffA);
            PG8_WAIT_V(8); PG8_WAIT_L(0); PG8_BAR; if (!skip1) { PG8_MMA(1, 0, At, B0); PG8_MMA(1, 1, At, B1); } PG8_BAR; PG8_SCHED;
            PG8_LDB(B0, 1, 0); PG8_LDB(B1, 1, 1); PG8_SCHED; PG8_LDA(At, 1, 0); PG8_STAGE(PG8_SA(0, 1), a2 + hstep, voffA);
            PG8_WAIT_V(8); PG8_WAIT_L(0); PG8_BAR; PG8_MMA(0, 0, At, B0); PG8_MMA(0, 1, At, B1); PG8_BAR; PG8_SCHED;
            PG8_LDA(At, 1, 1); PG8_STAGE(PG8_SB(1, 0), b3, voffB); PG8_STAGE(PG8_SB(1, 1), b3 + hstep, voffB); PG8_STAGE(PG8_SA(1, 0), a3, voffA);
            PG8_WAIT_V(8); PG8_WAIT_L(0); PG8_BAR; if (!skip1) { PG8_MMA(1, 0, At, B0); PG8_MMA(1, 1, At, B1); } PG8_BAR; PG8_SCHED;
            } else {
            PG8_LDB(B0, 0, 0); PG8_SCHED; PG8_LDA(At, 0, 0); PG8_STAGE(PG8_SA(1, 1), a1 + hstep, voffA);
            PG8_WAIT_L(8); PG8_BAR; PG8_WAIT_L(0); PG8_MMA(0, 0, At, B0); PG8_BAR; PG8_SCHED;
            PG8_LDB(B1, 0, 1); PG8_STAGE(PG8_SB(0, 0), b2, voffB);
            PG8_BAR; PG8_WAIT_L(0); PG8_MMA(0, 1, At, B1); PG8_BAR;
            PG8_LDA(At, 0, 1); PG8_STAGE(PG8_SA(0, 0), a2, voffA);
            PG8_BAR; PG8_WAIT_L(0); PG8_MMA(1, 0, At, B0); PG8_BAR; PG8_SCHED;
            PG8_STAGE(PG8_SB(0, 1), b2 + hstep, voffB);
            PG8_WAIT_V(6); PG8_BAR; PG8_MMA(1, 1, At, B1); PG8_BAR;
            PG8_LDB(B0, 1, 0); PG8_SCHED; PG8_LDA(At, 1, 0); PG8_STAGE(PG8_SA(0, 1), a2 + hstep, voffA);
            PG8_WAIT_L(8); PG8_BAR; PG8_WAIT_L(0); PG8_MMA(0, 0, At, B0); PG8_BAR; PG8_SCHED;
            PG8_LDB(B1, 1, 1); PG8_STAGE(PG8_SB(1, 0), b3, voffB);
            PG8_BAR; PG8_WAIT_L(0); PG8_MMA(0, 1, At, B1); PG8_BAR;
            PG8_LDA(At, 1, 1); PG8_STAGE(PG8_SA(1, 0), a3, voffA);
            PG8_BAR; PG8_WAIT_L(0); PG8_MMA(1, 0, At, B0); PG8_BAR; PG8_SCHED;
            PG8_STAGE(PG8_SB(1, 1), b3 + hstep, voffB);
            PG8_WAIT_V(6); PG8_BAR; PG8_MMA(1, 1, At, B1); PG8_BAR;
            }
        }
        if constexpr (ALIGN_EPI) { if (wr == 0) PG8_BAR; }
        if constexpr (!Epi::AFTER_DRAIN) { E(acc, cur, wr, wc, fr, fq); S.done(cur); }
        if (!has_next) break;
#pragma unroll
        for (int a = 0; a < 2; ++a)
#pragma unroll
            for (int b = 0; b < 2; ++b)
#pragma unroll
                for (int m = 0; m < 4; ++m)
#pragma unroll
                    for (int n = 0; n < 2; ++n) acc[a][b][m][n] = (f32x4){0.f, 0.f, 0.f, 0.f};
        cur = nxt; cA = nA; cB = nB; ++ui;
        if constexpr (ALIGN_EPI) { if (wr == 1) PG8_BAR; }
    }
    PG8_WAIT_V(0);
    if constexpr (!ALIGN_EPI) { if (wr == 0) PG8_BAR; }
    PG8_BAR;
    if constexpr (Epi::AFTER_DRAIN) { E.fused(acc, cur, wr, wc, fr, fq, lds, wid, lane); S.done(cur); }
#undef PG8_SA
#undef PG8_SB
#undef PG8_STAGE
#undef PG8_LDA
#undef PG8_LDB
#undef PG8_MMA
#undef PG8_WAIT_V
#undef PG8_WAIT_L
#undef PG8_BAR
#undef PG8_SCHED
}
}

constexpr int NWAVES = 8, NTHR = 512;
constexpr int DM = 1024, TSEQ = 4096, NP = 32768, NS = 128, NTOK = NP + NS, MPAD = 33024;
constexpr int INW = 9744, NPROJ = 9728, ABCOL = 6656;
constexpr float LN_EPS = 1e-5f, ALPHA = 1.189207115002721f, GLA_QSCALE = 0.08838834764831845f, NEG_BIG = -1e30f;
constexpr size_t OUT_YP = 0, OUT_YS = 33554432, OUT_KVP1 = 33685504, OUT_KVP2 = 34734080, OUT_KVP3 = 38928384, OUT_STP = 55705600,
                 OUT_KVS1 = 56754176, OUT_KVS2 = 60948480, OUT_KVS3 = 77725696, OUT_STS = 144834560, OUT_TOTAL = 149028864;
constexpr size_t MiB = 1u << 20;
constexpr size_t WS_CTL = 0, CTL_ZERO_BYTES = 1 * MiB;
constexpr size_t WS_KEYS = 1 * MiB, WS_LUT = WS_KEYS + 512 * 1024;
constexpr size_t WS_WA = 2 * MiB, WS_WB = 3 * MiB, WS_WO = 5 * MiB, WS_WQ = 7 * MiB, WS_WIN = 11 * MiB;
constexpr size_t WS_AB = 31 * MiB, WS_UT = 34 * MiB, WS_VT = 66 * MiB, WS_XB = 98 * MiB;
constexpr size_t WS_QA = 163 * MiB, WS_KA = 260 * MiB, WS_VA = 357 * MiB, WS_QB = 454 * MiB, WS_KB = 487 * MiB, WS_VB = 520 * MiB;
constexpr size_t WS_RB = 585 * MiB, WS_GA = 650 * MiB, WS_GB = 715 * MiB, WS_LSE = 780 * MiB, WS_OAM = 784 * MiB, WS_OBN = 817 * MiB, WS_H = 882 * MiB, WS_END = 1011 * MiB;
constexpr size_t WS_T1 = WS_KA, WS_MIX = WS_VA, WS_X1B = WS_QA, WS_QN = WS_RB, WS_EIDX = WS_GB, WS_GATE = WS_GB + 17 * MiB;
static_assert(WS_WIN + (size_t)NPROJ * 1024 * 2 <= WS_AB && WS_AB + (size_t)MPAD * 16 * 4 <= WS_UT && WS_XB + (size_t)MPAD * 1024 * 2 <= WS_QA, "ws map 1");
static_assert(WS_QA + (size_t)MPAD * 1536 * 2 <= WS_KA && WS_QB + (size_t)MPAD * 512 * 2 <= WS_KB && WS_VB + (size_t)MPAD * 1024 * 2 <= WS_RB, "ws map 2");
static_assert(WS_LSE + (size_t)3 * MPAD * 8 * 4 <= WS_OAM && WS_OAM + (size_t)MPAD * 512 * 2 <= WS_OBN && WS_OBN + (size_t)MPAD * 1024 * 2 <= WS_H && WS_H + (size_t)MPAD * 1024 * 4 <= WS_END, "ws map 3");
static_assert(WS_QN + (size_t)MPAD * 2048 * 2 <= WS_GB && WS_EIDX + (size_t)MPAD * 128 * 4 <= WS_GATE && WS_GATE + (size_t)MPAD * 128 * 4 <= WS_LSE, "ws map 4");
constexpr int CW_QUEUE = 64;
constexpr int CW_CPYQ = 128;
constexpr int CW_GDONE = 192;
constexpr int NCOPYWG = 10;
constexpr int CW_BAR = 4096;
constexpr int RING_BYTES = 131072, STATS_OFF = RING_BYTES, MISC_OFF = STATS_OFF + 10240 + 320, LDS_BYTES = 147456;
static_assert(MISC_OFF + 128 + 22 * 8 <= LDS_BYTES, "LDS map");

#define GAS __attribute__((address_space(1)))
#define LAS __attribute__((address_space(3)))
typedef unsigned short bf16;
typedef unsigned v4u __attribute__((ext_vector_type(4)));
typedef unsigned v2u __attribute__((ext_vector_type(2)));
typedef float f32x4 __attribute__((ext_vector_type(4)));
typedef float f32x16 __attribute__((ext_vector_type(16)));
typedef short bf16x8 __attribute__((ext_vector_type(8)));
typedef short s16x4 __attribute__((ext_vector_type(4)));
typedef GAS unsigned gu32;
#define RLX_AGENT __ATOMIC_RELAXED, __HIP_MEMORY_SCOPE_AGENT
#define LDS_WAIT() asm volatile("s_waitcnt lgkmcnt(0)" ::: "memory")
#define VM_WAIT() asm volatile("s_waitcnt vmcnt(0)" ::: "memory")
#define MFMA32(a, b, c) __builtin_amdgcn_mfma_f32_32x32x16_bf16((a), (b), (c), 0, 0, 0)
using pg8::cvt_pk_bf16; using pg8::bf_lo; using pg8::bf_hi;
__device__ __forceinline__ unsigned short f2bf(float f) { return (unsigned short)(cvt_pk_bf16(f, 0.f) & 0xffffu); }
__device__ __forceinline__ float bf2f(unsigned short h) { return __uint_as_float((unsigned)h << 16); }
__device__ __forceinline__ int crow(int reg, int hh) { return (reg & 3) + 8 * (reg >> 2) + 4 * hh; }
__device__ __forceinline__ float wave_sum(float v) {
#pragma unroll
    for (int o = 1; o < 64; o <<= 1) v += __shfl_xor(v, o);
    return v;
}
__device__ __forceinline__ float wave_max(float v) {
#pragma unroll
    for (int o = 1; o < 64; o <<= 1) v = fmaxf(v, __shfl_xor(v, o));
    return v;
}
__device__ __forceinline__ bf16x8 frag_row(const LAS unsigned char* T, int stride, int r0, int k0, int lane) {
    return *(const LAS bf16x8*)(T + (r0 + (lane & 31)) * stride + (k0 + 8 * (lane >> 5)) * 2);
}
typedef short v4i16_t __attribute__((ext_vector_type(4)));
template <bool PERM> __device__ __forceinline__ bf16x8 frag_tr(const LAS unsigned char* X, int stride, int k0, int c0, int lane) {
    const int i = lane & 15, g = (lane >> 4) & 1, hh = lane >> 5, q = i >> 2, p = i & 3;
    const int rA = PERM ? (k0 + 4 * hh + q) : (k0 + 8 * hh + q), rB = PERM ? (k0 + 8 + 4 * hh + q) : (k0 + 8 * hh + 4 + q);
    const int cb = (c0 + 16 * g + 4 * p) * 2;
    const s16x4 lo = __builtin_bit_cast(s16x4, __builtin_amdgcn_ds_read_tr16_b64_v4i16((LAS v4i16_t*)(X + rA * stride + cb)));
    const s16x4 hi = __builtin_bit_cast(s16x4, __builtin_amdgcn_ds_read_tr16_b64_v4i16((LAS v4i16_t*)(X + rB * stride + cb)));
    return __builtin_shufflevector(lo, hi, 0, 1, 2, 3, 4, 5, 6, 7);
}
__device__ __forceinline__ bf16x8 pack_acc(const f32x16& x, int s) {
    v4u p; p.x = cvt_pk_bf16(x[8 * s], x[8 * s + 1]); p.y = cvt_pk_bf16(x[8 * s + 2], x[8 * s + 3]); p.z = cvt_pk_bf16(x[8 * s + 4], x[8 * s + 5]); p.w = cvt_pk_bf16(x[8 * s + 6], x[8 * s + 7]);
    return __builtin_bit_cast(bf16x8, p);
}

#define XB_TMO      128
#define XB_XCNT(j)  (256  + 64 * (j))
#define XB_XSUB(j)  (1280 + 64 * (j))
#define XB_XGEN(j)  (2304 + 64 * (j))
#define XB_TOP      3328
#define XB_TOPGEN   3392
#define XCD_BAR_WORDS 3456
#define XB_SPIN_CAP (1u << 22)
__device__ __forceinline__ unsigned xb_ld(unsigned* p)              { return __hip_atomic_load(p, __ATOMIC_RELAXED, __HIP_MEMORY_SCOPE_AGENT); }
__device__ __forceinline__ unsigned xb_add(unsigned* p, unsigned v) { return __hip_atomic_fetch_add(p, v, __ATOMIC_RELAXED, __HIP_MEMORY_SCOPE_AGENT); }
__device__ __forceinline__ unsigned xb_xcc_id() { return (unsigned)__builtin_amdgcn_s_getreg((3 << 11) | 20) & 0xFu; }
#define XB_SPIN(cond, bar) do { unsigned _sp = 0; while (cond) { __builtin_amdgcn_s_sleep(1); \
    if ((++_sp & 255u) == 0u) { if (xb_ld(&(bar)[XB_TMO])) break; if (_sp > XB_SPIN_CAP) { atomicAdd(&(bar)[XB_TMO], 1u); break; } } } } while (0)
struct XcdBarrier { unsigned* bar; unsigned x; volatile LAS unsigned* st; };
__device__ __forceinline__ XcdBarrier xcd_barrier_post(unsigned* bar, volatile LAS unsigned* st) {
    XcdBarrier b; b.bar = bar; b.x = xb_xcc_id(); b.st = st;
    if (threadIdx.x == 0) (void)xb_add(&bar[XB_XCNT(b.x)], 1u);
    return b;
}
__device__ __forceinline__ void xcd_barrier_complete(unsigned* bar, unsigned x, unsigned& nloc, unsigned& nx) {
    const unsigned G = gridDim.x * gridDim.y * gridDim.z;
    unsigned sum, cnt, mine, sp = 0u;
    for (;;) {
        sum = 0u; cnt = 0u; mine = 0u;
#pragma unroll
        for (unsigned j = 0; j < 16; ++j) { const unsigned c = xb_ld(&bar[XB_XCNT(j)]); sum += c; cnt += (c > 0u) ? 1u : 0u; mine = (j == x) ? c : mine; }
        if (sum == G) break;
        __builtin_amdgcn_s_sleep(1);
        if ((++sp & 255u) == 0u) { if (xb_ld(&bar[XB_TMO])) break; if (sp > XB_SPIN_CAP) { atomicAdd(&bar[XB_TMO], 1u); break; } }
    }
    nloc = mine > 0u ? mine : 1u; nx = cnt > 0u ? cnt : 1u;
}
__device__ __forceinline__ void xcd_barrier(const XcdBarrier& b) {
    asm volatile("s_waitcnt vmcnt(0)" ::: "memory");
    __syncthreads();
    if (threadIdx.x == 0) {
        unsigned* bar = b.bar;
        __builtin_amdgcn_s_waitcnt(0);
        unsigned nloc = b.st[0], nx = b.st[1];
        if (nloc == 0u) { xcd_barrier_complete(bar, b.x, nloc, nx); b.st[0] = nloc; b.st[1] = nx; }
        const unsigned old = xb_add(&bar[XB_XSUB(b.x)], 1u);
        const unsigned gen = old / nloc;
        if (old + 1u == (gen + 1u) * nloc) {
            __builtin_amdgcn_fence(__ATOMIC_RELEASE, "agent");
            asm volatile("s_waitcnt vmcnt(0)" ::: "memory");
            const unsigned og = xb_add(&bar[XB_TOP], 1u);
            const unsigned tg = og / nx;
            if (og + 1u == (tg + 1u) * nx) xb_add(&bar[XB_TOPGEN], 1u);
            else XB_SPIN(xb_ld(&bar[XB_TOPGEN]) == tg, bar);
            __builtin_amdgcn_fence(__ATOMIC_ACQUIRE, "agent");
            xb_add(&bar[XB_XGEN(b.x)], 1u);
            asm volatile("s_waitcnt vmcnt(0)" ::: "memory");
        } else {
            XB_SPIN(xb_ld(&bar[XB_XGEN(b.x)]) == gen, bar);
            __builtin_amdgcn_fence(__ATOMIC_ACQUIRE, "agent");
            asm volatile("s_waitcnt vmcnt(0)" ::: "memory");
        }
    }
    __syncthreads();
}

struct Frame {
    LAS unsigned char* lds;
    volatile LAS unsigned* MISC;
    gu32* ctl;
    int tid, lane, wave, G;
    unsigned long long tp;
    float* out; unsigned char* ws;
};
#define WSP(T, off) ((T*)(F.ws + (off)))
#define WSL(T, off) ((T*)(ws_ + (off)))
#define LAUNDER_WS() unsigned char* ws_ = F.ws; asm volatile("" : "+s"(ws_))
constexpr int PTR_OFF = MISC_OFF + 128;
enum { I_XP = 0, I_XS, I_C1, I_C2, I_C3, I_ST0, I_RELB, I_WIN, I_WG2, I_BG, I_GN, I_WA, I_WB, I_WO, I_L1G, I_L1B, I_WQ, I_KEYS, I_PU, I_PV, I_L2G, I_L2B };
__device__ __forceinline__ const float* inptr(const Frame& F, int i) {
    const unsigned long long v = ((volatile LAS unsigned long long*)(F.lds + PTR_OFF))[i];
    const unsigned lo = __builtin_amdgcn_readfirstlane((unsigned)v), hi = __builtin_amdgcn_readfirstlane((unsigned)(v >> 32));
    return (const float*)(((unsigned long long)hi << 32) | lo);
}

__device__ __forceinline__ void p0_tr_load(const float* W, int N, int nsrc0, int k0, int lane, float (&v)[32]) {
#pragma unroll
    for (int i = 0; i < 32; ++i) { const int kk = 2 * i + (lane >> 5); v[i] = W[(size_t)(k0 + kk) * N + nsrc0 + (lane & 31)]; }
}
__device__ __forceinline__ void p0_tr_finish(const float (&v)[32], int K, bf16* WT, int ndst0, int k0, LAS float* scr, int lane) {
#pragma unroll
    for (int i = 0; i < 32; ++i) { const int kk = 2 * i + (lane >> 5); scr[kk * 33 + (lane & 31)] = v[i]; }
    LDS_WAIT(); asm volatile("" ::: "memory");
    const int c = lane & 7;
#pragma unroll
    for (int j = 0; j < 4; ++j) { const int n = (lane >> 3) + 8 * j; const LAS float* s = scr + (8 * c) * 33 + n;
        v4u o; o.x = cvt_pk_bf16(s[0 * 33], s[1 * 33]); o.y = cvt_pk_bf16(s[2 * 33], s[3 * 33]); o.z = cvt_pk_bf16(s[4 * 33], s[5 * 33]); o.w = cvt_pk_bf16(s[6 * 33], s[7 * 33]);
        *(GAS v4u*)(WT + (size_t)(ndst0 + n) * K + k0 + 8 * c) = o; }
    LDS_WAIT(); asm volatile("" ::: "memory");
}
__device__ __forceinline__ void p0_cvt8(const float* src, bf16* dst, size_t n8, size_t gt, size_t ngt) {
    for (size_t i = gt; i < n8; i += ngt) { const f32x4 a = *(const f32x4*)(src + i * 8), b = *(const f32x4*)(src + i * 8 + 4);
        v4u o; o.x = cvt_pk_bf16(a[0], a[1]); o.y = cvt_pk_bf16(a[2], a[3]); o.z = cvt_pk_bf16(b[0], b[1]); o.w = cvt_pk_bf16(b[2], b[3]); *(v4u*)(dst + i * 8) = o; }
}
typedef float f32x2_t __attribute__((ext_vector_type(2)));
typedef _Float16 h2_t __attribute__((ext_vector_type(2)));
constexpr float U_SCALE = 1024.0f, V_SCALE = 128.0f, X_SCALE = 16.0f;
__device__ __forceinline__ void p0_cvt_fp8(const float* src, unsigned char* dst, float scale, size_t n16, size_t gt, size_t ngt) {
    for (size_t i = gt; i < n16; i += ngt) { v4u o;
#pragma unroll
        for (int q = 0; q < 4; ++q) { const f32x4 a = *(const f32x4*)(src + i * 16 + 4 * q) * scale; int w = 0;
            w = __builtin_amdgcn_cvt_pk_fp8_f32(a[0], a[1], w, false); w = __builtin_amdgcn_cvt_pk_fp8_f32(a[2], a[3], w, true); o[q] = (unsigned)w; }
        const size_t e = i >> 6, q16 = i & 63;
        *(v4u*)(dst + (((q16 >> 3) * 16384 + e) << 7) + 16 * (q16 & 7)) = o; }
}
__device__ __forceinline__ void p0_kvshift(const float* src, float* dst, int Wb, size_t gt, size_t ngt) {
    const size_t n4 = (size_t)(Wb - 4) * 256, tot = n4 * 32;
    for (size_t i = gt; i < tot; i += ngt) { const size_t b = i / n4, r = i - b * n4;
        ((f32x4*)dst)[b * (size_t)Wb * 256 + r] = ((const f32x4*)src)[b * (size_t)Wb * 256 + 1024 + r]; }
}
__device__ __forceinline__ void p0_prologue(Frame& F) {
    const int gw = blockIdx.x * NWAVES + F.wave, NGW = F.G * NWAVES;
    const size_t gt = (size_t)blockIdx.x * NTHR + F.tid, ngt = (size_t)F.G * NTHR;
    const float* win = inptr(F, I_WIN); const float* xp = inptr(F, I_XP); const float* xs = inptr(F, I_XS);
    constexpr int WROW = 2064;
    for (int i = F.tid; i < 4096; i += NTHR) {
        const int k = i >> 2, c4 = (i & 3) * 4; const f32x4 w4 = *(const f32x4*)(win + (size_t)k * INW + ABCOL + c4);
#pragma unroll
        for (int cc = 0; cc < 4; ++cc) *(LAS unsigned short*)(F.lds + (c4 + cc) * WROW + k * 2) = f2bf(w4[cc]); }
    __syncthreads();
    bf16* XB = WSP(bf16, WS_XB); float* AB = WSP(float, WS_AB);
    {   const int lane = F.lane, r = lane & 15, kg = lane >> 4;
        typedef float f32x4a __attribute__((ext_vector_type(4)));
        for (int blk = gw; blk < MPAD / 16; blk += NGW) {
            const int m = 16 * blk + r;
            bf16* xo = XB + (size_t)m * 1024 + 8 * kg;
            if (16 * blk >= NTOK) {
#pragma unroll 8
                for (int s = 0; s < 32; ++s) *(v4u*)(xo + 32 * s) = (v4u){0u, 0u, 0u, 0u};
                if (kg == 0) { *(f32x4*)(AB + (size_t)m * 16) = (f32x4){0.f, 0.f, 0.f, 0.f}; *(f32x4*)(AB + (size_t)m * 16 + 4) = (f32x4){0.f, 0.f, 0.f, 0.f}; *(f32x4*)(AB + (size_t)m * 16 + 8) = (f32x4){0.f, 0.f, 0.f, 0.f}; *(f32x4*)(AB + (size_t)m * 16 + 12) = (f32x4){0.f, 0.f, 0.f, 0.f}; }
                continue; }
            const float* xr = (m < NP ? xp + (size_t)m * 1024 : xs + (size_t)(m - NP) * 1024) + 8 * kg;
            f32x4a acc = {0.f, 0.f, 0.f, 0.f};
#pragma unroll 1
            for (int s0 = 0; s0 < 32; s0 += 16) {
                f32x4 xa[16], xb[16];
#pragma unroll
                for (int u = 0; u < 16; ++u) { xa[u] = *(const f32x4*)(xr + 32 * (s0 + u)); xb[u] = *(const f32x4*)(xr + 32 * (s0 + u) + 4); }
#pragma unroll
                for (int u = 0; u < 16; ++u) { v4u w; w.x = cvt_pk_bf16(xa[u][0], xa[u][1]); w.y = cvt_pk_bf16(xa[u][2], xa[u][3]); w.z = cvt_pk_bf16(xb[u][0], xb[u][1]); w.w = cvt_pk_bf16(xb[u][2], xb[u][3]);
                    *(v4u*)(xo + 32 * (s0 + u)) = w;
                    const bf16x8 bfr = *(const LAS bf16x8*)(F.lds + r * WROW + (32 * (s0 + u) + 8 * kg) * 2);
                    acc = __builtin_amdgcn_mfma_f32_16x16x32_bf16(__builtin_bit_cast(bf16x8, w), bfr, acc, 0, 0, 0); }
            }
#pragma unroll
            for (int i2 = 0; i2 < 4; ++i2) AB[(size_t)(16 * blk + 4 * kg + i2) * 16 + r] = acc[i2];
        }
    }
    __syncthreads();
    LAS float* scr = (LAS float*)(F.lds + F.wave * 16384);
    const float* wa = inptr(F, I_WA); const float* wb = inptr(F, I_WB); const float* wo = inptr(F, I_WO); const float* wq = inptr(F, I_WQ);
    constexpr int I_IN = 16 * (NPROJ / 32), I_A = 8 * 32, I_B = 16 * 32, I_O = 16 * 32, I_Q = 16 * 64, NIT = I_IN + I_A + I_B + I_O + I_Q;
#define P0_TR_PARAMS(IT, W_, WT_, K_, N_, NS_, ND_, K0_) { int r = (IT); \
        if (r < I_IN) { const int nb = r % (NPROJ / 32), kb = r / (NPROJ / 32), nd = 32 * nb; W_ = win; WT_ = WSP(bf16, WS_WIN); K_ = 1024; N_ = INW; NS_ = nd + (nd >= ABCOL ? 16 : 0); ND_ = nd; K0_ = 64 * kb; } \
        else if ((r -= I_IN) < I_A) { W_ = wa; WT_ = WSP(bf16, WS_WA); K_ = 512; N_ = 1024; NS_ = ND_ = 32 * (r % 32); K0_ = 64 * (r / 32); } \
        else if ((r -= I_A) < I_B) { W_ = wb; WT_ = WSP(bf16, WS_WB); K_ = 1024; N_ = 1024; NS_ = ND_ = 32 * (r % 32); K0_ = 64 * (r / 32); } \
        else if ((r -= I_B) < I_O) { W_ = wo; WT_ = WSP(bf16, WS_WO); K_ = 1024; N_ = 1024; NS_ = ND_ = 32 * (r % 32); K0_ = 64 * (r / 32); } \
        else { r -= I_O; W_ = wq; WT_ = WSP(bf16, WS_WQ); K_ = 1024; N_ = 2048; NS_ = ND_ = 32 * (r % 64); K0_ = 64 * (r / 64); } }
    if (blockIdx.x != 0) {
        const int NW2 = NGW - NWAVES;
        for (int it = gw - NWAVES; it < NIT; it += 2 * NW2) {
            const int it2 = it + NW2; const bool has2 = it2 < NIT;
            const float* Wa; bf16* WTa; int Ka, Na, NSa, NDa, K0a; P0_TR_PARAMS(it, Wa, WTa, Ka, Na, NSa, NDa, K0a);
            const float* Wb = Wa; bf16* WTb = WTa; int Kb = Ka, Nb = Na, NSb = NSa, NDb = NDa, K0b = K0a;
            if (has2) P0_TR_PARAMS(it2, Wb, WTb, Kb, Nb, NSb, NDb, K0b);
            float va[32], vb[32];
            p0_tr_load(Wa, Na, NSa, K0a, F.lane, va);
            if (has2) p0_tr_load(Wb, Nb, NSb, K0b, F.lane, vb);
            p0_tr_finish(va, Ka, WTa, NDa, K0a, scr, F.lane);
            if (has2) p0_tr_finish(vb, Kb, WTb, NDb, K0b, scr, F.lane);
        }
    }
    p0_cvt_fp8(inptr(F, I_PU), WSP(unsigned char, WS_UT), U_SCALE, (size_t)16384 * 1024 / 16, gt, ngt);
    p0_cvt_fp8(inptr(F, I_PV), WSP(unsigned char, WS_VT), V_SCALE, (size_t)16384 * 1024 / 16, gt, ngt);
    p0_cvt8(inptr(F, I_KEYS), WSP(bf16, WS_KEYS), (size_t)8 * 2 * 128 * 128 / 8, gt, ngt);
    if (gt < 3 * 8 * 129) { const int g = (int)gt / (8 * 129), h = ((int)gt / 129) % 8, rel = (int)gt % 129; const int dil = g == 0 ? 1 : (g == 1 ? 4 : 16), dist = rel * dil;
        int bucket = dist;
        if (dist >= 16) { const float dd = (float)dist; int lg = 16 + (int)(logf(dd / 16.0f) / 4.852030263919617f * 16.0f); bucket = lg < 31 ? lg : 31; }
        WSP(float, WS_LUT)[gt] = inptr(F, I_RELB)[bucket * 24 + g * 8 + h]; }
}

constexpr size_t WS_KD = WS_OAM, WS_DEC = WS_OBN;
__device__ __forceinline__ void gla_prep_load(Frame& F, int unit, unsigned (&qv)[8], unsigned (&kv)[8], float (&abv)[2]) {
    const int d2 = F.tid & 63, ig = F.wave, h = unit & 3, n = (unit >> 2) & 63, b = unit >> 8;
    const size_t m0 = (size_t)b * TSEQ + (size_t)n * 64;
    const bf16* QB = WSP(bf16, WS_QB); const bf16* KB = WSP(bf16, WS_KB); const float* AB = WSP(float, WS_AB);
#pragma unroll
    for (int ii = 0; ii < 8; ++ii) { const size_t off = (m0 + 8 * ig + ii) * 512 + h * 128 + 2 * d2; qv[ii] = *(const unsigned*)(QB + off); kv[ii] = *(const unsigned*)(KB + off); }
    abv[0] = AB[(m0 + 8 * ig) * 16 + d2]; abv[1] = AB[(m0 + 8 * ig) * 16 + 64 + d2];
}
__device__ __forceinline__ void gla_prep_unit(Frame& F, int unit, const unsigned (&qv)[8], const unsigned (&kv)[8], const float (&abv)[2], const f32x2_t (&wg)[16], const f32x2_t bgd) {
    LAUNDER_WS();
    LAS float* GT = (LAS float*)F.lds;
    const int tid = F.tid, d2 = tid & 63, ig = F.wave;
    const int h = unit & 3, n = (unit >> 2) & 63, b = unit >> 8;
    const size_t m0 = (size_t)b * TSEQ + (size_t)n * 64;
    bf16* QB = WSL(bf16, WS_QB); bf16* KB = WSL(bf16, WS_KB); float* DEC = WSL(float, WS_DEC);
    f32x2_t c[8]; f32x2_t run = {0.f, 0.f};
#pragma unroll
    for (int ii = 0; ii < 8; ++ii) {
        f32x2_t x = bgd;
#pragma unroll
        for (int r = 0; r < 16; ++r) x += wg[r] * __uint_as_float((unsigned)__builtin_amdgcn_readlane((int)__float_as_uint(abv[ii >> 2]), 16 * (ii & 3) + r));
        f32x2_t ls; ls.x = fminf(x.x, 0.f) - __logf(1.0f + __expf(-fabsf(x.x))); ls.y = fminf(x.y, 0.f) - __logf(1.0f + __expf(-fabsf(x.y)));
        run += ls * (1.0f / 16.0f); c[ii] = run;
    }
    *(LAS f32x2_t*)(GT + ig * 128 + 2 * d2) = run;
    __syncthreads();
    f32x2_t offs = {0.f, 0.f}, bl = {0.f, 0.f};
#pragma unroll
    for (int g = 0; g < 8; ++g) { const f32x2_t t = *(const LAS f32x2_t*)(GT + g * 128 + 2 * d2); bl += t; if (g < ig) offs += t; }
    const f32x2_t ebl = {__expf(bl.x), __expf(bl.y)};
#pragma unroll
    for (int ii = 0; ii < 8; ++ii) {
        const f32x2_t bb = offs + c[ii]; const f32x2_t eb = {__expf(bb.x), __expf(bb.y)}, ieb = {__expf(-bb.x), __expf(-bb.y)};
        const f32x2_t q = {bf_lo(qv[ii]), bf_hi(qv[ii])}, k = {bf_lo(kv[ii]), bf_hi(kv[ii])};
        const f32x2_t qe = q * GLA_QSCALE * eb, ke = k * ieb;
        const size_t off = (m0 + 8 * ig + ii) * 512 + h * 128 + 2 * d2;
        *(unsigned*)(QB + off) = cvt_pk_bf16(qe.x, qe.y); *(unsigned*)(KB + off) = cvt_pk_bf16(ke.x, ke.y);
    }
    if (ig == 0) *(f32x2_t*)(DEC + ((size_t)b * 64 + n) * 512 + h * 128 + 2 * d2) = ebl;
    __syncthreads();
}
__device__ __forceinline__ void gla_prompt_unit(Frame& F, int b, int h, int sl) {
    LAUNDER_WS();
    LAS unsigned char* L = F.lds;
    constexpr int O_QE = 0, O_KE = 17408, O_KD = 34816, O_VT = 55296, O_SB = 67584, O_DEC = 92160;
    const int tid = F.tid, lane = F.lane, w = F.wave, hh = lane >> 5;
    const bf16* QB = WSL(bf16, WS_QB); const bf16* KB = WSL(bf16, WS_KB); bf16* VB = WSL(bf16, WS_VB); const float* DEC = WSL(float, WS_DEC);
    for (int i = tid; i < 128 * 192 / 4; i += NTHR) ((LAS unsigned*)(L + O_SB))[i] = 0u;
    f32x16 S;
#pragma unroll
    for (int r = 0; r < 16; ++r) S[r] = 0.f;
    const int dt = w >> 1, et = w & 1;
    const int r0 = tid >> 4, c0 = tid & 15;
    v4u tq[2], tk[2], tv; float tdec = 0.f;
#define GLA_LOAD(n_) do { const size_t m0_ = (size_t)b * TSEQ + (size_t)(n_) * 64; \
        _Pragma("unroll") for (int i_ = 0; i_ < 2; ++i_) { const size_t off_ = (m0_ + r0 + 32 * i_) * 512 + h * 128 + c0 * 8; tq[i_] = *(const v4u*)(QB + off_); tk[i_] = *(const v4u*)(KB + off_); } \
        tv = *(const v4u*)(VB + (m0_ + (tid >> 3)) * 1024 + h * 256 + sl * 64 + (tid & 7) * 8); \
        if (tid < 128) tdec = DEC[((size_t)b * 64 + (n_)) * 512 + h * 128 + tid]; } while (0)
    GLA_LOAD(0);
    for (int n = 0; n < 64; ++n) {
        const size_t m0 = (size_t)b * TSEQ + (size_t)n * 64;
#pragma unroll
        for (int i = 0; i < 2; ++i) { *(LAS v4u*)(L + O_QE + (r0 + 32 * i) * 272 + c0 * 16) = tq[i]; *(LAS v4u*)(L + O_KE + (r0 + 32 * i) * 272 + c0 * 16) = tk[i]; *(LAS v4u*)(L + O_KD + (r0 + 32 * i) * 320 + c0 * 16) = tk[i]; }
        *(LAS v4u*)(L + O_VT + (tid >> 3) * 192 + (tid & 7) * 16) = tv;
        if (tid < 128) ((LAS float*)(L + O_DEC))[tid] = tdec;
        __syncthreads();
        if (n + 1 < 64) GLA_LOAD(n + 1);
        if (w < 4) {
            const int it = w >> 1;
            f32x16 o;
#pragma unroll
            for (int r = 0; r < 16; ++r) o[r] = 0.f;
            for (int jt = 0; jt <= it; ++jt) {
                f32x16 X;
#pragma unroll
                for (int r = 0; r < 16; ++r) X[r] = 0.f;
#pragma unroll
                for (int s = 0; s < 8; ++s) X = MFMA32(frag_row(L + O_KE, 272, 32 * jt, 16 * s, lane), frag_row(L + O_QE, 272, 32 * it, 16 * s, lane), X);
                if (jt == it) {
#pragma unroll
                    for (int r = 0; r < 16; ++r) if (crow(r, hh) > (lane & 31)) X[r] = 0.f;
                }
#pragma unroll
                for (int s2 = 0; s2 < 2; ++s2) o = MFMA32(pack_acc(X, s2), frag_tr<true>(L + O_VT, 192, 32 * jt + 16 * s2, 32 * et, lane), o);
            }
#pragma unroll
            for (int s = 0; s < 8; ++s) o = MFMA32(frag_row(L + O_QE, 272, 32 * it, 16 * s, lane), frag_tr<false>(L + O_SB, 192, 16 * s, 32 * et, lane), o);
            bf16* op = VB + (m0 + 32 * it) * 1024 + h * 256 + sl * 64 + 32 * et + (lane & 31);
#pragma unroll
            for (int r = 0; r < 16; ++r) op[(size_t)crow(r, hh) * 1024] = f2bf(o[r]);
        }
        {
#pragma unroll
            for (int s = 0; s < 4; ++s) S = MFMA32(frag_tr<false>(L + O_KD, 320, 16 * s, 32 * dt, lane), frag_tr<false>(L + O_VT, 192, 16 * s, 32 * et, lane), S);
#pragma unroll
            for (int r = 0; r < 16; ++r) S[r] *= ((LAS float*)(L + O_DEC))[32 * dt + crow(r, hh)];
        }
        __syncthreads();
#pragma unroll
        for (int r = 0; r < 16; ++r) *(LAS unsigned short*)(L + O_SB + (32 * dt + crow(r, hh)) * 192 + (32 * et + (lane & 31)) * 2) = f2bf(S[r]);
    }
#undef GLA_LOAD
    float* so = F.out + OUT_STP + ((size_t)(b * 4 + h) * 128 + 32 * dt) * 256 + sl * 64 + 32 * et + (lane & 31);
#pragma unroll
    for (int r = 0; r < 16; ++r) so[(size_t)crow(r, hh) * 256] = S[r];
    __syncthreads();
}

struct AttnItem { int b, h, g, r, dil, i0, cb; size_t tok0; };
__device__ __forceinline__ AttnItem attn_decode(int item) {
    AttnItem a; const int bh = item / 48, sub = item % 48; a.b = bh >> 3; a.h = bh & 7;
    int ibg;
    if (sub < 16) { a.g = 0; a.r = 0; ibg = sub; } else if (sub < 32) { a.g = 1; a.r = (sub - 16) >> 2; ibg = (sub - 16) & 3; } else { a.g = 2; a.r = sub - 32; ibg = 0; }
    a.dil = a.g == 0 ? 1 : (a.g == 1 ? 4 : 16); a.i0 = 256 * ibg; a.tok0 = (size_t)a.b * TSEQ + a.r; a.cb = a.g * 512 + a.h * 64;
    return a;
}
__device__ __forceinline__ void attn_issue(Frame& F, int item, v4u (&kk)[6], v4u (&vv)[6], bf16x8 (&qf)[4]) {
    LAUNDER_WS();
    const AttnItem a = attn_decode(item);
    const int tid = F.tid, lane = F.lane, w = F.wave, hh = lane >> 5, il = lane & 31;
    const bf16* QA = WSL(bf16, WS_QA); const bf16* KA = WSL(bf16, WS_KA); const bf16* VA = WSL(bf16, WS_VA);
    const size_t qtok = a.tok0 + (size_t)a.dil * (a.i0 + 32 * w + il);
#pragma unroll
    for (int s = 0; s < 4; ++s) qf[s] = *(const bf16x8*)(QA + qtok * 1536 + a.cb + 16 * s + 8 * hh);
#pragma unroll
    for (int p = 0; p < 6; ++p) { const int idx = tid + NTHR * p, rr = idx >> 3, ch = idx & 7, j = a.i0 - 128 + rr;
        if (j >= 0) { const size_t so = (a.tok0 + (size_t)a.dil * j) * 1536 + a.cb + ch * 8; vv[p] = *(const v4u*)(VA + so); kk[p] = *(const v4u*)(KA + so); } }
}
__device__ __forceinline__ void attn_prompt_item(Frame& F, int item, v4u (&kk)[6], v4u (&vv)[6], const bf16x8 (&qf)[4], bool has_next, int next_item, bf16x8 (&qn)[4]) {
    LAUNDER_WS();
    LAS unsigned char* L = F.lds;
    constexpr int O_V = 0, O_K = 384 * 192, O_LUT = O_K + 384 * 144;
    static_assert(O_LUT + 129 * 4 <= RING_BYTES, "attention LDS");
    const int tid = F.tid, lane = F.lane, w = F.wave, hh = lane >> 5, il = lane & 31;
    const AttnItem a = attn_decode(item);
    const int b = a.b, h = a.h, g = a.g, dil = a.dil, i0 = a.i0, cb = a.cb; const size_t tok0 = a.tok0; (void)b;
    bf16* QA = WSL(bf16, WS_QA); float* LSE = WSL(float, WS_LSE);
    const size_t qtok = tok0 + (size_t)dil * (i0 + 32 * w + il);
#pragma unroll
    for (int p = 0; p < 6; ++p) { const int idx = tid + NTHR * p, rr = idx >> 3, ch = idx & 7, j = i0 - 128 + rr;
        if (j >= 0) { *(LAS v4u*)(L + O_V + rr * 192 + ch * 16) = vv[p]; *(LAS v4u*)(L + O_K + rr * 144 + ch * 16) = kk[p]; } }
    if (tid < 129) ((LAS float*)(L + O_LUT))[tid] = WSL(float, WS_LUT)[(g * 8 + h) * 129 + tid];
    __syncthreads();
    if (has_next) attn_issue(F, next_item, kk, vv, qn);
    float mrun = NEG_BIG, lrun = 0.f;
    f32x16 O0, O1;
#pragma unroll
    for (int x = 0; x < 16; ++x) { O0[x] = 0.f; O1[x] = 0.f; }
#pragma unroll 1
    for (int kt = 0; kt < 5; ++kt) {
        const int jb = i0 + 32 * (w + kt) - 128;
        if (jb < 0) continue;
        f32x16 ST;
#pragma unroll
        for (int x = 0; x < 16; ++x) ST[x] = 0.f;
#pragma unroll
        for (int s = 0; s < 4; ++s) ST = MFMA32(frag_row(L + O_K, 144, 32 * (w + kt), 16 * s, lane), qf[s], ST);
        const int relb = 128 - 32 * kt + il;
        float tmax = NEG_BIG;
#pragma unroll
        for (int x = 0; x < 16; ++x) { const int rel = relb - crow(x, hh); const bool ok = rel >= 0 && rel <= 128; const int rc = rel < 0 ? 0 : (rel > 128 ? 128 : rel);
            const float sc = ok ? ST[x] + ((LAS float*)(L + O_LUT))[rc] : NEG_BIG; ST[x] = sc; tmax = fmaxf(tmax, sc); }
        tmax = fmaxf(tmax, __shfl_xor(tmax, 32));
        const float mnew = fmaxf(mrun, tmax), alpha = __expf(mrun - mnew);
        float ps = 0.f;
#pragma unroll
        for (int x = 0; x < 16; ++x) { const float p = __expf(ST[x] - mnew); ST[x] = p; ps += p; }
        lrun = lrun * alpha + ps; mrun = mnew;
#pragma unroll
        for (int x = 0; x < 16; ++x) { O0[x] *= alpha; O1[x] *= alpha; }
#pragma unroll
        for (int s2 = 0; s2 < 2; ++s2) { const bf16x8 pf = pack_acc(ST, s2);
            O0 = MFMA32(frag_tr<true>(L + O_V, 192, 32 * (w + kt) + 16 * s2, 0, lane), pf, O0);
            O1 = MFMA32(frag_tr<true>(L + O_V, 192, 32 * (w + kt) + 16 * s2, 32, lane), pf, O1); }
    }
    const float ltot = lrun + __shfl_xor(lrun, 32), inv = 1.0f / ltot;
    bf16* op = QA + qtok * 1536 + cb;
#pragma unroll
    for (int k4 = 0; k4 < 4; ++k4) { v2u a, c2;
        a.x = cvt_pk_bf16(O0[4 * k4] * inv, O0[4 * k4 + 1] * inv); a.y = cvt_pk_bf16(O0[4 * k4 + 2] * inv, O0[4 * k4 + 3] * inv);
        c2.x = cvt_pk_bf16(O1[4 * k4] * inv, O1[4 * k4 + 1] * inv); c2.y = cvt_pk_bf16(O1[4 * k4 + 2] * inv, O1[4 * k4 + 3] * inv);
        *(v2u*)(op + 8 * k4 + 4 * hh) = a; *(v2u*)(op + 32 + 8 * k4 + 4 * hh) = c2; }
    if (hh == 0) LSE[((size_t)g * MPAD + qtok) * 8 + h] = mrun + __logf(ltot);
    __syncthreads();
}

template <int G_> __device__ __forceinline__ void attn_sample_waveitem_g(Frame& F, int wi, const float* cache) {
    LAUNDER_WS();
    const int lane = F.lane;
    LAS float* pl = (LAS float*)(F.lds + F.wave * 1024);
    constexpr int g = G_; const int h = (wi / 3) & 7, s = (wi / 24) & 3, b = wi / 96;
    constexpr int dil = g == 0 ? 1 : (g == 1 ? 4 : 16), Wb = 128 * dil;
    bf16* QA = WSL(bf16, WS_QA); const bf16* KA = WSL(bf16, WS_KA); const bf16* VA = WSL(bf16, WS_VA); float* LSE = WSL(float, WS_LSE);
    const size_t qrow = (size_t)NP + b * 4 + s; const int cb = g * 512 + h * 64;
    float q[64];
#pragma unroll
    for (int c = 0; c < 8; ++c) { const v4u u = *(const v4u*)(QA + qrow * 1536 + cb + 8 * c);
        q[8 * c] = bf_lo(u.x); q[8 * c + 1] = bf_hi(u.x); q[8 * c + 2] = bf_lo(u.y); q[8 * c + 3] = bf_hi(u.y); q[8 * c + 4] = bf_lo(u.z); q[8 * c + 5] = bf_hi(u.z); q[8 * c + 6] = bf_lo(u.w); q[8 * c + 7] = bf_hi(u.w); }
    const float* lut = WSL(float, WS_LUT) + (g * 8 + h) * 129;
    float sc[3];
#pragma unroll
    for (int p = 0; p < 3; ++p) { const int j = lane + 64 * p; float a = NEG_BIG;
        if (j <= 128) { const int idx = Wb + s - j * dil; a = 0.f;
            if (idx >= Wb) { const bf16* kr = KA + ((size_t)NP + b * 4 + (idx - Wb)) * 1536 + cb;
#pragma unroll
                for (int c = 0; c < 8; ++c) { const v4u u = *(const v4u*)(kr + 8 * c);
                    a += q[8 * c] * bf_lo(u.x) + q[8 * c + 1] * bf_hi(u.x) + q[8 * c + 2] * bf_lo(u.y) + q[8 * c + 3] * bf_hi(u.y) + q[8 * c + 4] * bf_lo(u.z) + q[8 * c + 5] * bf_hi(u.z) + q[8 * c + 6] * bf_lo(u.w) + q[8 * c + 7] * bf_hi(u.w); }
            } else { const float* kr = cache + (((size_t)b * Wb + idx) * 2 + 0) * 512 + h * 64;
#pragma unroll
                for (int c = 0; c < 16; ++c) { const f32x4 u = *(const f32x4*)(kr + 4 * c); a += q[4 * c] * u[0] + q[4 * c + 1] * u[1] + q[4 * c + 2] * u[2] + q[4 * c + 3] * u[3]; }
            }
            a += lut[j]; }
        sc[p] = a; }
    const float mx = wave_max(fmaxf(fmaxf(sc[0], sc[1]), sc[2]));
    float ps = 0.f;
#pragma unroll
    for (int p = 0; p < 3; ++p) { const float e = __expf(sc[p] - mx); ps += e; pl[lane + 64 * p] = e; }
    const float ltot = wave_sum(ps);
    LDS_WAIT(); asm volatile("" ::: "memory");
    float o = 0.f;
    {
        const int nnew = dil == 1 ? s + 1 : 1;
        for (int j = 0; j < nnew; ++j) o += pl[j] * bf2f(VA[((size_t)NP + b * 4 + (s - j * dil)) * 1536 + cb + lane]);
        const float* vbase = cache + (((size_t)b * Wb) * 2 + 1) * 512 + h * 64 + lane;
        for (int j0 = nnew; j0 <= 128; j0 += 44) { float vv[44];
#pragma unroll
            for (int u = 0; u < 44; ++u) { const int j = j0 + u; vv[u] = j <= 128 ? vbase[(size_t)(Wb + s - j * dil) * 1024] : 0.f; }
#pragma unroll
            for (int u = 0; u < 44; ++u) { const int j = j0 + u; o += (j <= 128 ? pl[j] : 0.f) * vv[u]; } }
    }
    QA[qrow * 1536 + cb + lane] = f2bf(o / ltot);
    if (lane == 0) LSE[((size_t)g * MPAD + qrow) * 8 + h] = mx + __logf(ltot);
    LDS_WAIT(); asm volatile("" ::: "memory");
}

__device__ __forceinline__ void attn_sample_waveitem(Frame& F, int wi) {
    const int g = wi % 3;
    if (g == 0) attn_sample_waveitem_g<0>(F, wi, inptr(F, I_C1)); else if (g == 1) attn_sample_waveitem_g<1>(F, wi, inptr(F, I_C2)); else attn_sample_waveitem_g<2>(F, wi, inptr(F, I_C3));
}
__device__ __forceinline__ void gla_sample_item(Frame& F, int item) {
    LAUNDER_WS();
    LAS float* L = (LAS float*)F.lds;
    constexpr int O_LA = 0, O_QE = 512, O_KE = 1024, O_KD = 1536, O_DEC = 2048, O_ATT = 2176, O_PART = 2304;
    const int tid = F.tid, b = item >> 2, h = item & 3;
    const bf16* QB = WSL(bf16, WS_QB); const bf16* KB = WSL(bf16, WS_KB); bf16* VB = WSL(bf16, WS_VB); const float* AB = WSL(float, WS_AB);
    const size_t row0 = (size_t)NP + b * 4;
    { const int i = tid >> 7, d = tid & 127; float x = inptr(F, I_BG)[h * 128 + d]; const float* wg2 = inptr(F, I_WG2);
#pragma unroll
      for (int r = 0; r < 16; ++r) x += AB[(row0 + i) * 16 + r] * wg2[r * 512 + h * 128 + d];
      L[O_LA + i * 128 + d] = (fminf(x, 0.f) - log1pf(expf(-fabsf(x)))) * (1.0f / 16.0f); }
    __syncthreads();
    if (tid < 128) { const int d = tid; float bb[4]; float run = 0.f;
#pragma unroll
        for (int i = 0; i < 4; ++i) { run += L[O_LA + i * 128 + d]; bb[i] = run; }
        const float ebl = expf(run); L[O_DEC + d] = ebl;
#pragma unroll
        for (int i = 0; i < 4; ++i) { const float q = bf2f(QB[(row0 + i) * 512 + h * 128 + d]), k = bf2f(KB[(row0 + i) * 512 + h * 128 + d]);
            L[O_QE + i * 128 + d] = q * GLA_QSCALE * expf(bb[i]); L[O_KE + i * 128 + d] = k * expf(-bb[i]); L[O_KD + i * 128 + d] = k * expf(run - bb[i]); } }
    __syncthreads();
    if (tid < 16) { const int i = tid >> 2, j = tid & 3; float a = 0.f;
        if (j <= i) for (int d = 0; d < 128; ++d) a += L[O_QE + i * 128 + d] * L[O_KE + j * 128 + d];
        L[O_ATT + tid] = a; }
    const int e = tid & 255, dh = tid >> 8;
    float v[4];
#pragma unroll
    for (int j = 0; j < 4; ++j) v[j] = bf2f(VB[(row0 + j) * 1024 + h * 256 + e]);
    const float* Sin = inptr(F, I_ST0) + ((size_t)(b * 4 + h) * 128) * 256 + e; float* Sout = F.out + OUT_STS + ((size_t)(b * 4 + h) * 128) * 256 + e;
    float acc[4] = {0.f, 0.f, 0.f, 0.f};
#pragma unroll 4
    for (int dd = 0; dd < 64; ++dd) { const int d = dh * 64 + dd; const float sv = Sin[(size_t)d * 256];
#pragma unroll
        for (int i = 0; i < 4; ++i) acc[i] += L[O_QE + i * 128 + d] * sv;
        float sn = L[O_DEC + d] * sv;
#pragma unroll
        for (int j = 0; j < 4; ++j) sn += L[O_KD + j * 128 + d] * v[j];
        Sout[(size_t)d * 256] = sn; }
#pragma unroll
    for (int i = 0; i < 4; ++i) L[O_PART + (dh * 4 + i) * 256 + e] = acc[i];
    __syncthreads();
    if (tid < 256) {
#pragma unroll
        for (int i = 0; i < 4; ++i) { float o = L[O_PART + i * 256 + e] + L[O_PART + (4 + i) * 256 + e];
#pragma unroll
            for (int j = 0; j < 4; ++j) o += L[O_ATT + i * 4 + j] * v[j];
            VB[(row0 + i) * 1024 + h * 256 + e] = f2bf(o); } }
    __syncthreads();
}

static_assert(true, "");
constexpr int P2_ATT = 3072, P2_DEC = 384, P2_GLS = 128, P2_CPY = 32 * (2 + 8 + 32), P2_ITEMS = P2_ATT + P2_DEC + P2_GLS;
constexpr int KQ0 = 32 * 31, KQ1 = KQ0 + 32 * 127, KQ_ALL = KQ1 + 32 * 511, KQ_PER = 3;
__device__ __forceinline__ void kvquad_addr(Frame& F, int q, const f32x4*& s4, f32x4*& d4) {
    int g, r = q; if (r < KQ0) g = 0; else if (r < KQ1) { g = 1; r -= KQ0; } else { g = 2; r -= KQ1; }
    const int Wb = g == 0 ? 128 : (g == 1 ? 512 : 2048), nq = Wb / 4 - 1, b = r / nq, pq = r % nq;
    const float* src = inptr(F, g == 0 ? I_C1 : (g == 1 ? I_C2 : I_C3)); float* dst = F.out + (g == 0 ? OUT_KVS1 : (g == 1 ? OUT_KVS2 : OUT_KVS3));
    s4 = (const f32x4*)src + ((size_t)b * Wb + 4 * pq + 4) * 256 + F.lane; d4 = (f32x4*)dst + ((size_t)b * Wb + 4 * pq) * 256 + F.lane;
}
__device__ __forceinline__ void kvshift_quads(Frame& F, int q0) {
    const f32x4* s4[KQ_PER]; f32x4* d4[KQ_PER]; f32x4 v[KQ_PER][16];
#pragma unroll
    for (int k = 0; k < KQ_PER; ++k) kvquad_addr(F, q0 + k < KQ_ALL ? q0 + k : KQ_ALL - 1, s4[k], d4[k]);
#pragma unroll
    for (int k = 0; k < KQ_PER; ++k) if (q0 + k < KQ_ALL) {
#pragma unroll
        for (int u = 0; u < 16; ++u) v[k][u] = __builtin_nontemporal_load(s4[k] + u * 64); }
#pragma unroll
    for (int k = 0; k < KQ_PER; ++k) if (q0 + k < KQ_ALL) {
#pragma unroll
        for (int u = 0; u < 16; ++u) __builtin_nontemporal_store(v[k][u], d4[k] + u * 64); }
}
template <bool STOP_ON_GDONE> __device__ __forceinline__ void kvshift_loop(Frame& F) {
    unsigned t = 0u, gd_prev = 0u;
    if (F.lane == 0) t = (STOP_ON_GDONE && __hip_atomic_load(F.ctl + CW_GDONE, RLX_AGENT) != 0u) ? 0xffffffffu : __hip_atomic_fetch_add(F.ctl + CW_CPYQ, (unsigned)KQ_PER, RLX_AGENT);
    t = (unsigned)__builtin_amdgcn_readfirstlane((int)t);
    for (;;) {
        if (t >= (unsigned)KQ_ALL) break;
        unsigned tn = 0xffffffffu, gd = 0u;
        if (F.lane == 0) { if (STOP_ON_GDONE) gd = __hip_atomic_load(F.ctl + CW_GDONE, RLX_AGENT); if (!STOP_ON_GDONE || gd_prev == 0u) tn = __hip_atomic_fetch_add(F.ctl + CW_CPYQ, (unsigned)KQ_PER, RLX_AGENT); }
#if defined(PROBE_PHASE) && PROBE_PHASE == 108
        if (STOP_ON_GDONE && blockIdx.x == 255) F.tp += 100ull;
#endif
        kvshift_quads(F, (int)t);
        gd_prev = gd;
        t = (unsigned)__builtin_amdgcn_readfirstlane((int)tn);
    }
}
__device__ __forceinline__ void kvshift_loop_wg(Frame& F) {
    if (F.tid == 0) F.MISC[0] = __hip_atomic_fetch_add(F.ctl + CW_CPYQ, (unsigned)(8 * KQ_PER), RLX_AGENT);
    __syncthreads();
    unsigned t = F.MISC[0];
    for (;;) {
        if (t >= (unsigned)KQ_ALL) break;
        unsigned tn = 0u;
        if (F.tid == 0) tn = __hip_atomic_fetch_add(F.ctl + CW_CPYQ, (unsigned)(8 * KQ_PER), RLX_AGENT);
        if (t + KQ_PER * F.wave < (unsigned)KQ_ALL) kvshift_quads(F, (int)(t + KQ_PER * F.wave));
        __syncthreads();
        if (F.tid == 0) F.MISC[0] = tn;
        __syncthreads();
        t = F.MISC[0];
    }
}
__device__ __forceinline__ void p2_prep(Frame& F) {
    unsigned qa[8], ka[8], qb[8], kb[8]; float aa[2], ab2[2];
    int u = blockIdx.x; if (u >= 2048) return;
    const int d2 = F.tid & 63, h = u & 3;
    const float* wg2 = inptr(F, I_WG2); const float* bgp = inptr(F, I_BG);
    f32x2_t wg[16];
#pragma unroll
    for (int r = 0; r < 16; ++r) wg[r] = *(const f32x2_t*)(wg2 + r * 512 + h * 128 + 2 * d2);
    const f32x2_t bgd = *(const f32x2_t*)(bgp + h * 128 + 2 * d2);
    gla_prep_load(F, u, qa, ka, aa);
    for (;;) {
        const int u1 = u + F.G; if (u1 < 2048) gla_prep_load(F, u1, qb, kb, ab2);
        gla_prep_unit(F, u, qa, ka, aa, wg, bgd); if (u1 >= 2048) break;
        const int u2 = u1 + F.G; if (u2 < 2048) gla_prep_load(F, u2, qa, ka, aa);
        gla_prep_unit(F, u1, qb, kb, ab2, wg, bgd); if (u2 >= 2048) break;
        u = u2;
    }
}
__device__ __forceinline__ void p2_mixers(Frame& F) {
#if defined(PROBE_PHASE) && PROBE_PHASE >= 100
    const unsigned long long tp0 = __builtin_amdgcn_s_memrealtime();
#endif
#ifndef P2_SKIP_GLAP
    if (blockIdx.x < 128) {
        const int bx = blockIdx.x, bh = (bx & 7) + 8 * (bx >> 5), sl = (bx >> 3) & 3;
        gla_prompt_unit(F, bh >> 2, bh & 3, sl); }
#endif
#if defined(PROBE_PHASE) && PROBE_PHASE == 100
    if (blockIdx.x == 0) F.tp = __builtin_amdgcn_s_memrealtime() - tp0;
#endif
    constexpr int QCHUNK = 4;
    for (int it = 0, itend = 0;; ++it) {
        if (it >= itend) {
            if (F.tid == 0) F.MISC[0] = __hip_atomic_fetch_add(F.ctl + CW_QUEUE, (unsigned)QCHUNK, RLX_AGENT);
            __syncthreads();
            it = (int)F.MISC[0]; itend = it + QCHUNK;
            __syncthreads();
        }
        if (it >= P2_ITEMS) break;
#if defined(PROBE_PHASE) && PROBE_PHASE == 101
        if (blockIdx.x == 255) F.tp = __builtin_amdgcn_s_memrealtime() - tp0;
#endif
#if defined(PROBE_PHASE) && PROBE_PHASE == 102
        if (blockIdx.x == 255 && it >= P2_GLS + P2_DEC + P2_ATT && F.tp == 0ull) F.tp = __builtin_amdgcn_s_memrealtime() - tp0;
#endif
#if defined(PROBE_PHASE) && PROBE_PHASE >= 103 && PROBE_PHASE <= 106
        const unsigned long long ti0 = __builtin_amdgcn_s_memrealtime();
        const int pcls = it < P2_GLS ? 105 : (it < P2_GLS + P2_DEC ? 104 : (it < P2_GLS + P2_DEC + P2_ATT ? 103 : 106));
#endif
        if (it < P2_GLS) {
#ifndef P2_SKIP_GLAS
            gla_sample_item(F, it);
#endif
        } else if (it < P2_GLS + P2_DEC) {
#ifndef P2_SKIP_DEC
            attn_sample_waveitem(F, (it - P2_GLS) * 8 + F.wave); __syncthreads();
#endif
        } else if (it < P2_GLS + P2_DEC + P2_ATT) {
#ifndef P2_SKIP_ATT
            const int a0 = it - P2_GLS - P2_DEC;
            v4u kk[6], vv[6]; bf16x8 qa[4], qb[4];
            attn_issue(F, a0, kk, vv, qa);
            attn_prompt_item(F, a0, kk, vv, qa, true, a0 + 1, qb);
            attn_prompt_item(F, a0 + 1, kk, vv, qb, true, a0 + 2, qa);
            attn_prompt_item(F, a0 + 2, kk, vv, qa, true, a0 + 3, qb);
            attn_prompt_item(F, a0 + 3, kk, vv, qb, false, 0, qa);
            it = itend - 1;
#endif
        }
#if defined(PROBE_PHASE) && PROBE_PHASE >= 103 && PROBE_PHASE <= 106
        if (blockIdx.x == 255 && pcls == PROBE_PHASE) F.tp += __builtin_amdgcn_s_memrealtime() - ti0;
#endif
    }
#if defined(PROBE_PHASE) && PROBE_PHASE == 107
    const unsigned long long tc0 = __builtin_amdgcn_s_memrealtime();
#endif
    kvshift_loop_wg(F);
#if defined(PROBE_PHASE) && PROBE_PHASE == 107
    if (blockIdx.x == 255) F.tp = __builtin_amdgcn_s_memrealtime() - tc0;
#endif
}

__device__ __forceinline__ void p3_kvout(const bf16* K, const bf16* V, float* dst, int g, int W, int nb, size_t rowbase, int rows_per_b, int first, int pos0, int Wdst, size_t gt, size_t ngt) {
    const size_t per_b = (size_t)W * 2 * 64, tot = per_b * nb;
    for (size_t i = gt; i < tot; i += ngt) { const size_t b = i / per_b, r = i - b * per_b; const int p = (int)(r >> 7), c = (int)(r >> 6) & 1, ch = (int)r & 63;
        const v4u u = *(const v4u*)((c ? V : K) + (rowbase + b * rows_per_b + first + p) * 1536 + g * 512 + ch * 8);
        float* o = dst + ((b * Wdst + pos0 + p) * 2 + c) * 512 + ch * 8;
        *(f32x4*)o = (f32x4){bf_lo(u.x), bf_hi(u.x), bf_lo(u.y), bf_hi(u.y)}; *(f32x4*)(o + 4) = (f32x4){bf_lo(u.z), bf_hi(u.z), bf_lo(u.w), bf_hi(u.w)}; }
}
__device__ __forceinline__ void p3_merge(Frame& F) {
    const int gw = blockIdx.x * NWAVES + F.wave, NGW = F.G * NWAVES, lane = F.lane;
    const size_t gt = (size_t)blockIdx.x * NTHR + F.tid, ngt = (size_t)F.G * NTHR;
    const bf16* OA = WSP(bf16, WS_QA); const bf16* OB = WSP(bf16, WS_VB); const bf16* RB = WSP(bf16, WS_RB); const float* LSE = WSP(float, WS_LSE);
    bf16* OAM = WSP(bf16, WS_OAM); bf16* OBN = WSP(bf16, WS_OBN); const float* gn = inptr(F, I_GN);
    for (int m = gw; m < MPAD; m += NGW) {
        if (m >= NTOK) { *(v4u*)(OAM + (size_t)m * 512 + lane * 8) = (v4u){0u, 0u, 0u, 0u}; *(v4u*)(OBN + (size_t)m * 1024 + lane * 16) = (v4u){0u, 0u, 0u, 0u}; *(v4u*)(OBN + (size_t)m * 1024 + lane * 16 + 8) = (v4u){0u, 0u, 0u, 0u}; continue; }
        {
            const int hd = lane >> 3, c8 = (lane & 7) * 8;
            const float l0 = LSE[((size_t)0 * MPAD + m) * 8 + hd], l1 = LSE[((size_t)1 * MPAD + m) * 8 + hd], l2 = LSE[((size_t)2 * MPAD + m) * 8 + hd];
            const float mx = fmaxf(l0, fmaxf(l1, l2)); float w0 = __expf(l0 - mx), w1 = __expf(l1 - mx), w2 = __expf(l2 - mx); const float iw = 1.0f / (w0 + w1 + w2); w0 *= iw; w1 *= iw; w2 *= iw;
            const v4u a = *(const v4u*)(OA + (size_t)m * 1536 + hd * 64 + c8), b2 = *(const v4u*)(OA + (size_t)m * 1536 + 512 + hd * 64 + c8), c = *(const v4u*)(OA + (size_t)m * 1536 + 1024 + hd * 64 + c8);
            v4u o;
            o.x = cvt_pk_bf16(w0 * bf_lo(a.x) + w1 * bf_lo(b2.x) + w2 * bf_lo(c.x), w0 * bf_hi(a.x) + w1 * bf_hi(b2.x) + w2 * bf_hi(c.x));
            o.y = cvt_pk_bf16(w0 * bf_lo(a.y) + w1 * bf_lo(b2.y) + w2 * bf_lo(c.y), w0 * bf_hi(a.y) + w1 * bf_hi(b2.y) + w2 * bf_hi(c.y));
            o.z = cvt_pk_bf16(w0 * bf_lo(a.z) + w1 * bf_lo(b2.z) + w2 * bf_lo(c.z), w0 * bf_hi(a.z) + w1 * bf_hi(b2.z) + w2 * bf_hi(c.z));
            o.w = cvt_pk_bf16(w0 * bf_lo(a.w) + w1 * bf_lo(b2.w) + w2 * bf_lo(c.w), w0 * bf_hi(a.w) + w1 * bf_hi(b2.w) + w2 * bf_hi(c.w));
            *(v4u*)(OAM + (size_t)m * 512 + hd * 64 + c8) = o;
        }
        {
            const int c0 = lane * 16;
            const v4u u0 = *(const v4u*)(OB + (size_t)m * 1024 + c0), u1 = *(const v4u*)(OB + (size_t)m * 1024 + c0 + 8);
            const v4u r0 = *(const v4u*)(RB + (size_t)m * 1024 + c0), r1 = *(const v4u*)(RB + (size_t)m * 1024 + c0 + 8);
            float x[16] = {bf_lo(u0.x), bf_hi(u0.x), bf_lo(u0.y), bf_hi(u0.y), bf_lo(u0.z), bf_hi(u0.z), bf_lo(u0.w), bf_hi(u0.w), bf_lo(u1.x), bf_hi(u1.x), bf_lo(u1.y), bf_hi(u1.y), bf_lo(u1.z), bf_hi(u1.z), bf_lo(u1.w), bf_hi(u1.w)};
            float rr[16] = {bf_lo(r0.x), bf_hi(r0.x), bf_lo(r0.y), bf_hi(r0.y), bf_lo(r0.z), bf_hi(r0.z), bf_lo(r0.w), bf_hi(r0.w), bf_lo(r1.x), bf_hi(r1.x), bf_lo(r1.y), bf_hi(r1.y), bf_lo(r1.z), bf_hi(r1.z), bf_lo(r1.w), bf_hi(r1.w)};
            float ss = 0.f;
#pragma unroll
            for (int i = 0; i < 16; ++i) ss += x[i] * x[i];
            ss += __shfl_xor(ss, 1); ss += __shfl_xor(ss, 2); ss += __shfl_xor(ss, 4); ss += __shfl_xor(ss, 8);
            const float rs = 1.0f / sqrtf(ss * (1.0f / 256.0f) + LN_EPS);
            float y[16];
#pragma unroll
            for (int i = 0; i < 16; ++i) { const float gte = rr[i] * __builtin_amdgcn_rcpf(1.0f + __expf(-rr[i])); y[i] = x[i] * rs * gn[c0 + i] * gte; }
            v4u o0, o1; o0.x = cvt_pk_bf16(y[0], y[1]); o0.y = cvt_pk_bf16(y[2], y[3]); o0.z = cvt_pk_bf16(y[4], y[5]); o0.w = cvt_pk_bf16(y[6], y[7]);
            o1.x = cvt_pk_bf16(y[8], y[9]); o1.y = cvt_pk_bf16(y[10], y[11]); o1.z = cvt_pk_bf16(y[12], y[13]); o1.w = cvt_pk_bf16(y[14], y[15]);
            *(v4u*)(OBN + (size_t)m * 1024 + c0) = o0; *(v4u*)(OBN + (size_t)m * 1024 + c0 + 8) = o1;
        }
    }
    const bf16* KA = WSP(bf16, WS_KA); const bf16* VA = WSP(bf16, WS_VA);
    p3_kvout(KA, VA, F.out + OUT_KVP1, 0, 128, 8, 0, TSEQ, TSEQ - 128, 0, 128, gt, ngt);
    p3_kvout(KA, VA, F.out + OUT_KVP2, 1, 512, 8, 0, TSEQ, TSEQ - 512, 0, 512, gt, ngt);
    p3_kvout(KA, VA, F.out + OUT_KVP3, 2, 2048, 8, 0, TSEQ, TSEQ - 2048, 0, 2048, gt, ngt);
    p3_kvout(KA, VA, F.out + OUT_KVS1, 0, 4, 32, NP, 4, 0, 124, 128, gt, ngt);
    p3_kvout(KA, VA, F.out + OUT_KVS2, 1, 4, 32, NP, 4, 0, 508, 512, gt, ngt);
    p3_kvout(KA, VA, F.out + OUT_KVS3, 2, 4, 32, NP, 4, 0, 2044, 2048, gt, ngt);
}

__device__ __forceinline__ void p6_ln1(Frame& F) {
    const int gw = blockIdx.x * NWAVES + F.wave, NGW = F.G * NWAVES, lane = F.lane;
    float* H = WSP(float, WS_H); bf16* X1B = WSP(bf16, WS_X1B); const float* l1g = inptr(F, I_L1G); const float* l1b = inptr(F, I_L1B);
    for (int m = gw; m < MPAD; m += NGW) {
        f32x4* hr = (f32x4*)(H + (size_t)m * 1024) + lane;
        f32x4 v[4]; float s = 0.f;
#pragma unroll
        for (int j = 0; j < 4; ++j) { v[j] = hr[64 * j]; s += (v[j][0] + v[j][1]) + (v[j][2] + v[j][3]); }
        const float mean = wave_sum(s) * (1.f / 1024.f); float s2 = 0.f;
#pragma unroll
        for (int j = 0; j < 4; ++j) { v[j] = v[j] - mean; s2 += (v[j][0] * v[j][0] + v[j][1] * v[j][1]) + (v[j][2] * v[j][2] + v[j][3] * v[j][3]); }
        const float rstd = 1.f / sqrtf(wave_sum(s2) * (1.f / 1024.f) + LN_EPS);
        unsigned long long* o8 = (unsigned long long*)(X1B + (size_t)m * 1024) + lane;
#pragma unroll
        for (int j = 0; j < 4; ++j) { const f32x4 gg = ((const f32x4*)l1g)[lane + 64 * j], bb = ((const f32x4*)l1b)[lane + 64 * j];
            const f32x4 y = v[j] * rstd * gg + bb; hr[64 * j] = y;
            o8[64 * j] = (unsigned long long)cvt_pk_bf16(y[0], y[1]) | ((unsigned long long)cvt_pk_bf16(y[2], y[3]) << 32);
 }
    }
}

__device__ __forceinline__ unsigned mono_key(float f) { const unsigned u = __float_as_uint(f); return u ^ ((unsigned)((int)u >> 31) | 0x80000000u); }
__device__ __forceinline__ float mono_inv(unsigned k) { return __uint_as_float((k & 0x80000000u) ? (k ^ 0x80000000u) : ~k); }
#define CE_DESC(a, b) do { const unsigned _mx = (a) > (b) ? (a) : (b), _mn = (a) > (b) ? (b) : (a); (a) = _mx; (b) = _mn; } while (0)
template <int J> __device__ __forceinline__ void bitonic_step_desc(unsigned (&v)[16]) {
#pragma unroll
    for (int i = 0; i < 16; ++i) if ((i & J) == 0) CE_DESC(v[i], v[i | J]);
}
template <int K, int J> __device__ __forceinline__ void bitonic_step(unsigned (&v)[16]) {
#pragma unroll
    for (int i = 0; i < 16; ++i) if ((i & J) == 0) { if ((i & K) == 0) CE_DESC(v[i], v[i | J]); else CE_DESC(v[i | J], v[i]); }
}
__device__ __forceinline__ void sort16_desc(unsigned (&v)[16]) {
    bitonic_step<2, 1>(v);
    bitonic_step<4, 2>(v); bitonic_step<4, 1>(v);
    bitonic_step<8, 4>(v); bitonic_step<8, 2>(v); bitonic_step<8, 1>(v);
    bitonic_step_desc<8>(v); bitonic_step_desc<4>(v); bitonic_step_desc<2>(v); bitonic_step_desc<1>(v);
}
__device__ __forceinline__ void merge16_desc(unsigned (&T)[16], const unsigned (&N)[16]) {
#pragma unroll
    for (int k = 0; k < 16; ++k) T[k] = T[k] > N[15 - k] ? T[k] : N[15 - k];
    bitonic_step_desc<8>(T); bitonic_step_desc<4>(T); bitonic_step_desc<2>(T); bitonic_step_desc<1>(T);
}
__device__ __forceinline__ void merge_partner16(unsigned (&T)[16]) {
    unsigned P[16];
#pragma unroll
    for (int k = 0; k < 16; ++k) P[k] = (unsigned)__shfl_xor((int)T[k], 32);
    merge16_desc(T, P);
}
__device__ __forceinline__ void p8_topk_item(Frame& F, int item) {
    const int lane = F.lane, hh = lane >> 5, il = lane & 31;
    const int tb = item >> 3, hd = item & 7; const int row = 32 * tb + il;
    const bf16* QN = WSP(bf16, WS_QN); const bf16* KEYS = WSP(bf16, WS_KEYS); int* EIDX = WSP(int, WS_EIDX); float* GATE = WSP(float, WS_GATE);
    LAS unsigned* LK = (LAS unsigned*)(F.lds + F.wave * 8192);
    unsigned T1[16], T2[16];
#pragma unroll
    for (int half = 0; half < 2; ++half) {
        bf16x8 bq[8];
#pragma unroll
        for (int s = 0; s < 8; ++s) bq[s] = *(const bf16x8*)(QN + (size_t)row * 2048 + hd * 256 + half * 128 + 16 * s + 8 * hh);
        unsigned T[16];
#pragma unroll
        for (int k = 0; k < 16; ++k) T[k] = 0u;
        const bf16* kbase = KEYS + ((size_t)(hd * 2 + half) * 128 + il) * 128 + 8 * hh;
        bf16x8 kf[8];
#pragma unroll
        for (int s = 0; s < 8; ++s) kf[s] = *(const bf16x8*)(kbase + 16 * s);
#pragma unroll 1
        for (int kt = 0; kt < 4; ++kt) {
            f32x16 acc;
#pragma unroll
            for (int x = 0; x < 16; ++x) acc[x] = 0.f;
#pragma unroll
            for (int s = 0; s < 8; ++s) acc = MFMA32(kf[s], bq[s], acc);
            if (kt < 3) {
#pragma unroll
                for (int s = 0; s < 8; ++s) kf[s] = *(const bf16x8*)(kbase + (size_t)(32 * (kt + 1)) * 128 + 16 * s); }
            unsigned N[16];
#pragma unroll
            for (int x = 0; x < 16; ++x) { const int idx = 32 * kt + crow(x, hh); N[x] = (mono_key(acc[x]) & ~127u) | (unsigned)(127 - idx); }
            sort16_desc(N);
            merge16_desc(T, N);
        }
        merge_partner16(T);
#pragma unroll
        for (int k = 0; k < 16; ++k) { LK[(half * 16 + k) * 64 + lane] = T[k]; if (half == 0) T1[k] = T[k]; else T2[k] = T[k]; }
    }
    float v1s[8], v2[16];
#pragma unroll
    for (int k = 0; k < 16; ++k) v2[k] = mono_inv(T2[k] & ~127u);
#pragma unroll
    for (int i2 = 0; i2 < 8; ++i2) v1s[i2] = mono_inv((hh ? T1[2 * i2 + 1] : T1[2 * i2]) & ~127u);
    unsigned C[16], D[16];
#pragma unroll
    for (int k = 0; k < 16; ++k) { C[k] = 0u; D[k] = 0u; }
    {   int n = 0;
#pragma unroll
        for (int i2 = 0; i2 < 8; ++i2)
#pragma unroll
            for (int c = 0; c < 16; ++c) if ((2 * i2 + 1) * (c + 1) <= 16) { const unsigned key = (mono_key(v1s[i2] + v2[c]) & ~255u) | (unsigned)(255 - (16 * (2 * i2 + hh) + c));
                if (n < 16) C[n] = key; else D[n - 16] = key; ++n; }
    }
    sort16_desc(C); sort16_desc(D); merge16_desc(C, D);
    merge_partner16(C);
    LDS_WAIT(); asm volatile("" ::: "memory");
    float sv[16]; int ex[16]; float mx = NEG_BIG;
#pragma unroll
    for (int k = 0; k < 16; ++k) { const int si = 255 - (int)(C[k] & 255u), a = si >> 4, c = si & 15;
        const unsigned k1 = LK[a * 64 + lane], k2 = LK[(16 + c) * 64 + lane];
        ex[k] = (127 - (int)(k1 & 127u)) * 128 + (127 - (int)(k2 & 127u)); sv[k] = mono_inv(k1 & ~127u) + mono_inv(k2 & ~127u); mx = fmaxf(mx, sv[k]); }
    float den = 0.f;
#pragma unroll
    for (int k = 0; k < 16; ++k) { sv[k] = __expf(sv[k] - mx); den += sv[k]; }
    const float iden = 1.0f / den;
    if (hh == 0 && row < NTOK) {
#pragma unroll
        for (int k4 = 0; k4 < 4; ++k4) { *(int4*)(EIDX + (size_t)row * 128 + hd * 16 + 4 * k4) = make_int4(ex[4 * k4], ex[4 * k4 + 1], ex[4 * k4 + 2], ex[4 * k4 + 3]);
            *(f32x4*)(GATE + (size_t)row * 128 + hd * 16 + 4 * k4) = (f32x4){sv[4 * k4] * iden, sv[4 * k4 + 1] * iden, sv[4 * k4 + 2] * iden, sv[4 * k4 + 3] * iden}; } }
    LDS_WAIT(); asm volatile("" ::: "memory");
}

constexpr size_t WS_ACTP = WS_QB, WS_COEF = WS_KA, WS_PEERO = WS_RB, WS_X1H = WS_VA;
static_assert(WS_ACTP + (size_t)8 * NTOK * 128 * 4 <= WS_RB && WS_PEERO + (size_t)NTOK * 1024 * 4 <= WS_GB, "peer buffers");
__device__ __forceinline__ float gelu_erf(float x) { return 0.5f * x * (1.0f + erff(x * 0.70710678118654752f)); }
#define DPP_F(x, ctrl) __uint_as_float((unsigned)__builtin_amdgcn_mov_dpp((int)__float_as_uint(x), (ctrl), 0xf, 0xf, true))
__device__ __forceinline__ float dot16_fp8(const float (&x)[16], const v4u u) {
    float a = 0.f;
#pragma unroll
    for (int q = 0; q < 4; ++q) { const f32x2_t lo = __builtin_amdgcn_cvt_pk_f32_fp8((int)u[q], false), hi = __builtin_amdgcn_cvt_pk_f32_fp8((int)u[q], true);
        a += x[4 * q] * lo.x + x[4 * q + 1] * lo.y + x[4 * q + 2] * hi.x + x[4 * q + 3] * hi.y; }
    return a;
}
typedef float f32x4_t __attribute__((ext_vector_type(4)));
typedef int i32x4_t __attribute__((ext_vector_type(4)));
#ifndef PEER_CVT_VIA_F32
#define PEER_CVT_VIA_F32 0
#endif
#ifndef PEER_DOT_F32
#define PEER_DOT_F32 0
#endif
#if PEER_DOT_F32
#define PEER_DOT2(d, a, b) do { const h2_t a__ = (a), b__ = (b); d += (float)a__.x * (float)b__.x + (float)a__.y * (float)b__.y; } while (0)
#else
#define PEER_DOT2(d, a, b) d = __builtin_amdgcn_fdot2((a), (b), d, false)
#endif
template <bool HI> __device__ __forceinline__ h2_t fp8x2_to_h2(int w) {
#if PEER_CVT_VIA_F32
    const f32x2_t f = __builtin_amdgcn_cvt_pk_f32_fp8(w, HI); return (h2_t){(_Float16)f.x, (_Float16)f.y};
#else
    return __builtin_amdgcn_cvt_scalef32_pk_f16_fp8(w, 1.0f, HI);
#endif
}
template <unsigned EMASK> __device__ __forceinline__ void peer_u_phase_t(Frame& F) {
    const int lane = F.lane, p = lane >> 3, q = lane & 7, c = blockIdx.x & 7, wv = (blockIdx.x >> 3) * NWAVES + F.wave, nwv = (F.G >> 3) * NWAVES;
    const int* EIDX = WSP(int, WS_EIDX) + 16 * p; float* ACTP = WSP(float, WS_ACTP) + (size_t)c * NTOK * 128 + 16 * p + 2 * q;
    const unsigned char* U8 = WSP(unsigned char, WS_UT) + ((size_t)c * 16384 << 7) + 16 * q;
#define PU_LOADE(EV, M) do { _Pragma("unroll") for (int t_ = 0; t_ < 4; ++t_) EV[t_] = *(const i32x4_t*)(EIDX + (size_t)(M) * 128 + 4 * t_); } while (0)
#define PU_ISSUE(UR, EV) do { _Pragma("unroll") for (int g = 0; g < 16; ++g) UR[g] = *(const v4u*)(U8 + (((unsigned)EV[g >> 2][g & 3] & EMASK) << 7)); } while (0)
#define PU_BODY(UR, UN, M) do { const int m_ = (M); const int m1_ = m_ + nwv, m2_ = m_ + 2 * nwv; \
        if (m1_ < NTOK) PU_ISSUE(UN, ev); \
        if (m2_ < NTOK) PU_LOADE(ev, m2_); \
        const float* xf_ = (const float*)(F.ws + WS_H) + (size_t)m_ * 1024 + 128 * c + 16 * q; \
        const f32x4 xa_ = *(const f32x4*)xf_, xb_ = *(const f32x4*)(xf_ + 4), xc_ = *(const f32x4*)(xf_ + 8), xd_ = *(const f32x4*)(xf_ + 12); \
        const h2_t xh[8] = {(h2_t){(_Float16)xa_[0], (_Float16)xa_[1]}, (h2_t){(_Float16)xa_[2], (_Float16)xa_[3]}, (h2_t){(_Float16)xb_[0], (_Float16)xb_[1]}, (h2_t){(_Float16)xb_[2], (_Float16)xb_[3]}, (h2_t){(_Float16)xc_[0], (_Float16)xc_[1]}, (h2_t){(_Float16)xc_[2], (_Float16)xc_[3]}, (h2_t){(_Float16)xd_[0], (_Float16)xd_[1]}, (h2_t){(_Float16)xd_[2], (_Float16)xd_[3]}}; \
        float a[16]; \
        _Pragma("unroll") for (int g = 0; g < 16; ++g) { float d_ = 0.f; \
            _Pragma("unroll") for (int t_ = 0; t_ < 4; ++t_) { PEER_DOT2(d_, fp8x2_to_h2<false>((int)UR[g][t_]), xh[2 * t_]); PEER_DOT2(d_, fp8x2_to_h2<true>((int)UR[g][t_]), xh[2 * t_ + 1]); } \
            a[g] = d_; if ((g & 1) == 1 && g < 15) asm volatile("" : "+v"(a[g - 1]), "+v"(a[g]), "+v"(UR[(g + 1) & 15]), "+v"(UR[(g + 2) & 15])); } \
        float b8[8], b4[4], b2[2]; \
        { const bool up = (q & 4) != 0; _Pragma("unroll") for (int k = 0; k < 8; ++k) { const float send = up ? a[k] : a[k + 8], keep = up ? a[k + 8] : a[k]; b8[k] = keep + DPP_F(send, 0x141); } } \
        { const bool up = (q & 2) != 0; _Pragma("unroll") for (int k = 0; k < 4; ++k) { const float send = up ? b8[k] : b8[k + 4], keep = up ? b8[k + 4] : b8[k]; b4[k] = keep + DPP_F(send, 0x4E); } } \
        { const bool up = (q & 1) != 0; _Pragma("unroll") for (int k = 0; k < 2; ++k) { const float send = up ? b4[k] : b4[k + 2], keep = up ? b4[k + 2] : b4[k]; b2[k] = keep + DPP_F(send, 0xB1); } } \
        *(f32x2_t*)(ACTP + (size_t)m_ * 128) = (f32x2_t){b2[0], b2[1]}; } while (0)
    int m = wv; if (m >= NTOK) return;
    i32x4_t ev[4];
    PU_LOADE(ev, m);
    v4u ua[16], ub[16];
    PU_ISSUE(ua, ev);
    if (m + nwv < NTOK) PU_LOADE(ev, m + nwv);
    for (;;) {
        PU_BODY(ua, ub, m); m += nwv; if (m >= NTOK) break;
        PU_BODY(ub, ua, m); m += nwv; if (m >= NTOK) break;
    }
#undef PU_LOADE
#undef PU_ISSUE
#undef PU_BODY
}
__device__ __forceinline__ void peer_u_phase(Frame& F) { peer_u_phase_t<0xffffffffu>(F); }
__device__ __forceinline__ void peer_coef_phase(Frame& F) {
    const int gw = blockIdx.x * NWAVES + F.wave, NGW = F.G * NWAVES, lane = F.lane;
    const float* ACTP = WSP(float, WS_ACTP); const float* GATE = WSP(float, WS_GATE); float* COEF = WSP(float, WS_COEF);
    for (int m = gw; m < NTOK; m += NGW) {
#pragma unroll
        for (int hf = 0; hf < 2; ++hf) { const int k = lane + 64 * hf; float a = 0.f;
#pragma unroll
            for (int c = 0; c < 8; ++c) a += ACTP[((size_t)c * NTOK + m) * 128 + k];
            COEF[(size_t)m * 128 + k] = GATE[(size_t)m * 128 + k] * gelu_erf(a * (1.0f / U_SCALE)); }
    }
}
__device__ __forceinline__ void peer_v_phase(Frame& F) {
    const int lane = F.lane, p = lane >> 3, q = lane & 7, c = blockIdx.x & 7, wv = (blockIdx.x >> 3) * NWAVES + F.wave, nwv = (F.G >> 3) * NWAVES;
    const int* EIDX = WSP(int, WS_EIDX) + 16 * p; const float* COEF = WSP(float, WS_COEF) + 16 * p; bf16* PEERO = WSP(bf16, WS_PEERO) + 128 * c + 16 * q + 2 * p;
    const unsigned char* V8 = WSP(unsigned char, WS_VT) + ((size_t)c * 16384 << 7) + 16 * q;
    int m = wv; if (m >= NTOK) return;
    i32x4_t ev[4];
#pragma unroll
    for (int t = 0; t < 4; ++t) ev[t] = *(const i32x4_t*)(EIDX + (size_t)m * 128 + 4 * t);
    v4u vr[16];
#pragma unroll
    for (int g = 0; g < 16; ++g) vr[g] = *(const v4u*)(V8 + ((unsigned)ev[g >> 2][g & 3] << 7));
    for (;;) {
        f32x4_t cv[4];
#pragma unroll
        for (int t = 0; t < 4; ++t) cv[t] = *(const f32x4_t*)(COEF + (size_t)m * 128 + 4 * t);
        const int mn = m + nwv; const bool more = mn < NTOK;
        if (more) {
#pragma unroll
            for (int t = 0; t < 4; ++t) ev[t] = *(const i32x4_t*)(EIDX + (size_t)mn * 128 + 4 * t); }
        h2_t acc[8];
#pragma unroll
        for (int i = 0; i < 8; ++i) acc[i] = (h2_t){(_Float16)0.f, (_Float16)0.f};
#pragma unroll
        for (int g = 0; g < 16; ++g) { const _Float16 cfh = (_Float16)cv[g >> 2][g & 3]; const h2_t cf2 = {cfh, cfh};
#pragma unroll
            for (int t = 0; t < 4; ++t) { acc[2 * t] += fp8x2_to_h2<false>((int)vr[g][t]) * cf2; acc[2 * t + 1] += fp8x2_to_h2<true>((int)vr[g][t]) * cf2; }
            if ((g & 3) == 3 && g < 15) asm volatile("" : "+v"(acc[0]), "+v"(acc[1]), "+v"(acc[2]), "+v"(acc[3]), "+v"(acc[4]), "+v"(acc[5]), "+v"(acc[6]), "+v"(acc[7]), "+v"(vr[(g + 1) & 15]), "+v"(vr[(g + 2) & 15]), "+v"(vr[(g + 3) & 15]), "+v"(vr[(g + 4) & 15])); }
        __builtin_amdgcn_sched_barrier(0);
        if (more) {
#pragma unroll
            for (int g = 0; g < 16; ++g) vr[g] = *(const v4u*)(V8 + ((unsigned)ev[g >> 2][g & 3] << 7)); }
        __builtin_amdgcn_sched_barrier(0);
        unsigned w[8];
#pragma unroll
        for (int i = 0; i < 8; ++i) w[i] = __builtin_bit_cast(unsigned, acc[i]);
        h2_t r4[4], r2[2], r1;
        { const bool up = (lane & 32) != 0;
#pragma unroll
          for (int k = 0; k < 4; ++k) { const unsigned send = up ? w[k] : w[k + 4], keep = up ? w[k + 4] : w[k]; r4[k] = __builtin_bit_cast(h2_t, keep) + __builtin_bit_cast(h2_t, (unsigned)__shfl_xor((int)send, 32)); } }
        { const bool up = (lane & 16) != 0;
#pragma unroll
          for (int k = 0; k < 2; ++k) { const unsigned a_ = __builtin_bit_cast(unsigned, r4[k]), b_ = __builtin_bit_cast(unsigned, r4[k + 2]); const unsigned send = up ? a_ : b_, keep = up ? b_ : a_; r2[k] = __builtin_bit_cast(h2_t, keep) + __builtin_bit_cast(h2_t, (unsigned)__shfl_xor((int)send, 16)); } }
        { const bool up = (lane & 8) != 0; const unsigned a_ = __builtin_bit_cast(unsigned, r2[0]), b_ = __builtin_bit_cast(unsigned, r2[1]); const unsigned send = up ? a_ : b_, keep = up ? b_ : a_;
          r1 = __builtin_bit_cast(h2_t, keep) + __builtin_bit_cast(h2_t, (unsigned)__builtin_amdgcn_mov_dpp((int)send, 0x128, 0xf, 0xf, true)); }
        *(unsigned*)(PEERO + (size_t)m * 1024) = cvt_pk_bf16((float)r1.x * (1.0f / V_SCALE), (float)r1.y * (1.0f / V_SCALE));
        if (!more) break;
        m = mn;
    }
}
__device__ __forceinline__ void peer_ln2_phase(Frame& F) {
    const int gw = blockIdx.x * NWAVES + F.wave, NGW = F.G * NWAVES, lane = F.lane;
    const float* X1 = WSP(float, WS_H); const bf16* PEERO = WSP(bf16, WS_PEERO); const float* l2g = inptr(F, I_L2G); const float* l2b = inptr(F, I_L2B);
    for (int m = gw; m < NTOK; m += NGW) {
        float acc[16]; float s = 0.f;
#pragma unroll
        for (int t = 0; t < 4; ++t) { const f32x4 a = *(const f32x4*)(X1 + (size_t)m * 1024 + 16 * lane + 4 * t); const v2u pw = *(const v2u*)(PEERO + (size_t)m * 1024 + 16 * lane + 4 * t);
            const float pz[4] = {bf_lo(pw.x), bf_hi(pw.x), bf_lo(pw.y), bf_hi(pw.y)};
#pragma unroll
            for (int i = 0; i < 4; ++i) { acc[4 * t + i] = ALPHA * a[i] + pz[i]; s += acc[4 * t + i]; } }
        const float mean = wave_sum(s) * (1.f / 1024.f); float s2 = 0.f;
#pragma unroll
        for (int i = 0; i < 16; ++i) { acc[i] -= mean; s2 += acc[i] * acc[i]; }
        const float rstd = 1.f / sqrtf(wave_sum(s2) * (1.f / 1024.f) + LN_EPS);
        float* yo = m < NP ? F.out + OUT_YP + (size_t)m * 1024 : F.out + OUT_YS + (size_t)(m - NP) * 1024;
#pragma unroll
        for (int t = 0; t < 4; ++t) { const int cc = 16 * lane + 4 * t; const f32x4 gg = *(const f32x4*)(l2g + cc), bb = *(const f32x4*)(l2b + cc);
            *(f32x4*)(yo + cc) = (f32x4){acc[4 * t] * rstd * gg[0] + bb[0], acc[4 * t + 1] * rstd * gg[1] + bb[1], acc[4 * t + 2] * rstd * gg[2] + bb[2], acc[4 * t + 3] * rstd * gg[3] + bb[3]}; }
    }
}

template <class Epi> __device__ __forceinline__ void skinny_sample_gemm(Frame& F, const bf16* A, const bf16* Bt, int K, const Epi& epi) {
    typedef float f32x4a __attribute__((ext_vector_type(4)));
    const int lane = F.lane, r = lane & 15, kg = lane >> 4;
    for (int strip = blockIdx.x; strip < 64; strip += F.G) {
        const bf16* ap = A + (size_t)(NP + 16 * F.wave + r) * K + 8 * kg;
        const bf16* bp = Bt + (size_t)(16 * strip + r) * K + 8 * kg;
        f32x4a acc = {0.f, 0.f, 0.f, 0.f};
        for (int s0 = 0; s0 < K / 32; s0 += 8) { bf16x8 af[8], bfr[8];
#pragma unroll
            for (int u = 0; u < 8; ++u) { af[u] = *(const bf16x8*)(ap + 32 * (s0 + u)); bfr[u] = *(const bf16x8*)(bp + 32 * (s0 + u)); }
#pragma unroll
            for (int u = 0; u < 8; ++u) acc = __builtin_amdgcn_mfma_f32_16x16x32_bf16(af[u], bfr[u], acc, 0, 0, 0); }
#pragma unroll
        for (int i = 0; i < 4; ++i) epi(NP + 16 * F.wave + 4 * kg + i, 16 * strip + r, acc[i]);
    }
}

struct Args { const float* in[22]; float* out; unsigned char* ws; int ph_lo, ph_hi; };
constexpr int NPHASE = 14;
__global__ void __launch_bounds__(NTHR, 2) mk_fwd(Args args) {
    extern __shared__ __attribute__((aligned(16))) unsigned char lds[];
    Frame F;
    F.lds = (LAS unsigned char*)lds; F.MISC = (volatile LAS unsigned*)(F.lds + MISC_OFF);
    F.tid = threadIdx.x; F.lane = F.tid & 63; F.wave = __builtin_amdgcn_readfirstlane(F.tid >> 6); F.G = gridDim.x;
    F.ws = args.ws; F.out = args.out; F.ctl = (gu32*)(args.ws + WS_CTL); F.tp = 0ull;
    for (int u = F.tid; u < (LDS_BYTES - MISC_OFF) / 4; u += NTHR) ((LAS unsigned*)(F.lds + MISC_OFF))[u] = 0u;
    __syncthreads();
    if (F.tid < 22) ((LAS unsigned long long*)(F.lds + PTR_OFF))[F.tid] = (unsigned long long)args.in[F.tid];
    __syncthreads();
    const int lo = args.ph_lo, hi = args.ph_hi;
    const bool multi = (hi - lo) > 1;
    XcdBarrier bar; bar.bar = (unsigned*)(F.ctl + CW_BAR); bar.x = 0; bar.st = nullptr;
    if (multi) bar = xcd_barrier_post((unsigned*)(F.ctl + CW_BAR), F.MISC + 8);
#ifdef ONLY_PHASE
#define IN(k) ((k) == ONLY_PHASE && lo <= (k) && (k) < hi)
#else
#define IN(k) (lo <= (k) && (k) < hi)
#endif
#ifdef PROBE_PHASE
    unsigned long long t_prev = __builtin_amdgcn_s_memrealtime(), t_probe = 0ull;
#define STAMP(k) do { const unsigned long long _t = __builtin_amdgcn_s_memrealtime(); if ((k) == PROBE_PHASE && blockIdx.x == 0) t_probe = _t - t_prev; t_prev = _t; } while (0)
#else
#define STAMP(k) do { } while (0)
#endif
#define SEAM(k) do { if (IN(k) && IN((k) + 1)) xcd_barrier(bar); STAMP(k); } while (0)
    if (IN(0)) { p0_prologue(F); }
    if (IN(0) && IN(1)) { cooperative_groups::this_grid().sync(); } STAMP(0);
    if (IN(1)) {
        if ((int)blockIdx.x >= F.G - NCOPYWG) kvshift_loop<true>(F);
        else {
        pg8::Gemm g{WSP(bf16, WS_XB), WSP(bf16, WS_WIN), MPAD, NPROJ, 1024, MPAD / 256 - 1}; pg8::StaticOrder S; S.init(MPAD, NPROJ, F.G - NCOPYWG, (int)blockIdx.x);
        pg8::EpiProj E{WSP(bf16, WS_QA), WSP(bf16, WS_KA), WSP(bf16, WS_VA), WSP(bf16, WS_QB), WSP(bf16, WS_KB), WSP(bf16, WS_VB), WSP(bf16, WS_RB), WSP(bf16, WS_GA), WSP(bf16, WS_GB)};
        pg8::gemm_phase<pg8::EpiProj, pg8::StaticOrder, true, true>(F.lds, g, S, E);
        if (F.tid == 0) __hip_atomic_fetch_add(F.ctl + CW_GDONE, 1u, RLX_AGENT);
        }
    } SEAM(1);
    if (IN(2)) { p2_prep(F); } SEAM(2);
    if (IN(3)) { p2_mixers(F); } SEAM(3);
    if (IN(4)) { p3_merge(F); } SEAM(4);
    if (IN(5)) {
        bf16* T1 = WSP(bf16, WS_T1); bf16* MIXp = WSP(bf16, WS_MIX); const bf16* GAp = WSP(bf16, WS_GA); const bf16* GBp = WSP(bf16, WS_GB);
        { pg8::Gemm g{WSP(bf16, WS_OAM), WSP(bf16, WS_WA), NP, 1024, 512, -1}; pg8::StaticOrder S; S.init(NP, 1024, F.G, (int)blockIdx.x, false);
          pg8::EpiGate<false> E{WSP(bf16, WS_GA), nullptr, WSP(bf16, WS_T1)};
          pg8::gemm_phase<pg8::EpiGate<false>, pg8::StaticOrder, true, true>(F.lds, g, S, E); }
        skinny_sample_gemm(F, WSP(bf16, WS_OAM), WSP(bf16, WS_WA), 512, [=](int row, int col, float v) { const size_t o = (size_t)row * 1024 + col; T1[o] = f2bf(pg8::sigmoidf_(bf2f(GAp[o])) * v); });
        VM_WAIT(); __syncthreads();
        { pg8::Gemm g{WSP(bf16, WS_OBN), WSP(bf16, WS_WB), NP, 1024, 1024, -1}; pg8::StaticOrder S; S.init(NP, 1024, F.G, (int)blockIdx.x, false);
          pg8::EpiGate<true> E{WSP(bf16, WS_GB), WSP(bf16, WS_T1), WSP(bf16, WS_MIX)};
          pg8::gemm_phase<pg8::EpiGate<true>, pg8::StaticOrder, true, true>(F.lds, g, S, E); }
        skinny_sample_gemm(F, WSP(bf16, WS_OBN), WSP(bf16, WS_WB), 1024, [=](int row, int col, float v) { const size_t o = (size_t)row * 1024 + col; MIXp[o] = f2bf(bf2f(T1[o]) + pg8::sigmoidf_(bf2f(GBp[o])) * v); });
    } SEAM(5);
    if (IN(6)) {
        pg8::Gemm g{WSP(bf16, WS_MIX), WSP(bf16, WS_WO), NP, 1024, 1024, -1}; pg8::StaticOrder S; S.init(NP, 1024, F.G, (int)blockIdx.x, false);
        pg8::EpiOut E{inptr(F, I_XP), inptr(F, I_XS), WSP(float, WS_H), NP, NTOK, ALPHA};
        pg8::gemm_phase<pg8::EpiOut, pg8::StaticOrder, true, true>(F.lds, g, S, E);
        const float* xsp = inptr(F, I_XS); float* Hp = WSP(float, WS_H);
        skinny_sample_gemm(F, WSP(bf16, WS_MIX), WSP(bf16, WS_WO), 1024, [=](int row, int col, float v) { Hp[(size_t)row * 1024 + col] = ALPHA * xsp[(size_t)(row - NP) * 1024 + col] + v; });
    } SEAM(6);
    if (IN(7)) { p6_ln1(F); } SEAM(7);
    if (IN(8)) {
        pg8::Gemm g{WSP(bf16, WS_X1B), WSP(bf16, WS_WQ), MPAD, 2048, 1024, MPAD / 256 - 1}; pg8::StaticOrder S; S.init(MPAD, 2048, F.G, (int)blockIdx.x);
        pg8::EpiHeadNorm E{WSP(bf16, WS_QN), 2048, F.lds + STATS_OFF, LN_EPS};
        pg8::gemm_phase<pg8::EpiHeadNorm, pg8::StaticOrder, true, true>(F.lds, g, S, E);
    } SEAM(8);
    if (IN(9)) {
        const int gw = blockIdx.x * NWAVES + F.wave, NGW = F.G * NWAVES;
        for (int it = gw; it < (NP / 32) * 8; it += NGW) p8_topk_item(F, it);
        for (int e = gw; e < 64 * (NS / 32) * 8; e += NGW) if ((e & 63) == 0) p8_topk_item(F, (NP / 32) * 8 + (e >> 6));
    } SEAM(9);
#if defined(PROBE_PHASE) && PROBE_PHASE >= 300 && PROBE_PHASE < 310
    if (IN(10)) { const unsigned long long td0 = __builtin_amdgcn_s_memrealtime();
        if (PROBE_PHASE == 300) peer_u_phase_t<2047u>(F); else if (PROBE_PHASE == 301) peer_u_phase_t<8191u>(F); else peer_u_phase_t<0xffffffffu>(F);
        xcd_barrier(bar); if (blockIdx.x == 0) F.tp = __builtin_amdgcn_s_memrealtime() - td0; }
#endif
    if (IN(10)) { peer_u_phase(F); } SEAM(10);
    if (IN(11)) { peer_coef_phase(F); } SEAM(11);
    if (IN(12)) { peer_v_phase(F); } SEAM(12);
    if (IN(13)) { peer_ln2_phase(F); }
#ifdef PROBE_PHASE
    if (PROBE_PHASE == 13) { xcd_barrier(bar); STAMP(13); }
    if (PROBE_PHASE == 200 || PROBE_PHASE == 201) {
        unsigned* xm = (unsigned*)(F.ws + WS_END);
        if (F.tid == 0) __hip_atomic_store(xm + blockIdx.x, xb_xcc_id() + 1u, RLX_AGENT);
        xcd_barrier(bar);
        if (blockIdx.x == 0 && F.tid == 0) { bool ok = true;
            for (int b = 0; b < (int)gridDim.x; ++b) { const unsigned a = __hip_atomic_load(xm + b, RLX_AGENT), r = __hip_atomic_load(xm + (PROBE_PHASE == 200 ? (b & 7) : (b & ~31)), RLX_AGENT); if (a != r) ok = false; }
            t_probe = ok ? 50000ull : 0ull; }
    }
    if ((PROBE_PHASE >= 100 && PROBE_PHASE < 200) || PROBE_PHASE >= 300) t_probe = F.tp;
    if (F.tid == 0 && t_probe != 0ull) { const unsigned long long t0 = __builtin_amdgcn_s_memrealtime(); while (__builtin_amdgcn_s_memrealtime() - t0 < PROBE_GAIN * t_probe) __builtin_amdgcn_s_sleep(8); }
#endif
#undef IN
#undef SEAM
}

extern "C" void kernel_launch(void* const* d_in, const int* in_sizes, int n_in, void* d_out, int out_size, void* d_ws, size_t ws_size, hipStream_t stream) {
    static int grid = 0;
    if (grid == 0) {
        if (n_in != 22 || (size_t)out_size != OUT_TOTAL || ws_size < WS_END) { fprintf(stderr, "kernel_launch: unexpected shapes: n_in %d out %d ws %zu (need >= %zu)\n", n_in, out_size, ws_size, (size_t)WS_END); grid = -1; return; }
        int dev = 0, cus = 0, per_cu = 0;
        if (hipGetDevice(&dev) != hipSuccess || hipDeviceGetAttribute(&cus, hipDeviceAttributeMultiprocessorCount, dev) != hipSuccess) { grid = -1; return; }
        if (hipFuncSetAttribute((const void*)mk_fwd, hipFuncAttributeMaxDynamicSharedMemorySize, LDS_BYTES) != hipSuccess) { fprintf(stderr, "kernel_launch: hipFuncSetAttribute failed\n"); grid = -1; return; }
        if (hipOccupancyMaxActiveBlocksPerMultiprocessor(&per_cu, (const void*)mk_fwd, NTHR, LDS_BYTES) != hipSuccess || per_cu < 1) fprintf(stderr, "kernel_launch: occupancy query reports %d blocks per CU\n", per_cu);
        (void)hipGetLastError();
        grid = cus;
    }
    if (grid < 0) return;
    (void)hipMemsetAsync((char*)d_ws + WS_CTL, 0, CTL_ZERO_BYTES, stream);
    Args a{};
    for (int i = 0; i < 22; ++i) a.in[i] = (const float*)d_in[i];
    a.out = (float*)d_out; a.ws = (unsigned char*)d_ws;
#if MK_SINGLE
    a.ph_lo = 0; a.ph_hi = NPHASE;
    void* kargs[] = {&a};
    hipError_t e = hipLaunchCooperativeKernel((const void*)mk_fwd, dim3(grid), dim3(NTHR), kargs, LDS_BYTES, stream);
    if (e != hipSuccess) fprintf(stderr, "kernel_launch: cooperative launch failed: %s\n", hipGetErrorString(e));
#else
    for (int p = 0; p < NPHASE; ++p) { a.ph_lo = p; a.ph_hi = p + 1; hipLaunchKernelGGL(mk_fwd, dim3(grid), dim3(NTHR), LDS_BYTES, stream, a); }
#endif
}
```

```cpp
#include <hip/hip_runtime.h>
#include <hip/hip_cooperative_groups.h>
#include <cstdio>
#include <cstdint>
#ifndef MK_SINGLE
#define MK_SINGLE 1
#endif
namespace pg8 {
#define PG8_LAS __attribute__((address_space(3)))
typedef unsigned short bf16_t;
typedef short bf16x8 __attribute__((ext_vector_type(8)));
typedef float f32x4 __attribute__((ext_vector_type(4)));
typedef unsigned u32x4 __attribute__((ext_vector_type(4)));
constexpr int BM = 256, BK = 64, HALF = 128, HTB = HALF * BK * 2  , STAGE_BYTES = 8 * HTB, NXCD = 8, WGM = 8;

__host__ __device__ __forceinline__ int lds_byte(int r, int c) { const int st = (r >> 4) * 2 + (c >> 5), rr = r & 15, cc = c & 31, ob = rr * 64 + cc * 2; return st * 1024 + (ob ^ (((ob >> 9) & 1) << 5)); }
__host__ __device__ __forceinline__ void stage_rc(int b, int& R, int& C) { const int st = b / 1024, sb = b % 1024, swz = sb ^ (((sb >> 9) & 1) << 5); R = (st >> 1) * 16 + swz / 64; C = (st & 1) * 32 + (swz % 64) / 2; }
__host__ __device__ __forceinline__ int perm32(int rho) { const int n = rho >> 4, i = rho & 15; return 8 * (i >> 2) + 4 * n + (i & 3); }

struct Unit { int pm, pn; };
struct Gemm { const bf16_t* A; const bf16_t* Bt; int M, N, K; int half_pm = -1; };

struct StaticOrder {
    int nM, nN, nwg, G, c, nfull;
    __host__ __device__ void init(int M, int N, int G_, int c_, bool half = true) { nM = half ? M / BM - 1 : M / BM; nN = N / BM; nfull = nM * nN; nwg = half ? nfull + nN : nfull; G = G_; c = c_; }
    __host__ __device__ bool next(int i, Unit& u) const {
        const long L = (long)i * G + c; if (L >= nwg) return false;
        if (L >= nfull) { u.pm = nM; u.pn = (int)(L - nfull); return true; }
        int wgid = (int)L; { const int q = nfull / NXCD, r = nfull % NXCD, xcd = wgid % NXCD, off = wgid / NXCD; wgid = (xcd < r ? xcd * (q + 1) : r * (q + 1) + (xcd - r) * q) + off; }
        const int nig = WGM * nN, gid = wgid / nig, fm = gid * WGM, gsz = (nM - fm) < WGM ? (nM - fm) : WGM;
        u.pm = fm + ((wgid % nig) % gsz); u.pn = (wgid % nig) / gsz; return true;
    }
    __device__ __forceinline__ void a_ready(const Unit&) const {}
    __device__ __forceinline__ void done(const Unit&) const {}
};


typedef float f32x2 __attribute__((ext_vector_type(2)));
typedef __bf16 bf16x2_t __attribute__((ext_vector_type(2)));
__device__ __forceinline__ unsigned cvt_pk_bf16(float lo, float hi) { f32x2 v = {lo, hi}; bf16x2_t b = __builtin_convertvector(v, bf16x2_t); return __builtin_bit_cast(unsigned, b); }
__device__ __forceinline__ float bf_lo(unsigned w) { return __uint_as_float(w << 16); }
__device__ __forceinline__ float bf_hi(unsigned w) { return __uint_as_float(w & 0xffff0000u); }
__device__ __forceinline__ float sigmoidf_(float x) { return __builtin_amdgcn_rcpf(1.0f + __expf(-x)); }

struct EpiProj {
    static constexpr bool PERM = true, AFTER_DRAIN = false;
    bf16_t *qa, *ka, *va, *qb, *kb, *vb, *rb, *ga, *gb;
    __device__ __forceinline__ void operator()(const f32x4 (&acc)[2][2][4][2], const Unit& u, int wr, int wc, int fr, int fq) const {
        const int pn = u.pn; bf16_t* base; int ldc, ct; float sc = 1.f;
        if (pn < 6) { base = qa; ldc = 1536; ct = pn; sc = 0.125f; }
        else if (pn < 12) { base = ka; ldc = 1536; ct = pn - 6; }
        else if (pn < 18) { base = va; ldc = 1536; ct = pn - 12; }
        else if (pn < 20) { base = qb; ldc = 512; ct = pn - 18; }
        else if (pn < 22) { base = kb; ldc = 512; ct = pn - 20; }
        else if (pn < 26) { base = vb; ldc = 1024; ct = pn - 22; }
        else if (pn < 30) { base = rb; ldc = 1024; ct = pn - 26; }
        else if (pn < 34) { base = ga; ldc = 1024; ct = pn - 30; }
        else { base = gb; ldc = 1024; ct = pn - 34; }
        const int row0 = u.pm * BM + wr * 64 + fr, col0 = ct * BM + wc * 32 + 8 * fq;
#pragma unroll
        for (int ai = 0; ai < 2; ++ai)
#pragma unroll
            for (int m = 0; m < 4; ++m) { bf16_t* rowp = base + (size_t)(row0 + ai * HALF + m * 16) * ldc + col0;
#pragma unroll
                for (int bj = 0; bj < 2; ++bj) { const f32x4 v0 = acc[ai][bj][m][0] * sc, v1 = acc[ai][bj][m][1] * sc;
                    u32x4 w; w.x = cvt_pk_bf16(v0[0], v0[1]); w.y = cvt_pk_bf16(v0[2], v0[3]); w.z = cvt_pk_bf16(v1[0], v1[1]); w.w = cvt_pk_bf16(v1[2], v1[3]);
                    *(u32x4*)(rowp + bj * HALF) = w; } }
    }
};
template <bool ADD> struct EpiGate {
    static constexpr bool PERM = true, AFTER_DRAIN = false;
    const bf16_t* G; const bf16_t* T1; bf16_t* O;
    __device__ __forceinline__ void operator()(const f32x4 (&acc)[2][2][4][2], const Unit& u, int wr, int wc, int fr, int fq) const {
        const int row0 = u.pm * BM + wr * 64 + fr, col0 = u.pn * BM + wc * 32 + 8 * fq;
#pragma unroll
        for (int ai = 0; ai < 2; ++ai)
#pragma unroll
            for (int m = 0; m < 4; ++m) { const size_t off = (size_t)(row0 + ai * HALF + m * 16) * 1024 + col0;
#pragma unroll
                for (int bj = 0; bj < 2; ++bj) {
                    const u32x4 g = *(const u32x4*)(G + off + bj * HALF);
                    f32x4 v0 = acc[ai][bj][m][0], v1 = acc[ai][bj][m][1];
                    v0[0] *= sigmoidf_(bf_lo(g.x)); v0[1] *= sigmoidf_(bf_hi(g.x)); v0[2] *= sigmoidf_(bf_lo(g.y)); v0[3] *= sigmoidf_(bf_hi(g.y));
                    v1[0] *= sigmoidf_(bf_lo(g.z)); v1[1] *= sigmoidf_(bf_hi(g.z)); v1[2] *= sigmoidf_(bf_lo(g.w)); v1[3] *= sigmoidf_(bf_hi(g.w));
                    if (ADD) { const u32x4 t = *(const u32x4*)(T1 + off + bj * HALF);
                        v0[0] += bf_lo(t.x); v0[1] += bf_hi(t.x); v0[2] += bf_lo(t.y); v0[3] += bf_hi(t.y);
                        v1[0] += bf_lo(t.z); v1[1] += bf_hi(t.z); v1[2] += bf_lo(t.w); v1[3] += bf_hi(t.w); }
                    u32x4 w; w.x = cvt_pk_bf16(v0[0], v0[1]); w.y = cvt_pk_bf16(v0[2], v0[3]); w.z = cvt_pk_bf16(v1[0], v1[1]); w.w = cvt_pk_bf16(v1[2], v1[3]);
                    *(u32x4*)(O + off + bj * HALF) = w; } }
    }
};
struct EpiOut {
    static constexpr bool PERM = false, AFTER_DRAIN = false;
    const float* xp; const float* xs; float* H; int np, ntok; float alpha;
    __device__ __forceinline__ void operator()(const f32x4 (&acc)[2][2][4][2], const Unit& u, int wr, int wc, int fr, int fq) const {
        const int row0 = u.pm * BM + wr * 64 + fr, col0 = u.pn * BM + wc * 32 + 4 * fq;
#pragma unroll
        for (int ai = 0; ai < 2; ++ai)
#pragma unroll
            for (int m = 0; m < 4; ++m) { const int r = row0 + ai * HALF + m * 16;
                const float* xr = r < np ? xp + (size_t)r * 1024 : xs + (size_t)(r < ntok ? r - np : 0) * 1024; const bool real = r < ntok;
#pragma unroll
                for (int bj = 0; bj < 2; ++bj)
#pragma unroll
                    for (int n = 0; n < 2; ++n) { const int c = col0 + bj * HALF + n * 16;
                        f32x4 xv = *(const f32x4*)(xr + c); if (!real) xv = (f32x4){0.f, 0.f, 0.f, 0.f};
                        *(f32x4*)(H + (size_t)r * 1024 + c) = xv * alpha + acc[ai][bj][m][n]; } }
    }
};
struct EpiHeadNorm {
    static constexpr bool PERM = true, AFTER_DRAIN = false;
    bf16_t* O; int ldc; PG8_LAS unsigned char* st; float eps;
    __device__ __forceinline__ void operator()(const f32x4 (&acc)[2][2][4][2], const Unit& u, int wr, int wc, int fr, int fq) const {
        PG8_LAS f32x2* P = (PG8_LAS f32x2*)st; PG8_LAS f32x2* S = (PG8_LAS f32x2*)(st + 8192);
        const int lane = fq * 16 + fr, wid = wr * 4 + wc;
#pragma unroll
        for (int ai = 0; ai < 2; ++ai)
#pragma unroll
            for (int m = 0; m < 4; ++m) {
                float s = 0.f;
#pragma unroll
                for (int bj = 0; bj < 2; ++bj)
#pragma unroll
                    for (int n = 0; n < 2; ++n) { const f32x4 x = acc[ai][bj][m][n]; s += (x[0] + x[1]) + (x[2] + x[3]); }
                s += __shfl_xor(s, 16); s += __shfl_xor(s, 32);
                const float mw = s * (1.0f / 64.0f); float q = 0.f;
#pragma unroll
                for (int bj = 0; bj < 2; ++bj)
#pragma unroll
                    for (int n = 0; n < 2; ++n) { const f32x4 d = acc[ai][bj][m][n] - mw; q += (d[0] * d[0] + d[1] * d[1]) + (d[2] * d[2] + d[3] * d[3]); }
                q += __shfl_xor(q, 16); q += __shfl_xor(q, 32);
                if (fq == 0) P[(ai * HALF + wr * 64 + m * 16 + fr) * 4 + wc] = (f32x2){mw, q};
            }
        asm volatile("s_waitcnt lgkmcnt(0)" ::: "memory"); __builtin_amdgcn_s_barrier(); asm volatile("" ::: "memory");
        const int row = wid * 32 + (lane & 31);
        if (lane < 32) {
            const f32x2 a = P[row * 4 + 0], b = P[row * 4 + 1], c = P[row * 4 + 2], d = P[row * 4 + 3];
            const float mt = (a.x + b.x + c.x + d.x) * 0.25f;
            const float da = a.x - mt, db = b.x - mt, dc = c.x - mt, dd = d.x - mt;
            const float m2 = (a.y + b.y) + (c.y + d.y) + 64.0f * ((da * da + db * db) + (dc * dc + dd * dd));
            S[row] = (f32x2){mt, 1.0f / sqrtf(m2 * (1.0f / 256.0f) + eps)};
        }
        asm volatile("s_waitcnt lgkmcnt(0)" ::: "memory"); __builtin_amdgcn_s_barrier(); asm volatile("" ::: "memory");
        const int row0 = u.pm * BM + wr * 64 + fr, col0 = u.pn * BM + wc * 32 + 8 * fq;
#pragma unroll
        for (int ai = 0; ai < 2; ++ai)
#pragma unroll
            for (int m = 0; m < 4; ++m) { const f32x2 sr = S[ai * HALF + wr * 64 + m * 16 + fr]; bf16_t* rowp = O + (size_t)(row0 + ai * HALF + m * 16) * ldc + col0;
#pragma unroll
                for (int bj = 0; bj < 2; ++bj) { const f32x4 v0 = (acc[ai][bj][m][0] - sr.x) * sr.y, v1 = (acc[ai][bj][m][1] - sr.x) * sr.y;
                    u32x4 w; w.x = cvt_pk_bf16(v0[0], v0[1]); w.y = cvt_pk_bf16(v0[2], v0[3]); w.z = cvt_pk_bf16(v1[0], v1[1]); w.w = cvt_pk_bf16(v1[2], v1[3]);
                    *(u32x4*)(rowp + bj * HALF) = w; } }
    }
};

template <class Epi, class Sched, bool ALIGN_EPI = false, bool SP2 = false>
__device__ __forceinline__ void gemm_phase(PG8_LAS unsigned char* lds, const Gemm g, const Sched& S, const Epi& E) {
    const int tid = threadIdx.x, wid = __builtin_amdgcn_readfirstlane(tid >> 6), lane = tid & 63, wr = wid >> 2, wc = wid & 3, fr = lane & 15, fq = lane >> 4;
    const int K = g.K, nt = K / BK;
    unsigned voffA[2], voffB[2];
#pragma unroll
    for (int i = 0; i < 2; ++i) { int R, C; stage_rc(tid * 16 + i * 8192, R, C); const int Rb = Epi::PERM ? ((R & ~31) + perm32(R & 31)) : R;
        voffA[i] = (unsigned)(R * K + C) * 2u; voffB[i] = (unsigned)(Rb * K + C) * 2u; }
    const size_t kstep = (size_t)(BK * 2);
    const size_t hstep = (size_t)HALF * K * 2;
    const size_t tstep = 2 * hstep;
    const unsigned ldsw = (unsigned)wid * 1024u;
    const int aoff = lds_byte(wr * 64 + fr, fq * 8), boff = lds_byte(wc * 32 + fr, fq * 8);
#define PG8_SA(b, h) (((b) * 2 + (h)) * HTB)
#define PG8_SB(b, h) ((4 + (b) * 2 + (h)) * HTB)
#define PG8_STAGE(bufoff, gbase, voff) do { _Pragma("unroll") for (int _i = 0; _i < 2; ++_i) \
        __builtin_amdgcn_global_load_lds((const unsigned*)((const char*)(gbase) + (voff)[_i]), (PG8_LAS unsigned*)(lds + (bufoff) + ldsw + _i * 8192), 16, 0, 0); } while (0)
#define PG8_LDA(dst, b, h) do { _Pragma("unroll") for (int m = 0; m < 4; ++m) _Pragma("unroll") for (int k = 0; k < 2; ++k) dst[m][k] = *(const PG8_LAS bf16x8*)(lds + PG8_SA(b, h) + aoff + m * 2048 + k * 1024); } while (0)
#define PG8_LDB(dst, b, h) do { _Pragma("unroll") for (int n = 0; n < 2; ++n) _Pragma("unroll") for (int k = 0; k < 2; ++k) dst[n][k] = *(const PG8_LAS bf16x8*)(lds + PG8_SB(b, h) + boff + n * 2048 + k * 1024); } while (0)
#define PG8_MMA(ai, bj, At, Bt) do { __builtin_amdgcn_s_setprio(1); _Pragma("unroll") for (int m = 0; m < 4; ++m) _Pragma("unroll") for (int n = 0; n < 2; ++n) _Pragma("unroll") for (int k = 0; k < 2; ++k) \
        acc[ai][bj][m][n] = __builtin_amdgcn_mfma_f32_16x16x32_bf16(Bt[n][k], At[m][k], acc[ai][bj][m][n], 0, 0, 0); __builtin_amdgcn_s_setprio(0); } while (0)
#define PG8_WAIT_V(n) asm volatile("s_waitcnt vmcnt(" #n ")" ::: "memory")
#define PG8_WAIT_L(n) asm volatile("s_waitcnt lgkmcnt(" #n ")" ::: "memory")
#define PG8_BAR __builtin_amdgcn_s_barrier()
#define PG8_SCHED __builtin_amdgcn_sched_barrier(0)
    Unit cur, nxt; int ui = 0;
    if (!S.next(0, cur)) return;
    f32x4 acc[2][2][4][2];
#pragma unroll
    for (int a = 0; a < 2; ++a)
#pragma unroll
        for (int b = 0; b < 2; ++b)
#pragma unroll
            for (int m = 0; m < 4; ++m)
#pragma unroll
                for (int n = 0; n < 2; ++n) acc[a][b][m][n] = (f32x4){0.f, 0.f, 0.f, 0.f};
    bf16x8 At[4][2], B0[2][2], B1[2][2];
    const char* cA = (const char*)g.A + (size_t)cur.pm * tstep; const char* cB = (const char*)g.Bt + (size_t)cur.pn * tstep;
    S.a_ready(cur);
    if constexpr (SP2) {
        PG8_STAGE(PG8_SB(0, 0), cB, voffB); PG8_STAGE(PG8_SB(0, 1), cB + hstep, voffB); PG8_STAGE(PG8_SA(0, 0), cA, voffA); PG8_STAGE(PG8_SA(0, 1), cA + hstep, voffA);
        if (wr == 1) PG8_BAR;
        PG8_WAIT_V(2); PG8_BAR;
        PG8_STAGE(PG8_SB(1, 0), cB + kstep, voffB); PG8_STAGE(PG8_SA(1, 0), cA + kstep, voffA); PG8_STAGE(PG8_SB(1, 1), cB + hstep + kstep, voffB);
        PG8_WAIT_V(6); PG8_BAR;
    } else {
        PG8_STAGE(PG8_SB(0, 0), cB, voffB); PG8_STAGE(PG8_SA(0, 0), cA, voffA); PG8_STAGE(PG8_SB(0, 1), cB + hstep, voffB); PG8_STAGE(PG8_SA(0, 1), cA + hstep, voffA);
        if (wr == 1) PG8_BAR;
        PG8_WAIT_V(4); PG8_BAR;
        PG8_STAGE(PG8_SB(1, 0), cB + kstep, voffB); PG8_STAGE(PG8_SA(1, 0), cA + kstep, voffA); PG8_STAGE(PG8_SB(1, 1), cB + hstep + kstep, voffB);
        PG8_WAIT_V(6); PG8_BAR;
    }
    for (;;) {
        const bool has_next = S.next(ui + 1, nxt);
        const bool skip1 = __builtin_amdgcn_readfirstlane((int)(cur.pm == g.half_pm)) != 0;
        const char* nA = has_next ? (const char*)g.A + (size_t)nxt.pm * tstep : cA; const char* nB = has_next ? (const char*)g.Bt + (size_t)nxt.pn * tstep : cB;
        for (int t = 0; t < nt; t += 2) {
            const bool last = (t == nt - 2);
            const char* a1 = cA + (size_t)(t + 1) * kstep;
            const char* a2 = last ? nA : cA + (size_t)(t + 2) * kstep; const char* b2 = last ? nB : cB + (size_t)(t + 2) * kstep;
            const char* a3 = a2 + kstep; const char* b3 = b2 + kstep;
            if (last && has_next) S.a_ready(nxt);
            if constexpr (SP2) {
            PG8_LDB(B0, 0, 0); PG8_LDB(B1, 0, 1); PG8_SCHED; PG8_LDA(At, 0, 0); PG8_STAGE(PG8_SA(1, 1), a1 + hstep, voffA);
            PG8_WAIT_V(8); PG8_WAIT_L(0); PG8_BAR; PG8_MMA(0, 0, At, B0); PG8_MMA(0, 1, At, B1); PG8_BAR; PG8_SCHED;
            PG8_LDA(At, 0, 1); PG8_STAGE(PG8_SB(0, 0), b2, voffB); PG8_STAGE(PG8_SB(0, 1), b2 + hstep, voffB); PG8_STAGE(PG8_SA(0, 0), a2, voffA);
            PG8_WAIT_V(8); PG8_WAIT_L(0); PG8_BAR; if (!skip1) { PG8_MMA(1, 0, At, B0); PG8_MMA(1, 1, At, B1); } PG8_BAR; PG8_SCHED;
            PG8_LDB(B0, 1, 0); PG8_LDB(B1, 1, 1); PG8_SCHED; PG8_LDA(At, 1, 0); PG8_STAGE(PG8_SA(0, 1), a2 + hstep, voffA);
            PG8_WAIT_V(8); PG8_WAIT_L(0); PG8_BAR; PG8_MMA(0, 0, At, B0); PG8_MMA(0, 1, At, B1); PG8_BAR; PG8_SCHED;
            PG8_LDA(At, 1, 1); PG8_STAGE(PG8_SB(1, 0), b3, voffB); PG8_STAGE(PG8_SB(1, 1), b3 + hstep, voffB); PG8_STAGE(PG8_SA(1, 0), a3, voffA);
            PG8_WAIT_V(8); PG8_WAIT_L(0); PG8_BAR; if (!skip1) { PG8_MMA(1, 0, At, B0); PG8_MMA(1, 1, At, B1); } PG8_BAR; PG8_SCHED;
            } else {
            PG8_LDB(B0, 0, 0); PG8_SCHED; PG8_LDA(At, 0, 0); PG8_STAGE(PG8_SA(1, 1), a1 + hstep, voffA);
            PG8_WAIT_L(8); PG8_BAR; PG8_WAIT_L(0); PG8_MMA(0, 0, At, B0); PG8_BAR; PG8_SCHED;
            PG8_LDB(B1, 0, 1); PG8_STAGE(PG8_SB(0, 0), b2, voffB);
            PG8_BAR; PG8_WAIT_L(0); PG8_MMA(0, 1, At, B1); PG8_BAR;
            PG8_LDA(At, 0, 1); PG8_STAGE(PG8_SA(0, 0), a2, voffA);
            PG8_BAR; PG8_WAIT_L(0); PG8_MMA(1, 0, At, B0); PG8_BAR; PG8_SCHED;
            PG8_STAGE(PG8_SB(0, 1), b2 + hstep, voffB);
            PG8_WAIT_V(6); PG8_BAR; PG8_MMA(1, 1, At, B1); PG8_BAR;
            PG8_LDB(B0, 1, 0); PG8_SCHED; PG8_LDA(At, 1, 0); PG8_STAGE(PG8_SA(0, 1), a2 + hstep, voffA);
            PG8_WAIT_L(8); PG8_BAR; PG8_WAIT_L(0); PG8_MMA(0, 0, At, B0); PG8_BAR; PG8_SCHED;
            PG8_LDB(B1, 1, 1); PG8_STAGE(PG8_SB(1, 0), b3, voffB);
            PG8_BAR; PG8_WAIT_L(0); PG8_MMA(0, 1, At, B1); PG8_BAR;
            PG8_LDA(At, 1, 1); PG8_STAGE(PG8_SA(1, 0), a3, voffA);
            PG8_BAR; PG8_WAIT_L(0); PG8_MMA(1, 0, At, B0); PG8_BAR; PG8_SCHED;
            PG8_STAGE(PG8_SB(1, 1), b3 + hstep, voffB);
            PG8_WAIT_V(6); PG8_BAR; PG8_MMA(1, 1, At, B1); PG8_BAR;
            }
        }
        if constexpr (ALIGN_EPI) { if (wr == 0) PG8_BAR; }
        if constexpr (!Epi::AFTER_DRAIN) { E(acc, cur, wr, wc, fr, fq); S.done(cur); }
        if (!has_next) break;
#pragma unroll
        for (int a = 0; a < 2; ++a)
#pragma unroll
            for (int b = 0; b < 2; ++b)
#pragma unroll
                for (int m = 0; m < 4; ++m)
#pragma unroll
                    for (int n = 0; n < 2; ++n) acc[a][b][m][n] = (f32x4){0.f, 0.f, 0.f, 0.f};
        cur = nxt; cA = nA; cB = nB; ++ui;
        if constexpr (ALIGN_EPI) { if (wr == 1) PG8_BAR; }
    }
    PG8_WAIT_V(0);
    if constexpr (!ALIGN_EPI) { if (wr == 0) PG8_BAR; }
    PG8_BAR;
    if constexpr (Epi::AFTER_DRAIN) { E.fused(acc, cur, wr, wc, fr, fq, lds, wid, lane); S.done(cur); }
#undef PG8_SA
#undef PG8_SB
#undef PG8_STAGE
#undef PG8_LDA
#undef PG8_LDB
#undef PG8_MMA
#undef PG8_WAIT_V
#undef PG8_WAIT_L
#undef PG8_BAR
#undef PG8_SCHED
}
}

constexpr int NWAVES = 8, NTHR = 512;
constexpr int DM = 1024, TSEQ = 4096, NP = 32768, NS = 128, NTOK = NP + NS, MPAD = 33024;
constexpr int INW = 9744, NPROJ = 9728, ABCOL = 6656;
constexpr float LN_EPS = 1e-5f, ALPHA = 1.189207115002721f, GLA_QSCALE = 0.08838834764831845f, NEG_BIG = -1e30f;
constexpr size_t OUT_YP = 0, OUT_YS = 33554432, OUT_KVP1 = 33685504, OUT_KVP2 = 34734080, OUT_KVP3 = 38928384, OUT_STP = 55705600,
                 OUT_KVS1 = 56754176, OUT_KVS2 = 60948480, OUT_KVS3 = 77725696, OUT_STS = 144834560, OUT_TOTAL = 149028864;
constexpr size_t MiB = 1u << 20;
constexpr size_t WS_CTL = 0, CTL_ZERO_BYTES = 1 * MiB;
constexpr size_t WS_KEYS = 1 * MiB, WS_LUT = WS_KEYS + 512 * 1024;
constexpr size_t WS_WA = 2 * MiB, WS_WB = 3 * MiB, WS_WO = 5 * MiB, WS_WQ = 7 * MiB, WS_WIN = 11 * MiB;
constexpr size_t WS_AB = 31 * MiB, WS_UT = 34 * MiB, WS_VT = 66 * MiB, WS_XB = 98 * MiB;
constexpr size_t WS_QA = 163 * MiB, WS_KA = 260 * MiB, WS_VA = 357 * MiB, WS_QB = 454 * MiB, WS_KB = 487 * MiB, WS_VB = 520 * MiB;
constexpr size_t WS_RB = 585 * MiB, WS_GA = 650 * MiB, WS_GB = 715 * MiB, WS_LSE = 780 * MiB, WS_OAM = 784 * MiB, WS_OBN = 817 * MiB, WS_H = 882 * MiB, WS_END = 1011 * MiB;
constexpr size_t WS_T1 = WS_KA, WS_MIX = WS_VA, WS_X1B = WS_QA, WS_QN = WS_RB, WS_EIDX = WS_GB, WS_GATE = WS_GB + 17 * MiB;
static_assert(WS_WIN + (size_t)NPROJ * 1024 * 2 <= WS_AB && WS_AB + (size_t)MPAD * 16 * 4 <= WS_UT && WS_XB + (size_t)MPAD * 1024 * 2 <= WS_QA, "ws map 1");
static_assert(WS_QA + (size_t)MPAD * 1536 * 2 <= WS_KA && WS_QB + (size_t)MPAD * 512 * 2 <= WS_KB && WS_VB + (size_t)MPAD * 1024 * 2 <= WS_RB, "ws map 2");
static_assert(WS_LSE + (size_t)3 * MPAD * 8 * 4 <= WS_OAM && WS_OAM + (size_t)MPAD * 512 * 2 <= WS_OBN && WS_OBN + (size_t)MPAD * 1024 * 2 <= WS_H && WS_H + (size_t)MPAD * 1024 * 4 <= WS_END, "ws map 3");
static_assert(WS_QN + (size_t)MPAD * 2048 * 2 <= WS_GB && WS_EIDX + (size_t)MPAD * 128 * 4 <= WS_GATE && WS_GATE + (size_t)MPAD * 128 * 4 <= WS_LSE, "ws map 4");
constexpr int CW_QUEUE = 64;
constexpr int CW_CPYQ = 128;
constexpr int CW_GDONE = 192;
constexpr int NCOPYWG = 10;
constexpr int CW_BAR = 4096;
constexpr int RING_BYTES = 131072, STATS_OFF = RING_BYTES, MISC_OFF = STATS_OFF + 10240 + 320, LDS_BYTES = 147456;
static_assert(MISC_OFF + 128 + 22 * 8 <= LDS_BYTES, "LDS map");

#define GAS __attribute__((address_space(1)))
#define LAS __attribute__((address_space(3)))
typedef unsigned short bf16;
typedef unsigned v4u __attribute__((ext_vector_type(4)));
typedef unsigned v2u __attribute__((ext_vector_type(2)));
typedef float f32x4 __attribute__((ext_vector_type(4)));
typedef float f32x16 __attribute__((ext_vector_type(16)));
typedef short bf16x8 __attribute__((ext_vector_type(8)));
typedef short s16x4 __attribute__((ext_vector_type(4)));
typedef GAS unsigned gu32;
#define RLX_AGENT __ATOMIC_RELAXED, __HIP_MEMORY_SCOPE_AGENT
#define LDS_WAIT() asm volatile("s_waitcnt lgkmcnt(0)" ::: "memory")
#define VM_WAIT() asm volatile("s_waitcnt vmcnt(0)" ::: "memory")
#define MFMA32(a, b, c) __builtin_amdgcn_mfma_f32_32x32x16_bf16((a), (b), (c), 0, 0, 0)
using pg8::cvt_pk_bf16; using pg8::bf_lo; using pg8::bf_hi;
__device__ __forceinline__ unsigned short f2bf(float f) { return (unsigned short)(cvt_pk_bf16(f, 0.f) & 0xffffu); }
__device__ __forceinline__ float bf2f(unsigned short h) { return __uint_as_float((unsigned)h << 16); }
__device__ __forceinline__ int crow(int reg, int hh) { return (reg & 3) + 8 * (reg >> 2) + 4 * hh; }
__device__ __forceinline__ float wave_sum(float v) {
#pragma unroll
    for (int o = 1; o < 64; o <<= 1) v += __shfl_xor(v, o);
    return v;
}
__device__ __forceinline__ float wave_max(float v) {
#pragma unroll
    for (int o = 1; o < 64; o <<= 1) v = fmaxf(v, __shfl_xor(v, o));
    return v;
}
__device__ __forceinline__ bf16x8 frag_row(const LAS unsigned char* T, int stride, int r0, int k0, int lane) {
    return *(const LAS bf16x8*)(T + (r0 + (lane & 31)) * stride + (k0 + 8 * (lane >> 5)) * 2);
}
typedef short v4i16_t __attribute__((ext_vector_type(4)));
template <bool PERM> __device__ __forceinline__ bf16x8 frag_tr(const LAS unsigned char* X, int stride, int k0, int c0, int lane) {
    const int i = lane & 15, g = (lane >> 4) & 1, hh = lane >> 5, q = i >> 2, p = i & 3;
    const int rA = PERM ? (k0 + 4 * hh + q) : (k0 + 8 * hh + q), rB = PERM ? (k0 + 8 + 4 * hh + q) : (k0 + 8 * hh + 4 + q);
    const int cb = (c0 + 16 * g + 4 * p) * 2;
    const s16x4 lo = __builtin_bit_cast(s16x4, __builtin_amdgcn_ds_read_tr16_b64_v4i16((LAS v4i16_t*)(X + rA * stride + cb)));
    const s16x4 hi = __builtin_bit_cast(s16x4, __builtin_amdgcn_ds_read_tr16_b64_v4i16((LAS v4i16_t*)(X + rB * stride + cb)));
    return __builtin_shufflevector(lo, hi, 0, 1, 2, 3, 4, 5, 6, 7);
}
__device__ __forceinline__ bf16x8 pack_acc(const f32x16& x, int s) {
    v4u p; p.x = cvt_pk_bf16(x[8 * s], x[8 * s + 1]); p.y = cvt_pk_bf16(x[8 * s + 2], x[8 * s + 3]); p.z = cvt_pk_bf16(x[8 * s + 4], x[8 * s + 5]); p.w = cvt_pk_bf16(x[8 * s + 6], x[8 * s + 7]);
    return __builtin_bit_cast(bf16x8, p);
}

#define XB_TMO      128
#define XB_XCNT(j)  (256  + 64 * (j))
#define XB_XSUB(j)  (1280 + 64 * (j))
#define XB_XGEN(j)  (2304 + 64 * (j))
#define XB_TOP      3328
#define XB_TOPGEN   3392
#define XCD_BAR_WORDS 3456
#define XB_SPIN_CAP (1u << 22)
__device__ __forceinline__ unsigned xb_ld(unsigned* p)              { return __hip_atomic_load(p, __ATOMIC_RELAXED, __HIP_MEMORY_SCOPE_AGENT); }
__device__ __forceinline__ unsigned xb_add(unsigned* p, unsigned v) { return __hip_atomic_fetch_add(p, v, __ATOMIC_RELAXED, __HIP_MEMORY_SCOPE_AGENT); }
__device__ __forceinline__ unsigned xb_xcc_id() { return (unsigned)__builtin_amdgcn_s_getreg((3 << 11) | 20) & 0xFu; }
#define XB_SPIN(cond, bar) do { unsigned _sp = 0; while (cond) { __builtin_amdgcn_s_sleep(1); \
    if ((++_sp & 255u) == 0u) { if (xb_ld(&(bar)[XB_TMO])) break; if (_sp > XB_SPIN_CAP) { atomicAdd(&(bar)[XB_TMO], 1u); break; } } } } while (0)
struct XcdBarrier { unsigned* bar; unsigned x; volatile LAS unsigned* st; };
__device__ __forceinline__ XcdBarrier xcd_barrier_post(unsigned* bar, volatile LAS unsigned* st) {
    XcdBarrier b; b.bar = bar; b.x = xb_xcc_id(); b.st = st;
    if (threadIdx.x == 0) (void)xb_add(&bar[XB_XCNT(b.x)], 1u);
    return b;
}
__device__ __forceinline__ void xcd_barrier_complete(unsigned* bar, unsigned x, unsigned& nloc, unsigned& nx) {
    const unsigned G = gridDim.x * gridDim.y * gridDim.z;
    unsigned sum, cnt, mine, sp = 0u;
    for (;;) {
        sum = 0u; cnt = 0u; mine = 0u;
#pragma unroll
        for (unsigned j = 0; j < 16; ++j) { const unsigned c = xb_ld(&bar[XB_XCNT(j)]); sum += c; cnt += (c > 0u) ? 1u : 0u; mine = (j == x) ? c : mine; }
        if (sum == G) break;
        __builtin_amdgcn_s_sleep(1);
        if ((++sp & 255u) == 0u) { if (xb_ld(&bar[XB_TMO])) break; if (sp > XB_SPIN_CAP) { atomicAdd(&bar[XB_TMO], 1u); break; } }
    }
    nloc = mine > 0u ? mine : 1u; nx = cnt > 0u ? cnt : 1u;
}
__device__ __forceinline__ void xcd_barrier(const XcdBarrier& b) {
    asm volatile("s_waitcnt vmcnt(0)" ::: "memory");
    __syncthreads();
    if (threadIdx.x == 0) {
        unsigned* bar = b.bar;
        __builtin_amdgcn_s_waitcnt(0);
        unsigned nloc = b.st[0], nx = b.st[1];
        if (nloc == 0u) { xcd_barrier_complete(bar, b.x, nloc, nx); b.st[0] = nloc; b.st[1] = nx; }
        const unsigned old = xb_add(&bar[XB_XSUB(b.x)], 1u);
        const unsigned gen = old / nloc;
        if (old + 1u == (gen + 1u) * nloc) {
            __builtin_amdgcn_fence(__ATOMIC_RELEASE, "agent");
            asm volatile("s_waitcnt vmcnt(0)" ::: "memory");
            const unsigned og = xb_add(&bar[XB_TOP], 1u);
            const unsigned tg = og / nx;
            if (og + 1u == (tg + 1u) * nx) xb_add(&bar[XB_TOPGEN], 1u);
            else XB_SPIN(xb_ld(&bar[XB_TOPGEN]) == tg, bar);
            __builtin_amdgcn_fence(__ATOMIC_ACQUIRE, "agent");
            xb_add(&bar[XB_XGEN(b.x)], 1u);
            asm volatile("s_waitcnt vmcnt(0)" ::: "memory");
        } else {
            XB_SPIN(xb_ld(&bar[XB_XGEN(b.x)]) == gen, bar);
            __builtin_amdgcn_fence(__ATOMIC_ACQUIRE, "agent");
            asm volatile("s_waitcnt vmcnt(0)" ::: "memory");
        }
    }
    __syncthreads();
}

struct Frame {
    LAS unsigned char* lds;
    volatile LAS unsigned* MISC;
    gu32* ctl;
    int tid, lane, wave, G;
    unsigned long long tp;
    float* out; unsigned char* ws;
};
#define WSP(T, off) ((T*)(F.ws + (off)))
#define WSL(T, off) ((T*)(ws_ + (off)))
#define LAUNDER_WS() unsigned char* ws_ = F.ws; asm volatile("" : "+s"(ws_))
constexpr int PTR_OFF = MISC_OFF + 128;
enum { I_XP = 0, I_XS, I_C1, I_C2, I_C3, I_ST0, I_RELB, I_WIN, I_WG2, I_BG, I_GN, I_WA, I_WB, I_WO, I_L1G, I_L1B, I_WQ, I_KEYS, I_PU, I_PV, I_L2G, I_L2B };
__device__ __forceinline__ const float* inptr(const Frame& F, int i) {
    const unsigned long long v = ((volatile LAS unsigned long long*)(F.lds + PTR_OFF))[i];
    const unsigned lo = __builtin_amdgcn_readfirstlane((unsigned)v), hi = __builtin_amdgcn_readfirstlane((unsigned)(v >> 32));
    return (const float*)(((unsigned long long)hi << 32) | lo);
}

__device__ __forceinline__ void p0_tr_load(const float* W, int N, int nsrc0, int k0, int lane, float (&v)[32]) {
#pragma unroll
    for (int i = 0; i < 32; ++i) { const int kk = 2 * i + (lane >> 5); v[i] = W[(size_t)(k0 + kk) * N + nsrc0 + (lane & 31)]; }
}
__device__ __forceinline__ void p0_tr_finish(const float (&v)[32], int K, bf16* WT, int ndst0, int k0, LAS float* scr, int lane) {
#pragma unroll
    for (int i = 0; i < 32; ++i) { const int kk = 2 * i + (lane >> 5); scr[kk * 33 + (lane & 31)] = v[i]; }
    LDS_WAIT(); asm volatile("" ::: "memory");
    const int c = lane & 7;
#pragma unroll
    for (int j = 0; j < 4; ++j) { const int n = (lane >> 3) + 8 * j; const LAS float* s = scr + (8 * c) * 33 + n;
        v4u o; o.x = cvt_pk_bf16(s[0 * 33], s[1 * 33]); o.y = cvt_pk_bf16(s[2 * 33], s[3 * 33]); o.z = cvt_pk_bf16(s[4 * 33], s[5 * 33]); o.w = cvt_pk_bf16(s[6 * 33], s[7 * 33]);
        *(GAS v4u*)(WT + (size_t)(ndst0 + n) * K + k0 + 8 * c) = o; }
    LDS_WAIT(); asm volatile("" ::: "memory");
}
__device__ __forceinline__ void p0_cvt8(const float* src, bf16* dst, size_t n8, size_t gt, size_t ngt) {
    for (size_t i = gt; i < n8; i += ngt) { const f32x4 a = *(const f32x4*)(src + i * 8), b = *(const f32x4*)(src + i * 8 + 4);
        v4u o; o.x = cvt_pk_bf16(a[0], a[1]); o.y = cvt_pk_bf16(a[2], a[3]); o.z = cvt_pk_bf16(b[0], b[1]); o.w = cvt_pk_bf16(b[2], b[3]); *(v4u*)(dst + i * 8) = o; }
}
typedef float f32x2_t __attribute__((ext_vector_type(2)));
typedef _Float16 h2_t __attribute__((ext_vector_type(2)));
constexpr float U_SCALE = 1024.0f, V_SCALE = 128.0f, X_SCALE = 16.0f;
__device__ __forceinline__ void p0_cvt_fp8(const float* src, unsigned char* dst, float scale, size_t n16, size_t gt, size_t ngt) {
    for (size_t i = gt; i < n16; i += ngt) { v4u o;
#pragma unroll
        for (int q = 0; q < 4; ++q) { const f32x4 a = *(const f32x4*)(src + i * 16 + 4 * q) * scale; int w = 0;
            w = __builtin_amdgcn_cvt_pk_fp8_f32(a[0], a[1], w, false); w = __builtin_amdgcn_cvt_pk_fp8_f32(a[2], a[3], w, true); o[q] = (unsigned)w; }
        const size_t e = i >> 6, q16 = i & 63;
        *(v4u*)(dst + (((q16 >> 3) * 16384 + e) << 7) + 16 * (q16 & 7)) = o; }
}
__device__ __forceinline__ void p0_kvshift(const float* src, float* dst, int Wb, size_t gt, size_t ngt) {
    const size_t n4 = (size_t)(Wb - 4) * 256, tot = n4 * 32;
    for (size_t i = gt; i < tot; i += ngt) { const size_t b = i / n4, r = i - b * n4;
        ((f32x4*)dst)[b * (size_t)Wb * 256 + r] = ((const f32x4*)src)[b * (size_t)Wb * 256 + 1024 + r]; }
}
__device__ __forceinline__ void p0_prologue(Frame& F) {
    const int gw = blockIdx.x * NWAVES + F.wave, NGW = F.G * NWAVES;
    const size_t gt = (size_t)blockIdx.x * NTHR + F.tid, ngt = (size_t)F.G * NTHR;
    const float* win = inptr(F, I_WIN); const float* xp = inptr(F, I_XP); const float* xs = inptr(F, I_XS);
    constexpr int WROW = 2064;
    for (int i = F.tid; i < 4096; i += NTHR) {
        const int k = i >> 2, c4 = (i & 3) * 4; const f32x4 w4 = *(const f32x4*)(win + (size_t)k * INW + ABCOL + c4);
#pragma unroll
        for (int cc = 0; cc < 4; ++cc) *(LAS unsigned short*)(F.lds + (c4 + cc) * WROW + k * 2) = f2bf(w4[cc]); }
    __syncthreads();
    bf16* XB = WSP(bf16, WS_XB); float* AB = WSP(float, WS_AB);
    {   const int lane = F.lane, r = lane & 15, kg = lane >> 4;
        typedef float f32x4a __attribute__((ext_vector_type(4)));
        for (int blk = gw; blk < MPAD / 16; blk += NGW) {
            const int m = 16 * blk + r;
            bf16* xo = XB + (size_t)m * 1024 + 8 * kg;
            if (16 * blk >= NTOK) {
#pragma unroll 8
                for (int s = 0; s < 32; ++s) *(v4u*)(xo + 32 * s) = (v4u){0u, 0u, 0u, 0u};
                if (kg == 0) { *(f32x4*)(AB + (size_t)m * 16) = (f32x4){0.f, 0.f, 0.f, 0.f}; *(f32x4*)(AB + (size_t)m * 16 + 4) = (f32x4){0.f, 0.f, 0.f, 0.f}; *(f32x4*)(AB + (size_t)m * 16 + 8) = (f32x4){0.f, 0.f, 0.f, 0.f}; *(f32x4*)(AB + (size_t)m * 16 + 12) = (f32x4){0.f, 0.f, 0.f, 0.f}; }
                continue; }
            const float* xr = (m < NP ? xp + (size_t)m * 1024 : xs + (size_t)(m - NP) * 1024) + 8 * kg;
            f32x4a acc = {0.f, 0.f, 0.f, 0.f};
#pragma unroll 1
            for (int s0 = 0; s0 < 32; s0 += 16) {
                f32x4 xa[16], xb[16];
#pragma unroll
                for (int u = 0; u < 16; ++u) { xa[u] = *(const f32x4*)(xr + 32 * (s0 + u)); xb[u] = *(const f32x4*)(xr + 32 * (s0 + u) + 4); }
#pragma unroll
                for (int u = 0; u < 16; ++u) { v4u w; w.x = cvt_pk_bf16(xa[u][0], xa[u][1]); w.y = cvt_pk_bf16(xa[u][2], xa[u][3]); w.z = cvt_pk_bf16(xb[u][0], xb[u][1]); w.w = cvt_pk_bf16(xb[u][2], xb[u][3]);
                    *(v4u*)(xo + 32 * (s0 + u)) = w;
                    const bf16x8 bfr = *(const LAS bf16x8*)(F.lds + r * WROW + (32 * (s0 + u) + 8 * kg) * 2);
                    acc = __builtin_amdgcn_mfma_f32_16x16x32_bf16(__builtin_bit_cast(bf16x8, w), bfr, acc, 0, 0, 0); }
            }
#pragma unroll
            for (int i2 = 0; i2 < 4; ++i2) AB[(size_t)(16 * blk + 4 * kg + i2) * 16 + r] = acc[i2];
        }
    }
    __syncthreads();
    LAS float* scr = (LAS float*)(F.lds + F.wave * 16384);
    const float* wa = inptr(F, I_WA); const float* wb = inptr(F, I_WB); const float* wo = inptr(F, I_WO); const float* wq = inptr(F, I_WQ);
    constexpr int I_IN = 16 * (NPROJ / 32), I_A = 8 * 32, I_B = 16 * 32, I_O = 16 * 32, I_Q = 16 * 64, NIT = I_IN + I_A + I_B + I_O + I_Q;
#define P0_TR_PARAMS(IT, W_, WT_, K_, N_, NS_, ND_, K0_) { int r = (IT); \
        if (r < I_IN) { const int nb = r % (NPROJ / 32), kb = r / (NPROJ / 32), nd = 32 * nb; W_ = win; WT_ = WSP(bf16, WS_WIN); K_ = 1024; N_ = INW; NS_ = nd + (nd >= ABCOL ? 16 : 0); ND_ = nd; K0_ = 64 * kb; } \
        else if ((r -= I_IN) < I_A) { W_ = wa; WT_ = WSP(bf16, WS_WA); K_ = 512; N_ = 1024; NS_ = ND_ = 32 * (r % 32); K0_ = 64 * (r / 32); } \
        else if ((r -= I_A) < I_B) { W_ = wb; WT_ = WSP(bf16, WS_WB); K_ = 1024; N_ = 1024; NS_ = ND_ = 32 * (r % 32); K0_ = 64 * (r / 32); } \
        else if ((r -= I_B) < I_O) { W_ = wo; WT_ = WSP(bf16, WS_WO); K_ = 1024; N_ = 1024; NS_ = ND_ = 32 * (r % 32); K0_ = 64 * (r / 32); } \
        else { r -= I_O; W_ = wq; WT_ = WSP(bf16, WS_WQ); K_ = 1024; N_ = 2048; NS_ = ND_ = 32 * (r % 64); K0_ = 64 * (r / 64); } }
    if (blockIdx.x != 0) {
        const int NW2 = NGW - NWAVES;
        for (int it = gw - NWAVES; it < NIT; it += 2 * NW2) {
            const int it2 = it + NW2; const bool has2 = it2 < NIT;
            const float* Wa; bf16* WTa; int Ka, Na, NSa, NDa, K0a; P0_TR_PARAMS(it, Wa, WTa, Ka, Na, NSa, NDa, K0a);
            const float* Wb = Wa; bf16* WTb = WTa; int Kb = Ka, Nb = Na, NSb = NSa, NDb = NDa, K0b = K0a;
            if (has2) P0_TR_PARAMS(it2, Wb, WTb, Kb, Nb, NSb, NDb, K0b);
            float va[32], vb[32];
            p0_tr_load(Wa, Na, NSa, K0a, F.lane, va);
            if (has2) p0_tr_load(Wb, Nb, NSb, K0b, F.lane, vb);
            p0_tr_finish(va, Ka, WTa, NDa, K0a, scr, F.lane);
            if (has2) p0_tr_finish(vb, Kb, WTb, NDb, K0b, scr, F.lane);
        }
    }
    p0_cvt_fp8(inptr(F, I_PU), WSP(unsigned char, WS_UT), U_SCALE, (size_t)16384 * 1024 / 16, gt, ngt);
    p0_cvt_fp8(inptr(F, I_PV), WSP(unsigned char, WS_VT), V_SCALE, (size_t)16384 * 1024 / 16, gt, ngt);
    p0_cvt8(inptr(F, I_KEYS), WSP(bf16, WS_KEYS), (size_t)8 * 2 * 128 * 128 / 8, gt, ngt);
    if (gt < 3 * 8 * 129) { const int g = (int)gt / (8 * 129), h = ((int)gt / 129) % 8, rel = (int)gt % 129; const int dil = g == 0 ? 1 : (g == 1 ? 4 : 16), dist = rel * dil;
        int bucket = dist;
        if (dist >= 16) { const float dd = (float)dist; int lg = 16 + (int)(logf(dd / 16.0f) / 4.852030263919617f * 16.0f); bucket = lg < 31 ? lg : 31; }
        WSP(float, WS_LUT)[gt] = inptr(F, I_RELB)[bucket * 24 + g * 8 + h]; }
}

constexpr size_t WS_KD = WS_OAM, WS_DEC = WS_OBN;
__device__ __forceinline__ void gla_prep_load(Frame& F, int unit, unsigned (&qv)[8], unsigned (&kv)[8], float (&abv)[2]) {
    const int d2 = F.tid & 63, ig = F.wave, h = unit & 3, n = (unit >> 2) & 63, b = unit >> 8;
    const size_t m0 = (size_t)b * TSEQ + (size_t)n * 64;
    const bf16* QB = WSP(bf16, WS_QB); const bf16* KB = WSP(bf16, WS_KB); const float* AB = WSP(float, WS_AB);
#pragma unroll
    for (int ii = 0; ii < 8; ++ii) { const size_t off = (m0 + 8 * ig + ii) * 512 + h * 128 + 2 * d2; qv[ii] = *(const unsigned*)(QB + off); kv[ii] = *(const unsigned*)(KB + off); }
    abv[0] = AB[(m0 + 8 * ig) * 16 + d2]; abv[1] = AB[(m0 + 8 * ig) * 16 + 64 + d2];
}
__device__ __forceinline__ void gla_prep_unit(Frame& F, int unit, const unsigned (&qv)[8], const unsigned (&kv)[8], const float (&abv)[2], const f32x2_t (&wg)[16], const f32x2_t bgd) {
    LAUNDER_WS();
    LAS float* GT = (LAS float*)F.lds;
    const int tid = F.tid, d2 = tid & 63, ig = F.wave;
    const int h = unit & 3, n = (unit >> 2) & 63, b = unit >> 8;
    const size_t m0 = (size_t)b * TSEQ + (size_t)n * 64;
    bf16* QB = WSL(bf16, WS_QB); bf16* KB = WSL(bf16, WS_KB); float* DEC = WSL(float, WS_DEC);
    f32x2_t c[8]; f32x2_t run = {0.f, 0.f};
#pragma unroll
    for (int ii = 0; ii < 8; ++ii) {
        f32x2_t x = bgd;
#pragma unroll
        for (int r = 0; r < 16; ++r) x += wg[r] * __uint_as_float((unsigned)__builtin_amdgcn_readlane((int)__float_as_uint(abv[ii >> 2]), 16 * (ii & 3) + r));
        f32x2_t ls; ls.x = fminf(x.x, 0.f) - __logf(1.0f + __expf(-fabsf(x.x))); ls.y = fminf(x.y, 0.f) - __logf(1.0f + __expf(-fabsf(x.y)));
        run += ls * (1.0f / 16.0f); c[ii] = run;
    }
    *(LAS f32x2_t*)(GT + ig * 128 + 2 * d2) = run;
    __syncthreads();
    f32x2_t offs = {0.f, 0.f}, bl = {0.f, 0.f};
#pragma unroll
    for (int g = 0; g < 8; ++g) { const f32x2_t t = *(const LAS f32x2_t*)(GT + g * 128 + 2 * d2); bl += t; if (g < ig) offs += t; }
    const f32x2_t ebl = {__expf(bl.x), __expf(bl.y)};
#pragma unroll
    for (int ii = 0; ii < 8; ++ii) {
        const f32x2_t bb = offs + c[ii]; const f32x2_t eb = {__expf(bb.x), __expf(bb.y)}, ieb = {__expf(-bb.x), __expf(-bb.y)};
        const f32x2_t q = {bf_lo(qv[ii]), bf_hi(qv[ii])}, k = {bf_lo(kv[ii]), bf_hi(kv[ii])};
        const f32x2_t qe = q * GLA_QSCALE * eb, ke = k * ieb;
        const size_t off = (m0 + 8 * ig + ii) * 512 + h * 128 + 2 * d2;
        *(unsigned*)(QB + off) = cvt_pk_bf16(qe.x, qe.y); *(unsigned*)(KB + off) = cvt_pk_bf16(ke.x, ke.y);
    }
    if (ig == 0) *(f32x2_t*)(DEC + ((size_t)b * 64 + n) * 512 + h * 128 + 2 * d2) = ebl;
    __syncthreads();
}
__device__ __forceinline__ void gla_prompt_unit(Frame& F, int b, int h, int sl) {
    LAUNDER_WS();
    LAS unsigned char* L = F.lds;
    constexpr int O_QE = 0, O_KE = 17408, O_KD = 34816, O_VT = 55296, O_SB = 67584, O_DEC = 92160;
    const int tid = F.tid, lane = F.lane, w = F.wave, hh = lane >> 5;
    const bf16* QB = WSL(bf16, WS_QB); const bf16* KB = WSL(bf16, WS_KB); bf16* VB = WSL(bf16, WS_VB); const float* DEC = WSL(float, WS_DEC);
    for (int i = tid; i < 128 * 192 / 4; i += NTHR) ((LAS unsigned*)(L + O_SB))[i] = 0u;
    f32x16 S;
#pragma unroll
    for (int r = 0; r < 16; ++r) S[r] = 0.f;
    const int dt = w >> 1, et = w & 1;
    const int r0 = tid >> 4, c0 = tid & 15;
    v4u tq[2], tk[2], tv; float tdec = 0.f;
#define GLA_LOAD(n_) do { const size_t m0_ = (size_t)b * TSEQ + (size_t)(n_) * 64; \
        _Pragma("unroll") for (int i_ = 0; i_ < 2; ++i_) { const size_t off_ = (m0_ + r0 + 32 * i_) * 512 + h * 128 + c0 * 8; tq[i_] = *(const v4u*)(QB + off_); tk[i_] = *(const v4u*)(KB + off_); } \
        tv = *(const v4u*)(VB + (m0_ + (tid >> 3)) * 1024 + h * 256 + sl * 64 + (tid & 7) * 8); \
        if (tid < 128) tdec = DEC[((size_t)b * 64 + (n_)) * 512 + h * 128 + tid]; } while (0)
    GLA_LOAD(0);
    for (int n = 0; n < 64; ++n) {
        const size_t m0 = (size_t)b * TSEQ + (size_t)n * 64;
#pragma unroll
        for (int i = 0; i < 2; ++i) { *(LAS v4u*)(L + O_QE + (r0 + 32 * i) * 272 + c0 * 16) = tq[i]; *(LAS v4u*)(L + O_KE + (r0 + 32 * i) * 272 + c0 * 16) = tk[i]; *(LAS v4u*)(L + O_KD + (r0 + 32 * i) * 320 + c0 * 16) = tk[i]; }
        *(LAS v4u*)(L + O_VT + (tid >> 3) * 192 + (tid & 7) * 16) = tv;
        if (tid < 128) ((LAS float*)(L + O_DEC))[tid] = tdec;
        __syncthreads();
        if (n + 1 < 64) GLA_LOAD(n + 1);
        if (w < 4) {
            const int it = w >> 1;
            f32x16 o;
#pragma unroll
            for (int r = 0; r < 16; ++r) o[r] = 0.f;
            for (int jt = 0; jt <= it; ++jt) {
                f32x16 X;
#pragma unroll
                for (int r = 0; r < 16; ++r) X[r] = 0.f;
#pragma unroll
                for (int s = 0; s < 8; ++s) X = MFMA32(frag_row(L + O_KE, 272, 32 * jt, 16 * s, lane), frag_row(L + O_QE, 272, 32 * it, 16 * s, lane), X);
                if (jt == it) {
#pragma unroll
                    for (int r = 0; r < 16; ++r) if (crow(r, hh) > (lane & 31)) X[r] = 0.f;
                }
#pragma unroll
                for (int s2 = 0; s2 < 2; ++s2) o = MFMA32(pack_acc(X, s2), frag_tr<true>(L + O_VT, 192, 32 * jt + 16 * s2, 32 * et, lane), o);
            }
#pragma unroll
            for (int s = 0; s < 8; ++s) o = MFMA32(frag_row(L + O_QE, 272, 32 * it, 16 * s, lane), frag_tr<false>(L + O_SB, 192, 16 * s, 32 * et, lane), o);
            bf16* op = VB + (m0 + 32 * it) * 1024 + h * 256 + sl * 64 + 32 * et + (lane & 31);
#pragma unroll
            for (int r = 0; r < 16; ++r) op[(size_t)crow(r, hh) * 1024] = f2bf(o[r]);
        }
        {
#pragma unroll
            for (int s = 0; s < 4; ++s) S = MFMA32(frag_tr<false>(L + O_KD, 320, 16 * s, 32 * dt, lane), frag_tr<false>(L + O_VT, 192, 16 * s, 32 * et, lane), S);
#pragma unroll
            for (int r = 0; r < 16; ++r) S[r] *= ((LAS float*)(L + O_DEC))[32 * dt + crow(r, hh)];
        }
        __syncthreads();
#pragma unroll
        for (int r = 0; r < 16; ++r) *(LAS unsigned short*)(L + O_SB + (32 * dt + crow(r, hh)) * 192 + (32 * et + (lane & 31)) * 2) = f2bf(S[r]);
    }
#undef GLA_LOAD
    float* so = F.out + OUT_STP + ((size_t)(b * 4 + h) * 128 + 32 * dt) * 256 + sl * 64 + 32 * et + (lane & 31);
#pragma unroll
    for (int r = 0; r < 16; ++r) so[(size_t)crow(r, hh) * 256] = S[r];
    __syncthreads();
}

struct AttnItem { int b, h, g, r, dil, i0, cb; size_t tok0; };
__device__ __forceinline__ AttnItem attn_decode(int item) {
    AttnItem a; const int bh = item / 48, sub = item % 48; a.b = bh >> 3; a.h = bh & 7;
    int ibg;
    if (sub < 16) { a.g = 0; a.r = 0; ibg = sub; } else if (sub < 32) { a.g = 1; a.r = (sub - 16) >> 2; ibg = (sub - 16) & 3; } else { a.g = 2; a.r = sub - 32; ibg = 0; }
    a.dil = a.g == 0 ? 1 : (a.g == 1 ? 4 : 16); a.i0 = 256 * ibg; a.tok0 = (size_t)a.b * TSEQ + a.r; a.cb = a.g * 512 + a.h * 64;
    return a;
}
__device__ __forceinline__ void attn_issue(Frame& F, int item, v4u (&kk)[6], v4u (&vv)[6], bf16x8 (&qf)[4]) {
    LAUNDER_WS();
    const AttnItem a = attn_decode(item);
    const int tid = F.tid, lane = F.lane, w = F.wave, hh = lane >> 5, il = lane & 31;
    const bf16* QA = WSL(bf16, WS_QA); const bf16* KA = WSL(bf16, WS_KA); const bf16* VA = WSL(bf16, WS_VA);
    const size_t qtok = a.tok0 + (size_t)a.dil * (a.i0 + 32 * w + il);
#pragma unroll
    for (int s = 0; s < 4; ++s) qf[s] = *(const bf16x8*)(QA + qtok * 1536 + a.cb + 16 * s + 8 * hh);
#pragma unroll
    for (int p = 0; p < 6; ++p) { const int idx = tid + NTHR * p, rr = idx >> 3, ch = idx & 7, j = a.i0 - 128 + rr;
        if (j >= 0) { const size_t so = (a.tok0 + (size_t)a.dil * j) * 1536 + a.cb + ch * 8; vv[p] = *(const v4u*)(VA + so); kk[p] = *(const v4u*)(KA + so); } }
}
__device__ __forceinline__ void attn_prompt_item(Frame& F, int item, v4u (&kk)[6], v4u (&vv)[6], const bf16x8 (&qf)[4], bool has_next, int next_item, bf16x8 (&qn)[4]) {
    LAUNDER_WS();
    LAS unsigned char* L = F.lds;
    constexpr int O_V = 0, O_K = 384 * 192, O_LUT = O_K + 384 * 144;
    static_assert(O_LUT + 129 * 4 <= RING_BYTES, "attention LDS");
    const int tid = F.tid, lane = F.lane, w = F.wave, hh = lane >> 5, il = lane & 31;
    const AttnItem a = attn_decode(item);
    const int b = a.b, h = a.h, g = a.g, dil = a.dil, i0 = a.i0, cb = a.cb; const size_t tok0 = a.tok0; (void)b;
    bf16* QA = WSL(bf16, WS_QA); float* LSE = WSL(float, WS_LSE);
    const size_t qtok = tok0 + (size_t)dil * (i0 + 32 * w + il);
#pragma unroll
    for (int p = 0; p < 6; ++p) { const int idx = tid + NTHR * p, rr = idx >> 3, ch = idx & 7, j = i0 - 128 + rr;
        if (j >= 0) { *(LAS v4u*)(L + O_V + rr * 192 + ch * 16) = vv[p]; *(LAS v4u*)(L + O_K + rr * 144 + ch * 16) = kk[p]; } }
    if (tid < 129) ((LAS float*)(L + O_LUT))[tid] = WSL(float, WS_LUT)[(g * 8 + h) * 129 + tid];
    __syncthreads();
    if (has_next) attn_issue(F, next_item, kk, vv, qn);
    float mrun = NEG_BIG, lrun = 0.f;
    f32x16 O0, O1;
#pragma unroll
    for (int x = 0; x < 16; ++x) { O0[x] = 0.f; O1[x] = 0.f; }
#pragma unroll 1
    for (int kt = 0; kt < 5; ++kt) {
        const int jb = i0 + 32 * (w + kt) - 128;
        if (jb < 0) continue;
        f32x16 ST;
#pragma unroll
        for (int x = 0; x < 16; ++x) ST[x] = 0.f;
#pragma unroll
        for (int s = 0; s < 4; ++s) ST = MFMA32(frag_row(L + O_K, 144, 32 * (w + kt), 16 * s, lane), qf[s], ST);
        const int relb = 128 - 32 * kt + il;
        float tmax = NEG_BIG;
#pragma unroll
        for (int x = 0; x < 16; ++x) { const int rel = relb - crow(x, hh); const bool ok = rel >= 0 && rel <= 128; const int rc = rel < 0 ? 0 : (rel > 128 ? 128 : rel);
            const float sc = ok ? ST[x] + ((LAS float*)(L + O_LUT))[rc] : NEG_BIG; ST[x] = sc; tmax = fmaxf(tmax, sc); }
        tmax = fmaxf(tmax, __shfl_xor(tmax, 32));
        const float mnew = fmaxf(mrun, tmax), alpha = __expf(mrun - mnew);
        float ps = 0.f;
#pragma unroll
        for (int x = 0; x < 16; ++x) { const float p = __expf(ST[x] - mnew); ST[x] = p; ps += p; }
        lrun = lrun * alpha + ps; mrun = mnew;
#pragma unroll
        for (int x = 0; x < 16; ++x) { O0[x] *= alpha; O1[x] *= alpha; }
#pragma unroll
        for (int s2 = 0; s2 < 2; ++s2) { const bf16x8 pf = pack_acc(ST, s2);
            O0 = MFMA32(frag_tr<true>(L + O_V, 192, 32 * (w + kt) + 16 * s2, 0, lane), pf, O0);
            O1 = MFMA32(frag_tr<true>(L + O_V, 192, 32 * (w + kt) + 16 * s2, 32, lane), pf, O1); }
    }
    const float ltot = lrun + __shfl_xor(lrun, 32), inv = 1.0f / ltot;
    bf16* op = QA + qtok * 1536 + cb;
#pragma unroll
    for (int k4 = 0; k4 < 4; ++k4) { v2u a, c2;
        a.x = cvt_pk_bf16(O0[4 * k4] * inv, O0[4 * k4 + 1] * inv); a.y = cvt_pk_bf16(O0[4 * k4 + 2] * inv, O0[4 * k4 + 3] * inv);
        c2.x = cvt_pk_bf16(O1[4 * k4] * inv, O1[4 * k4 + 1] * inv); c2.y = cvt_pk_bf16(O1[4 * k4 + 2] * inv, O1[4 * k4 + 3] * inv);
        *(v2u*)(op + 8 * k4 + 4 * hh) = a; *(v2u*)(op + 32 + 8 * k4 + 4 * hh) = c2; }
    if (hh == 0) LSE[((size_t)g * MPAD + qtok) * 8 + h] = mrun + __logf(ltot);
    __syncthreads();
}

template <int G_> __device__ __forceinline__ void attn_sample_waveitem_g(Frame& F, int wi, const float* cache) {
    LAUNDER_WS();
    const int lane = F.lane;
    LAS float* pl = (LAS float*)(F.lds + F.wave * 1024);
    constexpr int g = G_; const int h = (wi / 3) & 7, s = (wi / 24) & 3, b = wi / 96;
    constexpr int dil = g == 0 ? 1 : (g == 1 ? 4 : 16), Wb = 128 * dil;
    bf16* QA = WSL(bf16, WS_QA); const bf16* KA = WSL(bf16, WS_KA); const bf16* VA = WSL(bf16, WS_VA); float* LSE = WSL(float, WS_LSE);
    const size_t qrow = (size_t)NP + b * 4 + s; const int cb = g * 512 + h * 64;
    float q[64];
#pragma unroll
    for (int c = 0; c < 8; ++c) { const v4u u = *(const v4u*)(QA + qrow * 1536 + cb + 8 * c);
        q[8 * c] = bf_lo(u.x); q[8 * c + 1] = bf_hi(u.x); q[8 * c + 2] = bf_lo(u.y); q[8 * c + 3] = bf_hi(u.y); q[8 * c + 4] = bf_lo(u.z); q[8 * c + 5] = bf_hi(u.z); q[8 * c + 6] = bf_lo(u.w); q[8 * c + 7] = bf_hi(u.w); }
    const float* lut = WSL(float, WS_LUT) + (g * 8 + h) * 129;
    float sc[3];
#pragma unroll
    for (int p = 0; p < 3; ++p) { const int j = lane + 64 * p; float a = NEG_BIG;
        if (j <= 128) { const int idx = Wb + s - j * dil; a = 0.f;
            if (idx >= Wb) { const bf16* kr = KA + ((size_t)NP + b * 4 + (idx - Wb)) * 1536 + cb;
#pragma unroll
                for (int c = 0; c < 8; ++c) { const v4u u = *(const v4u*)(kr + 8 * c);
                    a += q[8 * c] * bf_lo(u.x) + q[8 * c + 1] * bf_hi(u.x) + q[8 * c + 2] * bf_lo(u.y) + q[8 * c + 3] * bf_hi(u.y) + q[8 * c + 4] * bf_lo(u.z) + q[8 * c + 5] * bf_hi(u.z) + q[8 * c + 6] * bf_lo(u.w) + q[8 * c + 7] * bf_hi(u.w); }
            } else { const float* kr = cache + (((size_t)b * Wb + idx) * 2 + 0) * 512 + h * 64;
#pragma unroll
                for (int c = 0; c < 16; ++c) { const f32x4 u = *(const f32x4*)(kr + 4 * c); a += q[4 * c] * u[0] + q[4 * c + 1] * u[1] + q[4 * c + 2] * u[2] + q[4 * c + 3] * u[3]; }
            }
            a += lut[j]; }
        sc[p] = a; }
    const float mx = wave_max(fmaxf(fmaxf(sc[0], sc[1]), sc[2]));
    float ps = 0.f;
#pragma unroll
    for (int p = 0; p < 3; ++p) { const float e = __expf(sc[p] - mx); ps += e; pl[lane + 64 * p] = e; }
    const float ltot = wave_sum(ps);
    LDS_WAIT(); asm volatile("" ::: "memory");
    float o = 0.f;
    {
        const int nnew = dil == 1 ? s + 1 : 1;
        for (int j = 0; j < nnew; ++j) o += pl[j] * bf2f(VA[((size_t)NP + b * 4 + (s - j * dil)) * 1536 + cb + lane]);
        const float* vbase = cache + (((size_t)b * Wb) * 2 + 1) * 512 + h * 64 + lane;
        for (int j0 = nnew; j0 <= 128; j0 += 44) { float vv[44];
#pragma unroll
            for (int u = 0; u < 44; ++u) { const int j = j0 + u; vv[u] = j <= 128 ? vbase[(size_t)(Wb + s - j * dil) * 1024] : 0.f; }
#pragma unroll
            for (int u = 0; u < 44; ++u) { const int j = j0 + u; o += (j <= 128 ? pl[j] : 0.f) * vv[u]; } }
    }
    QA[qrow * 1536 + cb + lane] = f2bf(o / ltot);
    if (lane == 0) LSE[((size_t)g * MPAD + qrow) * 8 + h] = mx + __logf(ltot);
    LDS_WAIT(); asm volatile("" ::: "memory");
}

__device__ __forceinline__ void attn_sample_waveitem(Frame& F, int wi) {
    const int g = wi % 3;
    if (g == 0) attn_sample_waveitem_g<0>(F, wi, inptr(F, I_C1)); else if (g == 1) attn_sample_waveitem_g<1>(F, wi, inptr(F, I_C2)); else attn_sample_waveitem_g<2>(F, wi, inptr(F, I_C3));
}
__device__ __forceinline__ void gla_sample_item(Frame& F, int item) {
    LAUNDER_WS();
    LAS float* L = (LAS float*)F.lds;
    constexpr int O_LA = 0, O_QE = 512, O_KE = 1024, O_KD = 1536, O_DEC = 2048, O_ATT = 2176, O_PART = 2304;
    const int tid = F.tid, b = item >> 2, h = item & 3;
    const bf16* QB = WSL(bf16, WS_QB); const bf16* KB = WSL(bf16, WS_KB); bf16* VB = WSL(bf16, WS_VB); const float* AB = WSL(float, WS_AB);
    const size_t row0 = (size_t)NP + b * 4;
    { const int i = tid >> 7, d = tid & 127; float x = inptr(F, I_BG)[h * 128 + d]; const float* wg2 = inptr(F, I_WG2);
#pragma unroll
      for (int r = 0; r < 16; ++r) x += AB[(row0 + i) * 16 + r] * wg2[r * 512 + h * 128 + d];
      L[O_LA + i * 128 + d] = (fminf(x, 0.f) - log1pf(expf(-fabsf(x)))) * (1.0f / 16.0f); }
    __syncthreads();
    if (tid < 128) { const int d = tid; float bb[4]; float run = 0.f;
#pragma unroll
        for (int i = 0; i < 4; ++i) { run += L[O_LA + i * 128 + d]; bb[i] = run; }
        const float ebl = expf(run); L[O_DEC + d] = ebl;
#pragma unroll
        for (int i = 0; i < 4; ++i) { const float q = bf2f(QB[(row0 + i) * 512 + h * 128 + d]), k = bf2f(KB[(row0 + i) * 512 + h * 128 + d]);
            L[O_QE + i * 128 + d] = q * GLA_QSCALE * expf(bb[i]); L[O_KE + i * 128 + d] = k * expf(-bb[i]); L[O_KD + i * 128 + d] = k * expf(run - bb[i]); } }
    __syncthreads();
    if (tid < 16) { const int i = tid >> 2, j = tid & 3; float a = 0.f;
        if (j <= i) for (int d = 0; d < 128; ++d) a += L[O_QE + i * 128 + d] * L[O_KE + j * 128 + d];
        L[O_ATT + tid] = a; }
    const int e = tid & 255, dh = tid >> 8;
    float v[4];
#pragma unroll
    for (int j = 0; j < 4; ++j) v[j] = bf2f(VB[(row0 + j) * 1024 + h * 256 + e]);
    const float* Sin = inptr(F, I_ST0) + ((size_t)(b * 4 + h) * 128) * 256 + e; float* Sout = F.out + OUT_STS + ((size_t)(b * 4 + h) * 128) * 256 + e;
    float acc[4] = {0.f, 0.f, 0.f, 0.f};
#pragma unroll 4
    for (int dd = 0; dd < 64; ++dd) { const int d = dh * 64 + dd; const float sv = Sin[(size_t)d * 256];
#pragma unroll
        for (int i = 0; i < 4; ++i) acc[i] += L[O_QE + i * 128 + d] * sv;
        float sn = L[O_DEC + d] * sv;
#pragma unroll
        for (int j = 0; j < 4; ++j) sn += L[O_KD + j * 128 + d] * v[j];
        Sout[(size_t)d * 256] = sn; }
#pragma unroll
    for (int i = 0; i < 4; ++i) L[O_PART + (dh * 4 + i) * 256 + e] = acc[i];
    __syncthreads();
    if (tid < 256) {
#pragma unroll
        for (int i = 0; i < 4; ++i) { float o = L[O_PART + i * 256 + e] + L[O_PART + (4 + i) * 256 + e];
#pragma unroll
            for (int j = 0; j < 4; ++j) o += L[O_ATT + i * 4 + j] * v[j];
            VB[(row0 + i) * 1024 + h * 256 + e] = f2bf(o); } }
    __syncthreads();
}

static_assert(true, "");
constexpr int P2_ATT = 3072, P2_DEC = 384, P2_GLS = 128, P2_CPY = 32 * (2 + 8 + 32), P2_ITEMS = P2_ATT + P2_DEC + P2_GLS;
__device__ __forceinline__ void kvshift_item(Frame& F, int item) {
    int g, r = item; if (r < 64) g = 0; else if (r < 64 + 256) { g = 1; r -= 64; } else { g = 2; r -= 320; }
    const int Wb = g == 0 ? 128 : (g == 1 ? 512 : 2048), npc = Wb / 64, b = r / npc, pc = r % npc;
    const float* src = inptr(F, g == 0 ? I_C1 : (g == 1 ? I_C2 : I_C3)); float* dst = F.out + (g == 0 ? OUT_KVS1 : (g == 1 ? OUT_KVS2 : OUT_KVS3));
    const int nrow = (pc == npc - 1) ? 60 : 64;
    const f32x4* s4 = (const f32x4*)src + ((size_t)b * Wb + 64 * pc + 4) * 256; f32x4* d4 = (f32x4*)dst + ((size_t)b * Wb + 64 * pc) * 256;
    { const int i = F.tid; f32x4 v[32];
#pragma unroll
        for (int u = 0; u < 32; ++u) if (u < 30 || nrow == 64) v[u] = __builtin_nontemporal_load(s4 + i + u * NTHR);
#pragma unroll
        for (int u = 0; u < 32; ++u) if (u < 30 || nrow == 64) __builtin_nontemporal_store(v[u], d4 + i + u * NTHR); }
}
template <bool STOP_ON_GDONE> __device__ __forceinline__ void kvshift_loop(Frame& F) {
    for (;;) {
        if (F.tid == 0) { unsigned t = 0xffffffffu;
            if (!STOP_ON_GDONE || __hip_atomic_load(F.ctl + CW_GDONE, RLX_AGENT) == 0u) t = __hip_atomic_fetch_add(F.ctl + CW_CPYQ, 1u, RLX_AGENT);
            F.MISC[0] = t; }
        __syncthreads();
        const unsigned t = F.MISC[0];
        __syncthreads();
        if (t >= (unsigned)P2_CPY) break;
        kvshift_item(F, (int)t);
    }
}
__device__ __forceinline__ void p2_prep(Frame& F) {
    unsigned qa[8], ka[8], qb[8], kb[8]; float aa[2], ab2[2];
    int u = blockIdx.x; if (u >= 2048) return;
    const int d2 = F.tid & 63, h = u & 3;
    const float* wg2 = inptr(F, I_WG2); const float* bgp = inptr(F, I_BG);
    f32x2_t wg[16];
#pragma unroll
    for (int r = 0; r < 16; ++r) wg[r] = *(const f32x2_t*)(wg2 + r * 512 + h * 128 + 2 * d2);
    const f32x2_t bgd = *(const f32x2_t*)(bgp + h * 128 + 2 * d2);
    gla_prep_load(F, u, qa, ka, aa);
    for (;;) {
        const int u1 = u + F.G; if (u1 < 2048) gla_prep_load(F, u1, qb, kb, ab2);
        gla_prep_unit(F, u, qa, ka, aa, wg, bgd); if (u1 >= 2048) break;
        const int u2 = u1 + F.G; if (u2 < 2048) gla_prep_load(F, u2, qa, ka, aa);
        gla_prep_unit(F, u1, qb, kb, ab2, wg, bgd); if (u2 >= 2048) break;
        u = u2;
    }
}
__device__ __forceinline__ void p2_mixers(Frame& F) {
#if defined(PROBE_PHASE) && PROBE_PHASE >= 100
    const unsigned long long tp0 = __builtin_amdgcn_s_memrealtime();
#endif
#ifndef P2_SKIP_GLAP
    if (blockIdx.x < 128) {
        const int bx = blockIdx.x, bh = (bx & 7) + 8 * (bx >> 5), sl = (bx >> 3) & 3;
        gla_prompt_unit(F, bh >> 2, bh & 3, sl); }
#endif
#if defined(PROBE_PHASE) && PROBE_PHASE == 100
    if (blockIdx.x == 0) F.tp = __builtin_amdgcn_s_memrealtime() - tp0;
#endif
    constexpr int QCHUNK = 4;
    for (int it = 0, itend = 0;; ++it) {
        if (it >= itend) {
            if (F.tid == 0) F.MISC[0] = __hip_atomic_fetch_add(F.ctl + CW_QUEUE, (unsigned)QCHUNK, RLX_AGENT);
            __syncthreads();
            it = (int)F.MISC[0]; itend = it + QCHUNK;
            __syncthreads();
        }
        if (it >= P2_ITEMS) break;
#if defined(PROBE_PHASE) && PROBE_PHASE == 101
        if (blockIdx.x == 255) F.tp = __builtin_amdgcn_s_memrealtime() - tp0;
#endif
#if defined(PROBE_PHASE) && PROBE_PHASE == 102
        if (blockIdx.x == 255 && it >= P2_GLS + P2_DEC + P2_ATT && F.tp == 0ull) F.tp = __builtin_amdgcn_s_memrealtime() - tp0;
#endif
#if defined(PROBE_PHASE) && PROBE_PHASE >= 103 && PROBE_PHASE <= 106
        const unsigned long long ti0 = __builtin_amdgcn_s_memrealtime();
        const int pcls = it < P2_GLS ? 105 : (it < P2_GLS + P2_DEC ? 104 : (it < P2_GLS + P2_DEC + P2_ATT ? 103 : 106));
#endif
        if (it < P2_GLS) {
#ifndef P2_SKIP_GLAS
            gla_sample_item(F, it);
#endif
        } else if (it < P2_GLS + P2_DEC) {
#ifndef P2_SKIP_DEC
            attn_sample_waveitem(F, (it - P2_GLS) * 8 + F.wave); __syncthreads();
#endif
        } else if (it < P2_GLS + P2_DEC + P2_ATT) {
#ifndef P2_SKIP_ATT
            const int a0 = it - P2_GLS - P2_DEC;
            v4u kk[6], vv[6]; bf16x8 qa[4], qb[4];
            attn_issue(F, a0, kk, vv, qa);
            attn_prompt_item(F, a0, kk, vv, qa, true, a0 + 1, qb);
            attn_prompt_item(F, a0 + 1, kk, vv, qb, true, a0 + 2, qa);
            attn_prompt_item(F, a0 + 2, kk, vv, qa, true, a0 + 3, qb);
            attn_prompt_item(F, a0 + 3, kk, vv, qb, false, 0, qa);
            it = itend - 1;
#endif
        }
#if defined(PROBE_PHASE) && PROBE_PHASE >= 103 && PROBE_PHASE <= 106
        if (blockIdx.x == 255 && pcls == PROBE_PHASE) F.tp += __builtin_amdgcn_s_memrealtime() - ti0;
#endif
    }
#if defined(PROBE_PHASE) && PROBE_PHASE == 107
    const unsigned long long tc0 = __builtin_amdgcn_s_memrealtime();
#endif
    kvshift_loop<false>(F);
#if defined(PROBE_PHASE) && PROBE_PHASE == 107
    if (blockIdx.x == 255) F.tp = __builtin_amdgcn_s_memrealtime() - tc0;
#endif
}

__device__ __forceinline__ void p3_kvout(const bf16* K, const bf16* V, float* dst, int g, int W, int nb, size_t rowbase, int rows_per_b, int first, int pos0, int Wdst, size_t gt, size_t ngt) {
    const size_t per_b = (size_t)W * 2 * 64, tot = per_b * nb;
    for (size_t i = gt; i < tot; i += ngt) { const size_t b = i / per_b, r = i - b * per_b; const int p = (int)(r >> 7), c = (int)(r >> 6) & 1, ch = (int)r & 63;
        const v4u u = *(const v4u*)((c ? V : K) + (rowbase + b * rows_per_b + first + p) * 1536 + g * 512 + ch * 8);
        float* o = dst + ((b * Wdst + pos0 + p) * 2 + c) * 512 + ch * 8;
        *(f32x4*)o = (f32x4){bf_lo(u.x), bf_hi(u.x), bf_lo(u.y), bf_hi(u.y)}; *(f32x4*)(o + 4) = (f32x4){bf_lo(u.z), bf_hi(u.z), bf_lo(u.w), bf_hi(u.w)}; }
}
__device__ __forceinline__ void p3_merge(Frame& F) {
    const int gw = blockIdx.x * NWAVES + F.wave, NGW = F.G * NWAVES, lane = F.lane;
    const size_t gt = (size_t)blockIdx.x * NTHR + F.tid, ngt = (size_t)F.G * NTHR;
    const bf16* OA = WSP(bf16, WS_QA); const bf16* OB = WSP(bf16, WS_VB); const bf16* RB = WSP(bf16, WS_RB); const float* LSE = WSP(float, WS_LSE);
    bf16* OAM = WSP(bf16, WS_OAM); bf16* OBN = WSP(bf16, WS_OBN); const float* gn = inptr(F, I_GN);
    for (int m = gw; m < MPAD; m += NGW) {
        if (m >= NTOK) { *(v4u*)(OAM + (size_t)m * 512 + lane * 8) = (v4u){0u, 0u, 0u, 0u}; *(v4u*)(OBN + (size_t)m * 1024 + lane * 16) = (v4u){0u, 0u, 0u, 0u}; *(v4u*)(OBN + (size_t)m * 1024 + lane * 16 + 8) = (v4u){0u, 0u, 0u, 0u}; continue; }
        {
            const int hd = lane >> 3, c8 = (lane & 7) * 8;
            const float l0 = LSE[((size_t)0 * MPAD + m) * 8 + hd], l1 = LSE[((size_t)1 * MPAD + m) * 8 + hd], l2 = LSE[((size_t)2 * MPAD + m) * 8 + hd];
            const float mx = fmaxf(l0, fmaxf(l1, l2)); float w0 = __expf(l0 - mx), w1 = __expf(l1 - mx), w2 = __expf(l2 - mx); const float iw = 1.0f / (w0 + w1 + w2); w0 *= iw; w1 *= iw; w2 *= iw;
            const v4u a = *(const v4u*)(OA + (size_t)m * 1536 + hd * 64 + c8), b2 = *(const v4u*)(OA + (size_t)m * 1536 + 512 + hd * 64 + c8), c = *(const v4u*)(OA + (size_t)m * 1536 + 1024 + hd * 64 + c8);
            v4u o;
            o.x = cvt_pk_bf16(w0 * bf_lo(a.x) + w1 * bf_lo(b2.x) + w2 * bf_lo(c.x), w0 * bf_hi(a.x) + w1 * bf_hi(b2.x) + w2 * bf_hi(c.x));
            o.y = cvt_pk_bf16(w0 * bf_lo(a.y) + w1 * bf_lo(b2.y) + w2 * bf_lo(c.y), w0 * bf_hi(a.y) + w1 * bf_hi(b2.y) + w2 * bf_hi(c.y));
            o.z = cvt_pk_bf16(w0 * bf_lo(a.z) + w1 * bf_lo(b2.z) + w2 * bf_lo(c.z), w0 * bf_hi(a.z) + w1 * bf_hi(b2.z) + w2 * bf_hi(c.z));
            o.w = cvt_pk_bf16(w0 * bf_lo(a.w) + w1 * bf_lo(b2.w) + w2 * bf_lo(c.w), w0 * bf_hi(a.w) + w1 * bf_hi(b2.w) + w2 * bf_hi(c.w));
            *(v4u*)(OAM + (size_t)m * 512 + hd * 64 + c8) = o;
        }
        {
            const int c0 = lane * 16;
            const v4u u0 = *(const v4u*)(OB + (size_t)m * 1024 + c0), u1 = *(const v4u*)(OB + (size_t)m * 1024 + c0 + 8);
            const v4u r0 = *(const v4u*)(RB + (size_t)m * 1024 + c0), r1 = *(const v4u*)(RB + (size_t)m * 1024 + c0 + 8);
            float x[16] = {bf_lo(u0.x), bf_hi(u0.x), bf_lo(u0.y), bf_hi(u0.y), bf_lo(u0.z), bf_hi(u0.z), bf_lo(u0.w), bf_hi(u0.w), bf_lo(u1.x), bf_hi(u1.x), bf_lo(u1.y), bf_hi(u1.y), bf_lo(u1.z), bf_hi(u1.z), bf_lo(u1.w), bf_hi(u1.w)};
            float rr[16] = {bf_lo(r0.x), bf_hi(r0.x), bf_lo(r0.y), bf_hi(r0.y), bf_lo(r0.z), bf_hi(r0.z), bf_lo(r0.w), bf_hi(r0.w), bf_lo(r1.x), bf_hi(r1.x), bf_lo(r1.y), bf_hi(r1.y), bf_lo(r1.z), bf_hi(r1.z), bf_lo(r1.w), bf_hi(r1.w)};
            float ss = 0.f;
#pragma unroll
            for (int i = 0; i < 16; ++i) ss += x[i] * x[i];
            ss += __shfl_xor(ss, 1); ss += __shfl_xor(ss, 2); ss += __shfl_xor(ss, 4); ss += __shfl_xor(ss, 8);
            const float rs = 1.0f / sqrtf(ss * (1.0f / 256.0f) + LN_EPS);
            float y[16];
#pragma unroll
            for (int i = 0; i < 16; ++i) { const float gte = rr[i] * __builtin_amdgcn_rcpf(1.0f + __expf(-rr[i])); y[i] = x[i] * rs * gn[c0 + i] * gte; }
            v4u o0, o1; o0.x = cvt_pk_bf16(y[0], y[1]); o0.y = cvt_pk_bf16(y[2], y[3]); o0.z = cvt_pk_bf16(y[4], y[5]); o0.w = cvt_pk_bf16(y[6], y[7]);
            o1.x = cvt_pk_bf16(y[8], y[9]); o1.y = cvt_pk_bf16(y[10], y[11]); o1.z = cvt_pk_bf16(y[12], y[13]); o1.w = cvt_pk_bf16(y[14], y[15]);
            *(v4u*)(OBN + (size_t)m * 1024 + c0) = o0; *(v4u*)(OBN + (size_t)m * 1024 + c0 + 8) = o1;
        }
    }
    const bf16* KA = WSP(bf16, WS_KA); const bf16* VA = WSP(bf16, WS_VA);
    p3_kvout(KA, VA, F.out + OUT_KVP1, 0, 128, 8, 0, TSEQ, TSEQ - 128, 0, 128, gt, ngt);
    p3_kvout(KA, VA, F.out + OUT_KVP2, 1, 512, 8, 0, TSEQ, TSEQ - 512, 0, 512, gt, ngt);
    p3_kvout(KA, VA, F.out + OUT_KVP3, 2, 2048, 8, 0, TSEQ, TSEQ - 2048, 0, 2048, gt, ngt);
    p3_kvout(KA, VA, F.out + OUT_KVS1, 0, 4, 32, NP, 4, 0, 124, 128, gt, ngt);
    p3_kvout(KA, VA, F.out + OUT_KVS2, 1, 4, 32, NP, 4, 0, 508, 512, gt, ngt);
    p3_kvout(KA, VA, F.out + OUT_KVS3, 2, 4, 32, NP, 4, 0, 2044, 2048, gt, ngt);
}

__device__ __forceinline__ void p6_ln1(Frame& F) {
    const int gw = blockIdx.x * NWAVES + F.wave, NGW = F.G * NWAVES, lane = F.lane;
    float* H = WSP(float, WS_H); bf16* X1B = WSP(bf16, WS_X1B); const float* l1g = inptr(F, I_L1G); const float* l1b = inptr(F, I_L1B);
    f32x4 gg[4], bb[4];
#pragma unroll
    for (int j = 0; j < 4; ++j) { gg[j] = ((const f32x4*)l1g)[lane + 64 * j]; bb[j] = ((const f32x4*)l1b)[lane + 64 * j]; }
    int m = gw; if (m >= MPAD) return;
    f32x4 v[4], vn[4];
#pragma unroll
    for (int j = 0; j < 4; ++j) v[j] = ((const f32x4*)(H + (size_t)m * 1024) + lane)[64 * j];
    for (;;) {
        const int mn = m + NGW; const bool more = mn < MPAD;
        if (more) {
#pragma unroll
            for (int j = 0; j < 4; ++j) vn[j] = ((const f32x4*)(H + (size_t)mn * 1024) + lane)[64 * j]; }
        float s = 0.f;
#pragma unroll
        for (int j = 0; j < 4; ++j) s += (v[j][0] + v[j][1]) + (v[j][2] + v[j][3]);
        const float mean = wave_sum(s) * (1.f / 1024.f); float s2 = 0.f;
#pragma unroll
        for (int j = 0; j < 4; ++j) { v[j] = v[j] - mean; s2 += (v[j][0] * v[j][0] + v[j][1] * v[j][1]) + (v[j][2] * v[j][2] + v[j][3] * v[j][3]); }
        const float rstd = 1.f / sqrtf(wave_sum(s2) * (1.f / 1024.f) + LN_EPS);
        f32x4* hr = (f32x4*)(H + (size_t)m * 1024) + lane;
        unsigned long long* o8 = (unsigned long long*)(X1B + (size_t)m * 1024) + lane;
#pragma unroll
        for (int j = 0; j < 4; ++j) { const f32x4 y = v[j] * rstd * gg[j] + bb[j]; hr[64 * j] = y;
            o8[64 * j] = (unsigned long long)cvt_pk_bf16(y[0], y[1]) | ((unsigned long long)cvt_pk_bf16(y[2], y[3]) << 32); }
        if (!more) break;
#pragma unroll
        for (int j = 0; j < 4; ++j) v[j] = vn[j];
        m = mn;
    }
}

__device__ __forceinline__ unsigned mono_key(float f) { const unsigned u = __float_as_uint(f); return u ^ ((unsigned)((int)u >> 31) | 0x80000000u); }
__device__ __forceinline__ float mono_inv(unsigned k) { return __uint_as_float((k & 0x80000000u) ? (k ^ 0x80000000u) : ~k); }
#define CE_DESC(a, b) do { const unsigned _mx = (a) > (b) ? (a) : (b), _mn = (a) > (b) ? (b) : (a); (a) = _mx; (b) = _mn; } while (0)
template <int J> __device__ __forceinline__ void bitonic_step_desc(unsigned (&v)[16]) {
#pragma unroll
    for (int i = 0; i < 16; ++i) if ((i & J) == 0) CE_DESC(v[i], v[i | J]);
}
template <int K, int J> __device__ __forceinline__ void bitonic_step(unsigned (&v)[16]) {
#pragma unroll
    for (int i = 0; i < 16; ++i) if ((i & J) == 0) { if ((i & K) == 0) CE_DESC(v[i], v[i | J]); else CE_DESC(v[i | J], v[i]); }
}
__device__ __forceinline__ void sort16_desc(unsigned (&v)[16]) {
    bitonic_step<2, 1>(v);
    bitonic_step<4, 2>(v); bitonic_step<4, 1>(v);
    bitonic_step<8, 4>(v); bitonic_step<8, 2>(v); bitonic_step<8, 1>(v);
    bitonic_step_desc<8>(v); bitonic_step_desc<4>(v); bitonic_step_desc<2>(v); bitonic_step_desc<1>(v);
}
__device__ __forceinline__ void merge16_desc(unsigned (&T)[16], const unsigned (&N)[16]) {
#pragma unroll
    for (int k = 0; k < 16; ++k) T[k] = T[k] > N[15 - k] ? T[k] : N[15 - k];
    bitonic_step_desc<8>(T); bitonic_step_desc<4>(T); bitonic_step_desc<2>(T); bitonic_step_desc<1>(T);
}
__device__ __forceinline__ void merge_partner16(unsigned (&T)[16]) {
    unsigned P[16];
#pragma unroll
    for (int k = 0; k < 16; ++k) P[k] = (unsigned)__shfl_xor((int)T[k], 32);
    merge16_desc(T, P);
}
__device__ __forceinline__ void p8_topk_item(Frame& F, int item) {
    const int lane = F.lane, hh = lane >> 5, il = lane & 31;
    const int tb = item >> 3, hd = item & 7; const int row = 32 * tb + il;
    const bf16* QN = WSP(bf16, WS_QN); const bf16* KEYS = WSP(bf16, WS_KEYS); int* EIDX = WSP(int, WS_EIDX); float* GATE = WSP(float, WS_GATE);
    LAS unsigned* LK = (LAS unsigned*)(F.lds + F.wave * 8192);
    unsigned T1[16], T2[16];
#pragma unroll
    for (int half = 0; half < 2; ++half) {
        bf16x8 bq[8];
#pragma unroll
        for (int s = 0; s < 8; ++s) bq[s] = *(const bf16x8*)(QN + (size_t)row * 2048 + hd * 256 + half * 128 + 16 * s + 8 * hh);
        unsigned T[16];
#pragma unroll
        for (int k = 0; k < 16; ++k) T[k] = 0u;
        const bf16* kbase = KEYS + ((size_t)(hd * 2 + half) * 128 + il) * 128 + 8 * hh;
        bf16x8 kf[8];
#pragma unroll
        for (int s = 0; s < 8; ++s) kf[s] = *(const bf16x8*)(kbase + 16 * s);
#pragma unroll 1
        for (int kt = 0; kt < 4; ++kt) {
            f32x16 acc;
#pragma unroll
            for (int x = 0; x < 16; ++x) acc[x] = 0.f;
#pragma unroll
            for (int s = 0; s < 8; ++s) acc = MFMA32(kf[s], bq[s], acc);
            if (kt < 3) {
#pragma unroll
                for (int s = 0; s < 8; ++s) kf[s] = *(const bf16x8*)(kbase + (size_t)(32 * (kt + 1)) * 128 + 16 * s); }
            unsigned N[16];
#pragma unroll
            for (int x = 0; x < 16; ++x) { const int idx = 32 * kt + crow(x, hh); N[x] = (mono_key(acc[x]) & ~127u) | (unsigned)(127 - idx); }
            sort16_desc(N);
            merge16_desc(T, N);
        }
        merge_partner16(T);
#pragma unroll
        for (int k = 0; k < 16; ++k) { LK[(half * 16 + k) * 64 + lane] = T[k]; if (half == 0) T1[k] = T[k]; else T2[k] = T[k]; }
    }
    float v1s[8], v2[16];
#pragma unroll
    for (int k = 0; k < 16; ++k) v2[k] = mono_inv(T2[k] & ~127u);
#pragma unroll
    for (int i2 = 0; i2 < 8; ++i2) v1s[i2] = mono_inv((hh ? T1[2 * i2 + 1] : T1[2 * i2]) & ~127u);
    unsigned C[16], D[16];
#pragma unroll
    for (int k = 0; k < 16; ++k) { C[k] = 0u; D[k] = 0u; }
    {   int n = 0;
#pragma unroll
        for (int i2 = 0; i2 < 8; ++i2)
#pragma unroll
            for (int c = 0; c < 16; ++c) if ((2 * i2 + 1) * (c + 1) <= 16) { const unsigned key = (mono_key(v1s[i2] + v2[c]) & ~255u) | (unsigned)(255 - (16 * (2 * i2 + hh) + c));
                if (n < 16) C[n] = key; else D[n - 16] = key; ++n; }
    }
    sort16_desc(C); sort16_desc(D); merge16_desc(C, D);
    merge_partner16(C);
    LDS_WAIT(); asm volatile("" ::: "memory");
    float sv[16]; int ex[16]; float mx = NEG_BIG;
#pragma unroll
    for (int k = 0; k < 16; ++k) { const int si = 255 - (int)(C[k] & 255u), a = si >> 4, c = si & 15;
        const unsigned k1 = LK[a * 64 + lane], k2 = LK[(16 + c) * 64 + lane];
        ex[k] = (127 - (int)(k1 & 127u)) * 128 + (127 - (int)(k2 & 127u)); sv[k] = mono_inv(k1 & ~127u) + mono_inv(k2 & ~127u); mx = fmaxf(mx, sv[k]); }
    float den = 0.f;
#pragma unroll
    for (int k = 0; k < 16; ++k) { sv[k] = __expf(sv[k] - mx); den += sv[k]; }
    const float iden = 1.0f / den;
    if (hh == 0 && row < NTOK) {
#pragma unroll
        for (int k4 = 0; k4 < 4; ++k4) { *(int4*)(EIDX + (size_t)row * 128 + hd * 16 + 4 * k4) = make_int4(ex[4 * k4], ex[4 * k4 + 1], ex[4 * k4 + 2], ex[4 * k4 + 3]);
            *(f32x4*)(GATE + (size_t)row * 128 + hd * 16 + 4 * k4) = (f32x4){sv[4 * k4] * iden, sv[4 * k4 + 1] * iden, sv[4 * k4 + 2] * iden, sv[4 * k4 + 3] * iden}; } }
    LDS_WAIT(); asm volatile("" ::: "memory");
}

constexpr size_t WS_ACTP = WS_QB, WS_COEF = WS_KA, WS_PEERO = WS_RB, WS_X1H = WS_VA;
static_assert(WS_ACTP + (size_t)8 * NTOK * 128 * 4 <= WS_RB && WS_PEERO + (size_t)NTOK * 1024 * 4 <= WS_GB, "peer buffers");
__device__ __forceinline__ float gelu_erf(float x) { return 0.5f * x * (1.0f + erff(x * 0.70710678118654752f)); }
#define DPP_F(x, ctrl) __uint_as_float((unsigned)__builtin_amdgcn_mov_dpp((int)__float_as_uint(x), (ctrl), 0xf, 0xf, true))
__device__ __forceinline__ float dot16_fp8(const float (&x)[16], const v4u u) {
    float a = 0.f;
#pragma unroll
    for (int q = 0; q < 4; ++q) { const f32x2_t lo = __builtin_amdgcn_cvt_pk_f32_fp8((int)u[q], false), hi = __builtin_amdgcn_cvt_pk_f32_fp8((int)u[q], true);
        a += x[4 * q] * lo.x + x[4 * q + 1] * lo.y + x[4 * q + 2] * hi.x + x[4 * q + 3] * hi.y; }
    return a;
}
typedef float f32x4_t __attribute__((ext_vector_type(4)));
typedef int i32x4_t __attribute__((ext_vector_type(4)));
#ifndef PEER_CVT_VIA_F32
#define PEER_CVT_VIA_F32 0
#endif
#ifndef PEER_DOT_F32
#define PEER_DOT_F32 0
#endif
#if PEER_DOT_F32
#define PEER_DOT2(d, a, b) do { const h2_t a__ = (a), b__ = (b); d += (float)a__.x * (float)b__.x + (float)a__.y * (float)b__.y; } while (0)
#else
#define PEER_DOT2(d, a, b) d = __builtin_amdgcn_fdot2((a), (b), d, false)
#endif
template <bool HI> __device__ __forceinline__ h2_t fp8x2_to_h2(int w) {
#if PEER_CVT_VIA_F32
    const f32x2_t f = __builtin_amdgcn_cvt_pk_f32_fp8(w, HI); return (h2_t){(_Float16)f.x, (_Float16)f.y};
#else
    return __builtin_amdgcn_cvt_scalef32_pk_f16_fp8(w, 1.0f, HI);
#endif
}
template <unsigned EMASK> __device__ __forceinline__ void peer_u_phase_t(Frame& F) {
    const int lane = F.lane, p = lane >> 3, q = lane & 7, c = blockIdx.x & 7, wv = (blockIdx.x >> 3) * NWAVES + F.wave, nwv = (F.G >> 3) * NWAVES;
    const int* EIDX = WSP(int, WS_EIDX) + 16 * p; float* ACTP = WSP(float, WS_ACTP) + (size_t)c * NTOK * 128 + 16 * p + 2 * q;
    const unsigned char* U8 = WSP(unsigned char, WS_UT) + ((size_t)c * 16384 << 7) + 16 * q;
#define PU_LOADE(EV, M) do { _Pragma("unroll") for (int t_ = 0; t_ < 4; ++t_) EV[t_] = *(const i32x4_t*)(EIDX + (size_t)(M) * 128 + 4 * t_); } while (0)
#define PU_ISSUE(UR, EV) do { _Pragma("unroll") for (int g = 0; g < 16; ++g) UR[g] = *(const v4u*)(U8 + (((unsigned)EV[g >> 2][g & 3] & EMASK) << 7)); } while (0)
#define PU_BODY(UR, UN, M) do { const int m_ = (M); const int m1_ = m_ + nwv, m2_ = m_ + 2 * nwv; \
        if (m1_ < NTOK) PU_ISSUE(UN, ev); \
        if (m2_ < NTOK) PU_LOADE(ev, m2_); \
        const float* xf_ = (const float*)(F.ws + WS_H) + (size_t)m_ * 1024 + 128 * c + 16 * q; \
        const f32x4 xa_ = *(const f32x4*)xf_, xb_ = *(const f32x4*)(xf_ + 4), xc_ = *(const f32x4*)(xf_ + 8), xd_ = *(const f32x4*)(xf_ + 12); \
        const h2_t xh[8] = {(h2_t){(_Float16)xa_[0], (_Float16)xa_[1]}, (h2_t){(_Float16)xa_[2], (_Float16)xa_[3]}, (h2_t){(_Float16)xb_[0], (_Float16)xb_[1]}, (h2_t){(_Float16)xb_[2], (_Float16)xb_[3]}, (h2_t){(_Float16)xc_[0], (_Float16)xc_[1]}, (h2_t){(_Float16)xc_[2], (_Float16)xc_[3]}, (h2_t){(_Float16)xd_[0], (_Float16)xd_[1]}, (h2_t){(_Float16)xd_[2], (_Float16)xd_[3]}}; \
        float a[16]; \
        _Pragma("unroll") for (int g = 0; g < 16; ++g) { float d_ = 0.f; \
            _Pragma("unroll") for (int t_ = 0; t_ < 4; ++t_) { PEER_DOT2(d_, fp8x2_to_h2<false>((int)UR[g][t_]), xh[2 * t_]); PEER_DOT2(d_, fp8x2_to_h2<true>((int)UR[g][t_]), xh[2 * t_ + 1]); } \
            a[g] = d_; if ((g & 1) == 1 && g < 15) asm volatile("" : "+v"(a[g - 1]), "+v"(a[g]), "+v"(UR[(g + 1) & 15]), "+v"(UR[(g + 2) & 15])); } \
        float b8[8], b4[4], b2[2]; \
        { const bool up = (q & 4) != 0; _Pragma("unroll") for (int k = 0; k < 8; ++k) { const float send = up ? a[k] : a[k + 8], keep = up ? a[k + 8] : a[k]; b8[k] = keep + DPP_F(send, 0x141); } } \
        { const bool up = (q & 2) != 0; _Pragma("unroll") for (int k = 0; k < 4; ++k) { const float send = up ? b8[k] : b8[k + 4], keep = up ? b8[k + 4] : b8[k]; b4[k] = keep + DPP_F(send, 0x4E); } } \
        { const bool up = (q & 1) != 0; _Pragma("unroll") for (int k = 0; k < 2; ++k) { const float send = up ? b4[k] : b4[k + 2], keep = up ? b4[k + 2] : b4[k]; b2[k] = keep + DPP_F(send, 0xB1); } } \
        *(f32x2_t*)(ACTP + (size_t)m_ * 128) = (f32x2_t){b2[0], b2[1]}; } while (0)
    int m = wv; if (m >= NTOK) return;
    i32x4_t ev[4];
    PU_LOADE(ev, m);
    v4u ua[16], ub[16];
    PU_ISSUE(ua, ev);
    if (m + nwv < NTOK) PU_LOADE(ev, m + nwv);
    for (;;) {
        PU_BODY(ua, ub, m); m += nwv; if (m >= NTOK) break;
        PU_BODY(ub, ua, m); m += nwv; if (m >= NTOK) break;
    }
#undef PU_LOADE
#undef PU_ISSUE
#undef PU_BODY
}
__device__ __forceinline__ void peer_u_phase(Frame& F) { peer_u_phase_t<0xffffffffu>(F); }
__device__ __forceinline__ void peer_coef_phase(Frame& F) {
    const int gw = blockIdx.x * NWAVES + F.wave, NGW = F.G * NWAVES, lane = F.lane;
    const float* ACTP = WSP(float, WS_ACTP); const float* GATE = WSP(float, WS_GATE); float* COEF = WSP(float, WS_COEF);
    for (int m = gw; m < NTOK; m += NGW) {
#pragma unroll
        for (int hf = 0; hf < 2; ++hf) { const int k = lane + 64 * hf; float a = 0.f;
#pragma unroll
            for (int c = 0; c < 8; ++c) a += ACTP[((size_t)c * NTOK + m) * 128 + k];
            COEF[(size_t)m * 128 + k] = GATE[(size_t)m * 128 + k] * gelu_erf(a * (1.0f / U_SCALE)); }
    }
}
__device__ __forceinline__ void peer_v_phase(Frame& F) {
    const int lane = F.lane, p = lane >> 3, q = lane & 7, c = blockIdx.x & 7, wv = (blockIdx.x >> 3) * NWAVES + F.wave, nwv = (F.G >> 3) * NWAVES;
    const int* EIDX = WSP(int, WS_EIDX) + 16 * p; const float* COEF = WSP(float, WS_COEF) + 16 * p; bf16* PEERO = WSP(bf16, WS_PEERO) + 128 * c + 16 * q + 2 * p;
    const unsigned char* V8 = WSP(unsigned char, WS_VT) + ((size_t)c * 16384 << 7) + 16 * q;
    int m = wv; if (m >= NTOK) return;
    i32x4_t ev[4];
#pragma unroll
    for (int t = 0; t < 4; ++t) ev[t] = *(const i32x4_t*)(EIDX + (size_t)m * 128 + 4 * t);
    v4u vr[16];
#pragma unroll
    for (int g = 0; g < 16; ++g) vr[g] = *(const v4u*)(V8 + ((unsigned)ev[g >> 2][g & 3] << 7));
    for (;;) {
        f32x4_t cv[4];
#pragma unroll
        for (int t = 0; t < 4; ++t) cv[t] = *(const f32x4_t*)(COEF + (size_t)m * 128 + 4 * t);
        const int mn = m + nwv; const bool more = mn < NTOK;
        if (more) {
#pragma unroll
            for (int t = 0; t < 4; ++t) ev[t] = *(const i32x4_t*)(EIDX + (size_t)mn * 128 + 4 * t); }
        h2_t acc[8];
#pragma unroll
        for (int i = 0; i < 8; ++i) acc[i] = (h2_t){(_Float16)0.f, (_Float16)0.f};
#pragma unroll
        for (int g = 0; g < 16; ++g) { const _Float16 cfh = (_Float16)cv[g >> 2][g & 3]; const h2_t cf2 = {cfh, cfh};
#pragma unroll
            for (int t = 0; t < 4; ++t) { acc[2 * t] += fp8x2_to_h2<false>((int)vr[g][t]) * cf2; acc[2 * t + 1] += fp8x2_to_h2<true>((int)vr[g][t]) * cf2; }
            if ((g & 3) == 3 && g < 15) asm volatile("" : "+v"(acc[0]), "+v"(acc[1]), "+v"(acc[2]), "+v"(acc[3]), "+v"(acc[4]), "+v"(acc[5]), "+v"(acc[6]), "+v"(acc[7]), "+v"(vr[(g + 1) & 15]), "+v"(vr[(g + 2) & 15]), "+v"(vr[(g + 3) & 15]), "+v"(vr[(g + 4) & 15])); }
        __builtin_amdgcn_sched_barrier(0);
        if (more) {
#pragma unroll
            for (int g = 0; g < 16; ++g) vr[g] = *(const v4u*)(V8 + ((unsigned)ev[g >> 2][g & 3] << 7)); }
        __builtin_amdgcn_sched_barrier(0);
        unsigned w[8];
#pragma unroll
        for (int i = 0; i < 8; ++i) w[i] = __builtin_bit_cast(unsigned, acc[i]);
        h2_t r4[4], r2[2], r1;
        { const bool up = (lane & 32) != 0;
#pragma unroll
          for (int k = 0; k < 4; ++k) { const unsigned send = up ? w[k] : w[k + 4], keep = up ? w[k + 4] : w[k]; r4[k] = __builtin_bit_cast(h2_t, keep) + __builtin_bit_cast(h2_t, (unsigned)__shfl_xor((int)send, 32)); } }
        { const bool up = (lane & 16) != 0;
#pragma unroll
          for (int k = 0; k < 2; ++k) { const unsigned a_ = __builtin_bit_cast(unsigned, r4[k]), b_ = __builtin_bit_cast(unsigned, r4[k + 2]); const unsigned send = up ? a_ : b_, keep = up ? b_ : a_; r2[k] = __builtin_bit_cast(h2_t, keep) + __builtin_bit_cast(h2_t, (unsigned)__shfl_xor((int)send, 16)); } }
        { const bool up = (lane & 8) != 0; const unsigned a_ = __builtin_bit_cast(unsigned, r2[0]), b_ = __builtin_bit_cast(unsigned, r2[1]); const unsigned send = up ? a_ : b_, keep = up ? b_ : a_;
          r1 = __builtin_bit_cast(h2_t, keep) + __builtin_bit_cast(h2_t, (unsigned)__builtin_amdgcn_mov_dpp((int)send, 0x128, 0xf, 0xf, true)); }
        *(unsigned*)(PEERO + (size_t)m * 1024) = cvt_pk_bf16((float)r1.x * (1.0f / V_SCALE), (float)r1.y * (1.0f / V_SCALE));
        if (!more) break;
        m = mn;
    }
}
__device__ __forceinline__ void peer_ln2_phase(Frame& F) {
    const int gw = blockIdx.x * NWAVES + F.wave, NGW = F.G * NWAVES, lane = F.lane;
    const float* X1 = WSP(float, WS_H); const bf16* PEERO = WSP(bf16, WS_PEERO); const float* l2g = inptr(F, I_L2G); const float* l2b = inptr(F, I_L2B);
    f32x4 gg[4], bb[4];
#pragma unroll
    for (int t = 0; t < 4; ++t) { gg[t] = *(const f32x4*)(l2g + 4 * lane + 256 * t); bb[t] = *(const f32x4*)(l2b + 4 * lane + 256 * t); }
    int m = gw; if (m >= NTOK) return;
    f32x4 xa[4], xn[4]; v2u pa[4], pn[4];
#pragma unroll
    for (int t = 0; t < 4; ++t) { xa[t] = *(const f32x4*)(X1 + (size_t)m * 1024 + 4 * lane + 256 * t); pa[t] = *(const v2u*)(PEERO + (size_t)m * 1024 + 4 * lane + 256 * t); }
    for (;;) {
        const int mn = m + NGW; const bool more = mn < NTOK;
        if (more) {
#pragma unroll
            for (int t = 0; t < 4; ++t) { xn[t] = *(const f32x4*)(X1 + (size_t)mn * 1024 + 4 * lane + 256 * t); pn[t] = *(const v2u*)(PEERO + (size_t)mn * 1024 + 4 * lane + 256 * t); } }
        float acc[16]; float s = 0.f;
#pragma unroll
        for (int t = 0; t < 4; ++t) { const float pz[4] = {bf_lo(pa[t].x), bf_hi(pa[t].x), bf_lo(pa[t].y), bf_hi(pa[t].y)};
#pragma unroll
            for (int i = 0; i < 4; ++i) { acc[4 * t + i] = ALPHA * xa[t][i] + pz[i]; s += acc[4 * t + i]; } }
        const float mean = wave_sum(s) * (1.f / 1024.f); float s2 = 0.f;
#pragma unroll
        for (int i = 0; i < 16; ++i) { acc[i] -= mean; s2 += acc[i] * acc[i]; }
        const float rstd = 1.f / sqrtf(wave_sum(s2) * (1.f / 1024.f) + LN_EPS);
        float* yo = m < NP ? F.out + OUT_YP + (size_t)m * 1024 : F.out + OUT_YS + (size_t)(m - NP) * 1024;
#pragma unroll
        for (int t = 0; t < 4; ++t) { const int cc = 4 * lane + 256 * t;
            *(f32x4*)(yo + cc) = (f32x4){acc[4 * t] * rstd * gg[t][0] + bb[t][0], acc[4 * t + 1] * rstd * gg[t][1] + bb[t][1], acc[4 * t + 2] * rstd * gg[t][2] + bb[t][2], acc[4 * t + 3] * rstd * gg[t][3] + bb[t][3]}; }
        if (!more) break;
#pragma unroll
        for (int t = 0; t < 4; ++t) { xa[t] = xn[t]; pa[t] = pn[t]; }
        m = mn;
    }
}

template <class Epi> __device__ __forceinline__ void skinny_sample_gemm(Frame& F, const bf16* A, const bf16* Bt, int K, const Epi& epi) {
    typedef float f32x4a __attribute__((ext_vector_type(4)));
    const int lane = F.lane, r = lane & 15, kg = lane >> 4;
    for (int strip = blockIdx.x; strip < 64; strip += F.G) {
        const bf16* ap = A + (size_t)(NP + 16 * F.wave + r) * K + 8 * kg;
        const bf16* bp = Bt + (size_t)(16 * strip + r) * K + 8 * kg;
        f32x4a acc = {0.f, 0.f, 0.f, 0.f};
        for (int s0 = 0; s0 < K / 32; s0 += 8) { bf16x8 af[8], bfr[8];
#pragma unroll
            for (int u = 0; u < 8; ++u) { af[u] = *(const bf16x8*)(ap + 32 * (s0 + u)); bfr[u] = *(const bf16x8*)(bp + 32 * (s0 + u)); }
#pragma unroll
            for (int u = 0; u < 8; ++u) acc = __builtin_amdgcn_mfma_f32_16x16x32_bf16(af[u], bfr[u], acc, 0, 0, 0); }
#pragma unroll
        for (int i = 0; i < 4; ++i) epi(NP + 16 * F.wave + 4 * kg + i, 16 * strip + r, acc[i]);
    }
}

struct Args { const float* in[22]; float* out; unsigned char* ws; int ph_lo, ph_hi; };
constexpr int NPHASE = 14;
__global__ void __launch_bounds__(NTHR, 2) mk_fwd(Args args) {
    extern __shared__ __attribute__((aligned(16))) unsigned char lds[];
    Frame F;
    F.lds = (LAS unsigned char*)lds; F.MISC = (volatile LAS unsigned*)(F.lds + MISC_OFF);
    F.tid = threadIdx.x; F.lane = F.tid & 63; F.wave = __builtin_amdgcn_readfirstlane(F.tid >> 6); F.G = gridDim.x;
    F.ws = args.ws; F.out = args.out; F.ctl = (gu32*)(args.ws + WS_CTL); F.tp = 0ull;
    for (int u = F.tid; u < (LDS_BYTES - MISC_OFF) / 4; u += NTHR) ((LAS unsigned*)(F.lds + MISC_OFF))[u] = 0u;
    __syncthreads();
    if (F.tid < 22) ((LAS unsigned long long*)(F.lds + PTR_OFF))[F.tid] = (unsigned long long)args.in[F.tid];
    __syncthreads();
    const int lo = args.ph_lo, hi = args.ph_hi;
    const bool multi = (hi - lo) > 1;
    XcdBarrier bar; bar.bar = (unsigned*)(F.ctl + CW_BAR); bar.x = 0; bar.st = nullptr;
    if (multi) bar = xcd_barrier_post((unsigned*)(F.ctl + CW_BAR), F.MISC + 8);
#ifdef ONLY_PHASE
#define IN(k) ((k) == ONLY_PHASE && lo <= (k) && (k) < hi)
#else
#define IN(k) (lo <= (k) && (k) < hi)
#endif
#ifdef PROBE_PHASE
    unsigned long long t_prev = __builtin_amdgcn_s_memrealtime(), t_probe = 0ull;
#define STAMP(k) do { const unsigned long long _t = __builtin_amdgcn_s_memrealtime(); if ((k) == PROBE_PHASE && blockIdx.x == 0) t_probe = _t - t_prev; t_prev = _t; } while (0)
#else
#define STAMP(k) do { } while (0)
#endif
#define SEAM(k) do { if (IN(k) && IN((k) + 1)) xcd_barrier(bar); STAMP(k); } while (0)
    if (IN(0)) { p0_prologue(F); }
    if (IN(0) && IN(1)) { cooperative_groups::this_grid().sync(); } STAMP(0);
    if (IN(1)) {
        if ((int)blockIdx.x >= F.G - NCOPYWG) kvshift_loop<true>(F);
        else {
        pg8::Gemm g{WSP(bf16, WS_XB), WSP(bf16, WS_WIN), MPAD, NPROJ, 1024, MPAD / 256 - 1}; pg8::StaticOrder S; S.init(MPAD, NPROJ, F.G - NCOPYWG, (int)blockIdx.x);
        pg8::EpiProj E{WSP(bf16, WS_QA), WSP(bf16, WS_KA), WSP(bf16, WS_VA), WSP(bf16, WS_QB), WSP(bf16, WS_KB), WSP(bf16, WS_VB), WSP(bf16, WS_RB), WSP(bf16, WS_GA), WSP(bf16, WS_GB)};
        pg8::gemm_phase<pg8::EpiProj, pg8::StaticOrder, true, true>(F.lds, g, S, E);
        if (F.tid == 0) __hip_atomic_fetch_add(F.ctl + CW_GDONE, 1u, RLX_AGENT);
        }
    } SEAM(1);
    if (IN(2)) { p2_prep(F); } SEAM(2);
    if (IN(3)) { p2_mixers(F); } SEAM(3);
    if (IN(4)) { p3_merge(F); } SEAM(4);
    if (IN(5)) {
        bf16* T1 = WSP(bf16, WS_T1); bf16* MIXp = WSP(bf16, WS_MIX); const bf16* GAp = WSP(bf16, WS_GA); const bf16* GBp = WSP(bf16, WS_GB);
        { pg8::Gemm g{WSP(bf16, WS_OAM), WSP(bf16, WS_WA), NP, 1024, 512, -1}; pg8::StaticOrder S; S.init(NP, 1024, F.G, (int)blockIdx.x, false);
          pg8::EpiGate<false> E{WSP(bf16, WS_GA), nullptr, WSP(bf16, WS_T1)};
          pg8::gemm_phase<pg8::EpiGate<false>, pg8::StaticOrder, true, true>(F.lds, g, S, E); }
        skinny_sample_gemm(F, WSP(bf16, WS_OAM), WSP(bf16, WS_WA), 512, [=](int row, int col, float v) { const size_t o = (size_t)row * 1024 + col; T1[o] = f2bf(pg8::sigmoidf_(bf2f(GAp[o])) * v); });
        VM_WAIT(); __syncthreads();
        { pg8::Gemm g{WSP(bf16, WS_OBN), WSP(bf16, WS_WB), NP, 1024, 1024, -1}; pg8::StaticOrder S; S.init(NP, 1024, F.G, (int)blockIdx.x, false);
          pg8::EpiGate<true> E{WSP(bf16, WS_GB), WSP(bf16, WS_T1), WSP(bf16, WS_MIX)};
          pg8::gemm_phase<pg8::EpiGate<true>, pg8::StaticOrder, true, true>(F.lds, g, S, E); }
        skinny_sample_gemm(F, WSP(bf16, WS_OBN), WSP(bf16, WS_WB), 1024, [=](int row, int col, float v) { const size_t o = (size_t)row * 1024 + col; MIXp[o] = f2bf(bf2f(T1[o]) + pg8::sigmoidf_(bf2f(GBp[o])) * v); });
    } SEAM(5);
    if (IN(6)) {
        pg8::Gemm g{WSP(bf16, WS_MIX), WSP(bf16, WS_WO), NP, 1024, 1024, -1}; pg8::StaticOrder S; S.init(NP, 1024, F.G, (int)blockIdx.x, false);
        pg8::EpiOut E{inptr(F, I_XP), inptr(F, I_XS), WSP(float, WS_H), NP, NTOK, ALPHA};
        pg8::gemm_phase<pg8::EpiOut, pg8::StaticOrder, true, true>(F.lds, g, S, E);
        const float* xsp = inptr(F, I_XS); float* Hp = WSP(float, WS_H);
        skinny_sample_gemm(F, WSP(bf16, WS_MIX), WSP(bf16, WS_WO), 1024, [=](int row, int col, float v) { Hp[(size_t)row * 1024 + col] = ALPHA * xsp[(size_t)(row - NP) * 1024 + col] + v; });
    } SEAM(6);
    if (IN(7)) { p6_ln1(F); } SEAM(7);
    if (IN(8)) {
        pg8::Gemm g{WSP(bf16, WS_X1B), WSP(bf16, WS_WQ), MPAD, 2048, 1024, MPAD / 256 - 1}; pg8::StaticOrder S; S.init(MPAD, 2048, F.G, (int)blockIdx.x);
        pg8::EpiHeadNorm E{WSP(bf16, WS_QN), 2048, F.lds + STATS_OFF, LN_EPS};
        pg8::gemm_phase<pg8::EpiHeadNorm, pg8::StaticOrder, true, true>(F.lds, g, S, E);
    } SEAM(8);
    if (IN(9)) {
        const int gw = blockIdx.x * NWAVES + F.wave, NGW = F.G * NWAVES;
        for (int it = gw; it < (NP / 32) * 8; it += NGW) p8_topk_item(F, it);
        for (int e = gw; e < 64 * (NS / 32) * 8; e += NGW) if ((e & 63) == 0) p8_topk_item(F, (NP / 32) * 8 + (e >> 6));
    } SEAM(9);
#if defined(PROBE_PHASE) && PROBE_PHASE >= 300 && PROBE_PHASE < 310
    if (IN(10)) { const unsigned long long td0 = __builtin_amdgcn_s_memrealtime();
        if (PROBE_PHASE == 300) peer_u_phase_t<2047u>(F); else if (PROBE_PHASE == 301) peer_u_phase_t<8191u>(F); else peer_u_phase_t<0xffffffffu>(F);
        xcd_barrier(bar); if (blockIdx.x == 0) F.tp = __builtin_amdgcn_s_memrealtime() - td0; }
#endif
    if (IN(10)) { peer_u_phase(F); } SEAM(10);
    if (IN(11)) { peer_coef_phase(F); } SEAM(11);
    if (IN(12)) { peer_v_phase(F); } SEAM(12);
    if (IN(13)) { peer_ln2_phase(F); }
#ifdef PROBE_PHASE
    if (PROBE_PHASE == 13) { xcd_barrier(bar); STAMP(13); }
    if (PROBE_PHASE == 200 || PROBE_PHASE == 201) {
        unsigned* xm = (unsigned*)(F.ws + WS_END);
        if (F.tid == 0) __hip_atomic_store(xm + blockIdx.x, xb_xcc_id() + 1u, RLX_AGENT);
        xcd_barrier(bar);
        if (blockIdx.x == 0 && F.tid == 0) { bool ok = true;
            for (int b = 0; b < (int)gridDim.x; ++b) { const unsigned a = __hip_atomic_load(xm + b, RLX_AGENT), r = __hip_atomic_load(xm + (PROBE_PHASE == 200 ? (b & 7) : (b & ~31)), RLX_AGENT); if (a != r) ok = false; }
            t_probe = ok ? 50000ull : 0ull; }
    }
    if ((PROBE_PHASE >= 100 && PROBE_PHASE < 200) || PROBE_PHASE >= 300) t_probe = F.tp;
    if (F.tid == 0 && t_probe != 0ull) { const unsigned long long t0 = __builtin_amdgcn_s_memrealtime(); while (__builtin_amdgcn_s_memrealtime() - t0 < PROBE_GAIN * t_probe) __builtin_amdgcn_s_sleep(8); }
#endif
#undef IN
#undef SEAM
}

extern "C" void kernel_launch(void* const* d_in, const int* in_sizes, int n_in, void* d_out, int out_size, void* d_ws, size_t ws_size, hipStream_t stream) {
    static int grid = 0;
    if (grid == 0) {
        if (n_in != 22 || (size_t)out_size != OUT_TOTAL || ws_size < WS_END) { fprintf(stderr, "kernel_launch: unexpected shapes: n_in %d out %d ws %zu (need >= %zu)\n", n_in, out_size, ws_size, (size_t)WS_END); grid = -1; return; }
        int dev = 0, cus = 0, per_cu = 0;
        if (hipGetDevice(&dev) != hipSuccess || hipDeviceGetAttribute(&cus, hipDeviceAttributeMultiprocessorCount, dev) != hipSuccess) { grid = -1; return; }
        if (hipFuncSetAttribute((const void*)mk_fwd, hipFuncAttributeMaxDynamicSharedMemorySize, LDS_BYTES) != hipSuccess) { fprintf(stderr, "kernel_launch: hipFuncSetAttribute failed\n"); grid = -1; return; }
        if (hipOccupancyMaxActiveBlocksPerMultiprocessor(&per_cu, (const void*)mk_fwd, NTHR, LDS_BYTES) != hipSuccess || per_cu < 1) fprintf(stderr, "kernel_launch: occupancy query reports %d blocks per CU\n", per_cu);
        (void)hipGetLastError();
        grid = cus;
    }
    if (grid < 0) return;
    (void)hipMemsetAsync((char*)d_ws + WS_CTL, 0, CTL_ZERO_BYTES, stream);
    Args a{};
    for (int i = 0; i < 22; ++i) a.in[i] = (const float*)d_in[i];
    a.out = (float*)d_out; a.ws = (unsigned char*)d_ws;
#if MK_SINGLE
    a.ph_lo = 0; a.ph_hi = NPHASE;
    void* kargs[] = {&a};
    hipError_t e = hipLaunchCooperativeKernel((const void*)mk_fwd, dim3(grid), dim3(NTHR), kargs, LDS_BYTES, stream);
    if (e != hipSuccess) fprintf(stderr, "kernel_launch: cooperative launch failed: %s\n", hipGetErrorString(e));
#else
    for (int p = 0; p < NPHASE; ++p) { a.ph_lo = p; a.ph_hi = p + 1; hipLaunchKernelGGL(mk_fwd, dim3(grid), dim3(NTHR), LDS_BYTES, stream, a); }
#endif
}
```

```cpp
#include <hip/hip_runtime.h>
#include <hip/hip_cooperative_groups.h>
#include <cstdio>
#include <cstdint>
#ifndef MK_SINGLE
#define MK_SINGLE 1
#endif
namespace pg8 {
#define PG8_LAS __attribute__((address_space(3)))
typedef unsigned short bf16_t;
typedef short bf16x8 __attribute__((ext_vector_type(8)));
typedef float f32x4 __attribute__((ext_vector_type(4)));
typedef unsigned u32x4 __attribute__((ext_vector_type(4)));
constexpr int BM = 256, BK = 64, HALF = 128, HTB = HALF * BK * 2  , STAGE_BYTES = 8 * HTB, NXCD = 8, WGM = 8;

__host__ __device__ __forceinline__ int lds_byte(int r, int c) { const int st = (r >> 4) * 2 + (c >> 5), rr = r & 15, cc = c & 31, ob = rr * 64 + cc * 2; return st * 1024 + (ob ^ (((ob >> 9) & 1) << 5)); }
__host__ __device__ __forceinline__ void stage_rc(int b, int& R, int& C) { const int st = b / 1024, sb = b % 1024, swz = sb ^ (((sb >> 9) & 1) << 5); R = (st >> 1) * 16 + swz / 64; C = (st & 1) * 32 + (swz % 64) / 2; }
__host__ __device__ __forceinline__ int perm32(int rho) { const int n = rho >> 4, i = rho & 15; return 8 * (i >> 2) + 4 * n + (i & 3); }

struct Unit { int pm, pn; };
struct Gemm { const bf16_t* A; const bf16_t* Bt; int M, N, K; int half_pm = -1; };

struct StaticOrder {
    int nM, nN, nwg, G, c, nfull;
    __host__ __device__ void init(int M, int N, int G_, int c_, bool half = true) { nM = half ? M / BM - 1 : M / BM; nN = N / BM; nfull = nM * nN; nwg = half ? nfull + nN : nfull; G = G_; c = c_; }
    __host__ __device__ bool next(int i, Unit& u) const {
        const long L = (long)i * G + c; if (L >= nwg) return false;
        if (L >= nfull) { u.pm = nM; u.pn = (int)(L - nfull); return true; }
        int wgid = (int)L; { const int q = nfull / NXCD, r = nfull % NXCD, xcd = wgid % NXCD, off = wgid / NXCD; wgid = (xcd < r ? xcd * (q + 1) : r * (q + 1) + (xcd - r) * q) + off; }
        const int nig = WGM * nN, gid = wgid / nig, fm = gid * WGM, gsz = (nM - fm) < WGM ? (nM - fm) : WGM;
        u.pm = fm + ((wgid % nig) % gsz); u.pn = (wgid % nig) / gsz; return true;
    }
    __device__ __forceinline__ void a_ready(const Unit&) const {}
    __device__ __forceinline__ void done(const Unit&) const {}
};


typedef float f32x2 __attribute__((ext_vector_type(2)));
typedef __bf16 bf16x2_t __attribute__((ext_vector_type(2)));
__device__ __forceinline__ unsigned cvt_pk_bf16(float lo, float hi) { f32x2 v = {lo, hi}; bf16x2_t b = __builtin_convertvector(v, bf16x2_t); return __builtin_bit_cast(unsigned, b); }
__device__ __forceinline__ float bf_lo(unsigned w) { return __uint_as_float(w << 16); }
__device__ __forceinline__ float bf_hi(unsigned w) { return __uint_as_float(w & 0xffff0000u); }
__device__ __forceinline__ float sigmoidf_(float x) { return __builtin_amdgcn_rcpf(1.0f + __expf(-x)); }

struct EpiProj {
    static constexpr bool PERM = true, AFTER_DRAIN = false;
    bf16_t *qa, *ka, *va, *qb, *kb, *vb, *rb, *ga, *gb;
    __device__ __forceinline__ void operator()(const f32x4 (&acc)[2][2][4][2], const Unit& u, int wr, int wc, int fr, int fq) const {
        const int pn = u.pn; bf16_t* base; int ldc, ct; float sc = 1.f;
        if (pn < 6) { base = qa; ldc = 1536; ct = pn; sc = 0.125f; }
        else if (pn < 12) { base = ka; ldc = 1536; ct = pn - 6; }
        else if (pn < 18) { base = va; ldc = 1536; ct = pn - 12; }
        else if (pn < 20) { base = qb; ldc = 512; ct = pn - 18; }
        else if (pn < 22) { base = kb; ldc = 512; ct = pn - 20; }
        else if (pn < 26) { base = vb; ldc = 1024; ct = pn - 22; }
        else if (pn < 30) { base = rb; ldc = 1024; ct = pn - 26; }
        else if (pn < 34) { base = ga; ldc = 1024; ct = pn - 30; }
        else { base = gb; ldc = 1024; ct = pn - 34; }
        const int row0 = u.pm * BM + wr * 64 + fr, col0 = ct * BM + wc * 32 + 8 * fq;
#pragma unroll
        for (int ai = 0; ai < 2; ++ai)
#pragma unroll
            for (int m = 0; m < 4; ++m) { bf16_t* rowp = base + (size_t)(row0 + ai * HALF + m * 16) * ldc + col0;
#pragma unroll
                for (int bj = 0; bj < 2; ++bj) { const f32x4 v0 = acc[ai][bj][m][0] * sc, v1 = acc[ai][bj][m][1] * sc;
                    u32x4 w; w.x = cvt_pk_bf16(v0[0], v0[1]); w.y = cvt_pk_bf16(v0[2], v0[3]); w.z = cvt_pk_bf16(v1[0], v1[1]); w.w = cvt_pk_bf16(v1[2], v1[3]);
                    *(u32x4*)(rowp + bj * HALF) = w; } }
    }
};
template <bool ADD> struct EpiGate {
    static constexpr bool PERM = true, AFTER_DRAIN = false;
    const bf16_t* G; const bf16_t* T1; bf16_t* O;
    __device__ __forceinline__ void operator()(const f32x4 (&acc)[2][2][4][2], const Unit& u, int wr, int wc, int fr, int fq) const {
        const int row0 = u.pm * BM + wr * 64 + fr, col0 = u.pn * BM + wc * 32 + 8 * fq;
#pragma unroll
        for (int ai = 0; ai < 2; ++ai)
#pragma unroll
            for (int m = 0; m < 4; ++m) { const size_t off = (size_t)(row0 + ai * HALF + m * 16) * 1024 + col0;
#pragma unroll
                for (int bj = 0; bj < 2; ++bj) {
                    const u32x4 g = *(const u32x4*)(G + off + bj * HALF);
                    f32x4 v0 = acc[ai][bj][m][0], v1 = acc[ai][bj][m][1];
                    v0[0] *= sigmoidf_(bf_lo(g.x)); v0[1] *= sigmoidf_(bf_hi(g.x)); v0[2] *= sigmoidf_(bf_lo(g.y)); v0[3] *= sigmoidf_(bf_hi(g.y));
                    v1[0] *= sigmoidf_(bf_lo(g.z)); v1[1] *= sigmoidf_(bf_hi(g.z)); v1[2] *= sigmoidf_(bf_lo(g.w)); v1[3] *= sigmoidf_(bf_hi(g.w));
                    if (ADD) { const u32x4 t = *(const u32x4*)(T1 + off + bj * HALF);
                        v0[0] += bf_lo(t.x); v0[1] += bf_hi(t.x); v0[2] += bf_lo(t.y); v0[3] += bf_hi(t.y);
                        v1[0] += bf_lo(t.z); v1[1] += bf_hi(t.z); v1[2] += bf_lo(t.w); v1[3] += bf_hi(t.w); }
                    u32x4 w; w.x = cvt_pk_bf16(v0[0], v0[1]); w.y = cvt_pk_bf16(v0[2], v0[3]); w.z = cvt_pk_bf16(v1[0], v1[1]); w.w = cvt_pk_bf16(v1[2], v1[3]);
                    *(u32x4*)(O + off + bj * HALF) = w; } }
    }
};
struct EpiOut {
    static constexpr bool PERM = false, AFTER_DRAIN = false;
    const float* xp; const float* xs; float* H; int np, ntok; float alpha;
    __device__ __forceinline__ void operator()(const f32x4 (&acc)[2][2][4][2], const Unit& u, int wr, int wc, int fr, int fq) const {
        const int row0 = u.pm * BM + wr * 64 + fr, col0 = u.pn * BM + wc * 32 + 4 * fq;
#pragma unroll
        for (int ai = 0; ai < 2; ++ai)
#pragma unroll
            for (int m = 0; m < 4; ++m) { const int r = row0 + ai * HALF + m * 16;
                const float* xr = r < np ? xp + (size_t)r * 1024 : xs + (size_t)(r < ntok ? r - np : 0) * 1024; const bool real = r < ntok;
#pragma unroll
                for (int bj = 0; bj < 2; ++bj)
#pragma unroll
                    for (int n = 0; n < 2; ++n) { const int c = col0 + bj * HALF + n * 16;
                        f32x4 xv = *(const f32x4*)(xr + c); if (!real) xv = (f32x4){0.f, 0.f, 0.f, 0.f};
                        *(f32x4*)(H + (size_t)r * 1024 + c) = xv * alpha + acc[ai][bj][m][n]; } }
    }
};
struct EpiHeadNorm {
    static constexpr bool PERM = true, AFTER_DRAIN = false;
    bf16_t* O; int ldc; PG8_LAS unsigned char* st; float eps;
    __device__ __forceinline__ void operator()(const f32x4 (&acc)[2][2][4][2], const Unit& u, int wr, int wc, int fr, int fq) const {
        PG8_LAS f32x2* P = (PG8_LAS f32x2*)st; PG8_LAS f32x2* S = (PG8_LAS f32x2*)(st + 8192);
        const int lane = fq * 16 + fr, wid = wr * 4 + wc;
#pragma unroll
        for (int ai = 0; ai < 2; ++ai)
#pragma unroll
            for (int m = 0; m < 4; ++m) {
                float s = 0.f;
#pragma unroll
                for (int bj = 0; bj < 2; ++bj)
#pragma unroll
                    for (int n = 0; n < 2; ++n) { const f32x4 x = acc[ai][bj][m][n]; s += (x[0] + x[1]) + (x[2] + x[3]); }
                s += __shfl_xor(s, 16); s += __shfl_xor(s, 32);
                const float mw = s * (1.0f / 64.0f); float q = 0.f;
#pragma unroll
                for (int bj = 0; bj < 2; ++bj)
#pragma unroll
                    for (int n = 0; n < 2; ++n) { const f32x4 d = acc[ai][bj][m][n] - mw; q += (d[0] * d[0] + d[1] * d[1]) + (d[2] * d[2] + d[3] * d[3]); }
                q += __shfl_xor(q, 16); q += __shfl_xor(q, 32);
                if (fq == 0) P[(ai * HALF + wr * 64 + m * 16 + fr) * 4 + wc] = (f32x2){mw, q};
            }
        asm volatile("s_waitcnt lgkmcnt(0)" ::: "memory"); __builtin_amdgcn_s_barrier(); asm volatile("" ::: "memory");
        const int row = wid * 32 + (lane & 31);
        if (lane < 32) {
            const f32x2 a = P[row * 4 + 0], b = P[row * 4 + 1], c = P[row * 4 + 2], d = P[row * 4 + 3];
            const float mt = (a.x + b.x + c.x + d.x) * 0.25f;
            const float da = a.x - mt, db = b.x - mt, dc = c.x - mt, dd = d.x - mt;
            const float m2 = (a.y + b.y) + (c.y + d.y) + 64.0f * ((da * da + db * db) + (dc * dc + dd * dd));
            S[row] = (f32x2){mt, 1.0f / sqrtf(m2 * (1.0f / 256.0f) + eps)};
        }
        asm volatile("s_waitcnt lgkmcnt(0)" ::: "memory"); __builtin_amdgcn_s_barrier(); asm volatile("" ::: "memory");
        const int row0 = u.pm * BM + wr * 64 + fr, col0 = u.pn * BM + wc * 32 + 8 * fq;
#pragma unroll
        for (int ai = 0; ai < 2; ++ai)
#pragma unroll
            for (int m = 0; m < 4; ++m) { const f32x2 sr = S[ai * HALF + wr * 64 + m * 16 + fr]; bf16_t* rowp = O + (size_t)(row0 + ai * HALF + m * 16) * ldc + col0;
#pragma unroll
                for (int bj = 0; bj < 2; ++bj) { const f32x4 v0 = (acc[ai][bj][m][0] - sr.x) * sr.y, v1 = (acc[ai][bj][m][1] - sr.x) * sr.y;
                    u32x4 w; w.x = cvt_pk_bf16(v0[0], v0[1]); w.y = cvt_pk_bf16(v0[2], v0[3]); w.z = cvt_pk_bf16(v1[0], v1[1]); w.w = cvt_pk_bf16(v1[2], v1[3]);
                    *(u32x4*)(rowp + bj * HALF) = w; } }
    }
};

template <class Epi, class Sched, bool ALIGN_EPI = false, bool SP2 = false>
__device__ __forceinline__ void gemm_phase(PG8_LAS unsigned char* lds, const Gemm g, const Sched& S, const Epi& E) {
    const int tid = threadIdx.x, wid = __builtin_amdgcn_readfirstlane(tid >> 6), lane = tid & 63, wr = wid >> 2, wc = wid & 3, fr = lane & 15, fq = lane >> 4;
    const int K = g.K, nt = K / BK;
    unsigned voffA[2], voffB[2];
#pragma unroll
    for (int i = 0; i < 2; ++i) { int R, C; stage_rc(tid * 16 + i * 8192, R, C); const int Rb = Epi::PERM ? ((R & ~31) + perm32(R & 31)) : R;
        voffA[i] = (unsigned)(R * K + C) * 2u; voffB[i] = (unsigned)(Rb * K + C) * 2u; }
    const size_t kstep = (size_t)(BK * 2);
    const size_t hstep = (size_t)HALF * K * 2;
    const size_t tstep = 2 * hstep;
    const unsigned ldsw = (unsigned)wid * 1024u;
    const int aoff = lds_byte(wr * 64 + fr, fq * 8), boff = lds_byte(wc * 32 + fr, fq * 8);
#define PG8_SA(b, h) (((b) * 2 + (h)) * HTB)
#define PG8_SB(b, h) ((4 + (b) * 2 + (h)) * HTB)
#define PG8_STAGE(bufoff, gbase, voff) do { _Pragma("unroll") for (int _i = 0; _i < 2; ++_i) \
        __builtin_amdgcn_global_load_lds((const unsigned*)((const char*)(gbase) + (voff)[_i]), (PG8_LAS unsigned*)(lds + (bufoff) + ldsw + _i * 8192), 16, 0, 0); } while (0)
#define PG8_LDA(dst, b, h) do { _Pragma("unroll") for (int m = 0; m < 4; ++m) _Pragma("unroll") for (int k = 0; k < 2; ++k) dst[m][k] = *(const PG8_LAS bf16x8*)(lds + PG8_SA(b, h) + aoff + m * 2048 + k * 1024); } while (0)
#define PG8_LDB(dst, b, h) do { _Pragma("unroll") for (int n = 0; n < 2; ++n) _Pragma("unroll") for (int k = 0; k < 2; ++k) dst[n][k] = *(const PG8_LAS bf16x8*)(lds + PG8_SB(b, h) + boff + n * 2048 + k * 1024); } while (0)
#define PG8_MMA(ai, bj, At, Bt) do { __builtin_amdgcn_s_setprio(1); _Pragma("unroll") for (int m = 0; m < 4; ++m) _Pragma("unroll") for (int n = 0; n < 2; ++n) _Pragma("unroll") for (int k = 0; k < 2; ++k) \
        acc[ai][bj][m][n] = __builtin_amdgcn_mfma_f32_16x16x32_bf16(Bt[n][k], At[m][k], acc[ai][bj][m][n], 0, 0, 0); __builtin_amdgcn_s_setprio(0); } while (0)
#define PG8_WAIT_V(n) asm volatile("s_waitcnt vmcnt(" #n ")" ::: "memory")
#define PG8_WAIT_L(n) asm volatile("s_waitcnt lgkmcnt(" #n ")" ::: "memory")
#define PG8_BAR __builtin_amdgcn_s_barrier()
#define PG8_SCHED __builtin_amdgcn_sched_barrier(0)
    Unit cur, nxt; int ui = 0;
    if (!S.next(0, cur)) return;
    f32x4 acc[2][2][4][2];
#pragma unroll
    for (int a = 0; a < 2; ++a)
#pragma unroll
        for (int b = 0; b < 2; ++b)
#pragma unroll
            for (int m = 0; m < 4; ++m)
#pragma unroll
                for (int n = 0; n < 2; ++n) acc[a][b][m][n] = (f32x4){0.f, 0.f, 0.f, 0.f};
    bf16x8 At[4][2], B0[2][2], B1[2][2];
    const char* cA = (const char*)g.A + (size_t)cur.pm * tstep; const char* cB = (const char*)g.Bt + (size_t)cur.pn * tstep;
    S.a_ready(cur);
    if constexpr (SP2) {
        PG8_STAGE(PG8_SB(0, 0), cB, voffB); PG8_STAGE(PG8_SB(0, 1), cB + hstep, voffB); PG8_STAGE(PG8_SA(0, 0), cA, voffA); PG8_STAGE(PG8_SA(0, 1), cA + hstep, voffA);
        if (wr == 1) PG8_BAR;
        PG8_WAIT_V(2); PG8_BAR;
        PG8_STAGE(PG8_SB(1, 0), cB + kstep, voffB); PG8_STAGE(PG8_SA(1, 0), cA + kstep, voffA); PG8_STAGE(PG8_SB(1, 1), cB + hstep + kstep, voffB);
        PG8_WAIT_V(6); PG8_BAR;
    } else {
        PG8_STAGE(PG8_SB(0, 0), cB, voffB); PG8_STAGE(PG8_SA(0, 0), cA, voffA); PG8_STAGE(PG8_SB(0, 1), cB + hstep, voffB); PG8_STAGE(PG8_SA(0, 1), cA + hstep, voffA);
        if (wr == 1) PG8_BAR;
        PG8_WAIT_V(4); PG8_BAR;
        PG8_STAGE(PG8_SB(1, 0), cB + kstep, voffB); PG8_STAGE(PG8_SA(1, 0), cA + kstep, voffA); PG8_STAGE(PG8_SB(1, 1), cB + hstep + kstep, voffB);
        PG8_WAIT_V(6); PG8_BAR;
    }
    for (;;) {
        const bool has_next = S.next(ui + 1, nxt);
        const bool skip1 = __builtin_amdgcn_readfirstlane((int)(cur.pm == g.half_pm)) != 0;
        const char* nA = has_next ? (const char*)g.A + (size_t)nxt.pm * tstep : cA; const char* nB = has_next ? (const char*)g.Bt + (size_t)nxt.pn * tstep : cB;
        for (int t = 0; t < nt; t += 2) {
            const bool last = (t == nt - 2);
            const char* a1 = cA + (size_t)(t + 1) * kstep;
            const char* a2 = last ? nA : cA + (size_t)(t + 2) * kstep; const char* b2 = last ? nB : cB + (size_t)(t + 2) * kstep;
            const char* a3 = a2 + kstep; const char* b3 = b2 + kstep;
            if (last && has_next) S.a_ready(nxt);
            if constexpr (SP2) {
            PG8_LDB(B0, 0, 0); PG8_LDB(B1, 0, 1); PG8_SCHED; PG8_LDA(At, 0, 0); PG8_STAGE(PG8_SA(1, 1), a1 + hstep, voffA);
            PG8_WAIT_V(8); PG8_WAIT_L(0); PG8_BAR; PG8_MMA(0, 0, At, B0); PG8_MMA(0, 1, At, B1); PG8_BAR; PG8_SCHED;
            PG8_LDA(At, 0, 1); PG8_STAGE(PG8_SB(0, 0), b2, voffB); PG8_STAGE(PG8_SB(0, 1), b2 + hstep, voffB); PG8_STAGE(PG8_SA(0, 0), a2, voffA);
            PG8_WAIT_V(8); PG8_WAIT_L(0); PG8_BAR; if (!skip1) { PG8_MMA(1, 0, At, B0); PG8_MMA(1, 1, At, B1); } PG8_BAR; PG8_SCHED;
            PG8_LDB(B0, 1, 0); PG8_LDB(B1, 1, 1); PG8_SCHED; PG8_LDA(At, 1, 0); PG8_STAGE(PG8_SA(0, 1), a2 + hstep, voffA);
            PG8_WAIT_V(8); PG8_WAIT_L(0); PG8_BAR; PG8_MMA(0, 0, At, B0); PG8_MMA(0, 1, At, B1); PG8_BAR; PG8_SCHED;
            PG8_LDA(At, 1, 1); PG8_STAGE(PG8_SB(1, 0), b3, voffB); PG8_STAGE(PG8_SB(1, 1), b3 + hstep, voffB); PG8_STAGE(PG8_SA(1, 0), a3, voffA);
            PG8_WAIT_V(8); PG8_WAIT_L(0); PG8_BAR; if (!skip1) { PG8_MMA(1, 0, At, B0); PG8_MMA(1, 1, At, B1); } PG8_BAR; PG8_SCHED;
            } else {
            PG8_LDB(B0, 0, 0); PG8_SCHED; PG8_LDA(At, 0, 0); PG8_STAGE(PG8_SA(1, 1), a1 + hstep, voffA);
            PG8_WAIT_L(8); PG8_BAR; PG8_WAIT_L(0); PG8_MMA(0, 0, At, B0); PG8_BAR; PG8_SCHED;
            PG8_LDB(B1, 0, 1); PG8_STAGE(PG8_SB(0, 0), b2, voffB);
            PG8_BAR; PG8_WAIT_L(0); PG8_MMA(0, 1, At, B1); PG8_BAR;
            PG8_LDA(At, 0, 1); PG8_STAGE(PG8_SA(0, 0), a2, voffA);
            PG8_BAR; PG8_WAIT_L(0); PG8_MMA(1, 0, At, B0); PG8_BAR; PG8_SCHED;
            PG8_STAGE(PG8_SB(0, 1), b2 + hstep, voffB);
            PG8_WAIT_V(6); PG8_BAR; PG8_MMA(1, 1, At, B1); PG8_BAR;
            PG8_LDB(B0, 1, 0); PG8_SCHED; PG8_LDA(At, 1, 0); PG8_STAGE(PG8_SA(0, 1), a2 + hstep, voffA);
            PG8_WAIT_L(8); PG8_BAR; PG8_WAIT_L(0); PG8_MMA(0, 0, At, B0); PG8_BAR; PG8_SCHED;
            PG8_LDB(B1, 1, 1); PG8_STAGE(PG8_SB(1, 0), b3, voffB);
            PG8_BAR; PG8_WAIT_L(0); PG8_MMA(0, 1, At, B1); PG8_BAR;
            PG8_LDA(At, 1, 1); PG8_STAGE(PG8_SA(1, 0), a3, voffA);
            PG8_BAR; PG8_WAIT_L(0); PG8_MMA(1, 0, At, B0); PG8_BAR; PG8_SCHED;
            PG8_STAGE(PG8_SB(1, 1), b3 + hstep, voffB);
            PG8_WAIT_V(6); PG8_BAR; PG8_MMA(1, 1, At, B1); PG8_BAR;
            }
        }
        if constexpr (ALIGN_EPI) { if (wr == 0) PG8_BAR; }
        if constexpr (!Epi::AFTER_DRAIN) { E(acc, cur, wr, wc, fr, fq); S.done(cur); }
        if (!has_next) break;
#pragma unroll
        for (int a = 0; a < 2; ++a)
#pragma unroll
            for (int b = 0; b < 2; ++b)
#pragma unroll
                for (int m = 0; m < 4; ++m)
#pragma unroll
                    for (int n = 0; n < 2; ++n) acc[a][b][m][n] = (f32x4){0.f, 0.f, 0.f, 0.f};
        cur = nxt; cA = nA; cB = nB; ++ui;
        if constexpr (ALIGN_EPI) { if (wr == 1) PG8_BAR; }
    }
    PG8_WAIT_V(0);
    if constexpr (!ALIGN_EPI) { if (wr == 0) PG8_BAR; }
    PG8_BAR;
    if constexpr (Epi::AFTER_DRAIN) { E.fused(acc, cur, wr, wc, fr, fq, lds, wid, lane); S.done(cur); }
#undef PG8_SA
#undef PG8_SB
#undef PG8_STAGE
#undef PG8_LDA
#undef PG8_LDB
#undef PG8_MMA
#undef PG8_WAIT_V
#undef PG8_WAIT_L
#undef PG8_BAR
#undef PG8_SCHED
}
}

constexpr int NWAVES = 8, NTHR = 512;
constexpr int DM = 1024, TSEQ = 4096, NP = 32768, NS = 128, NTOK = NP + NS, MPAD = 33024;
constexpr int INW = 9744, NPROJ = 9728, ABCOL = 6656;
constexpr float LN_EPS = 1e-5f, ALPHA = 1.189207115002721f, GLA_QSCALE = 0.08838834764831845f, NEG_BIG = -1e30f;
constexpr size_t OUT_YP = 0, OUT_YS = 33554432, OUT_KVP1 = 33685504, OUT_KVP2 = 34734080, OUT_KVP3 = 38928384, OUT_STP = 55705600,
                 OUT_KVS1 = 56754176, OUT_KVS2 = 60948480, OUT_KVS3 = 77725696, OUT_STS = 144834560, OUT_TOTAL = 149028864;
constexpr size_t MiB = 1u << 20;
constexpr size_t WS_CTL = 0, CTL_ZERO_BYTES = 1 * MiB;
constexpr size_t WS_KEYS = 1 * MiB, WS_LUT = WS_KEYS + 512 * 1024;
constexpr size_t WS_WA = 2 * MiB, WS_WB = 3 * MiB, WS_WO = 5 * MiB, WS_WQ = 7 * MiB, WS_WIN = 11 * MiB;
constexpr size_t WS_AB = 31 * MiB, WS_UT = 34 * MiB, WS_VT = 66 * MiB, WS_XB = 98 * MiB;
constexpr size_t WS_QA = 163 * MiB, WS_KA = 260 * MiB, WS_VA = 357 * MiB, WS_QB = 454 * MiB, WS_KB = 487 * MiB, WS_VB = 520 * MiB;
constexpr size_t WS_RB = 585 * MiB, WS_GA = 650 * MiB, WS_GB = 715 * MiB, WS_LSE = 780 * MiB, WS_OAM = 784 * MiB, WS_OBN = 817 * MiB, WS_H = 882 * MiB, WS_END = 1011 * MiB;
constexpr size_t WS_T1 = WS_KA, WS_MIX = WS_VA, WS_X1B = WS_QA, WS_QN = WS_RB, WS_EIDX = WS_GB, WS_GATE = WS_GB + 17 * MiB;
static_assert(WS_WIN + (size_t)NPROJ * 1024 * 2 <= WS_AB && WS_AB + (size_t)MPAD * 16 * 4 <= WS_UT && WS_XB + (size_t)MPAD * 1024 * 2 <= WS_QA, "ws map 1");
static_assert(WS_QA + (size_t)MPAD * 1536 * 2 <= WS_KA && WS_QB + (size_t)MPAD * 512 * 2 <= WS_KB && WS_VB + (size_t)MPAD * 1024 * 2 <= WS_RB, "ws map 2");
static_assert(WS_LSE + (size_t)3 * MPAD * 8 * 4 <= WS_OAM && WS_OAM + (size_t)MPAD * 512 * 2 <= WS_OBN && WS_OBN + (size_t)MPAD * 1024 * 2 <= WS_H && WS_H + (size_t)MPAD * 1024 * 4 <= WS_END, "ws map 3");
static_assert(WS_QN + (size_t)MPAD * 2048 * 2 <= WS_GB && WS_EIDX + (size_t)MPAD * 128 * 4 <= WS_GATE && WS_GATE + (size_t)MPAD * 128 * 4 <= WS_LSE, "ws map 4");
constexpr int CW_QUEUE = 64;
constexpr int CW_CPYQ = 128;
constexpr int CW_GDONE = 192;
constexpr int NCOPYWG = 10;
constexpr int CW_BAR = 4096;
constexpr int RING_BYTES = 131072, STATS_OFF = RING_BYTES, MISC_OFF = STATS_OFF + 10240 + 320, LDS_BYTES = 147456;
static_assert(MISC_OFF + 128 + 22 * 8 <= LDS_BYTES, "LDS map");

#define GAS __attribute__((address_space(1)))
#define LAS __attribute__((address_space(3)))
typedef unsigned short bf16;
typedef unsigned v4u __attribute__((ext_vector_type(4)));
typedef unsigned v2u __attribute__((ext_vector_type(2)));
typedef float f32x4 __attribute__((ext_vector_type(4)));
typedef float f32x16 __attribute__((ext_vector_type(16)));
typedef short bf16x8 __attribute__((ext_vector_type(8)));
typedef short s16x4 __attribute__((ext_vector_type(4)));
typedef GAS unsigned gu32;
#define RLX_AGENT __ATOMIC_RELAXED, __HIP_MEMORY_SCOPE_AGENT
#define LDS_WAIT() asm volatile("s_waitcnt lgkmcnt(0)" ::: "memory")
#define VM_WAIT() asm volatile("s_waitcnt vmcnt(0)" ::: "memory")
#define MFMA32(a, b, c) __builtin_amdgcn_mfma_f32_32x32x16_bf16((a), (b), (c), 0, 0, 0)
using pg8::cvt_pk_bf16; using pg8::bf_lo; using pg8::bf_hi;
__device__ __forceinline__ unsigned short f2bf(float f) { return (unsigned short)(cvt_pk_bf16(f, 0.f) & 0xffffu); }
__device__ __forceinline__ float bf2f(unsigned short h) { return __uint_as_float((unsigned)h << 16); }
__device__ __forceinline__ int crow(int reg, int hh) { return (reg & 3) + 8 * (reg >> 2) + 4 * hh; }
__device__ __forceinline__ float wave_sum(float v) {
#pragma unroll
    for (int o = 1; o < 64; o <<= 1) v += __shfl_xor(v, o);
    return v;
}
__device__ __forceinline__ float wave_max(float v) {
#pragma unroll
    for (int o = 1; o < 64; o <<= 1) v = fmaxf(v, __shfl_xor(v, o));
    return v;
}
__device__ __forceinline__ bf16x8 frag_row(const LAS unsigned char* T, int stride, int r0, int k0, int lane) {
    return *(const LAS bf16x8*)(T + (r0 + (lane & 31)) * stride + (k0 + 8 * (lane >> 5)) * 2);
}
typedef short v4i16_t __attribute__((ext_vector_type(4)));
template <bool PERM> __device__ __forceinline__ bf16x8 frag_tr(const LAS unsigned char* X, int stride, int k0, int c0, int lane) {
    const int i = lane & 15, g = (lane >> 4) & 1, hh = lane >> 5, q = i >> 2, p = i & 3;
    const int rA = PERM ? (k0 + 4 * hh + q) : (k0 + 8 * hh + q), rB = PERM ? (k0 + 8 + 4 * hh + q) : (k0 + 8 * hh + 4 + q);
    const int cb = (c0 + 16 * g + 4 * p) * 2;
    const s16x4 lo = __builtin_bit_cast(s16x4, __builtin_amdgcn_ds_read_tr16_b64_v4i16((LAS v4i16_t*)(X + rA * stride + cb)));
    const s16x4 hi = __builtin_bit_cast(s16x4, __builtin_amdgcn_ds_read_tr16_b64_v4i16((LAS v4i16_t*)(X + rB * stride + cb)));
    return __builtin_shufflevector(lo, hi, 0, 1, 2, 3, 4, 5, 6, 7);
}
__device__ __forceinline__ bf16x8 pack_acc(const f32x16& x, int s) {
    v4u p; p.x = cvt_pk_bf16(x[8 * s], x[8 * s + 1]); p.y = cvt_pk_bf16(x[8 * s + 2], x[8 * s + 3]); p.z = cvt_pk_bf16(x[8 * s + 4], x[8 * s + 5]); p.w = cvt_pk_bf16(x[8 * s + 6], x[8 * s + 7]);
    return __builtin_bit_cast(bf16x8, p);
}

#define XB_TMO      128
#define XB_XCNT(j)  (256  + 64 * (j))
#define XB_XSUB(j)  (1280 + 64 * (j))
#define XB_XGEN(j)  (2304 + 64 * (j))
#define XB_TOP      3328
#define XB_TOPGEN   3392
#define XCD_BAR_WORDS 3456
#define XB_SPIN_CAP (1u << 22)
__device__ __forceinline__ unsigned xb_ld(unsigned* p)              { return __hip_atomic_load(p, __ATOMIC_RELAXED, __HIP_MEMORY_SCOPE_AGENT); }
__device__ __forceinline__ unsigned xb_add(unsigned* p, unsigned v) { return __hip_atomic_fetch_add(p, v, __ATOMIC_RELAXED, __HIP_MEMORY_SCOPE_AGENT); }
__device__ __forceinline__ unsigned xb_xcc_id() { return (unsigned)__builtin_amdgcn_s_getreg((3 << 11) | 20) & 0xFu; }
#define XB_SPIN(cond, bar) do { unsigned _sp = 0; while (cond) { __builtin_amdgcn_s_sleep(1); \
    if ((++_sp & 255u) == 0u) { if (xb_ld(&(bar)[XB_TMO])) break; if (_sp > XB_SPIN_CAP) { atomicAdd(&(bar)[XB_TMO], 1u); break; } } } } while (0)
struct XcdBarrier { unsigned* bar; unsigned x; volatile LAS unsigned* st; };
__device__ __forceinline__ XcdBarrier xcd_barrier_post(unsigned* bar, volatile LAS unsigned* st) {
    XcdBarrier b; b.bar = bar; b.x = xb_xcc_id(); b.st = st;
    if (threadIdx.x == 0) (void)xb_add(&bar[XB_XCNT(b.x)], 1u);
    return b;
}
__device__ __forceinline__ void xcd_barrier_complete(unsigned* bar, unsigned x, unsigned& nloc, unsigned& nx) {
    const unsigned G = gridDim.x * gridDim.y * gridDim.z;
    unsigned sum, cnt, mine, sp = 0u;
    for (;;) {
        sum = 0u; cnt = 0u; mine = 0u;
#pragma unroll
        for (unsigned j = 0; j < 16; ++j) { const unsigned c = xb_ld(&bar[XB_XCNT(j)]); sum += c; cnt += (c > 0u) ? 1u : 0u; mine = (j == x) ? c : mine; }
        if (sum == G) break;
        __builtin_amdgcn_s_sleep(1);
        if ((++sp & 255u) == 0u) { if (xb_ld(&bar[XB_TMO])) break; if (sp > XB_SPIN_CAP) { atomicAdd(&bar[XB_TMO], 1u); break; } }
    }
    nloc = mine > 0u ? mine : 1u; nx = cnt > 0u ? cnt : 1u;
}
__device__ __forceinline__ void xcd_barrier(const XcdBarrier& b) {
    asm volatile("s_waitcnt vmcnt(0)" ::: "memory");
    __syncthreads();
    if (threadIdx.x == 0) {
        unsigned* bar = b.bar;
        __builtin_amdgcn_s_waitcnt(0);
        unsigned nloc = b.st[0], nx = b.st[1];
        if (nloc == 0u) { xcd_barrier_complete(bar, b.x, nloc, nx); b.st[0] = nloc; b.st[1] = nx; }
        const unsigned old = xb_add(&bar[XB_XSUB(b.x)], 1u);
        const unsigned gen = old / nloc;
        if (old + 1u == (gen + 1u) * nloc) {
            __builtin_amdgcn_fence(__ATOMIC_RELEASE, "agent");
            asm volatile("s_waitcnt vmcnt(0)" ::: "memory");
            const unsigned og = xb_add(&bar[XB_TOP], 1u);
            const unsigned tg = og / nx;
            if (og + 1u == (tg + 1u) * nx) xb_add(&bar[XB_TOPGEN], 1u);
            else XB_SPIN(xb_ld(&bar[XB_TOPGEN]) == tg, bar);
            __builtin_amdgcn_fence(__ATOMIC_ACQUIRE, "agent");
            xb_add(&bar[XB_XGEN(b.x)], 1u);
            asm volatile("s_waitcnt vmcnt(0)" ::: "memory");
        } else {
            XB_SPIN(xb_ld(&bar[XB_XGEN(b.x)]) == gen, bar);
            __builtin_amdgcn_fence(__ATOMIC_ACQUIRE, "agent");
            asm volatile("s_waitcnt vmcnt(0)" ::: "memory");
        }
    }
    __syncthreads();
}

struct Frame {
    LAS unsigned char* lds;
    volatile LAS unsigned* MISC;
    gu32* ctl;
    int tid, lane, wave, G;
    unsigned long long tp;
    float* out; unsigned char* ws;
};
#define WSP(T, off) ((T*)(F.ws + (off)))
#define WSL(T, off) ((T*)(ws_ + (off)))
#define LAUNDER_WS() unsigned char* ws_ = F.ws; asm volatile("" : "+s"(ws_))
constexpr int PTR_OFF = MISC_OFF + 128;
enum { I_XP = 0, I_XS, I_C1, I_C2, I_C3, I_ST0, I_RELB, I_WIN, I_WG2, I_BG, I_GN, I_WA, I_WB, I_WO, I_L1G, I_L1B, I_WQ, I_KEYS, I_PU, I_PV, I_L2G, I_L2B };
__device__ __forceinline__ const float* inptr(const Frame& F, int i) {
    const unsigned long long v = ((volatile LAS unsigned long long*)(F.lds + PTR_OFF))[i];
    const unsigned lo = __builtin_amdgcn_readfirstlane((unsigned)v), hi = __builtin_amdgcn_readfirstlane((unsigned)(v >> 32));
    return (const float*)(((unsigned long long)hi << 32) | lo);
}

__device__ __forceinline__ void p0_tr_load(const float* W, int N, int nsrc0, int k0, int lane, float (&v)[32]) {
#pragma unroll
    for (int i = 0; i < 32; ++i) { const int kk = 2 * i + (lane >> 5); v[i] = W[(size_t)(k0 + kk) * N + nsrc0 + (lane & 31)]; }
}
__device__ __forceinline__ void p0_tr_finish(const float (&v)[32], int K, bf16* WT, int ndst0, int k0, LAS float* scr, int lane) {
#pragma unroll
    for (int i = 0; i < 32; ++i) { const int kk = 2 * i + (lane >> 5); scr[kk * 33 + (lane & 31)] = v[i]; }
    LDS_WAIT(); asm volatile("" ::: "memory");
    const int c = lane & 7;
#pragma unroll
    for (int j = 0; j < 4; ++j) { const int n = (lane >> 3) + 8 * j; const LAS float* s = scr + (8 * c) * 33 + n;
        v4u o; o.x = cvt_pk_bf16(s[0 * 33], s[1 * 33]); o.y = cvt_pk_bf16(s[2 * 33], s[3 * 33]); o.z = cvt_pk_bf16(s[4 * 33], s[5 * 33]); o.w = cvt_pk_bf16(s[6 * 33], s[7 * 33]);
        *(GAS v4u*)(WT + (size_t)(ndst0 + n) * K + k0 + 8 * c) = o; }
    LDS_WAIT(); asm volatile("" ::: "memory");
}
__device__ __forceinline__ void p0_cvt8(const float* src, bf16* dst, size_t n8, size_t gt, size_t ngt) {
    for (size_t i = gt; i < n8; i += ngt) { const f32x4 a = *(const f32x4*)(src + i * 8), b = *(const f32x4*)(src + i * 8 + 4);
        v4u o; o.x = cvt_pk_bf16(a[0], a[1]); o.y = cvt_pk_bf16(a[2], a[3]); o.z = cvt_pk_bf16(b[0], b[1]); o.w = cvt_pk_bf16(b[2], b[3]); *(v4u*)(dst + i * 8) = o; }
}
typedef float f32x2_t __attribute__((ext_vector_type(2)));
typedef _Float16 h2_t __attribute__((ext_vector_type(2)));
constexpr float U_SCALE = 1024.0f, V_SCALE = 128.0f, X_SCALE = 16.0f;
__device__ __forceinline__ void p0_cvt_fp8(const float* src, unsigned char* dst, float scale, size_t n16, size_t gt, size_t ngt) {
    for (size_t i = gt; i < n16; i += ngt) { v4u o;
#pragma unroll
        for (int q = 0; q < 4; ++q) { const f32x4 a = *(const f32x4*)(src + i * 16 + 4 * q) * scale; int w = 0;
            w = __builtin_amdgcn_cvt_pk_fp8_f32(a[0], a[1], w, false); w = __builtin_amdgcn_cvt_pk_fp8_f32(a[2], a[3], w, true); o[q] = (unsigned)w; }
        const size_t e = i >> 6, q16 = i & 63;
        *(v4u*)(dst + (((q16 >> 3) * 16384 + e) << 7) + 16 * (q16 & 7)) = o; }
}
__device__ __forceinline__ void p0_kvshift(const float* src, float* dst, int Wb, size_t gt, size_t ngt) {
    const size_t n4 = (size_t)(Wb - 4) * 256, tot = n4 * 32;
    for (size_t i = gt; i < tot; i += ngt) { const size_t b = i / n4, r = i - b * n4;
        ((f32x4*)dst)[b * (size_t)Wb * 256 + r] = ((const f32x4*)src)[b * (size_t)Wb * 256 + 1024 + r]; }
}
__device__ __forceinline__ void p0_prologue(Frame& F) {
    const int gw = blockIdx.x * NWAVES + F.wave, NGW = F.G * NWAVES;
    const size_t gt = (size_t)blockIdx.x * NTHR + F.tid, ngt = (size_t)F.G * NTHR;
    const float* win = inptr(F, I_WIN); const float* xp = inptr(F, I_XP); const float* xs = inptr(F, I_XS);
    constexpr int WROW = 2064;
    for (int i = F.tid; i < 4096; i += NTHR) {
        const int k = i >> 2, c4 = (i & 3) * 4; const f32x4 w4 = *(const f32x4*)(win + (size_t)k * INW + ABCOL + c4);
#pragma unroll
        for (int cc = 0; cc < 4; ++cc) *(LAS unsigned short*)(F.lds + (c4 + cc) * WROW + k * 2) = f2bf(w4[cc]); }
    __syncthreads();
    bf16* XB = WSP(bf16, WS_XB); float* AB = WSP(float, WS_AB);
    {   const int lane = F.lane, r = lane & 15, kg = lane >> 4;
        typedef float f32x4a __attribute__((ext_vector_type(4)));
        for (int blk = gw; blk < MPAD / 16; blk += NGW) {
            const int m = 16 * blk + r;
            bf16* xo = XB + (size_t)m * 1024 + 8 * kg;
            if (16 * blk >= NTOK) {
#pragma unroll 8
                for (int s = 0; s < 32; ++s) *(v4u*)(xo + 32 * s) = (v4u){0u, 0u, 0u, 0u};
                if (kg == 0) { *(f32x4*)(AB + (size_t)m * 16) = (f32x4){0.f, 0.f, 0.f, 0.f}; *(f32x4*)(AB + (size_t)m * 16 + 4) = (f32x4){0.f, 0.f, 0.f, 0.f}; *(f32x4*)(AB + (size_t)m * 16 + 8) = (f32x4){0.f, 0.f, 0.f, 0.f}; *(f32x4*)(AB + (size_t)m * 16 + 12) = (f32x4){0.f, 0.f, 0.f, 0.f}; }
                continue; }
            const float* xr = (m < NP ? xp + (size_t)m * 1024 : xs + (size_t)(m - NP) * 1024) + 8 * kg;
            f32x4a acc = {0.f, 0.f, 0.f, 0.f};
#pragma unroll 1
            for (int s0 = 0; s0 < 32; s0 += 16) {
                f32x4 xa[16], xb[16];
#pragma unroll
                for (int u = 0; u < 16; ++u) { xa[u] = *(const f32x4*)(xr + 32 * (s0 + u)); xb[u] = *(const f32x4*)(xr + 32 * (s0 + u) + 4); }
#pragma unroll
                for (int u = 0; u < 16; ++u) { v4u w; w.x = cvt_pk_bf16(xa[u][0], xa[u][1]); w.y = cvt_pk_bf16(xa[u][2], xa[u][3]); w.z = cvt_pk_bf16(xb[u][0], xb[u][1]); w.w = cvt_pk_bf16(xb[u][2], xb[u][3]);
                    *(v4u*)(xo + 32 * (s0 + u)) = w;
                    const bf16x8 bfr = *(const LAS bf16x8*)(F.lds + r * WROW + (32 * (s0 + u) + 8 * kg) * 2);
                    acc = __builtin_amdgcn_mfma_f32_16x16x32_bf16(__builtin_bit_cast(bf16x8, w), bfr, acc, 0, 0, 0); }
            }
#pragma unroll
            for (int i2 = 0; i2 < 4; ++i2) AB[(size_t)(16 * blk + 4 * kg + i2) * 16 + r] = acc[i2];
        }
    }
    __syncthreads();
    LAS float* scr = (LAS float*)(F.lds + F.wave * 16384);
    const float* wa = inptr(F, I_WA); const float* wb = inptr(F, I_WB); const float* wo = inptr(F, I_WO); const float* wq = inptr(F, I_WQ);
    constexpr int I_IN = 16 * (NPROJ / 32), I_A = 8 * 32, I_B = 16 * 32, I_O = 16 * 32, I_Q = 16 * 64, NIT = I_IN + I_A + I_B + I_O + I_Q;
#define P0_TR_PARAMS(IT, W_, WT_, K_, N_, NS_, ND_, K0_) { int r = (IT); \
        if (r < I_IN) { const int nb = r % (NPROJ / 32), kb = r / (NPROJ / 32), nd = 32 * nb; W_ = win; WT_ = WSP(bf16, WS_WIN); K_ = 1024; N_ = INW; NS_ = nd + (nd >= ABCOL ? 16 : 0); ND_ = nd; K0_ = 64 * kb; } \
        else if ((r -= I_IN) < I_A) { W_ = wa; WT_ = WSP(bf16, WS_WA); K_ = 512; N_ = 1024; NS_ = ND_ = 32 * (r % 32); K0_ = 64 * (r / 32); } \
        else if ((r -= I_A) < I_B) { W_ = wb; WT_ = WSP(bf16, WS_WB); K_ = 1024; N_ = 1024; NS_ = ND_ = 32 * (r % 32); K0_ = 64 * (r / 32); } \
        else if ((r -= I_B) < I_O) { W_ = wo; WT_ = WSP(bf16, WS_WO); K_ = 1024; N_ = 1024; NS_ = ND_ = 32 * (r % 32); K0_ = 64 * (r / 32); } \
        else { r -= I_O; W_ = wq; WT_ = WSP(bf16, WS_WQ); K_ = 1024; N_ = 2048; NS_ = ND_ = 32 * (r % 64); K0_ = 64 * (r / 64); } }
    if (blockIdx.x != 0) {
        const int NW2 = NGW - NWAVES;
        for (int it = gw - NWAVES; it < NIT; it += 2 * NW2) {
            const int it2 = it + NW2; const bool has2 = it2 < NIT;
            const float* Wa; bf16* WTa; int Ka, Na, NSa, NDa, K0a; P0_TR_PARAMS(it, Wa, WTa, Ka, Na, NSa, NDa, K0a);
            const float* Wb = Wa; bf16* WTb = WTa; int Kb = Ka, Nb = Na, NSb = NSa, NDb = NDa, K0b = K0a;
            if (has2) P0_TR_PARAMS(it2, Wb, WTb, Kb, Nb, NSb, NDb, K0b);
            float va[32], vb[32];
            p0_tr_load(Wa, Na, NSa, K0a, F.lane, va);
            if (has2) p0_tr_load(Wb, Nb, NSb, K0b, F.lane, vb);
            p0_tr_finish(va, Ka, WTa, NDa, K0a, scr, F.lane);
            if (has2) p0_tr_finish(vb, Kb, WTb, NDb, K0b, scr, F.lane);
        }
    }
    p0_cvt_fp8(inptr(F, I_PU), WSP(unsigned char, WS_UT), U_SCALE, (size_t)16384 * 1024 / 16, gt, ngt);
    p0_cvt_fp8(inptr(F, I_PV), WSP(unsigned char, WS_VT), V_SCALE, (size_t)16384 * 1024 / 16, gt, ngt);
    p0_cvt8(inptr(F, I_KEYS), WSP(bf16, WS_KEYS), (size_t)8 * 2 * 128 * 128 / 8, gt, ngt);
    if (gt < 3 * 8 * 129) { const int g = (int)gt / (8 * 129), h = ((int)gt / 129) % 8, rel = (int)gt % 129; const int dil = g == 0 ? 1 : (g == 1 ? 4 : 16), dist = rel * dil;
        int bucket = dist;
        if (dist >= 16) { const float dd = (float)dist; int lg = 16 + (int)(logf(dd / 16.0f) / 4.852030263919617f * 16.0f); bucket = lg < 31 ? lg : 31; }
        WSP(float, WS_LUT)[gt] = inptr(F, I_RELB)[bucket * 24 + g * 8 + h]; }
}

constexpr size_t WS_KD = WS_OAM, WS_DEC = WS_OBN;
__device__ __forceinline__ void gla_prep_load(Frame& F, int unit, unsigned (&qv)[8], unsigned (&kv)[8], float (&abv)[2]) {
    const int d2 = F.tid & 63, ig = F.wave, h = unit & 3, n = (unit >> 2) & 63, b = unit >> 8;
    const size_t m0 = (size_t)b * TSEQ + (size_t)n * 64;
    const bf16* QB = WSP(bf16, WS_QB); const bf16* KB = WSP(bf16, WS_KB); const float* AB = WSP(float, WS_AB);
#pragma unroll
    for (int ii = 0; ii < 8; ++ii) { const size_t off = (m0 + 8 * ig + ii) * 512 + h * 128 + 2 * d2; qv[ii] = *(const unsigned*)(QB + off); kv[ii] = *(const unsigned*)(KB + off); }
    abv[0] = AB[(m0 + 8 * ig) * 16 + d2]; abv[1] = AB[(m0 + 8 * ig) * 16 + 64 + d2];
}
__device__ __forceinline__ void gla_prep_unit(Frame& F, int unit, const unsigned (&qv)[8], const unsigned (&kv)[8], const float (&abv)[2], const f32x2_t (&wg)[16], const f32x2_t bgd) {
    LAUNDER_WS();
    LAS float* GT = (LAS float*)F.lds;
    const int tid = F.tid, d2 = tid & 63, ig = F.wave;
    const int h = unit & 3, n = (unit >> 2) & 63, b = unit >> 8;
    const size_t m0 = (size_t)b * TSEQ + (size_t)n * 64;
    bf16* QB = WSL(bf16, WS_QB); bf16* KB = WSL(bf16, WS_KB); float* DEC = WSL(float, WS_DEC);
    f32x2_t c[8]; f32x2_t run = {0.f, 0.f};
#pragma unroll
    for (int ii = 0; ii < 8; ++ii) {
        f32x2_t x = bgd;
#pragma unroll
        for (int r = 0; r < 16; ++r) x += wg[r] * __uint_as_float((unsigned)__builtin_amdgcn_readlane((int)__float_as_uint(abv[ii >> 2]), 16 * (ii & 3) + r));
        f32x2_t ls; ls.x = fminf(x.x, 0.f) - __logf(1.0f + __expf(-fabsf(x.x))); ls.y = fminf(x.y, 0.f) - __logf(1.0f + __expf(-fabsf(x.y)));
        run += ls * (1.0f / 16.0f); c[ii] = run;
    }
    *(LAS f32x2_t*)(GT + ig * 128 + 2 * d2) = run;
    __syncthreads();
    f32x2_t offs = {0.f, 0.f}, bl = {0.f, 0.f};
#pragma unroll
    for (int g = 0; g < 8; ++g) { const f32x2_t t = *(const LAS f32x2_t*)(GT + g * 128 + 2 * d2); bl += t; if (g < ig) offs += t; }
    const f32x2_t ebl = {__expf(bl.x), __expf(bl.y)};
#pragma unroll
    for (int ii = 0; ii < 8; ++ii) {
        const f32x2_t bb = offs + c[ii]; const f32x2_t eb = {__expf(bb.x), __expf(bb.y)}, ieb = {__expf(-bb.x), __expf(-bb.y)};
        const f32x2_t q = {bf_lo(qv[ii]), bf_hi(qv[ii])}, k = {bf_lo(kv[ii]), bf_hi(kv[ii])};
        const f32x2_t qe = q * GLA_QSCALE * eb, ke = k * ieb;
        const size_t off = (m0 + 8 * ig + ii) * 512 + h * 128 + 2 * d2;
        *(unsigned*)(QB + off) = cvt_pk_bf16(qe.x, qe.y); *(unsigned*)(KB + off) = cvt_pk_bf16(ke.x, ke.y);
    }
    if (ig == 0) *(f32x2_t*)(DEC + ((size_t)b * 64 + n) * 512 + h * 128 + 2 * d2) = ebl;
    __syncthreads();
}
__device__ __forceinline__ void gla_prompt_unit(Frame& F, int b, int h, int sl) {
    LAUNDER_WS();
    LAS unsigned char* L = F.lds;
    constexpr int O_QE = 0, O_KE = 17408, O_KD = 34816, O_VT = 55296, O_SB = 67584, O_DEC = 92160;
    const int tid = F.tid, lane = F.lane, w = F.wave, hh = lane >> 5;
    const bf16* QB = WSL(bf16, WS_QB); const bf16* KB = WSL(bf16, WS_KB); bf16* VB = WSL(bf16, WS_VB); const float* DEC = WSL(float, WS_DEC);
    for (int i = tid; i < 128 * 192 / 4; i += NTHR) ((LAS unsigned*)(L + O_SB))[i] = 0u;
    f32x16 S;
#pragma unroll
    for (int r = 0; r < 16; ++r) S[r] = 0.f;
    const int dt = w >> 1, et = w & 1;
    const int r0 = tid >> 4, c0 = tid & 15;
    v4u tq[2], tk[2], tv; float tdec = 0.f;
#define GLA_LOAD(n_) do { const size_t m0_ = (size_t)b * TSEQ + (size_t)(n_) * 64; \
        _Pragma("unroll") for (int i_ = 0; i_ < 2; ++i_) { const size_t off_ = (m0_ + r0 + 32 * i_) * 512 + h * 128 + c0 * 8; tq[i_] = *(const v4u*)(QB + off_); tk[i_] = *(const v4u*)(KB + off_); } \
        tv = *(const v4u*)(VB + (m0_ + (tid >> 3)) * 1024 + h * 256 + sl * 64 + (tid & 7) * 8); \
        if (tid < 128) tdec = DEC[((size_t)b * 64 + (n_)) * 512 + h * 128 + tid]; } while (0)
    GLA_LOAD(0);
    for (int n = 0; n < 64; ++n) {
        const size_t m0 = (size_t)b * TSEQ + (size_t)n * 64;
#pragma unroll
        for (int i = 0; i < 2; ++i) { *(LAS v4u*)(L + O_QE + (r0 + 32 * i) * 272 + c0 * 16) = tq[i]; *(LAS v4u*)(L + O_KE + (r0 + 32 * i) * 272 + c0 * 16) = tk[i]; *(LAS v4u*)(L + O_KD + (r0 + 32 * i) * 320 + c0 * 16) = tk[i]; }
        *(LAS v4u*)(L + O_VT + (tid >> 3) * 192 + (tid & 7) * 16) = tv;
        if (tid < 128) ((LAS float*)(L + O_DEC))[tid] = tdec;
        __syncthreads();
        if (n + 1 < 64) GLA_LOAD(n + 1);
        if (w < 4) {
            const int it = w >> 1;
            f32x16 o;
#pragma unroll
            for (int r = 0; r < 16; ++r) o[r] = 0.f;
            for (int jt = 0; jt <= it; ++jt) {
                f32x16 X;
#pragma unroll
                for (int r = 0; r < 16; ++r) X[r] = 0.f;
#pragma unroll
                for (int s = 0; s < 8; ++s) X = MFMA32(frag_row(L + O_KE, 272, 32 * jt, 16 * s, lane), frag_row(L + O_QE, 272, 32 * it, 16 * s, lane), X);
                if (jt == it) {
#pragma unroll
                    for (int r = 0; r < 16; ++r) if (crow(r, hh) > (lane & 31)) X[r] = 0.f;
                }
#pragma unroll
                for (int s2 = 0; s2 < 2; ++s2) o = MFMA32(pack_acc(X, s2), frag_tr<true>(L + O_VT, 192, 32 * jt + 16 * s2, 32 * et, lane), o);
            }
#pragma unroll
            for (int s = 0; s < 8; ++s) o = MFMA32(frag_row(L + O_QE, 272, 32 * it, 16 * s, lane), frag_tr<false>(L + O_SB, 192, 16 * s, 32 * et, lane), o);
            bf16* op = VB + (m0 + 32 * it) * 1024 + h * 256 + sl * 64 + 32 * et + (lane & 31);
#pragma unroll
            for (int r = 0; r < 16; ++r) op[(size_t)crow(r, hh) * 1024] = f2bf(o[r]);
        }
        {
#pragma unroll
            for (int s = 0; s < 4; ++s) S = MFMA32(frag_tr<false>(L + O_KD, 320, 16 * s, 32 * dt, lane), frag_tr<false>(L + O_VT, 192, 16 * s, 32 * et, lane), S);
#pragma unroll
            for (int r = 0; r < 16; ++r) S[r] *= ((LAS float*)(L + O_DEC))[32 * dt + crow(r, hh)];
        }
        __syncthreads();
#pragma unroll
        for (int r = 0; r < 16; ++r) *(LAS unsigned short*)(L + O_SB + (32 * dt + crow(r, hh)) * 192 + (32 * et + (lane & 31)) * 2) = f2bf(S[r]);
    }
#undef GLA_LOAD
    float* so = F.out + OUT_STP + ((size_t)(b * 4 + h) * 128 + 32 * dt) * 256 + sl * 64 + 32 * et + (lane & 31);
#pragma unroll
    for (int r = 0; r < 16; ++r) so[(size_t)crow(r, hh) * 256] = S[r];
    __syncthreads();
}

struct AttnItem { int b, h, g, r, dil, i0, cb; size_t tok0; };
__device__ __forceinline__ AttnItem attn_decode(int item) {
    AttnItem a; const int bh = item / 48, sub = item % 48; a.b = bh >> 3; a.h = bh & 7;
    int ibg;
    if (sub < 16) { a.g = 0; a.r = 0; ibg = sub; } else if (sub < 32) { a.g = 1; a.r = (sub - 16) >> 2; ibg = (sub - 16) & 3; } else { a.g = 2; a.r = sub - 32; ibg = 0; }
    a.dil = a.g == 0 ? 1 : (a.g == 1 ? 4 : 16); a.i0 = 256 * ibg; a.tok0 = (size_t)a.b * TSEQ + a.r; a.cb = a.g * 512 + a.h * 64;
    return a;
}
__device__ __forceinline__ void attn_issue(Frame& F, int item, v4u (&kk)[6], v4u (&vv)[6], bf16x8 (&qf)[4]) {
    LAUNDER_WS();
    const AttnItem a = attn_decode(item);
    const int tid = F.tid, lane = F.lane, w = F.wave, hh = lane >> 5, il = lane & 31;
    const bf16* QA = WSL(bf16, WS_QA); const bf16* KA = WSL(bf16, WS_KA); const bf16* VA = WSL(bf16, WS_VA);
    const size_t qtok = a.tok0 + (size_t)a.dil * (a.i0 + 32 * w + il);
#pragma unroll
    for (int s = 0; s < 4; ++s) qf[s] = *(const bf16x8*)(QA + qtok * 1536 + a.cb + 16 * s + 8 * hh);
#pragma unroll
    for (int p = 0; p < 6; ++p) { const int idx = tid + NTHR * p, rr = idx >> 3, ch = idx & 7, j = a.i0 - 128 + rr;
        if (j >= 0) { const size_t so = (a.tok0 + (size_t)a.dil * j) * 1536 + a.cb + ch * 8; vv[p] = *(const v4u*)(VA + so); kk[p] = *(const v4u*)(KA + so); } }
}
__device__ __forceinline__ void attn_prompt_item(Frame& F, int item, v4u (&kk)[6], v4u (&vv)[6], const bf16x8 (&qf)[4], bool has_next, int next_item, bf16x8 (&qn)[4]) {
    LAUNDER_WS();
    LAS unsigned char* L = F.lds;
    constexpr int O_V = 0, O_K = 384 * 192, O_LUT = O_K + 384 * 144;
    static_assert(O_LUT + 129 * 4 <= RING_BYTES, "attention LDS");
    const int tid = F.tid, lane = F.lane, w = F.wave, hh = lane >> 5, il = lane & 31;
    const AttnItem a = attn_decode(item);
    const int b = a.b, h = a.h, g = a.g, dil = a.dil, i0 = a.i0, cb = a.cb; const size_t tok0 = a.tok0; (void)b;
    bf16* QA = WSL(bf16, WS_QA); float* LSE = WSL(float, WS_LSE);
    const size_t qtok = tok0 + (size_t)dil * (i0 + 32 * w + il);
#pragma unroll
    for (int p = 0; p < 6; ++p) { const int idx = tid + NTHR * p, rr = idx >> 3, ch = idx & 7, j = i0 - 128 + rr;
        if (j >= 0) { *(LAS v4u*)(L + O_V + rr * 192 + ch * 16) = vv[p]; *(LAS v4u*)(L + O_K + rr * 144 + ch * 16) = kk[p]; } }
    if (tid < 129) ((LAS float*)(L + O_LUT))[tid] = WSL(float, WS_LUT)[(g * 8 + h) * 129 + tid];
    __syncthreads();
    if (has_next) attn_issue(F, next_item, kk, vv, qn);
    float mrun = NEG_BIG, lrun = 0.f;
    f32x16 O0, O1;
#pragma unroll
    for (int x = 0; x < 16; ++x) { O0[x] = 0.f; O1[x] = 0.f; }
#pragma unroll 1
    for (int kt = 0; kt < 5; ++kt) {
        const int jb = i0 + 32 * (w + kt) - 128;
        if (jb < 0) continue;
        f32x16 ST;
#pragma unroll
        for (int x = 0; x < 16; ++x) ST[x] = 0.f;
#pragma unroll
        for (int s = 0; s < 4; ++s) ST = MFMA32(frag_row(L + O_K, 144, 32 * (w + kt), 16 * s, lane), qf[s], ST);
        const int relb = 128 - 32 * kt + il;
        float tmax = NEG_BIG;
#pragma unroll
        for (int x = 0; x < 16; ++x) { const int rel = relb - crow(x, hh); const bool ok = rel >= 0 && rel <= 128; const int rc = rel < 0 ? 0 : (rel > 128 ? 128 : rel);
            const float sc = ok ? ST[x] + ((LAS float*)(L + O_LUT))[rc] : NEG_BIG; ST[x] = sc; tmax = fmaxf(tmax, sc); }
        tmax = fmaxf(tmax, __shfl_xor(tmax, 32));
        const float mnew = fmaxf(mrun, tmax), alpha = __expf(mrun - mnew);
        float ps = 0.f;
#pragma unroll
        for (int x = 0; x < 16; ++x) { const float p = __expf(ST[x] - mnew); ST[x] = p; ps += p; }
        lrun = lrun * alpha + ps; mrun = mnew;
#pragma unroll
        for (int x = 0; x < 16; ++x) { O0[x] *= alpha; O1[x] *= alpha; }
#pragma unroll
        for (int s2 = 0; s2 < 2; ++s2) { const bf16x8 pf = pack_acc(ST, s2);
            O0 = MFMA32(frag_tr<true>(L + O_V, 192, 32 * (w + kt) + 16 * s2, 0, lane), pf, O0);
            O1 = MFMA32(frag_tr<true>(L + O_V, 192, 32 * (w + kt) + 16 * s2, 32, lane), pf, O1); }
    }
    const float ltot = lrun + __shfl_xor(lrun, 32), inv = 1.0f / ltot;
    bf16* op = QA + qtok * 1536 + cb;
#pragma unroll
    for (int k4 = 0; k4 < 4; ++k4) { v2u a, c2;
        a.x = cvt_pk_bf16(O0[4 * k4] * inv, O0[4 * k4 + 1] * inv); a.y = cvt_pk_bf16(O0[4 * k4 + 2] * inv, O0[4 * k4 + 3] * inv);
        c2.x = cvt_pk_bf16(O1[4 * k4] * inv, O1[4 * k4 + 1] * inv); c2.y = cvt_pk_bf16(O1[4 * k4 + 2] * inv, O1[4 * k4 + 3] * inv);
        *(v2u*)(op + 8 * k4 + 4 * hh) = a; *(v2u*)(op + 32 + 8 * k4 + 4 * hh) = c2; }
    if (hh == 0) LSE[((size_t)g * MPAD + qtok) * 8 + h] = mrun + __logf(ltot);
    __syncthreads();
}

template <int G_> __device__ __forceinline__ void attn_sample_waveitem_g(Frame& F, int wi, const float* cache) {
    LAUNDER_WS();
    const int lane = F.lane;
    LAS float* pl = (LAS float*)(F.lds + F.wave * 1024);
    constexpr int g = G_; const int h = (wi / 3) & 7, s = (wi / 24) & 3, b = wi / 96;
    constexpr int dil = g == 0 ? 1 : (g == 1 ? 4 : 16), Wb = 128 * dil;
    bf16* QA = WSL(bf16, WS_QA); const bf16* KA = WSL(bf16, WS_KA); const bf16* VA = WSL(bf16, WS_VA); float* LSE = WSL(float, WS_LSE);
    const size_t qrow = (size_t)NP + b * 4 + s; const int cb = g * 512 + h * 64;
    float q[64];
#pragma unroll
    for (int c = 0; c < 8; ++c) { const v4u u = *(const v4u*)(QA + qrow * 1536 + cb + 8 * c);
        q[8 * c] = bf_lo(u.x); q[8 * c + 1] = bf_hi(u.x); q[8 * c + 2] = bf_lo(u.y); q[8 * c + 3] = bf_hi(u.y); q[8 * c + 4] = bf_lo(u.z); q[8 * c + 5] = bf_hi(u.z); q[8 * c + 6] = bf_lo(u.w); q[8 * c + 7] = bf_hi(u.w); }
    const float* lut = WSL(float, WS_LUT) + (g * 8 + h) * 129;
    float sc[3];
#pragma unroll
    for (int p = 0; p < 3; ++p) { const int j = lane + 64 * p; float a = NEG_BIG;
        if (j <= 128) { const int idx = Wb + s - j * dil; a = 0.f;
            if (idx >= Wb) { const bf16* kr = KA + ((size_t)NP + b * 4 + (idx - Wb)) * 1536 + cb;
#pragma unroll
                for (int c = 0; c < 8; ++c) { const v4u u = *(const v4u*)(kr + 8 * c);
                    a += q[8 * c] * bf_lo(u.x) + q[8 * c + 1] * bf_hi(u.x) + q[8 * c + 2] * bf_lo(u.y) + q[8 * c + 3] * bf_hi(u.y) + q[8 * c + 4] * bf_lo(u.z) + q[8 * c + 5] * bf_hi(u.z) + q[8 * c + 6] * bf_lo(u.w) + q[8 * c + 7] * bf_hi(u.w); }
            } else { const float* kr = cache + (((size_t)b * Wb + idx) * 2 + 0) * 512 + h * 64;
#pragma unroll
                for (int c = 0; c < 16; ++c) { const f32x4 u = *(const f32x4*)(kr + 4 * c); a += q[4 * c] * u[0] + q[4 * c + 1] * u[1] + q[4 * c + 2] * u[2] + q[4 * c + 3] * u[3]; }
            }
            a += lut[j]; }
        sc[p] = a; }
    const float mx = wave_max(fmaxf(fmaxf(sc[0], sc[1]), sc[2]));
    float ps = 0.f;
#pragma unroll
    for (int p = 0; p < 3; ++p) { const float e = __expf(sc[p] - mx); ps += e; pl[lane + 64 * p] = e; }
    const float ltot = wave_sum(ps);
    LDS_WAIT(); asm volatile("" ::: "memory");
    float o = 0.f;
    {
        const int nnew = dil == 1 ? s + 1 : 1;
        for (int j = 0; j < nnew; ++j) o += pl[j] * bf2f(VA[((size_t)NP + b * 4 + (s - j * dil)) * 1536 + cb + lane]);
        const float* vbase = cache + (((size_t)b * Wb) * 2 + 1) * 512 + h * 64 + lane;
        for (int j0 = nnew; j0 <= 128; j0 += 44) { float vv[44];
#pragma unroll
            for (int u = 0; u < 44; ++u) { const int j = j0 + u; vv[u] = j <= 128 ? vbase[(size_t)(Wb + s - j * dil) * 1024] : 0.f; }
#pragma unroll
            for (int u = 0; u < 44; ++u) { const int j = j0 + u; o += (j <= 128 ? pl[j] : 0.f) * vv[u]; } }
    }
    QA[qrow * 1536 + cb + lane] = f2bf(o / ltot);
    if (lane == 0) LSE[((size_t)g * MPAD + qrow) * 8 + h] = mx + __logf(ltot);
    LDS_WAIT(); asm volatile("" ::: "memory");
}

__device__ __forceinline__ void attn_sample_waveitem(Frame& F, int wi) {
    const int g = wi % 3;
    if (g == 0) attn_sample_waveitem_g<0>(F, wi, inptr(F, I_C1)); else if (g == 1) attn_sample_waveitem_g<1>(F, wi, inptr(F, I_C2)); else attn_sample_waveitem_g<2>(F, wi, inptr(F, I_C3));
}
__device__ __forceinline__ void gla_sample_item(Frame& F, int item) {
    LAUNDER_WS();
    LAS float* L = (LAS float*)F.lds;
    constexpr int O_LA = 0, O_QE = 512, O_KE = 1024, O_KD = 1536, O_DEC = 2048, O_ATT = 2176, O_PART = 2304;
    const int tid = F.tid, b = item >> 2, h = item & 3;
    const bf16* QB = WSL(bf16, WS_QB); const bf16* KB = WSL(bf16, WS_KB); bf16* VB = WSL(bf16, WS_VB); const float* AB = WSL(float, WS_AB);
    const size_t row0 = (size_t)NP + b * 4;
    { const int i = tid >> 7, d = tid & 127; float x = inptr(F, I_BG)[h * 128 + d]; const float* wg2 = inptr(F, I_WG2);
#pragma unroll
      for (int r = 0; r < 16; ++r) x += AB[(row0 + i) * 16 + r] * wg2[r * 512 + h * 128 + d];
      L[O_LA + i * 128 + d] = (fminf(x, 0.f) - log1pf(expf(-fabsf(x)))) * (1.0f / 16.0f); }
    __syncthreads();
    if (tid < 128) { const int d = tid; float bb[4]; float run = 0.f;
#pragma unroll
        for (int i = 0; i < 4; ++i) { run += L[O_LA + i * 128 + d]; bb[i] = run; }
        const float ebl = expf(run); L[O_DEC + d] = ebl;
#pragma unroll
        for (int i = 0; i < 4; ++i) { const float q = bf2f(QB[(row0 + i) * 512 + h * 128 + d]), k = bf2f(KB[(row0 + i) * 512 + h * 128 + d]);
            L[O_QE + i * 128 + d] = q * GLA_QSCALE * expf(bb[i]); L[O_KE + i * 128 + d] = k * expf(-bb[i]); L[O_KD + i * 128 + d] = k * expf(run - bb[i]); } }
    __syncthreads();
    if (tid < 16) { const int i = tid >> 2, j = tid & 3; float a = 0.f;
        if (j <= i) for (int d = 0; d < 128; ++d) a += L[O_QE + i * 128 + d] * L[O_KE + j * 128 + d];
        L[O_ATT + tid] = a; }
    const int e = tid & 255, dh = tid >> 8;
    float v[4];
#pragma unroll
    for (int j = 0; j < 4; ++j) v[j] = bf2f(VB[(row0 + j) * 1024 + h * 256 + e]);
    const float* Sin = inptr(F, I_ST0) + ((size_t)(b * 4 + h) * 128) * 256 + e; float* Sout = F.out + OUT_STS + ((size_t)(b * 4 + h) * 128) * 256 + e;
    float acc[4] = {0.f, 0.f, 0.f, 0.f};
#pragma unroll 4
    for (int dd = 0; dd < 64; ++dd) { const int d = dh * 64 + dd; const float sv = Sin[(size_t)d * 256];
#pragma unroll
        for (int i = 0; i < 4; ++i) acc[i] += L[O_QE + i * 128 + d] * sv;
        float sn = L[O_DEC + d] * sv;
#pragma unroll
        for (int j = 0; j < 4; ++j) sn += L[O_KD + j * 128 + d] * v[j];
        Sout[(size_t)d * 256] = sn; }
#pragma unroll
    for (int i = 0; i < 4; ++i) L[O_PART + (dh * 4 + i) * 256 + e] = acc[i];
    __syncthreads();
    if (tid < 256) {
#pragma unroll
        for (int i = 0; i < 4; ++i) { float o = L[O_PART + i * 256 + e] + L[O_PART + (4 + i) * 256 + e];
#pragma unroll
            for (int j = 0; j < 4; ++j) o += L[O_ATT + i * 4 + j] * v[j];
            VB[(row0 + i) * 1024 + h * 256 + e] = f2bf(o); } }
    __syncthreads();
}

static_assert(true, "");
constexpr int P2_ATT = 3072, P2_DEC = 384, P2_GLS = 128, P2_CPY = 32 * (2 + 8 + 32), P2_ITEMS = P2_ATT + P2_DEC + P2_GLS;
__device__ __forceinline__ void kvshift_item(Frame& F, int item) {
    int g, r = item; if (r < 64) g = 0; else if (r < 64 + 256) { g = 1; r -= 64; } else { g = 2; r -= 320; }
    const int Wb = g == 0 ? 128 : (g == 1 ? 512 : 2048), npc = Wb / 64, b = r / npc, pc = r % npc;
    const float* src = inptr(F, g == 0 ? I_C1 : (g == 1 ? I_C2 : I_C3)); float* dst = F.out + (g == 0 ? OUT_KVS1 : (g == 1 ? OUT_KVS2 : OUT_KVS3));
    const int nrow = (pc == npc - 1) ? 60 : 64;
    const f32x4* s4 = (const f32x4*)src + ((size_t)b * Wb + 64 * pc + 4) * 256; f32x4* d4 = (f32x4*)dst + ((size_t)b * Wb + 64 * pc) * 256;
    { const int i = F.tid; f32x4 v[32];
#pragma unroll
        for (int u = 0; u < 32; ++u) if (u < 30 || nrow == 64) v[u] = __builtin_nontemporal_load(s4 + i + u * NTHR);
#pragma unroll
        for (int u = 0; u < 32; ++u) if (u < 30 || nrow == 64) __builtin_nontemporal_store(v[u], d4 + i + u * NTHR); }
}
template <bool STOP_ON_GDONE> __device__ __forceinline__ void kvshift_loop(Frame& F) {
    for (;;) {
        if (F.tid == 0) { unsigned t = 0xffffffffu;
            if (!STOP_ON_GDONE || __hip_atomic_load(F.ctl + CW_GDONE, RLX_AGENT) == 0u) t = __hip_atomic_fetch_add(F.ctl + CW_CPYQ, 1u, RLX_AGENT);
            F.MISC[0] = t; }
        __syncthreads();
        const unsigned t = F.MISC[0];
        __syncthreads();
        if (t >= (unsigned)P2_CPY) break;
        kvshift_item(F, (int)t);
    }
}
__device__ __forceinline__ void p2_prep(Frame& F) {
    unsigned qa[8], ka[8], qb[8], kb[8]; float aa[2], ab2[2];
    int u = blockIdx.x; if (u >= 2048) return;
    const int d2 = F.tid & 63, h = u & 3;
    const float* wg2 = inptr(F, I_WG2); const float* bgp = inptr(F, I_BG);
    f32x2_t wg[16];
#pragma unroll
    for (int r = 0; r < 16; ++r) wg[r] = *(const f32x2_t*)(wg2 + r * 512 + h * 128 + 2 * d2);
    const f32x2_t bgd = *(const f32x2_t*)(bgp + h * 128 + 2 * d2);
    gla_prep_load(F, u, qa, ka, aa);
    for (;;) {
        const int u1 = u + F.G; if (u1 < 2048) gla_prep_load(F, u1, qb, kb, ab2);
        gla_prep_unit(F, u, qa, ka, aa, wg, bgd); if (u1 >= 2048) break;
        const int u2 = u1 + F.G; if (u2 < 2048) gla_prep_load(F, u2, qa, ka, aa);
        gla_prep_unit(F, u1, qb, kb, ab2, wg, bgd); if (u2 >= 2048) break;
        u = u2;
    }
}
__device__ __forceinline__ void p2_mixers(Frame& F) {
#if defined(PROBE_PHASE) && PROBE_PHASE >= 100
    const unsigned long long tp0 = __builtin_amdgcn_s_memrealtime();
#endif
#ifndef P2_SKIP_GLAP
    if (blockIdx.x < 128) {
        const int bx = blockIdx.x, bh = (bx & 7) + 8 * (bx >> 5), sl = (bx >> 3) & 3;
        gla_prompt_unit(F, bh >> 2, bh & 3, sl); }
#endif
#if defined(PROBE_PHASE) && PROBE_PHASE == 100
    if (blockIdx.x == 0) F.tp = __builtin_amdgcn_s_memrealtime() - tp0;
#endif
    constexpr int QCHUNK = 4;
    for (int it = 0, itend = 0;; ++it) {
        if (it >= itend) {
            if (F.tid == 0) F.MISC[0] = __hip_atomic_fetch_add(F.ctl + CW_QUEUE, (unsigned)QCHUNK, RLX_AGENT);
            __syncthreads();
            it = (int)F.MISC[0]; itend = it + QCHUNK;
            __syncthreads();
        }
        if (it >= P2_ITEMS) break;
#if defined(PROBE_PHASE) && PROBE_PHASE == 101
        if (blockIdx.x == 255) F.tp = __builtin_amdgcn_s_memrealtime() - tp0;
#endif
#if defined(PROBE_PHASE) && PROBE_PHASE == 102
        if (blockIdx.x == 255 && it >= P2_GLS + P2_DEC + P2_ATT && F.tp == 0ull) F.tp = __builtin_amdgcn_s_memrealtime() - tp0;
#endif
#if defined(PROBE_PHASE) && PROBE_PHASE >= 103 && PROBE_PHASE <= 106
        const unsigned long long ti0 = __builtin_amdgcn_s_memrealtime();
        const int pcls = it < P2_GLS ? 105 : (it < P2_GLS + P2_DEC ? 104 : (it < P2_GLS + P2_DEC + P2_ATT ? 103 : 106));
#endif
        if (it < P2_GLS) {
#ifndef P2_SKIP_GLAS
            gla_sample_item(F, it);
#endif
        } else if (it < P2_GLS + P2_DEC) {
#ifndef P2_SKIP_DEC
            attn_sample_waveitem(F, (it - P2_GLS) * 8 + F.wave); __syncthreads();
#endif
        } else if (it < P2_GLS + P2_DEC + P2_ATT) {
#ifndef P2_SKIP_ATT
            const int a0 = it - P2_GLS - P2_DEC;
            v4u kk[6], vv[6]; bf16x8 qa[4], qb[4];
            attn_issue(F, a0, kk, vv, qa);
            attn_prompt_item(F, a0, kk, vv, qa, true, a0 + 1, qb);
            attn_prompt_item(F, a0 + 1, kk, vv, qb, true, a0 + 2, qa);
            attn_prompt_item(F, a0 + 2, kk, vv, qa, true, a0 + 3, qb);
            attn_prompt_item(F, a0 + 3, kk, vv, qb, false, 0, qa);
            it = itend - 1;
#endif
        }
#if defined(PROBE_PHASE) && PROBE_PHASE >= 103 && PROBE_PHASE <= 106
        if (blockIdx.x == 255 && pcls == PROBE_PHASE) F.tp += __builtin_amdgcn_s_memrealtime() - ti0;
#endif
    }
#if defined(PROBE_PHASE) && PROBE_PHASE == 107
    const unsigned long long tc0 = __builtin_amdgcn_s_memrealtime();
#endif
    kvshift_loop<false>(F);
#if defined(PROBE_PHASE) && PROBE_PHASE == 107
    if (blockIdx.x == 255) F.tp = __builtin_amdgcn_s_memrealtime() - tc0;
#endif
}

__device__ __forceinline__ void p3_kvout(const bf16* K, const bf16* V, float* dst, int g, int W, int nb, size_t rowbase, int rows_per_b, int first, int pos0, int Wdst, size_t gt, size_t ngt) {
    const size_t per_b = (size_t)W * 2 * 64, tot = per_b * nb;
    for (size_t i0 = gt; i0 < tot; i0 += 4 * ngt) { v4u u[4]; float* o[4];
#pragma unroll
        for (int k = 0; k < 4; ++k) { const size_t i = i0 + k * ngt; if (i < tot) { const size_t b = i / per_b, r = i - b * per_b; const int p = (int)(r >> 7), c = (int)(r >> 6) & 1, ch = (int)r & 63;
            u[k] = *(const v4u*)((c ? V : K) + (rowbase + b * rows_per_b + first + p) * 1536 + g * 512 + ch * 8);
            o[k] = dst + ((b * Wdst + pos0 + p) * 2 + c) * 512 + ch * 8; } }
#pragma unroll
        for (int k = 0; k < 4; ++k) if (i0 + k * ngt < tot) {
            *(f32x4*)o[k] = (f32x4){bf_lo(u[k].x), bf_hi(u[k].x), bf_lo(u[k].y), bf_hi(u[k].y)}; *(f32x4*)(o[k] + 4) = (f32x4){bf_lo(u[k].z), bf_hi(u[k].z), bf_lo(u[k].w), bf_hi(u[k].w)}; } }
}
struct MergeRow { float l0, l1, l2; v4u a, b2, c, u0, u1, r0, r1; };
__device__ __forceinline__ void p3_merge_load(const bf16* OA, const bf16* OB, const bf16* RB, const float* LSE, int m, int lane, MergeRow& R) {
    const int hd = lane >> 3, c8 = (lane & 7) * 8, c0 = lane * 16;
    R.l0 = LSE[((size_t)0 * MPAD + m) * 8 + hd]; R.l1 = LSE[((size_t)1 * MPAD + m) * 8 + hd]; R.l2 = LSE[((size_t)2 * MPAD + m) * 8 + hd];
    R.a = *(const v4u*)(OA + (size_t)m * 1536 + hd * 64 + c8); R.b2 = *(const v4u*)(OA + (size_t)m * 1536 + 512 + hd * 64 + c8); R.c = *(const v4u*)(OA + (size_t)m * 1536 + 1024 + hd * 64 + c8);
    R.u0 = *(const v4u*)(OB + (size_t)m * 1024 + c0); R.u1 = *(const v4u*)(OB + (size_t)m * 1024 + c0 + 8);
    R.r0 = *(const v4u*)(RB + (size_t)m * 1024 + c0); R.r1 = *(const v4u*)(RB + (size_t)m * 1024 + c0 + 8);
}
__device__ __forceinline__ void p3_merge(Frame& F) {
    const int gw = blockIdx.x * NWAVES + F.wave, NGW = F.G * NWAVES, lane = F.lane;
    const size_t gt = (size_t)blockIdx.x * NTHR + F.tid, ngt = (size_t)F.G * NTHR;
    const bf16* OA = WSP(bf16, WS_QA); const bf16* OB = WSP(bf16, WS_VB); const bf16* RB = WSP(bf16, WS_RB); const float* LSE = WSP(float, WS_LSE);
    bf16* OAM = WSP(bf16, WS_OAM); bf16* OBN = WSP(bf16, WS_OBN); const float* gn = inptr(F, I_GN);
    float gnv[16];
#pragma unroll
    for (int i = 0; i < 16; ++i) gnv[i] = gn[lane * 16 + i];
    for (int m = NTOK + gw; m < MPAD; m += NGW) {
        *(v4u*)(OAM + (size_t)m * 512 + lane * 8) = (v4u){0u, 0u, 0u, 0u}; *(v4u*)(OBN + (size_t)m * 1024 + lane * 16) = (v4u){0u, 0u, 0u, 0u}; *(v4u*)(OBN + (size_t)m * 1024 + lane * 16 + 8) = (v4u){0u, 0u, 0u, 0u}; }
    int m = gw;
    if (m < NTOK) {
        MergeRow R, Rn; p3_merge_load(OA, OB, RB, LSE, m, lane, R);
        for (;;) {
            const int mn = m + NGW; const bool more = mn < NTOK;
            if (more) p3_merge_load(OA, OB, RB, LSE, mn, lane, Rn);
            {
                const int hd = lane >> 3, c8 = (lane & 7) * 8;
                const float l0 = R.l0, l1 = R.l1, l2 = R.l2;
                const float mx = fmaxf(l0, fmaxf(l1, l2)); float w0 = __expf(l0 - mx), w1 = __expf(l1 - mx), w2 = __expf(l2 - mx); const float iw = 1.0f / (w0 + w1 + w2); w0 *= iw; w1 *= iw; w2 *= iw;
                const v4u a = R.a, b2 = R.b2, c = R.c;
                v4u o;
                o.x = cvt_pk_bf16(w0 * bf_lo(a.x) + w1 * bf_lo(b2.x) + w2 * bf_lo(c.x), w0 * bf_hi(a.x) + w1 * bf_hi(b2.x) + w2 * bf_hi(c.x));
                o.y = cvt_pk_bf16(w0 * bf_lo(a.y) + w1 * bf_lo(b2.y) + w2 * bf_lo(c.y), w0 * bf_hi(a.y) + w1 * bf_hi(b2.y) + w2 * bf_hi(c.y));
                o.z = cvt_pk_bf16(w0 * bf_lo(a.z) + w1 * bf_lo(b2.z) + w2 * bf_lo(c.z), w0 * bf_hi(a.z) + w1 * bf_hi(b2.z) + w2 * bf_hi(c.z));
                o.w = cvt_pk_bf16(w0 * bf_lo(a.w) + w1 * bf_lo(b2.w) + w2 * bf_lo(c.w), w0 * bf_hi(a.w) + w1 * bf_hi(b2.w) + w2 * bf_hi(c.w));
                *(v4u*)(OAM + (size_t)m * 512 + hd * 64 + c8) = o;
            }
            {
                const int c0 = lane * 16;
                const v4u u0 = R.u0, u1 = R.u1, r0 = R.r0, r1 = R.r1;
                float x[16] = {bf_lo(u0.x), bf_hi(u0.x), bf_lo(u0.y), bf_hi(u0.y), bf_lo(u0.z), bf_hi(u0.z), bf_lo(u0.w), bf_hi(u0.w), bf_lo(u1.x), bf_hi(u1.x), bf_lo(u1.y), bf_hi(u1.y), bf_lo(u1.z), bf_hi(u1.z), bf_lo(u1.w), bf_hi(u1.w)};
                float rr[16] = {bf_lo(r0.x), bf_hi(r0.x), bf_lo(r0.y), bf_hi(r0.y), bf_lo(r0.z), bf_hi(r0.z), bf_lo(r0.w), bf_hi(r0.w), bf_lo(r1.x), bf_hi(r1.x), bf_lo(r1.y), bf_hi(r1.y), bf_lo(r1.z), bf_hi(r1.z), bf_lo(r1.w), bf_hi(r1.w)};
                float ss = 0.f;
#pragma unroll
                for (int i = 0; i < 16; ++i) ss += x[i] * x[i];
                ss += __shfl_xor(ss, 1); ss += __shfl_xor(ss, 2); ss += __shfl_xor(ss, 4); ss += __shfl_xor(ss, 8);
                const float rs = 1.0f / sqrtf(ss * (1.0f / 256.0f) + LN_EPS);
                float y[16];
#pragma unroll
                for (int i = 0; i < 16; ++i) { const float gte = rr[i] * __builtin_amdgcn_rcpf(1.0f + __expf(-rr[i])); y[i] = x[i] * rs * gnv[i] * gte; }
                v4u o0, o1; o0.x = cvt_pk_bf16(y[0], y[1]); o0.y = cvt_pk_bf16(y[2], y[3]); o0.z = cvt_pk_bf16(y[4], y[5]); o0.w = cvt_pk_bf16(y[6], y[7]);
                o1.x = cvt_pk_bf16(y[8], y[9]); o1.y = cvt_pk_bf16(y[10], y[11]); o1.z = cvt_pk_bf16(y[12], y[13]); o1.w = cvt_pk_bf16(y[14], y[15]);
                *(v4u*)(OBN + (size_t)m * 1024 + c0) = o0; *(v4u*)(OBN + (size_t)m * 1024 + c0 + 8) = o1;
            }
            if (!more) break;
            R = Rn; m = mn;
        }
    }
    const bf16* KA = WSP(bf16, WS_KA); const bf16* VA = WSP(bf16, WS_VA);
    p3_kvout(KA, VA, F.out + OUT_KVP1, 0, 128, 8, 0, TSEQ, TSEQ - 128, 0, 128, gt, ngt);
    p3_kvout(KA, VA, F.out + OUT_KVP2, 1, 512, 8, 0, TSEQ, TSEQ - 512, 0, 512, gt, ngt);
    p3_kvout(KA, VA, F.out + OUT_KVP3, 2, 2048, 8, 0, TSEQ, TSEQ - 2048, 0, 2048, gt, ngt);
    p3_kvout(KA, VA, F.out + OUT_KVS1, 0, 4, 32, NP, 4, 0, 124, 128, gt, ngt);
    p3_kvout(KA, VA, F.out + OUT_KVS2, 1, 4, 32, NP, 4, 0, 508, 512, gt, ngt);
    p3_kvout(KA, VA, F.out + OUT_KVS3, 2, 4, 32, NP, 4, 0, 2044, 2048, gt, ngt);
}

__device__ __forceinline__ void p6_ln1(Frame& F) {
    const int gw = blockIdx.x * NWAVES + F.wave, NGW = F.G * NWAVES, lane = F.lane;
    float* H = WSP(float, WS_H); bf16* X1B = WSP(bf16, WS_X1B); const float* l1g = inptr(F, I_L1G); const float* l1b = inptr(F, I_L1B);
    f32x4 gg[4], bb[4];
#pragma unroll
    for (int j = 0; j < 4; ++j) { gg[j] = ((const f32x4*)l1g)[lane + 64 * j]; bb[j] = ((const f32x4*)l1b)[lane + 64 * j]; }
    int m = gw; if (m >= MPAD) return;
    f32x4 v[4], vn[4];
#pragma unroll
    for (int j = 0; j < 4; ++j) v[j] = ((const f32x4*)(H + (size_t)m * 1024) + lane)[64 * j];
    for (;;) {
        const int mn = m + NGW; const bool more = mn < MPAD;
        if (more) {
#pragma unroll
            for (int j = 0; j < 4; ++j) vn[j] = ((const f32x4*)(H + (size_t)mn * 1024) + lane)[64 * j]; }
        float s = 0.f;
#pragma unroll
        for (int j = 0; j < 4; ++j) s += (v[j][0] + v[j][1]) + (v[j][2] + v[j][3]);
        const float mean = wave_sum(s) * (1.f / 1024.f); float s2 = 0.f;
#pragma unroll
        for (int j = 0; j < 4; ++j) { v[j] = v[j] - mean; s2 += (v[j][0] * v[j][0] + v[j][1] * v[j][1]) + (v[j][2] * v[j][2] + v[j][3] * v[j][3]); }
        const float rstd = 1.f / sqrtf(wave_sum(s2) * (1.f / 1024.f) + LN_EPS);
        f32x4* hr = (f32x4*)(H + (size_t)m * 1024) + lane;
        unsigned long long* o8 = (unsigned long long*)(X1B + (size_t)m * 1024) + lane;
#pragma unroll
        for (int j = 0; j < 4; ++j) { const f32x4 y = v[j] * rstd * gg[j] + bb[j]; hr[64 * j] = y;
            o8[64 * j] = (unsigned long long)cvt_pk_bf16(y[0], y[1]) | ((unsigned long long)cvt_pk_bf16(y[2], y[3]) << 32); }
        if (!more) break;
#pragma unroll
        for (int j = 0; j < 4; ++j) v[j] = vn[j];
        m = mn;
    }
}

__device__ __forceinline__ unsigned mono_key(float f) { const unsigned u = __float_as_uint(f); return u ^ ((unsigned)((int)u >> 31) | 0x80000000u); }
__device__ __forceinline__ float mono_inv(unsigned k) { return __uint_as_float((k & 0x80000000u) ? (k ^ 0x80000000u) : ~k); }
#define CE_DESC(a, b) do { const unsigned _mx = (a) > (b) ? (a) : (b), _mn = (a) > (b) ? (b) : (a); (a) = _mx; (b) = _mn; } while (0)
template <int J> __device__ __forceinline__ void bitonic_step_desc(unsigned (&v)[16]) {
#pragma unroll
    for (int i = 0; i < 16; ++i) if ((i & J) == 0) CE_DESC(v[i], v[i | J]);
}
template <int K, int J> __device__ __forceinline__ void bitonic_step(unsigned (&v)[16]) {
#pragma unroll
    for (int i = 0; i < 16; ++i) if ((i & J) == 0) { if ((i & K) == 0) CE_DESC(v[i], v[i | J]); else CE_DESC(v[i | J], v[i]); }
}
__device__ __forceinline__ void sort16_desc(unsigned (&v)[16]) {
    bitonic_step<2, 1>(v);
    bitonic_step<4, 2>(v); bitonic_step<4, 1>(v);
    bitonic_step<8, 4>(v); bitonic_step<8, 2>(v); bitonic_step<8, 1>(v);
    bitonic_step_desc<8>(v); bitonic_step_desc<4>(v); bitonic_step_desc<2>(v); bitonic_step_desc<1>(v);
}
__device__ __forceinline__ void merge16_desc(unsigned (&T)[16], const unsigned (&N)[16]) {
#pragma unroll
    for (int k = 0; k < 16; ++k) T[k] = T[k] > N[15 - k] ? T[k] : N[15 - k];
    bitonic_step_desc<8>(T); bitonic_step_desc<4>(T); bitonic_step_desc<2>(T); bitonic_step_desc<1>(T);
}
__device__ __forceinline__ void merge_partner16(unsigned (&T)[16]) {
    unsigned P[16];
#pragma unroll
    for (int k = 0; k < 16; ++k) P[k] = (unsigned)__shfl_xor((int)T[k], 32);
    merge16_desc(T, P);
}
__device__ __forceinline__ void p8_topk_item(Frame& F, int item) {
    const int lane = F.lane, hh = lane >> 5, il = lane & 31;
    const int tb = item >> 3, hd = item & 7; const int row = 32 * tb + il;
    const bf16* QN = WSP(bf16, WS_QN); const bf16* KEYS = WSP(bf16, WS_KEYS); int* EIDX = WSP(int, WS_EIDX); float* GATE = WSP(float, WS_GATE);
    LAS unsigned* LK = (LAS unsigned*)(F.lds + F.wave * 8192);
    unsigned T1[16], T2[16];
    bf16x8 bqh[2][8], kf[8];
#pragma unroll
    for (int half = 0; half < 2; ++half)
#pragma unroll
        for (int s = 0; s < 8; ++s) bqh[half][s] = *(const bf16x8*)(QN + (size_t)row * 2048 + hd * 256 + half * 128 + 16 * s + 8 * hh);
#pragma unroll
    for (int s = 0; s < 8; ++s) kf[s] = *(const bf16x8*)(KEYS + ((size_t)(hd * 2) * 128 + il) * 128 + 8 * hh + 16 * s);
#pragma unroll
    for (int half = 0; half < 2; ++half) {
        const bf16x8 (&bq)[8] = bqh[half];
        unsigned T[16];
#pragma unroll
        for (int k = 0; k < 16; ++k) T[k] = 0u;
        const bf16* kbase = KEYS + ((size_t)(hd * 2 + half) * 128 + il) * 128 + 8 * hh;
#pragma unroll 1
        for (int kt = 0; kt < 4; ++kt) {
            f32x16 acc;
#pragma unroll
            for (int x = 0; x < 16; ++x) acc[x] = 0.f;
#pragma unroll
            for (int s = 0; s < 8; ++s) acc = MFMA32(kf[s], bq[s], acc);
            if (kt < 3 || half == 0) {
                const bf16* kn = kt < 3 ? kbase + (size_t)(32 * (kt + 1)) * 128 : kbase + (size_t)128 * 128;
#pragma unroll
                for (int s = 0; s < 8; ++s) kf[s] = *(const bf16x8*)(kn + 16 * s); }
            unsigned N[16];
#pragma unroll
            for (int x = 0; x < 16; ++x) { const int idx = 32 * kt + crow(x, hh); N[x] = (mono_key(acc[x]) & ~127u) | (unsigned)(127 - idx); }
            sort16_desc(N);
            merge16_desc(T, N);
        }
        merge_partner16(T);
#pragma unroll
        for (int k = 0; k < 16; ++k) { LK[(half * 16 + k) * 64 + lane] = T[k]; if (half == 0) T1[k] = T[k]; else T2[k] = T[k]; }
    }
    float v1s[8], v2[16];
#pragma unroll
    for (int k = 0; k < 16; ++k) v2[k] = mono_inv(T2[k] & ~127u);
#pragma unroll
    for (int i2 = 0; i2 < 8; ++i2) v1s[i2] = mono_inv((hh ? T1[2 * i2 + 1] : T1[2 * i2]) & ~127u);
    unsigned C[16], D[16];
#pragma unroll
    for (int k = 0; k < 16; ++k) { C[k] = 0u; D[k] = 0u; }
    {   int n = 0;
#pragma unroll
        for (int i2 = 0; i2 < 8; ++i2)
#pragma unroll
            for (int c = 0; c < 16; ++c) if ((2 * i2 + 1) * (c + 1) <= 16) { const unsigned key = (mono_key(v1s[i2] + v2[c]) & ~255u) | (unsigned)(255 - (16 * (2 * i2 + hh) + c));
                if (n < 16) C[n] = key; else D[n - 16] = key; ++n; }
    }
    sort16_desc(C); sort16_desc(D); merge16_desc(C, D);
    merge_partner16(C);
    LDS_WAIT(); asm volatile("" ::: "memory");
    float sv[16]; int ex[16]; float mx = NEG_BIG;
#pragma unroll
    for (int k = 0; k < 16; ++k) { const int si = 255 - (int)(C[k] & 255u), a = si >> 4, c = si & 15;
        const unsigned k1 = LK[a * 64 + lane], k2 = LK[(16 + c) * 64 + lane];
        ex[k] = (127 - (int)(k1 & 127u)) * 128 + (127 - (int)(k2 & 127u)); sv[k] = mono_inv(k1 & ~127u) + mono_inv(k2 & ~127u); mx = fmaxf(mx, sv[k]); }
    float den = 0.f;
#pragma unroll
    for (int k = 0; k < 16; ++k) { sv[k] = __expf(sv[k] - mx); den += sv[k]; }
    const float iden = 1.0f / den;
    if (hh == 0 && row < NTOK) {
#pragma unroll
        for (int k4 = 0; k4 < 4; ++k4) { *(int4*)(EIDX + (size_t)row * 128 + hd * 16 + 4 * k4) = make_int4(ex[4 * k4], ex[4 * k4 + 1], ex[4 * k4 + 2], ex[4 * k4 + 3]);
            *(f32x4*)(GATE + (size_t)row * 128 + hd * 16 + 4 * k4) = (f32x4){sv[4 * k4] * iden, sv[4 * k4 + 1] * iden, sv[4 * k4 + 2] * iden, sv[4 * k4 + 3] * iden}; } }
    LDS_WAIT(); asm volatile("" ::: "memory");
}

constexpr size_t WS_ACTP = WS_QB, WS_COEF = WS_KA, WS_PEERO = WS_RB, WS_X1H = WS_VA;
static_assert(WS_ACTP + (size_t)8 * NTOK * 128 * 4 <= WS_RB && WS_PEERO + (size_t)NTOK * 1024 * 4 <= WS_GB, "peer buffers");
__device__ __forceinline__ float gelu_erf(float x) { return 0.5f * x * (1.0f + erff(x * 0.70710678118654752f)); }
#define DPP_F(x, ctrl) __uint_as_float((unsigned)__builtin_amdgcn_mov_dpp((int)__float_as_uint(x), (ctrl), 0xf, 0xf, true))
__device__ __forceinline__ float dot16_fp8(const float (&x)[16], const v4u u) {
    float a = 0.f;
#pragma unroll
    for (int q = 0; q < 4; ++q) { const f32x2_t lo = __builtin_amdgcn_cvt_pk_f32_fp8((int)u[q], false), hi = __builtin_amdgcn_cvt_pk_f32_fp8((int)u[q], true);
        a += x[4 * q] * lo.x + x[4 * q + 1] * lo.y + x[4 * q + 2] * hi.x + x[4 * q + 3] * hi.y; }
    return a;
}
typedef float f32x4_t __attribute__((ext_vector_type(4)));
typedef int i32x4_t __attribute__((ext_vector_type(4)));
#ifndef PEER_CVT_VIA_F32
#define PEER_CVT_VIA_F32 0
#endif
#ifndef PEER_DOT_F32
#define PEER_DOT_F32 0
#endif
#if PEER_DOT_F32
#define PEER_DOT2(d, a, b) do { const h2_t a__ = (a), b__ = (b); d += (float)a__.x * (float)b__.x + (float)a__.y * (float)b__.y; } while (0)
#else
#define PEER_DOT2(d, a, b) d = __builtin_amdgcn_fdot2((a), (b), d, false)
#endif
template <bool HI> __device__ __forceinline__ h2_t fp8x2_to_h2(int w) {
#if PEER_CVT_VIA_F32
    const f32x2_t f = __builtin_amdgcn_cvt_pk_f32_fp8(w, HI); return (h2_t){(_Float16)f.x, (_Float16)f.y};
#else
    return __builtin_amdgcn_cvt_scalef32_pk_f16_fp8(w, 1.0f, HI);
#endif
}
template <unsigned EMASK> __device__ __forceinline__ void peer_u_phase_t(Frame& F) {
    const int lane = F.lane, p = lane >> 3, q = lane & 7, c = blockIdx.x & 7, wv = (blockIdx.x >> 3) * NWAVES + F.wave, nwv = (F.G >> 3) * NWAVES;
    const int* EIDX = WSP(int, WS_EIDX) + 16 * p; float* ACTP = WSP(float, WS_ACTP) + (size_t)c * NTOK * 128 + 16 * p + 2 * q;
    const unsigned char* U8 = WSP(unsigned char, WS_UT) + ((size_t)c * 16384 << 7) + 16 * q;
#define PU_LOADE(EV, M) do { _Pragma("unroll") for (int t_ = 0; t_ < 4; ++t_) EV[t_] = *(const i32x4_t*)(EIDX + (size_t)(M) * 128 + 4 * t_); } while (0)
#define PU_ISSUE(UR, EV) do { _Pragma("unroll") for (int g = 0; g < 16; ++g) UR[g] = *(const v4u*)(U8 + (((unsigned)EV[g >> 2][g & 3] & EMASK) << 7)); } while (0)
#define PU_BODY(UR, UN, M) do { const int m_ = (M); const int m1_ = m_ + nwv, m2_ = m_ + 2 * nwv; \
        if (m1_ < NTOK) PU_ISSUE(UN, ev); \
        if (m2_ < NTOK) PU_LOADE(ev, m2_); \
        const float* xf_ = (const float*)(F.ws + WS_H) + (size_t)m_ * 1024 + 128 * c + 16 * q; \
        const f32x4 xa_ = *(const f32x4*)xf_, xb_ = *(const f32x4*)(xf_ + 4), xc_ = *(const f32x4*)(xf_ + 8), xd_ = *(const f32x4*)(xf_ + 12); \
        const h2_t xh[8] = {(h2_t){(_Float16)xa_[0], (_Float16)xa_[1]}, (h2_t){(_Float16)xa_[2], (_Float16)xa_[3]}, (h2_t){(_Float16)xb_[0], (_Float16)xb_[1]}, (h2_t){(_Float16)xb_[2], (_Float16)xb_[3]}, (h2_t){(_Float16)xc_[0], (_Float16)xc_[1]}, (h2_t){(_Float16)xc_[2], (_Float16)xc_[3]}, (h2_t){(_Float16)xd_[0], (_Float16)xd_[1]}, (h2_t){(_Float16)xd_[2], (_Float16)xd_[3]}}; \
        float a[16]; \
        _Pragma("unroll") for (int g = 0; g < 16; ++g) { float d_ = 0.f; \
            _Pragma("unroll") for (int t_ = 0; t_ < 4; ++t_) { PEER_DOT2(d_, fp8x2_to_h2<false>((int)UR[g][t_]), xh[2 * t_]); PEER_DOT2(d_, fp8x2_to_h2<true>((int)UR[g][t_]), xh[2 * t_ + 1]); } \
            a[g] = d_; if ((g & 1) == 1 && g < 15) asm volatile("" : "+v"(a[g - 1]), "+v"(a[g]), "+v"(UR[(g + 1) & 15]), "+v"(UR[(g + 2) & 15])); } \
        float b8[8], b4[4], b2[2]; \
        { const bool up = (q & 4) != 0; _Pragma("unroll") for (int k = 0; k < 8; ++k) { const float send = up ? a[k] : a[k + 8], keep = up ? a[k + 8] : a[k]; b8[k] = keep + DPP_F(send, 0x141); } } \
        { const bool up = (q & 2) != 0; _Pragma("unroll") for (int k = 0; k < 4; ++k) { const float send = up ? b8[k] : b8[k + 4], keep = up ? b8[k + 4] : b8[k]; b4[k] = keep + DPP_F(send, 0x4E); } } \
        { const bool up = (q & 1) != 0; _Pragma("unroll") for (int k = 0; k < 2; ++k) { const float send = up ? b4[k] : b4[k + 2], keep = up ? b4[k + 2] : b4[k]; b2[k] = keep + DPP_F(send, 0xB1); } } \
        *(f32x2_t*)(ACTP + (size_t)m_ * 128) = (f32x2_t){b2[0], b2[1]}; } while (0)
    int m = wv; if (m >= NTOK) return;
    i32x4_t ev[4];
    PU_LOADE(ev, m);
    v4u ua[16], ub[16];
    PU_ISSUE(ua, ev);
    if (m + nwv < NTOK) PU_LOADE(ev, m + nwv);
    for (;;) {
        PU_BODY(ua, ub, m); m += nwv; if (m >= NTOK) break;
        PU_BODY(ub, ua, m); m += nwv; if (m >= NTOK) break;
    }
#undef PU_LOADE
#undef PU_ISSUE
#undef PU_BODY
}
__device__ __forceinline__ void peer_u_phase(Frame& F) { peer_u_phase_t<0xffffffffu>(F); }
__device__ __forceinline__ void peer_coef_phase(Frame& F) {
    const int gw = blockIdx.x * NWAVES + F.wave, NGW = F.G * NWAVES, lane = F.lane;
    const float* ACTP = WSP(float, WS_ACTP); const float* GATE = WSP(float, WS_GATE); float* COEF = WSP(float, WS_COEF);
    int m = gw; if (m >= NTOK) return;
    float av[2][8], gv[2], an[2][8], gnx[2];
#pragma unroll
    for (int hf = 0; hf < 2; ++hf) { const int k = lane + 64 * hf; gv[hf] = GATE[(size_t)m * 128 + k];
#pragma unroll
        for (int c = 0; c < 8; ++c) av[hf][c] = ACTP[((size_t)c * NTOK + m) * 128 + k]; }
    for (;;) {
        const int mn = m + NGW; const bool more = mn < NTOK;
        if (more) {
#pragma unroll
            for (int hf = 0; hf < 2; ++hf) { const int k = lane + 64 * hf; gnx[hf] = GATE[(size_t)mn * 128 + k];
#pragma unroll
                for (int c = 0; c < 8; ++c) an[hf][c] = ACTP[((size_t)c * NTOK + mn) * 128 + k]; } }
#pragma unroll
        for (int hf = 0; hf < 2; ++hf) { const int k = lane + 64 * hf; float a = 0.f;
#pragma unroll
            for (int c = 0; c < 8; ++c) a += av[hf][c];
            COEF[(size_t)m * 128 + k] = gv[hf] * gelu_erf(a * (1.0f / U_SCALE)); }
        if (!more) break;
#pragma unroll
        for (int hf = 0; hf < 2; ++hf) { gv[hf] = gnx[hf];
#pragma unroll
            for (int c = 0; c < 8; ++c) av[hf][c] = an[hf][c]; }
        m = mn;
    }
}
__device__ __forceinline__ void peer_v_phase(Frame& F) {
    const int lane = F.lane, p = lane >> 3, q = lane & 7, c = blockIdx.x & 7, wv = (blockIdx.x >> 3) * NWAVES + F.wave, nwv = (F.G >> 3) * NWAVES;
    const int* EIDX = WSP(int, WS_EIDX) + 16 * p; const float* COEF = WSP(float, WS_COEF) + 16 * p; bf16* PEERO = WSP(bf16, WS_PEERO) + 128 * c + 16 * q + 2 * p;
    const unsigned char* V8 = WSP(unsigned char, WS_VT) + ((size_t)c * 16384 << 7) + 16 * q;
    int m = wv; if (m >= NTOK) return;
    i32x4_t ev[4];
#pragma unroll
    for (int t = 0; t < 4; ++t) ev[t] = *(const i32x4_t*)(EIDX + (size_t)m * 128 + 4 * t);
    v4u vr[16];
#pragma unroll
    for (int g = 0; g < 16; ++g) vr[g] = *(const v4u*)(V8 + ((unsigned)ev[g >> 2][g & 3] << 7));
    for (;;) {
        f32x4_t cv[4];
#pragma unroll
        for (int t = 0; t < 4; ++t) cv[t] = *(const f32x4_t*)(COEF + (size_t)m * 128 + 4 * t);
        const int mn = m + nwv; const bool more = mn < NTOK;
        if (more) {
#pragma unroll
            for (int t = 0; t < 4; ++t) ev[t] = *(const i32x4_t*)(EIDX + (size_t)mn * 128 + 4 * t); }
        h2_t acc[8];
#pragma unroll
        for (int i = 0; i < 8; ++i) acc[i] = (h2_t){(_Float16)0.f, (_Float16)0.f};
#pragma unroll
        for (int g = 0; g < 16; ++g) { const _Float16 cfh = (_Float16)cv[g >> 2][g & 3]; const h2_t cf2 = {cfh, cfh};
#pragma unroll
            for (int t = 0; t < 4; ++t) { acc[2 * t] += fp8x2_to_h2<false>((int)vr[g][t]) * cf2; acc[2 * t + 1] += fp8x2_to_h2<true>((int)vr[g][t]) * cf2; }
            if ((g & 3) == 3 && g < 15) asm volatile("" : "+v"(acc[0]), "+v"(acc[1]), "+v"(acc[2]), "+v"(acc[3]), "+v"(acc[4]), "+v"(acc[5]), "+v"(acc[6]), "+v"(acc[7]), "+v"(vr[(g + 1) & 15]), "+v"(vr[(g + 2) & 15]), "+v"(vr[(g + 3) & 15]), "+v"(vr[(g + 4) & 15])); }
        __builtin_amdgcn_sched_barrier(0);
        if (more) {
#pragma unroll
            for (int g = 0; g < 16; ++g) vr[g] = *(const v4u*)(V8 + ((unsigned)ev[g >> 2][g & 3] << 7)); }
        __builtin_amdgcn_sched_barrier(0);
        unsigned w[8];
#pragma unroll
        for (int i = 0; i < 8; ++i) w[i] = __builtin_bit_cast(unsigned, acc[i]);
        h2_t r4[4], r2[2], r1;
        { const bool up = (lane & 32) != 0;
#pragma unroll
          for (int k = 0; k < 4; ++k) { const unsigned send = up ? w[k] : w[k + 4], keep = up ? w[k + 4] : w[k]; r4[k] = __builtin_bit_cast(h2_t, keep) + __builtin_bit_cast(h2_t, (unsigned)__shfl_xor((int)send, 32)); } }
        { const bool up = (lane & 16) != 0;
#pragma unroll
          for (int k = 0; k < 2; ++k) { const unsigned a_ = __builtin_bit_cast(unsigned, r4[k]), b_ = __builtin_bit_cast(unsigned, r4[k + 2]); const unsigned send = up ? a_ : b_, keep = up ? b_ : a_; r2[k] = __builtin_bit_cast(h2_t, keep) + __builtin_bit_cast(h2_t, (unsigned)__shfl_xor((int)send, 16)); } }
        { const bool up = (lane & 8) != 0; const unsigned a_ = __builtin_bit_cast(unsigned, r2[0]), b_ = __builtin_bit_cast(unsigned, r2[1]); const unsigned send = up ? a_ : b_, keep = up ? b_ : a_;
          r1 = __builtin_bit_cast(h2_t, keep) + __builtin_bit_cast(h2_t, (unsigned)__builtin_amdgcn_mov_dpp((int)send, 0x128, 0xf, 0xf, true)); }
        *(unsigned*)(PEERO + (size_t)m * 1024) = cvt_pk_bf16((float)r1.x * (1.0f / V_SCALE), (float)r1.y * (1.0f / V_SCALE));
        if (!more) break;
        m = mn;
    }
}
__device__ __forceinline__ void peer_ln2_phase(Frame& F) {
    const int gw = blockIdx.x * NWAVES + F.wave, NGW = F.G * NWAVES, lane = F.lane;
    const float* X1 = WSP(float, WS_H); const bf16* PEERO = WSP(bf16, WS_PEERO); const float* l2g = inptr(F, I_L2G); const float* l2b = inptr(F, I_L2B);
    f32x4 gg[4], bb[4];
#pragma unroll
    for (int t = 0; t < 4; ++t) { gg[t] = *(const f32x4*)(l2g + 4 * lane + 256 * t); bb[t] = *(const f32x4*)(l2b + 4 * lane + 256 * t); }
    int m = gw; if (m >= NTOK) return;
    f32x4 xa[4], xn[4]; v2u pa[4], pn[4];
#pragma unroll
    for (int t = 0; t < 4; ++t) { xa[t] = *(const f32x4*)(X1 + (size_t)m * 1024 + 4 * lane + 256 * t); pa[t] = *(const v2u*)(PEERO + (size_t)m * 1024 + 4 * lane + 256 * t); }
    for (;;) {
        const int mn = m + NGW; const bool more = mn < NTOK;
        if (more) {
#pragma unroll
            for (int t = 0; t < 4; ++t) { xn[t] = *(const f32x4*)(X1 + (size_t)mn * 1024 + 4 * lane + 256 * t); pn[t] = *(const v2u*)(PEERO + (size_t)mn * 1024 + 4 * lane + 256 * t); } }
        float acc[16]; float s = 0.f;
#pragma unroll
        for (int t = 0; t < 4; ++t) { const float pz[4] = {bf_lo(pa[t].x), bf_hi(pa[t].x), bf_lo(pa[t].y), bf_hi(pa[t].y)};
#pragma unroll
            for (int i = 0; i < 4; ++i) { acc[4 * t + i] = ALPHA * xa[t][i] + pz[i]; s += acc[4 * t + i]; } }
        const float mean = wave_sum(s) * (1.f / 1024.f); float s2 = 0.f;
#pragma unroll
        for (int i = 0; i < 16; ++i) { acc[i] -= mean; s2 += acc[i] * acc[i]; }
        const float rstd = 1.f / sqrtf(wave_sum(s2) * (1.f / 1024.f) + LN_EPS);
        float* yo = m < NP ? F.out + OUT_YP + (size_t)m * 1024 : F.out + OUT_YS + (size_t)(m - NP) * 1024;
#pragma unroll
        for (int t = 0; t < 4; ++t) { const int cc = 4 * lane + 256 * t;
            *(f32x4*)(yo + cc) = (f32x4){acc[4 * t] * rstd * gg[t][0] + bb[t][0], acc[4 * t + 1] * rstd * gg[t][1] + bb[t][1], acc[4 * t + 2] * rstd * gg[t][2] + bb[t][2], acc[4 * t + 3] * rstd * gg[t][3] + bb[t][3]}; }
        if (!more) break;
#pragma unroll
        for (int t = 0; t < 4; ++t) { xa[t] = xn[t]; pa[t] = pn[t]; }
        m = mn;
    }
}

template <class Epi> __device__ __forceinline__ void skinny_sample_gemm(Frame& F, const bf16* A, const bf16* Bt, int K, const Epi& epi) {
    typedef float f32x4a __attribute__((ext_vector_type(4)));
    const int lane = F.lane, r = lane & 15, kg = lane >> 4;
    for (int strip = blockIdx.x; strip < 64; strip += F.G) {
        const bf16* ap = A + (size_t)(NP + 16 * F.wave + r) * K + 8 * kg;
        const bf16* bp = Bt + (size_t)(16 * strip + r) * K + 8 * kg;
        f32x4a acc = {0.f, 0.f, 0.f, 0.f};
        for (int s0 = 0; s0 < K / 32; s0 += 8) { bf16x8 af[8], bfr[8];
#pragma unroll
            for (int u = 0; u < 8; ++u) { af[u] = *(const bf16x8*)(ap + 32 * (s0 + u)); bfr[u] = *(const bf16x8*)(bp + 32 * (s0 + u)); }
#pragma unroll
            for (int u = 0; u < 8; ++u) acc = __builtin_amdgcn_mfma_f32_16x16x32_bf16(af[u], bfr[u], acc, 0, 0, 0); }
#pragma unroll
        for (int i = 0; i < 4; ++i) epi(NP + 16 * F.wave + 4 * kg + i, 16 * strip + r, acc[i]);
    }
}

struct Args { const float* in[22]; float* out; unsigned char* ws; int ph_lo, ph_hi; };
constexpr int NPHASE = 14;
__global__ void __launch_bounds__(NTHR, 2) mk_fwd(Args args) {
    extern __shared__ __attribute__((aligned(16))) unsigned char lds[];
    Frame F;
    F.lds = (LAS unsigned char*)lds; F.MISC = (volatile LAS unsigned*)(F.lds + MISC_OFF);
    F.tid = threadIdx.x; F.lane = F.tid & 63; F.wave = __builtin_amdgcn_readfirstlane(F.tid >> 6); F.G = gridDim.x;
    F.ws = args.ws; F.out = args.out; F.ctl = (gu32*)(args.ws + WS_CTL); F.tp = 0ull;
    for (int u = F.tid; u < (LDS_BYTES - MISC_OFF) / 4; u += NTHR) ((LAS unsigned*)(F.lds + MISC_OFF))[u] = 0u;
    __syncthreads();
    if (F.tid < 22) ((LAS unsigned long long*)(F.lds + PTR_OFF))[F.tid] = (unsigned long long)args.in[F.tid];
    __syncthreads();
    const int lo = args.ph_lo, hi = args.ph_hi;
    const bool multi = (hi - lo) > 1;
    XcdBarrier bar; bar.bar = (unsigned*)(F.ctl + CW_BAR); bar.x = 0; bar.st = nullptr;
    if (multi) bar = xcd_barrier_post((unsigned*)(F.ctl + CW_BAR), F.MISC + 8);
#ifdef ONLY_PHASE
#define IN(k) ((k) == ONLY_PHASE && lo <= (k) && (k) < hi)
#else
#define IN(k) (lo <= (k) && (k) < hi)
#endif
#ifdef PROBE_PHASE
    unsigned long long t_prev = __builtin_amdgcn_s_memrealtime(), t_probe = 0ull;
#define STAMP(k) do { const unsigned long long _t = __builtin_amdgcn_s_memrealtime(); if ((k) == PROBE_PHASE && blockIdx.x == 0) t_probe = _t - t_prev; t_prev = _t; } while (0)
#else
#define STAMP(k) do { } while (0)
#endif
#define SEAM(k) do { if (IN(k) && IN((k) + 1)) xcd_barrier(bar); STAMP(k); } while (0)
    if (IN(0)) { p0_prologue(F); }
    if (IN(0) && IN(1)) { cooperative_groups::this_grid().sync(); } STAMP(0);
    if (IN(1)) {
        if ((int)blockIdx.x >= F.G - NCOPYWG) kvshift_loop<true>(F);
        else {
        pg8::Gemm g{WSP(bf16, WS_XB), WSP(bf16, WS_WIN), MPAD, NPROJ, 1024, MPAD / 256 - 1}; pg8::StaticOrder S; S.init(MPAD, NPROJ, F.G - NCOPYWG, (int)blockIdx.x);
        pg8::EpiProj E{WSP(bf16, WS_QA), WSP(bf16, WS_KA), WSP(bf16, WS_VA), WSP(bf16, WS_QB), WSP(bf16, WS_KB), WSP(bf16, WS_VB), WSP(bf16, WS_RB), WSP(bf16, WS_GA), WSP(bf16, WS_GB)};
        pg8::gemm_phase<pg8::EpiProj, pg8::StaticOrder, true, true>(F.lds, g, S, E);
        if (F.tid == 0) __hip_atomic_fetch_add(F.ctl + CW_GDONE, 1u, RLX_AGENT);
        }
    } SEAM(1);
    if (IN(2)) { p2_prep(F); } SEAM(2);
    if (IN(3)) { p2_mixers(F); } SEAM(3);
    if (IN(4)) { p3_merge(F); } SEAM(4);
    if (IN(5)) {
        bf16* T1 = WSP(bf16, WS_T1); bf16* MIXp = WSP(bf16, WS_MIX); const bf16* GAp = WSP(bf16, WS_GA); const bf16* GBp = WSP(bf16, WS_GB);
        { pg8::Gemm g{WSP(bf16, WS_OAM), WSP(bf16, WS_WA), NP, 1024, 512, -1}; pg8::StaticOrder S; S.init(NP, 1024, F.G, (int)blockIdx.x, false);
          pg8::EpiGate<false> E{WSP(bf16, WS_GA), nullptr, WSP(bf16, WS_T1)};
          pg8::gemm_phase<pg8::EpiGate<false>, pg8::StaticOrder, true, true>(F.lds, g, S, E); }
        skinny_sample_gemm(F, WSP(bf16, WS_OAM), WSP(bf16, WS_WA), 512, [=](int row, int col, float v) { const size_t o = (size_t)row * 1024 + col; T1[o] = f2bf(pg8::sigmoidf_(bf2f(GAp[o])) * v); });
        VM_WAIT(); __syncthreads();
        { pg8::Gemm g{WSP(bf16, WS_OBN), WSP(bf16, WS_WB), NP, 1024, 1024, -1}; pg8::StaticOrder S; S.init(NP, 1024, F.G, (int)blockIdx.x, false);
          pg8::EpiGate<true> E{WSP(bf16, WS_GB), WSP(bf16, WS_T1), WSP(bf16, WS_MIX)};
          pg8::gemm_phase<pg8::EpiGate<true>, pg8::StaticOrder, true, true>(F.lds, g, S, E); }
        skinny_sample_gemm(F, WSP(bf16, WS_OBN), WSP(bf16, WS_WB), 1024, [=](int row, int col, float v) { const size_t o = (size_t)row * 1024 + col; MIXp[o] = f2bf(bf2f(T1[o]) + pg8::sigmoidf_(bf2f(GBp[o])) * v); });
    } SEAM(5);
    if (IN(6)) {
        pg8::Gemm g{WSP(bf16, WS_MIX), WSP(bf16, WS_WO), NP, 1024, 1024, -1}; pg8::StaticOrder S; S.init(NP, 1024, F.G, (int)blockIdx.x, false);
        pg8::EpiOut E{inptr(F, I_XP), inptr(F, I_XS), WSP(float, WS_H), NP, NTOK, ALPHA};
        pg8::gemm_phase<pg8::EpiOut, pg8::StaticOrder, true, true>(F.lds, g, S, E);
        const float* xsp = inptr(F, I_XS); float* Hp = WSP(float, WS_H);
        skinny_sample_gemm(F, WSP(bf16, WS_MIX), WSP(bf16, WS_WO), 1024, [=](int row, int col, float v) { Hp[(size_t)row * 1024 + col] = ALPHA * xsp[(size_t)(row - NP) * 1024 + col] + v; });
    } SEAM(6);
    if (IN(7)) { p6_ln1(F); } SEAM(7);
    if (IN(8)) {
        pg8::Gemm g{WSP(bf16, WS_X1B), WSP(bf16, WS_WQ), MPAD, 2048, 1024, MPAD / 256 - 1}; pg8::StaticOrder S; S.init(MPAD, 2048, F.G, (int)blockIdx.x);
        pg8::EpiHeadNorm E{WSP(bf16, WS_QN), 2048, F.lds + STATS_OFF, LN_EPS};
        pg8::gemm_phase<pg8::EpiHeadNorm, pg8::StaticOrder, true, true>(F.lds, g, S, E);
    } SEAM(8);
    if (IN(9)) {
        const int gw = blockIdx.x * NWAVES + F.wave, NGW = F.G * NWAVES;
        for (int it = gw; it < (NP / 32) * 8; it += NGW) p8_topk_item(F, it);
        for (int e = gw; e < 64 * (NS / 32) * 8; e += NGW) if ((e & 63) == 0) p8_topk_item(F, (NP / 32) * 8 + (e >> 6));
    } SEAM(9);
#if defined(PROBE_PHASE) && PROBE_PHASE >= 300 && PROBE_PHASE < 310
    if (IN(10)) { const unsigned long long td0 = __builtin_amdgcn_s_memrealtime();
        if (PROBE_PHASE == 300) peer_u_phase_t<2047u>(F); else if (PROBE_PHASE == 301) peer_u_phase_t<8191u>(F); else peer_u_phase_t<0xffffffffu>(F);
        xcd_barrier(bar); if (blockIdx.x == 0) F.tp = __builtin_amdgcn_s_memrealtime() - td0; }
#endif
    if (IN(10)) { peer_u_phase(F); } SEAM(10);
    if (IN(11)) { peer_coef_phase(F); } SEAM(11);
    if (IN(12)) { peer_v_phase(F); } SEAM(12);
    if (IN(13)) { peer_ln2_phase(F); }
#ifdef PROBE_PHASE
    if (PROBE_PHASE == 13) { xcd_barrier(bar); STAMP(13); }
    if (PROBE_PHASE == 200 || PROBE_PHASE == 201) {
        unsigned* xm = (unsigned*)(F.ws + WS_END);
        if (F.tid == 0) __hip_atomic_store(xm + blockIdx.x, xb_xcc_id() + 1u, RLX_AGENT);
        xcd_barrier(bar);
        if (blockIdx.x == 0 && F.tid == 0) { bool ok = true;
            for (int b = 0; b < (int)gridDim.x; ++b) { const unsigned a = __hip_atomic_load(xm + b, RLX_AGENT), r = __hip_atomic_load(xm + (PROBE_PHASE == 200 ? (b & 7) : (b & ~31)), RLX_AGENT); if (a != r) ok = false; }
            t_probe = ok ? 50000ull : 0ull; }
    }
    if ((PROBE_PHASE >= 100 && PROBE_PHASE < 200) || PROBE_PHASE >= 300) t_probe = F.tp;
    if (F.tid == 0 && t_probe != 0ull) { const unsigned long long t0 = __builtin_amdgcn_s_memrealtime(); while (__builtin_amdgcn_s_memrealtime() - t0 < PROBE_GAIN * t_probe) __builtin_amdgcn_s_sleep(8); }
#endif
#undef IN
#undef SEAM
}

extern "C" void kernel_launch(void* const* d_in, const int* in_sizes, int n_in, void* d_out, int out_size, void* d_ws, size_t ws_size, hipStream_t stream) {
    static int grid = 0;
    if (grid == 0) {
        if (n_in != 22 || (size_t)out_size != OUT_TOTAL || ws_size < WS_END) { fprintf(stderr, "kernel_launch: unexpected shapes: n_in %d out %d ws %zu (need >= %zu)\n", n_in, out_size, ws_size, (size_t)WS_END); grid = -1; return; }
        int dev = 0, cus = 0, per_cu = 0;
        if (hipGetDevice(&dev) != hipSuccess || hipDeviceGetAttribute(&cus, hipDeviceAttributeMultiprocessorCount, dev) != hipSuccess) { grid = -1; return; }
        if (hipFuncSetAttribute((const void*)mk_fwd, hipFuncAttributeMaxDynamicSharedMemorySize, LDS_BYTES) != hipSuccess) { fprintf(stderr, "kernel_launch: hipFuncSetAttribute failed\n"); grid = -1; return; }
        if (hipOccupancyMaxActiveBlocksPerMultiprocessor(&per_cu, (const void*)mk_fwd, NTHR, LDS_BYTES) != hipSuccess || per_cu < 1) fprintf(stderr, "kernel_launch: occupancy query reports %d blocks per CU\n", per_cu);
        (void)hipGetLastError();
        grid = cus;
    }
    if (grid < 0) return;
    (void)hipMemsetAsync((char*)d_ws + WS_CTL, 0, CTL_ZERO_BYTES, stream);
    Args a{};
    for (int i = 0; i < 22; ++i) a.in[i] = (const float*)d_in[i];
    a.out = (float*)d_out; a.ws = (unsigned char*)d_ws;
#if MK_SINGLE
    a.ph_lo = 0; a.ph_hi = NPHASE;
    void* kargs[] = {&a};
    hipError_t e = hipLaunchCooperativeKernel((const void*)mk_fwd, dim3(grid), dim3(NTHR), kargs, LDS_BYTES, stream);
    if (e != hipSuccess) fprintf(stderr, "kernel_launch: cooperative launch failed: %s\n", hipGetErrorString(e));
#else
    for (int p = 0; p < NPHASE; ++p) { a.ph_lo = p; a.ph_hi = p + 1; hipLaunchKernelGGL(mk_fwd, dim3(grid), dim3(NTHR), LDS_BYTES, stream, a); }
#endif
}
```

```cpp
#include <hip/hip_runtime.h>
#include <hip/hip_cooperative_groups.h>
#include <cstdio>
#include <cstdint>
#ifndef MK_SINGLE
#define MK_SINGLE 1
#endif
namespace pg8 {
#define PG8_LAS __attribute__((address_space(3)))
typedef unsigned short bf16_t;
typedef short bf16x8 __attribute__((ext_vector_type(8)));
typedef float f32x4 __attribute__((ext_vector_type(4)));
typedef unsigned u32x4 __attribute__((ext_vector_type(4)));
constexpr int BM = 256, BK = 64, HALF = 128, HTB = HALF * BK * 2  , STAGE_BYTES = 8 * HTB, NXCD = 8, WGM = 8;

__host__ __device__ __forceinline__ int lds_byte(int r, int c) { const int st = (r >> 4) * 2 + (c >> 5), rr = r & 15, cc = c & 31, ob = rr * 64 + cc * 2; return st * 1024 + (ob ^ (((ob >> 9) & 1) << 5)); }
__host__ __device__ __forceinline__ void stage_rc(int b, int& R, int& C) { const int st = b / 1024, sb = b % 1024, swz = sb ^ (((sb >> 9) & 1) << 5); R = (st >> 1) * 16 + swz / 64; C = (st & 1) * 32 + (swz % 64) / 2; }
__host__ __device__ __forceinline__ int perm32(int rho) { const int n = rho >> 4, i = rho & 15; return 8 * (i >> 2) + 4 * n + (i & 3); }

struct Unit { int pm, pn; };
struct Gemm { const bf16_t* A; const bf16_t* Bt; int M, N, K; int half_pm = -1; };

struct StaticOrder {
    int nM, nN, nwg, G, c, nfull;
    __host__ __device__ void init(int M, int N, int G_, int c_, bool half = true) { nM = half ? M / BM - 1 : M / BM; nN = N / BM; nfull = nM * nN; nwg = half ? nfull + nN : nfull; G = G_; c = c_; }
    __host__ __device__ bool next(int i, Unit& u) const {
        const long L = (long)i * G + c; if (L >= nwg) return false;
        if (L >= nfull) { u.pm = nM; u.pn = (int)(L - nfull); return true; }
        int wgid = (int)L; { const int q = nfull / NXCD, r = nfull % NXCD, xcd = wgid % NXCD, off = wgid / NXCD; wgid = (xcd < r ? xcd * (q + 1) : r * (q + 1) + (xcd - r) * q) + off; }
        const int nig = WGM * nN, gid = wgid / nig, fm = gid * WGM, gsz = (nM - fm) < WGM ? (nM - fm) : WGM;
        u.pm = fm + ((wgid % nig) % gsz); u.pn = (wgid % nig) / gsz; return true;
    }
    __device__ __forceinline__ void a_ready(const Unit&) const {}
    __device__ __forceinline__ void done(const Unit&) const {}
};


typedef float f32x2 __attribute__((ext_vector_type(2)));
typedef __bf16 bf16x2_t __attribute__((ext_vector_type(2)));
__device__ __forceinline__ unsigned cvt_pk_bf16(float lo, float hi) { f32x2 v = {lo, hi}; bf16x2_t b = __builtin_convertvector(v, bf16x2_t); return __builtin_bit_cast(unsigned, b); }
__device__ __forceinline__ float bf_lo(unsigned w) { return __uint_as_float(w << 16); }
__device__ __forceinline__ float bf_hi(unsigned w) { return __uint_as_float(w & 0xffff0000u); }
__device__ __forceinline__ float sigmoidf_(float x) { return __builtin_amdgcn_rcpf(1.0f + __expf(-x)); }

struct EpiProj {
    static constexpr bool PERM = true, AFTER_DRAIN = false;
    bf16_t *qa, *ka, *va, *qb, *kb, *vb, *rb, *ga, *gb;
    __device__ __forceinline__ void operator()(const f32x4 (&acc)[2][2][4][2], const Unit& u, int wr, int wc, int fr, int fq) const {
        const int pn = u.pn; bf16_t* base; int ldc, ct; float sc = 1.f;
        if (pn < 6) { base = qa; ldc = 1536; ct = pn; sc = 0.125f; }
        else if (pn < 12) { base = ka; ldc = 1536; ct = pn - 6; }
        else if (pn < 18) { base = va; ldc = 1536; ct = pn - 12; }
        else if (pn < 20) { base = qb; ldc = 512; ct = pn - 18; }
        else if (pn < 22) { base = kb; ldc = 512; ct = pn - 20; }
        else if (pn < 26) { base = vb; ldc = 1024; ct = pn - 22; }
        else if (pn < 30) { base = rb; ldc = 1024; ct = pn - 26; }
        else if (pn < 34) { base = ga; ldc = 1024; ct = pn - 30; }
        else { base = gb; ldc = 1024; ct = pn - 34; }
        const int row0 = u.pm * BM + wr * 64 + fr, col0 = ct * BM + wc * 32 + 8 * fq;
#pragma unroll
        for (int ai = 0; ai < 2; ++ai)
#pragma unroll
            for (int m = 0; m < 4; ++m) { bf16_t* rowp = base + (size_t)(row0 + ai * HALF + m * 16) * ldc + col0;
#pragma unroll
                for (int bj = 0; bj < 2; ++bj) { const f32x4 v0 = acc[ai][bj][m][0] * sc, v1 = acc[ai][bj][m][1] * sc;
                    u32x4 w; w.x = cvt_pk_bf16(v0[0], v0[1]); w.y = cvt_pk_bf16(v0[2], v0[3]); w.z = cvt_pk_bf16(v1[0], v1[1]); w.w = cvt_pk_bf16(v1[2], v1[3]);
                    *(u32x4*)(rowp + bj * HALF) = w; } }
    }
};
template <bool ADD> struct EpiGate {
    static constexpr bool PERM = true, AFTER_DRAIN = false;
    const bf16_t* G; const bf16_t* T1; bf16_t* O;
    __device__ __forceinline__ void operator()(const f32x4 (&acc)[2][2][4][2], const Unit& u, int wr, int wc, int fr, int fq) const {
        const int row0 = u.pm * BM + wr * 64 + fr, col0 = u.pn * BM + wc * 32 + 8 * fq;
#pragma unroll
        for (int ai = 0; ai < 2; ++ai)
#pragma unroll
            for (int m = 0; m < 4; ++m) { const size_t off = (size_t)(row0 + ai * HALF + m * 16) * 1024 + col0;
#pragma unroll
                for (int bj = 0; bj < 2; ++bj) {
                    const u32x4 g = *(const u32x4*)(G + off + bj * HALF);
                    f32x4 v0 = acc[ai][bj][m][0], v1 = acc[ai][bj][m][1];
                    v0[0] *= sigmoidf_(bf_lo(g.x)); v0[1] *= sigmoidf_(bf_hi(g.x)); v0[2] *= sigmoidf_(bf_lo(g.y)); v0[3] *= sigmoidf_(bf_hi(g.y));
                    v1[0] *= sigmoidf_(bf_lo(g.z)); v1[1] *= sigmoidf_(bf_hi(g.z)); v1[2] *= sigmoidf_(bf_lo(g.w)); v1[3] *= sigmoidf_(bf_hi(g.w));
                    if (ADD) { const u32x4 t = *(const u32x4*)(T1 + off + bj * HALF);
                        v0[0] += bf_lo(t.x); v0[1] += bf_hi(t.x); v0[2] += bf_lo(t.y); v0[3] += bf_hi(t.y);
                        v1[0] += bf_lo(t.z); v1[1] += bf_hi(t.z); v1[2] += bf_lo(t.w); v1[3] += bf_hi(t.w); }
                    u32x4 w; w.x = cvt_pk_bf16(v0[0], v0[1]); w.y = cvt_pk_bf16(v0[2], v0[3]); w.z = cvt_pk_bf16(v1[0], v1[1]); w.w = cvt_pk_bf16(v1[2], v1[3]);
                    *(u32x4*)(O + off + bj * HALF) = w; } }
    }
};
struct EpiOut {
    static constexpr bool PERM = false, AFTER_DRAIN = false;
    const float* xp; const float* xs; float* H; int np, ntok; float alpha;
    __device__ __forceinline__ void operator()(const f32x4 (&acc)[2][2][4][2], const Unit& u, int wr, int wc, int fr, int fq) const {
        const int row0 = u.pm * BM + wr * 64 + fr, col0 = u.pn * BM + wc * 32 + 4 * fq;
#pragma unroll
        for (int ai = 0; ai < 2; ++ai)
#pragma unroll
            for (int m = 0; m < 4; ++m) { const int r = row0 + ai * HALF + m * 16;
                const float* xr = r < np ? xp + (size_t)r * 1024 : xs + (size_t)(r < ntok ? r - np : 0) * 1024; const bool real = r < ntok;
#pragma unroll
                for (int bj = 0; bj < 2; ++bj)
#pragma unroll
                    for (int n = 0; n < 2; ++n) { const int c = col0 + bj * HALF + n * 16;
                        f32x4 xv = *(const f32x4*)(xr + c); if (!real) xv = (f32x4){0.f, 0.f, 0.f, 0.f};
                        *(f32x4*)(H + (size_t)r * 1024 + c) = xv * alpha + acc[ai][bj][m][n]; } }
    }
};
struct EpiHeadNorm {
    static constexpr bool PERM = true, AFTER_DRAIN = false;
    bf16_t* O; int ldc; PG8_LAS unsigned char* st; float eps;
    __device__ __forceinline__ void operator()(const f32x4 (&acc)[2][2][4][2], const Unit& u, int wr, int wc, int fr, int fq) const {
        PG8_LAS f32x2* P = (PG8_LAS f32x2*)st; PG8_LAS f32x2* S = (PG8_LAS f32x2*)(st + 8192);
        const int lane = fq * 16 + fr, wid = wr * 4 + wc;
#pragma unroll
        for (int ai = 0; ai < 2; ++ai)
#pragma unroll
            for (int m = 0; m < 4; ++m) {
                float s = 0.f;
#pragma unroll
                for (int bj = 0; bj < 2; ++bj)
#pragma unroll
                    for (int n = 0; n < 2; ++n) { const f32x4 x = acc[ai][bj][m][n]; s += (x[0] + x[1]) + (x[2] + x[3]); }
                s += __shfl_xor(s, 16); s += __shfl_xor(s, 32);
                const float mw = s * (1.0f / 64.0f); float q = 0.f;
#pragma unroll
                for (int bj = 0; bj < 2; ++bj)
#pragma unroll
                    for (int n = 0; n < 2; ++n) { const f32x4 d = acc[ai][bj][m][n] - mw; q += (d[0] * d[0] + d[1] * d[1]) + (d[2] * d[2] + d[3] * d[3]); }
                q += __shfl_xor(q, 16); q += __shfl_xor(q, 32);
                if (fq == 0) P[(ai * HALF + wr * 64 + m * 16 + fr) * 4 + wc] = (f32x2){mw, q};
            }
        asm volatile("s_waitcnt lgkmcnt(0)" ::: "memory"); __builtin_amdgcn_s_barrier(); asm volatile("" ::: "memory");
        const int row = wid * 32 + (lane & 31);
        if (lane < 32) {
            const f32x2 a = P[row * 4 + 0], b = P[row * 4 + 1], c = P[row * 4 + 2], d = P[row * 4 + 3];
            const float mt = (a.x + b.x + c.x + d.x) * 0.25f;
            const float da = a.x - mt, db = b.x - mt, dc = c.x - mt, dd = d.x - mt;
            const float m2 = (a.y + b.y) + (c.y + d.y) + 64.0f * ((da * da + db * db) + (dc * dc + dd * dd));
            S[row] = (f32x2){mt, 1.0f / sqrtf(m2 * (1.0f / 256.0f) + eps)};
        }
        asm volatile("s_waitcnt lgkmcnt(0)" ::: "memory"); __builtin_amdgcn_s_barrier(); asm volatile("" ::: "memory");
        const int row0 = u.pm * BM + wr * 64 + fr, col0 = u.pn * BM + wc * 32 + 8 * fq;
#pragma unroll
        for (int ai = 0; ai < 2; ++ai)
#pragma unroll
            for (int m = 0; m < 4; ++m) { const f32x2 sr = S[ai * HALF + wr * 64 + m * 16 + fr]; bf16_t* rowp = O + (size_t)(row0 + ai * HALF + m * 16) * ldc + col0;
#pragma unroll
                for (int bj = 0; bj < 2; ++bj) { const f32x4 v0 = (acc[ai][bj][m][0] - sr.x) * sr.y, v1 = (acc[ai][bj][m][1] - sr.x) * sr.y;
                    u32x4 w; w.x = cvt_pk_bf16(v0[0], v0[1]); w.y = cvt_pk_bf16(v0[2], v0[3]); w.z = cvt_pk_bf16(v1[0], v1[1]); w.w = cvt_pk_bf16(v1[2], v1[3]);
                    *(u32x4*)(rowp + bj * HALF) = w; } }
    }
};

template <class Epi, class Sched, bool ALIGN_EPI = false, bool SP2 = false>
__device__ __forceinline__ void gemm_phase(PG8_LAS unsigned char* lds, const Gemm g, const Sched& S, const Epi& E) {
    const int tid = threadIdx.x, wid = __builtin_amdgcn_readfirstlane(tid >> 6), lane = tid & 63, wr = wid >> 2, wc = wid & 3, fr = lane & 15, fq = lane >> 4;
    const int K = g.K, nt = K / BK;
    unsigned voffA[2], voffB[2];
#pragma unroll
    for (int i = 0; i < 2; ++i) { int R, C; stage_rc(tid * 16 + i * 8192, R, C); const int Rb = Epi::PERM ? ((R & ~31) + perm32(R & 31)) : R;
        voffA[i] = (unsigned)(R * K + C) * 2u; voffB[i] = (unsigned)(Rb * K + C) * 2u; }
    const size_t kstep = (size_t)(BK * 2);
    const size_t hstep = (size_t)HALF * K * 2;
    const size_t tstep = 2 * hstep;
    const unsigned ldsw = (unsigned)wid * 1024u;
    const int aoff = lds_byte(wr * 64 + fr, fq * 8), boff = lds_byte(wc * 32 + fr, fq * 8);
#define PG8_SA(b, h) (((b) * 2 + (h)) * HTB)
#define PG8_SB(b, h) ((4 + (b) * 2 + (h)) * HTB)
#define PG8_STAGE(bufoff, gbase, voff) do { _Pragma("unroll") for (int _i = 0; _i < 2; ++_i) \
        __builtin_amdgcn_global_load_lds((const unsigned*)((const char*)(gbase) + (voff)[_i]), (PG8_LAS unsigned*)(lds + (bufoff) + ldsw + _i * 8192), 16, 0, 0); } while (0)
#define PG8_LDA(dst, b, h) do { _Pragma("unroll") for (int m = 0; m < 4; ++m) _Pragma("unroll") for (int k = 0; k < 2; ++k) dst[m][k] = *(const PG8_LAS bf16x8*)(lds + PG8_SA(b, h) + aoff + m * 2048 + k * 1024); } while (0)
#define PG8_LDB(dst, b, h) do { _Pragma("unroll") for (int n = 0; n < 2; ++n) _Pragma("unroll") for (int k = 0; k < 2; ++k) dst[n][k] = *(const PG8_LAS bf16x8*)(lds + PG8_SB(b, h) + boff + n * 2048 + k * 1024); } while (0)
#define PG8_MMA(ai, bj, At, Bt) do { __builtin_amdgcn_s_setprio(1); _Pragma("unroll") for (int m = 0; m < 4; ++m) _Pragma("unroll") for (int n = 0; n < 2; ++n) _Pragma("unroll") for (int k = 0; k < 2; ++k) \
        acc[ai][bj][m][n] = __builtin_amdgcn_mfma_f32_16x16x32_bf16(Bt[n][k], At[m][k], acc[ai][bj][m][n], 0, 0, 0); __builtin_amdgcn_s_setprio(0); } while (0)
#define PG8_WAIT_V(n) asm volatile("s_waitcnt vmcnt(" #n ")" ::: "memory")
#define PG8_WAIT_L(n) asm volatile("s_waitcnt lgkmcnt(" #n ")" ::: "memory")
#define PG8_BAR __builtin_amdgcn_s_barrier()
#define PG8_SCHED __builtin_amdgcn_sched_barrier(0)
    Unit cur, nxt; int ui = 0;
    if (!S.next(0, cur)) return;
    f32x4 acc[2][2][4][2];
#pragma unroll
    for (int a = 0; a < 2; ++a)
#pragma unroll
        for (int b = 0; b < 2; ++b)
#pragma unroll
            for (int m = 0; m < 4; ++m)
#pragma unroll
                for (int n = 0; n < 2; ++n) acc[a][b][m][n] = (f32x4){0.f, 0.f, 0.f, 0.f};
    bf16x8 At[4][2], B0[2][2], B1[2][2];
    const char* cA = (const char*)g.A + (size_t)cur.pm * tstep; const char* cB = (const char*)g.Bt + (size_t)cur.pn * tstep;
    S.a_ready(cur);
    if constexpr (SP2) {
        PG8_STAGE(PG8_SB(0, 0), cB, voffB); PG8_STAGE(PG8_SB(0, 1), cB + hstep, voffB); PG8_STAGE(PG8_SA(0, 0), cA, voffA); PG8_STAGE(PG8_SA(0, 1), cA + hstep, voffA);
        if (wr == 1) PG8_BAR;
        PG8_WAIT_V(2); PG8_BAR;
        PG8_STAGE(PG8_SB(1, 0), cB + kstep, voffB); PG8_STAGE(PG8_SA(1, 0), cA + kstep, voffA); PG8_STAGE(PG8_SB(1, 1), cB + hstep + kstep, voffB);
        PG8_WAIT_V(6); PG8_BAR;
    } else {
        PG8_STAGE(PG8_SB(0, 0), cB, voffB); PG8_STAGE(PG8_SA(0, 0), cA, voffA); PG8_STAGE(PG8_SB(0, 1), cB + hstep, voffB); PG8_STAGE(PG8_SA(0, 1), cA + hstep, voffA);
        if (wr == 1) PG8_BAR;
        PG8_WAIT_V(4); PG8_BAR;
        PG8_STAGE(PG8_SB(1, 0), cB + kstep, voffB); PG8_STAGE(PG8_SA(1, 0), cA + kstep, voffA); PG8_STAGE(PG8_SB(1, 1), cB + hstep + kstep, voffB);
        PG8_WAIT_V(6); PG8_BAR;
    }
    for (;;) {
        const bool has_next = S.next(ui + 1, nxt);
        const bool skip1 = __builtin_amdgcn_readfirstlane((int)(cur.pm == g.half_pm)) != 0;
        const char* nA = has_next ? (const char*)g.A + (size_t)nxt.pm * tstep : cA; const char* nB = has_next ? (const char*)g.Bt + (size_t)nxt.pn * tstep : cB;
        for (int t = 0; t < nt; t += 2) {
            const bool last = (t == nt - 2);
            const char* a1 = cA + (size_t)(t + 1) * kstep;
            const char* a2 = last ? nA : cA + (size_t)(t + 2) * kstep; const char* b2 = last ? nB : cB + (size_t)(t + 2) * kstep;
            const char* a3 = a2 + kstep; const char* b3 = b2 + kstep;
            if (last && has_next) S.a_ready(nxt);
            if constexpr (SP2) {
            PG8_LDB(B0, 0, 0); PG8_LDB(B1, 0, 1); PG8_SCHED; PG8_LDA(At, 0, 0); PG8_STAGE(PG8_SA(1, 1), a1 + hstep, voffA);
            PG8_WAIT_V(8); PG8_WAIT_L(0); PG8_BAR; PG8_MMA(0, 0, At, B0); PG8_MMA(0, 1, At, B1); PG8_BAR; PG8_SCHED;
            PG8_LDA(At, 0, 1); PG8_STAGE(PG8_SB(0, 0), b2, voffB); PG8_STAGE(PG8_SB(0, 1), b2 + hstep, voffB); PG8_STAGE(PG8_SA(0, 0), a2, voffA);
            PG8_WAIT_V(8); PG8_WAIT_L(0); PG8_BAR; if (!skip1) { PG8_MMA(1, 0, At, B0); PG8_MMA(1, 1, At, B1); } PG8_BAR; PG8_SCHED;
            PG8_LDB(B0, 1, 0); PG8_LDB(B1, 1, 1); PG8_SCHED; PG8_LDA(At, 1, 0); PG8_STAGE(PG8_SA(0, 1), a2 + hstep, voffA);
            PG8_WAIT_V(8); PG8_WAIT_L(0); PG8_BAR; PG8_MMA(0, 0, At, B0); PG8_MMA(0, 1, At, B1); PG8_BAR; PG8_SCHED;
            PG8_LDA(At, 1, 1); PG8_STAGE(PG8_SB(1, 0), b3, voffB); PG8_STAGE(PG8_SB(1, 1), b3 + hstep, voffB); PG8_STAGE(PG8_SA(1, 0), a3, voffA);
            PG8_WAIT_V(8); PG8_WAIT_L(0); PG8_BAR; if (!skip1) { PG8_MMA(1, 0, At, B0); PG8_MMA(1, 1, At, B1); } PG8_BAR; PG8_SCHED;
            } else {
            PG8_LDB(B0, 0, 0); PG8_SCHED; PG8_LDA(At, 0, 0); PG8_STAGE(PG8_SA(1, 1), a1 + hstep, voffA);
            PG8_WAIT_L(8); PG8_BAR; PG8_WAIT_L(0); PG8_MMA(0, 0, At, B0); PG8_BAR; PG8_SCHED;
            PG8_LDB(B1, 0, 1); PG8_STAGE(PG8_SB(0, 0), b2, voffB);
            PG8_BAR; PG8_WAIT_L(0); PG8_MMA(0, 1, At, B1); PG8_BAR;
            PG8_LDA(At, 0, 1); PG8_STAGE(PG8_SA(0, 0), a2, voffA);
            PG8_BAR; PG8_WAIT_L(0); PG8_MMA(1, 0, At, B0); PG8_BAR; PG8_SCHED;
            PG8_STAGE(PG8_SB(0, 1), b2 + hstep, voffB);
            PG8_WAIT_V(6); PG8_BAR; PG8_MMA(1, 1, At, B1); PG8_BAR;
            PG8_LDB(B0, 1, 0); PG8_SCHED; PG8_LDA(At, 1, 0); PG8_STAGE(PG8_SA(0, 1), a2 + hstep, voffA);
            PG8_WAIT_L(8); PG8_BAR; PG8_WAIT_L(0); PG8_MMA(0, 0, At, B0); PG8_BAR; PG8_SCHED;
            PG8_LDB(B1, 1, 1); PG8_STAGE(PG8_SB(1, 0), b3, voffB);
            PG8_BAR; PG8_WAIT_L(0); PG8_MMA(0, 1, At, B1); PG8_BAR;
            PG8_LDA(At, 1, 1); PG8_STAGE(PG8_SA(1, 0), a3, voffA);
            PG8_BAR; PG8_WAIT_L(0); PG8_MMA(1, 0, At, B0); PG8_BAR; PG8_SCHED;
            PG8_STAGE(PG8_SB(1, 1), b3 + hstep, voffB);
            PG8_WAIT_V(6); PG8_BAR; PG8_MMA(1, 1, At, B1); PG8_BAR;
            }
        }
        if constexpr (ALIGN_EPI) { if (wr == 0) PG8_BAR; }
        if constexpr (!Epi::AFTER_DRAIN) { E(acc, cur, wr, wc, fr, fq); S.done(cur); }
        if (!has_next) break;
#pragma unroll
        for (int a = 0; a < 2; ++a)
#pragma unroll
            for (int b = 0; b < 2; ++b)
#pragma unroll
                for (int m = 0; m < 4; ++m)
#pragma unroll
                    for (int n = 0; n < 2; ++n) acc[a][b][m][n] = (f32x4){0.f, 0.f, 0.f, 0.f};
        cur = nxt; cA = nA; cB = nB; ++ui;
        if constexpr (ALIGN_EPI) { if (wr == 1) PG8_BAR; }
    }
    PG8_WAIT_V(0);
    if constexpr (!ALIGN_EPI) { if (wr == 0) PG8_BAR; }
    PG8_BAR;
    if constexpr (Epi::AFTER_DRAIN) { E.fused(acc, cur, wr, wc, fr, fq, lds, wid, lane); S.done(cur); }
#undef PG8_SA
#undef PG8_SB
#undef PG8_STAGE
#undef PG8_LDA
#undef PG8_LDB
#undef PG8_MMA
#undef PG8_WAIT_V
#undef PG8_WAIT_L
#undef PG8_BAR
#undef PG8_SCHED
}
}

constexpr int NWAVES = 8, NTHR = 512;
constexpr int DM = 1024, TSEQ = 4096, NP = 32768, NS = 128, NTOK = NP + NS, MPAD = 33024;
constexpr int INW = 9744, NPROJ = 9728, ABCOL = 6656;
constexpr float LN_EPS = 1e-5f, ALPHA = 1.189207115002721f, GLA_QSCALE = 0.08838834764831845f, NEG_BIG = -1e30f;
constexpr size_t OUT_YP = 0, OUT_YS = 33554432, OUT_KVP1 = 33685504, OUT_KVP2 = 34734080, OUT_KVP3 = 38928384, OUT_STP = 55705600,
                 OUT_KVS1 = 56754176, OUT_KVS2 = 60948480, OUT_KVS3 = 77725696, OUT_STS = 144834560, OUT_TOTAL = 149028864;
constexpr size_t MiB = 1u << 20;
constexpr size_t WS_CTL = 0, CTL_ZERO_BYTES = 1 * MiB;
constexpr size_t WS_KEYS = 1 * MiB, WS_LUT = WS_KEYS + 512 * 1024;
constexpr size_t WS_WA = 2 * MiB, WS_WB = 3 * MiB, WS_WO = 5 * MiB, WS_WQ = 7 * MiB, WS_WIN = 11 * MiB;
constexpr size_t WS_AB = 31 * MiB, WS_UT = 34 * MiB, WS_VT = 66 * MiB, WS_XB = 98 * MiB;
constexpr size_t WS_QA = 163 * MiB, WS_KA = 260 * MiB, WS_VA = 357 * MiB, WS_QB = 454 * MiB, WS_KB = 487 * MiB, WS_VB = 520 * MiB;
constexpr size_t WS_RB = 585 * MiB, WS_GA = 650 * MiB, WS_GB = 715 * MiB, WS_LSE = 780 * MiB, WS_OAM = 784 * MiB, WS_OBN = 817 * MiB, WS_H = 882 * MiB, WS_END = 1011 * MiB;
constexpr size_t WS_T1 = WS_KA, WS_MIX = WS_VA, WS_X1B = WS_QA, WS_QN = WS_RB, WS_EIDX = WS_GB, WS_GATE = WS_GB + 17 * MiB;
static_assert(WS_WIN + (size_t)NPROJ * 1024 * 2 <= WS_AB && WS_AB + (size_t)MPAD * 16 * 4 <= WS_UT && WS_XB + (size_t)MPAD * 1024 * 2 <= WS_QA, "ws map 1");
static_assert(WS_QA + (size_t)MPAD * 1536 * 2 <= WS_KA && WS_QB + (size_t)MPAD * 512 * 2 <= WS_KB && WS_VB + (size_t)MPAD * 1024 * 2 <= WS_RB, "ws map 2");
static_assert(WS_LSE + (size_t)3 * MPAD * 8 * 4 <= WS_OAM && WS_OAM + (size_t)MPAD * 512 * 2 <= WS_OBN && WS_OBN + (size_t)MPAD * 1024 * 2 <= WS_H && WS_H + (size_t)MPAD * 1024 * 4 <= WS_END, "ws map 3");
static_assert(WS_QN + (size_t)MPAD * 2048 * 2 <= WS_GB && WS_EIDX + (size_t)MPAD * 128 * 4 <= WS_GATE && WS_GATE + (size_t)MPAD * 128 * 4 <= WS_LSE, "ws map 4");
constexpr int CW_QUEUE = 64;
constexpr int CW_CPYQ = 128;
constexpr int CW_GDONE = 192;
constexpr int NCOPYWG = 10;
constexpr int CW_BAR = 4096;
constexpr int RING_BYTES = 131072, STATS_OFF = RING_BYTES, MISC_OFF = STATS_OFF + 10240 + 320, LDS_BYTES = 147456;
static_assert(MISC_OFF + 128 + 22 * 8 <= LDS_BYTES, "LDS map");

#define GAS __attribute__((address_space(1)))
#define LAS __attribute__((address_space(3)))
typedef unsigned short bf16;
typedef unsigned v4u __attribute__((ext_vector_type(4)));
typedef unsigned v2u __attribute__((ext_vector_type(2)));
typedef float f32x4 __attribute__((ext_vector_type(4)));
typedef float f32x16 __attribute__((ext_vector_type(16)));
typedef short bf16x8 __attribute__((ext_vector_type(8)));
typedef short s16x4 __attribute__((ext_vector_type(4)));
typedef GAS unsigned gu32;
#define RLX_AGENT __ATOMIC_RELAXED, __HIP_MEMORY_SCOPE_AGENT
#define LDS_WAIT() asm volatile("s_waitcnt lgkmcnt(0)" ::: "memory")
#define VM_WAIT() asm volatile("s_waitcnt vmcnt(0)" ::: "memory")
#define MFMA32(a, b, c) __builtin_amdgcn_mfma_f32_32x32x16_bf16((a), (b), (c), 0, 0, 0)
using pg8::cvt_pk_bf16; using pg8::bf_lo; using pg8::bf_hi;
__device__ __forceinline__ unsigned short f2bf(float f) { return (unsigned short)(cvt_pk_bf16(f, 0.f) & 0xffffu); }
__device__ __forceinline__ float bf2f(unsigned short h) { return __uint_as_float((unsigned)h << 16); }
__device__ __forceinline__ int crow(int reg, int hh) { return (reg & 3) + 8 * (reg >> 2) + 4 * hh; }
__device__ __forceinline__ float wave_sum(float v) {
#pragma unroll
    for (int o = 1; o < 64; o <<= 1) v += __shfl_xor(v, o);
    return v;
}
__device__ __forceinline__ float wave_max(float v) {
#pragma unroll
    for (int o = 1; o < 64; o <<= 1) v = fmaxf(v, __shfl_xor(v, o));
    return v;
}
__device__ __forceinline__ bf16x8 frag_row(const LAS unsigned char* T, int stride, int r0, int k0, int lane) {
    return *(const LAS bf16x8*)(T + (r0 + (lane & 31)) * stride + (k0 + 8 * (lane >> 5)) * 2);
}
typedef short v4i16_t __attribute__((ext_vector_type(4)));
template <bool PERM> __device__ __forceinline__ bf16x8 frag_tr(const LAS unsigned char* X, int stride, int k0, int c0, int lane) {
    const int i = lane & 15, g = (lane >> 4) & 1, hh = lane >> 5, q = i >> 2, p = i & 3;
    const int rA = PERM ? (k0 + 4 * hh + q) : (k0 + 8 * hh + q), rB = PERM ? (k0 + 8 + 4 * hh + q) : (k0 + 8 * hh + 4 + q);
    const int cb = (c0 + 16 * g + 4 * p) * 2;
    const s16x4 lo = __builtin_bit_cast(s16x4, __builtin_amdgcn_ds_read_tr16_b64_v4i16((LAS v4i16_t*)(X + rA * stride + cb)));
    const s16x4 hi = __builtin_bit_cast(s16x4, __builtin_amdgcn_ds_read_tr16_b64_v4i16((LAS v4i16_t*)(X + rB * stride + cb)));
    return __builtin_shufflevector(lo, hi, 0, 1, 2, 3, 4, 5, 6, 7);
}
__device__ __forceinline__ bf16x8 pack_acc(const f32x16& x, int s) {
    v4u p; p.x = cvt_pk_bf16(x[8 * s], x[8 * s + 1]); p.y = cvt_pk_bf16(x[8 * s + 2], x[8 * s + 3]); p.z = cvt_pk_bf16(x[8 * s + 4], x[8 * s + 5]); p.w = cvt_pk_bf16(x[8 * s + 6], x[8 * s + 7]);
    return __builtin_bit_cast(bf16x8, p);
}

#define XB_TMO      128
#define XB_XCNT(j)  (256  + 64 * (j))
#define XB_XSUB(j)  (1280 + 64 * (j))
#define XB_XGEN(j)  (2304 + 64 * (j))
#define XB_TOP      3328
#define XB_TOPGEN   3392
#define XCD_BAR_WORDS 3456
#define XB_SPIN_CAP (1u << 22)
__device__ __forceinline__ unsigned xb_ld(unsigned* p)              { return __hip_atomic_load(p, __ATOMIC_RELAXED, __HIP_MEMORY_SCOPE_AGENT); }
__device__ __forceinline__ unsigned xb_add(unsigned* p, unsigned v) { return __hip_atomic_fetch_add(p, v, __ATOMIC_RELAXED, __HIP_MEMORY_SCOPE_AGENT); }
__device__ __forceinline__ unsigned xb_xcc_id() { return (unsigned)__builtin_amdgcn_s_getreg((3 << 11) | 20) & 0xFu; }
#define XB_SPIN(cond, bar) do { unsigned _sp = 0; while (cond) { __builtin_amdgcn_s_sleep(1); \
    if ((++_sp & 255u) == 0u) { if (xb_ld(&(bar)[XB_TMO])) break; if (_sp > XB_SPIN_CAP) { atomicAdd(&(bar)[XB_TMO], 1u); break; } } } } while (0)
struct XcdBarrier { unsigned* bar; unsigned x; volatile LAS unsigned* st; };
__device__ __forceinline__ XcdBarrier xcd_barrier_post(unsigned* bar, volatile LAS unsigned* st) {
    XcdBarrier b; b.bar = bar; b.x = xb_xcc_id(); b.st = st;
    if (threadIdx.x == 0) (void)xb_add(&bar[XB_XCNT(b.x)], 1u);
    return b;
}
__device__ __forceinline__ void xcd_barrier_complete(unsigned* bar, unsigned x, unsigned& nloc, unsigned& nx) {
    const unsigned G = gridDim.x * gridDim.y * gridDim.z;
    unsigned sum, cnt, mine, sp = 0u;
    for (;;) {
        sum = 0u; cnt = 0u; mine = 0u;
#pragma unroll
        for (unsigned j = 0; j < 16; ++j) { const unsigned c = xb_ld(&bar[XB_XCNT(j)]); sum += c; cnt += (c > 0u) ? 1u : 0u; mine = (j == x) ? c : mine; }
        if (sum == G) break;
        __builtin_amdgcn_s_sleep(1);
        if ((++sp & 255u) == 0u) { if (xb_ld(&bar[XB_TMO])) break; if (sp > XB_SPIN_CAP) { atomicAdd(&bar[XB_TMO], 1u); break; } }
    }
    nloc = mine > 0u ? mine : 1u; nx = cnt > 0u ? cnt : 1u;
}
__device__ __forceinline__ void xcd_barrier(const XcdBarrier& b) {
    asm volatile("s_waitcnt vmcnt(0)" ::: "memory");
    __syncthreads();
    if (threadIdx.x == 0) {
        unsigned* bar = b.bar;
        __builtin_amdgcn_s_waitcnt(0);
        unsigned nloc = b.st[0], nx = b.st[1];
        if (nloc == 0u) { xcd_barrier_complete(bar, b.x, nloc, nx); b.st[0] = nloc; b.st[1] = nx; }
        const unsigned old = xb_add(&bar[XB_XSUB(b.x)], 1u);
        const unsigned gen = old / nloc;
        if (old + 1u == (gen + 1u) * nloc) {
            __builtin_amdgcn_fence(__ATOMIC_RELEASE, "agent");
            asm volatile("s_waitcnt vmcnt(0)" ::: "memory");
            const unsigned og = xb_add(&bar[XB_TOP], 1u);
            const unsigned tg = og / nx;
            if (og + 1u == (tg + 1u) * nx) xb_add(&bar[XB_TOPGEN], 1u);
            else XB_SPIN(xb_ld(&bar[XB_TOPGEN]) == tg, bar);
            __builtin_amdgcn_fence(__ATOMIC_ACQUIRE, "agent");
            xb_add(&bar[XB_XGEN(b.x)], 1u);
            asm volatile("s_waitcnt vmcnt(0)" ::: "memory");
        } else {
            XB_SPIN(xb_ld(&bar[XB_XGEN(b.x)]) == gen, bar);
            __builtin_amdgcn_fence(__ATOMIC_ACQUIRE, "agent");
            asm volatile("s_waitcnt vmcnt(0)" ::: "memory");
        }
    }
    __syncthreads();
}

struct Frame {
    LAS unsigned char* lds;
    volatile LAS unsigned* MISC;
    gu32* ctl;
    int tid, lane, wave, G;
    unsigned long long tp;
    float* out; unsigned char* ws;
};
#define WSP(T, off) ((T*)(F.ws + (off)))
#define WSL(T, off) ((T*)(ws_ + (off)))
#define LAUNDER_WS() unsigned char* ws_ = F.ws; asm volatile("" : "+s"(ws_))
constexpr int PTR_OFF = MISC_OFF + 128;
enum { I_XP = 0, I_XS, I_C1, I_C2, I_C3, I_ST0, I_RELB, I_WIN, I_WG2, I_BG, I_GN, I_WA, I_WB, I_WO, I_L1G, I_L1B, I_WQ, I_KEYS, I_PU, I_PV, I_L2G, I_L2B };
__device__ __forceinline__ const float* inptr(const Frame& F, int i) {
    const unsigned long long v = ((volatile LAS unsigned long long*)(F.lds + PTR_OFF))[i];
    const unsigned lo = __builtin_amdgcn_readfirstlane((unsigned)v), hi = __builtin_amdgcn_readfirstlane((unsigned)(v >> 32));
    return (const float*)(((unsigned long long)hi << 32) | lo);
}

__device__ __forceinline__ void p0_tr_load(const float* W, int N, int nsrc0, int k0, int lane, float (&v)[32]) {
#pragma unroll
    for (int i = 0; i < 32; ++i) { const int kk = 2 * i + (lane >> 5); v[i] = W[(size_t)(k0 + kk) * N + nsrc0 + (lane & 31)]; }
}
__device__ __forceinline__ void p0_tr_finish(const float (&v)[32], int K, bf16* WT, int ndst0, int k0, LAS float* scr, int lane) {
#pragma unroll
    for (int i = 0; i < 32; ++i) { const int kk = 2 * i + (lane >> 5); scr[kk * 33 + (lane & 31)] = v[i]; }
    LDS_WAIT(); asm volatile("" ::: "memory");
    const int c = lane & 7;
#pragma unroll
    for (int j = 0; j < 4; ++j) { const int n = (lane >> 3) + 8 * j; const LAS float* s = scr + (8 * c) * 33 + n;
        v4u o; o.x = cvt_pk_bf16(s[0 * 33], s[1 * 33]); o.y = cvt_pk_bf16(s[2 * 33], s[3 * 33]); o.z = cvt_pk_bf16(s[4 * 33], s[5 * 33]); o.w = cvt_pk_bf16(s[6 * 33], s[7 * 33]);
        *(GAS v4u*)(WT + (size_t)(ndst0 + n) * K + k0 + 8 * c) = o; }
    LDS_WAIT(); asm volatile("" ::: "memory");
}
__device__ __forceinline__ void p0_cvt8(const float* src, bf16* dst, size_t n8, size_t gt, size_t ngt) {
    for (size_t i = gt; i < n8; i += ngt) { const f32x4 a = *(const f32x4*)(src + i * 8), b = *(const f32x4*)(src + i * 8 + 4);
        v4u o; o.x = cvt_pk_bf16(a[0], a[1]); o.y = cvt_pk_bf16(a[2], a[3]); o.z = cvt_pk_bf16(b[0], b[1]); o.w = cvt_pk_bf16(b[2], b[3]); *(v4u*)(dst + i * 8) = o; }
}
typedef float f32x2_t __attribute__((ext_vector_type(2)));
typedef _Float16 h2_t __attribute__((ext_vector_type(2)));
constexpr float U_SCALE = 1024.0f, V_SCALE = 128.0f, X_SCALE = 16.0f;
__device__ __forceinline__ void p0_cvt_fp8(const float* src, unsigned char* dst, float scale, size_t n16, size_t gt, size_t ngt) {
    for (size_t i = gt; i < n16; i += ngt) { v4u o;
#pragma unroll
        for (int q = 0; q < 4; ++q) { const f32x4 a = *(const f32x4*)(src + i * 16 + 4 * q) * scale; int w = 0;
            w = __builtin_amdgcn_cvt_pk_fp8_f32(a[0], a[1], w, false); w = __builtin_amdgcn_cvt_pk_fp8_f32(a[2], a[3], w, true); o[q] = (unsigned)w; }
        const size_t e = i >> 6, q16 = i & 63;
        *(v4u*)(dst + (((q16 >> 3) * 16384 + e) << 7) + 16 * (q16 & 7)) = o; }
}
__device__ __forceinline__ void p0_kvshift(const float* src, float* dst, int Wb, size_t gt, size_t ngt) {
    const size_t n4 = (size_t)(Wb - 4) * 256, tot = n4 * 32;
    for (size_t i = gt; i < tot; i += ngt) { const size_t b = i / n4, r = i - b * n4;
        ((f32x4*)dst)[b * (size_t)Wb * 256 + r] = ((const f32x4*)src)[b * (size_t)Wb * 256 + 1024 + r]; }
}
__device__ __forceinline__ void p0_prologue(Frame& F) {
    const int gw = blockIdx.x * NWAVES + F.wave, NGW = F.G * NWAVES;
    const size_t gt = (size_t)blockIdx.x * NTHR + F.tid, ngt = (size_t)F.G * NTHR;
    const float* win = inptr(F, I_WIN); const float* xp = inptr(F, I_XP); const float* xs = inptr(F, I_XS);
    constexpr int WROW = 2064;
    for (int i = F.tid; i < 4096; i += NTHR) {
        const int k = i >> 2, c4 = (i & 3) * 4; const f32x4 w4 = *(const f32x4*)(win + (size_t)k * INW + ABCOL + c4);
#pragma unroll
        for (int cc = 0; cc < 4; ++cc) *(LAS unsigned short*)(F.lds + (c4 + cc) * WROW + k * 2) = f2bf(w4[cc]); }
    __syncthreads();
    bf16* XB = WSP(bf16, WS_XB); float* AB = WSP(float, WS_AB);
    {   const int lane = F.lane, r = lane & 15, kg = lane >> 4;
        typedef float f32x4a __attribute__((ext_vector_type(4)));
        for (int blk = gw; blk < MPAD / 16; blk += NGW) {
            const int m = 16 * blk + r;
            bf16* xo = XB + (size_t)m * 1024 + 8 * kg;
            if (16 * blk >= NTOK) {
#pragma unroll 8
                for (int s = 0; s < 32; ++s) *(v4u*)(xo + 32 * s) = (v4u){0u, 0u, 0u, 0u};
                if (kg == 0) { *(f32x4*)(AB + (size_t)m * 16) = (f32x4){0.f, 0.f, 0.f, 0.f}; *(f32x4*)(AB + (size_t)m * 16 + 4) = (f32x4){0.f, 0.f, 0.f, 0.f}; *(f32x4*)(AB + (size_t)m * 16 + 8) = (f32x4){0.f, 0.f, 0.f, 0.f}; *(f32x4*)(AB + (size_t)m * 16 + 12) = (f32x4){0.f, 0.f, 0.f, 0.f}; }
                continue; }
            const float* xr = (m < NP ? xp + (size_t)m * 1024 : xs + (size_t)(m - NP) * 1024) + 8 * kg;
            f32x4a acc = {0.f, 0.f, 0.f, 0.f};
#pragma unroll 1
            for (int s0 = 0; s0 < 32; s0 += 16) {
                f32x4 xa[16], xb[16];
#pragma unroll
                for (int u = 0; u < 16; ++u) { xa[u] = *(const f32x4*)(xr + 32 * (s0 + u)); xb[u] = *(const f32x4*)(xr + 32 * (s0 + u) + 4); }
#pragma unroll
                for (int u = 0; u < 16; ++u) { v4u w; w.x = cvt_pk_bf16(xa[u][0], xa[u][1]); w.y = cvt_pk_bf16(xa[u][2], xa[u][3]); w.z = cvt_pk_bf16(xb[u][0], xb[u][1]); w.w = cvt_pk_bf16(xb[u][2], xb[u][3]);
                    *(v4u*)(xo + 32 * (s0 + u)) = w;
                    const bf16x8 bfr = *(const LAS bf16x8*)(F.lds + r * WROW + (32 * (s0 + u) + 8 * kg) * 2);
                    acc = __builtin_amdgcn_mfma_f32_16x16x32_bf16(__builtin_bit_cast(bf16x8, w), bfr, acc, 0, 0, 0); }
            }
#pragma unroll
            for (int i2 = 0; i2 < 4; ++i2) AB[(size_t)(16 * blk + 4 * kg + i2) * 16 + r] = acc[i2];
        }
    }
    __syncthreads();
    LAS float* scr = (LAS float*)(F.lds + F.wave * 16384);
    const float* wa = inptr(F, I_WA); const float* wb = inptr(F, I_WB); const float* wo = inptr(F, I_WO); const float* wq = inptr(F, I_WQ);
    constexpr int I_IN = 16 * (NPROJ / 32), I_A = 8 * 32, I_B = 16 * 32, I_O = 16 * 32, I_Q = 16 * 64, NIT = I_IN + I_A + I_B + I_O + I_Q;
#define P0_TR_PARAMS(IT, W_, WT_, K_, N_, NS_, ND_, K0_) { int r = (IT); \
        if (r < I_IN) { const int nb = r % (NPROJ / 32), kb = r / (NPROJ / 32), nd = 32 * nb; W_ = win; WT_ = WSP(bf16, WS_WIN); K_ = 1024; N_ = INW; NS_ = nd + (nd >= ABCOL ? 16 : 0); ND_ = nd; K0_ = 64 * kb; } \
        else if ((r -= I_IN) < I_A) { W_ = wa; WT_ = WSP(bf16, WS_WA); K_ = 512; N_ = 1024; NS_ = ND_ = 32 * (r % 32); K0_ = 64 * (r / 32); } \
        else if ((r -= I_A) < I_B) { W_ = wb; WT_ = WSP(bf16, WS_WB); K_ = 1024; N_ = 1024; NS_ = ND_ = 32 * (r % 32); K0_ = 64 * (r / 32); } \
        else if ((r -= I_B) < I_O) { W_ = wo; WT_ = WSP(bf16, WS_WO); K_ = 1024; N_ = 1024; NS_ = ND_ = 32 * (r % 32); K0_ = 64 * (r / 32); } \
        else { r -= I_O; W_ = wq; WT_ = WSP(bf16, WS_WQ); K_ = 1024; N_ = 2048; NS_ = ND_ = 32 * (r % 64); K0_ = 64 * (r / 64); } }
    if (blockIdx.x != 0) {
        const int NW2 = NGW - NWAVES;
        for (int it = gw - NWAVES; it < NIT; it += 2 * NW2) {
            const int it2 = it + NW2; const bool has2 = it2 < NIT;
            const float* Wa; bf16* WTa; int Ka, Na, NSa, NDa, K0a; P0_TR_PARAMS(it, Wa, WTa, Ka, Na, NSa, NDa, K0a);
            const float* Wb = Wa; bf16* WTb = WTa; int Kb = Ka, Nb = Na, NSb = NSa, NDb = NDa, K0b = K0a;
            if (has2) P0_TR_PARAMS(it2, Wb, WTb, Kb, Nb, NSb, NDb, K0b);
            float va[32], vb[32];
            p0_tr_load(Wa, Na, NSa, K0a, F.lane, va);
            if (has2) p0_tr_load(Wb, Nb, NSb, K0b, F.lane, vb);
            p0_tr_finish(va, Ka, WTa, NDa, K0a, scr, F.lane);
            if (has2) p0_tr_finish(vb, Kb, WTb, NDb, K0b, scr, F.lane);
        }
    }
    p0_cvt_fp8(inptr(F, I_PU), WSP(unsigned char, WS_UT), U_SCALE, (size_t)16384 * 1024 / 16, gt, ngt);
    p0_cvt_fp8(inptr(F, I_PV), WSP(unsigned char, WS_VT), V_SCALE, (size_t)16384 * 1024 / 16, gt, ngt);
    p0_cvt8(inptr(F, I_KEYS), WSP(bf16, WS_KEYS), (size_t)8 * 2 * 128 * 128 / 8, gt, ngt);
    if (gt < 3 * 8 * 129) { const int g = (int)gt / (8 * 129), h = ((int)gt / 129) % 8, rel = (int)gt % 129; const int dil = g == 0 ? 1 : (g == 1 ? 4 : 16), dist = rel * dil;
        int bucket = dist;
        if (dist >= 16) { const float dd = (float)dist; int lg = 16 + (int)(logf(dd / 16.0f) / 4.852030263919617f * 16.0f); bucket = lg < 31 ? lg : 31; }
        WSP(float, WS_LUT)[gt] = inptr(F, I_RELB)[bucket * 24 + g * 8 + h]; }
}

constexpr size_t WS_KD = WS_OAM, WS_DEC = WS_OBN;
__device__ __forceinline__ void gla_prep_load(Frame& F, int unit, unsigned (&qv)[8], unsigned (&kv)[8], float (&abv)[2]) {
    const int d2 = F.tid & 63, ig = F.wave, h = unit & 3, n = (unit >> 2) & 63, b = unit >> 8;
    const size_t m0 = (size_t)b * TSEQ + (size_t)n * 64;
    const bf16* QB = WSP(bf16, WS_QB); const bf16* KB = WSP(bf16, WS_KB); const float* AB = WSP(float, WS_AB);
#pragma unroll
    for (int ii = 0; ii < 8; ++ii) { const size_t off = (m0 + 8 * ig + ii) * 512 + h * 128 + 2 * d2; qv[ii] = *(const unsigned*)(QB + off); kv[ii] = *(const unsigned*)(KB + off); }
    abv[0] = AB[(m0 + 8 * ig) * 16 + d2]; abv[1] = AB[(m0 + 8 * ig) * 16 + 64 + d2];
}
__device__ __forceinline__ void gla_prep_unit(Frame& F, int unit, const unsigned (&qv)[8], const unsigned (&kv)[8], const float (&abv)[2], const f32x2_t (&wg)[16], const f32x2_t bgd) {
    LAUNDER_WS();
    LAS float* GT = (LAS float*)F.lds;
    const int tid = F.tid, d2 = tid & 63, ig = F.wave;
    const int h = unit & 3, n = (unit >> 2) & 63, b = unit >> 8;
    const size_t m0 = (size_t)b * TSEQ + (size_t)n * 64;
    bf16* QB = WSL(bf16, WS_QB); bf16* KB = WSL(bf16, WS_KB); float* DEC = WSL(float, WS_DEC);
    f32x2_t c[8]; f32x2_t run = {0.f, 0.f};
#pragma unroll
    for (int ii = 0; ii < 8; ++ii) {
        f32x2_t x = bgd;
#pragma unroll
        for (int r = 0; r < 16; ++r) x += wg[r] * __uint_as_float((unsigned)__builtin_amdgcn_readlane((int)__float_as_uint(abv[ii >> 2]), 16 * (ii & 3) + r));
        f32x2_t ls; ls.x = fminf(x.x, 0.f) - __logf(1.0f + __expf(-fabsf(x.x))); ls.y = fminf(x.y, 0.f) - __logf(1.0f + __expf(-fabsf(x.y)));
        run += ls * (1.0f / 16.0f); c[ii] = run;
    }
    *(LAS f32x2_t*)(GT + ig * 128 + 2 * d2) = run;
    __syncthreads();
    f32x2_t offs = {0.f, 0.f}, bl = {0.f, 0.f};
#pragma unroll
    for (int g = 0; g < 8; ++g) { const f32x2_t t = *(const LAS f32x2_t*)(GT + g * 128 + 2 * d2); bl += t; if (g < ig) offs += t; }
    const f32x2_t ebl = {__expf(bl.x), __expf(bl.y)};
#pragma unroll
    for (int ii = 0; ii < 8; ++ii) {
        const f32x2_t bb = offs + c[ii]; const f32x2_t eb = {__expf(bb.x), __expf(bb.y)}, ieb = {__expf(-bb.x), __expf(-bb.y)};
        const f32x2_t q = {bf_lo(qv[ii]), bf_hi(qv[ii])}, k = {bf_lo(kv[ii]), bf_hi(kv[ii])};
        const f32x2_t qe = q * GLA_QSCALE * eb, ke = k * ieb;
        const size_t off = (m0 + 8 * ig + ii) * 512 + h * 128 + 2 * d2;
        *(unsigned*)(QB + off) = cvt_pk_bf16(qe.x, qe.y); *(unsigned*)(KB + off) = cvt_pk_bf16(ke.x, ke.y);
    }
    if (ig == 0) *(f32x2_t*)(DEC + ((size_t)b * 64 + n) * 512 + h * 128 + 2 * d2) = ebl;
    __syncthreads();
}
__device__ __forceinline__ void gla_prompt_unit(Frame& F, int b, int h, int sl) {
    LAUNDER_WS();
    LAS unsigned char* L = F.lds;
    constexpr int O_QE = 0, O_KE = 17408, O_KD = 34816, O_VT = 55296, O_SB = 67584, O_DEC = 92160;
    const int tid = F.tid, lane = F.lane, w = F.wave, hh = lane >> 5;
    const bf16* QB = WSL(bf16, WS_QB); const bf16* KB = WSL(bf16, WS_KB); bf16* VB = WSL(bf16, WS_VB); const float* DEC = WSL(float, WS_DEC);
    for (int i = tid; i < 128 * 192 / 4; i += NTHR) ((LAS unsigned*)(L + O_SB))[i] = 0u;
    f32x16 S;
#pragma unroll
    for (int r = 0; r < 16; ++r) S[r] = 0.f;
    const int dt = w >> 1, et = w & 1;
    const int r0 = tid >> 4, c0 = tid & 15;
    v4u tq[2], tk[2], tv; float tdec = 0.f;
#define GLA_LOAD(n_) do { const size_t m0_ = (size_t)b * TSEQ + (size_t)(n_) * 64; \
        _Pragma("unroll") for (int i_ = 0; i_ < 2; ++i_) { const size_t off_ = (m0_ + r0 + 32 * i_) * 512 + h * 128 + c0 * 8; tq[i_] = *(const v4u*)(QB + off_); tk[i_] = *(const v4u*)(KB + off_); } \
        tv = *(const v4u*)(VB + (m0_ + (tid >> 3)) * 1024 + h * 256 + sl * 64 + (tid & 7) * 8); \
        if (tid < 128) tdec = DEC[((size_t)b * 64 + (n_)) * 512 + h * 128 + tid]; } while (0)
    GLA_LOAD(0);
    for (int n = 0; n < 64; ++n) {
        const size_t m0 = (size_t)b * TSEQ + (size_t)n * 64;
#pragma unroll
        for (int i = 0; i < 2; ++i) { *(LAS v4u*)(L + O_QE + (r0 + 32 * i) * 272 + c0 * 16) = tq[i]; *(LAS v4u*)(L + O_KE + (r0 + 32 * i) * 272 + c0 * 16) = tk[i]; *(LAS v4u*)(L + O_KD + (r0 + 32 * i) * 320 + c0 * 16) = tk[i]; }
        *(LAS v4u*)(L + O_VT + (tid >> 3) * 192 + (tid & 7) * 16) = tv;
        if (tid < 128) ((LAS float*)(L + O_DEC))[tid] = tdec;
        __syncthreads();
        if (n + 1 < 64) GLA_LOAD(n + 1);
        if (w < 4) {
            const int it = w >> 1;
            f32x16 o;
#pragma unroll
            for (int r = 0; r < 16; ++r) o[r] = 0.f;
            for (int jt = 0; jt <= it; ++jt) {
                f32x16 X;
#pragma unroll
                for (int r = 0; r < 16; ++r) X[r] = 0.f;
#pragma unroll
                for (int s = 0; s < 8; ++s) X = MFMA32(frag_row(L + O_KE, 272, 32 * jt, 16 * s, lane), frag_row(L + O_QE, 272, 32 * it, 16 * s, lane), X);
                if (jt == it) {
#pragma unroll
                    for (int r = 0; r < 16; ++r) if (crow(r, hh) > (lane & 31)) X[r] = 0.f;
                }
#pragma unroll
                for (int s2 = 0; s2 < 2; ++s2) o = MFMA32(pack_acc(X, s2), frag_tr<true>(L + O_VT, 192, 32 * jt + 16 * s2, 32 * et, lane), o);
            }
#pragma unroll
            for (int s = 0; s < 8; ++s) o = MFMA32(frag_row(L + O_QE, 272, 32 * it, 16 * s, lane), frag_tr<false>(L + O_SB, 192, 16 * s, 32 * et, lane), o);
            bf16* op = VB + (m0 + 32 * it) * 1024 + h * 256 + sl * 64 + 32 * et + (lane & 31);
#pragma unroll
            for (int r = 0; r < 16; ++r) op[(size_t)crow(r, hh) * 1024] = f2bf(o[r]);
        }
        {
#pragma unroll
            for (int s = 0; s < 4; ++s) S = MFMA32(frag_tr<false>(L + O_KD, 320, 16 * s, 32 * dt, lane), frag_tr<false>(L + O_VT, 192, 16 * s, 32 * et, lane), S);
#pragma unroll
            for (int r = 0; r < 16; ++r) S[r] *= ((LAS float*)(L + O_DEC))[32 * dt + crow(r, hh)];
        }
        __syncthreads();
#pragma unroll
        for (int r = 0; r < 16; ++r) *(LAS unsigned short*)(L + O_SB + (32 * dt + crow(r, hh)) * 192 + (32 * et + (lane & 31)) * 2) = f2bf(S[r]);
    }
#undef GLA_LOAD
    float* so = F.out + OUT_STP + ((size_t)(b * 4 + h) * 128 + 32 * dt) * 256 + sl * 64 + 32 * et + (lane & 31);
#pragma unroll
    for (int r = 0; r < 16; ++r) so[(size_t)crow(r, hh) * 256] = S[r];
    __syncthreads();
}

struct AttnItem { int b, h, g, r, dil, i0, cb; size_t tok0; };
__device__ __forceinline__ AttnItem attn_decode(int item) {
    AttnItem a; const int bh = item / 48, sub = item % 48; a.b = bh >> 3; a.h = bh & 7;
    int ibg;
    if (sub < 16) { a.g = 0; a.r = 0; ibg = sub; } else if (sub < 32) { a.g = 1; a.r = (sub - 16) >> 2; ibg = (sub - 16) & 3; } else { a.g = 2; a.r = sub - 32; ibg = 0; }
    a.dil = a.g == 0 ? 1 : (a.g == 1 ? 4 : 16); a.i0 = 256 * ibg; a.tok0 = (size_t)a.b * TSEQ + a.r; a.cb = a.g * 512 + a.h * 64;
    return a;
}
__device__ __forceinline__ void attn_issue(Frame& F, int item, v4u (&kk)[6], v4u (&vv)[6], bf16x8 (&qf)[4]) {
    LAUNDER_WS();
    const AttnItem a = attn_decode(item);
    const int tid = F.tid, lane = F.lane, w = F.wave, hh = lane >> 5, il = lane & 31;
    const bf16* QA = WSL(bf16, WS_QA); const bf16* KA = WSL(bf16, WS_KA); const bf16* VA = WSL(bf16, WS_VA);
    const size_t qtok = a.tok0 + (size_t)a.dil * (a.i0 + 32 * w + il);
#pragma unroll
    for (int s = 0; s < 4; ++s) qf[s] = *(const bf16x8*)(QA + qtok * 1536 + a.cb + 16 * s + 8 * hh);
#pragma unroll
    for (int p = 0; p < 6; ++p) { const int idx = tid + NTHR * p, rr = idx >> 3, ch = idx & 7, j = a.i0 - 128 + rr;
        if (j >= 0) { const size_t so = (a.tok0 + (size_t)a.dil * j) * 1536 + a.cb + ch * 8; vv[p] = *(const v4u*)(VA + so); kk[p] = *(const v4u*)(KA + so); } }
}
__device__ __forceinline__ void attn_prompt_item(Frame& F, int item, v4u (&kk)[6], v4u (&vv)[6], const bf16x8 (&qf)[4], bool has_next, int next_item, bf16x8 (&qn)[4]) {
    LAUNDER_WS();
    LAS unsigned char* L = F.lds;
    constexpr int O_V = 0, O_K = 384 * 192, O_LUT = O_K + 384 * 144;
    static_assert(O_LUT + 129 * 4 <= RING_BYTES, "attention LDS");
    const int tid = F.tid, lane = F.lane, w = F.wave, hh = lane >> 5, il = lane & 31;
    const AttnItem a = attn_decode(item);
    const int b = a.b, h = a.h, g = a.g, dil = a.dil, i0 = a.i0, cb = a.cb; const size_t tok0 = a.tok0; (void)b;
    bf16* QA = WSL(bf16, WS_QA); float* LSE = WSL(float, WS_LSE);
    const size_t qtok = tok0 + (size_t)dil * (i0 + 32 * w + il);
#pragma unroll
    for (int p = 0; p < 6; ++p) { const int idx = tid + NTHR * p, rr = idx >> 3, ch = idx & 7, j = i0 - 128 + rr;
        if (j >= 0) { *(LAS v4u*)(L + O_V + rr * 192 + ch * 16) = vv[p]; *(LAS v4u*)(L + O_K + rr * 144 + ch * 16) = kk[p]; } }
    if (tid < 129) ((LAS float*)(L + O_LUT))[tid] = WSL(float, WS_LUT)[(g * 8 + h) * 129 + tid];
    __syncthreads();
    if (has_next) attn_issue(F, next_item, kk, vv, qn);
    float mrun = NEG_BIG, lrun = 0.f;
    f32x16 O0, O1;
#pragma unroll
    for (int x = 0; x < 16; ++x) { O0[x] = 0.f; O1[x] = 0.f; }
#pragma unroll 1
    for (int kt = 0; kt < 5; ++kt) {
        const int jb = i0 + 32 * (w + kt) - 128;
        if (jb < 0) continue;
        f32x16 ST;
#pragma unroll
        for (int x = 0; x < 16; ++x) ST[x] = 0.f;
#pragma unroll
        for (int s = 0; s < 4; ++s) ST = MFMA32(frag_row(L + O_K, 144, 32 * (w + kt), 16 * s, lane), qf[s], ST);
        const int relb = 128 - 32 * kt + il;
        float tmax = NEG_BIG;
#pragma unroll
        for (int x = 0; x < 16; ++x) { const int rel = relb - crow(x, hh); const bool ok = rel >= 0 && rel <= 128; const int rc = rel < 0 ? 0 : (rel > 128 ? 128 : rel);
            const float sc = ok ? ST[x] + ((LAS float*)(L + O_LUT))[rc] : NEG_BIG; ST[x] = sc; tmax = fmaxf(tmax, sc); }
        tmax = fmaxf(tmax, __shfl_xor(tmax, 32));
        const float mnew = fmaxf(mrun, tmax), alpha = __expf(mrun - mnew);
        float ps = 0.f;
#pragma unroll
        for (int x = 0; x < 16; ++x) { const float p = __expf(ST[x] - mnew); ST[x] = p; ps += p; }
        lrun = lrun * alpha + ps; mrun = mnew;
#pragma unroll
        for (int x = 0; x < 16; ++x) { O0[x] *= alpha; O1[x] *= alpha; }
#pragma unroll
        for (int s2 = 0; s2 < 2; ++s2) { const bf16x8 pf = pack_acc(ST, s2);
            O0 = MFMA32(frag_tr<true>(L + O_V, 192, 32 * (w + kt) + 16 * s2, 0, lane), pf, O0);
            O1 = MFMA32(frag_tr<true>(L + O_V, 192, 32 * (w + kt) + 16 * s2, 32, lane), pf, O1); }
    }
    const float ltot = lrun + __shfl_xor(lrun, 32), inv = 1.0f / ltot;
    bf16* op = QA + qtok * 1536 + cb;
#pragma unroll
    for (int k4 = 0; k4 < 4; ++k4) { v2u a, c2;
        a.x = cvt_pk_bf16(O0[4 * k4] * inv, O0[4 * k4 + 1] * inv); a.y = cvt_pk_bf16(O0[4 * k4 + 2] * inv, O0[4 * k4 + 3] * inv);
        c2.x = cvt_pk_bf16(O1[4 * k4] * inv, O1[4 * k4 + 1] * inv); c2.y = cvt_pk_bf16(O1[4 * k4 + 2] * inv, O1[4 * k4 + 3] * inv);
        *(v2u*)(op + 8 * k4 + 4 * hh) = a; *(v2u*)(op + 32 + 8 * k4 + 4 * hh) = c2; }
    if (hh == 0) LSE[((size_t)g * MPAD + qtok) * 8 + h] = mrun + __logf(ltot);
    __syncthreads();
}

#define DPP_FA(x, ctrl) __uint_as_float((unsigned)__builtin_amdgcn_mov_dpp((int)__float_as_uint(x), (ctrl), 0xf, 0xf, true))
template <int G_> __device__ __forceinline__ void attn_sample_waveitem_g(Frame& F, int wi, const float* cache) {
    LAUNDER_WS();
    int lane = F.lane; asm volatile("" : "+v"(lane));
    const int grp = lane >> 4, l16 = lane & 15;
    constexpr int g = G_; const int h = (wi / 3) & 7, s = (wi / 24) & 3, b = wi / 96;
    constexpr int dil = g == 0 ? 1 : (g == 1 ? 4 : 16), Wb = 128 * dil;
    bf16* QA = WSL(bf16, WS_QA); const bf16* KA = WSL(bf16, WS_KA); const bf16* VA = WSL(bf16, WS_VA); float* LSE = WSL(float, WS_LSE);
    const size_t qrow = (size_t)NP + b * 4 + s; const int cb = g * 512 + h * 64;
    const v2u qu = *(const v2u*)(QA + qrow * 1536 + cb + 4 * l16);
    const float q0 = bf_lo(qu.x), q1 = bf_hi(qu.x), q2 = bf_lo(qu.y), q3 = bf_hi(qu.y);
    const float* lut = WSL(float, WS_LUT) + (g * 8 + h) * 129;
    const float* kc = cache + ((size_t)b * Wb * 2) * 512 + h * 64 + 4 * l16;
    const bf16* kn = KA + ((size_t)NP + b * 4) * 1536 + cb + 4 * l16; const bf16* vn = VA + ((size_t)NP + b * 4) * 1536 + cb + 4 * l16;
    float sc[33];
#pragma unroll
    for (int i0 = 0; i0 < 33; i0 += 11) { f32x4 kv[11]; float lb[11];
#pragma unroll
        for (int u = 0; u < 11; ++u) { const int jj = 4 * (i0 + u) + grp; kv[u] = (f32x4){0.f, 0.f, 0.f, 0.f}; lb[u] = 0.f;
            if (jj <= 128) { const int idx = Wb + s - jj * dil; lb[u] = lut[jj];
                if (idx >= Wb) { const v2u w2 = *(const v2u*)(kn + (size_t)(idx - Wb) * 1536); kv[u] = (f32x4){bf_lo(w2.x), bf_hi(w2.x), bf_lo(w2.y), bf_hi(w2.y)}; }
                else kv[u] = *(const f32x4*)(kc + (size_t)idx * 1024); } }
#pragma unroll
        for (int u = 0; u < 11; ++u) { const int jj = 4 * (i0 + u) + grp;
            float a = (q0 * kv[u][0] + q1 * kv[u][1]) + (q2 * kv[u][2] + q3 * kv[u][3]);
            a += DPP_FA(a, 0xB1); a += DPP_FA(a, 0x4E); a += DPP_FA(a, 0x141); a += DPP_FA(a, 0x128);
            sc[i0 + u] = jj <= 128 ? a + lb[u] : NEG_BIG; }
    }
    float mx = sc[0];
#pragma unroll
    for (int i = 1; i < 33; ++i) mx = fmaxf(mx, sc[i]);
    mx = fmaxf(mx, __shfl_xor(mx, 16)); mx = fmaxf(mx, __shfl_xor(mx, 32));
    float ps = 0.f;
#pragma unroll
    for (int i = 0; i < 33; ++i) { sc[i] = __expf(sc[i] - mx); ps += sc[i]; }
    ps += __shfl_xor(ps, 16); ps += __shfl_xor(ps, 32);
    f32x4 o = {0.f, 0.f, 0.f, 0.f};
#pragma unroll
    for (int i0 = 0; i0 < 33; i0 += 11) { f32x4 vv[11];
#pragma unroll
        for (int u = 0; u < 11; ++u) { const int jj = 4 * (i0 + u) + grp; vv[u] = (f32x4){0.f, 0.f, 0.f, 0.f};
            if (jj <= 128) { const int idx = Wb + s - jj * dil;
                if (idx >= Wb) { const v2u w2 = *(const v2u*)(vn + (size_t)(idx - Wb) * 1536); vv[u] = (f32x4){bf_lo(w2.x), bf_hi(w2.x), bf_lo(w2.y), bf_hi(w2.y)}; }
                else vv[u] = *(const f32x4*)(kc + (size_t)idx * 1024 + 512); } }
#pragma unroll
        for (int u = 0; u < 11; ++u) o += vv[u] * sc[i0 + u];
    }
#pragma unroll
    for (int k = 0; k < 4; ++k) { o[k] += __shfl_xor(o[k], 16); o[k] += __shfl_xor(o[k], 32); }
    const float inv = 1.0f / ps;
    if (grp == 0) { v2u w2; w2.x = cvt_pk_bf16(o[0] * inv, o[1] * inv); w2.y = cvt_pk_bf16(o[2] * inv, o[3] * inv); *(v2u*)(QA + qrow * 1536 + cb + 4 * l16) = w2; }
    if (lane == 0) LSE[((size_t)g * MPAD + qrow) * 8 + h] = mx + __logf(ps);
}

__device__ __forceinline__ void attn_sample_waveitem(Frame& F, int wi) {
    const int g = wi % 3;
    if (g == 0) attn_sample_waveitem_g<0>(F, wi, inptr(F, I_C1)); else if (g == 1) attn_sample_waveitem_g<1>(F, wi, inptr(F, I_C2)); else attn_sample_waveitem_g<2>(F, wi, inptr(F, I_C3));
}
__device__ __forceinline__ void gla_sample_item(Frame& F, int item) {
    LAUNDER_WS();
    LAS float* L = (LAS float*)F.lds;
    constexpr int O_LA = 0, O_QE = 512, O_KE = 1024, O_KD = 1536, O_DEC = 2048, O_ATT = 2176, O_PART = 2304;
    const int tid = F.tid, b = item >> 2, h = item & 3;
    const bf16* QB = WSL(bf16, WS_QB); const bf16* KB = WSL(bf16, WS_KB); bf16* VB = WSL(bf16, WS_VB); const float* AB = WSL(float, WS_AB);
    const size_t row0 = (size_t)NP + b * 4;
    { const int i = tid >> 7, d = tid & 127; float x = inptr(F, I_BG)[h * 128 + d]; const float* wg2 = inptr(F, I_WG2);
#pragma unroll
      for (int r = 0; r < 16; ++r) x += AB[(row0 + i) * 16 + r] * wg2[r * 512 + h * 128 + d];
      L[O_LA + i * 128 + d] = (fminf(x, 0.f) - log1pf(expf(-fabsf(x)))) * (1.0f / 16.0f); }
    __syncthreads();
    if (tid < 128) { const int d = tid; float bb[4]; float run = 0.f;
#pragma unroll
        for (int i = 0; i < 4; ++i) { run += L[O_LA + i * 128 + d]; bb[i] = run; }
        const float ebl = expf(run); L[O_DEC + d] = ebl;
#pragma unroll
        for (int i = 0; i < 4; ++i) { const float q = bf2f(QB[(row0 + i) * 512 + h * 128 + d]), k = bf2f(KB[(row0 + i) * 512 + h * 128 + d]);
            L[O_QE + i * 128 + d] = q * GLA_QSCALE * expf(bb[i]); L[O_KE + i * 128 + d] = k * expf(-bb[i]); L[O_KD + i * 128 + d] = k * expf(run - bb[i]); } }
    __syncthreads();
    if (tid < 16) { const int i = tid >> 2, j = tid & 3; float a = 0.f;
        if (j <= i) for (int d = 0; d < 128; ++d) a += L[O_QE + i * 128 + d] * L[O_KE + j * 128 + d];
        L[O_ATT + tid] = a; }
    const int e = tid & 255, dh = tid >> 8;
    float v[4];
#pragma unroll
    for (int j = 0; j < 4; ++j) v[j] = bf2f(VB[(row0 + j) * 1024 + h * 256 + e]);
    const float* Sin = inptr(F, I_ST0) + ((size_t)(b * 4 + h) * 128) * 256 + e; float* Sout = F.out + OUT_STS + ((size_t)(b * 4 + h) * 128) * 256 + e;
    float acc[4] = {0.f, 0.f, 0.f, 0.f};
#pragma unroll 4
    for (int dd = 0; dd < 64; ++dd) { const int d = dh * 64 + dd; const float sv = Sin[(size_t)d * 256];
#pragma unroll
        for (int i = 0; i < 4; ++i) acc[i] += L[O_QE + i * 128 + d] * sv;
        float sn = L[O_DEC + d] * sv;
#pragma unroll
        for (int j = 0; j < 4; ++j) sn += L[O_KD + j * 128 + d] * v[j];
        Sout[(size_t)d * 256] = sn; }
#pragma unroll
    for (int i = 0; i < 4; ++i) L[O_PART + (dh * 4 + i) * 256 + e] = acc[i];
    __syncthreads();
    if (tid < 256) {
#pragma unroll
        for (int i = 0; i < 4; ++i) { float o = L[O_PART + i * 256 + e] + L[O_PART + (4 + i) * 256 + e];
#pragma unroll
            for (int j = 0; j < 4; ++j) o += L[O_ATT + i * 4 + j] * v[j];
            VB[(row0 + i) * 1024 + h * 256 + e] = f2bf(o); } }
    __syncthreads();
}

static_assert(true, "");
constexpr int P2_ATT = 3072, P2_DEC = 384, P2_GLS = 128, P2_CPY = 32 * (2 + 8 + 32), P2_ITEMS = P2_ATT + P2_DEC + P2_GLS;
__device__ __forceinline__ void kvshift_item(Frame& F, int item) {
    int g, r = item; if (r < 64) g = 0; else if (r < 64 + 256) { g = 1; r -= 64; } else { g = 2; r -= 320; }
    const int Wb = g == 0 ? 128 : (g == 1 ? 512 : 2048), npc = Wb / 64, b = r / npc, pc = r % npc;
    const float* src = inptr(F, g == 0 ? I_C1 : (g == 1 ? I_C2 : I_C3)); float* dst = F.out + (g == 0 ? OUT_KVS1 : (g == 1 ? OUT_KVS2 : OUT_KVS3));
    const int nrow = (pc == npc - 1) ? 60 : 64;
    const f32x4* s4 = (const f32x4*)src + ((size_t)b * Wb + 64 * pc + 4) * 256; f32x4* d4 = (f32x4*)dst + ((size_t)b * Wb + 64 * pc) * 256;
    { const int i = F.tid; f32x4 v[32];
#pragma unroll
        for (int u = 0; u < 32; ++u) if (u < 30 || nrow == 64) v[u] = __builtin_nontemporal_load(s4 + i + u * NTHR);
#pragma unroll
        for (int u = 0; u < 32; ++u) if (u < 30 || nrow == 64) __builtin_nontemporal_store(v[u], d4 + i + u * NTHR); }
}
template <bool STOP_ON_GDONE> __device__ __forceinline__ void kvshift_loop(Frame& F) {
    for (;;) {
        if (F.tid == 0) { unsigned t = 0xffffffffu;
            if (!STOP_ON_GDONE || __hip_atomic_load(F.ctl + CW_GDONE, RLX_AGENT) == 0u) t = __hip_atomic_fetch_add(F.ctl + CW_CPYQ, 1u, RLX_AGENT);
            F.MISC[0] = t; }
        __syncthreads();
        const unsigned t = F.MISC[0];
        __syncthreads();
        if (t >= (unsigned)P2_CPY) break;
        kvshift_item(F, (int)t);
    }
}
__device__ __forceinline__ void p2_prep(Frame& F) {
    unsigned qa[8], ka[8], qb[8], kb[8]; float aa[2], ab2[2];
    int u = blockIdx.x; if (u >= 2048) return;
    const int d2 = F.tid & 63, h = u & 3;
    const float* wg2 = inptr(F, I_WG2); const float* bgp = inptr(F, I_BG);
    f32x2_t wg[16];
#pragma unroll
    for (int r = 0; r < 16; ++r) wg[r] = *(const f32x2_t*)(wg2 + r * 512 + h * 128 + 2 * d2);
    const f32x2_t bgd = *(const f32x2_t*)(bgp + h * 128 + 2 * d2);
    gla_prep_load(F, u, qa, ka, aa);
    for (;;) {
        const int u1 = u + F.G; if (u1 < 2048) gla_prep_load(F, u1, qb, kb, ab2);
        gla_prep_unit(F, u, qa, ka, aa, wg, bgd); if (u1 >= 2048) break;
        const int u2 = u1 + F.G; if (u2 < 2048) gla_prep_load(F, u2, qa, ka, aa);
        gla_prep_unit(F, u1, qb, kb, ab2, wg, bgd); if (u2 >= 2048) break;
        u = u2;
    }
}
__device__ __forceinline__ void p2_mixers(Frame& F) {
#if defined(PROBE_PHASE) && PROBE_PHASE >= 100
    const unsigned long long tp0 = __builtin_amdgcn_s_memrealtime();
#endif
#ifndef P2_SKIP_GLAP
    if (blockIdx.x < 128) {
        const int bx = blockIdx.x, bh = (bx & 7) + 8 * (bx >> 5), sl = (bx >> 3) & 3;
        gla_prompt_unit(F, bh >> 2, bh & 3, sl); }
#endif
#if defined(PROBE_PHASE) && PROBE_PHASE == 100
    if (blockIdx.x == 0) F.tp = __builtin_amdgcn_s_memrealtime() - tp0;
#endif
    constexpr int QCHUNK = 4;
    for (int it = 0, itend = 0;; ++it) {
        if (it >= itend) {
            if (F.tid == 0) F.MISC[0] = __hip_atomic_fetch_add(F.ctl + CW_QUEUE, (unsigned)QCHUNK, RLX_AGENT);
            __syncthreads();
            it = (int)F.MISC[0]; itend = it + QCHUNK;
            __syncthreads();
        }
        if (it >= P2_ITEMS) break;
#if defined(PROBE_PHASE) && PROBE_PHASE == 101
        if (blockIdx.x == 255) F.tp = __builtin_amdgcn_s_memrealtime() - tp0;
#endif
#if defined(PROBE_PHASE) && PROBE_PHASE == 102
        if (blockIdx.x == 255 && it >= P2_GLS + P2_DEC + P2_ATT && F.tp == 0ull) F.tp = __builtin_amdgcn_s_memrealtime() - tp0;
#endif
#if defined(PROBE_PHASE) && PROBE_PHASE >= 103 && PROBE_PHASE <= 106
        const unsigned long long ti0 = __builtin_amdgcn_s_memrealtime();
        const int pcls = it < P2_GLS ? 105 : (it < P2_GLS + P2_DEC ? 104 : (it < P2_GLS + P2_DEC + P2_ATT ? 103 : 106));
#endif
        if (it < P2_GLS) {
#ifndef P2_SKIP_GLAS
            gla_sample_item(F, it);
#endif
        } else if (it < P2_GLS + P2_DEC) {
#ifndef P2_SKIP_DEC
            attn_sample_waveitem(F, (it - P2_GLS) * 8 + F.wave); __syncthreads();
#endif
        } else if (it < P2_GLS + P2_DEC + P2_ATT) {
#ifndef P2_SKIP_ATT
            const int a0 = it - P2_GLS - P2_DEC;
            v4u kk[6], vv[6]; bf16x8 qa[4], qb[4];
            attn_issue(F, a0, kk, vv, qa);
            attn_prompt_item(F, a0, kk, vv, qa, true, a0 + 1, qb);
            attn_prompt_item(F, a0 + 1, kk, vv, qb, true, a0 + 2, qa);
            attn_prompt_item(F, a0 + 2, kk, vv, qa, true, a0 + 3, qb);
            attn_prompt_item(F, a0 + 3, kk, vv, qb, false, 0, qa);
            it = itend - 1;
#endif
        }
#if defined(PROBE_PHASE) && PROBE_PHASE >= 103 && PROBE_PHASE <= 106
        if (blockIdx.x == 255 && pcls == PROBE_PHASE) F.tp += __builtin_amdgcn_s_memrealtime() - ti0;
#endif
    }
#if defined(PROBE_PHASE) && PROBE_PHASE == 107
    const unsigned long long tc0 = __builtin_amdgcn_s_memrealtime();
#endif
    kvshift_loop<false>(F);
#if defined(PROBE_PHASE) && PROBE_PHASE == 107
    if (blockIdx.x == 255) F.tp = __builtin_amdgcn_s_memrealtime() - tc0;
#endif
}

__device__ __forceinline__ void p3_kvout(const bf16* K, const bf16* V, float* dst, int g, int W, int nb, size_t rowbase, int rows_per_b, int first, int pos0, int Wdst, size_t gt, size_t ngt) {
    const size_t per_b = (size_t)W * 2 * 64, tot = per_b * nb;
    for (size_t i0 = gt; i0 < tot; i0 += 4 * ngt) { v4u u[4]; float* o[4];
#pragma unroll
        for (int k = 0; k < 4; ++k) { const size_t i = i0 + k * ngt; if (i < tot) { const size_t b = i / per_b, r = i - b * per_b; const int p = (int)(r >> 7), c = (int)(r >> 6) & 1, ch = (int)r & 63;
            u[k] = *(const v4u*)((c ? V : K) + (rowbase + b * rows_per_b + first + p) * 1536 + g * 512 + ch * 8);
            o[k] = dst + ((b * Wdst + pos0 + p) * 2 + c) * 512 + ch * 8; } }
#pragma unroll
        for (int k = 0; k < 4; ++k) if (i0 + k * ngt < tot) {
            *(f32x4*)o[k] = (f32x4){bf_lo(u[k].x), bf_hi(u[k].x), bf_lo(u[k].y), bf_hi(u[k].y)}; *(f32x4*)(o[k] + 4) = (f32x4){bf_lo(u[k].z), bf_hi(u[k].z), bf_lo(u[k].w), bf_hi(u[k].w)}; } }
}
struct MergeRow { float l0, l1, l2; v4u a, b2, c, u0, u1, r0, r1; };
__device__ __forceinline__ void p3_merge_load(const bf16* OA, const bf16* OB, const bf16* RB, const float* LSE, int m, int lane, MergeRow& R) {
    const int hd = lane >> 3, c8 = (lane & 7) * 8, c0 = lane * 16;
    R.l0 = LSE[((size_t)0 * MPAD + m) * 8 + hd]; R.l1 = LSE[((size_t)1 * MPAD + m) * 8 + hd]; R.l2 = LSE[((size_t)2 * MPAD + m) * 8 + hd];
    R.a = *(const v4u*)(OA + (size_t)m * 1536 + hd * 64 + c8); R.b2 = *(const v4u*)(OA + (size_t)m * 1536 + 512 + hd * 64 + c8); R.c = *(const v4u*)(OA + (size_t)m * 1536 + 1024 + hd * 64 + c8);
    R.u0 = *(const v4u*)(OB + (size_t)m * 1024 + c0); R.u1 = *(const v4u*)(OB + (size_t)m * 1024 + c0 + 8);
    R.r0 = *(const v4u*)(RB + (size_t)m * 1024 + c0); R.r1 = *(const v4u*)(RB + (size_t)m * 1024 + c0 + 8);
}
__device__ __forceinline__ void p3_merge(Frame& F) {
    const int gw = blockIdx.x * NWAVES + F.wave, NGW = F.G * NWAVES, lane = F.lane;
    const size_t gt = (size_t)blockIdx.x * NTHR + F.tid, ngt = (size_t)F.G * NTHR;
    const bf16* OA = WSP(bf16, WS_QA); const bf16* OB = WSP(bf16, WS_VB); const bf16* RB = WSP(bf16, WS_RB); const float* LSE = WSP(float, WS_LSE);
    bf16* OAM = WSP(bf16, WS_OAM); bf16* OBN = WSP(bf16, WS_OBN); const float* gn = inptr(F, I_GN);
    float gnv[16];
#pragma unroll
    for (int i = 0; i < 16; ++i) gnv[i] = gn[lane * 16 + i];
    for (int m = NTOK + gw; m < MPAD; m += NGW) {
        *(v4u*)(OAM + (size_t)m * 512 + lane * 8) = (v4u){0u, 0u, 0u, 0u}; *(v4u*)(OBN + (size_t)m * 1024 + lane * 16) = (v4u){0u, 0u, 0u, 0u}; *(v4u*)(OBN + (size_t)m * 1024 + lane * 16 + 8) = (v4u){0u, 0u, 0u, 0u}; }
    int m = gw;
    if (m < NTOK) {
        MergeRow R, Rn; p3_merge_load(OA, OB, RB, LSE, m, lane, R);
        for (;;) {
            const int mn = m + NGW; const bool more = mn < NTOK;
            if (more) p3_merge_load(OA, OB, RB, LSE, mn, lane, Rn);
            {
                const int hd = lane >> 3, c8 = (lane & 7) * 8;
                const float l0 = R.l0, l1 = R.l1, l2 = R.l2;
                const float mx = fmaxf(l0, fmaxf(l1, l2)); float w0 = __expf(l0 - mx), w1 = __expf(l1 - mx), w2 = __expf(l2 - mx); const float iw = 1.0f / (w0 + w1 + w2); w0 *= iw; w1 *= iw; w2 *= iw;
                const v4u a = R.a, b2 = R.b2, c = R.c;
                v4u o;
                o.x = cvt_pk_bf16(w0 * bf_lo(a.x) + w1 * bf_lo(b2.x) + w2 * bf_lo(c.x), w0 * bf_hi(a.x) + w1 * bf_hi(b2.x) + w2 * bf_hi(c.x));
                o.y = cvt_pk_bf16(w0 * bf_lo(a.y) + w1 * bf_lo(b2.y) + w2 * bf_lo(c.y), w0 * bf_hi(a.y) + w1 * bf_hi(b2.y) + w2 * bf_hi(c.y));
                o.z = cvt_pk_bf16(w0 * bf_lo(a.z) + w1 * bf_lo(b2.z) + w2 * bf_lo(c.z), w0 * bf_hi(a.z) + w1 * bf_hi(b2.z) + w2 * bf_hi(c.z));
                o.w = cvt_pk_bf16(w0 * bf_lo(a.w) + w1 * bf_lo(b2.w) + w2 * bf_lo(c.w), w0 * bf_hi(a.w) + w1 * bf_hi(b2.w) + w2 * bf_hi(c.w));
                *(v4u*)(OAM + (size_t)m * 512 + hd * 64 + c8) = o;
            }
            {
                const int c0 = lane * 16;
                const v4u u0 = R.u0, u1 = R.u1, r0 = R.r0, r1 = R.r1;
                float x[16] = {bf_lo(u0.x), bf_hi(u0.x), bf_lo(u0.y), bf_hi(u0.y), bf_lo(u0.z), bf_hi(u0.z), bf_lo(u0.w), bf_hi(u0.w), bf_lo(u1.x), bf_hi(u1.x), bf_lo(u1.y), bf_hi(u1.y), bf_lo(u1.z), bf_hi(u1.z), bf_lo(u1.w), bf_hi(u1.w)};
                float rr[16] = {bf_lo(r0.x), bf_hi(r0.x), bf_lo(r0.y), bf_hi(r0.y), bf_lo(r0.z), bf_hi(r0.z), bf_lo(r0.w), bf_hi(r0.w), bf_lo(r1.x), bf_hi(r1.x), bf_lo(r1.y), bf_hi(r1.y), bf_lo(r1.z), bf_hi(r1.z), bf_lo(r1.w), bf_hi(r1.w)};
                float ss = 0.f;
#pragma unroll
                for (int i = 0; i < 16; ++i) ss += x[i] * x[i];
                ss += __shfl_xor(ss, 1); ss += __shfl_xor(ss, 2); ss += __shfl_xor(ss, 4); ss += __shfl_xor(ss, 8);
                const float rs = 1.0f / sqrtf(ss * (1.0f / 256.0f) + LN_EPS);
                float y[16];
#pragma unroll
                for (int i = 0; i < 16; ++i) { const float gte = rr[i] * __builtin_amdgcn_rcpf(1.0f + __expf(-rr[i])); y[i] = x[i] * rs * gnv[i] * gte; }
                v4u o0, o1; o0.x = cvt_pk_bf16(y[0], y[1]); o0.y = cvt_pk_bf16(y[2], y[3]); o0.z = cvt_pk_bf16(y[4], y[5]); o0.w = cvt_pk_bf16(y[6], y[7]);
                o1.x = cvt_pk_bf16(y[8], y[9]); o1.y = cvt_pk_bf16(y[10], y[11]); o1.z = cvt_pk_bf16(y[12], y[13]); o1.w = cvt_pk_bf16(y[14], y[15]);
                *(v4u*)(OBN + (size_t)m * 1024 + c0) = o0; *(v4u*)(OBN + (size_t)m * 1024 + c0 + 8) = o1;
            }
            if (!more) break;
            R = Rn; m = mn;
        }
    }
    const bf16* KA = WSP(bf16, WS_KA); const bf16* VA = WSP(bf16, WS_VA);
    p3_kvout(KA, VA, F.out + OUT_KVP1, 0, 128, 8, 0, TSEQ, TSEQ - 128, 0, 128, gt, ngt);
    p3_kvout(KA, VA, F.out + OUT_KVP2, 1, 512, 8, 0, TSEQ, TSEQ - 512, 0, 512, gt, ngt);
    p3_kvout(KA, VA, F.out + OUT_KVP3, 2, 2048, 8, 0, TSEQ, TSEQ - 2048, 0, 2048, gt, ngt);
    p3_kvout(KA, VA, F.out + OUT_KVS1, 0, 4, 32, NP, 4, 0, 124, 128, gt, ngt);
    p3_kvout(KA, VA, F.out + OUT_KVS2, 1, 4, 32, NP, 4, 0, 508, 512, gt, ngt);
    p3_kvout(KA, VA, F.out + OUT_KVS3, 2, 4, 32, NP, 4, 0, 2044, 2048, gt, ngt);
}

__device__ __forceinline__ void p6_ln1(Frame& F) {
    const int gw = blockIdx.x * NWAVES + F.wave, NGW = F.G * NWAVES, lane = F.lane;
    float* H = WSP(float, WS_H); bf16* X1B = WSP(bf16, WS_X1B); const float* l1g = inptr(F, I_L1G); const float* l1b = inptr(F, I_L1B);
    f32x4 gg[4], bb[4];
#pragma unroll
    for (int j = 0; j < 4; ++j) { gg[j] = ((const f32x4*)l1g)[lane + 64 * j]; bb[j] = ((const f32x4*)l1b)[lane + 64 * j]; }
    int m = gw; if (m >= MPAD) return;
    f32x4 v[4], vn[4];
#pragma unroll
    for (int j = 0; j < 4; ++j) v[j] = ((const f32x4*)(H + (size_t)m * 1024) + lane)[64 * j];
    for (;;) {
        const int mn = m + NGW; const bool more = mn < MPAD;
        if (more) {
#pragma unroll
            for (int j = 0; j < 4; ++j) vn[j] = ((const f32x4*)(H + (size_t)mn * 1024) + lane)[64 * j]; }
        float s = 0.f;
#pragma unroll
        for (int j = 0; j < 4; ++j) s += (v[j][0] + v[j][1]) + (v[j][2] + v[j][3]);
        const float mean = wave_sum(s) * (1.f / 1024.f); float s2 = 0.f;
#pragma unroll
        for (int j = 0; j < 4; ++j) { v[j] = v[j] - mean; s2 += (v[j][0] * v[j][0] + v[j][1] * v[j][1]) + (v[j][2] * v[j][2] + v[j][3] * v[j][3]); }
        const float rstd = 1.f / sqrtf(wave_sum(s2) * (1.f / 1024.f) + LN_EPS);
        f32x4* hr = (f32x4*)(H + (size_t)m * 1024) + lane;
        unsigned long long* o8 = (unsigned long long*)(X1B + (size_t)m * 1024) + lane;
#pragma unroll
        for (int j = 0; j < 4; ++j) { const f32x4 y = v[j] * rstd * gg[j] + bb[j]; hr[64 * j] = y;
            o8[64 * j] = (unsigned long long)cvt_pk_bf16(y[0], y[1]) | ((unsigned long long)cvt_pk_bf16(y[2], y[3]) << 32); }
        if (!more) break;
#pragma unroll
        for (int j = 0; j < 4; ++j) v[j] = vn[j];
        m = mn;
    }
}

__device__ __forceinline__ unsigned mono_key(float f) { const unsigned u = __float_as_uint(f); return u ^ ((unsigned)((int)u >> 31) | 0x80000000u); }
__device__ __forceinline__ float mono_inv(unsigned k) { return __uint_as_float((k & 0x80000000u) ? (k ^ 0x80000000u) : ~k); }
#define CE_DESC(a, b) do { const unsigned _mx = (a) > (b) ? (a) : (b), _mn = (a) > (b) ? (b) : (a); (a) = _mx; (b) = _mn; } while (0)
template <int J> __device__ __forceinline__ void bitonic_step_desc(unsigned (&v)[16]) {
#pragma unroll
    for (int i = 0; i < 16; ++i) if ((i & J) == 0) CE_DESC(v[i], v[i | J]);
}
template <int K, int J> __device__ __forceinline__ void bitonic_step(unsigned (&v)[16]) {
#pragma unroll
    for (int i = 0; i < 16; ++i) if ((i & J) == 0) { if ((i & K) == 0) CE_DESC(v[i], v[i | J]); else CE_DESC(v[i | J], v[i]); }
}
__device__ __forceinline__ void sort16_desc(unsigned (&v)[16]) {
    bitonic_step<2, 1>(v);
    bitonic_step<4, 2>(v); bitonic_step<4, 1>(v);
    bitonic_step<8, 4>(v); bitonic_step<8, 2>(v); bitonic_step<8, 1>(v);
    bitonic_step_desc<8>(v); bitonic_step_desc<4>(v); bitonic_step_desc<2>(v); bitonic_step_desc<1>(v);
}
__device__ __forceinline__ void merge16_desc(unsigned (&T)[16], const unsigned (&N)[16]) {
#pragma unroll
    for (int k = 0; k < 16; ++k) T[k] = T[k] > N[15 - k] ? T[k] : N[15 - k];
    bitonic_step_desc<8>(T); bitonic_step_desc<4>(T); bitonic_step_desc<2>(T); bitonic_step_desc<1>(T);
}
__device__ __forceinline__ void merge_partner16(unsigned (&T)[16]) {
    unsigned P[16];
#pragma unroll
    for (int k = 0; k < 16; ++k) P[k] = (unsigned)__shfl_xor((int)T[k], 32);
    merge16_desc(T, P);
}
__device__ __forceinline__ void p8_topk_item(Frame& F, int item) {
    const int lane = F.lane, hh = lane >> 5, il = lane & 31;
    const int tb = item >> 3, hd = item & 7; const int row = 32 * tb + il;
    const bf16* QN = WSP(bf16, WS_QN); const bf16* KEYS = WSP(bf16, WS_KEYS); int* EIDX = WSP(int, WS_EIDX); float* GATE = WSP(float, WS_GATE);
    LAS unsigned* LK = (LAS unsigned*)(F.lds + F.wave * 8192);
    unsigned T1[16], T2[16];
    bf16x8 bqh[2][8], kf[8];
#pragma unroll
    for (int half = 0; half < 2; ++half)
#pragma unroll
        for (int s = 0; s < 8; ++s) bqh[half][s] = *(const bf16x8*)(QN + (size_t)row * 2048 + hd * 256 + half * 128 + 16 * s + 8 * hh);
#pragma unroll
    for (int s = 0; s < 8; ++s) kf[s] = *(const bf16x8*)(KEYS + ((size_t)(hd * 2) * 128 + il) * 128 + 8 * hh + 16 * s);
#pragma unroll
    for (int half = 0; half < 2; ++half) {
        const bf16x8 (&bq)[8] = bqh[half];
        unsigned T[16];
#pragma unroll
        for (int k = 0; k < 16; ++k) T[k] = 0u;
        const bf16* kbase = KEYS + ((size_t)(hd * 2 + half) * 128 + il) * 128 + 8 * hh;
#pragma unroll 1
        for (int kt = 0; kt < 4; ++kt) {
            f32x16 acc;
#pragma unroll
            for (int x = 0; x < 16; ++x) acc[x] = 0.f;
#pragma unroll
            for (int s = 0; s < 8; ++s) acc = MFMA32(kf[s], bq[s], acc);
            if (kt < 3 || half == 0) {
                const bf16* kn = kt < 3 ? kbase + (size_t)(32 * (kt + 1)) * 128 : kbase + (size_t)128 * 128;
#pragma unroll
                for (int s = 0; s < 8; ++s) kf[s] = *(const bf16x8*)(kn + 16 * s); }
            unsigned N[16];
#pragma unroll
            for (int x = 0; x < 16; ++x) { const int idx = 32 * kt + crow(x, hh); N[x] = (mono_key(acc[x]) & ~127u) | (unsigned)(127 - idx); }
            sort16_desc(N);
            merge16_desc(T, N);
        }
        merge_partner16(T);
#pragma unroll
        for (int k = 0; k < 16; ++k) { LK[(half * 16 + k) * 64 + lane] = T[k]; if (half == 0) T1[k] = T[k]; else T2[k] = T[k]; }
    }
    float v1s[8], v2[16];
#pragma unroll
    for (int k = 0; k < 16; ++k) v2[k] = mono_inv(T2[k] & ~127u);
#pragma unroll
    for (int i2 = 0; i2 < 8; ++i2) v1s[i2] = mono_inv((hh ? T1[2 * i2 + 1] : T1[2 * i2]) & ~127u);
    unsigned C[16], D[16];
#pragma unroll
    for (int k = 0; k < 16; ++k) { C[k] = 0u; D[k] = 0u; }
    {   int n = 0;
#pragma unroll
        for (int i2 = 0; i2 < 8; ++i2)
#pragma unroll
            for (int c = 0; c < 16; ++c) if ((2 * i2 + 1) * (c + 1) <= 16) { const unsigned key = (mono_key(v1s[i2] + v2[c]) & ~255u) | (unsigned)(255 - (16 * (2 * i2 + hh) + c));
                if (n < 16) C[n] = key; else D[n - 16] = key; ++n; }
    }
    sort16_desc(C); sort16_desc(D); merge16_desc(C, D);
    merge_partner16(C);
    LDS_WAIT(); asm volatile("" ::: "memory");
    float sv[16]; int ex[16]; float mx = NEG_BIG;
#pragma unroll
    for (int k = 0; k < 16; ++k) { const int si = 255 - (int)(C[k] & 255u), a = si >> 4, c = si & 15;
        const unsigned k1 = LK[a * 64 + lane], k2 = LK[(16 + c) * 64 + lane];
        ex[k] = (127 - (int)(k1 & 127u)) * 128 + (127 - (int)(k2 & 127u)); sv[k] = mono_inv(k1 & ~127u) + mono_inv(k2 & ~127u); mx = fmaxf(mx, sv[k]); }
    float den = 0.f;
#pragma unroll
    for (int k = 0; k < 16; ++k) { sv[k] = __expf(sv[k] - mx); den += sv[k]; }
    const float iden = 1.0f / den;
    if (hh == 0 && row < NTOK) {
#pragma unroll
        for (int k4 = 0; k4 < 4; ++k4) { *(int4*)(EIDX + (size_t)row * 128 + hd * 16 + 4 * k4) = make_int4(ex[4 * k4], ex[4 * k4 + 1], ex[4 * k4 + 2], ex[4 * k4 + 3]);
            *(f32x4*)(GATE + (size_t)row * 128 + hd * 16 + 4 * k4) = (f32x4){sv[4 * k4] * iden, sv[4 * k4 + 1] * iden, sv[4 * k4 + 2] * iden, sv[4 * k4 + 3] * iden}; } }
    LDS_WAIT(); asm volatile("" ::: "memory");
}

constexpr size_t WS_ACTP = WS_QB, WS_COEF = WS_KA, WS_PEERO = WS_RB, WS_X1H = WS_VA;
static_assert(WS_ACTP + (size_t)8 * NTOK * 128 * 4 <= WS_RB && WS_PEERO + (size_t)NTOK * 1024 * 4 <= WS_GB, "peer buffers");
__device__ __forceinline__ float gelu_erf(float x) { return 0.5f * x * (1.0f + erff(x * 0.70710678118654752f)); }
#define DPP_F(x, ctrl) __uint_as_float((unsigned)__builtin_amdgcn_mov_dpp((int)__float_as_uint(x), (ctrl), 0xf, 0xf, true))
__device__ __forceinline__ float dot16_fp8(const float (&x)[16], const v4u u) {
    float a = 0.f;
#pragma unroll
    for (int q = 0; q < 4; ++q) { const f32x2_t lo = __builtin_amdgcn_cvt_pk_f32_fp8((int)u[q], false), hi = __builtin_amdgcn_cvt_pk_f32_fp8((int)u[q], true);
        a += x[4 * q] * lo.x + x[4 * q + 1] * lo.y + x[4 * q + 2] * hi.x + x[4 * q + 3] * hi.y; }
    return a;
}
typedef float f32x4_t __attribute__((ext_vector_type(4)));
typedef int i32x4_t __attribute__((ext_vector_type(4)));
#ifndef PEER_CVT_VIA_F32
#define PEER_CVT_VIA_F32 0
#endif
#ifndef PEER_DOT_F32
#define PEER_DOT_F32 0
#endif
#if PEER_DOT_F32
#define PEER_DOT2(d, a, b) do { const h2_t a__ = (a), b__ = (b); d += (float)a__.x * (float)b__.x + (float)a__.y * (float)b__.y; } while (0)
#else
#define PEER_DOT2(d, a, b) d = __builtin_amdgcn_fdot2((a), (b), d, false)
#endif
template <bool HI> __device__ __forceinline__ h2_t fp8x2_to_h2(int w) {
#if PEER_CVT_VIA_F32
    const f32x2_t f = __builtin_amdgcn_cvt_pk_f32_fp8(w, HI); return (h2_t){(_Float16)f.x, (_Float16)f.y};
#else
    return __builtin_amdgcn_cvt_scalef32_pk_f16_fp8(w, 1.0f, HI);
#endif
}
template <unsigned EMASK> __device__ __forceinline__ void peer_u_phase_t(Frame& F) {
    const int lane = F.lane, p = lane >> 3, q = lane & 7, c = blockIdx.x & 7, wv = (blockIdx.x >> 3) * NWAVES + F.wave, nwv = (F.G >> 3) * NWAVES;
    const int* EIDX = WSP(int, WS_EIDX) + 16 * p; float* ACTP = WSP(float, WS_ACTP) + (size_t)c * NTOK * 128 + 16 * p + 2 * q;
    const unsigned char* U8 = WSP(unsigned char, WS_UT) + ((size_t)c * 16384 << 7) + 16 * q;
#define PU_LOADE(EV, M) do { _Pragma("unroll") for (int t_ = 0; t_ < 4; ++t_) EV[t_] = *(const i32x4_t*)(EIDX + (size_t)(M) * 128 + 4 * t_); } while (0)
#define PU_ISSUE(UR, EV) do { _Pragma("unroll") for (int g = 0; g < 16; ++g) UR[g] = *(const v4u*)(U8 + (((unsigned)EV[g >> 2][g & 3] & EMASK) << 7)); } while (0)
#define PU_BODY(UR, UN, M) do { const int m_ = (M); const int m1_ = m_ + nwv, m2_ = m_ + 2 * nwv; \
        if (m1_ < NTOK) PU_ISSUE(UN, ev); \
        if (m2_ < NTOK) PU_LOADE(ev, m2_); \
        const float* xf_ = (const float*)(F.ws + WS_H) + (size_t)m_ * 1024 + 128 * c + 16 * q; \
        const f32x4 xa_ = *(const f32x4*)xf_, xb_ = *(const f32x4*)(xf_ + 4), xc_ = *(const f32x4*)(xf_ + 8), xd_ = *(const f32x4*)(xf_ + 12); \
        const h2_t xh[8] = {(h2_t){(_Float16)xa_[0], (_Float16)xa_[1]}, (h2_t){(_Float16)xa_[2], (_Float16)xa_[3]}, (h2_t){(_Float16)xb_[0], (_Float16)xb_[1]}, (h2_t){(_Float16)xb_[2], (_Float16)xb_[3]}, (h2_t){(_Float16)xc_[0], (_Float16)xc_[1]}, (h2_t){(_Float16)xc_[2], (_Float16)xc_[3]}, (h2_t){(_Float16)xd_[0], (_Float16)xd_[1]}, (h2_t){(_Float16)xd_[2], (_Float16)xd_[3]}}; \
        float a[16]; \
        _Pragma("unroll") for (int g = 0; g < 16; ++g) { float d_ = 0.f; \
            _Pragma("unroll") for (int t_ = 0; t_ < 4; ++t_) { PEER_DOT2(d_, fp8x2_to_h2<false>((int)UR[g][t_]), xh[2 * t_]); PEER_DOT2(d_, fp8x2_to_h2<true>((int)UR[g][t_]), xh[2 * t_ + 1]); } \
            a[g] = d_; if ((g & 1) == 1 && g < 15) asm volatile("" : "+v"(a[g - 1]), "+v"(a[g]), "+v"(UR[(g + 1) & 15]), "+v"(UR[(g + 2) & 15])); } \
        float b8[8], b4[4], b2[2]; \
        { const bool up = (q & 4) != 0; _Pragma("unroll") for (int k = 0; k < 8; ++k) { const float send = up ? a[k] : a[k + 8], keep = up ? a[k + 8] : a[k]; b8[k] = keep + DPP_F(send, 0x141); } } \
        { const bool up = (q & 2) != 0; _Pragma("unroll") for (int k = 0; k < 4; ++k) { const float send = up ? b8[k] : b8[k + 4], keep = up ? b8[k + 4] : b8[k]; b4[k] = keep + DPP_F(send, 0x4E); } } \
        { const bool up = (q & 1) != 0; _Pragma("unroll") for (int k = 0; k < 2; ++k) { const float send = up ? b4[k] : b4[k + 2], keep = up ? b4[k + 2] : b4[k]; b2[k] = keep + DPP_F(send, 0xB1); } } \
        *(f32x2_t*)(ACTP + (size_t)m_ * 128) = (f32x2_t){b2[0], b2[1]}; } while (0)
    int m = wv; if (m >= NTOK) return;
    i32x4_t ev[4];
    PU_LOADE(ev, m);
    v4u ua[16], ub[16];
    PU_ISSUE(ua, ev);
    if (m + nwv < NTOK) PU_LOADE(ev, m + nwv);
    for (;;) {
        PU_BODY(ua, ub, m); m += nwv; if (m >= NTOK) break;
        PU_BODY(ub, ua, m); m += nwv; if (m >= NTOK) break;
    }
#undef PU_LOADE
#undef PU_ISSUE
#undef PU_BODY
}
__device__ __forceinline__ void peer_u_phase(Frame& F) { peer_u_phase_t<0xffffffffu>(F); }
__device__ __forceinline__ void peer_coef_phase(Frame& F) {
    const int gw = blockIdx.x * NWAVES + F.wave, NGW = F.G * NWAVES, lane = F.lane;
    const float* ACTP = WSP(float, WS_ACTP); const float* GATE = WSP(float, WS_GATE); float* COEF = WSP(float, WS_COEF);
    int m = gw; if (m >= NTOK) return;
    float av[2][8], gv[2], an[2][8], gnx[2];
#pragma unroll
    for (int hf = 0; hf < 2; ++hf) { const int k = lane + 64 * hf; gv[hf] = GATE[(size_t)m * 128 + k];
#pragma unroll
        for (int c = 0; c < 8; ++c) av[hf][c] = ACTP[((size_t)c * NTOK + m) * 128 + k]; }
    for (;;) {
        const int mn = m + NGW; const bool more = mn < NTOK;
        if (more) {
#pragma unroll
            for (int hf = 0; hf < 2; ++hf) { const int k = lane + 64 * hf; gnx[hf] = GATE[(size_t)mn * 128 + k];
#pragma unroll
                for (int c = 0; c < 8; ++c) an[hf][c] = ACTP[((size_t)c * NTOK + mn) * 128 + k]; } }
#pragma unroll
        for (int hf = 0; hf < 2; ++hf) { const int k = lane + 64 * hf; float a = 0.f;
#pragma unroll
            for (int c = 0; c < 8; ++c) a += av[hf][c];
            COEF[(size_t)m * 128 + k] = gv[hf] * gelu_erf(a * (1.0f / U_SCALE)); }
        if (!more) break;
#pragma unroll
        for (int hf = 0; hf < 2; ++hf) { gv[hf] = gnx[hf];
#pragma unroll
            for (int c = 0; c < 8; ++c) av[hf][c] = an[hf][c]; }
        m = mn;
    }
}
__device__ __forceinline__ void peer_v_phase(Frame& F) {
    const int lane = F.lane, p = lane >> 3, q = lane & 7, c = blockIdx.x & 7, wv = (blockIdx.x >> 3) * NWAVES + F.wave, nwv = (F.G >> 3) * NWAVES;
    const int* EIDX = WSP(int, WS_EIDX) + 16 * p; const float* COEF = WSP(float, WS_COEF) + 16 * p; bf16* PEERO = WSP(bf16, WS_PEERO) + 128 * c + 16 * q + 2 * p;
    const unsigned char* V8 = WSP(unsigned char, WS_VT) + ((size_t)c * 16384 << 7) + 16 * q;
    int m = wv; if (m >= NTOK) return;
    i32x4_t ev[4];
#pragma unroll
    for (int t = 0; t < 4; ++t) ev[t] = *(const i32x4_t*)(EIDX + (size_t)m * 128 + 4 * t);
    v4u vr[16];
#pragma unroll
    for (int g = 0; g < 16; ++g) vr[g] = *(const v4u*)(V8 + ((unsigned)ev[g >> 2][g & 3] << 7));
    for (;;) {
        f32x4_t cv[4];
#pragma unroll
        for (int t = 0; t < 4; ++t) cv[t] = *(const f32x4_t*)(COEF + (size_t)m * 128 + 4 * t);
        const int mn = m + nwv; const bool more = mn < NTOK;
        if (more) {
#pragma unroll
            for (int t = 0; t < 4; ++t) ev[t] = *(const i32x4_t*)(EIDX + (size_t)mn * 128 + 4 * t); }
        h2_t acc[8];
#pragma unroll
        for (int i = 0; i < 8; ++i) acc[i] = (h2_t){(_Float16)0.f, (_Float16)0.f};
#pragma unroll
        for (int g = 0; g < 16; ++g) { const _Float16 cfh = (_Float16)cv[g >> 2][g & 3]; const h2_t cf2 = {cfh, cfh};
#pragma unroll
            for (int t = 0; t < 4; ++t) { acc[2 * t] += fp8x2_to_h2<false>((int)vr[g][t]) * cf2; acc[2 * t + 1] += fp8x2_to_h2<true>((int)vr[g][t]) * cf2; }
            if ((g & 3) == 3 && g < 15) asm volatile("" : "+v"(acc[0]), "+v"(acc[1]), "+v"(acc[2]), "+v"(acc[3]), "+v"(acc[4]), "+v"(acc[5]), "+v"(acc[6]), "+v"(acc[7]), "+v"(vr[(g + 1) & 15]), "+v"(vr[(g + 2) & 15]), "+v"(vr[(g + 3) & 15]), "+v"(vr[(g + 4) & 15])); }
        __builtin_amdgcn_sched_barrier(0);
        if (more) {
#pragma unroll
            for (int g = 0; g < 16; ++g) vr[g] = *(const v4u*)(V8 + ((unsigned)ev[g >> 2][g & 3] << 7)); }
        __builtin_amdgcn_sched_barrier(0);
        unsigned w[8];
#pragma unroll
        for (int i = 0; i < 8; ++i) w[i] = __builtin_bit_cast(unsigned, acc[i]);
        h2_t r4[4], r2[2], r1;
        { const bool up = (lane & 32) != 0;
#pragma unroll
          for (int k = 0; k < 4; ++k) { const unsigned send = up ? w[k] : w[k + 4], keep = up ? w[k + 4] : w[k]; r4[k] = __builtin_bit_cast(h2_t, keep) + __builtin_bit_cast(h2_t, (unsigned)__shfl_xor((int)send, 32)); } }
        { const bool up = (lane & 16) != 0;
#pragma unroll
          for (int k = 0; k < 2; ++k) { const unsigned a_ = __builtin_bit_cast(unsigned, r4[k]), b_ = __builtin_bit_cast(unsigned, r4[k + 2]); const unsigned send = up ? a_ : b_, keep = up ? b_ : a_; r2[k] = __builtin_bit_cast(h2_t, keep) + __builtin_bit_cast(h2_t, (unsigned)__shfl_xor((int)send, 16)); } }
        { const bool up = (lane & 8) != 0; const unsigned a_ = __builtin_bit_cast(unsigned, r2[0]), b_ = __builtin_bit_cast(unsigned, r2[1]); const unsigned send = up ? a_ : b_, keep = up ? b_ : a_;
          r1 = __builtin_bit_cast(h2_t, keep) + __builtin_bit_cast(h2_t, (unsigned)__builtin_amdgcn_mov_dpp((int)send, 0x128, 0xf, 0xf, true)); }
        *(unsigned*)(PEERO + (size_t)m * 1024) = cvt_pk_bf16((float)r1.x * (1.0f / V_SCALE), (float)r1.y * (1.0f / V_SCALE));
        if (!more) break;
        m = mn;
    }
}
__device__ __forceinline__ void peer_ln2_phase(Frame& F) {
    const int gw = blockIdx.x * NWAVES + F.wave, NGW = F.G * NWAVES, lane = F.lane;
    const float* X1 = WSP(float, WS_H); const bf16* PEERO = WSP(bf16, WS_PEERO); const float* l2g = inptr(F, I_L2G); const float* l2b = inptr(F, I_L2B);
    f32x4 gg[4], bb[4];
#pragma unroll
    for (int t = 0; t < 4; ++t) { gg[t] = *(const f32x4*)(l2g + 4 * lane + 256 * t); bb[t] = *(const f32x4*)(l2b + 4 * lane + 256 * t); }
    int m = gw; if (m >= NTOK) return;
    f32x4 xa[4], xn[4]; v2u pa[4], pn[4];
#pragma unroll
    for (int t = 0; t < 4; ++t) { xa[t] = *(const f32x4*)(X1 + (size_t)m * 1024 + 4 * lane + 256 * t); pa[t] = *(const v2u*)(PEERO + (size_t)m * 1024 + 4 * lane + 256 * t); }
    for (;;) {
        const int mn = m + NGW; const bool more = mn < NTOK;
        if (more) {
#pragma unroll
            for (int t = 0; t < 4; ++t) { xn[t] = *(const f32x4*)(X1 + (size_t)mn * 1024 + 4 * lane + 256 * t); pn[t] = *(const v2u*)(PEERO + (size_t)mn * 1024 + 4 * lane + 256 * t); } }
        float acc[16]; float s = 0.f;
#pragma unroll
        for (int t = 0; t < 4; ++t) { const float pz[4] = {bf_lo(pa[t].x), bf_hi(pa[t].x), bf_lo(pa[t].y), bf_hi(pa[t].y)};
#pragma unroll
            for (int i = 0; i < 4; ++i) { acc[4 * t + i] = ALPHA * xa[t][i] + pz[i]; s += acc[4 * t + i]; } }
        const float mean = wave_sum(s) * (1.f / 1024.f); float s2 = 0.f;
#pragma unroll
        for (int i = 0; i < 16; ++i) { acc[i] -= mean; s2 += acc[i] * acc[i]; }
        const float rstd = 1.f / sqrtf(wave_sum(s2) * (1.f / 1024.f) + LN_EPS);
        float* yo = m < NP ? F.out + OUT_YP + (size_t)m * 1024 : F.out + OUT_YS + (size_t)(m - NP) * 1024;
#pragma unroll
        for (int t = 0; t < 4; ++t) { const int cc = 4 * lane + 256 * t;
            *(f32x4*)(yo + cc) = (f32x4){acc[4 * t] * rstd * gg[t][0] + bb[t][0], acc[4 * t + 1] * rstd * gg[t][1] + bb[t][1], acc[4 * t + 2] * rstd * gg[t][2] + bb[t][2], acc[4 * t + 3] * rstd * gg[t][3] + bb[t][3]}; }
        if (!more) break;
#pragma unroll
        for (int t = 0; t < 4; ++t) { xa[t] = xn[t]; pa[t] = pn[t]; }
        m = mn;
    }
}

template <class Epi> __device__ __forceinline__ void skinny_sample_gemm(Frame& F, const bf16* A, const bf16* Bt, int K, const Epi& epi) {
    typedef float f32x4a __attribute__((ext_vector_type(4)));
    const int lane = F.lane, r = lane & 15, kg = lane >> 4;
    for (int strip = blockIdx.x; strip < 64; strip += F.G) {
        const bf16* ap = A + (size_t)(NP + 16 * F.wave + r) * K + 8 * kg;
        const bf16* bp = Bt + (size_t)(16 * strip + r) * K + 8 * kg;
        f32x4a acc = {0.f, 0.f, 0.f, 0.f};
        for (int s0 = 0; s0 < K / 32; s0 += 16) { bf16x8 af[16], bfr[16];
#pragma unroll
            for (int u = 0; u < 16; ++u) { af[u] = *(const bf16x8*)(ap + 32 * (s0 + u)); bfr[u] = *(const bf16x8*)(bp + 32 * (s0 + u)); }
#pragma unroll
            for (int u = 0; u < 16; ++u) acc = __builtin_amdgcn_mfma_f32_16x16x32_bf16(af[u], bfr[u], acc, 0, 0, 0); }
#pragma unroll
        for (int i = 0; i < 4; ++i) epi(NP + 16 * F.wave + 4 * kg + i, 16 * strip + r, acc[i]);
    }
}

struct Args { const float* in[22]; float* out; unsigned char* ws; int ph_lo, ph_hi; };
constexpr int NPHASE = 14;
__global__ void __launch_bounds__(NTHR, 2) mk_fwd(Args args) {
    extern __shared__ __attribute__((aligned(16))) unsigned char lds[];
    Frame F;
    F.lds = (LAS unsigned char*)lds; F.MISC = (volatile LAS unsigned*)(F.lds + MISC_OFF);
    F.tid = threadIdx.x; F.lane = F.tid & 63; F.wave = __builtin_amdgcn_readfirstlane(F.tid >> 6); F.G = gridDim.x;
    F.ws = args.ws; F.out = args.out; F.ctl = (gu32*)(args.ws + WS_CTL); F.tp = 0ull;
    for (int u = F.tid; u < (LDS_BYTES - MISC_OFF) / 4; u += NTHR) ((LAS unsigned*)(F.lds + MISC_OFF))[u] = 0u;
    __syncthreads();
    if (F.tid < 22) ((LAS unsigned long long*)(F.lds + PTR_OFF))[F.tid] = (unsigned long long)args.in[F.tid];
    __syncthreads();
    const int lo = args.ph_lo, hi = args.ph_hi;
    const bool multi = (hi - lo) > 1;
    XcdBarrier bar; bar.bar = (unsigned*)(F.ctl + CW_BAR); bar.x = 0; bar.st = nullptr;
    if (multi) bar = xcd_barrier_post((unsigned*)(F.ctl + CW_BAR), F.MISC + 8);
#ifdef ONLY_PHASE
#define IN(k) ((k) == ONLY_PHASE && lo <= (k) && (k) < hi)
#else
#define IN(k) (lo <= (k) && (k) < hi)
#endif
#ifdef PROBE_PHASE
    unsigned long long t_prev = __builtin_amdgcn_s_memrealtime(), t_probe = 0ull;
#define STAMP(k) do { const unsigned long long _t = __builtin_amdgcn_s_memrealtime(); if ((k) == PROBE_PHASE && blockIdx.x == 0) t_probe = _t - t_prev; t_prev = _t; } while (0)
#else
#define STAMP(k) do { } while (0)
#endif
#define SEAM(k) do { if (IN(k) && IN((k) + 1)) xcd_barrier(bar); STAMP(k); } while (0)
    if (IN(0)) { p0_prologue(F); }
    if (IN(0) && IN(1)) { cooperative_groups::this_grid().sync(); } STAMP(0);
    if (IN(1)) {
        if ((int)blockIdx.x >= F.G - NCOPYWG) kvshift_loop<true>(F);
        else {
        pg8::Gemm g{WSP(bf16, WS_XB), WSP(bf16, WS_WIN), MPAD, NPROJ, 1024, MPAD / 256 - 1}; pg8::StaticOrder S; S.init(MPAD, NPROJ, F.G - NCOPYWG, (int)blockIdx.x);
        pg8::EpiProj E{WSP(bf16, WS_QA), WSP(bf16, WS_KA), WSP(bf16, WS_VA), WSP(bf16, WS_QB), WSP(bf16, WS_KB), WSP(bf16, WS_VB), WSP(bf16, WS_RB), WSP(bf16, WS_GA), WSP(bf16, WS_GB)};
        pg8::gemm_phase<pg8::EpiProj, pg8::StaticOrder, true, true>(F.lds, g, S, E);
        if (F.tid == 0) __hip_atomic_fetch_add(F.ctl + CW_GDONE, 1u, RLX_AGENT);
        }
    } SEAM(1);
    if (IN(2)) { p2_prep(F); } SEAM(2);
    if (IN(3)) { p2_mixers(F); } SEAM(3);
    if (IN(4)) { p3_merge(F); } SEAM(4);
    if (IN(5)) {
        bf16* T1 = WSP(bf16, WS_T1); bf16* MIXp = WSP(bf16, WS_MIX); const bf16* GAp = WSP(bf16, WS_GA); const bf16* GBp = WSP(bf16, WS_GB);
        { pg8::Gemm g{WSP(bf16, WS_OAM), WSP(bf16, WS_WA), NP, 1024, 512, -1}; pg8::StaticOrder S; S.init(NP, 1024, F.G, (int)blockIdx.x, false);
          pg8::EpiGate<false> E{WSP(bf16, WS_GA), nullptr, WSP(bf16, WS_T1)};
          pg8::gemm_phase<pg8::EpiGate<false>, pg8::StaticOrder, true, true>(F.lds, g, S, E); }
        skinny_sample_gemm(F, WSP(bf16, WS_OAM), WSP(bf16, WS_WA), 512, [=](int row, int col, float v) { const size_t o = (size_t)row * 1024 + col; T1[o] = f2bf(pg8::sigmoidf_(bf2f(GAp[o])) * v); });
        VM_WAIT(); __syncthreads();
        { pg8::Gemm g{WSP(bf16, WS_OBN), WSP(bf16, WS_WB), NP, 1024, 1024, -1}; pg8::StaticOrder S; S.init(NP, 1024, F.G, (int)blockIdx.x, false);
          pg8::EpiGate<true> E{WSP(bf16, WS_GB), WSP(bf16, WS_T1), WSP(bf16, WS_MIX)};
          pg8::gemm_phase<pg8::EpiGate<true>, pg8::StaticOrder, true, true>(F.lds, g, S, E); }
        skinny_sample_gemm(F, WSP(bf16, WS_OBN), WSP(bf16, WS_WB), 1024, [=](int row, int col, float v) { const size_t o = (size_t)row * 1024 + col; MIXp[o] = f2bf(bf2f(T1[o]) + pg8::sigmoidf_(bf2f(GBp[o])) * v); });
    } SEAM(5);
    if (IN(6)) {
        pg8::Gemm g{WSP(bf16, WS_MIX), WSP(bf16, WS_WO), NP, 1024, 1024, -1}; pg8::StaticOrder S; S.init(NP, 1024, F.G, (int)blockIdx.x, false);
        pg8::EpiOut E{inptr(F, I_XP), inptr(F, I_XS), WSP(float, WS_H), NP, NTOK, ALPHA};
        pg8::gemm_phase<pg8::EpiOut, pg8::StaticOrder, true, true>(F.lds, g, S, E);
        const float* xsp = inptr(F, I_XS); float* Hp = WSP(float, WS_H);
        skinny_sample_gemm(F, WSP(bf16, WS_MIX), WSP(bf16, WS_WO), 1024, [=](int row, int col, float v) { Hp[(size_t)row * 1024 + col] = ALPHA * xsp[(size_t)(row - NP) * 1024 + col] + v; });
    } SEAM(6);
    if (IN(7)) { p6_ln1(F); } SEAM(7);
    if (IN(8)) {
        pg8::Gemm g{WSP(bf16, WS_X1B), WSP(bf16, WS_WQ), MPAD, 2048, 1024, MPAD / 256 - 1}; pg8::StaticOrder S; S.init(MPAD, 2048, F.G, (int)blockIdx.x);
        pg8::EpiHeadNorm E{WSP(bf16, WS_QN), 2048, F.lds + STATS_OFF, LN_EPS};
        pg8::gemm_phase<pg8::EpiHeadNorm, pg8::StaticOrder, true, true>(F.lds, g, S, E);
    } SEAM(8);
    if (IN(9)) {
        const int gw = blockIdx.x * NWAVES + F.wave, NGW = F.G * NWAVES;
        for (int it = gw; it < (NP / 32) * 8; it += NGW) p8_topk_item(F, it);
        for (int e = gw; e < 64 * (NS / 32) * 8; e += NGW) if ((e & 63) == 0) p8_topk_item(F, (NP / 32) * 8 + (e >> 6));
    } SEAM(9);
#if defined(PROBE_PHASE) && PROBE_PHASE >= 300 && PROBE_PHASE < 310
    if (IN(10)) { const unsigned long long td0 = __builtin_amdgcn_s_memrealtime();
        if (PROBE_PHASE == 300) peer_u_phase_t<2047u>(F); else if (PROBE_PHASE == 301) peer_u_phase_t<8191u>(F); else peer_u_phase_t<0xffffffffu>(F);
        xcd_barrier(bar); if (blockIdx.x == 0) F.tp = __builtin_amdgcn_s_memrealtime() - td0; }
#endif
    if (IN(10)) { peer_u_phase(F); } SEAM(10);
    if (IN(11)) { peer_coef_phase(F); } SEAM(11);
    if (IN(12)) { peer_v_phase(F); } SEAM(12);
    if (IN(13)) { peer_ln2_phase(F); }
#ifdef PROBE_PHASE
    if (PROBE_PHASE == 13) { xcd_barrier(bar); STAMP(13); }
    if (PROBE_PHASE == 200 || PROBE_PHASE == 201) {
        unsigned* xm = (unsigned*)(F.ws + WS_END);
        if (F.tid == 0) __hip_atomic_store(xm + blockIdx.x, xb_xcc_id() + 1u, RLX_AGENT);
        xcd_barrier(bar);
        if (blockIdx.x == 0 && F.tid == 0) { bool ok = true;
            for (int b = 0; b < (int)gridDim.x; ++b) { const unsigned a = __hip_atomic_load(xm + b, RLX_AGENT), r = __hip_atomic_load(xm + (PROBE_PHASE == 200 ? (b & 7) : (b & ~31)), RLX_AGENT); if (a != r) ok = false; }
            t_probe = ok ? 50000ull : 0ull; }
    }
    if ((PROBE_PHASE >= 100 && PROBE_PHASE < 200) || PROBE_PHASE >= 300) t_probe = F.tp;
    if (F.tid == 0 && t_probe != 0ull) { const unsigned long long t0 = __builtin_amdgcn_s_memrealtime(); while (__builtin_amdgcn_s_memrealtime() - t0 < PROBE_GAIN * t_probe) __builtin_amdgcn_s_sleep(8); }
#endif
#undef IN
#undef SEAM
}

extern "C" void kernel_launch(void* const* d_in, const int* in_sizes, int n_in, void* d_out, int out_size, void* d_ws, size_t ws_size, hipStream_t stream) {
    static int grid = 0;
    if (grid == 0) {
        if (n_in != 22 || (size_t)out_size != OUT_TOTAL || ws_size < WS_END) { fprintf(stderr, "kernel_launch: unexpected shapes: n_in %d out %d ws %zu (need >= %zu)\n", n_in, out_size, ws_size, (size_t)WS_END); grid = -1; return; }
        int dev = 0, cus = 0, per_cu = 0;
        if (hipGetDevice(&dev) != hipSuccess || hipDeviceGetAttribute(&cus, hipDeviceAttributeMultiprocessorCount, dev) != hipSuccess) { grid = -1; return; }
        if (hipFuncSetAttribute((const void*)mk_fwd, hipFuncAttributeMaxDynamicSharedMemorySize, LDS_BYTES) != hipSuccess) { fprintf(stderr, "kernel_launch: hipFuncSetAttribute failed\n"); grid = -1; return; }
        if (hipOccupancyMaxActiveBlocksPerMultiprocessor(&per_cu, (const void*)mk_fwd, NTHR, LDS_BYTES) != hipSuccess || per_cu < 1) fprintf(stderr, "kernel_launch: occupancy query reports %d blocks per CU\n", per_cu);
        (void)hipGetLastError();
        grid = cus;
    }
    if (grid < 0) return;
    (void)hipMemsetAsync((char*)d_ws + WS_CTL, 0, CTL_ZERO_BYTES, stream);
    Args a{};
    for (int i = 0; i < 22; ++i) a.in[i] = (const float*)d_in[i];
    a.out = (float*)d_out; a.ws = (unsigned char*)d_ws;
#if MK_SINGLE
    a.ph_lo = 0; a.ph_hi = NPHASE;
    void* kargs[] = {&a};
    hipError_t e = hipLaunchCooperativeKernel((const void*)mk_fwd, dim3(grid), dim3(NTHR), kargs, LDS_BYTES, stream);
    if (e != hipSuccess) fprintf(stderr, "kernel_launch: cooperative launch failed: %s\n", hipGetErrorString(e));
#else
    for (int p = 0; p < NPHASE; ++p) { a.ph_lo = p; a.ph_hi = p + 1; hipLaunchKernelGGL(mk_fwd, dim3(grid), dim3(NTHR), LDS_BYTES, stream, a); }
#endif
}
```

```cpp
#include <hip/hip_runtime.h>
#include <hip/hip_cooperative_groups.h>
#include <cstdio>
#include <cstdint>
#ifndef MK_SINGLE
#define MK_SINGLE 1
#endif
namespace pg8 {
#define PG8_LAS __attribute__((address_space(3)))
typedef unsigned short bf16_t;
typedef short bf16x8 __attribute__((ext_vector_type(8)));
typedef float f32x4 __attribute__((ext_vector_type(4)));
typedef unsigned u32x4 __attribute__((ext_vector_type(4)));
constexpr int BM = 256, BK = 64, HALF = 128, HTB = HALF * BK * 2  , STAGE_BYTES = 8 * HTB, NXCD = 8, WGM = 8;

__host__ __device__ __forceinline__ int lds_byte(int r, int c) { const int st = (r >> 4) * 2 + (c >> 5), rr = r & 15, cc = c & 31, ob = rr * 64 + cc * 2; return st * 1024 + (ob ^ (((ob >> 9) & 1) << 5)); }
__host__ __device__ __forceinline__ void stage_rc(int b, int& R, int& C) { const int st = b / 1024, sb = b % 1024, swz = sb ^ (((sb >> 9) & 1) << 5); R = (st >> 1) * 16 + swz / 64; C = (st & 1) * 32 + (swz % 64) / 2; }
__host__ __device__ __forceinline__ int perm32(int rho) { const int n = rho >> 4, i = rho & 15; return 8 * (i >> 2) + 4 * n + (i & 3); }

struct Unit { int pm, pn; };
struct Gemm { const bf16_t* A; const bf16_t* Bt; int M, N, K; int half_pm = -1; };

struct StaticOrder {
    int nM, nN, nwg, G, c, nfull;
    __host__ __device__ void init(int M, int N, int G_, int c_, bool half = true) { nM = half ? M / BM - 1 : M / BM; nN = N / BM; nfull = nM * nN; nwg = half ? nfull + nN : nfull; G = G_; c = c_; }
    __host__ __device__ bool next(int i, Unit& u) const {
        const long L = (long)i * G + c; if (L >= nwg) return false;
        if (L >= nfull) { u.pm = nM; u.pn = (int)(L - nfull); return true; }
        int wgid = (int)L; { const int q = nfull / NXCD, r = nfull % NXCD, xcd = wgid % NXCD, off = wgid / NXCD; wgid = (xcd < r ? xcd * (q + 1) : r * (q + 1) + (xcd - r) * q) + off; }
        const int nig = WGM * nN, gid = wgid / nig, fm = gid * WGM, gsz = (nM - fm) < WGM ? (nM - fm) : WGM;
        u.pm = fm + ((wgid % nig) % gsz); u.pn = (wgid % nig) / gsz; return true;
    }
    __device__ __forceinline__ void a_ready(const Unit&) const {}
    __device__ __forceinline__ void done(const Unit&) const {}
};


typedef float f32x2 __attribute__((ext_vector_type(2)));
typedef __bf16 bf16x2_t __attribute__((ext_vector_type(2)));
__device__ __forceinline__ unsigned cvt_pk_bf16(float lo, float hi) { f32x2 v = {lo, hi}; bf16x2_t b = __builtin_convertvector(v, bf16x2_t); return __builtin_bit_cast(unsigned, b); }
__device__ __forceinline__ float bf_lo(unsigned w) { return __uint_as_float(w << 16); }
__device__ __forceinline__ float bf_hi(unsigned w) { return __uint_as_float(w & 0xffff0000u); }
__device__ __forceinline__ float sigmoidf_(float x) { return __builtin_amdgcn_rcpf(1.0f + __expf(-x)); }

struct EpiProj {
    static constexpr bool PERM = true, AFTER_DRAIN = false;
    bf16_t *qa, *ka, *va, *qb, *kb, *vb, *rb, *ga, *gb;
    __device__ __forceinline__ void operator()(const f32x4 (&acc)[2][2][4][2], const Unit& u, int wr, int wc, int fr, int fq) const {
        const int pn = u.pn; bf16_t* base; int ldc, ct; float sc = 1.f;
        if (pn < 6) { base = qa; ldc = 1536; ct = pn; sc = 0.125f; }
        else if (pn < 12) { base = ka; ldc = 1536; ct = pn - 6; }
        else if (pn < 18) { base = va; ldc = 1536; ct = pn - 12; }
        else if (pn < 20) { base = qb; ldc = 512; ct = pn - 18; }
        else if (pn < 22) { base = kb; ldc = 512; ct = pn - 20; }
        else if (pn < 26) { base = vb; ldc = 1024; ct = pn - 22; }
        else if (pn < 30) { base = rb; ldc = 1024; ct = pn - 26; }
        else if (pn < 34) { base = ga; ldc = 1024; ct = pn - 30; }
        else { base = gb; ldc = 1024; ct = pn - 34; }
        const int row0 = u.pm * BM + wr * 64 + fr, col0 = ct * BM + wc * 32 + 8 * fq;
#pragma unroll
        for (int ai = 0; ai < 2; ++ai)
#pragma unroll
            for (int m = 0; m < 4; ++m) { bf16_t* rowp = base + (size_t)(row0 + ai * HALF + m * 16) * ldc + col0;
#pragma unroll
                for (int bj = 0; bj < 2; ++bj) { const f32x4 v0 = acc[ai][bj][m][0] * sc, v1 = acc[ai][bj][m][1] * sc;
                    u32x4 w; w.x = cvt_pk_bf16(v0[0], v0[1]); w.y = cvt_pk_bf16(v0[2], v0[3]); w.z = cvt_pk_bf16(v1[0], v1[1]); w.w = cvt_pk_bf16(v1[2], v1[3]);
                    *(u32x4*)(rowp + bj * HALF) = w; } }
    }
};
template <bool ADD> struct EpiGate {
    static constexpr bool PERM = true, AFTER_DRAIN = false;
    const bf16_t* G; const bf16_t* T1; bf16_t* O;
    __device__ __forceinline__ void operator()(const f32x4 (&acc)[2][2][4][2], const Unit& u, int wr, int wc, int fr, int fq) const {
        const int row0 = u.pm * BM + wr * 64 + fr, col0 = u.pn * BM + wc * 32 + 8 * fq;
#pragma unroll
        for (int ai = 0; ai < 2; ++ai) {
            u32x4 gq[4][2], tq[4][2];
#pragma unroll
            for (int m = 0; m < 4; ++m) { const size_t off = (size_t)(row0 + ai * HALF + m * 16) * 1024 + col0;
#pragma unroll
                for (int bj = 0; bj < 2; ++bj) { gq[m][bj] = *(const u32x4*)(G + off + bj * HALF); if (ADD) tq[m][bj] = *(const u32x4*)(T1 + off + bj * HALF); } }
#pragma unroll
            for (int m = 0; m < 4; ++m) { const size_t off = (size_t)(row0 + ai * HALF + m * 16) * 1024 + col0;
#pragma unroll
                for (int bj = 0; bj < 2; ++bj) {
                    const u32x4 g = gq[m][bj];
                    f32x4 v0 = acc[ai][bj][m][0], v1 = acc[ai][bj][m][1];
                    v0[0] *= sigmoidf_(bf_lo(g.x)); v0[1] *= sigmoidf_(bf_hi(g.x)); v0[2] *= sigmoidf_(bf_lo(g.y)); v0[3] *= sigmoidf_(bf_hi(g.y));
                    v1[0] *= sigmoidf_(bf_lo(g.z)); v1[1] *= sigmoidf_(bf_hi(g.z)); v1[2] *= sigmoidf_(bf_lo(g.w)); v1[3] *= sigmoidf_(bf_hi(g.w));
                    if (ADD) { const u32x4 t = tq[m][bj];
                        v0[0] += bf_lo(t.x); v0[1] += bf_hi(t.x); v0[2] += bf_lo(t.y); v0[3] += bf_hi(t.y);
                        v1[0] += bf_lo(t.z); v1[1] += bf_hi(t.z); v1[2] += bf_lo(t.w); v1[3] += bf_hi(t.w); }
                    u32x4 w; w.x = cvt_pk_bf16(v0[0], v0[1]); w.y = cvt_pk_bf16(v0[2], v0[3]); w.z = cvt_pk_bf16(v1[0], v1[1]); w.w = cvt_pk_bf16(v1[2], v1[3]);
                    *(u32x4*)(O + off + bj * HALF) = w; } } }
    }
};
struct EpiOut {
    static constexpr bool PERM = true, AFTER_DRAIN = false;
    const bf16_t* xb; bf16_t* HB; float alpha;
    __device__ __forceinline__ void operator()(const f32x4 (&acc)[2][2][4][2], const Unit& u, int wr, int wc, int fr, int fq) const {
        const int row0 = u.pm * BM + wr * 64 + fr, col0 = u.pn * BM + wc * 32 + 8 * fq;
#pragma unroll
        for (int ai = 0; ai < 2; ++ai) {
            u32x4 xq[4][2];
#pragma unroll
            for (int m = 0; m < 4; ++m) { const size_t off = (size_t)(row0 + ai * HALF + m * 16) * 1024 + col0;
#pragma unroll
                for (int bj = 0; bj < 2; ++bj) xq[m][bj] = *(const u32x4*)(xb + off + bj * HALF); }
#pragma unroll
            for (int m = 0; m < 4; ++m) { const size_t off = (size_t)(row0 + ai * HALF + m * 16) * 1024 + col0;
#pragma unroll
                for (int bj = 0; bj < 2; ++bj) { const u32x4 t = xq[m][bj]; const f32x4 a0 = acc[ai][bj][m][0], a1 = acc[ai][bj][m][1];
                    u32x4 w; w.x = cvt_pk_bf16(alpha * bf_lo(t.x) + a0[0], alpha * bf_hi(t.x) + a0[1]); w.y = cvt_pk_bf16(alpha * bf_lo(t.y) + a0[2], alpha * bf_hi(t.y) + a0[3]);
                    w.z = cvt_pk_bf16(alpha * bf_lo(t.z) + a1[0], alpha * bf_hi(t.z) + a1[1]); w.w = cvt_pk_bf16(alpha * bf_lo(t.w) + a1[2], alpha * bf_hi(t.w) + a1[3]);
                    *(u32x4*)(HB + off + bj * HALF) = w; } }
        }
    }
};
struct EpiHeadNorm {
    static constexpr bool PERM = true, AFTER_DRAIN = false;
    bf16_t* O; int ldc; PG8_LAS unsigned char* st; float eps;
    __device__ __forceinline__ void operator()(const f32x4 (&acc)[2][2][4][2], const Unit& u, int wr, int wc, int fr, int fq) const {
        PG8_LAS f32x2* P = (PG8_LAS f32x2*)st; PG8_LAS f32x2* S = (PG8_LAS f32x2*)(st + 8192);
        const int lane = fq * 16 + fr, wid = wr * 4 + wc;
#pragma unroll
        for (int ai = 0; ai < 2; ++ai)
#pragma unroll
            for (int m = 0; m < 4; ++m) {
                float s = 0.f;
#pragma unroll
                for (int bj = 0; bj < 2; ++bj)
#pragma unroll
                    for (int n = 0; n < 2; ++n) { const f32x4 x = acc[ai][bj][m][n]; s += (x[0] + x[1]) + (x[2] + x[3]); }
                s += __shfl_xor(s, 16); s += __shfl_xor(s, 32);
                const float mw = s * (1.0f / 64.0f); float q = 0.f;
#pragma unroll
                for (int bj = 0; bj < 2; ++bj)
#pragma unroll
                    for (int n = 0; n < 2; ++n) { const f32x4 d = acc[ai][bj][m][n] - mw; q += (d[0] * d[0] + d[1] * d[1]) + (d[2] * d[2] + d[3] * d[3]); }
                q += __shfl_xor(q, 16); q += __shfl_xor(q, 32);
                if (fq == 0) P[(ai * HALF + wr * 64 + m * 16 + fr) * 4 + wc] = (f32x2){mw, q};
            }
        asm volatile("s_waitcnt lgkmcnt(0)" ::: "memory"); __builtin_amdgcn_s_barrier(); asm volatile("" ::: "memory");
        const int row = wid * 32 + (lane & 31);
        if (lane < 32) {
            const f32x2 a = P[row * 4 + 0], b = P[row * 4 + 1], c = P[row * 4 + 2], d = P[row * 4 + 3];
            const float mt = (a.x + b.x + c.x + d.x) * 0.25f;
            const float da = a.x - mt, db = b.x - mt, dc = c.x - mt, dd = d.x - mt;
            const float m2 = (a.y + b.y) + (c.y + d.y) + 64.0f * ((da * da + db * db) + (dc * dc + dd * dd));
            S[row] = (f32x2){mt, 1.0f / sqrtf(m2 * (1.0f / 256.0f) + eps)};
        }
        asm volatile("s_waitcnt lgkmcnt(0)" ::: "memory"); __builtin_amdgcn_s_barrier(); asm volatile("" ::: "memory");
        const int row0 = u.pm * BM + wr * 64 + fr, col0 = u.pn * BM + wc * 32 + 8 * fq;
#pragma unroll
        for (int ai = 0; ai < 2; ++ai)
#pragma unroll
            for (int m = 0; m < 4; ++m) { const f32x2 sr = S[ai * HALF + wr * 64 + m * 16 + fr]; bf16_t* rowp = O + (size_t)(row0 + ai * HALF + m * 16) * ldc + col0;
#pragma unroll
                for (int bj = 0; bj < 2; ++bj) { const f32x4 v0 = (acc[ai][bj][m][0] - sr.x) * sr.y, v1 = (acc[ai][bj][m][1] - sr.x) * sr.y;
                    u32x4 w; w.x = cvt_pk_bf16(v0[0], v0[1]); w.y = cvt_pk_bf16(v0[2], v0[3]); w.z = cvt_pk_bf16(v1[0], v1[1]); w.w = cvt_pk_bf16(v1[2], v1[3]);
                    *(u32x4*)(rowp + bj * HALF) = w; } }
    }
};

template <class Epi, class Sched, bool ALIGN_EPI = false, bool SP2 = false>
__device__ __forceinline__ void gemm_phase(PG8_LAS unsigned char* lds, const Gemm g, const Sched& S, const Epi& E) {
    const int tid = threadIdx.x, wid = __builtin_amdgcn_readfirstlane(tid >> 6), lane = tid & 63, wr = wid >> 2, wc = wid & 3, fr = lane & 15, fq = lane >> 4;
    const int K = g.K, nt = K / BK;
    unsigned voffA[2], voffB[2];
#pragma unroll
    for (int i = 0; i < 2; ++i) { int R, C; stage_rc(tid * 16 + i * 8192, R, C); const int Rb = Epi::PERM ? ((R & ~31) + perm32(R & 31)) : R;
        voffA[i] = (unsigned)(R * K + C) * 2u; voffB[i] = (unsigned)(Rb * K + C) * 2u; }
    const size_t kstep = (size_t)(BK * 2);
    const size_t hstep = (size_t)HALF * K * 2;
    const size_t tstep = 2 * hstep;
    const unsigned ldsw = (unsigned)wid * 1024u;
    const int aoff = lds_byte(wr * 64 + fr, fq * 8), boff = lds_byte(wc * 32 + fr, fq * 8);
#define PG8_SA(b, h) (((b) * 2 + (h)) * HTB)
#define PG8_SB(b, h) ((4 + (b) * 2 + (h)) * HTB)
#define PG8_STAGE(bufoff, gbase, voff) do { _Pragma("unroll") for (int _i = 0; _i < 2; ++_i) \
        __builtin_amdgcn_global_load_lds((const unsigned*)((const char*)(gbase) + (voff)[_i]), (PG8_LAS unsigned*)(lds + (bufoff) + ldsw + _i * 8192), 16, 0, 0); } while (0)
#define PG8_LDA(dst, b, h) do { _Pragma("unroll") for (int m = 0; m < 4; ++m) _Pragma("unroll") for (int k = 0; k < 2; ++k) dst[m][k] = *(const PG8_LAS bf16x8*)(lds + PG8_SA(b, h) + aoff + m * 2048 + k * 1024); } while (0)
#define PG8_LDB(dst, b, h) do { _Pragma("unroll") for (int n = 0; n < 2; ++n) _Pragma("unroll") for (int k = 0; k < 2; ++k) dst[n][k] = *(const PG8_LAS bf16x8*)(lds + PG8_SB(b, h) + boff + n * 2048 + k * 1024); } while (0)
#define PG8_MMA(ai, bj, At, Bt) do { __builtin_amdgcn_s_setprio(1); _Pragma("unroll") for (int m = 0; m < 4; ++m) _Pragma("unroll") for (int n = 0; n < 2; ++n) _Pragma("unroll") for (int k = 0; k < 2; ++k) \
        acc[ai][bj][m][n] = __builtin_amdgcn_mfma_f32_16x16x32_bf16(Bt[n][k], At[m][k], acc[ai][bj][m][n], 0, 0, 0); __builtin_amdgcn_s_setprio(0); } while (0)
#define PG8_WAIT_V(n) asm volatile("s_waitcnt vmcnt(" #n ")" ::: "memory")
#define PG8_WAIT_L(n) asm volatile("s_waitcnt lgkmcnt(" #n ")" ::: "memory")
#define PG8_BAR __builtin_amdgcn_s_barrier()
#define PG8_SCHED __builtin_amdgcn_sched_barrier(0)
    Unit cur, nxt; int ui = 0;
    if (!S.next(0, cur)) return;
    f32x4 acc[2][2][4][2];
#pragma unroll
    for (int a = 0; a < 2; ++a)
#pragma unroll
        for (int b = 0; b < 2; ++b)
#pragma unroll
            for (int m = 0; m < 4; ++m)
#pragma unroll
                for (int n = 0; n < 2; ++n) acc[a][b][m][n] = (f32x4){0.f, 0.f, 0.f, 0.f};
    bf16x8 At[4][2], B0[2][2], B1[2][2];
    const char* cA = (const char*)g.A + (size_t)cur.pm * tstep; const char* cB = (const char*)g.Bt + (size_t)cur.pn * tstep;
    S.a_ready(cur);
    if constexpr (SP2) {
        PG8_STAGE(PG8_SB(0, 0), cB, voffB); PG8_STAGE(PG8_SB(0, 1), cB + hstep, voffB); PG8_STAGE(PG8_SA(0, 0), cA, voffA); PG8_STAGE(PG8_SA(0, 1), cA + hstep, voffA);
        if (wr == 1) PG8_BAR;
        PG8_WAIT_V(2); PG8_BAR;
        PG8_STAGE(PG8_SB(1, 0), cB + kstep, voffB); PG8_STAGE(PG8_SA(1, 0), cA + kstep, voffA); PG8_STAGE(PG8_SB(1, 1), cB + hstep + kstep, voffB);
        PG8_WAIT_V(6); PG8_BAR;
    } else {
        PG8_STAGE(PG8_SB(0, 0), cB, voffB); PG8_STAGE(PG8_SA(0, 0), cA, voffA); PG8_STAGE(PG8_SB(0, 1), cB + hstep, voffB); PG8_STAGE(PG8_SA(0, 1), cA + hstep, voffA);
        if (wr == 1) PG8_BAR;
        PG8_WAIT_V(4); PG8_BAR;
        PG8_STAGE(PG8_SB(1, 0), cB + kstep, voffB); PG8_STAGE(PG8_SA(1, 0), cA + kstep, voffA); PG8_STAGE(PG8_SB(1, 1), cB + hstep + kstep, voffB);
        PG8_WAIT_V(6); PG8_BAR;
    }
    for (;;) {
        const bool has_next = S.next(ui + 1, nxt);
        const bool skip1 = __builtin_amdgcn_readfirstlane((int)(cur.pm == g.half_pm)) != 0;
        const char* nA = has_next ? (const char*)g.A + (size_t)nxt.pm * tstep : cA; const char* nB = has_next ? (const char*)g.Bt + (size_t)nxt.pn * tstep : cB;
        for (int t = 0; t < nt; t += 2) {
            const bool last = (t == nt - 2);
            const char* a1 = cA + (size_t)(t + 1) * kstep;
            const char* a2 = last ? nA : cA + (size_t)(t + 2) * kstep; const char* b2 = last ? nB : cB + (size_t)(t + 2) * kstep;
            const char* a3 = a2 + kstep; const char* b3 = b2 + kstep;
            if (last && has_next) S.a_ready(nxt);
            if constexpr (SP2) {
            PG8_LDB(B0, 0, 0); PG8_LDB(B1, 0, 1); PG8_SCHED; PG8_LDA(At, 0, 0); PG8_STAGE(PG8_SA(1, 1), a1 + hstep, voffA);
            PG8_WAIT_V(8); PG8_WAIT_L(0); PG8_BAR; PG8_MMA(0, 0, At, B0); PG8_MMA(0, 1, At, B1); PG8_BAR; PG8_SCHED;
            PG8_LDA(At, 0, 1); PG8_STAGE(PG8_SB(0, 0), b2, voffB); PG8_STAGE(PG8_SB(0, 1), b2 + hstep, voffB); PG8_STAGE(PG8_SA(0, 0), a2, voffA);
            PG8_WAIT_V(8); PG8_WAIT_L(0); PG8_BAR; if (!skip1) { PG8_MMA(1, 0, At, B0); PG8_MMA(1, 1, At, B1); } PG8_BAR; PG8_SCHED;
            PG8_LDB(B0, 1, 0); PG8_LDB(B1, 1, 1); PG8_SCHED; PG8_LDA(At, 1, 0); PG8_STAGE(PG8_SA(0, 1), a2 + hstep, voffA);
            PG8_WAIT_V(8); PG8_WAIT_L(0); PG8_BAR; PG8_MMA(0, 0, At, B0); PG8_MMA(0, 1, At, B1); PG8_BAR; PG8_SCHED;
            PG8_LDA(At, 1, 1); PG8_STAGE(PG8_SB(1, 0), b3, voffB); PG8_STAGE(PG8_SB(1, 1), b3 + hstep, voffB); PG8_STAGE(PG8_SA(1, 0), a3, voffA);
            PG8_WAIT_V(8); PG8_WAIT_L(0); PG8_BAR; if (!skip1) { PG8_MMA(1, 0, At, B0); PG8_MMA(1, 1, At, B1); } PG8_BAR; PG8_SCHED;
            } else {
            PG8_LDB(B0, 0, 0); PG8_SCHED; PG8_LDA(At, 0, 0); PG8_STAGE(PG8_SA(1, 1), a1 + hstep, voffA);
            PG8_WAIT_L(8); PG8_BAR; PG8_WAIT_L(0); PG8_MMA(0, 0, At, B0); PG8_BAR; PG8_SCHED;
            PG8_LDB(B1, 0, 1); PG8_STAGE(PG8_SB(0, 0), b2, voffB);
            PG8_BAR; PG8_WAIT_L(0); PG8_MMA(0, 1, At, B1); PG8_BAR;
            PG8_LDA(At, 0, 1); PG8_STAGE(PG8_SA(0, 0), a2, voffA);
            PG8_BAR; PG8_WAIT_L(0); PG8_MMA(1, 0, At, B0); PG8_BAR; PG8_SCHED;
            PG8_STAGE(PG8_SB(0, 1), b2 + hstep, voffB);
            PG8_WAIT_V(6); PG8_BAR; PG8_MMA(1, 1, At, B1); PG8_BAR;
            PG8_LDB(B0, 1, 0); PG8_SCHED; PG8_LDA(At, 1, 0); PG8_STAGE(PG8_SA(0, 1), a2 + hstep, voffA);
            PG8_WAIT_L(8); PG8_BAR; PG8_WAIT_L(0); PG8_MMA(0, 0, At, B0); PG8_BAR; PG8_SCHED;
            PG8_LDB(B1, 1, 1); PG8_STAGE(PG8_SB(1, 0), b3, voffB);
            PG8_BAR; PG8_WAIT_L(0); PG8_MMA(0, 1, At, B1); PG8_BAR;
            PG8_LDA(At, 1, 1); PG8_STAGE(PG8_SA(1, 0), a3, voffA);
            PG8_BAR; PG8_WAIT_L(0); PG8_MMA(1, 0, At, B0); PG8_BAR; PG8_SCHED;
            PG8_STAGE(PG8_SB(1, 1), b3 + hstep, voffB);
            PG8_WAIT_V(6); PG8_BAR; PG8_MMA(1, 1, At, B1); PG8_BAR;
            }
        }
        if constexpr (ALIGN_EPI) { if (wr == 0) PG8_BAR; }
        if constexpr (!Epi::AFTER_DRAIN) { E(acc, cur, wr, wc, fr, fq); S.done(cur); }
        if (!has_next) break;
#pragma unroll
        for (int a = 0; a < 2; ++a)
#pragma unroll
            for (int b = 0; b < 2; ++b)
#pragma unroll
                for (int m = 0; m < 4; ++m)
#pragma unroll
                    for (int n = 0; n < 2; ++n) acc[a][b][m][n] = (f32x4){0.f, 0.f, 0.f, 0.f};
        cur = nxt; cA = nA; cB = nB; ++ui;
        if constexpr (ALIGN_EPI) { if (wr == 1) PG8_BAR; }
    }
    PG8_WAIT_V(0);
    if constexpr (!ALIGN_EPI) { if (wr == 0) PG8_BAR; }
    PG8_BAR;
    if constexpr (Epi::AFTER_DRAIN) { E.fused(acc, cur, wr, wc, fr, fq, lds, wid, lane); S.done(cur); }
#undef PG8_SA
#undef PG8_SB
#undef PG8_STAGE
#undef PG8_LDA
#undef PG8_LDB
#undef PG8_MMA
#undef PG8_WAIT_V
#undef PG8_WAIT_L
#undef PG8_BAR
#undef PG8_SCHED
}
}

constexpr int NWAVES = 8, NTHR = 512;
constexpr int DM = 1024, TSEQ = 4096, NP = 32768, NS = 128, NTOK = NP + NS, MPAD = 33024;
constexpr int INW = 9744, NPROJ = 9728, ABCOL = 6656;
constexpr float LN_EPS = 1e-5f, ALPHA = 1.189207115002721f, GLA_QSCALE = 0.08838834764831845f, NEG_BIG = -1e30f;
constexpr size_t OUT_YP = 0, OUT_YS = 33554432, OUT_KVP1 = 33685504, OUT_KVP2 = 34734080, OUT_KVP3 = 38928384, OUT_STP = 55705600,
                 OUT_KVS1 = 56754176, OUT_KVS2 = 60948480, OUT_KVS3 = 77725696, OUT_STS = 144834560, OUT_TOTAL = 149028864;
constexpr size_t MiB = 1u << 20;
constexpr size_t WS_CTL = 0, CTL_ZERO_BYTES = 1 * MiB;
constexpr size_t WS_KEYS = 1 * MiB, WS_LUT = WS_KEYS + 512 * 1024;
constexpr size_t WS_WA = 2 * MiB, WS_WB = 3 * MiB, WS_WO = 5 * MiB, WS_WQ = 7 * MiB, WS_WIN = 11 * MiB;
constexpr size_t WS_AB = 31 * MiB, WS_UT = 34 * MiB, WS_VT = 66 * MiB, WS_XB = 98 * MiB;
constexpr size_t WS_QA = 163 * MiB, WS_KA = 260 * MiB, WS_VA = 357 * MiB, WS_QB = 454 * MiB, WS_KB = 487 * MiB, WS_VB = 520 * MiB;
constexpr size_t WS_RB = 585 * MiB, WS_GA = 650 * MiB, WS_GB = 715 * MiB, WS_LSE = 780 * MiB, WS_OAM = 784 * MiB, WS_OBN = 817 * MiB, WS_H = 882 * MiB, WS_END = 1011 * MiB;
constexpr size_t WS_HB = WS_KA;
constexpr size_t WS_T1 = WS_KA, WS_MIX = WS_VA, WS_X1B = WS_QA, WS_QN = WS_RB, WS_EIDX = WS_GB, WS_GATE = WS_GB + 17 * MiB;
static_assert(WS_WIN + (size_t)NPROJ * 1024 * 2 <= WS_AB && WS_AB + (size_t)MPAD * 16 * 4 <= WS_UT && WS_XB + (size_t)MPAD * 1024 * 2 <= WS_QA, "ws map 1");
static_assert(WS_QA + (size_t)MPAD * 1536 * 2 <= WS_KA && WS_QB + (size_t)MPAD * 512 * 2 <= WS_KB && WS_VB + (size_t)MPAD * 1024 * 2 <= WS_RB, "ws map 2");
static_assert(WS_LSE + (size_t)3 * MPAD * 8 * 4 <= WS_OAM && WS_OAM + (size_t)MPAD * 512 * 2 <= WS_OBN && WS_OBN + (size_t)MPAD * 1024 * 2 <= WS_H && WS_H + (size_t)MPAD * 1024 * 4 <= WS_END, "ws map 3");
static_assert(WS_QN + (size_t)MPAD * 2048 * 2 <= WS_GB && WS_EIDX + (size_t)MPAD * 128 * 4 <= WS_GATE && WS_GATE + (size_t)MPAD * 128 * 4 <= WS_LSE, "ws map 4");
constexpr int CW_QUEUE = 64;
constexpr int CW_CPYQ = 128;
constexpr int CW_GDONE = 192;
constexpr int NCOPYWG = 10;
constexpr int CW_BAR = 4096;
constexpr int RING_BYTES = 131072, STATS_OFF = RING_BYTES, MISC_OFF = STATS_OFF + 10240 + 320, LDS_BYTES = 147456;
static_assert(MISC_OFF + 128 + 22 * 8 <= LDS_BYTES, "LDS map");

#define GAS __attribute__((address_space(1)))
#define LAS __attribute__((address_space(3)))
typedef unsigned short bf16;
typedef unsigned v4u __attribute__((ext_vector_type(4)));
typedef unsigned v2u __attribute__((ext_vector_type(2)));
typedef float f32x4 __attribute__((ext_vector_type(4)));
typedef float f32x16 __attribute__((ext_vector_type(16)));
typedef short bf16x8 __attribute__((ext_vector_type(8)));
typedef short s16x4 __attribute__((ext_vector_type(4)));
typedef GAS unsigned gu32;
#define RLX_AGENT __ATOMIC_RELAXED, __HIP_MEMORY_SCOPE_AGENT
#define LDS_WAIT() asm volatile("s_waitcnt lgkmcnt(0)" ::: "memory")
#define VM_WAIT() asm volatile("s_waitcnt vmcnt(0)" ::: "memory")
#define MFMA32(a, b, c) __builtin_amdgcn_mfma_f32_32x32x16_bf16((a), (b), (c), 0, 0, 0)
using pg8::cvt_pk_bf16; using pg8::bf_lo; using pg8::bf_hi;
__device__ __forceinline__ unsigned short f2bf(float f) { return (unsigned short)(cvt_pk_bf16(f, 0.f) & 0xffffu); }
__device__ __forceinline__ float bf2f(unsigned short h) { return __uint_as_float((unsigned)h << 16); }
__device__ __forceinline__ int crow(int reg, int hh) { return (reg & 3) + 8 * (reg >> 2) + 4 * hh; }
__device__ __forceinline__ float wave_sum(float v) {
#pragma unroll
    for (int o = 1; o < 64; o <<= 1) v += __shfl_xor(v, o);
    return v;
}
__device__ __forceinline__ float wave_max(float v) {
#pragma unroll
    for (int o = 1; o < 64; o <<= 1) v = fmaxf(v, __shfl_xor(v, o));
    return v;
}
__device__ __forceinline__ bf16x8 frag_row(const LAS unsigned char* T, int stride, int r0, int k0, int lane) {
    return *(const LAS bf16x8*)(T + (r0 + (lane & 31)) * stride + (k0 + 8 * (lane >> 5)) * 2);
}
typedef short v4i16_t __attribute__((ext_vector_type(4)));
template <bool PERM> __device__ __forceinline__ bf16x8 frag_tr(const LAS unsigned char* X, int stride, int k0, int c0, int lane) {
    const int i = lane & 15, g = (lane >> 4) & 1, hh = lane >> 5, q = i >> 2, p = i & 3;
    const int rA = PERM ? (k0 + 4 * hh + q) : (k0 + 8 * hh + q), rB = PERM ? (k0 + 8 + 4 * hh + q) : (k0 + 8 * hh + 4 + q);
    const int cb = (c0 + 16 * g + 4 * p) * 2;
    const s16x4 lo = __builtin_bit_cast(s16x4, __builtin_amdgcn_ds_read_tr16_b64_v4i16((LAS v4i16_t*)(X + rA * stride + cb)));
    const s16x4 hi = __builtin_bit_cast(s16x4, __builtin_amdgcn_ds_read_tr16_b64_v4i16((LAS v4i16_t*)(X + rB * stride + cb)));
    return __builtin_shufflevector(lo, hi, 0, 1, 2, 3, 4, 5, 6, 7);
}
__device__ __forceinline__ bf16x8 pack_acc(const f32x16& x, int s) {
    v4u p; p.x = cvt_pk_bf16(x[8 * s], x[8 * s + 1]); p.y = cvt_pk_bf16(x[8 * s + 2], x[8 * s + 3]); p.z = cvt_pk_bf16(x[8 * s + 4], x[8 * s + 5]); p.w = cvt_pk_bf16(x[8 * s + 6], x[8 * s + 7]);
    return __builtin_bit_cast(bf16x8, p);
}

#define XB_TMO      128
#define XB_XCNT(j)  (256  + 64 * (j))
#define XB_XSUB(j)  (1280 + 64 * (j))
#define XB_XGEN(j)  (2304 + 64 * (j))
#define XB_TOP      3328
#define XB_TOPGEN   3392
#define XCD_BAR_WORDS 3456
#define XB_SPIN_CAP (1u << 22)
__device__ __forceinline__ unsigned xb_ld(unsigned* p)              { return __hip_atomic_load(p, __ATOMIC_RELAXED, __HIP_MEMORY_SCOPE_AGENT); }
__device__ __forceinline__ unsigned xb_add(unsigned* p, unsigned v) { return __hip_atomic_fetch_add(p, v, __ATOMIC_RELAXED, __HIP_MEMORY_SCOPE_AGENT); }
__device__ __forceinline__ unsigned xb_xcc_id() { return (unsigned)__builtin_amdgcn_s_getreg((3 << 11) | 20) & 0xFu; }
#define XB_SPIN(cond, bar) do { unsigned _sp = 0; while (cond) { __builtin_amdgcn_s_sleep(1); \
    if ((++_sp & 255u) == 0u) { if (xb_ld(&(bar)[XB_TMO])) break; if (_sp > XB_SPIN_CAP) { atomicAdd(&(bar)[XB_TMO], 1u); break; } } } } while (0)
struct XcdBarrier { unsigned* bar; unsigned x; volatile LAS unsigned* st; };
__device__ __forceinline__ XcdBarrier xcd_barrier_post(unsigned* bar, volatile LAS unsigned* st) {
    XcdBarrier b; b.bar = bar; b.x = xb_xcc_id(); b.st = st;
    if (threadIdx.x == 0) (void)xb_add(&bar[XB_XCNT(b.x)], 1u);
    return b;
}
__device__ __forceinline__ void xcd_barrier_complete(unsigned* bar, unsigned x, unsigned& nloc, unsigned& nx) {
    const unsigned G = gridDim.x * gridDim.y * gridDim.z;
    unsigned sum, cnt, mine, sp = 0u;
    for (;;) {
        sum = 0u; cnt = 0u; mine = 0u;
#pragma unroll
        for (unsigned j = 0; j < 16; ++j) { const unsigned c = xb_ld(&bar[XB_XCNT(j)]); sum += c; cnt += (c > 0u) ? 1u : 0u; mine = (j == x) ? c : mine; }
        if (sum == G) break;
        __builtin_amdgcn_s_sleep(1);
        if ((++sp & 255u) == 0u) { if (xb_ld(&bar[XB_TMO])) break; if (sp > XB_SPIN_CAP) { atomicAdd(&bar[XB_TMO], 1u); break; } }
    }
    nloc = mine > 0u ? mine : 1u; nx = cnt > 0u ? cnt : 1u;
}
__device__ __forceinline__ void xcd_barrier(const XcdBarrier& b) {
    asm volatile("s_waitcnt vmcnt(0)" ::: "memory");
    __syncthreads();
    if (threadIdx.x == 0) {
        unsigned* bar = b.bar;
        __builtin_amdgcn_s_waitcnt(0);
        unsigned nloc = b.st[0], nx = b.st[1];
        if (nloc == 0u) { xcd_barrier_complete(bar, b.x, nloc, nx); b.st[0] = nloc; b.st[1] = nx; }
        const unsigned old = xb_add(&bar[XB_XSUB(b.x)], 1u);
        const unsigned gen = old / nloc;
        if (old + 1u == (gen + 1u) * nloc) {
            __builtin_amdgcn_fence(__ATOMIC_RELEASE, "agent");
            asm volatile("s_waitcnt vmcnt(0)" ::: "memory");
            const unsigned og = xb_add(&bar[XB_TOP], 1u);
            const unsigned tg = og / nx;
            if (og + 1u == (tg + 1u) * nx) xb_add(&bar[XB_TOPGEN], 1u);
            else XB_SPIN(xb_ld(&bar[XB_TOPGEN]) == tg, bar);
            __builtin_amdgcn_fence(__ATOMIC_ACQUIRE, "agent");
            xb_add(&bar[XB_XGEN(b.x)], 1u);
            asm volatile("s_waitcnt vmcnt(0)" ::: "memory");
        } else {
            XB_SPIN(xb_ld(&bar[XB_XGEN(b.x)]) == gen, bar);
            __builtin_amdgcn_fence(__ATOMIC_ACQUIRE, "agent");
            asm volatile("s_waitcnt vmcnt(0)" ::: "memory");
        }
    }
    __syncthreads();
}

struct Frame {
    LAS unsigned char* lds;
    volatile LAS unsigned* MISC;
    gu32* ctl;
    int tid, lane, wave, G;
    unsigned long long tp;
    float* out; unsigned char* ws;
};
#define WSP(T, off) ((T*)(F.ws + (off)))
#define WSL(T, off) ((T*)(ws_ + (off)))
#define LAUNDER_WS() unsigned char* ws_ = F.ws; asm volatile("" : "+s"(ws_))
constexpr int PTR_OFF = MISC_OFF + 128;
enum { I_XP = 0, I_XS, I_C1, I_C2, I_C3, I_ST0, I_RELB, I_WIN, I_WG2, I_BG, I_GN, I_WA, I_WB, I_WO, I_L1G, I_L1B, I_WQ, I_KEYS, I_PU, I_PV, I_L2G, I_L2B };
__device__ __forceinline__ const float* inptr(const Frame& F, int i) {
    const unsigned long long v = ((volatile LAS unsigned long long*)(F.lds + PTR_OFF))[i];
    const unsigned lo = __builtin_amdgcn_readfirstlane((unsigned)v), hi = __builtin_amdgcn_readfirstlane((unsigned)(v >> 32));
    return (const float*)(((unsigned long long)hi << 32) | lo);
}

__device__ __forceinline__ void p0_tr_load(const float* W, int N, int nsrc0, int k0, int lane, float (&v)[32]) {
#pragma unroll
    for (int i = 0; i < 32; ++i) { const int kk = 2 * i + (lane >> 5); v[i] = W[(size_t)(k0 + kk) * N + nsrc0 + (lane & 31)]; }
}
__device__ __forceinline__ void p0_tr_finish(const float (&v)[32], int K, bf16* WT, int ndst0, int k0, LAS float* scr, int lane) {
#pragma unroll
    for (int i = 0; i < 32; ++i) { const int kk = 2 * i + (lane >> 5); scr[kk * 33 + (lane & 31)] = v[i]; }
    LDS_WAIT(); asm volatile("" ::: "memory");
    const int c = lane & 7;
#pragma unroll
    for (int j = 0; j < 4; ++j) { const int n = (lane >> 3) + 8 * j; const LAS float* s = scr + (8 * c) * 33 + n;
        v4u o; o.x = cvt_pk_bf16(s[0 * 33], s[1 * 33]); o.y = cvt_pk_bf16(s[2 * 33], s[3 * 33]); o.z = cvt_pk_bf16(s[4 * 33], s[5 * 33]); o.w = cvt_pk_bf16(s[6 * 33], s[7 * 33]);
        *(GAS v4u*)(WT + (size_t)(ndst0 + n) * K + k0 + 8 * c) = o; }
    LDS_WAIT(); asm volatile("" ::: "memory");
}
__device__ __forceinline__ void p0_cvt8(const float* src, bf16* dst, size_t n8, size_t gt, size_t ngt) {
    for (size_t i = gt; i < n8; i += ngt) { const f32x4 a = *(const f32x4*)(src + i * 8), b = *(const f32x4*)(src + i * 8 + 4);
        v4u o; o.x = cvt_pk_bf16(a[0], a[1]); o.y = cvt_pk_bf16(a[2], a[3]); o.z = cvt_pk_bf16(b[0], b[1]); o.w = cvt_pk_bf16(b[2], b[3]); *(v4u*)(dst + i * 8) = o; }
}
typedef float f32x2_t __attribute__((ext_vector_type(2)));
typedef _Float16 h2_t __attribute__((ext_vector_type(2)));
constexpr float U_SCALE = 1024.0f, V_SCALE = 128.0f, X_SCALE = 16.0f;
__device__ __forceinline__ void p0_cvt_fp8(const float* src, unsigned char* dst, float scale, size_t n16, size_t gt, size_t ngt) {
    for (size_t i = gt; i < n16; i += ngt) { v4u o;
#pragma unroll
        for (int q = 0; q < 4; ++q) { const f32x4 a = *(const f32x4*)(src + i * 16 + 4 * q) * scale; int w = 0;
            w = __builtin_amdgcn_cvt_pk_fp8_f32(a[0], a[1], w, false); w = __builtin_amdgcn_cvt_pk_fp8_f32(a[2], a[3], w, true); o[q] = (unsigned)w; }
        const size_t e = i >> 6, q16 = i & 63;
        *(v4u*)(dst + (((q16 >> 3) * 16384 + e) << 7) + 16 * (q16 & 7)) = o; }
}
__device__ __forceinline__ void p0_kvshift(const float* src, float* dst, int Wb, size_t gt, size_t ngt) {
    const size_t n4 = (size_t)(Wb - 4) * 256, tot = n4 * 32;
    for (size_t i = gt; i < tot; i += ngt) { const size_t b = i / n4, r = i - b * n4;
        ((f32x4*)dst)[b * (size_t)Wb * 256 + r] = ((const f32x4*)src)[b * (size_t)Wb * 256 + 1024 + r]; }
}
__device__ __forceinline__ void p0_prologue(Frame& F) {
    const int gw = blockIdx.x * NWAVES + F.wave, NGW = F.G * NWAVES;
    const size_t gt = (size_t)blockIdx.x * NTHR + F.tid, ngt = (size_t)F.G * NTHR;
    const float* win = inptr(F, I_WIN); const float* xp = inptr(F, I_XP); const float* xs = inptr(F, I_XS);
    constexpr int WROW = 2064;
    for (int i = F.tid; i < 4096; i += NTHR) {
        const int k = i >> 2, c4 = (i & 3) * 4; const f32x4 w4 = *(const f32x4*)(win + (size_t)k * INW + ABCOL + c4);
#pragma unroll
        for (int cc = 0; cc < 4; ++cc) *(LAS unsigned short*)(F.lds + (c4 + cc) * WROW + k * 2) = f2bf(w4[cc]); }
    __syncthreads();
    bf16* XB = WSP(bf16, WS_XB); float* AB = WSP(float, WS_AB);
    {   const int lane = F.lane, r = lane & 15, kg = lane >> 4;
        typedef float f32x4a __attribute__((ext_vector_type(4)));
        for (int blk = gw; blk < MPAD / 16; blk += NGW) {
            const int m = 16 * blk + r;
            bf16* xo = XB + (size_t)m * 1024 + 8 * kg;
            if (16 * blk >= NTOK) {
#pragma unroll 8
                for (int s = 0; s < 32; ++s) *(v4u*)(xo + 32 * s) = (v4u){0u, 0u, 0u, 0u};
                if (kg == 0) { *(f32x4*)(AB + (size_t)m * 16) = (f32x4){0.f, 0.f, 0.f, 0.f}; *(f32x4*)(AB + (size_t)m * 16 + 4) = (f32x4){0.f, 0.f, 0.f, 0.f}; *(f32x4*)(AB + (size_t)m * 16 + 8) = (f32x4){0.f, 0.f, 0.f, 0.f}; *(f32x4*)(AB + (size_t)m * 16 + 12) = (f32x4){0.f, 0.f, 0.f, 0.f}; }
                continue; }
            const float* xr = (m < NP ? xp + (size_t)m * 1024 : xs + (size_t)(m - NP) * 1024) + 8 * kg;
            f32x4a acc = {0.f, 0.f, 0.f, 0.f};
#pragma unroll 1
            for (int s0 = 0; s0 < 32; s0 += 16) {
                f32x4 xa[16], xb[16];
#pragma unroll
                for (int u = 0; u < 16; ++u) { xa[u] = *(const f32x4*)(xr + 32 * (s0 + u)); xb[u] = *(const f32x4*)(xr + 32 * (s0 + u) + 4); }
#pragma unroll
                for (int u = 0; u < 16; ++u) { v4u w; w.x = cvt_pk_bf16(xa[u][0], xa[u][1]); w.y = cvt_pk_bf16(xa[u][2], xa[u][3]); w.z = cvt_pk_bf16(xb[u][0], xb[u][1]); w.w = cvt_pk_bf16(xb[u][2], xb[u][3]);
                    *(v4u*)(xo + 32 * (s0 + u)) = w;
                    const bf16x8 bfr = *(const LAS bf16x8*)(F.lds + r * WROW + (32 * (s0 + u) + 8 * kg) * 2);
                    acc = __builtin_amdgcn_mfma_f32_16x16x32_bf16(__builtin_bit_cast(bf16x8, w), bfr, acc, 0, 0, 0); }
            }
#pragma unroll
            for (int i2 = 0; i2 < 4; ++i2) AB[(size_t)(16 * blk + 4 * kg + i2) * 16 + r] = acc[i2];
        }
    }
    __syncthreads();
    LAS float* scr = (LAS float*)(F.lds + F.wave * 16384);
    const float* wa = inptr(F, I_WA); const float* wb = inptr(F, I_WB); const float* wo = inptr(F, I_WO); const float* wq = inptr(F, I_WQ);
    constexpr int I_IN = 16 * (NPROJ / 32), I_A = 8 * 32, I_B = 16 * 32, I_O = 16 * 32, I_Q = 16 * 64, NIT = I_IN + I_A + I_B + I_O + I_Q;
#define P0_TR_PARAMS(IT, W_, WT_, K_, N_, NS_, ND_, K0_) { int r = (IT); \
        if (r < I_IN) { const int nb = r % (NPROJ / 32), kb = r / (NPROJ / 32), nd = 32 * nb; W_ = win; WT_ = WSP(bf16, WS_WIN); K_ = 1024; N_ = INW; NS_ = nd + (nd >= ABCOL ? 16 : 0); ND_ = nd; K0_ = 64 * kb; } \
        else if ((r -= I_IN) < I_A) { W_ = wa; WT_ = WSP(bf16, WS_WA); K_ = 512; N_ = 1024; NS_ = ND_ = 32 * (r % 32); K0_ = 64 * (r / 32); } \
        else if ((r -= I_A) < I_B) { W_ = wb; WT_ = WSP(bf16, WS_WB); K_ = 1024; N_ = 1024; NS_ = ND_ = 32 * (r % 32); K0_ = 64 * (r / 32); } \
        else if ((r -= I_B) < I_O) { W_ = wo; WT_ = WSP(bf16, WS_WO); K_ = 1024; N_ = 1024; NS_ = ND_ = 32 * (r % 32); K0_ = 64 * (r / 32); } \
        else { r -= I_O; W_ = wq; WT_ = WSP(bf16, WS_WQ); K_ = 1024; N_ = 2048; NS_ = ND_ = 32 * (r % 64); K0_ = 64 * (r / 64); } }
    if (blockIdx.x != 0) {
        const int NW2 = NGW - NWAVES;
        for (int it = gw - NWAVES; it < NIT; it += 2 * NW2) {
            const int it2 = it + NW2; const bool has2 = it2 < NIT;
            const float* Wa; bf16* WTa; int Ka, Na, NSa, NDa, K0a; P0_TR_PARAMS(it, Wa, WTa, Ka, Na, NSa, NDa, K0a);
            const float* Wb = Wa; bf16* WTb = WTa; int Kb = Ka, Nb = Na, NSb = NSa, NDb = NDa, K0b = K0a;
            if (has2) P0_TR_PARAMS(it2, Wb, WTb, Kb, Nb, NSb, NDb, K0b);
            float va[32], vb[32];
            p0_tr_load(Wa, Na, NSa, K0a, F.lane, va);
            if (has2) p0_tr_load(Wb, Nb, NSb, K0b, F.lane, vb);
            p0_tr_finish(va, Ka, WTa, NDa, K0a, scr, F.lane);
            if (has2) p0_tr_finish(vb, Kb, WTb, NDb, K0b, scr, F.lane);
        }
    }
    p0_cvt_fp8(inptr(F, I_PU), WSP(unsigned char, WS_UT), U_SCALE, (size_t)16384 * 1024 / 16, gt, ngt);
    p0_cvt_fp8(inptr(F, I_PV), WSP(unsigned char, WS_VT), V_SCALE, (size_t)16384 * 1024 / 16, gt, ngt);
    p0_cvt8(inptr(F, I_KEYS), WSP(bf16, WS_KEYS), (size_t)8 * 2 * 128 * 128 / 8, gt, ngt);
    if (gt < 3 * 8 * 129) { const int g = (int)gt / (8 * 129), h = ((int)gt / 129) % 8, rel = (int)gt % 129; const int dil = g == 0 ? 1 : (g == 1 ? 4 : 16), dist = rel * dil;
        int bucket = dist;
        if (dist >= 16) { const float dd = (float)dist; int lg = 16 + (int)(logf(dd / 16.0f) / 4.852030263919617f * 16.0f); bucket = lg < 31 ? lg : 31; }
        WSP(float, WS_LUT)[gt] = inptr(F, I_RELB)[bucket * 24 + g * 8 + h]; }
}

constexpr size_t WS_KD = WS_OAM, WS_DEC = WS_OBN;
__device__ __forceinline__ void gla_prep_load(Frame& F, int unit, unsigned (&qv)[8], unsigned (&kv)[8], float (&abv)[2]) {
    const int d2 = F.tid & 63, ig = F.wave, h = unit & 3, n = (unit >> 2) & 63, b = unit >> 8;
    const size_t m0 = (size_t)b * TSEQ + (size_t)n * 64;
    const bf16* QB = WSP(bf16, WS_QB); const bf16* KB = WSP(bf16, WS_KB); const float* AB = WSP(float, WS_AB);
#pragma unroll
    for (int ii = 0; ii < 8; ++ii) { const size_t off = (m0 + 8 * ig + ii) * 512 + h * 128 + 2 * d2; qv[ii] = *(const unsigned*)(QB + off); kv[ii] = *(const unsigned*)(KB + off); }
    abv[0] = AB[(m0 + 8 * ig) * 16 + d2]; abv[1] = AB[(m0 + 8 * ig) * 16 + 64 + d2];
}
__device__ __forceinline__ void gla_prep_unit(Frame& F, int unit, const unsigned (&qv)[8], const unsigned (&kv)[8], const float (&abv)[2], const f32x2_t (&wg)[16], const f32x2_t bgd) {
    LAUNDER_WS();
    LAS float* GT = (LAS float*)F.lds;
    const int tid = F.tid, d2 = tid & 63, ig = F.wave;
    const int h = unit & 3, n = (unit >> 2) & 63, b = unit >> 8;
    const size_t m0 = (size_t)b * TSEQ + (size_t)n * 64;
    bf16* QB = WSL(bf16, WS_QB); bf16* KB = WSL(bf16, WS_KB); float* DEC = WSL(float, WS_DEC);
    f32x2_t c[8]; f32x2_t run = {0.f, 0.f};
#pragma unroll
    for (int ii = 0; ii < 8; ++ii) {
        f32x2_t x = bgd;
#pragma unroll
        for (int r = 0; r < 16; ++r) x += wg[r] * __uint_as_float((unsigned)__builtin_amdgcn_readlane((int)__float_as_uint(abv[ii >> 2]), 16 * (ii & 3) + r));
        f32x2_t ls; ls.x = fminf(x.x, 0.f) - __logf(1.0f + __expf(-fabsf(x.x))); ls.y = fminf(x.y, 0.f) - __logf(1.0f + __expf(-fabsf(x.y)));
        run += ls * (1.0f / 16.0f); c[ii] = run;
    }
    *(LAS f32x2_t*)(GT + ig * 128 + 2 * d2) = run;
    __syncthreads();
    f32x2_t offs = {0.f, 0.f}, bl = {0.f, 0.f};
#pragma unroll
    for (int g = 0; g < 8; ++g) { const f32x2_t t = *(const LAS f32x2_t*)(GT + g * 128 + 2 * d2); bl += t; if (g < ig) offs += t; }
    const f32x2_t ebl = {__expf(bl.x), __expf(bl.y)};
#pragma unroll
    for (int ii = 0; ii < 8; ++ii) {
        const f32x2_t bb = offs + c[ii]; const f32x2_t eb = {__expf(bb.x), __expf(bb.y)}, ieb = {__expf(-bb.x), __expf(-bb.y)};
        const f32x2_t q = {bf_lo(qv[ii]), bf_hi(qv[ii])}, k = {bf_lo(kv[ii]), bf_hi(kv[ii])};
        const f32x2_t qe = q * GLA_QSCALE * eb, ke = k * ieb;
        const size_t off = (m0 + 8 * ig + ii) * 512 + h * 128 + 2 * d2;
        *(unsigned*)(QB + off) = cvt_pk_bf16(qe.x, qe.y); *(unsigned*)(KB + off) = cvt_pk_bf16(ke.x, ke.y);
    }
    if (ig == 0) *(f32x2_t*)(DEC + ((size_t)b * 64 + n) * 512 + h * 128 + 2 * d2) = ebl;
    __syncthreads();
}
__device__ __forceinline__ void gla_prompt_unit(Frame& F, int b, int h, int sl) {
    LAUNDER_WS();
    LAS unsigned char* L = F.lds;
    constexpr int O_QE = 0, O_KE = 17408, O_KD = 34816, O_VT = 55296, O_SB = 67584, O_DEC = 92160;
    const int tid = F.tid, lane = F.lane, w = F.wave, hh = lane >> 5;
    const bf16* QB = WSL(bf16, WS_QB); const bf16* KB = WSL(bf16, WS_KB); bf16* VB = WSL(bf16, WS_VB); const float* DEC = WSL(float, WS_DEC);
    for (int i = tid; i < 128 * 192 / 4; i += NTHR) ((LAS unsigned*)(L + O_SB))[i] = 0u;
    f32x16 S;
#pragma unroll
    for (int r = 0; r < 16; ++r) S[r] = 0.f;
    const int dt = w >> 1, et = w & 1;
    const int r0 = tid >> 4, c0 = tid & 15;
    v4u tq[2], tk[2], tv; float tdec = 0.f;
#define GLA_LOAD(n_) do { const size_t m0_ = (size_t)b * TSEQ + (size_t)(n_) * 64; \
        _Pragma("unroll") for (int i_ = 0; i_ < 2; ++i_) { const size_t off_ = (m0_ + r0 + 32 * i_) * 512 + h * 128 + c0 * 8; tq[i_] = *(const v4u*)(QB + off_); tk[i_] = *(const v4u*)(KB + off_); } \
        tv = *(const v4u*)(VB + (m0_ + (tid >> 3)) * 1024 + h * 256 + sl * 64 + (tid & 7) * 8); \
        if (tid < 128) tdec = DEC[((size_t)b * 64 + (n_)) * 512 + h * 128 + tid]; } while (0)
    GLA_LOAD(0);
    for (int n = 0; n < 64; ++n) {
        const size_t m0 = (size_t)b * TSEQ + (size_t)n * 64;
#pragma unroll
        for (int i = 0; i < 2; ++i) { *(LAS v4u*)(L + O_QE + (r0 + 32 * i) * 272 + c0 * 16) = tq[i]; *(LAS v4u*)(L + O_KE + (r0 + 32 * i) * 272 + c0 * 16) = tk[i]; *(LAS v4u*)(L + O_KD + (r0 + 32 * i) * 320 + c0 * 16) = tk[i]; }
        *(LAS v4u*)(L + O_VT + (tid >> 3) * 192 + (tid & 7) * 16) = tv;
        if (tid < 128) ((LAS float*)(L + O_DEC))[tid] = tdec;
        __syncthreads();
        if (n + 1 < 64) GLA_LOAD(n + 1);
        if (w < 4) {
            const int it = w >> 1;
            f32x16 o;
#pragma unroll
            for (int r = 0; r < 16; ++r) o[r] = 0.f;
            for (int jt = 0; jt <= it; ++jt) {
                f32x16 X;
#pragma unroll
                for (int r = 0; r < 16; ++r) X[r] = 0.f;
#pragma unroll
                for (int s = 0; s < 8; ++s) X = MFMA32(frag_row(L + O_KE, 272, 32 * jt, 16 * s, lane), frag_row(L + O_QE, 272, 32 * it, 16 * s, lane), X);
                if (jt == it) {
#pragma unroll
                    for (int r = 0; r < 16; ++r) if (crow(r, hh) > (lane & 31)) X[r] = 0.f;
                }
#pragma unroll
                for (int s2 = 0; s2 < 2; ++s2) o = MFMA32(pack_acc(X, s2), frag_tr<true>(L + O_VT, 192, 32 * jt + 16 * s2, 32 * et, lane), o);
            }
#pragma unroll
            for (int s = 0; s < 8; ++s) o = MFMA32(frag_row(L + O_QE, 272, 32 * it, 16 * s, lane), frag_tr<false>(L + O_SB, 192, 16 * s, 32 * et, lane), o);
            bf16* op = VB + (m0 + 32 * it) * 1024 + h * 256 + sl * 64 + 32 * et + (lane & 31);
#pragma unroll
            for (int r = 0; r < 16; ++r) op[(size_t)crow(r, hh) * 1024] = f2bf(o[r]);
        }
        {
#pragma unroll
            for (int s = 0; s < 4; ++s) S = MFMA32(frag_tr<false>(L + O_KD, 320, 16 * s, 32 * dt, lane), frag_tr<false>(L + O_VT, 192, 16 * s, 32 * et, lane), S);
#pragma unroll
            for (int r = 0; r < 16; ++r) S[r] *= ((LAS float*)(L + O_DEC))[32 * dt + crow(r, hh)];
        }
        __syncthreads();
#pragma unroll
        for (int r = 0; r < 16; ++r) *(LAS unsigned short*)(L + O_SB + (32 * dt + crow(r, hh)) * 192 + (32 * et + (lane & 31)) * 2) = f2bf(S[r]);
    }
#undef GLA_LOAD
    float* so = F.out + OUT_STP + ((size_t)(b * 4 + h) * 128 + 32 * dt) * 256 + sl * 64 + 32 * et + (lane & 31);
#pragma unroll
    for (int r = 0; r < 16; ++r) so[(size_t)crow(r, hh) * 256] = S[r];
    __syncthreads();
}

struct AttnItem { int b, h, g, r, dil, i0, cb; size_t tok0; };
__device__ __forceinline__ AttnItem attn_decode(int item) {
    AttnItem a; const int bh = item / 48, sub = item % 48; a.b = bh >> 3; a.h = bh & 7;
    int ibg;
    if (sub < 16) { a.g = 0; a.r = 0; ibg = sub; } else if (sub < 32) { a.g = 1; a.r = (sub - 16) >> 2; ibg = (sub - 16) & 3; } else { a.g = 2; a.r = sub - 32; ibg = 0; }
    a.dil = a.g == 0 ? 1 : (a.g == 1 ? 4 : 16); a.i0 = 256 * ibg; a.tok0 = (size_t)a.b * TSEQ + a.r; a.cb = a.g * 512 + a.h * 64;
    return a;
}
__device__ __forceinline__ void attn_issue(Frame& F, int item, v4u (&kk)[6], v4u (&vv)[6], bf16x8 (&qf)[4]) {
    LAUNDER_WS();
    const AttnItem a = attn_decode(item);
    const int tid = F.tid, lane = F.lane, w = F.wave, hh = lane >> 5, il = lane & 31;
    const bf16* QA = WSL(bf16, WS_QA); const bf16* KA = WSL(bf16, WS_KA); const bf16* VA = WSL(bf16, WS_VA);
    const size_t qtok = a.tok0 + (size_t)a.dil * (a.i0 + 32 * w + il);
#pragma unroll
    for (int s = 0; s < 4; ++s) qf[s] = *(const bf16x8*)(QA + qtok * 1536 + a.cb + 16 * s + 8 * hh);
#pragma unroll
    for (int p = 0; p < 6; ++p) { const int idx = tid + NTHR * p, rr = idx >> 3, ch = idx & 7, j = a.i0 - 128 + rr;
        if (j >= 0) { const size_t so = (a.tok0 + (size_t)a.dil * j) * 1536 + a.cb + ch * 8; vv[p] = *(const v4u*)(VA + so); kk[p] = *(const v4u*)(KA + so); } }
}
__device__ __forceinline__ void attn_prompt_item(Frame& F, int item, v4u (&kk)[6], v4u (&vv)[6], const bf16x8 (&qf)[4], bool has_next, int next_item, bf16x8 (&qn)[4]) {
    LAUNDER_WS();
    LAS unsigned char* L = F.lds;
    constexpr int O_V = 0, O_K = 384 * 192, O_LUT = O_K + 384 * 144;
    static_assert(O_LUT + 129 * 4 <= RING_BYTES, "attention LDS");
    const int tid = F.tid, lane = F.lane, w = F.wave, hh = lane >> 5, il = lane & 31;
    const AttnItem a = attn_decode(item);
    const int b = a.b, h = a.h, g = a.g, dil = a.dil, i0 = a.i0, cb = a.cb; const size_t tok0 = a.tok0; (void)b;
    bf16* QA = WSL(bf16, WS_QA); float* LSE = WSL(float, WS_LSE);
    const size_t qtok = tok0 + (size_t)dil * (i0 + 32 * w + il);
#pragma unroll
    for (int p = 0; p < 6; ++p) { const int idx = tid + NTHR * p, rr = idx >> 3, ch = idx & 7, j = i0 - 128 + rr;
        if (j >= 0) { *(LAS v4u*)(L + O_V + rr * 192 + ch * 16) = vv[p]; *(LAS v4u*)(L + O_K + rr * 144 + ch * 16) = kk[p]; } }
    if (tid < 129) ((LAS float*)(L + O_LUT))[tid] = WSL(float, WS_LUT)[(g * 8 + h) * 129 + tid];
    __syncthreads();
    if (has_next) attn_issue(F, next_item, kk, vv, qn);
    float mrun = NEG_BIG, lrun = 0.f;
    f32x16 O0, O1;
#pragma unroll
    for (int x = 0; x < 16; ++x) { O0[x] = 0.f; O1[x] = 0.f; }
#pragma unroll 1
    for (int kt = 0; kt < 5; ++kt) {
        const int jb = i0 + 32 * (w + kt) - 128;
        if (jb < 0) continue;
        f32x16 ST;
#pragma unroll
        for (int x = 0; x < 16; ++x) ST[x] = 0.f;
#pragma unroll
        for (int s = 0; s < 4; ++s) ST = MFMA32(frag_row(L + O_K, 144, 32 * (w + kt), 16 * s, lane), qf[s], ST);
        const int relb = 128 - 32 * kt + il;
        float tmax = NEG_BIG;
#pragma unroll
        for (int x = 0; x < 16; ++x) { const int rel = relb - crow(x, hh); const bool ok = rel >= 0 && rel <= 128; const int rc = rel < 0 ? 0 : (rel > 128 ? 128 : rel);
            const float sc = ok ? ST[x] + ((LAS float*)(L + O_LUT))[rc] : NEG_BIG; ST[x] = sc; tmax = fmaxf(tmax, sc); }
        tmax = fmaxf(tmax, __shfl_xor(tmax, 32));
        const float mnew = fmaxf(mrun, tmax), alpha = __expf(mrun - mnew);
        float ps = 0.f;
#pragma unroll
        for (int x = 0; x < 16; ++x) { const float p = __expf(ST[x] - mnew); ST[x] = p; ps += p; }
        lrun = lrun * alpha + ps; mrun = mnew;
#pragma unroll
        for (int x = 0; x < 16; ++x) { O0[x] *= alpha; O1[x] *= alpha; }
#pragma unroll
        for (int s2 = 0; s2 < 2; ++s2) { const bf16x8 pf = pack_acc(ST, s2);
            O0 = MFMA32(frag_tr<true>(L + O_V, 192, 32 * (w + kt) + 16 * s2, 0, lane), pf, O0);
            O1 = MFMA32(frag_tr<true>(L + O_V, 192, 32 * (w + kt) + 16 * s2, 32, lane), pf, O1); }
    }
    const float ltot = lrun + __shfl_xor(lrun, 32), inv = 1.0f / ltot;
    bf16* op = QA + qtok * 1536 + cb;
#pragma unroll
    for (int k4 = 0; k4 < 4; ++k4) { v2u a, c2;
        a.x = cvt_pk_bf16(O0[4 * k4] * inv, O0[4 * k4 + 1] * inv); a.y = cvt_pk_bf16(O0[4 * k4 + 2] * inv, O0[4 * k4 + 3] * inv);
        c2.x = cvt_pk_bf16(O1[4 * k4] * inv, O1[4 * k4 + 1] * inv); c2.y = cvt_pk_bf16(O1[4 * k4 + 2] * inv, O1[4 * k4 + 3] * inv);
        *(v2u*)(op + 8 * k4 + 4 * hh) = a; *(v2u*)(op + 32 + 8 * k4 + 4 * hh) = c2; }
    if (hh == 0) LSE[((size_t)g * MPAD + qtok) * 8 + h] = mrun + __logf(ltot);
    __syncthreads();
}

#define DPP_FA(x, ctrl) __uint_as_float((unsigned)__builtin_amdgcn_mov_dpp((int)__float_as_uint(x), (ctrl), 0xf, 0xf, true))
template <int G_> __device__ __forceinline__ void attn_sample_waveitem_g(Frame& F, int wi, const float* cache) {
    LAUNDER_WS();
    int lane = F.lane; asm volatile("" : "+v"(lane));
    const int grp = lane >> 4, l16 = lane & 15;
    constexpr int g = G_; const int h = (wi / 3) & 7, s = (wi / 24) & 3, b = wi / 96;
    constexpr int dil = g == 0 ? 1 : (g == 1 ? 4 : 16), Wb = 128 * dil;
    bf16* QA = WSL(bf16, WS_QA); const bf16* KA = WSL(bf16, WS_KA); const bf16* VA = WSL(bf16, WS_VA); float* LSE = WSL(float, WS_LSE);
    const size_t qrow = (size_t)NP + b * 4 + s; const int cb = g * 512 + h * 64;
    const v2u qu = *(const v2u*)(QA + qrow * 1536 + cb + 4 * l16);
    const float q0 = bf_lo(qu.x), q1 = bf_hi(qu.x), q2 = bf_lo(qu.y), q3 = bf_hi(qu.y);
    const float* lut = WSL(float, WS_LUT) + (g * 8 + h) * 129;
    const float* kc = cache + ((size_t)b * Wb * 2) * 512 + h * 64 + 4 * l16;
    const bf16* kn = KA + ((size_t)NP + b * 4) * 1536 + cb + 4 * l16; const bf16* vn = VA + ((size_t)NP + b * 4) * 1536 + cb + 4 * l16;
    float sc[33];
#pragma unroll
    for (int i0 = 0; i0 < 33; i0 += 11) { f32x4 kv[11]; float lb[11];
#pragma unroll
        for (int u = 0; u < 11; ++u) { const int jj = 4 * (i0 + u) + grp; kv[u] = (f32x4){0.f, 0.f, 0.f, 0.f}; lb[u] = 0.f;
            if (jj <= 128) { const int idx = Wb + s - jj * dil; lb[u] = lut[jj];
                if (idx >= Wb) { const v2u w2 = *(const v2u*)(kn + (size_t)(idx - Wb) * 1536); kv[u] = (f32x4){bf_lo(w2.x), bf_hi(w2.x), bf_lo(w2.y), bf_hi(w2.y)}; }
                else kv[u] = *(const f32x4*)(kc + (size_t)idx * 1024); } }
#pragma unroll
        for (int u = 0; u < 11; ++u) { const int jj = 4 * (i0 + u) + grp;
            float a = (q0 * kv[u][0] + q1 * kv[u][1]) + (q2 * kv[u][2] + q3 * kv[u][3]);
            a += DPP_FA(a, 0xB1); a += DPP_FA(a, 0x4E); a += DPP_FA(a, 0x141); a += DPP_FA(a, 0x128);
            sc[i0 + u] = jj <= 128 ? a + lb[u] : NEG_BIG; }
    }
    float mx = sc[0];
#pragma unroll
    for (int i = 1; i < 33; ++i) mx = fmaxf(mx, sc[i]);
    mx = fmaxf(mx, __shfl_xor(mx, 16)); mx = fmaxf(mx, __shfl_xor(mx, 32));
    float ps = 0.f;
#pragma unroll
    for (int i = 0; i < 33; ++i) { sc[i] = __expf(sc[i] - mx); ps += sc[i]; }
    ps += __shfl_xor(ps, 16); ps += __shfl_xor(ps, 32);
    f32x4 o = {0.f, 0.f, 0.f, 0.f};
#pragma unroll
    for (int i0 = 0; i0 < 33; i0 += 11) { f32x4 vv[11];
#pragma unroll
        for (int u = 0; u < 11; ++u) { const int jj = 4 * (i0 + u) + grp; vv[u] = (f32x4){0.f, 0.f, 0.f, 0.f};
            if (jj <= 128) { const int idx = Wb + s - jj * dil;
                if (idx >= Wb) { const v2u w2 = *(const v2u*)(vn + (size_t)(idx - Wb) * 1536); vv[u] = (f32x4){bf_lo(w2.x), bf_hi(w2.x), bf_lo(w2.y), bf_hi(w2.y)}; }
                else vv[u] = *(const f32x4*)(kc + (size_t)idx * 1024 + 512); } }
#pragma unroll
        for (int u = 0; u < 11; ++u) o += vv[u] * sc[i0 + u];
    }
#pragma unroll
    for (int k = 0; k < 4; ++k) { o[k] += __shfl_xor(o[k], 16); o[k] += __shfl_xor(o[k], 32); }
    const float inv = 1.0f / ps;
    if (grp == 0) { v2u w2; w2.x = cvt_pk_bf16(o[0] * inv, o[1] * inv); w2.y = cvt_pk_bf16(o[2] * inv, o[3] * inv); *(v2u*)(QA + qrow * 1536 + cb + 4 * l16) = w2; }
    if (lane == 0) LSE[((size_t)g * MPAD + qrow) * 8 + h] = mx + __logf(ps);
}

__device__ __forceinline__ void attn_sample_waveitem(Frame& F, int wi) {
    const int g = wi % 3;
    if (g == 0) attn_sample_waveitem_g<0>(F, wi, inptr(F, I_C1)); else if (g == 1) attn_sample_waveitem_g<1>(F, wi, inptr(F, I_C2)); else attn_sample_waveitem_g<2>(F, wi, inptr(F, I_C3));
}
__device__ __forceinline__ void gla_sample_item(Frame& F, int item) {
    LAUNDER_WS();
    LAS float* L = (LAS float*)F.lds;
    constexpr int O_LA = 0, O_QE = 512, O_KE = 1024, O_KD = 1536, O_DEC = 2048, O_ATT = 2176, O_PART = 2304;
    const int tid = F.tid, b = item >> 2, h = item & 3;
    const bf16* QB = WSL(bf16, WS_QB); const bf16* KB = WSL(bf16, WS_KB); bf16* VB = WSL(bf16, WS_VB); const float* AB = WSL(float, WS_AB);
    const size_t row0 = (size_t)NP + b * 4;
    { const int i = tid >> 7, d = tid & 127; float x = inptr(F, I_BG)[h * 128 + d]; const float* wg2 = inptr(F, I_WG2);
#pragma unroll
      for (int r = 0; r < 16; ++r) x += AB[(row0 + i) * 16 + r] * wg2[r * 512 + h * 128 + d];
      L[O_LA + i * 128 + d] = (fminf(x, 0.f) - log1pf(expf(-fabsf(x)))) * (1.0f / 16.0f); }
    __syncthreads();
    if (tid < 128) { const int d = tid; float bb[4]; float run = 0.f;
#pragma unroll
        for (int i = 0; i < 4; ++i) { run += L[O_LA + i * 128 + d]; bb[i] = run; }
        const float ebl = expf(run); L[O_DEC + d] = ebl;
#pragma unroll
        for (int i = 0; i < 4; ++i) { const float q = bf2f(QB[(row0 + i) * 512 + h * 128 + d]), k = bf2f(KB[(row0 + i) * 512 + h * 128 + d]);
            L[O_QE + i * 128 + d] = q * GLA_QSCALE * expf(bb[i]); L[O_KE + i * 128 + d] = k * expf(-bb[i]); L[O_KD + i * 128 + d] = k * expf(run - bb[i]); } }
    __syncthreads();
    if (tid < 16) { const int i = tid >> 2, j = tid & 3; float a = 0.f;
        if (j <= i) for (int d = 0; d < 128; ++d) a += L[O_QE + i * 128 + d] * L[O_KE + j * 128 + d];
        L[O_ATT + tid] = a; }
    const int e = tid & 255, dh = tid >> 8;
    float v[4];
#pragma unroll
    for (int j = 0; j < 4; ++j) v[j] = bf2f(VB[(row0 + j) * 1024 + h * 256 + e]);
    const float* Sin = inptr(F, I_ST0) + ((size_t)(b * 4 + h) * 128) * 256 + e; float* Sout = F.out + OUT_STS + ((size_t)(b * 4 + h) * 128) * 256 + e;
    float acc[4] = {0.f, 0.f, 0.f, 0.f};
#pragma unroll 1
    for (int dd0 = 0; dd0 < 64; dd0 += 16) { float svv[16];
#pragma unroll
        for (int u = 0; u < 16; ++u) svv[u] = Sin[(size_t)(dh * 64 + dd0 + u) * 256];
#pragma unroll
        for (int u = 0; u < 16; ++u) { const int d = dh * 64 + dd0 + u; const float sv = svv[u];
#pragma unroll
            for (int i = 0; i < 4; ++i) acc[i] += L[O_QE + i * 128 + d] * sv;
            float sn = L[O_DEC + d] * sv;
#pragma unroll
            for (int j = 0; j < 4; ++j) sn += L[O_KD + j * 128 + d] * v[j];
            Sout[(size_t)d * 256] = sn; } }
#pragma unroll
    for (int i = 0; i < 4; ++i) L[O_PART + (dh * 4 + i) * 256 + e] = acc[i];
    __syncthreads();
    if (tid < 256) {
#pragma unroll
        for (int i = 0; i < 4; ++i) { float o = L[O_PART + i * 256 + e] + L[O_PART + (4 + i) * 256 + e];
#pragma unroll
            for (int j = 0; j < 4; ++j) o += L[O_ATT + i * 4 + j] * v[j];
            VB[(row0 + i) * 1024 + h * 256 + e] = f2bf(o); } }
    __syncthreads();
}

static_assert(true, "");
constexpr int P2_ATT = 3072, P2_DEC = 384, P2_GLS = 128, P2_CPY = 32 * (2 + 8 + 32), P2_ITEMS = P2_ATT + P2_DEC + P2_GLS;
__device__ __forceinline__ void kvshift_item(Frame& F, int item) {
    int g, r = item; if (r < 64) g = 0; else if (r < 64 + 256) { g = 1; r -= 64; } else { g = 2; r -= 320; }
    const int Wb = g == 0 ? 128 : (g == 1 ? 512 : 2048), npc = Wb / 64, b = r / npc, pc = r % npc;
    const float* src = inptr(F, g == 0 ? I_C1 : (g == 1 ? I_C2 : I_C3)); float* dst = F.out + (g == 0 ? OUT_KVS1 : (g == 1 ? OUT_KVS2 : OUT_KVS3));
    const int nrow = (pc == npc - 1) ? 60 : 64;
    const f32x4* s4 = (const f32x4*)src + ((size_t)b * Wb + 64 * pc + 4) * 256; f32x4* d4 = (f32x4*)dst + ((size_t)b * Wb + 64 * pc) * 256;
    { const int i = F.tid; f32x4 v[32];
#pragma unroll
        for (int u = 0; u < 32; ++u) if (u < 30 || nrow == 64) v[u] = __builtin_nontemporal_load(s4 + i + u * NTHR);
#pragma unroll
        for (int u = 0; u < 32; ++u) if (u < 30 || nrow == 64) __builtin_nontemporal_store(v[u], d4 + i + u * NTHR); }
}
template <bool STOP_ON_GDONE> __device__ __forceinline__ void kvshift_loop(Frame& F) {
    for (;;) {
        if (F.tid == 0) { unsigned t = 0xffffffffu;
            if (!STOP_ON_GDONE || __hip_atomic_load(F.ctl + CW_GDONE, RLX_AGENT) == 0u) t = __hip_atomic_fetch_add(F.ctl + CW_CPYQ, 1u, RLX_AGENT);
            F.MISC[0] = t; }
        __syncthreads();
        const unsigned t = F.MISC[0];
        __syncthreads();
        if (t >= (unsigned)P2_CPY) break;
        kvshift_item(F, (int)t);
    }
}
__device__ __forceinline__ void p2_prep(Frame& F) {
    unsigned qa[8], ka[8], qb[8], kb[8]; float aa[2], ab2[2];
    int u = blockIdx.x; if (u >= 2048) return;
    const int d2 = F.tid & 63, h = u & 3;
    const float* wg2 = inptr(F, I_WG2); const float* bgp = inptr(F, I_BG);
    f32x2_t wg[16];
#pragma unroll
    for (int r = 0; r < 16; ++r) wg[r] = *(const f32x2_t*)(wg2 + r * 512 + h * 128 + 2 * d2);
    const f32x2_t bgd = *(const f32x2_t*)(bgp + h * 128 + 2 * d2);
    gla_prep_load(F, u, qa, ka, aa);
    for (;;) {
        const int u1 = u + F.G; if (u1 < 2048) gla_prep_load(F, u1, qb, kb, ab2);
        gla_prep_unit(F, u, qa, ka, aa, wg, bgd); if (u1 >= 2048) break;
        const int u2 = u1 + F.G; if (u2 < 2048) gla_prep_load(F, u2, qa, ka, aa);
        gla_prep_unit(F, u1, qb, kb, ab2, wg, bgd); if (u2 >= 2048) break;
        u = u2;
    }
}
__device__ __forceinline__ void p2_mixers(Frame& F) {
#if defined(PROBE_PHASE) && PROBE_PHASE >= 100
    const unsigned long long tp0 = __builtin_amdgcn_s_memrealtime();
#endif
#ifndef P2_SKIP_GLAP
    if (blockIdx.x < 128) {
        const int bx = blockIdx.x, bh = (bx & 7) + 8 * (bx >> 5), sl = (bx >> 3) & 3;
        gla_prompt_unit(F, bh >> 2, bh & 3, sl); }
#endif
#if defined(PROBE_PHASE) && PROBE_PHASE == 100
    if (blockIdx.x == 0) F.tp = __builtin_amdgcn_s_memrealtime() - tp0;
#endif
    constexpr int QCHUNK = 4;
    for (int it = 0, itend = 0;; ++it) {
        if (it >= itend) {
            if (F.tid == 0) F.MISC[0] = __hip_atomic_fetch_add(F.ctl + CW_QUEUE, (unsigned)QCHUNK, RLX_AGENT);
            __syncthreads();
            it = (int)F.MISC[0]; itend = it + QCHUNK;
            __syncthreads();
        }
        if (it >= P2_ITEMS) break;
#if defined(PROBE_PHASE) && PROBE_PHASE == 101
        if (blockIdx.x == 255) F.tp = __builtin_amdgcn_s_memrealtime() - tp0;
#endif
#if defined(PROBE_PHASE) && PROBE_PHASE == 102
        if (blockIdx.x == 255 && it >= P2_GLS + P2_DEC + P2_ATT && F.tp == 0ull) F.tp = __builtin_amdgcn_s_memrealtime() - tp0;
#endif
#if defined(PROBE_PHASE) && PROBE_PHASE >= 103 && PROBE_PHASE <= 106
        const unsigned long long ti0 = __builtin_amdgcn_s_memrealtime();
        const int pcls = it < P2_GLS ? 105 : (it < P2_GLS + P2_DEC ? 104 : (it < P2_GLS + P2_DEC + P2_ATT ? 103 : 106));
#endif
        if (it < P2_GLS) {
#ifndef P2_SKIP_GLAS
            gla_sample_item(F, it);
#endif
        } else if (it < P2_GLS + P2_DEC) {
#ifndef P2_SKIP_DEC
            attn_sample_waveitem(F, (it - P2_GLS) * 8 + F.wave); __syncthreads();
#endif
        } else if (it < P2_GLS + P2_DEC + P2_ATT) {
#ifndef P2_SKIP_ATT
            const int a0 = it - P2_GLS - P2_DEC;
            v4u kk[6], vv[6]; bf16x8 qa[4], qb[4];
            attn_issue(F, a0, kk, vv, qa);
            attn_prompt_item(F, a0, kk, vv, qa, true, a0 + 1, qb);
            attn_prompt_item(F, a0 + 1, kk, vv, qb, true, a0 + 2, qa);
            attn_prompt_item(F, a0 + 2, kk, vv, qa, true, a0 + 3, qb);
            attn_prompt_item(F, a0 + 3, kk, vv, qb, false, 0, qa);
            it = itend - 1;
#endif
        }
#if defined(PROBE_PHASE) && PROBE_PHASE >= 103 && PROBE_PHASE <= 106
        if (blockIdx.x == 255 && pcls == PROBE_PHASE) F.tp += __builtin_amdgcn_s_memrealtime() - ti0;
#endif
    }
#if defined(PROBE_PHASE) && PROBE_PHASE == 107
    const unsigned long long tc0 = __builtin_amdgcn_s_memrealtime();
#endif
    kvshift_loop<false>(F);
#if defined(PROBE_PHASE) && PROBE_PHASE == 107
    if (blockIdx.x == 255) F.tp = __builtin_amdgcn_s_memrealtime() - tc0;
#endif
}

__device__ __forceinline__ void p3_kvout(const bf16* K, const bf16* V, float* dst, int g, int W, int nb, size_t rowbase, int rows_per_b, int first, int pos0, int Wdst, size_t gt, size_t ngt) {
    const size_t per_b = (size_t)W * 2 * 64, tot = per_b * nb;
    for (size_t i0 = gt; i0 < tot; i0 += 4 * ngt) { v4u u[4]; float* o[4];
#pragma unroll
        for (int k = 0; k < 4; ++k) { const size_t i = i0 + k * ngt; if (i < tot) { const size_t b = i / per_b, r = i - b * per_b; const int p = (int)(r >> 7), c = (int)(r >> 6) & 1, ch = (int)r & 63;
            u[k] = *(const v4u*)((c ? V : K) + (rowbase + b * rows_per_b + first + p) * 1536 + g * 512 + ch * 8);
            o[k] = dst + ((b * Wdst + pos0 + p) * 2 + c) * 512 + ch * 8; } }
#pragma unroll
        for (int k = 0; k < 4; ++k) if (i0 + k * ngt < tot) {
            *(f32x4*)o[k] = (f32x4){bf_lo(u[k].x), bf_hi(u[k].x), bf_lo(u[k].y), bf_hi(u[k].y)}; *(f32x4*)(o[k] + 4) = (f32x4){bf_lo(u[k].z), bf_hi(u[k].z), bf_lo(u[k].w), bf_hi(u[k].w)}; } }
}
struct MergeRow { float l0, l1, l2; v4u a, b2, c, u0, u1, r0, r1; };
__device__ __forceinline__ void p3_merge_load(const bf16* OA, const bf16* OB, const bf16* RB, const float* LSE, int m, int lane, MergeRow& R) {
    const int hd = lane >> 3, c8 = (lane & 7) * 8, c0 = lane * 16;
    R.l0 = LSE[((size_t)0 * MPAD + m) * 8 + hd]; R.l1 = LSE[((size_t)1 * MPAD + m) * 8 + hd]; R.l2 = LSE[((size_t)2 * MPAD + m) * 8 + hd];
    R.a = *(const v4u*)(OA + (size_t)m * 1536 + hd * 64 + c8); R.b2 = *(const v4u*)(OA + (size_t)m * 1536 + 512 + hd * 64 + c8); R.c = *(const v4u*)(OA + (size_t)m * 1536 + 1024 + hd * 64 + c8);
    R.u0 = *(const v4u*)(OB + (size_t)m * 1024 + c0); R.u1 = *(const v4u*)(OB + (size_t)m * 1024 + c0 + 8);
    R.r0 = *(const v4u*)(RB + (size_t)m * 1024 + c0); R.r1 = *(const v4u*)(RB + (size_t)m * 1024 + c0 + 8);
}
__device__ __forceinline__ void p3_merge(Frame& F) {
    const int gw = blockIdx.x * NWAVES + F.wave, NGW = F.G * NWAVES, lane = F.lane;
    const size_t gt = (size_t)blockIdx.x * NTHR + F.tid, ngt = (size_t)F.G * NTHR;
    const bf16* OA = WSP(bf16, WS_QA); const bf16* OB = WSP(bf16, WS_VB); const bf16* RB = WSP(bf16, WS_RB); const float* LSE = WSP(float, WS_LSE);
    bf16* OAM = WSP(bf16, WS_OAM); bf16* OBN = WSP(bf16, WS_OBN); const float* gn = inptr(F, I_GN);
    float gnv[16];
#pragma unroll
    for (int i = 0; i < 16; ++i) gnv[i] = gn[lane * 16 + i];
    for (int m = NTOK + gw; m < MPAD; m += NGW) {
        *(v4u*)(OAM + (size_t)m * 512 + lane * 8) = (v4u){0u, 0u, 0u, 0u}; *(v4u*)(OBN + (size_t)m * 1024 + lane * 16) = (v4u){0u, 0u, 0u, 0u}; *(v4u*)(OBN + (size_t)m * 1024 + lane * 16 + 8) = (v4u){0u, 0u, 0u, 0u}; }
    int m = gw;
    if (m < NTOK) {
        MergeRow R, Rn; p3_merge_load(OA, OB, RB, LSE, m, lane, R);
        for (;;) {
            const int mn = m + NGW; const bool more = mn < NTOK;
            if (more) p3_merge_load(OA, OB, RB, LSE, mn, lane, Rn);
            {
                const int hd = lane >> 3, c8 = (lane & 7) * 8;
                const float l0 = R.l0, l1 = R.l1, l2 = R.l2;
                const float mx = fmaxf(l0, fmaxf(l1, l2)); float w0 = __expf(l0 - mx), w1 = __expf(l1 - mx), w2 = __expf(l2 - mx); const float iw = 1.0f / (w0 + w1 + w2); w0 *= iw; w1 *= iw; w2 *= iw;
                const v4u a = R.a, b2 = R.b2, c = R.c;
                v4u o;
                o.x = cvt_pk_bf16(w0 * bf_lo(a.x) + w1 * bf_lo(b2.x) + w2 * bf_lo(c.x), w0 * bf_hi(a.x) + w1 * bf_hi(b2.x) + w2 * bf_hi(c.x));
                o.y = cvt_pk_bf16(w0 * bf_lo(a.y) + w1 * bf_lo(b2.y) + w2 * bf_lo(c.y), w0 * bf_hi(a.y) + w1 * bf_hi(b2.y) + w2 * bf_hi(c.y));
                o.z = cvt_pk_bf16(w0 * bf_lo(a.z) + w1 * bf_lo(b2.z) + w2 * bf_lo(c.z), w0 * bf_hi(a.z) + w1 * bf_hi(b2.z) + w2 * bf_hi(c.z));
                o.w = cvt_pk_bf16(w0 * bf_lo(a.w) + w1 * bf_lo(b2.w) + w2 * bf_lo(c.w), w0 * bf_hi(a.w) + w1 * bf_hi(b2.w) + w2 * bf_hi(c.w));
                *(v4u*)(OAM + (size_t)m * 512 + hd * 64 + c8) = o;
            }
            {
                const int c0 = lane * 16;
                const v4u u0 = R.u0, u1 = R.u1, r0 = R.r0, r1 = R.r1;
                float x[16] = {bf_lo(u0.x), bf_hi(u0.x), bf_lo(u0.y), bf_hi(u0.y), bf_lo(u0.z), bf_hi(u0.z), bf_lo(u0.w), bf_hi(u0.w), bf_lo(u1.x), bf_hi(u1.x), bf_lo(u1.y), bf_hi(u1.y), bf_lo(u1.z), bf_hi(u1.z), bf_lo(u1.w), bf_hi(u1.w)};
                float rr[16] = {bf_lo(r0.x), bf_hi(r0.x), bf_lo(r0.y), bf_hi(r0.y), bf_lo(r0.z), bf_hi(r0.z), bf_lo(r0.w), bf_hi(r0.w), bf_lo(r1.x), bf_hi(r1.x), bf_lo(r1.y), bf_hi(r1.y), bf_lo(r1.z), bf_hi(r1.z), bf_lo(r1.w), bf_hi(r1.w)};
                float ss = 0.f;
#pragma unroll
                for (int i = 0; i < 16; ++i) ss += x[i] * x[i];
                ss += __shfl_xor(ss, 1); ss += __shfl_xor(ss, 2); ss += __shfl_xor(ss, 4); ss += __shfl_xor(ss, 8);
                const float rs = 1.0f / sqrtf(ss * (1.0f / 256.0f) + LN_EPS);
                float y[16];
#pragma unroll
                for (int i = 0; i < 16; ++i) { const float gte = rr[i] * __builtin_amdgcn_rcpf(1.0f + __expf(-rr[i])); y[i] = x[i] * rs * gnv[i] * gte; }
                v4u o0, o1; o0.x = cvt_pk_bf16(y[0], y[1]); o0.y = cvt_pk_bf16(y[2], y[3]); o0.z = cvt_pk_bf16(y[4], y[5]); o0.w = cvt_pk_bf16(y[6], y[7]);
                o1.x = cvt_pk_bf16(y[8], y[9]); o1.y = cvt_pk_bf16(y[10], y[11]); o1.z = cvt_pk_bf16(y[12], y[13]); o1.w = cvt_pk_bf16(y[14], y[15]);
                *(v4u*)(OBN + (size_t)m * 1024 + c0) = o0; *(v4u*)(OBN + (size_t)m * 1024 + c0 + 8) = o1;
            }
            if (!more) break;
            R = Rn; m = mn;
        }
    }
    const bf16* KA = WSP(bf16, WS_KA); const bf16* VA = WSP(bf16, WS_VA);
    p3_kvout(KA, VA, F.out + OUT_KVP1, 0, 128, 8, 0, TSEQ, TSEQ - 128, 0, 128, gt, ngt);
    p3_kvout(KA, VA, F.out + OUT_KVP2, 1, 512, 8, 0, TSEQ, TSEQ - 512, 0, 512, gt, ngt);
    p3_kvout(KA, VA, F.out + OUT_KVP3, 2, 2048, 8, 0, TSEQ, TSEQ - 2048, 0, 2048, gt, ngt);
    p3_kvout(KA, VA, F.out + OUT_KVS1, 0, 4, 32, NP, 4, 0, 124, 128, gt, ngt);
    p3_kvout(KA, VA, F.out + OUT_KVS2, 1, 4, 32, NP, 4, 0, 508, 512, gt, ngt);
    p3_kvout(KA, VA, F.out + OUT_KVS3, 2, 4, 32, NP, 4, 0, 2044, 2048, gt, ngt);
}

__device__ __forceinline__ void p6_ln1(Frame& F) {
    const int gw = blockIdx.x * NWAVES + F.wave, NGW = F.G * NWAVES, lane = F.lane;
    float* H = WSP(float, WS_H); const bf16* HB = WSP(bf16, WS_HB); bf16* X1B = WSP(bf16, WS_X1B); const float* l1g = inptr(F, I_L1G); const float* l1b = inptr(F, I_L1B);
    f32x4 gg[4], bb[4];
#pragma unroll
    for (int j = 0; j < 4; ++j) { gg[j] = ((const f32x4*)l1g)[lane + 64 * j]; bb[j] = ((const f32x4*)l1b)[lane + 64 * j]; }
    int m = gw; if (m >= MPAD) return;
    f32x4 v[4], vn[4];
#pragma unroll
    for (int j = 0; j < 4; ++j) { const v2u t = ((const v2u*)(HB + (size_t)m * 1024) + lane)[64 * j]; v[j] = (f32x4){bf_lo(t.x), bf_hi(t.x), bf_lo(t.y), bf_hi(t.y)}; }
    for (;;) {
        const int mn = m + NGW; const bool more = mn < MPAD;
        if (more) {
#pragma unroll
            for (int j = 0; j < 4; ++j) { const v2u t = ((const v2u*)(HB + (size_t)mn * 1024) + lane)[64 * j]; vn[j] = (f32x4){bf_lo(t.x), bf_hi(t.x), bf_lo(t.y), bf_hi(t.y)}; } }
        float s = 0.f;
#pragma unroll
        for (int j = 0; j < 4; ++j) s += (v[j][0] + v[j][1]) + (v[j][2] + v[j][3]);
        const float mean = wave_sum(s) * (1.f / 1024.f); float s2 = 0.f;
#pragma unroll
        for (int j = 0; j < 4; ++j) { v[j] = v[j] - mean; s2 += (v[j][0] * v[j][0] + v[j][1] * v[j][1]) + (v[j][2] * v[j][2] + v[j][3] * v[j][3]); }
        const float rstd = 1.f / sqrtf(wave_sum(s2) * (1.f / 1024.f) + LN_EPS);
        f32x4* hr = (f32x4*)(H + (size_t)m * 1024) + lane;
        unsigned long long* o8 = (unsigned long long*)(X1B + (size_t)m * 1024) + lane;
#pragma unroll
        for (int j = 0; j < 4; ++j) { const f32x4 y = v[j] * rstd * gg[j] + bb[j]; hr[64 * j] = y;
            o8[64 * j] = (unsigned long long)cvt_pk_bf16(y[0], y[1]) | ((unsigned long long)cvt_pk_bf16(y[2], y[3]) << 32); }
        if (!more) break;
#pragma unroll
        for (int j = 0; j < 4; ++j) v[j] = vn[j];
        m = mn;
    }
}

__device__ __forceinline__ unsigned mono_key(float f) { const unsigned u = __float_as_uint(f); return u ^ ((unsigned)((int)u >> 31) | 0x80000000u); }
__device__ __forceinline__ float mono_inv(unsigned k) { return __uint_as_float((k & 0x80000000u) ? (k ^ 0x80000000u) : ~k); }
#define CE_DESC(a, b) do { const unsigned _mx = (a) > (b) ? (a) : (b), _mn = (a) > (b) ? (b) : (a); (a) = _mx; (b) = _mn; } while (0)
template <int J> __device__ __forceinline__ void bitonic_step_desc(unsigned (&v)[16]) {
#pragma unroll
    for (int i = 0; i < 16; ++i) if ((i & J) == 0) CE_DESC(v[i], v[i | J]);
}
template <int K, int J> __device__ __forceinline__ void bitonic_step(unsigned (&v)[16]) {
#pragma unroll
    for (int i = 0; i < 16; ++i) if ((i & J) == 0) { if ((i & K) == 0) CE_DESC(v[i], v[i | J]); else CE_DESC(v[i | J], v[i]); }
}
__device__ __forceinline__ void sort16_desc(unsigned (&v)[16]) {
    bitonic_step<2, 1>(v);
    bitonic_step<4, 2>(v); bitonic_step<4, 1>(v);
    bitonic_step<8, 4>(v); bitonic_step<8, 2>(v); bitonic_step<8, 1>(v);
    bitonic_step_desc<8>(v); bitonic_step_desc<4>(v); bitonic_step_desc<2>(v); bitonic_step_desc<1>(v);
}
__device__ __forceinline__ void merge16_desc(unsigned (&T)[16], const unsigned (&N)[16]) {
#pragma unroll
    for (int k = 0; k < 16; ++k) T[k] = T[k] > N[15 - k] ? T[k] : N[15 - k];
    bitonic_step_desc<8>(T); bitonic_step_desc<4>(T); bitonic_step_desc<2>(T); bitonic_step_desc<1>(T);
}
__device__ __forceinline__ void merge_partner16(unsigned (&T)[16]) {
    unsigned P[16];
#pragma unroll
    for (int k = 0; k < 16; ++k) P[k] = (unsigned)__shfl_xor((int)T[k], 32);
    merge16_desc(T, P);
}
__device__ __forceinline__ void p8_topk_item(Frame& F, int item) {
    const int lane = F.lane, hh = lane >> 5, il = lane & 31;
    const int tb = item >> 3, hd = item & 7; const int row = 32 * tb + il;
    const bf16* QN = WSP(bf16, WS_QN); const bf16* KEYS = WSP(bf16, WS_KEYS); int* EIDX = WSP(int, WS_EIDX); float* GATE = WSP(float, WS_GATE);
    LAS unsigned* LK = (LAS unsigned*)(F.lds + F.wave * 8192);
    unsigned T1[16], T2[16];
    bf16x8 bqh[2][8], kf[8];
#pragma unroll
    for (int half = 0; half < 2; ++half)
#pragma unroll
        for (int s = 0; s < 8; ++s) bqh[half][s] = *(const bf16x8*)(QN + (size_t)row * 2048 + hd * 256 + half * 128 + 16 * s + 8 * hh);
#pragma unroll
    for (int s = 0; s < 8; ++s) kf[s] = *(const bf16x8*)(KEYS + ((size_t)(hd * 2) * 128 + il) * 128 + 8 * hh + 16 * s);
#pragma unroll
    for (int half = 0; half < 2; ++half) {
        const bf16x8 (&bq)[8] = bqh[half];
        unsigned T[16];
#pragma unroll
        for (int k = 0; k < 16; ++k) T[k] = 0u;
        const bf16* kbase = KEYS + ((size_t)(hd * 2 + half) * 128 + il) * 128 + 8 * hh;
#pragma unroll 1
        for (int kt = 0; kt < 4; ++kt) {
            f32x16 acc;
#pragma unroll
            for (int x = 0; x < 16; ++x) acc[x] = 0.f;
#pragma unroll
            for (int s = 0; s < 8; ++s) acc = MFMA32(kf[s], bq[s], acc);
            if (kt < 3 || half == 0) {
                const bf16* kn = kt < 3 ? kbase + (size_t)(32 * (kt + 1)) * 128 : kbase + (size_t)128 * 128;
#pragma unroll
                for (int s = 0; s < 8; ++s) kf[s] = *(const bf16x8*)(kn + 16 * s); }
            unsigned N[16];
#pragma unroll
            for (int x = 0; x < 16; ++x) { const int idx = 32 * kt + crow(x, hh); N[x] = (mono_key(acc[x]) & ~127u) | (unsigned)(127 - idx); }
            sort16_desc(N);
            merge16_desc(T, N);
        }
        merge_partner16(T);
#pragma unroll
        for (int k = 0; k < 16; ++k) { LK[(half * 16 + k) * 64 + lane] = T[k]; if (half == 0) T1[k] = T[k]; else T2[k] = T[k]; }
    }
    float v1s[8], v2[16];
#pragma unroll
    for (int k = 0; k < 16; ++k) v2[k] = mono_inv(T2[k] & ~127u);
#pragma unroll
    for (int i2 = 0; i2 < 8; ++i2) v1s[i2] = mono_inv((hh ? T1[2 * i2 + 1] : T1[2 * i2]) & ~127u);
    unsigned C[16], D[16];
#pragma unroll
    for (int k = 0; k < 16; ++k) { C[k] = 0u; D[k] = 0u; }
    {   int n = 0;
#pragma unroll
        for (int i2 = 0; i2 < 8; ++i2)
#pragma unroll
            for (int c = 0; c < 16; ++c) if ((2 * i2 + 1) * (c + 1) <= 16) { const unsigned key = (mono_key(v1s[i2] + v2[c]) & ~255u) | (unsigned)(255 - (16 * (2 * i2 + hh) + c));
                if (n < 16) C[n] = key; else D[n - 16] = key; ++n; }
    }
    sort16_desc(C); sort16_desc(D); merge16_desc(C, D);
    merge_partner16(C);
    LDS_WAIT(); asm volatile("" ::: "memory");
    float sv[16]; int ex[16]; float mx = NEG_BIG;
#pragma unroll
    for (int k = 0; k < 16; ++k) { const int si = 255 - (int)(C[k] & 255u), a = si >> 4, c = si & 15;
        const unsigned k1 = LK[a * 64 + lane], k2 = LK[(16 + c) * 64 + lane];
        ex[k] = (127 - (int)(k1 & 127u)) * 128 + (127 - (int)(k2 & 127u)); sv[k] = mono_inv(k1 & ~127u) + mono_inv(k2 & ~127u); mx = fmaxf(mx, sv[k]); }
    float den = 0.f;
#pragma unroll
    for (int k = 0; k < 16; ++k) { sv[k] = __expf(sv[k] - mx); den += sv[k]; }
    const float iden = 1.0f / den;
    if (hh == 0 && row < NTOK) {
#pragma unroll
        for (int k4 = 0; k4 < 4; ++k4) { *(int4*)(EIDX + (size_t)row * 128 + hd * 16 + 4 * k4) = make_int4(ex[4 * k4], ex[4 * k4 + 1], ex[4 * k4 + 2], ex[4 * k4 + 3]);
            *(f32x4*)(GATE + (size_t)row * 128 + hd * 16 + 4 * k4) = (f32x4){sv[4 * k4] * iden, sv[4 * k4 + 1] * iden, sv[4 * k4 + 2] * iden, sv[4 * k4 + 3] * iden}; } }
    LDS_WAIT(); asm volatile("" ::: "memory");
}

constexpr size_t WS_ACTP = WS_QB, WS_COEF = WS_KA, WS_PEERO = WS_RB, WS_X1H = WS_VA;
static_assert(WS_ACTP + (size_t)8 * NTOK * 128 * 4 <= WS_RB && WS_PEERO + (size_t)NTOK * 1024 * 4 <= WS_GB, "peer buffers");
__device__ __forceinline__ float gelu_erf(float x) { return 0.5f * x * (1.0f + erff(x * 0.70710678118654752f)); }
#define DPP_F(x, ctrl) __uint_as_float((unsigned)__builtin_amdgcn_mov_dpp((int)__float_as_uint(x), (ctrl), 0xf, 0xf, true))
__device__ __forceinline__ float dot16_fp8(const float (&x)[16], const v4u u) {
    float a = 0.f;
#pragma unroll
    for (int q = 0; q < 4; ++q) { const f32x2_t lo = __builtin_amdgcn_cvt_pk_f32_fp8((int)u[q], false), hi = __builtin_amdgcn_cvt_pk_f32_fp8((int)u[q], true);
        a += x[4 * q] * lo.x + x[4 * q + 1] * lo.y + x[4 * q + 2] * hi.x + x[4 * q + 3] * hi.y; }
    return a;
}
typedef float f32x4_t __attribute__((ext_vector_type(4)));
typedef int i32x4_t __attribute__((ext_vector_type(4)));
#ifndef PEER_CVT_VIA_F32
#define PEER_CVT_VIA_F32 0
#endif
#ifndef PEER_DOT_F32
#define PEER_DOT_F32 0
#endif
#if PEER_DOT_F32
#define PEER_DOT2(d, a, b) do { const h2_t a__ = (a), b__ = (b); d += (float)a__.x * (float)b__.x + (float)a__.y * (float)b__.y; } while (0)
#else
#define PEER_DOT2(d, a, b) d = __builtin_amdgcn_fdot2((a), (b), d, false)
#endif
template <bool HI> __device__ __forceinline__ h2_t fp8x2_to_h2(int w) {
#if PEER_CVT_VIA_F32
    const f32x2_t f = __builtin_amdgcn_cvt_pk_f32_fp8(w, HI); return (h2_t){(_Float16)f.x, (_Float16)f.y};
#else
    return __builtin_amdgcn_cvt_scalef32_pk_f16_fp8(w, 1.0f, HI);
#endif
}
template <unsigned EMASK> __device__ __forceinline__ void peer_u_phase_t(Frame& F) {
    const int lane = F.lane, p = lane >> 3, q = lane & 7, c = blockIdx.x & 7, wv = (blockIdx.x >> 3) * NWAVES + F.wave, nwv = (F.G >> 3) * NWAVES;
    const int* EIDX = WSP(int, WS_EIDX) + 16 * p; float* ACTP = WSP(float, WS_ACTP) + (size_t)c * NTOK * 128 + 16 * p + 2 * q;
    const unsigned char* U8 = WSP(unsigned char, WS_UT) + ((size_t)c * 16384 << 7) + 16 * q;
#define PU_LOADE(EV, M) do { _Pragma("unroll") for (int t_ = 0; t_ < 4; ++t_) EV[t_] = *(const i32x4_t*)(EIDX + (size_t)(M) * 128 + 4 * t_); } while (0)
#define PU_ISSUE(UR, EV) do { _Pragma("unroll") for (int g = 0; g < 16; ++g) UR[g] = *(const v4u*)(U8 + (((unsigned)EV[g >> 2][g & 3] & EMASK) << 7)); } while (0)
#define PU_BODY(UR, UN, M) do { const int m_ = (M); const int m1_ = m_ + nwv, m2_ = m_ + 2 * nwv; \
        if (m1_ < NTOK) PU_ISSUE(UN, ev); \
        if (m2_ < NTOK) PU_LOADE(ev, m2_); \
        const float* xf_ = (const float*)(F.ws + WS_H) + (size_t)m_ * 1024 + 128 * c + 16 * q; \
        const f32x4 xa_ = *(const f32x4*)xf_, xb_ = *(const f32x4*)(xf_ + 4), xc_ = *(const f32x4*)(xf_ + 8), xd_ = *(const f32x4*)(xf_ + 12); \
        const h2_t xh[8] = {(h2_t){(_Float16)xa_[0], (_Float16)xa_[1]}, (h2_t){(_Float16)xa_[2], (_Float16)xa_[3]}, (h2_t){(_Float16)xb_[0], (_Float16)xb_[1]}, (h2_t){(_Float16)xb_[2], (_Float16)xb_[3]}, (h2_t){(_Float16)xc_[0], (_Float16)xc_[1]}, (h2_t){(_Float16)xc_[2], (_Float16)xc_[3]}, (h2_t){(_Float16)xd_[0], (_Float16)xd_[1]}, (h2_t){(_Float16)xd_[2], (_Float16)xd_[3]}}; \
        float a[16]; \
        _Pragma("unroll") for (int g = 0; g < 16; ++g) { float d_ = 0.f; \
            _Pragma("unroll") for (int t_ = 0; t_ < 4; ++t_) { PEER_DOT2(d_, fp8x2_to_h2<false>((int)UR[g][t_]), xh[2 * t_]); PEER_DOT2(d_, fp8x2_to_h2<true>((int)UR[g][t_]), xh[2 * t_ + 1]); } \
            a[g] = d_; if ((g & 1) == 1 && g < 15) asm volatile("" : "+v"(a[g - 1]), "+v"(a[g]), "+v"(UR[(g + 1) & 15]), "+v"(UR[(g + 2) & 15])); } \
        float b8[8], b4[4], b2[2]; \
        { const bool up = (q & 4) != 0; _Pragma("unroll") for (int k = 0; k < 8; ++k) { const float send = up ? a[k] : a[k + 8], keep = up ? a[k + 8] : a[k]; b8[k] = keep + DPP_F(send, 0x141); } } \
        { const bool up = (q & 2) != 0; _Pragma("unroll") for (int k = 0; k < 4; ++k) { const float send = up ? b8[k] : b8[k + 4], keep = up ? b8[k + 4] : b8[k]; b4[k] = keep + DPP_F(send, 0x4E); } } \
        { const bool up = (q & 1) != 0; _Pragma("unroll") for (int k = 0; k < 2; ++k) { const float send = up ? b4[k] : b4[k + 2], keep = up ? b4[k + 2] : b4[k]; b2[k] = keep + DPP_F(send, 0xB1); } } \
        *(f32x2_t*)(ACTP + (size_t)m_ * 128) = (f32x2_t){b2[0], b2[1]}; } while (0)
    int m = wv; if (m >= NTOK) return;
    i32x4_t ev[4];
    PU_LOADE(ev, m);
    v4u ua[16], ub[16];
    PU_ISSUE(ua, ev);
    if (m + nwv < NTOK) PU_LOADE(ev, m + nwv);
    for (;;) {
        PU_BODY(ua, ub, m); m += nwv; if (m >= NTOK) break;
        PU_BODY(ub, ua, m); m += nwv; if (m >= NTOK) break;
    }
#undef PU_LOADE
#undef PU_ISSUE
#undef PU_BODY
}
__device__ __forceinline__ void peer_u_phase(Frame& F) { peer_u_phase_t<0xffffffffu>(F); }
__device__ __forceinline__ void peer_coef_phase(Frame& F) {
    const int gw = blockIdx.x * NWAVES + F.wave, NGW = F.G * NWAVES, lane = F.lane;
    const float* ACTP = WSP(float, WS_ACTP); const float* GATE = WSP(float, WS_GATE); float* COEF = WSP(float, WS_COEF);
    int m = gw; if (m >= NTOK) return;
    float av[2][8], gv[2], an[2][8], gnx[2];
#pragma unroll
    for (int hf = 0; hf < 2; ++hf) { const int k = lane + 64 * hf; gv[hf] = GATE[(size_t)m * 128 + k];
#pragma unroll
        for (int c = 0; c < 8; ++c) av[hf][c] = ACTP[((size_t)c * NTOK + m) * 128 + k]; }
    for (;;) {
        const int mn = m + NGW; const bool more = mn < NTOK;
        if (more) {
#pragma unroll
            for (int hf = 0; hf < 2; ++hf) { const int k = lane + 64 * hf; gnx[hf] = GATE[(size_t)mn * 128 + k];
#pragma unroll
                for (int c = 0; c < 8; ++c) an[hf][c] = ACTP[((size_t)c * NTOK + mn) * 128 + k]; } }
#pragma unroll
        for (int hf = 0; hf < 2; ++hf) { const int k = lane + 64 * hf; float a = 0.f;
#pragma unroll
            for (int c = 0; c < 8; ++c) a += av[hf][c];
            COEF[(size_t)m * 128 + k] = gv[hf] * gelu_erf(a * (1.0f / U_SCALE)); }
        if (!more) break;
#pragma unroll
        for (int hf = 0; hf < 2; ++hf) { gv[hf] = gnx[hf];
#pragma unroll
            for (int c = 0; c < 8; ++c) av[hf][c] = an[hf][c]; }
        m = mn;
    }
}
__device__ __forceinline__ void peer_v_phase(Frame& F) {
    const int lane = F.lane, p = lane >> 3, q = lane & 7, c = blockIdx.x & 7, wv = (blockIdx.x >> 3) * NWAVES + F.wave, nwv = (F.G >> 3) * NWAVES;
    const int* EIDX = WSP(int, WS_EIDX) + 16 * p; const float* COEF = WSP(float, WS_COEF) + 16 * p; bf16* PEERO = WSP(bf16, WS_PEERO) + 128 * c + 16 * q + 2 * p;
    const unsigned char* V8 = WSP(unsigned char, WS_VT) + ((size_t)c * 16384 << 7) + 16 * q;
    int m = wv; if (m >= NTOK) return;
    i32x4_t ev[4];
#pragma unroll
    for (int t = 0; t < 4; ++t) ev[t] = *(const i32x4_t*)(EIDX + (size_t)m * 128 + 4 * t);
    v4u vr[16];
#pragma unroll
    for (int g = 0; g < 16; ++g) vr[g] = *(const v4u*)(V8 + ((unsigned)ev[g >> 2][g & 3] << 7));
    for (;;) {
        f32x4_t cv[4];
#pragma unroll
        for (int t = 0; t < 4; ++t) cv[t] = *(const f32x4_t*)(COEF + (size_t)m * 128 + 4 * t);
        const int mn = m + nwv; const bool more = mn < NTOK;
        if (more) {
#pragma unroll
            for (int t = 0; t < 4; ++t) ev[t] = *(const i32x4_t*)(EIDX + (size_t)mn * 128 + 4 * t); }
        h2_t acc[8];
#pragma unroll
        for (int i = 0; i < 8; ++i) acc[i] = (h2_t){(_Float16)0.f, (_Float16)0.f};
#pragma unroll
        for (int g = 0; g < 16; ++g) { const _Float16 cfh = (_Float16)cv[g >> 2][g & 3]; const h2_t cf2 = {cfh, cfh};
#pragma unroll
            for (int t = 0; t < 4; ++t) { acc[2 * t] += fp8x2_to_h2<false>((int)vr[g][t]) * cf2; acc[2 * t + 1] += fp8x2_to_h2<true>((int)vr[g][t]) * cf2; }
            if ((g & 3) == 3 && g < 15) asm volatile("" : "+v"(acc[0]), "+v"(acc[1]), "+v"(acc[2]), "+v"(acc[3]), "+v"(acc[4]), "+v"(acc[5]), "+v"(acc[6]), "+v"(acc[7]), "+v"(vr[(g + 1) & 15]), "+v"(vr[(g + 2) & 15]), "+v"(vr[(g + 3) & 15]), "+v"(vr[(g + 4) & 15])); }
        __builtin_amdgcn_sched_barrier(0);
        if (more) {
#pragma unroll
            for (int g = 0; g < 16; ++g) vr[g] = *(const v4u*)(V8 + ((unsigned)ev[g >> 2][g & 3] << 7)); }
        __builtin_amdgcn_sched_barrier(0);
        unsigned w[8];
#pragma unroll
        for (int i = 0; i < 8; ++i) w[i] = __builtin_bit_cast(unsigned, acc[i]);
        h2_t r4[4], r2[2], r1;
        { const bool up = (lane & 32) != 0;
#pragma unroll
          for (int k = 0; k < 4; ++k) { const unsigned send = up ? w[k] : w[k + 4], keep = up ? w[k + 4] : w[k]; r4[k] = __builtin_bit_cast(h2_t, keep) + __builtin_bit_cast(h2_t, (unsigned)__shfl_xor((int)send, 32)); } }
        { const bool up = (lane & 16) != 0;
#pragma unroll
          for (int k = 0; k < 2; ++k) { const unsigned a_ = __builtin_bit_cast(unsigned, r4[k]), b_ = __builtin_bit_cast(unsigned, r4[k + 2]); const unsigned send = up ? a_ : b_, keep = up ? b_ : a_; r2[k] = __builtin_bit_cast(h2_t, keep) + __builtin_bit_cast(h2_t, (unsigned)__shfl_xor((int)send, 16)); } }
        { const bool up = (lane & 8) != 0; const unsigned a_ = __builtin_bit_cast(unsigned, r2[0]), b_ = __builtin_bit_cast(unsigned, r2[1]); const unsigned send = up ? a_ : b_, keep = up ? b_ : a_;
          r1 = __builtin_bit_cast(h2_t, keep) + __builtin_bit_cast(h2_t, (unsigned)__builtin_amdgcn_mov_dpp((int)send, 0x128, 0xf, 0xf, true)); }
        *(unsigned*)(PEERO + (size_t)m * 1024) = cvt_pk_bf16((float)r1.x * (1.0f / V_SCALE), (float)r1.y * (1.0f / V_SCALE));
        if (!more) break;
        m = mn;
    }
}
__device__ __forceinline__ void peer_ln2_phase(Frame& F) {
    const int gw = blockIdx.x * NWAVES + F.wave, NGW = F.G * NWAVES, lane = F.lane;
    const float* X1 = WSP(float, WS_H); const bf16* PEERO = WSP(bf16, WS_PEERO); const float* l2g = inptr(F, I_L2G); const float* l2b = inptr(F, I_L2B);
    f32x4 gg[4], bb[4];
#pragma unroll
    for (int t = 0; t < 4; ++t) { gg[t] = *(const f32x4*)(l2g + 4 * lane + 256 * t); bb[t] = *(const f32x4*)(l2b + 4 * lane + 256 * t); }
    int m = gw; if (m >= NTOK) return;
    f32x4 xa[4], xn[4]; v2u pa[4], pn[4];
#pragma unroll
    for (int t = 0; t < 4; ++t) { xa[t] = *(const f32x4*)(X1 + (size_t)m * 1024 + 4 * lane + 256 * t); pa[t] = *(const v2u*)(PEERO + (size_t)m * 1024 + 4 * lane + 256 * t); }
    for (;;) {
        const int mn = m + NGW; const bool more = mn < NTOK;
        if (more) {
#pragma unroll
            for (int t = 0; t < 4; ++t) { xn[t] = *(const f32x4*)(X1 + (size_t)mn * 1024 + 4 * lane + 256 * t); pn[t] = *(const v2u*)(PEERO + (size_t)mn * 1024 + 4 * lane + 256 * t); } }
        float acc[16]; float s = 0.f;
#pragma unroll
        for (int t = 0; t < 4; ++t) { const float pz[4] = {bf_lo(pa[t].x), bf_hi(pa[t].x), bf_lo(pa[t].y), bf_hi(pa[t].y)};
#pragma unroll
            for (int i = 0; i < 4; ++i) { acc[4 * t + i] = ALPHA * xa[t][i] + pz[i]; s += acc[4 * t + i]; } }
        const float mean = wave_sum(s) * (1.f / 1024.f); float s2 = 0.f;
#pragma unroll
        for (int i = 0; i < 16; ++i) { acc[i] -= mean; s2 += acc[i] * acc[i]; }
        const float rstd = 1.f / sqrtf(wave_sum(s2) * (1.f / 1024.f) + LN_EPS);
        float* yo = m < NP ? F.out + OUT_YP + (size_t)m * 1024 : F.out + OUT_YS + (size_t)(m - NP) * 1024;
#pragma unroll
        for (int t = 0; t < 4; ++t) { const int cc = 4 * lane + 256 * t;
            *(f32x4*)(yo + cc) = (f32x4){acc[4 * t] * rstd * gg[t][0] + bb[t][0], acc[4 * t + 1] * rstd * gg[t][1] + bb[t][1], acc[4 * t + 2] * rstd * gg[t][2] + bb[t][2], acc[4 * t + 3] * rstd * gg[t][3] + bb[t][3]}; }
        if (!more) break;
#pragma unroll
        for (int t = 0; t < 4; ++t) { xa[t] = xn[t]; pa[t] = pn[t]; }
        m = mn;
    }
}

template <class Epi> __device__ __forceinline__ void skinny_sample_gemm(Frame& F, const bf16* A, const bf16* Bt, int K, const Epi& epi) {
    typedef float f32x4a __attribute__((ext_vector_type(4)));
    const int lane = F.lane, r = lane & 15, kg = lane >> 4;
    for (int strip = blockIdx.x; strip < 64; strip += F.G) {
        const bf16* ap = A + (size_t)(NP + 16 * F.wave + r) * K + 8 * kg;
        const bf16* bp = Bt + (size_t)(16 * strip + r) * K + 8 * kg;
        f32x4a acc = {0.f, 0.f, 0.f, 0.f};
        for (int s0 = 0; s0 < K / 32; s0 += 16) { bf16x8 af[16], bfr[16];
#pragma unroll
            for (int u = 0; u < 16; ++u) { af[u] = *(const bf16x8*)(ap + 32 * (s0 + u)); bfr[u] = *(const bf16x8*)(bp + 32 * (s0 + u)); }
#pragma unroll
            for (int u = 0; u < 16; ++u) acc = __builtin_amdgcn_mfma_f32_16x16x32_bf16(af[u], bfr[u], acc, 0, 0, 0); }
#pragma unroll
        for (int i = 0; i < 4; ++i) epi(NP + 16 * F.wave + 4 * kg + i, 16 * strip + r, acc[i]);
    }
}

struct Args { const float* in[22]; float* out; unsigned char* ws; int ph_lo, ph_hi; };
constexpr int NPHASE = 14;
__global__ void __launch_bounds__(NTHR, 2) mk_fwd(Args args) {
    extern __shared__ __attribute__((aligned(16))) unsigned char lds[];
    Frame F;
    F.lds = (LAS unsigned char*)lds; F.MISC = (volatile LAS unsigned*)(F.lds + MISC_OFF);
    F.tid = threadIdx.x; F.lane = F.tid & 63; F.wave = __builtin_amdgcn_readfirstlane(F.tid >> 6); F.G = gridDim.x;
    F.ws = args.ws; F.out = args.out; F.ctl = (gu32*)(args.ws + WS_CTL); F.tp = 0ull;
    for (int u = F.tid; u < (LDS_BYTES - MISC_OFF) / 4; u += NTHR) ((LAS unsigned*)(F.lds + MISC_OFF))[u] = 0u;
    __syncthreads();
    if (F.tid < 22) ((LAS unsigned long long*)(F.lds + PTR_OFF))[F.tid] = (unsigned long long)args.in[F.tid];
    __syncthreads();
    const int lo = args.ph_lo, hi = args.ph_hi;
    const bool multi = (hi - lo) > 1;
    XcdBarrier bar; bar.bar = (unsigned*)(F.ctl + CW_BAR); bar.x = 0; bar.st = nullptr;
    if (multi) bar = xcd_barrier_post((unsigned*)(F.ctl + CW_BAR), F.MISC + 8);
#ifdef ONLY_PHASE
#define IN(k) ((k) == ONLY_PHASE && lo <= (k) && (k) < hi)
#else
#define IN(k) (lo <= (k) && (k) < hi)
#endif
#ifdef PROBE_PHASE
    unsigned long long t_prev = __builtin_amdgcn_s_memrealtime(), t_probe = 0ull;
#define STAMP(k) do { const unsigned long long _t = __builtin_amdgcn_s_memrealtime(); if ((k) == PROBE_PHASE && blockIdx.x == 0) t_probe = _t - t_prev; t_prev = _t; } while (0)
#else
#define STAMP(k) do { } while (0)
#endif
#define SEAM(k) do { if (IN(k) && IN((k) + 1)) xcd_barrier(bar); STAMP(k); } while (0)
    if (IN(0)) { p0_prologue(F); }
    if (IN(0) && IN(1)) { cooperative_groups::this_grid().sync(); } STAMP(0);
    if (IN(1)) {
        if ((int)blockIdx.x >= F.G - NCOPYWG) kvshift_loop<true>(F);
        else {
        pg8::Gemm g{WSP(bf16, WS_XB), WSP(bf16, WS_WIN), MPAD, NPROJ, 1024, MPAD / 256 - 1}; pg8::StaticOrder S; S.init(MPAD, NPROJ, F.G - NCOPYWG, (int)blockIdx.x);
        pg8::EpiProj E{WSP(bf16, WS_QA), WSP(bf16, WS_KA), WSP(bf16, WS_VA), WSP(bf16, WS_QB), WSP(bf16, WS_KB), WSP(bf16, WS_VB), WSP(bf16, WS_RB), WSP(bf16, WS_GA), WSP(bf16, WS_GB)};
        pg8::gemm_phase<pg8::EpiProj, pg8::StaticOrder, true, true>(F.lds, g, S, E);
        if (F.tid == 0) __hip_atomic_fetch_add(F.ctl + CW_GDONE, 1u, RLX_AGENT);
        }
    } SEAM(1);
    if (IN(2)) { p2_prep(F); } SEAM(2);
    if (IN(3)) { p2_mixers(F); } SEAM(3);
    if (IN(4)) { p3_merge(F); } SEAM(4);
    if (IN(5)) {
        bf16* T1 = WSP(bf16, WS_T1); bf16* MIXp = WSP(bf16, WS_MIX); const bf16* GAp = WSP(bf16, WS_GA); const bf16* GBp = WSP(bf16, WS_GB);
        { pg8::Gemm g{WSP(bf16, WS_OAM), WSP(bf16, WS_WA), NP, 1024, 512, -1}; pg8::StaticOrder S; S.init(NP, 1024, F.G, (int)blockIdx.x, false);
          pg8::EpiGate<false> E{WSP(bf16, WS_GA), nullptr, WSP(bf16, WS_T1)};
          pg8::gemm_phase<pg8::EpiGate<false>, pg8::StaticOrder, true, true>(F.lds, g, S, E); }
        skinny_sample_gemm(F, WSP(bf16, WS_OAM), WSP(bf16, WS_WA), 512, [=](int row, int col, float v) { const size_t o = (size_t)row * 1024 + col; T1[o] = f2bf(pg8::sigmoidf_(bf2f(GAp[o])) * v); });
        VM_WAIT(); __syncthreads();
        { pg8::Gemm g{WSP(bf16, WS_OBN), WSP(bf16, WS_WB), NP, 1024, 1024, -1}; pg8::StaticOrder S; S.init(NP, 1024, F.G, (int)blockIdx.x, false);
          pg8::EpiGate<true> E{WSP(bf16, WS_GB), WSP(bf16, WS_T1), WSP(bf16, WS_MIX)};
          pg8::gemm_phase<pg8::EpiGate<true>, pg8::StaticOrder, true, true>(F.lds, g, S, E); }
        skinny_sample_gemm(F, WSP(bf16, WS_OBN), WSP(bf16, WS_WB), 1024, [=](int row, int col, float v) { const size_t o = (size_t)row * 1024 + col; MIXp[o] = f2bf(bf2f(T1[o]) + pg8::sigmoidf_(bf2f(GBp[o])) * v); });
    } SEAM(5);
    if (IN(6)) {
        pg8::Gemm g{WSP(bf16, WS_MIX), WSP(bf16, WS_WO), NP, 1024, 1024, -1}; pg8::StaticOrder S; S.init(NP, 1024, F.G, (int)blockIdx.x, false);
        pg8::EpiOut E{WSP(bf16, WS_XB), WSP(bf16, WS_HB), ALPHA};
        pg8::gemm_phase<pg8::EpiOut, pg8::StaticOrder, true, true>(F.lds, g, S, E);
        const bf16* xbp = WSP(bf16, WS_XB); bf16* Hp = WSP(bf16, WS_HB);
        skinny_sample_gemm(F, WSP(bf16, WS_MIX), WSP(bf16, WS_WO), 1024, [=](int row, int col, float v) { const size_t o = (size_t)row * 1024 + col; Hp[o] = f2bf(ALPHA * bf2f(xbp[o]) + v); });
    } SEAM(6);
    if (IN(7)) { p6_ln1(F); } SEAM(7);
    if (IN(8)) {
        pg8::Gemm g{WSP(bf16, WS_X1B), WSP(bf16, WS_WQ), MPAD, 2048, 1024, MPAD / 256 - 1}; pg8::StaticOrder S; S.init(MPAD, 2048, F.G, (int)blockIdx.x);
        pg8::EpiHeadNorm E{WSP(bf16, WS_QN), 2048, F.lds + STATS_OFF, LN_EPS};
        pg8::gemm_phase<pg8::EpiHeadNorm, pg8::StaticOrder, true, true>(F.lds, g, S, E);
    } SEAM(8);
    if (IN(9)) {
        const int gw = blockIdx.x * NWAVES + F.wave, NGW = F.G * NWAVES;
        for (int it = gw; it < (NP / 32) * 8; it += NGW) p8_topk_item(F, it);
        for (int e = gw; e < 64 * (NS / 32) * 8; e += NGW) if ((e & 63) == 0) p8_topk_item(F, (NP / 32) * 8 + (e >> 6));
    } SEAM(9);
#if defined(PROBE_PHASE) && PROBE_PHASE >= 300 && PROBE_PHASE < 310
    if (IN(10)) { const unsigned long long td0 = __builtin_amdgcn_s_memrealtime();
        if (PROBE_PHASE == 300) peer_u_phase_t<2047u>(F); else if (PROBE_PHASE == 301) peer_u_phase_t<8191u>(F); else peer_u_phase_t<0xffffffffu>(F);
        xcd_barrier(bar); if (blockIdx.x == 0) F.tp = __builtin_amdgcn_s_memrealtime() - td0; }
#endif
    if (IN(10)) { peer_u_phase(F); } SEAM(10);
    if (IN(11)) { peer_coef_phase(F); } SEAM(11);
    if (IN(12)) { peer_v_phase(F); } SEAM(12);
    if (IN(13)) { peer_ln2_phase(F); }
#ifdef PROBE_PHASE
    if (PROBE_PHASE == 13) { xcd_barrier(bar); STAMP(13); }
    if (PROBE_PHASE == 200 || PROBE_PHASE == 201) {
        unsigned* xm = (unsigned*)(F.ws + WS_END);
        if (F.tid == 0) __hip_atomic_store(xm + blockIdx.x, xb_xcc_id() + 1u, RLX_AGENT);
        xcd_barrier(bar);
        if (blockIdx.x == 0 && F.tid == 0) { bool ok = true;
            for (int b = 0; b < (int)gridDim.x; ++b) { const unsigned a = __hip_atomic_load(xm + b, RLX_AGENT), r = __hip_atomic_load(xm + (PROBE_PHASE == 200 ? (b & 7) : (b & ~31)), RLX_AGENT); if (a != r) ok = false; }
            t_probe = ok ? 50000ull : 0ull; }
    }
    if ((PROBE_PHASE >= 100 && PROBE_PHASE < 200) || PROBE_PHASE >= 300) t_probe = F.tp;
    if (F.tid == 0 && t_probe != 0ull) { const unsigned long long t0 = __builtin_amdgcn_s_memrealtime(); while (__builtin_amdgcn_s_memrealtime() - t0 < PROBE_GAIN * t_probe) __builtin_amdgcn_s_sleep(8); }
#endif
#undef IN
#undef SEAM
}

extern "C" void kernel_launch(void* const* d_in, const int* in_sizes, int n_in, void* d_out, int out_size, void* d_ws, size_t ws_size, hipStream_t stream) {
    static int grid = 0;
    if (grid == 0) {
        if (n_in != 22 || (size_t)out_size != OUT_TOTAL || ws_size < WS_END) { fprintf(stderr, "kernel_launch: unexpected shapes: n_in %d out %d ws %zu (need >= %zu)\n", n_in, out_size, ws_size, (size_t)WS_END); grid = -1; return; }
        int dev = 0, cus = 0, per_cu = 0;
        if (hipGetDevice(&dev) != hipSuccess || hipDeviceGetAttribute(&cus, hipDeviceAttributeMultiprocessorCount, dev) != hipSuccess) { grid = -1; return; }
        if (hipFuncSetAttribute((const void*)mk_fwd, hipFuncAttributeMaxDynamicSharedMemorySize, LDS_BYTES) != hipSuccess) { fprintf(stderr, "kernel_launch: hipFuncSetAttribute failed\n"); grid = -1; return; }
        if (hipOccupancyMaxActiveBlocksPerMultiprocessor(&per_cu, (const void*)mk_fwd, NTHR, LDS_BYTES) != hipSuccess || per_cu < 1) fprintf(stderr, "kernel_launch: occupancy query reports %d blocks per CU\n", per_cu);
        (void)hipGetLastError();
        grid = cus;
    }
    if (grid < 0) return;
    (void)hipMemsetAsync((char*)d_ws + WS_CTL, 0, CTL_ZERO_BYTES, stream);
    Args a{};
    for (int i = 0; i < 22; ++i) a.in[i] = (const float*)d_in[i];
    a.out = (float*)d_out; a.ws = (unsigned char*)d_ws;
#if MK_SINGLE
    a.ph_lo = 0; a.ph_hi = NPHASE;
    void* kargs[] = {&a};
    hipError_t e = hipLaunchCooperativeKernel((const void*)mk_fwd, dim3(grid), dim3(NTHR), kargs, LDS_BYTES, stream);
    if (e != hipSuccess) fprintf(stderr, "kernel_launch: cooperative launch failed: %s\n", hipGetErrorString(e));
#else
    for (int p = 0; p < NPHASE; ++p) { a.ph_lo = p; a.ph_hi = p + 1; hipLaunchKernelGGL(mk_fwd, dim3(grid), dim3(NTHR), LDS_BYTES, stream, a); }
#endif
}
```

```cpp
#include <hip/hip_runtime.h>
#include <hip/hip_cooperative_groups.h>
#include <cstdio>
#include <cstdint>
#ifndef MK_SINGLE
#define MK_SINGLE 1
#endif
namespace pg8 {
#define PG8_LAS __attribute__((address_space(3)))
typedef unsigned short bf16_t;
typedef short bf16x8 __attribute__((ext_vector_type(8)));
typedef float f32x4 __attribute__((ext_vector_type(4)));
typedef unsigned u32x4 __attribute__((ext_vector_type(4)));
constexpr int BM = 256, BK = 64, HALF = 128, HTB = HALF * BK * 2  , STAGE_BYTES = 8 * HTB, NXCD = 8, WGM = 8;

__host__ __device__ __forceinline__ int lds_byte(int r, int c) { const int st = (r >> 4) * 2 + (c >> 5), rr = r & 15, cc = c & 31, ob = rr * 64 + cc * 2; return st * 1024 + (ob ^ (((ob >> 9) & 1) << 5)); }
__host__ __device__ __forceinline__ void stage_rc(int b, int& R, int& C) { const int st = b / 1024, sb = b % 1024, swz = sb ^ (((sb >> 9) & 1) << 5); R = (st >> 1) * 16 + swz / 64; C = (st & 1) * 32 + (swz % 64) / 2; }
__host__ __device__ __forceinline__ int perm32(int rho) { const int n = rho >> 4, i = rho & 15; return 8 * (i >> 2) + 4 * n + (i & 3); }

struct Unit { int pm, pn; };
struct Gemm { const bf16_t* A; const bf16_t* Bt; int M, N, K; int half_pm = -1; };

struct StaticOrder {
    int nM, nN, nwg, G, c, nfull;
    __host__ __device__ void init(int M, int N, int G_, int c_, bool half = true) { nM = half ? M / BM - 1 : M / BM; nN = N / BM; nfull = nM * nN; nwg = half ? nfull + nN : nfull; G = G_; c = c_; }
    __host__ __device__ bool next(int i, Unit& u) const {
        const long L = (long)i * G + c; if (L >= nwg) return false;
        if (L >= nfull) { u.pm = nM; u.pn = (int)(L - nfull); return true; }
        int wgid = (int)L; { const int q = nfull / NXCD, r = nfull % NXCD, xcd = wgid % NXCD, off = wgid / NXCD; wgid = (xcd < r ? xcd * (q + 1) : r * (q + 1) + (xcd - r) * q) + off; }
        const int nig = WGM * nN, gid = wgid / nig, fm = gid * WGM, gsz = (nM - fm) < WGM ? (nM - fm) : WGM;
        u.pm = fm + ((wgid % nig) % gsz); u.pn = (wgid % nig) / gsz; return true;
    }
    __device__ __forceinline__ void a_ready(const Unit&) const {}
    __device__ __forceinline__ void done(const Unit&) const {}
};


typedef float f32x2 __attribute__((ext_vector_type(2)));
typedef __bf16 bf16x2_t __attribute__((ext_vector_type(2)));
__device__ __forceinline__ unsigned cvt_pk_bf16(float lo, float hi) { f32x2 v = {lo, hi}; bf16x2_t b = __builtin_convertvector(v, bf16x2_t); return __builtin_bit_cast(unsigned, b); }
__device__ __forceinline__ float bf_lo(unsigned w) { return __uint_as_float(w << 16); }
__device__ __forceinline__ float bf_hi(unsigned w) { return __uint_as_float(w & 0xffff0000u); }
__device__ __forceinline__ float sigmoidf_(float x) { return __builtin_amdgcn_rcpf(1.0f + __expf(-x)); }

struct EpiProj {
    static constexpr bool PERM = true, AFTER_DRAIN = false;
    bf16_t *qa, *ka, *va, *qb, *kb, *vb, *rb, *ga, *gb;
    __device__ __forceinline__ void operator()(const f32x4 (&acc)[2][2][4][2], const Unit& u, int wr, int wc, int fr, int fq) const {
        const int pn = u.pn; bf16_t* base; int ldc, ct; float sc = 1.f;
        if (pn < 6) { base = qa; ldc = 1536; ct = pn; sc = 0.125f; }
        else if (pn < 12) { base = ka; ldc = 1536; ct = pn - 6; }
        else if (pn < 18) { base = va; ldc = 1536; ct = pn - 12; }
        else if (pn < 20) { base = qb; ldc = 512; ct = pn - 18; }
        else if (pn < 22) { base = kb; ldc = 512; ct = pn - 20; }
        else if (pn < 26) { base = vb; ldc = 1024; ct = pn - 22; }
        else if (pn < 30) { base = rb; ldc = 1024; ct = pn - 26; }
        else if (pn < 34) { base = ga; ldc = 1024; ct = pn - 30; }
        else { base = gb; ldc = 1024; ct = pn - 34; }
        const int row0 = u.pm * BM + wr * 64 + fr, col0 = ct * BM + wc * 32 + 8 * fq;
#pragma unroll
        for (int ai = 0; ai < 2; ++ai)
#pragma unroll
            for (int m = 0; m < 4; ++m) { bf16_t* rowp = base + (size_t)(row0 + ai * HALF + m * 16) * ldc + col0;
#pragma unroll
                for (int bj = 0; bj < 2; ++bj) { const f32x4 v0 = acc[ai][bj][m][0] * sc, v1 = acc[ai][bj][m][1] * sc;
                    u32x4 w; w.x = cvt_pk_bf16(v0[0], v0[1]); w.y = cvt_pk_bf16(v0[2], v0[3]); w.z = cvt_pk_bf16(v1[0], v1[1]); w.w = cvt_pk_bf16(v1[2], v1[3]);
                    *(u32x4*)(rowp + bj * HALF) = w; } }
    }
};
template <bool ADD> struct EpiGate {
    static constexpr bool PERM = true, AFTER_DRAIN = false;
    const bf16_t* G; const bf16_t* T1; bf16_t* O;
    __device__ __forceinline__ void operator()(const f32x4 (&acc)[2][2][4][2], const Unit& u, int wr, int wc, int fr, int fq) const {
        const int row0 = u.pm * BM + wr * 64 + fr, col0 = u.pn * BM + wc * 32 + 8 * fq;
#pragma unroll
        for (int ai = 0; ai < 2; ++ai) {
            u32x4 gq[4][2], tq[4][2];
#pragma unroll
            for (int m = 0; m < 4; ++m) { const size_t off = (size_t)(row0 + ai * HALF + m * 16) * 1024 + col0;
#pragma unroll
                for (int bj = 0; bj < 2; ++bj) { gq[m][bj] = *(const u32x4*)(G + off + bj * HALF); if (ADD) tq[m][bj] = *(const u32x4*)(T1 + off + bj * HALF); } }
#pragma unroll
            for (int m = 0; m < 4; ++m) { const size_t off = (size_t)(row0 + ai * HALF + m * 16) * 1024 + col0;
#pragma unroll
                for (int bj = 0; bj < 2; ++bj) {
                    const u32x4 g = gq[m][bj];
                    f32x4 v0 = acc[ai][bj][m][0], v1 = acc[ai][bj][m][1];
                    v0[0] *= sigmoidf_(bf_lo(g.x)); v0[1] *= sigmoidf_(bf_hi(g.x)); v0[2] *= sigmoidf_(bf_lo(g.y)); v0[3] *= sigmoidf_(bf_hi(g.y));
                    v1[0] *= sigmoidf_(bf_lo(g.z)); v1[1] *= sigmoidf_(bf_hi(g.z)); v1[2] *= sigmoidf_(bf_lo(g.w)); v1[3] *= sigmoidf_(bf_hi(g.w));
                    if (ADD) { const u32x4 t = tq[m][bj];
                        v0[0] += bf_lo(t.x); v0[1] += bf_hi(t.x); v0[2] += bf_lo(t.y); v0[3] += bf_hi(t.y);
                        v1[0] += bf_lo(t.z); v1[1] += bf_hi(t.z); v1[2] += bf_lo(t.w); v1[3] += bf_hi(t.w); }
                    u32x4 w; w.x = cvt_pk_bf16(v0[0], v0[1]); w.y = cvt_pk_bf16(v0[2], v0[3]); w.z = cvt_pk_bf16(v1[0], v1[1]); w.w = cvt_pk_bf16(v1[2], v1[3]);
                    *(u32x4*)(O + off + bj * HALF) = w; } } }
    }
};
struct EpiOut {
    static constexpr bool PERM = true, AFTER_DRAIN = false;
    const bf16_t* xb; bf16_t* HB; float alpha;
    __device__ __forceinline__ void operator()(const f32x4 (&acc)[2][2][4][2], const Unit& u, int wr, int wc, int fr, int fq) const {
        const int row0 = u.pm * BM + wr * 64 + fr, col0 = u.pn * BM + wc * 32 + 8 * fq;
#pragma unroll
        for (int ai = 0; ai < 2; ++ai) {
            u32x4 xq[4][2];
#pragma unroll
            for (int m = 0; m < 4; ++m) { const size_t off = (size_t)(row0 + ai * HALF + m * 16) * 1024 + col0;
#pragma unroll
                for (int bj = 0; bj < 2; ++bj) xq[m][bj] = *(const u32x4*)(xb + off + bj * HALF); }
#pragma unroll
            for (int m = 0; m < 4; ++m) { const size_t off = (size_t)(row0 + ai * HALF + m * 16) * 1024 + col0;
#pragma unroll
                for (int bj = 0; bj < 2; ++bj) { const u32x4 t = xq[m][bj]; const f32x4 a0 = acc[ai][bj][m][0], a1 = acc[ai][bj][m][1];
                    u32x4 w; w.x = cvt_pk_bf16(alpha * bf_lo(t.x) + a0[0], alpha * bf_hi(t.x) + a0[1]); w.y = cvt_pk_bf16(alpha * bf_lo(t.y) + a0[2], alpha * bf_hi(t.y) + a0[3]);
                    w.z = cvt_pk_bf16(alpha * bf_lo(t.z) + a1[0], alpha * bf_hi(t.z) + a1[1]); w.w = cvt_pk_bf16(alpha * bf_lo(t.w) + a1[2], alpha * bf_hi(t.w) + a1[3]);
                    *(u32x4*)(HB + off + bj * HALF) = w; } }
        }
    }
};
struct EpiHeadNorm {
    static constexpr bool PERM = true, AFTER_DRAIN = false;
    bf16_t* O; int ldc; PG8_LAS unsigned char* st; float eps;
    __device__ __forceinline__ void operator()(const f32x4 (&acc)[2][2][4][2], const Unit& u, int wr, int wc, int fr, int fq) const {
        PG8_LAS f32x2* P = (PG8_LAS f32x2*)st; PG8_LAS f32x2* S = (PG8_LAS f32x2*)(st + 8192);
        const int lane = fq * 16 + fr, wid = wr * 4 + wc;
#pragma unroll
        for (int ai = 0; ai < 2; ++ai)
#pragma unroll
            for (int m = 0; m < 4; ++m) {
                float s = 0.f;
#pragma unroll
                for (int bj = 0; bj < 2; ++bj)
#pragma unroll
                    for (int n = 0; n < 2; ++n) { const f32x4 x = acc[ai][bj][m][n]; s += (x[0] + x[1]) + (x[2] + x[3]); }
                s += __shfl_xor(s, 16); s += __shfl_xor(s, 32);
                const float mw = s * (1.0f / 64.0f); float q = 0.f;
#pragma unroll
                for (int bj = 0; bj < 2; ++bj)
#pragma unroll
                    for (int n = 0; n < 2; ++n) { const f32x4 d = acc[ai][bj][m][n] - mw; q += (d[0] * d[0] + d[1] * d[1]) + (d[2] * d[2] + d[3] * d[3]); }
                q += __shfl_xor(q, 16); q += __shfl_xor(q, 32);
                if (fq == 0) P[(ai * HALF + wr * 64 + m * 16 + fr) * 4 + wc] = (f32x2){mw, q};
            }
        asm volatile("s_waitcnt lgkmcnt(0)" ::: "memory"); __builtin_amdgcn_s_barrier(); asm volatile("" ::: "memory");
        const int row = wid * 32 + (lane & 31);
        if (lane < 32) {
            const f32x2 a = P[row * 4 + 0], b = P[row * 4 + 1], c = P[row * 4 + 2], d = P[row * 4 + 3];
            const float mt = (a.x + b.x + c.x + d.x) * 0.25f;
            const float da = a.x - mt, db = b.x - mt, dc = c.x - mt, dd = d.x - mt;
            const float m2 = (a.y + b.y) + (c.y + d.y) + 64.0f * ((da * da + db * db) + (dc * dc + dd * dd));
            S[row] = (f32x2){mt, 1.0f / sqrtf(m2 * (1.0f / 256.0f) + eps)};
        }
        asm volatile("s_waitcnt lgkmcnt(0)" ::: "memory"); __builtin_amdgcn_s_barrier(); asm volatile("" ::: "memory");
        const int row0 = u.pm * BM + wr * 64 + fr, col0 = u.pn * BM + wc * 32 + 8 * fq;
#pragma unroll
        for (int ai = 0; ai < 2; ++ai)
#pragma unroll
            for (int m = 0; m < 4; ++m) { const f32x2 sr = S[ai * HALF + wr * 64 + m * 16 + fr]; bf16_t* rowp = O + (size_t)(row0 + ai * HALF + m * 16) * ldc + col0;
#pragma unroll
                for (int bj = 0; bj < 2; ++bj) { const f32x4 v0 = (acc[ai][bj][m][0] - sr.x) * sr.y, v1 = (acc[ai][bj][m][1] - sr.x) * sr.y;
                    u32x4 w; w.x = cvt_pk_bf16(v0[0], v0[1]); w.y = cvt_pk_bf16(v0[2], v0[3]); w.z = cvt_pk_bf16(v1[0], v1[1]); w.w = cvt_pk_bf16(v1[2], v1[3]);
                    *(u32x4*)(rowp + bj * HALF) = w; } }
    }
};

template <class Epi, class Sched, bool ALIGN_EPI = false, bool SP2 = false>
__device__ __forceinline__ void gemm_phase(PG8_LAS unsigned char* lds, const Gemm g, const Sched& S, const Epi& E) {
    const int tid = threadIdx.x, wid = __builtin_amdgcn_readfirstlane(tid >> 6), lane = tid & 63, wr = wid >> 2, wc = wid & 3, fr = lane & 15, fq = lane >> 4;
    const int K = g.K, nt = K / BK;
    unsigned voffA[2], voffB[2];
#pragma unroll
    for (int i = 0; i < 2; ++i) { int R, C; stage_rc(tid * 16 + i * 8192, R, C); const int Rb = Epi::PERM ? ((R & ~31) + perm32(R & 31)) : R;
        voffA[i] = (unsigned)(R * K + C) * 2u; voffB[i] = (unsigned)(Rb * K + C) * 2u; }
    const size_t kstep = (size_t)(BK * 2);
    const size_t hstep = (size_t)HALF * K * 2;
    const size_t tstep = 2 * hstep;
    const unsigned ldsw = (unsigned)wid * 1024u;
    const int aoff = lds_byte(wr * 64 + fr, fq * 8), boff = lds_byte(wc * 32 + fr, fq * 8);
#define PG8_SA(b, h) (((b) * 2 + (h)) * HTB)
#define PG8_SB(b, h) ((4 + (b) * 2 + (h)) * HTB)
#define PG8_STAGE(bufoff, gbase, voff) do { _Pragma("unroll") for (int _i = 0; _i < 2; ++_i) \
        __builtin_amdgcn_global_load_lds((const unsigned*)((const char*)(gbase) + (voff)[_i]), (PG8_LAS unsigned*)(lds + (bufoff) + ldsw + _i * 8192), 16, 0, 0); } while (0)
#define PG8_LDA(dst, b, h) do { _Pragma("unroll") for (int m = 0; m < 4; ++m) _Pragma("unroll") for (int k = 0; k < 2; ++k) dst[m][k] = *(const PG8_LAS bf16x8*)(lds + PG8_SA(b, h) + aoff + m * 2048 + k * 1024); } while (0)
#define PG8_LDB(dst, b, h) do { _Pragma("unroll") for (int n = 0; n < 2; ++n) _Pragma("unroll") for (int k = 0; k < 2; ++k) dst[n][k] = *(const PG8_LAS bf16x8*)(lds + PG8_SB(b, h) + boff + n * 2048 + k * 1024); } while (0)
#define PG8_MMA(ai, bj, At, Bt) do { __builtin_amdgcn_s_setprio(1); _Pragma("unroll") for (int m = 0; m < 4; ++m) _Pragma("unroll") for (int n = 0; n < 2; ++n) _Pragma("unroll") for (int k = 0; k < 2; ++k) \
        acc[ai][bj][m][n] = __builtin_amdgcn_mfma_f32_16x16x32_bf16(Bt[n][k], At[m][k], acc[ai][bj][m][n], 0, 0, 0); __builtin_amdgcn_s_setprio(0); } while (0)
#define PG8_WAIT_V(n) asm volatile("s_waitcnt vmcnt(" #n ")" ::: "memory")
#define PG8_WAIT_L(n) asm volatile("s_waitcnt lgkmcnt(" #n ")" ::: "memory")
#define PG8_BAR __builtin_amdgcn_s_barrier()
#define PG8_SCHED __builtin_amdgcn_sched_barrier(0)
    Unit cur, nxt; int ui = 0;
    if (!S.next(0, cur)) return;
    f32x4 acc[2][2][4][2];
#pragma unroll
    for (int a = 0; a < 2; ++a)
#pragma unroll
        for (int b = 0; b < 2; ++b)
#pragma unroll
            for (int m = 0; m < 4; ++m)
#pragma unroll
                for (int n = 0; n < 2; ++n) acc[a][b][m][n] = (f32x4){0.f, 0.f, 0.f, 0.f};
    bf16x8 At[4][2], B0[2][2], B1[2][2];
    const char* cA = (const char*)g.A + (size_t)cur.pm * tstep; const char* cB = (const char*)g.Bt + (size_t)cur.pn * tstep;
    S.a_ready(cur);
    if constexpr (SP2) {
        PG8_STAGE(PG8_SB(0, 0), cB, voffB); PG8_STAGE(PG8_SB(0, 1), cB + hstep, voffB); PG8_STAGE(PG8_SA(0, 0), cA, voffA); PG8_STAGE(PG8_SA(0, 1), cA + hstep, voffA);
        if (wr == 1) PG8_BAR;
        PG8_WAIT_V(2); PG8_BAR;
        PG8_STAGE(PG8_SB(1, 0), cB + kstep, voffB); PG8_STAGE(PG8_SA(1, 0), cA + kstep, voffA); PG8_STAGE(PG8_SB(1, 1), cB + hstep + kstep, voffB);
        PG8_WAIT_V(6); PG8_BAR;
    } else {
        PG8_STAGE(PG8_SB(0, 0), cB, voffB); PG8_STAGE(PG8_SA(0, 0), cA, voffA); PG8_STAGE(PG8_SB(0, 1), cB + hstep, voffB); PG8_STAGE(PG8_SA(0, 1), cA + hstep, voffA);
        if (wr == 1) PG8_BAR;
        PG8_WAIT_V(4); PG8_BAR;
        PG8_STAGE(PG8_SB(1, 0), cB + kstep, voffB); PG8_STAGE(PG8_SA(1, 0), cA + kstep, voffA); PG8_STAGE(PG8_SB(1, 1), cB + hstep + kstep, voffB);
        PG8_WAIT_V(6); PG8_BAR;
    }
    for (;;) {
        const bool has_next = S.next(ui + 1, nxt);
        const bool skip1 = __builtin_amdgcn_readfirstlane((int)(cur.pm == g.half_pm)) != 0;
        const char* nA = has_next ? (const char*)g.A + (size_t)nxt.pm * tstep : cA; const char* nB = has_next ? (const char*)g.Bt + (size_t)nxt.pn * tstep : cB;
        for (int t = 0; t < nt; t += 2) {
            const bool last = (t == nt - 2);
            const char* a1 = cA + (size_t)(t + 1) * kstep;
            const char* a2 = last ? nA : cA + (size_t)(t + 2) * kstep; const char* b2 = last ? nB : cB + (size_t)(t + 2) * kstep;
            const char* a3 = a2 + kstep; const char* b3 = b2 + kstep;
            if (last && has_next) S.a_ready(nxt);
            if constexpr (SP2) {
            PG8_LDB(B0, 0, 0); PG8_LDB(B1, 0, 1); PG8_SCHED; PG8_LDA(At, 0, 0); PG8_STAGE(PG8_SA(1, 1), a1 + hstep, voffA);
            PG8_WAIT_V(8); PG8_WAIT_L(0); PG8_BAR; PG8_MMA(0, 0, At, B0); PG8_MMA(0, 1, At, B1); PG8_BAR; PG8_SCHED;
            PG8_LDA(At, 0, 1); PG8_STAGE(PG8_SB(0, 0), b2, voffB); PG8_STAGE(PG8_SB(0, 1), b2 + hstep, voffB); PG8_STAGE(PG8_SA(0, 0), a2, voffA);
            PG8_WAIT_V(8); PG8_WAIT_L(0); PG8_BAR; if (!skip1) { PG8_MMA(1, 0, At, B0); PG8_MMA(1, 1, At, B1); } PG8_BAR; PG8_SCHED;
            PG8_LDB(B0, 1, 0); PG8_LDB(B1, 1, 1); PG8_SCHED; PG8_LDA(At, 1, 0); PG8_STAGE(PG8_SA(0, 1), a2 + hstep, voffA);
            PG8_WAIT_V(8); PG8_WAIT_L(0); PG8_BAR; PG8_MMA(0, 0, At, B0); PG8_MMA(0, 1, At, B1); PG8_BAR; PG8_SCHED;
            PG8_LDA(At, 1, 1); PG8_STAGE(PG8_SB(1, 0), b3, voffB); PG8_STAGE(PG8_SB(1, 1), b3 + hstep, voffB); PG8_STAGE(PG8_SA(1, 0), a3, voffA);
            PG8_WAIT_V(8); PG8_WAIT_L(0); PG8_BAR; if (!skip1) { PG8_MMA(1, 0, At, B0); PG8_MMA(1, 1, At, B1); } PG8_BAR; PG8_SCHED;
            } else {
            PG8_LDB(B0, 0, 0); PG8_SCHED; PG8_LDA(At, 0, 0); PG8_STAGE(PG8_SA(1, 1), a1 + hstep, voffA);
            PG8_WAIT_L(8); PG8_BAR; PG8_WAIT_L(0); PG8_MMA(0, 0, At, B0); PG8_BAR; PG8_SCHED;
            PG8_LDB(B1, 0, 1); PG8_STAGE(PG8_SB(0, 0), b2, voffB);
            PG8_BAR; PG8_WAIT_L(0); PG8_MMA(0, 1, At, B1); PG8_BAR;
            PG8_LDA(At, 0, 1); PG8_STAGE(PG8_SA(0, 0), a2, voffA);
            PG8_BAR; PG8_WAIT_L(0); PG8_MMA(1, 0, At, B0); PG8_BAR; PG8_SCHED;
            PG8_STAGE(PG8_SB(0, 1), b2 + hstep, voffB);
            PG8_WAIT_V(6); PG8_BAR; PG8_MMA(1, 1, At, B1); PG8_BAR;
            PG8_LDB(B0, 1, 0); PG8_SCHED; PG8_LDA(At, 1, 0); PG8_STAGE(PG8_SA(0, 1), a2 + hstep, voffA);
            PG8_WAIT_L(8); PG8_BAR; PG8_WAIT_L(0); PG8_MMA(0, 0, At, B0); PG8_BAR; PG8_SCHED;
            PG8_LDB(B1, 1, 1); PG8_STAGE(PG8_SB(1, 0), b3, voffB);
            PG8_BAR; PG8_WAIT_L(0); PG8_MMA(0, 1, At, B1); PG8_BAR;
            PG8_LDA(At, 1, 1); PG8_STAGE(PG8_SA(1, 0), a3, voffA);
            PG8_BAR; PG8_WAIT_L(0); PG8_MMA(1, 0, At, B0); PG8_BAR; PG8_SCHED;
            PG8_STAGE(PG8_SB(1, 1), b3 + hstep, voffB);
            PG8_WAIT_V(6); PG8_BAR; PG8_MMA(1, 1, At, B1); PG8_BAR;
            }
        }
        if constexpr (ALIGN_EPI) { if (wr == 0) PG8_BAR; }
        if constexpr (!Epi::AFTER_DRAIN) { E(acc, cur, wr, wc, fr, fq); S.done(cur); }
        if (!has_next) break;
#pragma unroll
        for (int a = 0; a < 2; ++a)
#pragma unroll
            for (int b = 0; b < 2; ++b)
#pragma unroll
                for (int m = 0; m < 4; ++m)
#pragma unroll
                    for (int n = 0; n < 2; ++n) acc[a][b][m][n] = (f32x4){0.f, 0.f, 0.f, 0.f};
        cur = nxt; cA = nA; cB = nB; ++ui;
        if constexpr (ALIGN_EPI) { if (wr == 1) PG8_BAR; }
    }
    PG8_WAIT_V(0);
    if constexpr (!ALIGN_EPI) { if (wr == 0) PG8_BAR; }
    PG8_BAR;
    if constexpr (Epi::AFTER_DRAIN) { E.fused(acc, cur, wr, wc, fr, fq, lds, wid, lane); S.done(cur); }
#undef PG8_SA
#undef PG8_SB
#undef PG8_STAGE
#undef PG8_LDA
#undef PG8_LDB
#undef PG8_MMA
#undef PG8_WAIT_V
#undef PG8_WAIT_L
#undef PG8_BAR
#undef PG8_SCHED
}
}

constexpr int NWAVES = 8, NTHR = 512;
constexpr int DM = 1024, TSEQ = 4096, NP = 32768, NS = 128, NTOK = NP + NS, MPAD = 33024;
constexpr int INW = 9744, NPROJ = 9728, ABCOL = 6656;
constexpr float LN_EPS = 1e-5f, ALPHA = 1.189207115002721f, GLA_QSCALE = 0.08838834764831845f, NEG_BIG = -1e30f;
constexpr size_t OUT_YP = 0, OUT_YS = 33554432, OUT_KVP1 = 33685504, OUT_KVP2 = 34734080, OUT_KVP3 = 38928384, OUT_STP = 55705600,
                 OUT_KVS1 = 56754176, OUT_KVS2 = 60948480, OUT_KVS3 = 77725696, OUT_STS = 144834560, OUT_TOTAL = 149028864;
constexpr size_t MiB = 1u << 20;
constexpr size_t WS_CTL = 0, CTL_ZERO_BYTES = 1 * MiB;
constexpr size_t WS_KEYS = 1 * MiB, WS_LUT = WS_KEYS + 512 * 1024;
constexpr size_t WS_WA = 2 * MiB, WS_WB = 3 * MiB, WS_WO = 5 * MiB, WS_WQ = 7 * MiB, WS_WIN = 11 * MiB;
constexpr size_t WS_AB = 31 * MiB, WS_UT = 34 * MiB, WS_VT = 66 * MiB, WS_XB = 98 * MiB;
constexpr size_t WS_QA = 163 * MiB, WS_KA = 260 * MiB, WS_VA = 357 * MiB, WS_QB = 454 * MiB, WS_KB = 487 * MiB, WS_VB = 520 * MiB;
constexpr size_t WS_RB = 585 * MiB, WS_GA = 650 * MiB, WS_GB = 715 * MiB, WS_LSE = 780 * MiB, WS_OAM = 784 * MiB, WS_OBN = 817 * MiB, WS_H = 882 * MiB, WS_END = 1011 * MiB;
constexpr size_t WS_HB = WS_KA;
constexpr size_t WS_T1 = WS_KA, WS_MIX = WS_VA, WS_X1B = WS_QA, WS_QN = WS_RB, WS_EIDX = WS_GB, WS_GATE = WS_GB + 17 * MiB;
static_assert(WS_WIN + (size_t)NPROJ * 1024 * 2 <= WS_AB && WS_AB + (size_t)MPAD * 16 * 4 <= WS_UT && WS_XB + (size_t)MPAD * 1024 * 2 <= WS_QA, "ws map 1");
static_assert(WS_QA + (size_t)MPAD * 1536 * 2 <= WS_KA && WS_QB + (size_t)MPAD * 512 * 2 <= WS_KB && WS_VB + (size_t)MPAD * 1024 * 2 <= WS_RB, "ws map 2");
static_assert(WS_LSE + (size_t)3 * MPAD * 8 * 4 <= WS_OAM && WS_OAM + (size_t)MPAD * 512 * 2 <= WS_OBN && WS_OBN + (size_t)MPAD * 1024 * 2 <= WS_H && WS_H + (size_t)MPAD * 1024 * 4 <= WS_END, "ws map 3");
static_assert(WS_QN + (size_t)MPAD * 2048 * 2 <= WS_GB && WS_EIDX + (size_t)MPAD * 128 * 4 <= WS_GATE && WS_GATE + (size_t)MPAD * 128 * 4 <= WS_LSE, "ws map 4");
constexpr int CW_QUEUE = 64;
constexpr int CW_CPYQ = 128;
constexpr int CW_GDONE = 192;
constexpr int NCOPYWG = 10;
constexpr int CW_BAR = 4096;
constexpr int RING_BYTES = 131072, STATS_OFF = RING_BYTES, MISC_OFF = STATS_OFF + 10240 + 320, LDS_BYTES = 147456;
static_assert(MISC_OFF + 128 + 22 * 8 <= LDS_BYTES, "LDS map");

#define GAS __attribute__((address_space(1)))
#define LAS __attribute__((address_space(3)))
typedef unsigned short bf16;
typedef unsigned v4u __attribute__((ext_vector_type(4)));
typedef unsigned v2u __attribute__((ext_vector_type(2)));
typedef float f32x4 __attribute__((ext_vector_type(4)));
typedef float f32x16 __attribute__((ext_vector_type(16)));
typedef short bf16x8 __attribute__((ext_vector_type(8)));
typedef short s16x4 __attribute__((ext_vector_type(4)));
typedef GAS unsigned gu32;
#define RLX_AGENT __ATOMIC_RELAXED, __HIP_MEMORY_SCOPE_AGENT
#define LDS_WAIT() asm volatile("s_waitcnt lgkmcnt(0)" ::: "memory")
#define VM_WAIT() asm volatile("s_waitcnt vmcnt(0)" ::: "memory")
#define MFMA32(a, b, c) __builtin_amdgcn_mfma_f32_32x32x16_bf16((a), (b), (c), 0, 0, 0)
using pg8::cvt_pk_bf16; using pg8::bf_lo; using pg8::bf_hi;
__device__ __forceinline__ unsigned short f2bf(float f) { return (unsigned short)(cvt_pk_bf16(f, 0.f) & 0xffffu); }
__device__ __forceinline__ float bf2f(unsigned short h) { return __uint_as_float((unsigned)h << 16); }
__device__ __forceinline__ int crow(int reg, int hh) { return (reg & 3) + 8 * (reg >> 2) + 4 * hh; }
__device__ __forceinline__ float wave_sum(float v) {
#pragma unroll
    for (int o = 1; o < 64; o <<= 1) v += __shfl_xor(v, o);
    return v;
}
__device__ __forceinline__ float wave_max(float v) {
#pragma unroll
    for (int o = 1; o < 64; o <<= 1) v = fmaxf(v, __shfl_xor(v, o));
    return v;
}
__device__ __forceinline__ bf16x8 frag_row(const LAS unsigned char* T, int stride, int r0, int k0, int lane) {
    return *(const LAS bf16x8*)(T + (r0 + (lane & 31)) * stride + (k0 + 8 * (lane >> 5)) * 2);
}
typedef short v4i16_t __attribute__((ext_vector_type(4)));
template <bool PERM> __device__ __forceinline__ bf16x8 frag_tr(const LAS unsigned char* X, int stride, int k0, int c0, int lane) {
    const int i = lane & 15, g = (lane >> 4) & 1, hh = lane >> 5, q = i >> 2, p = i & 3;
    const int rA = PERM ? (k0 + 4 * hh + q) : (k0 + 8 * hh + q), rB = PERM ? (k0 + 8 + 4 * hh + q) : (k0 + 8 * hh + 4 + q);
    const int cb = (c0 + 16 * g + 4 * p) * 2;
    const s16x4 lo = __builtin_bit_cast(s16x4, __builtin_amdgcn_ds_read_tr16_b64_v4i16((LAS v4i16_t*)(X + rA * stride + cb)));
    const s16x4 hi = __builtin_bit_cast(s16x4, __builtin_amdgcn_ds_read_tr16_b64_v4i16((LAS v4i16_t*)(X + rB * stride + cb)));
    return __builtin_shufflevector(lo, hi, 0, 1, 2, 3, 4, 5, 6, 7);
}
__device__ __forceinline__ bf16x8 pack_acc(const f32x16& x, int s) {
    v4u p; p.x = cvt_pk_bf16(x[8 * s], x[8 * s + 1]); p.y = cvt_pk_bf16(x[8 * s + 2], x[8 * s + 3]); p.z = cvt_pk_bf16(x[8 * s + 4], x[8 * s + 5]); p.w = cvt_pk_bf16(x[8 * s + 6], x[8 * s + 7]);
    return __builtin_bit_cast(bf16x8, p);
}

#define XB_TMO      128
#define XB_XCNT(j)  (256  + 64 * (j))
#define XB_XSUB(j)  (1280 + 64 * (j))
#define XB_XGEN(j)  (2304 + 64 * (j))
#define XB_TOP      3328
#define XB_TOPGEN   3392
#define XCD_BAR_WORDS 3456
#define XB_SPIN_CAP (1u << 22)
__device__ __forceinline__ unsigned xb_ld(unsigned* p)              { return __hip_atomic_load(p, __ATOMIC_RELAXED, __HIP_MEMORY_SCOPE_AGENT); }
__device__ __forceinline__ unsigned xb_add(unsigned* p, unsigned v) { return __hip_atomic_fetch_add(p, v, __ATOMIC_RELAXED, __HIP_MEMORY_SCOPE_AGENT); }
__device__ __forceinline__ unsigned xb_xcc_id() { return (unsigned)__builtin_amdgcn_s_getreg((3 << 11) | 20) & 0xFu; }
#define XB_SPIN(cond, bar) do { unsigned _sp = 0; while (cond) { __builtin_amdgcn_s_sleep(1); \
    if ((++_sp & 255u) == 0u) { if (xb_ld(&(bar)[XB_TMO])) break; if (_sp > XB_SPIN_CAP) { atomicAdd(&(bar)[XB_TMO], 1u); break; } } } } while (0)
struct XcdBarrier { unsigned* bar; unsigned x; volatile LAS unsigned* st; };
__device__ __forceinline__ XcdBarrier xcd_barrier_post(unsigned* bar, volatile LAS unsigned* st) {
    XcdBarrier b; b.bar = bar; b.x = xb_xcc_id(); b.st = st;
    if (threadIdx.x == 0) (void)xb_add(&bar[XB_XCNT(b.x)], 1u);
    return b;
}
__device__ __forceinline__ void xcd_barrier_complete(unsigned* bar, unsigned x, unsigned& nloc, unsigned& nx) {
    const unsigned G = gridDim.x * gridDim.y * gridDim.z;
    unsigned sum, cnt, mine, sp = 0u;
    for (;;) {
        sum = 0u; cnt = 0u; mine = 0u;
#pragma unroll
        for (unsigned j = 0; j < 16; ++j) { const unsigned c = xb_ld(&bar[XB_XCNT(j)]); sum += c; cnt += (c > 0u) ? 1u : 0u; mine = (j == x) ? c : mine; }
        if (sum == G) break;
        __builtin_amdgcn_s_sleep(1);
        if ((++sp & 255u) == 0u) { if (xb_ld(&bar[XB_TMO])) break; if (sp > XB_SPIN_CAP) { atomicAdd(&bar[XB_TMO], 1u); break; } }
    }
    nloc = mine > 0u ? mine : 1u; nx = cnt > 0u ? cnt : 1u;
}
__device__ __forceinline__ void xcd_barrier(const XcdBarrier& b) {
    asm volatile("s_waitcnt vmcnt(0)" ::: "memory");
    __syncthreads();
    if (threadIdx.x == 0) {
        unsigned* bar = b.bar;
        __builtin_amdgcn_s_waitcnt(0);
        unsigned nloc = b.st[0], nx = b.st[1];
        if (nloc == 0u) { xcd_barrier_complete(bar, b.x, nloc, nx); b.st[0] = nloc; b.st[1] = nx; }
        const unsigned old = xb_add(&bar[XB_XSUB(b.x)], 1u);
        const unsigned gen = old / nloc;
        if (old + 1u == (gen + 1u) * nloc) {
            __builtin_amdgcn_fence(__ATOMIC_RELEASE, "agent");
            asm volatile("s_waitcnt vmcnt(0)" ::: "memory");
            const unsigned og = xb_add(&bar[XB_TOP], 1u);
            const unsigned tg = og / nx;
            if (og + 1u == (tg + 1u) * nx) xb_add(&bar[XB_TOPGEN], 1u);
            else XB_SPIN(xb_ld(&bar[XB_TOPGEN]) == tg, bar);
            __builtin_amdgcn_fence(__ATOMIC_ACQUIRE, "agent");
            xb_add(&bar[XB_XGEN(b.x)], 1u);
            asm volatile("s_waitcnt vmcnt(0)" ::: "memory");
        } else {
            XB_SPIN(xb_ld(&bar[XB_XGEN(b.x)]) == gen, bar);
            __builtin_amdgcn_fence(__ATOMIC_ACQUIRE, "agent");
            asm volatile("s_waitcnt vmcnt(0)" ::: "memory");
        }
    }
    __syncthreads();
}

struct Frame {
    LAS unsigned char* lds;
    volatile LAS unsigned* MISC;
    gu32* ctl;
    int tid, lane, wave, G;
    unsigned long long tp;
    float* out; unsigned char* ws;
};
#define WSP(T, off) ((T*)(F.ws + (off)))
#define WSL(T, off) ((T*)(ws_ + (off)))
#define LAUNDER_WS() unsigned char* ws_ = F.ws; asm volatile("" : "+s"(ws_))
constexpr int PTR_OFF = MISC_OFF + 128;
enum { I_XP = 0, I_XS, I_C1, I_C2, I_C3, I_ST0, I_RELB, I_WIN, I_WG2, I_BG, I_GN, I_WA, I_WB, I_WO, I_L1G, I_L1B, I_WQ, I_KEYS, I_PU, I_PV, I_L2G, I_L2B };
__device__ __forceinline__ const float* inptr(const Frame& F, int i) {
    const unsigned long long v = ((volatile LAS unsigned long long*)(F.lds + PTR_OFF))[i];
    const unsigned lo = __builtin_amdgcn_readfirstlane((unsigned)v), hi = __builtin_amdgcn_readfirstlane((unsigned)(v >> 32));
    return (const float*)(((unsigned long long)hi << 32) | lo);
}

__device__ __forceinline__ void p0_tr_load(const float* W, int N, int nsrc0, int k0, int lane, float (&v)[32]) {
#pragma unroll
    for (int i = 0; i < 32; ++i) { const int kk = 2 * i + (lane >> 5); v[i] = W[(size_t)(k0 + kk) * N + nsrc0 + (lane & 31)]; }
}
__device__ __forceinline__ void p0_tr_finish(const float (&v)[32], int K, bf16* WT, int ndst0, int k0, LAS float* scr, int lane) {
#pragma unroll
    for (int i = 0; i < 32; ++i) { const int kk = 2 * i + (lane >> 5); scr[kk * 33 + (lane & 31)] = v[i]; }
    LDS_WAIT(); asm volatile("" ::: "memory");
    const int c = lane & 7;
#pragma unroll
    for (int j = 0; j < 4; ++j) { const int n = (lane >> 3) + 8 * j; const LAS float* s = scr + (8 * c) * 33 + n;
        v4u o; o.x = cvt_pk_bf16(s[0 * 33], s[1 * 33]); o.y = cvt_pk_bf16(s[2 * 33], s[3 * 33]); o.z = cvt_pk_bf16(s[4 * 33], s[5 * 33]); o.w = cvt_pk_bf16(s[6 * 33], s[7 * 33]);
        *(GAS v4u*)(WT + (size_t)(ndst0 + n) * K + k0 + 8 * c) = o; }
    LDS_WAIT(); asm volatile("" ::: "memory");
}
__device__ __forceinline__ void p0_cvt8(const float* src, bf16* dst, size_t n8, size_t gt, size_t ngt) {
    for (size_t i = gt; i < n8; i += ngt) { const f32x4 a = *(const f32x4*)(src + i * 8), b = *(const f32x4*)(src + i * 8 + 4);
        v4u o; o.x = cvt_pk_bf16(a[0], a[1]); o.y = cvt_pk_bf16(a[2], a[3]); o.z = cvt_pk_bf16(b[0], b[1]); o.w = cvt_pk_bf16(b[2], b[3]); *(v4u*)(dst + i * 8) = o; }
}
typedef float f32x2_t __attribute__((ext_vector_type(2)));
typedef _Float16 h2_t __attribute__((ext_vector_type(2)));
constexpr float U_SCALE = 1024.0f, V_SCALE = 128.0f, X_SCALE = 16.0f;
__device__ __forceinline__ void p0_cvt_fp8(const float* src, unsigned char* dst, float scale, size_t n16, size_t gt, size_t ngt) {
    for (size_t i = gt; i < n16; i += ngt) { v4u o;
#pragma unroll
        for (int q = 0; q < 4; ++q) { const f32x4 a = *(const f32x4*)(src + i * 16 + 4 * q) * scale; int w = 0;
            w = __builtin_amdgcn_cvt_pk_fp8_f32(a[0], a[1], w, false); w = __builtin_amdgcn_cvt_pk_fp8_f32(a[2], a[3], w, true); o[q] = (unsigned)w; }
        const size_t e = i >> 6, q16 = i & 63;
        *(v4u*)(dst + (((q16 >> 3) * 16384 + e) << 7) + 16 * (q16 & 7)) = o; }
}
__device__ __forceinline__ void p0_kvshift(const float* src, float* dst, int Wb, size_t gt, size_t ngt) {
    const size_t n4 = (size_t)(Wb - 4) * 256, tot = n4 * 32;
    for (size_t i = gt; i < tot; i += ngt) { const size_t b = i / n4, r = i - b * n4;
        ((f32x4*)dst)[b * (size_t)Wb * 256 + r] = ((const f32x4*)src)[b * (size_t)Wb * 256 + 1024 + r]; }
}
__device__ __forceinline__ void p0_prologue(Frame& F) {
    const int gw = blockIdx.x * NWAVES + F.wave, NGW = F.G * NWAVES;
    const size_t gt = (size_t)blockIdx.x * NTHR + F.tid, ngt = (size_t)F.G * NTHR;
    const float* win = inptr(F, I_WIN); const float* xp = inptr(F, I_XP); const float* xs = inptr(F, I_XS);
    constexpr int WROW = 2064;
    for (int i = F.tid; i < 4096; i += NTHR) {
        const int k = i >> 2, c4 = (i & 3) * 4; const f32x4 w4 = *(const f32x4*)(win + (size_t)k * INW + ABCOL + c4);
#pragma unroll
        for (int cc = 0; cc < 4; ++cc) *(LAS unsigned short*)(F.lds + (c4 + cc) * WROW + k * 2) = f2bf(w4[cc]); }
    __syncthreads();
    bf16* XB = WSP(bf16, WS_XB); float* AB = WSP(float, WS_AB);
    {   const int lane = F.lane, r = lane & 15, kg = lane >> 4;
        typedef float f32x4a __attribute__((ext_vector_type(4)));
        for (int blk = gw; blk < MPAD / 16; blk += NGW) {
            const int m = 16 * blk + r;
            bf16* xo = XB + (size_t)m * 1024 + 8 * kg;
            if (16 * blk >= NTOK) {
#pragma unroll 8
                for (int s = 0; s < 32; ++s) *(v4u*)(xo + 32 * s) = (v4u){0u, 0u, 0u, 0u};
                if (kg == 0) { *(f32x4*)(AB + (size_t)m * 16) = (f32x4){0.f, 0.f, 0.f, 0.f}; *(f32x4*)(AB + (size_t)m * 16 + 4) = (f32x4){0.f, 0.f, 0.f, 0.f}; *(f32x4*)(AB + (size_t)m * 16 + 8) = (f32x4){0.f, 0.f, 0.f, 0.f}; *(f32x4*)(AB + (size_t)m * 16 + 12) = (f32x4){0.f, 0.f, 0.f, 0.f}; }
                continue; }
            const float* xr = (m < NP ? xp + (size_t)m * 1024 : xs + (size_t)(m - NP) * 1024) + 8 * kg;
            f32x4a acc = {0.f, 0.f, 0.f, 0.f};
#pragma unroll 1
            for (int s0 = 0; s0 < 32; s0 += 16) {
                f32x4 xa[16], xb[16];
#pragma unroll
                for (int u = 0; u < 16; ++u) { xa[u] = *(const f32x4*)(xr + 32 * (s0 + u)); xb[u] = *(const f32x4*)(xr + 32 * (s0 + u) + 4); }
#pragma unroll
                for (int u = 0; u < 16; ++u) { v4u w; w.x = cvt_pk_bf16(xa[u][0], xa[u][1]); w.y = cvt_pk_bf16(xa[u][2], xa[u][3]); w.z = cvt_pk_bf16(xb[u][0], xb[u][1]); w.w = cvt_pk_bf16(xb[u][2], xb[u][3]);
                    *(v4u*)(xo + 32 * (s0 + u)) = w;
                    const bf16x8 bfr = *(const LAS bf16x8*)(F.lds + r * WROW + (32 * (s0 + u) + 8 * kg) * 2);
                    acc = __builtin_amdgcn_mfma_f32_16x16x32_bf16(__builtin_bit_cast(bf16x8, w), bfr, acc, 0, 0, 0); }
            }
#pragma unroll
            for (int i2 = 0; i2 < 4; ++i2) AB[(size_t)(16 * blk + 4 * kg + i2) * 16 + r] = acc[i2];
        }
    }
    __syncthreads();
    LAS float* scr = (LAS float*)(F.lds + F.wave * 16384);
    const float* wa = inptr(F, I_WA); const float* wb = inptr(F, I_WB); const float* wo = inptr(F, I_WO); const float* wq = inptr(F, I_WQ);
    constexpr int I_IN = 16 * (NPROJ / 32), I_A = 8 * 32, I_B = 16 * 32, I_O = 16 * 32, I_Q = 16 * 64, NIT = I_IN + I_A + I_B + I_O + I_Q;
#define P0_TR_PARAMS(IT, W_, WT_, K_, N_, NS_, ND_, K0_) { int r = (IT); \
        if (r < I_IN) { const int nb = r % (NPROJ / 32), kb = r / (NPROJ / 32), nd = 32 * nb; W_ = win; WT_ = WSP(bf16, WS_WIN); K_ = 1024; N_ = INW; NS_ = nd + (nd >= ABCOL ? 16 : 0); ND_ = nd; K0_ = 64 * kb; } \
        else if ((r -= I_IN) < I_A) { W_ = wa; WT_ = WSP(bf16, WS_WA); K_ = 512; N_ = 1024; NS_ = ND_ = 32 * (r % 32); K0_ = 64 * (r / 32); } \
        else if ((r -= I_A) < I_B) { W_ = wb; WT_ = WSP(bf16, WS_WB); K_ = 1024; N_ = 1024; NS_ = ND_ = 32 * (r % 32); K0_ = 64 * (r / 32); } \
        else if ((r -= I_B) < I_O) { W_ = wo; WT_ = WSP(bf16, WS_WO); K_ = 1024; N_ = 1024; NS_ = ND_ = 32 * (r % 32); K0_ = 64 * (r / 32); } \
        else { r -= I_O; W_ = wq; WT_ = WSP(bf16, WS_WQ); K_ = 1024; N_ = 2048; NS_ = ND_ = 32 * (r % 64); K0_ = 64 * (r / 64); } }
    if (blockIdx.x != 0) {
        const int NW2 = NGW - NWAVES;
        for (int it = gw - NWAVES; it < NIT; it += 2 * NW2) {
            const int it2 = it + NW2; const bool has2 = it2 < NIT;
            const float* Wa; bf16* WTa; int Ka, Na, NSa, NDa, K0a; P0_TR_PARAMS(it, Wa, WTa, Ka, Na, NSa, NDa, K0a);
            const float* Wb = Wa; bf16* WTb = WTa; int Kb = Ka, Nb = Na, NSb = NSa, NDb = NDa, K0b = K0a;
            if (has2) P0_TR_PARAMS(it2, Wb, WTb, Kb, Nb, NSb, NDb, K0b);
            float va[32], vb[32];
            p0_tr_load(Wa, Na, NSa, K0a, F.lane, va);
            if (has2) p0_tr_load(Wb, Nb, NSb, K0b, F.lane, vb);
            p0_tr_finish(va, Ka, WTa, NDa, K0a, scr, F.lane);
            if (has2) p0_tr_finish(vb, Kb, WTb, NDb, K0b, scr, F.lane);
        }
    }
    p0_cvt_fp8(inptr(F, I_PU), WSP(unsigned char, WS_UT), U_SCALE, (size_t)16384 * 1024 / 16, gt, ngt);
    p0_cvt_fp8(inptr(F, I_PV), WSP(unsigned char, WS_VT), V_SCALE, (size_t)16384 * 1024 / 16, gt, ngt);
    p0_cvt8(inptr(F, I_KEYS), WSP(bf16, WS_KEYS), (size_t)8 * 2 * 128 * 128 / 8, gt, ngt);
    if (gt < 3 * 8 * 129) { const int g = (int)gt / (8 * 129), h = ((int)gt / 129) % 8, rel = (int)gt % 129; const int dil = g == 0 ? 1 : (g == 1 ? 4 : 16), dist = rel * dil;
        int bucket = dist;
        if (dist >= 16) { const float dd = (float)dist; int lg = 16 + (int)(logf(dd / 16.0f) / 4.852030263919617f * 16.0f); bucket = lg < 31 ? lg : 31; }
        WSP(float, WS_LUT)[gt] = inptr(F, I_RELB)[bucket * 24 + g * 8 + h]; }
}

constexpr size_t WS_KD = WS_OAM, WS_DEC = WS_OBN;
__device__ __forceinline__ void gla_prep_load(Frame& F, int unit, unsigned (&qv)[8], unsigned (&kv)[8], float (&abv)[2]) {
    const int d2 = F.tid & 63, ig = F.wave, h = unit & 3, n = (unit >> 2) & 63, b = unit >> 8;
    const size_t m0 = (size_t)b * TSEQ + (size_t)n * 64;
    const bf16* QB = WSP(bf16, WS_QB); const bf16* KB = WSP(bf16, WS_KB); const float* AB = WSP(float, WS_AB);
#pragma unroll
    for (int ii = 0; ii < 8; ++ii) { const size_t off = (m0 + 8 * ig + ii) * 512 + h * 128 + 2 * d2; qv[ii] = *(const unsigned*)(QB + off); kv[ii] = *(const unsigned*)(KB + off); }
    abv[0] = AB[(m0 + 8 * ig) * 16 + d2]; abv[1] = AB[(m0 + 8 * ig) * 16 + 64 + d2];
}
__device__ __forceinline__ void gla_prep_unit(Frame& F, int unit, const unsigned (&qv)[8], const unsigned (&kv)[8], const float (&abv)[2], const f32x2_t (&wg)[16], const f32x2_t bgd) {
    LAUNDER_WS();
    LAS float* GT = (LAS float*)F.lds;
    const int tid = F.tid, d2 = tid & 63, ig = F.wave;
    const int h = unit & 3, n = (unit >> 2) & 63, b = unit >> 8;
    const size_t m0 = (size_t)b * TSEQ + (size_t)n * 64;
    bf16* QB = WSL(bf16, WS_QB); bf16* KB = WSL(bf16, WS_KB); float* DEC = WSL(float, WS_DEC);
    f32x2_t c[8]; f32x2_t run = {0.f, 0.f};
#pragma unroll
    for (int ii = 0; ii < 8; ++ii) {
        f32x2_t x = bgd;
#pragma unroll
        for (int r = 0; r < 16; ++r) x += wg[r] * __uint_as_float((unsigned)__builtin_amdgcn_readlane((int)__float_as_uint(abv[ii >> 2]), 16 * (ii & 3) + r));
        f32x2_t ls; ls.x = fminf(x.x, 0.f) - __logf(1.0f + __expf(-fabsf(x.x))); ls.y = fminf(x.y, 0.f) - __logf(1.0f + __expf(-fabsf(x.y)));
        run += ls * (1.0f / 16.0f); c[ii] = run;
    }
    *(LAS f32x2_t*)(GT + ig * 128 + 2 * d2) = run;
    __syncthreads();
    f32x2_t offs = {0.f, 0.f}, bl = {0.f, 0.f};
#pragma unroll
    for (int g = 0; g < 8; ++g) { const f32x2_t t = *(const LAS f32x2_t*)(GT + g * 128 + 2 * d2); bl += t; if (g < ig) offs += t; }
    const f32x2_t ebl = {__expf(bl.x), __expf(bl.y)};
#pragma unroll
    for (int ii = 0; ii < 8; ++ii) {
        const f32x2_t bb = offs + c[ii]; const f32x2_t eb = {__expf(bb.x), __expf(bb.y)}, ieb = {__expf(-bb.x), __expf(-bb.y)};
        const f32x2_t q = {bf_lo(qv[ii]), bf_hi(qv[ii])}, k = {bf_lo(kv[ii]), bf_hi(kv[ii])};
        const f32x2_t qe = q * GLA_QSCALE * eb, ke = k * ieb;
        const size_t off = (m0 + 8 * ig + ii) * 512 + h * 128 + 2 * d2;
        *(unsigned*)(QB + off) = cvt_pk_bf16(qe.x, qe.y); *(unsigned*)(KB + off) = cvt_pk_bf16(ke.x, ke.y);
    }
    if (ig == 0) *(f32x2_t*)(DEC + ((size_t)b * 64 + n) * 512 + h * 128 + 2 * d2) = ebl;
    __syncthreads();
}
__device__ __forceinline__ void gla_prompt_unit(Frame& F, int b, int h, int sl) {
    LAUNDER_WS();
    LAS unsigned char* L = F.lds;
    constexpr int O_QE = 0, O_KE = 17408, O_KD = 34816, O_VT = 55296, O_SB = 67584, O_DEC = 92160;
    const int tid = F.tid, lane = F.lane, w = F.wave, hh = lane >> 5;
    const bf16* QB = WSL(bf16, WS_QB); const bf16* KB = WSL(bf16, WS_KB); bf16* VB = WSL(bf16, WS_VB); const float* DEC = WSL(float, WS_DEC);
    for (int i = tid; i < 128 * 192 / 4; i += NTHR) ((LAS unsigned*)(L + O_SB))[i] = 0u;
    f32x16 S;
#pragma unroll
    for (int r = 0; r < 16; ++r) S[r] = 0.f;
    const int dt = w >> 1, et = w & 1;
    const int r0 = tid >> 4, c0 = tid & 15;
    v4u tq[2], tk[2], tv; float tdec = 0.f;
#define GLA_LOAD(n_) do { const size_t m0_ = (size_t)b * TSEQ + (size_t)(n_) * 64; \
        _Pragma("unroll") for (int i_ = 0; i_ < 2; ++i_) { const size_t off_ = (m0_ + r0 + 32 * i_) * 512 + h * 128 + c0 * 8; tq[i_] = *(const v4u*)(QB + off_); tk[i_] = *(const v4u*)(KB + off_); } \
        tv = *(const v4u*)(VB + (m0_ + (tid >> 3)) * 1024 + h * 256 + sl * 64 + (tid & 7) * 8); \
        if (tid < 128) tdec = DEC[((size_t)b * 64 + (n_)) * 512 + h * 128 + tid]; } while (0)
    GLA_LOAD(0);
    for (int n = 0; n < 64; ++n) {
        const size_t m0 = (size_t)b * TSEQ + (size_t)n * 64;
#pragma unroll
        for (int i = 0; i < 2; ++i) { *(LAS v4u*)(L + O_QE + (r0 + 32 * i) * 272 + c0 * 16) = tq[i]; *(LAS v4u*)(L + O_KE + (r0 + 32 * i) * 272 + c0 * 16) = tk[i]; *(LAS v4u*)(L + O_KD + (r0 + 32 * i) * 320 + c0 * 16) = tk[i]; }
        *(LAS v4u*)(L + O_VT + (tid >> 3) * 192 + (tid & 7) * 16) = tv;
        if (tid < 128) ((LAS float*)(L + O_DEC))[tid] = tdec;
        __syncthreads();
        if (n + 1 < 64) GLA_LOAD(n + 1);
        if (w < 4) {
            const int it = w >> 1;
            f32x16 o;
#pragma unroll
            for (int r = 0; r < 16; ++r) o[r] = 0.f;
            for (int jt = 0; jt <= it; ++jt) {
                f32x16 X;
#pragma unroll
                for (int r = 0; r < 16; ++r) X[r] = 0.f;
#pragma unroll
                for (int s = 0; s < 8; ++s) X = MFMA32(frag_row(L + O_KE, 272, 32 * jt, 16 * s, lane), frag_row(L + O_QE, 272, 32 * it, 16 * s, lane), X);
                if (jt == it) {
#pragma unroll
                    for (int r = 0; r < 16; ++r) if (crow(r, hh) > (lane & 31)) X[r] = 0.f;
                }
#pragma unroll
                for (int s2 = 0; s2 < 2; ++s2) o = MFMA32(pack_acc(X, s2), frag_tr<true>(L + O_VT, 192, 32 * jt + 16 * s2, 32 * et, lane), o);
            }
#pragma unroll
            for (int s = 0; s < 8; ++s) o = MFMA32(frag_row(L + O_QE, 272, 32 * it, 16 * s, lane), frag_tr<false>(L + O_SB, 192, 16 * s, 32 * et, lane), o);
            bf16* op = VB + (m0 + 32 * it) * 1024 + h * 256 + sl * 64 + 32 * et + (lane & 31);
#pragma unroll
            for (int r = 0; r < 16; ++r) op[(size_t)crow(r, hh) * 1024] = f2bf(o[r]);
        }
        {
#pragma unroll
            for (int s = 0; s < 4; ++s) S = MFMA32(frag_tr<false>(L + O_KD, 320, 16 * s, 32 * dt, lane), frag_tr<false>(L + O_VT, 192, 16 * s, 32 * et, lane), S);
#pragma unroll
            for (int r = 0; r < 16; ++r) S[r] *= ((LAS float*)(L + O_DEC))[32 * dt + crow(r, hh)];
        }
        __syncthreads();
#pragma unroll
        for (int r = 0; r < 16; ++r) *(LAS unsigned short*)(L + O_SB + (32 * dt + crow(r, hh)) * 192 + (32 * et + (lane & 31)) * 2) = f2bf(S[r]);
    }
#undef GLA_LOAD
    float* so = F.out + OUT_STP + ((size_t)(b * 4 + h) * 128 + 32 * dt) * 256 + sl * 64 + 32 * et + (lane & 31);
#pragma unroll
    for (int r = 0; r < 16; ++r) so[(size_t)crow(r, hh) * 256] = S[r];
    __syncthreads();
}

struct AttnItem { int b, h, g, r, dil, i0, cb; size_t tok0; };
__device__ __forceinline__ AttnItem attn_decode(int item) {
    AttnItem a; const int bh = item / 48, sub = item % 48; a.b = bh >> 3; a.h = bh & 7;
    int ibg;
    if (sub < 16) { a.g = 0; a.r = 0; ibg = sub; } else if (sub < 32) { a.g = 1; a.r = (sub - 16) >> 2; ibg = (sub - 16) & 3; } else { a.g = 2; a.r = sub - 32; ibg = 0; }
    a.dil = a.g == 0 ? 1 : (a.g == 1 ? 4 : 16); a.i0 = 256 * ibg; a.tok0 = (size_t)a.b * TSEQ + a.r; a.cb = a.g * 512 + a.h * 64;
    return a;
}
__device__ __forceinline__ void attn_issue(Frame& F, int item, v4u (&kk)[6], v4u (&vv)[6], bf16x8 (&qf)[4]) {
    LAUNDER_WS();
    const AttnItem a = attn_decode(item);
    const int tid = F.tid, lane = F.lane, w = F.wave, hh = lane >> 5, il = lane & 31;
    const bf16* QA = WSL(bf16, WS_QA); const bf16* KA = WSL(bf16, WS_KA); const bf16* VA = WSL(bf16, WS_VA);
    const size_t qtok = a.tok0 + (size_t)a.dil * (a.i0 + 32 * w + il);
#pragma unroll
    for (int s = 0; s < 4; ++s) qf[s] = *(const bf16x8*)(QA + qtok * 1536 + a.cb + 16 * s + 8 * hh);
#pragma unroll
    for (int p = 0; p < 6; ++p) { const int idx = tid + NTHR * p, rr = idx >> 3, ch = idx & 7, j = a.i0 - 128 + rr;
        if (j >= 0) { const size_t so = (a.tok0 + (size_t)a.dil * j) * 1536 + a.cb + ch * 8; vv[p] = *(const v4u*)(VA + so); kk[p] = *(const v4u*)(KA + so); } }
}
__device__ __forceinline__ void attn_prompt_item(Frame& F, int item, v4u (&kk)[6], v4u (&vv)[6], const bf16x8 (&qf)[4], bool has_next, int next_item, bf16x8 (&qn)[4]) {
    LAUNDER_WS();
    LAS unsigned char* L = F.lds;
    constexpr int O_V = 0, O_K = 384 * 192, O_LUT = O_K + 384 * 144;
    static_assert(O_LUT + 129 * 4 <= RING_BYTES, "attention LDS");
    const int tid = F.tid, lane = F.lane, w = F.wave, hh = lane >> 5, il = lane & 31;
    const AttnItem a = attn_decode(item);
    const int b = a.b, h = a.h, g = a.g, dil = a.dil, i0 = a.i0, cb = a.cb; const size_t tok0 = a.tok0; (void)b;
    bf16* QA = WSL(bf16, WS_QA); float* LSE = WSL(float, WS_LSE);
    const size_t qtok = tok0 + (size_t)dil * (i0 + 32 * w + il);
#pragma unroll
    for (int p = 0; p < 6; ++p) { const int idx = tid + NTHR * p, rr = idx >> 3, ch = idx & 7, j = i0 - 128 + rr;
        if (j >= 0) { *(LAS v4u*)(L + O_V + rr * 192 + ch * 16) = vv[p]; *(LAS v4u*)(L + O_K + rr * 144 + ch * 16) = kk[p]; } }
    if (tid < 129) ((LAS float*)(L + O_LUT))[tid] = WSL(float, WS_LUT)[(g * 8 + h) * 129 + tid];
    __syncthreads();
    if (has_next) attn_issue(F, next_item, kk, vv, qn);
    float mrun = NEG_BIG, lrun = 0.f;
    f32x16 O0, O1;
#pragma unroll
    for (int x = 0; x < 16; ++x) { O0[x] = 0.f; O1[x] = 0.f; }
#pragma unroll 1
    for (int kt = 0; kt < 5; ++kt) {
        const int jb = i0 + 32 * (w + kt) - 128;
        if (jb < 0) continue;
        f32x16 ST;
#pragma unroll
        for (int x = 0; x < 16; ++x) ST[x] = 0.f;
#pragma unroll
        for (int s = 0; s < 4; ++s) ST = MFMA32(frag_row(L + O_K, 144, 32 * (w + kt), 16 * s, lane), qf[s], ST);
        const int relb = 128 - 32 * kt + il;
        float tmax = NEG_BIG;
#pragma unroll
        for (int x = 0; x < 16; ++x) { const int rel = relb - crow(x, hh); const bool ok = rel >= 0 && rel <= 128; const int rc = rel < 0 ? 0 : (rel > 128 ? 128 : rel);
            const float sc = ok ? ST[x] + ((LAS float*)(L + O_LUT))[rc] : NEG_BIG; ST[x] = sc; tmax = fmaxf(tmax, sc); }
        tmax = fmaxf(tmax, __shfl_xor(tmax, 32));
        const float mnew = fmaxf(mrun, tmax), alpha = __expf(mrun - mnew);
        float ps = 0.f;
#pragma unroll
        for (int x = 0; x < 16; ++x) { const float p = __expf(ST[x] - mnew); ST[x] = p; ps += p; }
        lrun = lrun * alpha + ps; mrun = mnew;
#pragma unroll
        for (int x = 0; x < 16; ++x) { O0[x] *= alpha; O1[x] *= alpha; }
#pragma unroll
        for (int s2 = 0; s2 < 2; ++s2) { const bf16x8 pf = pack_acc(ST, s2);
            O0 = MFMA32(frag_tr<true>(L + O_V, 192, 32 * (w + kt) + 16 * s2, 0, lane), pf, O0);
            O1 = MFMA32(frag_tr<true>(L + O_V, 192, 32 * (w + kt) + 16 * s2, 32, lane), pf, O1); }
    }
    const float ltot = lrun + __shfl_xor(lrun, 32), inv = 1.0f / ltot;
    bf16* op = QA + qtok * 1536 + cb;
#pragma unroll
    for (int k4 = 0; k4 < 4; ++k4) { v2u a, c2;
        a.x = cvt_pk_bf16(O0[4 * k4] * inv, O0[4 * k4 + 1] * inv); a.y = cvt_pk_bf16(O0[4 * k4 + 2] * inv, O0[4 * k4 + 3] * inv);
        c2.x = cvt_pk_bf16(O1[4 * k4] * inv, O1[4 * k4 + 1] * inv); c2.y = cvt_pk_bf16(O1[4 * k4 + 2] * inv, O1[4 * k4 + 3] * inv);
        *(v2u*)(op + 8 * k4 + 4 * hh) = a; *(v2u*)(op + 32 + 8 * k4 + 4 * hh) = c2; }
    if (hh == 0) LSE[((size_t)g * MPAD + qtok) * 8 + h] = mrun + __logf(ltot);
    __syncthreads();
}

#define DPP_FA(x, ctrl) __uint_as_float((unsigned)__builtin_amdgcn_mov_dpp((int)__float_as_uint(x), (ctrl), 0xf, 0xf, true))
template <int G_> __device__ __forceinline__ void attn_sample_waveitem_g(Frame& F, int wi, const float* cache) {
    LAUNDER_WS();
    int lane = F.lane; asm volatile("" : "+v"(lane));
    const int grp = lane >> 4, l16 = lane & 15;
    constexpr int g = G_; const int h = (wi / 3) & 7, s = (wi / 24) & 3, b = wi / 96;
    constexpr int dil = g == 0 ? 1 : (g == 1 ? 4 : 16), Wb = 128 * dil;
    bf16* QA = WSL(bf16, WS_QA); const bf16* KA = WSL(bf16, WS_KA); const bf16* VA = WSL(bf16, WS_VA); float* LSE = WSL(float, WS_LSE);
    const size_t qrow = (size_t)NP + b * 4 + s; const int cb = g * 512 + h * 64;
    const v2u qu = *(const v2u*)(QA + qrow * 1536 + cb + 4 * l16);
    const float q0 = bf_lo(qu.x), q1 = bf_hi(qu.x), q2 = bf_lo(qu.y), q3 = bf_hi(qu.y);
    const float* lut = WSL(float, WS_LUT) + (g * 8 + h) * 129;
    const float* kc = cache + ((size_t)b * Wb * 2) * 512 + h * 64 + 4 * l16;
    const bf16* kn = KA + ((size_t)NP + b * 4) * 1536 + cb + 4 * l16; const bf16* vn = VA + ((size_t)NP + b * 4) * 1536 + cb + 4 * l16;
    float sc[33];
#pragma unroll
    for (int i0 = 0; i0 < 33; i0 += 11) { f32x4 kv[11]; float lb[11];
#pragma unroll
        for (int u = 0; u < 11; ++u) { const int jj = 4 * (i0 + u) + grp; kv[u] = (f32x4){0.f, 0.f, 0.f, 0.f}; lb[u] = 0.f;
            if (jj <= 128) { const int idx = Wb + s - jj * dil; lb[u] = lut[jj];
                if (idx >= Wb) { const v2u w2 = *(const v2u*)(kn + (size_t)(idx - Wb) * 1536); kv[u] = (f32x4){bf_lo(w2.x), bf_hi(w2.x), bf_lo(w2.y), bf_hi(w2.y)}; }
                else kv[u] = *(const f32x4*)(kc + (size_t)idx * 1024); } }
#pragma unroll
        for (int u = 0; u < 11; ++u) { const int jj = 4 * (i0 + u) + grp;
            float a = (q0 * kv[u][0] + q1 * kv[u][1]) + (q2 * kv[u][2] + q3 * kv[u][3]);
            a += DPP_FA(a, 0xB1); a += DPP_FA(a, 0x4E); a += DPP_FA(a, 0x141); a += DPP_FA(a, 0x128);
            sc[i0 + u] = jj <= 128 ? a + lb[u] : NEG_BIG; }
    }
    float mx = sc[0];
#pragma unroll
    for (int i = 1; i < 33; ++i) mx = fmaxf(mx, sc[i]);
    mx = fmaxf(mx, __shfl_xor(mx, 16)); mx = fmaxf(mx, __shfl_xor(mx, 32));
    float ps = 0.f;
#pragma unroll
    for (int i = 0; i < 33; ++i) { sc[i] = __expf(sc[i] - mx); ps += sc[i]; }
    ps += __shfl_xor(ps, 16); ps += __shfl_xor(ps, 32);
    f32x4 o = {0.f, 0.f, 0.f, 0.f};
#pragma unroll
    for (int i0 = 0; i0 < 33; i0 += 11) { f32x4 vv[11];
#pragma unroll
        for (int u = 0; u < 11; ++u) { const int jj = 4 * (i0 + u) + grp; vv[u] = (f32x4){0.f, 0.f, 0.f, 0.f};
            if (jj <= 128) { const int idx = Wb + s - jj * dil;
                if (idx >= Wb) { const v2u w2 = *(const v2u*)(vn + (size_t)(idx - Wb) * 1536); vv[u] = (f32x4){bf_lo(w2.x), bf_hi(w2.x), bf_lo(w2.y), bf_hi(w2.y)}; }
                else vv[u] = *(const f32x4*)(kc + (size_t)idx * 1024 + 512); } }
#pragma unroll
        for (int u = 0; u < 11; ++u) o += vv[u] * sc[i0 + u];
    }
#pragma unroll
    for (int k = 0; k < 4; ++k) { o[k] += __shfl_xor(o[k], 16); o[k] += __shfl_xor(o[k], 32); }
    const float inv = 1.0f / ps;
    if (grp == 0) { v2u w2; w2.x = cvt_pk_bf16(o[0] * inv, o[1] * inv); w2.y = cvt_pk_bf16(o[2] * inv, o[3] * inv); *(v2u*)(QA + qrow * 1536 + cb + 4 * l16) = w2; }
    if (lane == 0) LSE[((size_t)g * MPAD + qrow) * 8 + h] = mx + __logf(ps);
}

__device__ __forceinline__ void attn_sample_waveitem(Frame& F, int wi) {
    const int g = wi % 3;
    if (g == 0) attn_sample_waveitem_g<0>(F, wi, inptr(F, I_C1)); else if (g == 1) attn_sample_waveitem_g<1>(F, wi, inptr(F, I_C2)); else attn_sample_waveitem_g<2>(F, wi, inptr(F, I_C3));
}
__device__ __forceinline__ void gla_sample_item(Frame& F, int item) {
    LAUNDER_WS();
    LAS float* L = (LAS float*)F.lds;
    constexpr int O_LA = 0, O_QE = 512, O_KE = 1024, O_KD = 1536, O_DEC = 2048, O_ATT = 2176, O_PART = 2304;
    const int tid = F.tid, b = item >> 2, h = item & 3;
    const bf16* QB = WSL(bf16, WS_QB); const bf16* KB = WSL(bf16, WS_KB); bf16* VB = WSL(bf16, WS_VB); const float* AB = WSL(float, WS_AB);
    const size_t row0 = (size_t)NP + b * 4;
    { const int i = tid >> 7, d = tid & 127; float x = inptr(F, I_BG)[h * 128 + d]; const float* wg2 = inptr(F, I_WG2);
#pragma unroll
      for (int r = 0; r < 16; ++r) x += AB[(row0 + i) * 16 + r] * wg2[r * 512 + h * 128 + d];
      L[O_LA + i * 128 + d] = (fminf(x, 0.f) - log1pf(expf(-fabsf(x)))) * (1.0f / 16.0f); }
    __syncthreads();
    if (tid < 128) { const int d = tid; float bb[4]; float run = 0.f;
#pragma unroll
        for (int i = 0; i < 4; ++i) { run += L[O_LA + i * 128 + d]; bb[i] = run; }
        const float ebl = expf(run); L[O_DEC + d] = ebl;
#pragma unroll
        for (int i = 0; i < 4; ++i) { const float q = bf2f(QB[(row0 + i) * 512 + h * 128 + d]), k = bf2f(KB[(row0 + i) * 512 + h * 128 + d]);
            L[O_QE + i * 128 + d] = q * GLA_QSCALE * expf(bb[i]); L[O_KE + i * 128 + d] = k * expf(-bb[i]); L[O_KD + i * 128 + d] = k * expf(run - bb[i]); } }
    __syncthreads();
    if (tid < 16) { const int i = tid >> 2, j = tid & 3; float a = 0.f;
        if (j <= i) for (int d = 0; d < 128; ++d) a += L[O_QE + i * 128 + d] * L[O_KE + j * 128 + d];
        L[O_ATT + tid] = a; }
    const int e = tid & 255, dh = tid >> 8;
    float v[4];
#pragma unroll
    for (int j = 0; j < 4; ++j) v[j] = bf2f(VB[(row0 + j) * 1024 + h * 256 + e]);
    const float* Sin = inptr(F, I_ST0) + ((size_t)(b * 4 + h) * 128) * 256 + e; float* Sout = F.out + OUT_STS + ((size_t)(b * 4 + h) * 128) * 256 + e;
    float acc[4] = {0.f, 0.f, 0.f, 0.f};
#pragma unroll 1
    for (int dd0 = 0; dd0 < 64; dd0 += 16) { float svv[16];
#pragma unroll
        for (int u = 0; u < 16; ++u) svv[u] = Sin[(size_t)(dh * 64 + dd0 + u) * 256];
#pragma unroll
        for (int u = 0; u < 16; ++u) { const int d = dh * 64 + dd0 + u; const float sv = svv[u];
#pragma unroll
            for (int i = 0; i < 4; ++i) acc[i] += L[O_QE + i * 128 + d] * sv;
            float sn = L[O_DEC + d] * sv;
#pragma unroll
            for (int j = 0; j < 4; ++j) sn += L[O_KD + j * 128 + d] * v[j];
            Sout[(size_t)d * 256] = sn; } }
#pragma unroll
    for (int i = 0; i < 4; ++i) L[O_PART + (dh * 4 + i) * 256 + e] = acc[i];
    __syncthreads();
    if (tid < 256) {
#pragma unroll
        for (int i = 0; i < 4; ++i) { float o = L[O_PART + i * 256 + e] + L[O_PART + (4 + i) * 256 + e];
#pragma unroll
            for (int j = 0; j < 4; ++j) o += L[O_ATT + i * 4 + j] * v[j];
            VB[(row0 + i) * 1024 + h * 256 + e] = f2bf(o); } }
    __syncthreads();
}

static_assert(true, "");
constexpr int P2_ATT = 3072, P2_DEC = 384, P2_GLS = 128, P2_CPY = 32 * (2 + 8 + 32), P2_ITEMS = P2_ATT + P2_DEC + P2_GLS;
__device__ __forceinline__ void kvshift_item(Frame& F, int item) {
    int g, r = item; if (r < 64) g = 0; else if (r < 64 + 256) { g = 1; r -= 64; } else { g = 2; r -= 320; }
    const int Wb = g == 0 ? 128 : (g == 1 ? 512 : 2048), npc = Wb / 64, b = r / npc, pc = r % npc;
    const float* src = inptr(F, g == 0 ? I_C1 : (g == 1 ? I_C2 : I_C3)); float* dst = F.out + (g == 0 ? OUT_KVS1 : (g == 1 ? OUT_KVS2 : OUT_KVS3));
    const int nrow = (pc == npc - 1) ? 60 : 64;
    const f32x4* s4 = (const f32x4*)src + ((size_t)b * Wb + 64 * pc + 4) * 256; f32x4* d4 = (f32x4*)dst + ((size_t)b * Wb + 64 * pc) * 256;
    { const int i = F.tid; f32x4 v[32];
#pragma unroll
        for (int u = 0; u < 32; ++u) if (u < 30 || nrow == 64) v[u] = __builtin_nontemporal_load(s4 + i + u * NTHR);
#pragma unroll
        for (int u = 0; u < 32; ++u) if (u < 30 || nrow == 64) __builtin_nontemporal_store(v[u], d4 + i + u * NTHR); }
}
template <bool STOP_ON_GDONE> __device__ __forceinline__ void kvshift_loop(Frame& F) {
    for (;;) {
        if (F.tid == 0) { unsigned t = 0xffffffffu;
            if (!STOP_ON_GDONE || __hip_atomic_load(F.ctl + CW_GDONE, RLX_AGENT) == 0u) t = __hip_atomic_fetch_add(F.ctl + CW_CPYQ, 1u, RLX_AGENT);
            F.MISC[0] = t; }
        __syncthreads();
        const unsigned t = F.MISC[0];
        __syncthreads();
        if (t >= (unsigned)P2_CPY) break;
        kvshift_item(F, (int)t);
    }
}
__device__ __forceinline__ void p2_prep(Frame& F) {
    unsigned qa[8], ka[8], qb[8], kb[8]; float aa[2], ab2[2];
    int u = blockIdx.x; if (u >= 2048) return;
    const int d2 = F.tid & 63, h = u & 3;
    const float* wg2 = inptr(F, I_WG2); const float* bgp = inptr(F, I_BG);
    f32x2_t wg[16];
#pragma unroll
    for (int r = 0; r < 16; ++r) wg[r] = *(const f32x2_t*)(wg2 + r * 512 + h * 128 + 2 * d2);
    const f32x2_t bgd = *(const f32x2_t*)(bgp + h * 128 + 2 * d2);
    gla_prep_load(F, u, qa, ka, aa);
    for (;;) {
        const int u1 = u + F.G; if (u1 < 2048) gla_prep_load(F, u1, qb, kb, ab2);
        gla_prep_unit(F, u, qa, ka, aa, wg, bgd); if (u1 >= 2048) break;
        const int u2 = u1 + F.G; if (u2 < 2048) gla_prep_load(F, u2, qa, ka, aa);
        gla_prep_unit(F, u1, qb, kb, ab2, wg, bgd); if (u2 >= 2048) break;
        u = u2;
    }
}
__device__ __forceinline__ void p2_mixers(Frame& F) {
#if defined(PROBE_PHASE) && PROBE_PHASE >= 100
    const unsigned long long tp0 = __builtin_amdgcn_s_memrealtime();
#endif
#ifndef P2_SKIP_GLAP
    if (blockIdx.x < 128) {
        const int bx = blockIdx.x, bh = (bx & 7) + 8 * (bx >> 5), sl = (bx >> 3) & 3;
        gla_prompt_unit(F, bh >> 2, bh & 3, sl); }
#endif
#if defined(PROBE_PHASE) && PROBE_PHASE == 100
    if (blockIdx.x == 0) F.tp = __builtin_amdgcn_s_memrealtime() - tp0;
#endif
    constexpr int QCHUNK = 4;
    for (int it = 0, itend = 0;; ++it) {
        if (it >= itend) {
            if (F.tid == 0) F.MISC[0] = __hip_atomic_fetch_add(F.ctl + CW_QUEUE, (unsigned)QCHUNK, RLX_AGENT);
            __syncthreads();
            it = (int)F.MISC[0]; itend = it + QCHUNK;
            __syncthreads();
        }
        if (it >= P2_ITEMS) break;
#if defined(PROBE_PHASE) && PROBE_PHASE == 101
        if (blockIdx.x == 255) F.tp = __builtin_amdgcn_s_memrealtime() - tp0;
#endif
#if defined(PROBE_PHASE) && PROBE_PHASE == 102
        if (blockIdx.x == 255 && it >= P2_GLS + P2_DEC + P2_ATT && F.tp == 0ull) F.tp = __builtin_amdgcn_s_memrealtime() - tp0;
#endif
#if defined(PROBE_PHASE) && PROBE_PHASE >= 103 && PROBE_PHASE <= 106
        const unsigned long long ti0 = __builtin_amdgcn_s_memrealtime();
        const int pcls = it < P2_GLS ? 105 : (it < P2_GLS + P2_DEC ? 104 : (it < P2_GLS + P2_DEC + P2_ATT ? 103 : 106));
#endif
        if (it < P2_GLS) {
#ifndef P2_SKIP_GLAS
            gla_sample_item(F, it);
#endif
        } else if (it < P2_GLS + P2_DEC) {
#ifndef P2_SKIP_DEC
            attn_sample_waveitem(F, (it - P2_GLS) * 8 + F.wave); __syncthreads();
#endif
        } else if (it < P2_GLS + P2_DEC + P2_ATT) {
#ifndef P2_SKIP_ATT
            const int a0 = it - P2_GLS - P2_DEC;
            v4u kk[6], vv[6]; bf16x8 qa[4], qb[4];
            attn_issue(F, a0, kk, vv, qa);
            attn_prompt_item(F, a0, kk, vv, qa, true, a0 + 1, qb);
            attn_prompt_item(F, a0 + 1, kk, vv, qb, true, a0 + 2, qa);
            attn_prompt_item(F, a0 + 2, kk, vv, qa, true, a0 + 3, qb);
            attn_prompt_item(F, a0 + 3, kk, vv, qb, false, 0, qa);
            it = itend - 1;
#endif
        }
#if defined(PROBE_PHASE) && PROBE_PHASE >= 103 && PROBE_PHASE <= 106
        if (blockIdx.x == 255 && pcls == PROBE_PHASE) F.tp += __builtin_amdgcn_s_memrealtime() - ti0;
#endif
    }
#if defined(PROBE_PHASE) && PROBE_PHASE == 107
    const unsigned long long tc0 = __builtin_amdgcn_s_memrealtime();
#endif
    kvshift_loop<false>(F);
#if defined(PROBE_PHASE) && PROBE_PHASE == 107
    if (blockIdx.x == 255) F.tp = __builtin_amdgcn_s_memrealtime() - tc0;
#endif
}

__device__ __forceinline__ void p3_kvout(const bf16* K, const bf16* V, float* dst, int g, int W, int nb, size_t rowbase, int rows_per_b, int first, int pos0, int Wdst, size_t gt, size_t ngt) {
    const size_t per_b = (size_t)W * 2 * 64, tot = per_b * nb;
    for (size_t i0 = gt; i0 < tot; i0 += 4 * ngt) { v4u u[4]; float* o[4];
#pragma unroll
        for (int k = 0; k < 4; ++k) { const size_t i = i0 + k * ngt; if (i < tot) { const size_t b = i / per_b, r = i - b * per_b; const int p = (int)(r >> 7), c = (int)(r >> 6) & 1, ch = (int)r & 63;
            u[k] = *(const v4u*)((c ? V : K) + (rowbase + b * rows_per_b + first + p) * 1536 + g * 512 + ch * 8);
            o[k] = dst + ((b * Wdst + pos0 + p) * 2 + c) * 512 + ch * 8; } }
#pragma unroll
        for (int k = 0; k < 4; ++k) if (i0 + k * ngt < tot) {
            *(f32x4*)o[k] = (f32x4){bf_lo(u[k].x), bf_hi(u[k].x), bf_lo(u[k].y), bf_hi(u[k].y)}; *(f32x4*)(o[k] + 4) = (f32x4){bf_lo(u[k].z), bf_hi(u[k].z), bf_lo(u[k].w), bf_hi(u[k].w)}; } }
}
struct MergeRow { float l0, l1, l2; v4u a, b2, c, u0, u1, r0, r1; };
__device__ __forceinline__ void p3_merge_load(const bf16* OA, const bf16* OB, const bf16* RB, const float* LSE, int m, int lane, MergeRow& R) {
    const int hd = lane >> 3, c8 = (lane & 7) * 8, c0 = lane * 16;
    R.l0 = LSE[((size_t)0 * MPAD + m) * 8 + hd]; R.l1 = LSE[((size_t)1 * MPAD + m) * 8 + hd]; R.l2 = LSE[((size_t)2 * MPAD + m) * 8 + hd];
    R.a = *(const v4u*)(OA + (size_t)m * 1536 + hd * 64 + c8); R.b2 = *(const v4u*)(OA + (size_t)m * 1536 + 512 + hd * 64 + c8); R.c = *(const v4u*)(OA + (size_t)m * 1536 + 1024 + hd * 64 + c8);
    R.u0 = *(const v4u*)(OB + (size_t)m * 1024 + c0); R.u1 = *(const v4u*)(OB + (size_t)m * 1024 + c0 + 8);
    R.r0 = *(const v4u*)(RB + (size_t)m * 1024 + c0); R.r1 = *(const v4u*)(RB + (size_t)m * 1024 + c0 + 8);
}
__device__ __forceinline__ void p3_merge(Frame& F) {
    const int gw = blockIdx.x * NWAVES + F.wave, NGW = F.G * NWAVES, lane = F.lane;
    const size_t gt = (size_t)blockIdx.x * NTHR + F.tid, ngt = (size_t)F.G * NTHR;
    const bf16* OA = WSP(bf16, WS_QA); const bf16* OB = WSP(bf16, WS_VB); const bf16* RB = WSP(bf16, WS_RB); const float* LSE = WSP(float, WS_LSE);
    bf16* OAM = WSP(bf16, WS_OAM); bf16* OBN = WSP(bf16, WS_OBN); const float* gn = inptr(F, I_GN);
    float gnv[16];
#pragma unroll
    for (int i = 0; i < 16; ++i) gnv[i] = gn[lane * 16 + i];
    for (int m = NTOK + gw; m < MPAD; m += NGW) {
        *(v4u*)(OAM + (size_t)m * 512 + lane * 8) = (v4u){0u, 0u, 0u, 0u}; *(v4u*)(OBN + (size_t)m * 1024 + lane * 16) = (v4u){0u, 0u, 0u, 0u}; *(v4u*)(OBN + (size_t)m * 1024 + lane * 16 + 8) = (v4u){0u, 0u, 0u, 0u}; }
    int m = gw;
    if (m < NTOK) {
        MergeRow R, Rn; p3_merge_load(OA, OB, RB, LSE, m, lane, R);
        for (;;) {
            const int mn = m + NGW; const bool more = mn < NTOK;
            if (more) p3_merge_load(OA, OB, RB, LSE, mn, lane, Rn);
            {
                const int hd = lane >> 3, c8 = (lane & 7) * 8;
                const float l0 = R.l0, l1 = R.l1, l2 = R.l2;
                const float mx = fmaxf(l0, fmaxf(l1, l2)); float w0 = __expf(l0 - mx), w1 = __expf(l1 - mx), w2 = __expf(l2 - mx); const float iw = 1.0f / (w0 + w1 + w2); w0 *= iw; w1 *= iw; w2 *= iw;
                const v4u a = R.a, b2 = R.b2, c = R.c;
                v4u o;
                o.x = cvt_pk_bf16(w0 * bf_lo(a.x) + w1 * bf_lo(b2.x) + w2 * bf_lo(c.x), w0 * bf_hi(a.x) + w1 * bf_hi(b2.x) + w2 * bf_hi(c.x));
                o.y = cvt_pk_bf16(w0 * bf_lo(a.y) + w1 * bf_lo(b2.y) + w2 * bf_lo(c.y), w0 * bf_hi(a.y) + w1 * bf_hi(b2.y) + w2 * bf_hi(c.y));
                o.z = cvt_pk_bf16(w0 * bf_lo(a.z) + w1 * bf_lo(b2.z) + w2 * bf_lo(c.z), w0 * bf_hi(a.z) + w1 * bf_hi(b2.z) + w2 * bf_hi(c.z));
                o.w = cvt_pk_bf16(w0 * bf_lo(a.w) + w1 * bf_lo(b2.w) + w2 * bf_lo(c.w), w0 * bf_hi(a.w) + w1 * bf_hi(b2.w) + w2 * bf_hi(c.w));
                *(v4u*)(OAM + (size_t)m * 512 + hd * 64 + c8) = o;
            }
            {
                const int c0 = lane * 16;
                const v4u u0 = R.u0, u1 = R.u1, r0 = R.r0, r1 = R.r1;
                float x[16] = {bf_lo(u0.x), bf_hi(u0.x), bf_lo(u0.y), bf_hi(u0.y), bf_lo(u0.z), bf_hi(u0.z), bf_lo(u0.w), bf_hi(u0.w), bf_lo(u1.x), bf_hi(u1.x), bf_lo(u1.y), bf_hi(u1.y), bf_lo(u1.z), bf_hi(u1.z), bf_lo(u1.w), bf_hi(u1.w)};
                float rr[16] = {bf_lo(r0.x), bf_hi(r0.x), bf_lo(r0.y), bf_hi(r0.y), bf_lo(r0.z), bf_hi(r0.z), bf_lo(r0.w), bf_hi(r0.w), bf_lo(r1.x), bf_hi(r1.x), bf_lo(r1.y), bf_hi(r1.y), bf_lo(r1.z), bf_hi(r1.z), bf_lo(r1.w), bf_hi(r1.w)};
                float ss = 0.f;
#pragma unroll
                for (int i = 0; i < 16; ++i) ss += x[i] * x[i];
                ss += __shfl_xor(ss, 1); ss += __shfl_xor(ss, 2); ss += __shfl_xor(ss, 4); ss += __shfl_xor(ss, 8);
                const float rs = 1.0f / sqrtf(ss * (1.0f / 256.0f) + LN_EPS);
                float y[16];
#pragma unroll
                for (int i = 0; i < 16; ++i) { const float gte = rr[i] * __builtin_amdgcn_rcpf(1.0f + __expf(-rr[i])); y[i] = x[i] * rs * gnv[i] * gte; }
                v4u o0, o1; o0.x = cvt_pk_bf16(y[0], y[1]); o0.y = cvt_pk_bf16(y[2], y[3]); o0.z = cvt_pk_bf16(y[4], y[5]); o0.w = cvt_pk_bf16(y[6], y[7]);
                o1.x = cvt_pk_bf16(y[8], y[9]); o1.y = cvt_pk_bf16(y[10], y[11]); o1.z = cvt_pk_bf16(y[12], y[13]); o1.w = cvt_pk_bf16(y[14], y[15]);
                *(v4u*)(OBN + (size_t)m * 1024 + c0) = o0; *(v4u*)(OBN + (size_t)m * 1024 + c0 + 8) = o1;
            }
            if (!more) break;
            R = Rn; m = mn;
        }
    }
    const bf16* KA = WSP(bf16, WS_KA); const bf16* VA = WSP(bf16, WS_VA);
    p3_kvout(KA, VA, F.out + OUT_KVP1, 0, 128, 8, 0, TSEQ, TSEQ - 128, 0, 128, gt, ngt);
    p3_kvout(KA, VA, F.out + OUT_KVP2, 1, 512, 8, 0, TSEQ, TSEQ - 512, 0, 512, gt, ngt);
    p3_kvout(KA, VA, F.out + OUT_KVP3, 2, 2048, 8, 0, TSEQ, TSEQ - 2048, 0, 2048, gt, ngt);
    p3_kvout(KA, VA, F.out + OUT_KVS1, 0, 4, 32, NP, 4, 0, 124, 128, gt, ngt);
    p3_kvout(KA, VA, F.out + OUT_KVS2, 1, 4, 32, NP, 4, 0, 508, 512, gt, ngt);
    p3_kvout(KA, VA, F.out + OUT_KVS3, 2, 4, 32, NP, 4, 0, 2044, 2048, gt, ngt);
}

__device__ __forceinline__ void p6_ln1(Frame& F) {
    const int gw = blockIdx.x * NWAVES + F.wave, NGW = F.G * NWAVES, lane = F.lane;
    const bf16* HB = WSP(bf16, WS_HB); bf16* X1B = WSP(bf16, WS_X1B); const float* l1g = inptr(F, I_L1G); const float* l1b = inptr(F, I_L1B);
    f32x4 gg[4], bb[4];
#pragma unroll
    for (int j = 0; j < 4; ++j) { gg[j] = ((const f32x4*)l1g)[lane + 64 * j]; bb[j] = ((const f32x4*)l1b)[lane + 64 * j]; }
    int m = gw; if (m >= MPAD) return;
    f32x4 v[4], vn[4];
#pragma unroll
    for (int j = 0; j < 4; ++j) { const v2u t = ((const v2u*)(HB + (size_t)m * 1024) + lane)[64 * j]; v[j] = (f32x4){bf_lo(t.x), bf_hi(t.x), bf_lo(t.y), bf_hi(t.y)}; }
    for (;;) {
        const int mn = m + NGW; const bool more = mn < MPAD;
        if (more) {
#pragma unroll
            for (int j = 0; j < 4; ++j) { const v2u t = ((const v2u*)(HB + (size_t)mn * 1024) + lane)[64 * j]; vn[j] = (f32x4){bf_lo(t.x), bf_hi(t.x), bf_lo(t.y), bf_hi(t.y)}; } }
        float s = 0.f;
#pragma unroll
        for (int j = 0; j < 4; ++j) s += (v[j][0] + v[j][1]) + (v[j][2] + v[j][3]);
        const float mean = wave_sum(s) * (1.f / 1024.f); float s2 = 0.f;
#pragma unroll
        for (int j = 0; j < 4; ++j) { v[j] = v[j] - mean; s2 += (v[j][0] * v[j][0] + v[j][1] * v[j][1]) + (v[j][2] * v[j][2] + v[j][3] * v[j][3]); }
        const float rstd = 1.f / sqrtf(wave_sum(s2) * (1.f / 1024.f) + LN_EPS);
        unsigned long long* o8 = (unsigned long long*)(X1B + (size_t)m * 1024) + lane;
#pragma unroll
        for (int j = 0; j < 4; ++j) { const f32x4 y = v[j] * rstd * gg[j] + bb[j];
            o8[64 * j] = (unsigned long long)cvt_pk_bf16(y[0], y[1]) | ((unsigned long long)cvt_pk_bf16(y[2], y[3]) << 32); }
        if (!more) break;
#pragma unroll
        for (int j = 0; j < 4; ++j) v[j] = vn[j];
        m = mn;
    }
}

__device__ __forceinline__ unsigned mono_key(float f) { const unsigned u = __float_as_uint(f); return u ^ ((unsigned)((int)u >> 31) | 0x80000000u); }
__device__ __forceinline__ float mono_inv(unsigned k) { return __uint_as_float((k & 0x80000000u) ? (k ^ 0x80000000u) : ~k); }
#define CE_DESC(a, b) do { const unsigned _mx = (a) > (b) ? (a) : (b), _mn = (a) > (b) ? (b) : (a); (a) = _mx; (b) = _mn; } while (0)
template <int J> __device__ __forceinline__ void bitonic_step_desc(unsigned (&v)[16]) {
#pragma unroll
    for (int i = 0; i < 16; ++i) if ((i & J) == 0) CE_DESC(v[i], v[i | J]);
}
template <int K, int J> __device__ __forceinline__ void bitonic_step(unsigned (&v)[16]) {
#pragma unroll
    for (int i = 0; i < 16; ++i) if ((i & J) == 0) { if ((i & K) == 0) CE_DESC(v[i], v[i | J]); else CE_DESC(v[i | J], v[i]); }
}
__device__ __forceinline__ void sort16_desc(unsigned (&v)[16]) {
    bitonic_step<2, 1>(v);
    bitonic_step<4, 2>(v); bitonic_step<4, 1>(v);
    bitonic_step<8, 4>(v); bitonic_step<8, 2>(v); bitonic_step<8, 1>(v);
    bitonic_step_desc<8>(v); bitonic_step_desc<4>(v); bitonic_step_desc<2>(v); bitonic_step_desc<1>(v);
}
__device__ __forceinline__ void merge16_desc(unsigned (&T)[16], const unsigned (&N)[16]) {
#pragma unroll
    for (int k = 0; k < 16; ++k) T[k] = T[k] > N[15 - k] ? T[k] : N[15 - k];
    bitonic_step_desc<8>(T); bitonic_step_desc<4>(T); bitonic_step_desc<2>(T); bitonic_step_desc<1>(T);
}
__device__ __forceinline__ void merge_partner16(unsigned (&T)[16]) {
    unsigned P[16];
#pragma unroll
    for (int k = 0; k < 16; ++k) P[k] = (unsigned)__shfl_xor((int)T[k], 32);
    merge16_desc(T, P);
}
__device__ __forceinline__ void p8_topk_item(Frame& F, int item) {
    const int lane = F.lane, hh = lane >> 5, il = lane & 31;
    const int tb = item >> 3, hd = item & 7; const int row = 32 * tb + il;
    const bf16* QN = WSP(bf16, WS_QN); const bf16* KEYS = WSP(bf16, WS_KEYS); int* EIDX = WSP(int, WS_EIDX); float* GATE = WSP(float, WS_GATE);
    LAS unsigned* LK = (LAS unsigned*)(F.lds + F.wave * 8192);
    unsigned T1[16], T2[16];
    bf16x8 bqh[2][8], kf[8];
#pragma unroll
    for (int half = 0; half < 2; ++half)
#pragma unroll
        for (int s = 0; s < 8; ++s) bqh[half][s] = *(const bf16x8*)(QN + (size_t)row * 2048 + hd * 256 + half * 128 + 16 * s + 8 * hh);
#pragma unroll
    for (int s = 0; s < 8; ++s) kf[s] = *(const bf16x8*)(KEYS + ((size_t)(hd * 2) * 128 + il) * 128 + 8 * hh + 16 * s);
#pragma unroll
    for (int half = 0; half < 2; ++half) {
        const bf16x8 (&bq)[8] = bqh[half];
        unsigned T[16];
#pragma unroll
        for (int k = 0; k < 16; ++k) T[k] = 0u;
        const bf16* kbase = KEYS + ((size_t)(hd * 2 + half) * 128 + il) * 128 + 8 * hh;
#pragma unroll 1
        for (int kt = 0; kt < 4; ++kt) {
            f32x16 acc;
#pragma unroll
            for (int x = 0; x < 16; ++x) acc[x] = 0.f;
#pragma unroll
            for (int s = 0; s < 8; ++s) acc = MFMA32(kf[s], bq[s], acc);
            if (kt < 3 || half == 0) {
                const bf16* kn = kt < 3 ? kbase + (size_t)(32 * (kt + 1)) * 128 : kbase + (size_t)128 * 128;
#pragma unroll
                for (int s = 0; s < 8; ++s) kf[s] = *(const bf16x8*)(kn + 16 * s); }
            unsigned N[16];
#pragma unroll
            for (int x = 0; x < 16; ++x) { const int idx = 32 * kt + crow(x, hh); N[x] = (mono_key(acc[x]) & ~127u) | (unsigned)(127 - idx); }
            sort16_desc(N);
            merge16_desc(T, N);
        }
        merge_partner16(T);
#pragma unroll
        for (int k = 0; k < 16; ++k) { LK[(half * 16 + k) * 64 + lane] = T[k]; if (half == 0) T1[k] = T[k]; else T2[k] = T[k]; }
    }
    float v1s[8], v2[16];
#pragma unroll
    for (int k = 0; k < 16; ++k) v2[k] = mono_inv(T2[k] & ~127u);
#pragma unroll
    for (int i2 = 0; i2 < 8; ++i2) v1s[i2] = mono_inv((hh ? T1[2 * i2 + 1] : T1[2 * i2]) & ~127u);
    unsigned C[16], D[16];
#pragma unroll
    for (int k = 0; k < 16; ++k) { C[k] = 0u; D[k] = 0u; }
    {   int n = 0;
#pragma unroll
        for (int i2 = 0; i2 < 8; ++i2)
#pragma unroll
            for (int c = 0; c < 16; ++c) if ((2 * i2 + 1) * (c + 1) <= 16) { const unsigned key = (mono_key(v1s[i2] + v2[c]) & ~255u) | (unsigned)(255 - (16 * (2 * i2 + hh) + c));
                if (n < 16) C[n] = key; else D[n - 16] = key; ++n; }
    }
    sort16_desc(C); sort16_desc(D); merge16_desc(C, D);
    merge_partner16(C);
    LDS_WAIT(); asm volatile("" ::: "memory");
    float sv[16]; int ex[16]; float mx = NEG_BIG;
#pragma unroll
    for (int k = 0; k < 16; ++k) { const int si = 255 - (int)(C[k] & 255u), a = si >> 4, c = si & 15;
        const unsigned k1 = LK[a * 64 + lane], k2 = LK[(16 + c) * 64 + lane];
        ex[k] = (127 - (int)(k1 & 127u)) * 128 + (127 - (int)(k2 & 127u)); sv[k] = mono_inv(k1 & ~127u) + mono_inv(k2 & ~127u); mx = fmaxf(mx, sv[k]); }
    float den = 0.f;
#pragma unroll
    for (int k = 0; k < 16; ++k) { sv[k] = __expf(sv[k] - mx); den += sv[k]; }
    const float iden = 1.0f / den;
    if (hh == 0 && row < NTOK) {
#pragma unroll
        for (int k4 = 0; k4 < 4; ++k4) { *(int4*)(EIDX + (size_t)row * 128 + hd * 16 + 4 * k4) = make_int4(ex[4 * k4], ex[4 * k4 + 1], ex[4 * k4 + 2], ex[4 * k4 + 3]);
            *(f32x4*)(GATE + (size_t)row * 128 + hd * 16 + 4 * k4) = (f32x4){sv[4 * k4] * iden, sv[4 * k4 + 1] * iden, sv[4 * k4 + 2] * iden, sv[4 * k4 + 3] * iden}; } }
    LDS_WAIT(); asm volatile("" ::: "memory");
}

constexpr size_t WS_ACTP = WS_QB, WS_COEF = WS_KA, WS_PEERO = WS_RB, WS_X1H = WS_VA;
static_assert(WS_ACTP + (size_t)8 * NTOK * 128 * 4 <= WS_RB && WS_PEERO + (size_t)NTOK * 1024 * 4 <= WS_GB, "peer buffers");
__device__ __forceinline__ float gelu_erf(float x) { return 0.5f * x * (1.0f + erff(x * 0.70710678118654752f)); }
#define DPP_F(x, ctrl) __uint_as_float((unsigned)__builtin_amdgcn_mov_dpp((int)__float_as_uint(x), (ctrl), 0xf, 0xf, true))
__device__ __forceinline__ float dot16_fp8(const float (&x)[16], const v4u u) {
    float a = 0.f;
#pragma unroll
    for (int q = 0; q < 4; ++q) { const f32x2_t lo = __builtin_amdgcn_cvt_pk_f32_fp8((int)u[q], false), hi = __builtin_amdgcn_cvt_pk_f32_fp8((int)u[q], true);
        a += x[4 * q] * lo.x + x[4 * q + 1] * lo.y + x[4 * q + 2] * hi.x + x[4 * q + 3] * hi.y; }
    return a;
}
typedef float f32x4_t __attribute__((ext_vector_type(4)));
typedef int i32x4_t __attribute__((ext_vector_type(4)));
#ifndef PEER_CVT_VIA_F32
#define PEER_CVT_VIA_F32 0
#endif
#ifndef PEER_DOT_F32
#define PEER_DOT_F32 0
#endif
#if PEER_DOT_F32
#define PEER_DOT2(d, a, b) do { const h2_t a__ = (a), b__ = (b); d += (float)a__.x * (float)b__.x + (float)a__.y * (float)b__.y; } while (0)
#else
#define PEER_DOT2(d, a, b) d = __builtin_amdgcn_fdot2((a), (b), d, false)
#endif
template <bool HI> __device__ __forceinline__ h2_t fp8x2_to_h2(int w) {
#if PEER_CVT_VIA_F32
    const f32x2_t f = __builtin_amdgcn_cvt_pk_f32_fp8(w, HI); return (h2_t){(_Float16)f.x, (_Float16)f.y};
#else
    return __builtin_amdgcn_cvt_scalef32_pk_f16_fp8(w, 1.0f, HI);
#endif
}
template <unsigned EMASK> __device__ __forceinline__ void peer_u_phase_t(Frame& F) {
    const int lane = F.lane, p = lane >> 3, q = lane & 7, c = blockIdx.x & 7, wv = (blockIdx.x >> 3) * NWAVES + F.wave, nwv = (F.G >> 3) * NWAVES;
    const int* EIDX = WSP(int, WS_EIDX) + 16 * p; float* ACTP = WSP(float, WS_ACTP) + (size_t)c * NTOK * 128 + 16 * p + 2 * q;
    const unsigned char* U8 = WSP(unsigned char, WS_UT) + ((size_t)c * 16384 << 7) + 16 * q;
#define PU_LOADE(EV, M) do { _Pragma("unroll") for (int t_ = 0; t_ < 4; ++t_) EV[t_] = *(const i32x4_t*)(EIDX + (size_t)(M) * 128 + 4 * t_); } while (0)
#define PU_ISSUE(UR, EV) do { _Pragma("unroll") for (int g = 0; g < 16; ++g) UR[g] = *(const v4u*)(U8 + (((unsigned)EV[g >> 2][g & 3] & EMASK) << 7)); } while (0)
#define PU_BODY(UR, UN, M) do { const int m_ = (M); const int m1_ = m_ + nwv, m2_ = m_ + 2 * nwv; \
        if (m1_ < NTOK) PU_ISSUE(UN, ev); \
        if (m2_ < NTOK) PU_LOADE(ev, m2_); \
        const bf16* xf_ = (const bf16*)(F.ws + WS_X1B) + (size_t)m_ * 1024 + 128 * c + 16 * q; \
        const v4u xa_ = *(const v4u*)xf_, xb_ = *(const v4u*)(xf_ + 8); \
        const h2_t xh[8] = {(h2_t){(_Float16)bf_lo(xa_.x), (_Float16)bf_hi(xa_.x)}, (h2_t){(_Float16)bf_lo(xa_.y), (_Float16)bf_hi(xa_.y)}, (h2_t){(_Float16)bf_lo(xa_.z), (_Float16)bf_hi(xa_.z)}, (h2_t){(_Float16)bf_lo(xa_.w), (_Float16)bf_hi(xa_.w)}, \
                            (h2_t){(_Float16)bf_lo(xb_.x), (_Float16)bf_hi(xb_.x)}, (h2_t){(_Float16)bf_lo(xb_.y), (_Float16)bf_hi(xb_.y)}, (h2_t){(_Float16)bf_lo(xb_.z), (_Float16)bf_hi(xb_.z)}, (h2_t){(_Float16)bf_lo(xb_.w), (_Float16)bf_hi(xb_.w)}}; \
        float a[16]; \
        _Pragma("unroll") for (int g = 0; g < 16; ++g) { float d_ = 0.f; \
            _Pragma("unroll") for (int t_ = 0; t_ < 4; ++t_) { PEER_DOT2(d_, fp8x2_to_h2<false>((int)UR[g][t_]), xh[2 * t_]); PEER_DOT2(d_, fp8x2_to_h2<true>((int)UR[g][t_]), xh[2 * t_ + 1]); } \
            a[g] = d_; if ((g & 1) == 1 && g < 15) asm volatile("" : "+v"(a[g - 1]), "+v"(a[g]), "+v"(UR[(g + 1) & 15]), "+v"(UR[(g + 2) & 15])); } \
        float b8[8], b4[4], b2[2]; \
        { const bool up = (q & 4) != 0; _Pragma("unroll") for (int k = 0; k < 8; ++k) { const float send = up ? a[k] : a[k + 8], keep = up ? a[k + 8] : a[k]; b8[k] = keep + DPP_F(send, 0x141); } } \
        { const bool up = (q & 2) != 0; _Pragma("unroll") for (int k = 0; k < 4; ++k) { const float send = up ? b8[k] : b8[k + 4], keep = up ? b8[k + 4] : b8[k]; b4[k] = keep + DPP_F(send, 0x4E); } } \
        { const bool up = (q & 1) != 0; _Pragma("unroll") for (int k = 0; k < 2; ++k) { const float send = up ? b4[k] : b4[k + 2], keep = up ? b4[k + 2] : b4[k]; b2[k] = keep + DPP_F(send, 0xB1); } } \
        *(f32x2_t*)(ACTP + (size_t)m_ * 128) = (f32x2_t){b2[0], b2[1]}; } while (0)
    int m = wv; if (m >= NTOK) return;
    i32x4_t ev[4];
    PU_LOADE(ev, m);
    v4u ua[16], ub[16];
    PU_ISSUE(ua, ev);
    if (m + nwv < NTOK) PU_LOADE(ev, m + nwv);
    for (;;) {
        PU_BODY(ua, ub, m); m += nwv; if (m >= NTOK) break;
        PU_BODY(ub, ua, m); m += nwv; if (m >= NTOK) break;
    }
#undef PU_LOADE
#undef PU_ISSUE
#undef PU_BODY
}
__device__ __forceinline__ void peer_u_phase(Frame& F) { peer_u_phase_t<0xffffffffu>(F); }
__device__ __forceinline__ void peer_coef_phase(Frame& F) {
    const int gw = blockIdx.x * NWAVES + F.wave, NGW = F.G * NWAVES, lane = F.lane;
    const float* ACTP = WSP(float, WS_ACTP); const float* GATE = WSP(float, WS_GATE); float* COEF = WSP(float, WS_COEF);
    int m = gw; if (m >= NTOK) return;
    float av[2][8], gv[2], an[2][8], gnx[2];
#pragma unroll
    for (int hf = 0; hf < 2; ++hf) { const int k = lane + 64 * hf; gv[hf] = GATE[(size_t)m * 128 + k];
#pragma unroll
        for (int c = 0; c < 8; ++c) av[hf][c] = ACTP[((size_t)c * NTOK + m) * 128 + k]; }
    for (;;) {
        const int mn = m + NGW; const bool more = mn < NTOK;
        if (more) {
#pragma unroll
            for (int hf = 0; hf < 2; ++hf) { const int k = lane + 64 * hf; gnx[hf] = GATE[(size_t)mn * 128 + k];
#pragma unroll
                for (int c = 0; c < 8; ++c) an[hf][c] = ACTP[((size_t)c * NTOK + mn) * 128 + k]; } }
#pragma unroll
        for (int hf = 0; hf < 2; ++hf) { const int k = lane + 64 * hf; float a = 0.f;
#pragma unroll
            for (int c = 0; c < 8; ++c) a += av[hf][c];
            COEF[(size_t)m * 128 + k] = gv[hf] * gelu_erf(a * (1.0f / U_SCALE)); }
        if (!more) break;
#pragma unroll
        for (int hf = 0; hf < 2; ++hf) { gv[hf] = gnx[hf];
#pragma unroll
            for (int c = 0; c < 8; ++c) av[hf][c] = an[hf][c]; }
        m = mn;
    }
}
__device__ __forceinline__ void peer_v_phase(Frame& F) {
    const int lane = F.lane, p = lane >> 3, q = lane & 7, c = blockIdx.x & 7, wv = (blockIdx.x >> 3) * NWAVES + F.wave, nwv = (F.G >> 3) * NWAVES;
    const int* EIDX = WSP(int, WS_EIDX) + 16 * p; const float* COEF = WSP(float, WS_COEF) + 16 * p; bf16* PEERO = WSP(bf16, WS_PEERO) + 128 * c + 16 * q + 2 * p;
    const unsigned char* V8 = WSP(unsigned char, WS_VT) + ((size_t)c * 16384 << 7) + 16 * q;
    int m = wv; if (m >= NTOK) return;
    i32x4_t ev[4];
#pragma unroll
    for (int t = 0; t < 4; ++t) ev[t] = *(const i32x4_t*)(EIDX + (size_t)m * 128 + 4 * t);
    v4u vr[16];
#pragma unroll
    for (int g = 0; g < 16; ++g) vr[g] = *(const v4u*)(V8 + ((unsigned)ev[g >> 2][g & 3] << 7));
    for (;;) {
        f32x4_t cv[4];
#pragma unroll
        for (int t = 0; t < 4; ++t) cv[t] = *(const f32x4_t*)(COEF + (size_t)m * 128 + 4 * t);
        const int mn = m + nwv; const bool more = mn < NTOK;
        if (more) {
#pragma unroll
            for (int t = 0; t < 4; ++t) ev[t] = *(const i32x4_t*)(EIDX + (size_t)mn * 128 + 4 * t); }
        h2_t acc[8];
#pragma unroll
        for (int i = 0; i < 8; ++i) acc[i] = (h2_t){(_Float16)0.f, (_Float16)0.f};
#pragma unroll
        for (int g = 0; g < 16; ++g) { const _Float16 cfh = (_Float16)cv[g >> 2][g & 3]; const h2_t cf2 = {cfh, cfh};
#pragma unroll
            for (int t = 0; t < 4; ++t) { acc[2 * t] += fp8x2_to_h2<false>((int)vr[g][t]) * cf2; acc[2 * t + 1] += fp8x2_to_h2<true>((int)vr[g][t]) * cf2; }
            if ((g & 3) == 3 && g < 15) asm volatile("" : "+v"(acc[0]), "+v"(acc[1]), "+v"(acc[2]), "+v"(acc[3]), "+v"(acc[4]), "+v"(acc[5]), "+v"(acc[6]), "+v"(acc[7]), "+v"(vr[(g + 1) & 15]), "+v"(vr[(g + 2) & 15]), "+v"(vr[(g + 3) & 15]), "+v"(vr[(g + 4) & 15])); }
        __builtin_amdgcn_sched_barrier(0);
        if (more) {
#pragma unroll
            for (int g = 0; g < 16; ++g) vr[g] = *(const v4u*)(V8 + ((unsigned)ev[g >> 2][g & 3] << 7)); }
        __builtin_amdgcn_sched_barrier(0);
        unsigned w[8];
#pragma unroll
        for (int i = 0; i < 8; ++i) w[i] = __builtin_bit_cast(unsigned, acc[i]);
        h2_t r4[4], r2[2], r1;
        { const bool up = (lane & 32) != 0;
#pragma unroll
          for (int k = 0; k < 4; ++k) { const unsigned send = up ? w[k] : w[k + 4], keep = up ? w[k + 4] : w[k]; r4[k] = __builtin_bit_cast(h2_t, keep) + __builtin_bit_cast(h2_t, (unsigned)__shfl_xor((int)send, 32)); } }
        { const bool up = (lane & 16) != 0;
#pragma unroll
          for (int k = 0; k < 2; ++k) { const unsigned a_ = __builtin_bit_cast(unsigned, r4[k]), b_ = __builtin_bit_cast(unsigned, r4[k + 2]); const unsigned send = up ? a_ : b_, keep = up ? b_ : a_; r2[k] = __builtin_bit_cast(h2_t, keep) + __builtin_bit_cast(h2_t, (unsigned)__shfl_xor((int)send, 16)); } }
        { const bool up = (lane & 8) != 0; const unsigned a_ = __builtin_bit_cast(unsigned, r2[0]), b_ = __builtin_bit_cast(unsigned, r2[1]); const unsigned send = up ? a_ : b_, keep = up ? b_ : a_;
          r1 = __builtin_bit_cast(h2_t, keep) + __builtin_bit_cast(h2_t, (unsigned)__builtin_amdgcn_mov_dpp((int)send, 0x128, 0xf, 0xf, true)); }
        *(unsigned*)(PEERO + (size_t)m * 1024) = cvt_pk_bf16((float)r1.x * (1.0f / V_SCALE), (float)r1.y * (1.0f / V_SCALE));
        if (!more) break;
        m = mn;
    }
}
__device__ __forceinline__ void peer_ln2_phase(Frame& F) {
    const int gw = blockIdx.x * NWAVES + F.wave, NGW = F.G * NWAVES, lane = F.lane;
    const bf16* X1 = WSP(bf16, WS_X1B); const bf16* PEERO = WSP(bf16, WS_PEERO); const float* l2g = inptr(F, I_L2G); const float* l2b = inptr(F, I_L2B);
    f32x4 gg[4], bb[4];
#pragma unroll
    for (int t = 0; t < 4; ++t) { gg[t] = *(const f32x4*)(l2g + 4 * lane + 256 * t); bb[t] = *(const f32x4*)(l2b + 4 * lane + 256 * t); }
    int m = gw; if (m >= NTOK) return;
    v2u xa[4], xn[4]; v2u pa[4], pn[4];
#pragma unroll
    for (int t = 0; t < 4; ++t) { xa[t] = *(const v2u*)(X1 + (size_t)m * 1024 + 4 * lane + 256 * t); pa[t] = *(const v2u*)(PEERO + (size_t)m * 1024 + 4 * lane + 256 * t); }
    for (;;) {
        const int mn = m + NGW; const bool more = mn < NTOK;
        if (more) {
#pragma unroll
            for (int t = 0; t < 4; ++t) { xn[t] = *(const v2u*)(X1 + (size_t)mn * 1024 + 4 * lane + 256 * t); pn[t] = *(const v2u*)(PEERO + (size_t)mn * 1024 + 4 * lane + 256 * t); } }
        float acc[16]; float s = 0.f;
#pragma unroll
        for (int t = 0; t < 4; ++t) { const float pz[4] = {bf_lo(pa[t].x), bf_hi(pa[t].x), bf_lo(pa[t].y), bf_hi(pa[t].y)};
            const float xz[4] = {bf_lo(xa[t].x), bf_hi(xa[t].x), bf_lo(xa[t].y), bf_hi(xa[t].y)};
#pragma unroll
            for (int i = 0; i < 4; ++i) { acc[4 * t + i] = ALPHA * xz[i] + pz[i]; s += acc[4 * t + i]; } }
        const float mean = wave_sum(s) * (1.f / 1024.f); float s2 = 0.f;
#pragma unroll
        for (int i = 0; i < 16; ++i) { acc[i] -= mean; s2 += acc[i] * acc[i]; }
        const float rstd = 1.f / sqrtf(wave_sum(s2) * (1.f / 1024.f) + LN_EPS);
        float* yo = m < NP ? F.out + OUT_YP + (size_t)m * 1024 : F.out + OUT_YS + (size_t)(m - NP) * 1024;
#pragma unroll
        for (int t = 0; t < 4; ++t) { const int cc = 4 * lane + 256 * t;
            *(f32x4*)(yo + cc) = (f32x4){acc[4 * t] * rstd * gg[t][0] + bb[t][0], acc[4 * t + 1] * rstd * gg[t][1] + bb[t][1], acc[4 * t + 2] * rstd * gg[t][2] + bb[t][2], acc[4 * t + 3] * rstd * gg[t][3] + bb[t][3]}; }
        if (!more) break;
#pragma unroll
        for (int t = 0; t < 4; ++t) { xa[t] = xn[t]; pa[t] = pn[t]; }
        m = mn;
    }
}

template <class Epi> __device__ __forceinline__ void skinny_sample_gemm(Frame& F, const bf16* A, const bf16* Bt, int K, const Epi& epi) {
    typedef float f32x4a __attribute__((ext_vector_type(4)));
    const int lane = F.lane, r = lane & 15, kg = lane >> 4;
    for (int strip = blockIdx.x; strip < 64; strip += F.G) {
        const bf16* ap = A + (size_t)(NP + 16 * F.wave + r) * K + 8 * kg;
        const bf16* bp = Bt + (size_t)(16 * strip + r) * K + 8 * kg;
        f32x4a acc = {0.f, 0.f, 0.f, 0.f};
        for (int s0 = 0; s0 < K / 32; s0 += 16) { bf16x8 af[16], bfr[16];
#pragma unroll
            for (int u = 0; u < 16; ++u) { af[u] = *(const bf16x8*)(ap + 32 * (s0 + u)); bfr[u] = *(const bf16x8*)(bp + 32 * (s0 + u)); }
#pragma unroll
            for (int u = 0; u < 16; ++u) acc = __builtin_amdgcn_mfma_f32_16x16x32_bf16(af[u], bfr[u], acc, 0, 0, 0); }
#pragma unroll
        for (int i = 0; i < 4; ++i) epi(NP + 16 * F.wave + 4 * kg + i, 16 * strip + r, acc[i]);
    }
}

struct Args { const float* in[22]; float* out; unsigned char* ws; int ph_lo, ph_hi; };
constexpr int NPHASE = 14;
__global__ void __launch_bounds__(NTHR, 2) mk_fwd(Args args) {
    extern __shared__ __attribute__((aligned(16))) unsigned char lds[];
    Frame F;
    F.lds = (LAS unsigned char*)lds; F.MISC = (volatile LAS unsigned*)(F.lds + MISC_OFF);
    F.tid = threadIdx.x; F.lane = F.tid & 63; F.wave = __builtin_amdgcn_readfirstlane(F.tid >> 6); F.G = gridDim.x;
    F.ws = args.ws; F.out = args.out; F.ctl = (gu32*)(args.ws + WS_CTL); F.tp = 0ull;
    for (int u = F.tid; u < (LDS_BYTES - MISC_OFF) / 4; u += NTHR) ((LAS unsigned*)(F.lds + MISC_OFF))[u] = 0u;
    __syncthreads();
    if (F.tid < 22) ((LAS unsigned long long*)(F.lds + PTR_OFF))[F.tid] = (unsigned long long)args.in[F.tid];
    __syncthreads();
    const int lo = args.ph_lo, hi = args.ph_hi;
    const bool multi = (hi - lo) > 1;
    XcdBarrier bar; bar.bar = (unsigned*)(F.ctl + CW_BAR); bar.x = 0; bar.st = nullptr;
    if (multi) bar = xcd_barrier_post((unsigned*)(F.ctl + CW_BAR), F.MISC + 8);
#ifdef ONLY_PHASE
#define IN(k) ((k) == ONLY_PHASE && lo <= (k) && (k) < hi)
#else
#define IN(k) (lo <= (k) && (k) < hi)
#endif
#ifdef PROBE_PHASE
    unsigned long long t_prev = __builtin_amdgcn_s_memrealtime(), t_probe = 0ull;
#define STAMP(k) do { const unsigned long long _t = __builtin_amdgcn_s_memrealtime(); if ((k) == PROBE_PHASE && blockIdx.x == 0) t_probe = _t - t_prev; t_prev = _t; } while (0)
#else
#define STAMP(k) do { } while (0)
#endif
#define SEAM(k) do { if (IN(k) && IN((k) + 1)) xcd_barrier(bar); STAMP(k); } while (0)
    if (IN(0)) { p0_prologue(F); }
    if (IN(0) && IN(1)) { cooperative_groups::this_grid().sync(); } STAMP(0);
    if (IN(1)) {
        if ((int)blockIdx.x >= F.G - NCOPYWG) kvshift_loop<true>(F);
        else {
        pg8::Gemm g{WSP(bf16, WS_XB), WSP(bf16, WS_WIN), MPAD, NPROJ, 1024, MPAD / 256 - 1}; pg8::StaticOrder S; S.init(MPAD, NPROJ, F.G - NCOPYWG, (int)blockIdx.x);
        pg8::EpiProj E{WSP(bf16, WS_QA), WSP(bf16, WS_KA), WSP(bf16, WS_VA), WSP(bf16, WS_QB), WSP(bf16, WS_KB), WSP(bf16, WS_VB), WSP(bf16, WS_RB), WSP(bf16, WS_GA), WSP(bf16, WS_GB)};
        pg8::gemm_phase<pg8::EpiProj, pg8::StaticOrder, true, true>(F.lds, g, S, E);
        if (F.tid == 0) __hip_atomic_fetch_add(F.ctl + CW_GDONE, 1u, RLX_AGENT);
        }
    } SEAM(1);
    if (IN(2)) { p2_prep(F); } SEAM(2);
    if (IN(3)) { p2_mixers(F); } SEAM(3);
    if (IN(4)) { p3_merge(F); } SEAM(4);
    if (IN(5)) {
        bf16* T1 = WSP(bf16, WS_T1); bf16* MIXp = WSP(bf16, WS_MIX); const bf16* GAp = WSP(bf16, WS_GA); const bf16* GBp = WSP(bf16, WS_GB);
        { pg8::Gemm g{WSP(bf16, WS_OAM), WSP(bf16, WS_WA), NP, 1024, 512, -1}; pg8::StaticOrder S; S.init(NP, 1024, F.G, (int)blockIdx.x, false);
          pg8::EpiGate<false> E{WSP(bf16, WS_GA), nullptr, WSP(bf16, WS_T1)};
          pg8::gemm_phase<pg8::EpiGate<false>, pg8::StaticOrder, true, true>(F.lds, g, S, E); }
        skinny_sample_gemm(F, WSP(bf16, WS_OAM), WSP(bf16, WS_WA), 512, [=](int row, int col, float v) { const size_t o = (size_t)row * 1024 + col; T1[o] = f2bf(pg8::sigmoidf_(bf2f(GAp[o])) * v); });
        VM_WAIT(); __syncthreads();
        { pg8::Gemm g{WSP(bf16, WS_OBN), WSP(bf16, WS_WB), NP, 1024, 1024, -1}; pg8::StaticOrder S; S.init(NP, 1024, F.G, (int)blockIdx.x, false);
          pg8::EpiGate<true> E{WSP(bf16, WS_GB), WSP(bf16, WS_T1), WSP(bf16, WS_MIX)};
          pg8::gemm_phase<pg8::EpiGate<true>, pg8::StaticOrder, true, true>(F.lds, g, S, E); }
        skinny_sample_gemm(F, WSP(bf16, WS_OBN), WSP(bf16, WS_WB), 1024, [=](int row, int col, float v) { const size_t o = (size_t)row * 1024 + col; MIXp[o] = f2bf(bf2f(T1[o]) + pg8::sigmoidf_(bf2f(GBp[o])) * v); });
    } SEAM(5);
    if (IN(6)) {
        pg8::Gemm g{WSP(bf16, WS_MIX), WSP(bf16, WS_WO), NP, 1024, 1024, -1}; pg8::StaticOrder S; S.init(NP, 1024, F.G, (int)blockIdx.x, false);
        pg8::EpiOut E{WSP(bf16, WS_XB), WSP(bf16, WS_HB), ALPHA};
        pg8::gemm_phase<pg8::EpiOut, pg8::StaticOrder, true, true>(F.lds, g, S, E);
        const bf16* xbp = WSP(bf16, WS_XB); bf16* Hp = WSP(bf16, WS_HB);
        skinny_sample_gemm(F, WSP(bf16, WS_MIX), WSP(bf16, WS_WO), 1024, [=](int row, int col, float v) { const size_t o = (size_t)row * 1024 + col; Hp[o] = f2bf(ALPHA * bf2f(xbp[o]) + v); });
    } SEAM(6);
    if (IN(7)) { p6_ln1(F); } SEAM(7);
    if (IN(8)) {
        pg8::Gemm g{WSP(bf16, WS_X1B), WSP(bf16, WS_WQ), MPAD, 2048, 1024, MPAD / 256 - 1}; pg8::StaticOrder S; S.init(MPAD, 2048, F.G, (int)blockIdx.x);
        pg8::EpiHeadNorm E{WSP(bf16, WS_QN), 2048, F.lds + STATS_OFF, LN_EPS};
        pg8::gemm_phase<pg8::EpiHeadNorm, pg8::StaticOrder, true, true>(F.lds, g, S, E);
    } SEAM(8);
    if (IN(9)) {
        const int gw = blockIdx.x * NWAVES + F.wave, NGW = F.G * NWAVES;
        for (int it = gw; it < (NP / 32) * 8; it += NGW) p8_topk_item(F, it);
        for (int e = gw; e < 64 * (NS / 32) * 8; e += NGW) if ((e & 63) == 0) p8_topk_item(F, (NP / 32) * 8 + (e >> 6));
    } SEAM(9);
#if defined(PROBE_PHASE) && PROBE_PHASE >= 300 && PROBE_PHASE < 310
    if (IN(10)) { const unsigned long long td0 = __builtin_amdgcn_s_memrealtime();
        if (PROBE_PHASE == 300) peer_u_phase_t<2047u>(F); else if (PROBE_PHASE == 301) peer_u_phase_t<8191u>(F); else peer_u_phase_t<0xffffffffu>(F);
        xcd_barrier(bar); if (blockIdx.x == 0) F.tp = __builtin_amdgcn_s_memrealtime() - td0; }
#endif
    if (IN(10)) { peer_u_phase(F); } SEAM(10);
    if (IN(11)) { peer_coef_phase(F); } SEAM(11);
    if (IN(12)) { peer_v_phase(F); } SEAM(12);
    if (IN(13)) { peer_ln2_phase(F); }
#ifdef PROBE_PHASE
    if (PROBE_PHASE == 13) { xcd_barrier(bar); STAMP(13); }
    if (PROBE_PHASE == 200 || PROBE_PHASE == 201) {
        unsigned* xm = (unsigned*)(F.ws + WS_END);
        if (F.tid == 0) __hip_atomic_store(xm + blockIdx.x, xb_xcc_id() + 1u, RLX_AGENT);
        xcd_barrier(bar);
        if (blockIdx.x == 0 && F.tid == 0) { bool ok = true;
            for (int b = 0; b < (int)gridDim.x; ++b) { const unsigned a = __hip_atomic_load(xm + b, RLX_AGENT), r = __hip_atomic_load(xm + (PROBE_PHASE == 200 ? (b & 7) : (b & ~31)), RLX_AGENT); if (a != r) ok = false; }
            t_probe = ok ? 50000ull : 0ull; }
    }
    if ((PROBE_PHASE >= 100 && PROBE_PHASE < 200) || PROBE_PHASE >= 300) t_probe = F.tp;
    if (F.tid == 0 && t_probe != 0ull) { const unsigned long long t0 = __builtin_amdgcn_s_memrealtime(); while (__builtin_amdgcn_s_memrealtime() - t0 < PROBE_GAIN * t_probe) __builtin_amdgcn_s_sleep(8); }
#endif
#undef IN
#undef SEAM
}

extern "C" void kernel_launch(void* const* d_in, const int* in_sizes, int n_in, void* d_out, int out_size, void* d_ws, size_t ws_size, hipStream_t stream) {
    static int grid = 0;
    if (grid == 0) {
        if (n_in != 22 || (size_t)out_size != OUT_TOTAL || ws_size < WS_END) { fprintf(stderr, "kernel_launch: unexpected shapes: n_in %d out %d ws %zu (need >= %zu)\n", n_in, out_size, ws_size, (size_t)WS_END); grid = -1; return; }
        int dev = 0, cus = 0, per_cu = 0;
        if (hipGetDevice(&dev) != hipSuccess || hipDeviceGetAttribute(&cus, hipDeviceAttributeMultiprocessorCount, dev) != hipSuccess) { grid = -1; return; }
        if (hipFuncSetAttribute((const void*)mk_fwd, hipFuncAttributeMaxDynamicSharedMemorySize, LDS_BYTES) != hipSuccess) { fprintf(stderr, "kernel_launch: hipFuncSetAttribute failed\n"); grid = -1; return; }
        if (hipOccupancyMaxActiveBlocksPerMultiprocessor(&per_cu, (const void*)mk_fwd, NTHR, LDS_BYTES) != hipSuccess || per_cu < 1) fprintf(stderr, "kernel_launch: occupancy query reports %d blocks per CU\n", per_cu);
        (void)hipGetLastError();
        grid = cus;
    }
    if (grid < 0) return;
    (void)hipMemsetAsync((char*)d_ws + WS_CTL, 0, CTL_ZERO_BYTES, stream);
    Args a{};
    for (int i = 0; i < 22; ++i) a.in[i] = (const float*)d_in[i];
    a.out = (float*)d_out; a.ws = (unsigned char*)d_ws;
#if MK_SINGLE
    a.ph_lo = 0; a.ph_hi = NPHASE;
    void* kargs[] = {&a};
    hipError_t e = hipLaunchCooperativeKernel((const void*)mk_fwd, dim3(grid), dim3(NTHR), kargs, LDS_BYTES, stream);
    if (e != hipSuccess) fprintf(stderr, "kernel_launch: cooperative launch failed: %s\n", hipGetErrorString(e));
#else
    for (int p = 0; p < NPHASE; ++p) { a.ph_lo = p; a.ph_hi = p + 1; hipLaunchKernelGGL(mk_fwd, dim3(grid), dim3(NTHR), LDS_BYTES, stream, a); }
#endif
}
```

```cpp
#include <hip/hip_runtime.h>
#include <hip/hip_cooperative_groups.h>
#include <cstdio>
#include <cstdint>
#ifndef MK_SINGLE
#define MK_SINGLE 1
#endif
namespace pg8 {
#define PG8_LAS __attribute__((address_space(3)))
typedef unsigned short bf16_t;
typedef short bf16x8 __attribute__((ext_vector_type(8)));
typedef float f32x4 __attribute__((ext_vector_type(4)));
typedef unsigned u32x4 __attribute__((ext_vector_type(4)));
constexpr int BM = 256, BK = 64, HALF = 128, HTB = HALF * BK * 2  , STAGE_BYTES = 8 * HTB, NXCD = 8, WGM = 8;

__host__ __device__ __forceinline__ int lds_byte(int r, int c) { const int st = (r >> 4) * 2 + (c >> 5), rr = r & 15, cc = c & 31, ob = rr * 64 + cc * 2; return st * 1024 + (ob ^ (((ob >> 9) & 1) << 5)); }
__host__ __device__ __forceinline__ void stage_rc(int b, int& R, int& C) { const int st = b / 1024, sb = b % 1024, swz = sb ^ (((sb >> 9) & 1) << 5); R = (st >> 1) * 16 + swz / 64; C = (st & 1) * 32 + (swz % 64) / 2; }
__host__ __device__ __forceinline__ int perm32(int rho) { const int n = rho >> 4, i = rho & 15; return 8 * (i >> 2) + 4 * n + (i & 3); }

struct Unit { int pm, pn; };
struct Gemm { const bf16_t* A; const bf16_t* Bt; int M, N, K; int half_pm = -1; };

struct StaticOrder {
    int nM, nN, nwg, G, c, nfull;
    __host__ __device__ void init(int M, int N, int G_, int c_, bool half = true) { nM = half ? M / BM - 1 : M / BM; nN = N / BM; nfull = nM * nN; nwg = half ? nfull + nN : nfull; G = G_; c = c_; }
    __host__ __device__ bool next(int i, Unit& u) const {
        const long L = (long)i * G + c; if (L >= nwg) return false;
        if (L >= nfull) { u.pm = nM; u.pn = (int)(L - nfull); return true; }
        int wgid = (int)L; { const int q = nfull / NXCD, r = nfull % NXCD, xcd = wgid % NXCD, off = wgid / NXCD; wgid = (xcd < r ? xcd * (q + 1) : r * (q + 1) + (xcd - r) * q) + off; }
        const int nig = WGM * nN, gid = wgid / nig, fm = gid * WGM, gsz = (nM - fm) < WGM ? (nM - fm) : WGM;
        u.pm = fm + ((wgid % nig) % gsz); u.pn = (wgid % nig) / gsz; return true;
    }
    __device__ __forceinline__ void a_ready(const Unit&) const {}
    __device__ __forceinline__ void done(const Unit&) const {}
};


typedef float f32x2 __attribute__((ext_vector_type(2)));
typedef __bf16 bf16x2_t __attribute__((ext_vector_type(2)));
__device__ __forceinline__ unsigned cvt_pk_bf16(float lo, float hi) { f32x2 v = {lo, hi}; bf16x2_t b = __builtin_convertvector(v, bf16x2_t); return __builtin_bit_cast(unsigned, b); }
__device__ __forceinline__ float bf_lo(unsigned w) { return __uint_as_float(w << 16); }
__device__ __forceinline__ float bf_hi(unsigned w) { return __uint_as_float(w & 0xffff0000u); }
__device__ __forceinline__ float sigmoidf_(float x) { return __builtin_amdgcn_rcpf(1.0f + __expf(-x)); }

struct EpiProj {
    static constexpr bool PERM = true, AFTER_DRAIN = false;
    bf16_t *qa, *ka, *va, *qb, *kb, *vb, *rb, *ga, *gb;
    __device__ __forceinline__ void operator()(const f32x4 (&acc)[2][2][4][2], const Unit& u, int wr, int wc, int fr, int fq) const {
        const int pn = u.pn; bf16_t* base; int ldc, ct; float sc = 1.f;
        if (pn < 6) { base = qa; ldc = 1536; ct = pn; sc = 0.125f; }
        else if (pn < 12) { base = ka; ldc = 1536; ct = pn - 6; }
        else if (pn < 18) { base = va; ldc = 1536; ct = pn - 12; }
        else if (pn < 20) { base = qb; ldc = 512; ct = pn - 18; }
        else if (pn < 22) { base = kb; ldc = 512; ct = pn - 20; }
        else if (pn < 26) { base = vb; ldc = 1024; ct = pn - 22; }
        else if (pn < 30) { base = rb; ldc = 1024; ct = pn - 26; }
        else if (pn < 34) { base = ga; ldc = 1024; ct = pn - 30; }
        else { base = gb; ldc = 1024; ct = pn - 34; }
        const int row0 = u.pm * BM + wr * 64 + fr, col0 = ct * BM + wc * 32 + 8 * fq;
#pragma unroll
        for (int ai = 0; ai < 2; ++ai)
#pragma unroll
            for (int m = 0; m < 4; ++m) { bf16_t* rowp = base + (size_t)(row0 + ai * HALF + m * 16) * ldc + col0;
#pragma unroll
                for (int bj = 0; bj < 2; ++bj) { const f32x4 v0 = acc[ai][bj][m][0] * sc, v1 = acc[ai][bj][m][1] * sc;
                    u32x4 w; w.x = cvt_pk_bf16(v0[0], v0[1]); w.y = cvt_pk_bf16(v0[2], v0[3]); w.z = cvt_pk_bf16(v1[0], v1[1]); w.w = cvt_pk_bf16(v1[2], v1[3]);
                    *(u32x4*)(rowp + bj * HALF) = w; } }
    }
};
template <bool ADD> struct EpiGate {
    static constexpr bool PERM = true, AFTER_DRAIN = false;
    const bf16_t* G; const bf16_t* T1; bf16_t* O;
    __device__ __forceinline__ void operator()(const f32x4 (&acc)[2][2][4][2], const Unit& u, int wr, int wc, int fr, int fq) const {
        const int row0 = u.pm * BM + wr * 64 + fr, col0 = u.pn * BM + wc * 32 + 8 * fq;
#pragma unroll
        for (int ai = 0; ai < 2; ++ai) {
            u32x4 gq[4][2], tq[4][2];
#pragma unroll
            for (int m = 0; m < 4; ++m) { const size_t off = (size_t)(row0 + ai * HALF + m * 16) * 1024 + col0;
#pragma unroll
                for (int bj = 0; bj < 2; ++bj) { gq[m][bj] = *(const u32x4*)(G + off + bj * HALF); if (ADD) tq[m][bj] = *(const u32x4*)(T1 + off + bj * HALF); } }
#pragma unroll
            for (int m = 0; m < 4; ++m) { const size_t off = (size_t)(row0 + ai * HALF + m * 16) * 1024 + col0;
#pragma unroll
                for (int bj = 0; bj < 2; ++bj) {
                    const u32x4 g = gq[m][bj];
                    f32x4 v0 = acc[ai][bj][m][0], v1 = acc[ai][bj][m][1];
                    v0[0] *= sigmoidf_(bf_lo(g.x)); v0[1] *= sigmoidf_(bf_hi(g.x)); v0[2] *= sigmoidf_(bf_lo(g.y)); v0[3] *= sigmoidf_(bf_hi(g.y));
                    v1[0] *= sigmoidf_(bf_lo(g.z)); v1[1] *= sigmoidf_(bf_hi(g.z)); v1[2] *= sigmoidf_(bf_lo(g.w)); v1[3] *= sigmoidf_(bf_hi(g.w));
                    if (ADD) { const u32x4 t = tq[m][bj];
                        v0[0] += bf_lo(t.x); v0[1] += bf_hi(t.x); v0[2] += bf_lo(t.y); v0[3] += bf_hi(t.y);
                        v1[0] += bf_lo(t.z); v1[1] += bf_hi(t.z); v1[2] += bf_lo(t.w); v1[3] += bf_hi(t.w); }
                    u32x4 w; w.x = cvt_pk_bf16(v0[0], v0[1]); w.y = cvt_pk_bf16(v0[2], v0[3]); w.z = cvt_pk_bf16(v1[0], v1[1]); w.w = cvt_pk_bf16(v1[2], v1[3]);
                    *(u32x4*)(O + off + bj * HALF) = w; } } }
    }
};
struct EpiOut {
    static constexpr bool PERM = true, AFTER_DRAIN = false;
    const bf16_t* xb; bf16_t* HB; float alpha;
    __device__ __forceinline__ void operator()(const f32x4 (&acc)[2][2][4][2], const Unit& u, int wr, int wc, int fr, int fq) const {
        const int row0 = u.pm * BM + wr * 64 + fr, col0 = u.pn * BM + wc * 32 + 8 * fq;
#pragma unroll
        for (int ai = 0; ai < 2; ++ai) {
            u32x4 xq[4][2];
#pragma unroll
            for (int m = 0; m < 4; ++m) { const size_t off = (size_t)(row0 + ai * HALF + m * 16) * 1024 + col0;
#pragma unroll
                for (int bj = 0; bj < 2; ++bj) xq[m][bj] = *(const u32x4*)(xb + off + bj * HALF); }
#pragma unroll
            for (int m = 0; m < 4; ++m) { const size_t off = (size_t)(row0 + ai * HALF + m * 16) * 1024 + col0;
#pragma unroll
                for (int bj = 0; bj < 2; ++bj) { const u32x4 t = xq[m][bj]; const f32x4 a0 = acc[ai][bj][m][0], a1 = acc[ai][bj][m][1];
                    u32x4 w; w.x = cvt_pk_bf16(alpha * bf_lo(t.x) + a0[0], alpha * bf_hi(t.x) + a0[1]); w.y = cvt_pk_bf16(alpha * bf_lo(t.y) + a0[2], alpha * bf_hi(t.y) + a0[3]);
                    w.z = cvt_pk_bf16(alpha * bf_lo(t.z) + a1[0], alpha * bf_hi(t.z) + a1[1]); w.w = cvt_pk_bf16(alpha * bf_lo(t.w) + a1[2], alpha * bf_hi(t.w) + a1[3]);
                    *(u32x4*)(HB + off + bj * HALF) = w; } }
        }
    }
};
struct EpiHeadNorm {
    static constexpr bool PERM = true, AFTER_DRAIN = false;
    bf16_t* O; int ldc; PG8_LAS unsigned char* st; float eps;
    __device__ __forceinline__ void operator()(const f32x4 (&acc)[2][2][4][2], const Unit& u, int wr, int wc, int fr, int fq) const {
        PG8_LAS f32x2* P = (PG8_LAS f32x2*)st; PG8_LAS f32x2* S = (PG8_LAS f32x2*)(st + 8192);
        const int lane = fq * 16 + fr, wid = wr * 4 + wc;
#pragma unroll
        for (int ai = 0; ai < 2; ++ai)
#pragma unroll
            for (int m = 0; m < 4; ++m) {
                float s = 0.f;
#pragma unroll
                for (int bj = 0; bj < 2; ++bj)
#pragma unroll
                    for (int n = 0; n < 2; ++n) { const f32x4 x = acc[ai][bj][m][n]; s += (x[0] + x[1]) + (x[2] + x[3]); }
                s += __shfl_xor(s, 16); s += __shfl_xor(s, 32);
                const float mw = s * (1.0f / 64.0f); float q = 0.f;
#pragma unroll
                for (int bj = 0; bj < 2; ++bj)
#pragma unroll
                    for (int n = 0; n < 2; ++n) { const f32x4 d = acc[ai][bj][m][n] - mw; q += (d[0] * d[0] + d[1] * d[1]) + (d[2] * d[2] + d[3] * d[3]); }
                q += __shfl_xor(q, 16); q += __shfl_xor(q, 32);
                if (fq == 0) P[(ai * HALF + wr * 64 + m * 16 + fr) * 4 + wc] = (f32x2){mw, q};
            }
        asm volatile("s_waitcnt lgkmcnt(0)" ::: "memory"); __builtin_amdgcn_s_barrier(); asm volatile("" ::: "memory");
        const int row = wid * 32 + (lane & 31);
        if (lane < 32) {
            const f32x2 a = P[row * 4 + 0], b = P[row * 4 + 1], c = P[row * 4 + 2], d = P[row * 4 + 3];
            const float mt = (a.x + b.x + c.x + d.x) * 0.25f;
            const float da = a.x - mt, db = b.x - mt, dc = c.x - mt, dd = d.x - mt;
            const float m2 = (a.y + b.y) + (c.y + d.y) + 64.0f * ((da * da + db * db) + (dc * dc + dd * dd));
            S[row] = (f32x2){mt, 1.0f / sqrtf(m2 * (1.0f / 256.0f) + eps)};
        }
        asm volatile("s_waitcnt lgkmcnt(0)" ::: "memory"); __builtin_amdgcn_s_barrier(); asm volatile("" ::: "memory");
        const int row0 = u.pm * BM + wr * 64 + fr, col0 = u.pn * BM + wc * 32 + 8 * fq;
#pragma unroll
        for (int ai = 0; ai < 2; ++ai)
#pragma unroll
            for (int m = 0; m < 4; ++m) { const f32x2 sr = S[ai * HALF + wr * 64 + m * 16 + fr]; bf16_t* rowp = O + (size_t)(row0 + ai * HALF + m * 16) * ldc + col0;
#pragma unroll
                for (int bj = 0; bj < 2; ++bj) { const f32x4 v0 = (acc[ai][bj][m][0] - sr.x) * sr.y, v1 = (acc[ai][bj][m][1] - sr.x) * sr.y;
                    u32x4 w; w.x = cvt_pk_bf16(v0[0], v0[1]); w.y = cvt_pk_bf16(v0[2], v0[3]); w.z = cvt_pk_bf16(v1[0], v1[1]); w.w = cvt_pk_bf16(v1[2], v1[3]);
                    *(u32x4*)(rowp + bj * HALF) = w; } }
    }
};

template <class Epi, class Sched, bool ALIGN_EPI = false, bool SP2 = false>
__device__ __forceinline__ void gemm_phase(PG8_LAS unsigned char* lds, const Gemm g, const Sched& S, const Epi& E) {
    const int tid = threadIdx.x, wid = __builtin_amdgcn_readfirstlane(tid >> 6), lane = tid & 63, wr = wid >> 2, wc = wid & 3, fr = lane & 15, fq = lane >> 4;
    const int K = g.K, nt = K / BK;
    unsigned voffA[2], voffB[2];
#pragma unroll
    for (int i = 0; i < 2; ++i) { int R, C; stage_rc(tid * 16 + i * 8192, R, C); const int Rb = Epi::PERM ? ((R & ~31) + perm32(R & 31)) : R;
        voffA[i] = (unsigned)(R * K + C) * 2u; voffB[i] = (unsigned)(Rb * K + C) * 2u; }
    const size_t kstep = (size_t)(BK * 2);
    const size_t hstep = (size_t)HALF * K * 2;
    const size_t tstep = 2 * hstep;
    const unsigned ldsw = (unsigned)wid * 1024u;
    const int aoff = lds_byte(wr * 64 + fr, fq * 8), boff = lds_byte(wc * 32 + fr, fq * 8);
#define PG8_SA(b, h) (((b) * 2 + (h)) * HTB)
#define PG8_SB(b, h) ((4 + (b) * 2 + (h)) * HTB)
#define PG8_STAGE(bufoff, gbase, voff) do { _Pragma("unroll") for (int _i = 0; _i < 2; ++_i) \
        __builtin_amdgcn_global_load_lds((const unsigned*)((const char*)(gbase) + (voff)[_i]), (PG8_LAS unsigned*)(lds + (bufoff) + ldsw + _i * 8192), 16, 0, 0); } while (0)
#define PG8_LDA(dst, b, h) do { _Pragma("unroll") for (int m = 0; m < 4; ++m) _Pragma("unroll") for (int k = 0; k < 2; ++k) dst[m][k] = *(const PG8_LAS bf16x8*)(lds + PG8_SA(b, h) + aoff + m * 2048 + k * 1024); } while (0)
#define PG8_LDB(dst, b, h) do { _Pragma("unroll") for (int n = 0; n < 2; ++n) _Pragma("unroll") for (int k = 0; k < 2; ++k) dst[n][k] = *(const PG8_LAS bf16x8*)(lds + PG8_SB(b, h) + boff + n * 2048 + k * 1024); } while (0)
#define PG8_MMA(ai, bj, At, Bt) do { __builtin_amdgcn_s_setprio(1); _Pragma("unroll") for (int m = 0; m < 4; ++m) _Pragma("unroll") for (int n = 0; n < 2; ++n) _Pragma("unroll") for (int k = 0; k < 2; ++k) \
        acc[ai][bj][m][n] = __builtin_amdgcn_mfma_f32_16x16x32_bf16(Bt[n][k], At[m][k], acc[ai][bj][m][n], 0, 0, 0); __builtin_amdgcn_s_setprio(0); } while (0)
#define PG8_WAIT_V(n) asm volatile("s_waitcnt vmcnt(" #n ")" ::: "memory")
#define PG8_WAIT_L(n) asm volatile("s_waitcnt lgkmcnt(" #n ")" ::: "memory")
#define PG8_BAR __builtin_amdgcn_s_barrier()
#define PG8_SCHED __builtin_amdgcn_sched_barrier(0)
    Unit cur, nxt; int ui = 0;
    if (!S.next(0, cur)) return;
    f32x4 acc[2][2][4][2];
#pragma unroll
    for (int a = 0; a < 2; ++a)
#pragma unroll
        for (int b = 0; b < 2; ++b)
#pragma unroll
            for (int m = 0; m < 4; ++m)
#pragma unroll
                for (int n = 0; n < 2; ++n) acc[a][b][m][n] = (f32x4){0.f, 0.f, 0.f, 0.f};
    bf16x8 At[4][2], B0[2][2], B1[2][2];
    const char* cA = (const char*)g.A + (size_t)cur.pm * tstep; const char* cB = (const char*)g.Bt + (size_t)cur.pn * tstep;
    S.a_ready(cur);
    if constexpr (SP2) {
        PG8_STAGE(PG8_SB(0, 0), cB, voffB); PG8_STAGE(PG8_SB(0, 1), cB + hstep, voffB); PG8_STAGE(PG8_SA(0, 0), cA, voffA); PG8_STAGE(PG8_SA(0, 1), cA + hstep, voffA);
        if (wr == 1) PG8_BAR;
        PG8_WAIT_V(2); PG8_BAR;
        PG8_STAGE(PG8_SB(1, 0), cB + kstep, voffB); PG8_STAGE(PG8_SA(1, 0), cA + kstep, voffA); PG8_STAGE(PG8_SB(1, 1), cB + hstep + kstep, voffB);
        PG8_WAIT_V(6); PG8_BAR;
    } else {
        PG8_STAGE(PG8_SB(0, 0), cB, voffB); PG8_STAGE(PG8_SA(0, 0), cA, voffA); PG8_STAGE(PG8_SB(0, 1), cB + hstep, voffB); PG8_STAGE(PG8_SA(0, 1), cA + hstep, voffA);
        if (wr == 1) PG8_BAR;
        PG8_WAIT_V(4); PG8_BAR;
        PG8_STAGE(PG8_SB(1, 0), cB + kstep, voffB); PG8_STAGE(PG8_SA(1, 0), cA + kstep, voffA); PG8_STAGE(PG8_SB(1, 1), cB + hstep + kstep, voffB);
        PG8_WAIT_V(6); PG8_BAR;
    }
    for (;;) {
        const bool has_next = S.next(ui + 1, nxt);
        const bool skip1 = __builtin_amdgcn_readfirstlane((int)(cur.pm == g.half_pm)) != 0;
        const char* nA = has_next ? (const char*)g.A + (size_t)nxt.pm * tstep : cA; const char* nB = has_next ? (const char*)g.Bt + (size_t)nxt.pn * tstep : cB;
        for (int t = 0; t < nt; t += 2) {
            const bool last = (t == nt - 2);
            const char* a1 = cA + (size_t)(t + 1) * kstep;
            const char* a2 = last ? nA : cA + (size_t)(t + 2) * kstep; const char* b2 = last ? nB : cB + (size_t)(t + 2) * kstep;
            const char* a3 = a2 + kstep; const char* b3 = b2 + kstep;
            if (last && has_next) S.a_ready(nxt);
            if constexpr (SP2) {
            PG8_LDB(B0, 0, 0); PG8_LDB(B1, 0, 1); PG8_SCHED; PG8_LDA(At, 0, 0); PG8_STAGE(PG8_SA(1, 1), a1 + hstep, voffA);
            PG8_WAIT_V(8); PG8_WAIT_L(0); PG8_BAR; PG8_MMA(0, 0, At, B0); PG8_MMA(0, 1, At, B1); PG8_BAR; PG8_SCHED;
            PG8_LDA(At, 0, 1); PG8_STAGE(PG8_SB(0, 0), b2, voffB); PG8_STAGE(PG8_SB(0, 1), b2 + hstep, voffB); PG8_STAGE(PG8_SA(0, 0), a2, voffA);
            PG8_WAIT_V(8); PG8_WAIT_L(0); PG8_BAR; if (!skip1) { PG8_MMA(1, 0, At, B0); PG8_MMA(1, 1, At, B1); } PG8_BAR; PG8_SCHED;
            PG8_LDB(B0, 1, 0); PG8_LDB(B1, 1, 1); PG8_SCHED; PG8_LDA(At, 1, 0); PG8_STAGE(PG8_SA(0, 1), a2 + hstep, voffA);
            PG8_WAIT_V(8); PG8_WAIT_L(0); PG8_BAR; PG8_MMA(0, 0, At, B0); PG8_MMA(0, 1, At, B1); PG8_BAR; PG8_SCHED;
            PG8_LDA(At, 1, 1); PG8_STAGE(PG8_SB(1, 0), b3, voffB); PG8_STAGE(PG8_SB(1, 1), b3 + hstep, voffB); PG8_STAGE(PG8_SA(1, 0), a3, voffA);
            PG8_WAIT_V(8); PG8_WAIT_L(0); PG8_BAR; if (!skip1) { PG8_MMA(1, 0, At, B0); PG8_MMA(1, 1, At, B1); } PG8_BAR; PG8_SCHED;
            } else {
            PG8_LDB(B0, 0, 0); PG8_SCHED; PG8_LDA(At, 0, 0); PG8_STAGE(PG8_SA(1, 1), a1 + hstep, voffA);
            PG8_WAIT_L(8); PG8_BAR; PG8_WAIT_L(0); PG8_MMA(0, 0, At, B0); PG8_BAR; PG8_SCHED;
            PG8_LDB(B1, 0, 1); PG8_STAGE(PG8_SB(0, 0), b2, voffB);
            PG8_BAR; PG8_WAIT_L(0); PG8_MMA(0, 1, At, B1); PG8_BAR;
            PG8_LDA(At, 0, 1); PG8_STAGE(PG8_SA(0, 0), a2, voffA);
            PG8_BAR; PG8_WAIT_L(0); PG8_MMA(1, 0, At, B0); PG8_BAR; PG8_SCHED;
            PG8_STAGE(PG8_SB(0, 1), b2 + hstep, voffB);
            PG8_WAIT_V(6); PG8_BAR; PG8_MMA(1, 1, At, B1); PG8_BAR;
            PG8_LDB(B0, 1, 0); PG8_SCHED; PG8_LDA(At, 1, 0); PG8_STAGE(PG8_SA(0, 1), a2 + hstep, voffA);
            PG8_WAIT_L(8); PG8_BAR; PG8_WAIT_L(0); PG8_MMA(0, 0, At, B0); PG8_BAR; PG8_SCHED;
            PG8_LDB(B1, 1, 1); PG8_STAGE(PG8_SB(1, 0), b3, voffB);
            PG8_BAR; PG8_WAIT_L(0); PG8_MMA(0, 1, At, B1); PG8_BAR;
            PG8_LDA(At, 1, 1); PG8_STAGE(PG8_SA(1, 0), a3, voffA);
            PG8_BAR; PG8_WAIT_L(0); PG8_MMA(1, 0, At, B0); PG8_BAR; PG8_SCHED;
            PG8_STAGE(PG8_SB(1, 1), b3 + hstep, voffB);
            PG8_WAIT_V(6); PG8_BAR; PG8_MMA(1, 1, At, B1); PG8_BAR;
            }
        }
        if constexpr (ALIGN_EPI) { if (wr == 0) PG8_BAR; }
        if constexpr (!Epi::AFTER_DRAIN) { E(acc, cur, wr, wc, fr, fq); S.done(cur); }
        if (!has_next) break;
#pragma unroll
        for (int a = 0; a < 2; ++a)
#pragma unroll
            for (int b = 0; b < 2; ++b)
#pragma unroll
                for (int m = 0; m < 4; ++m)
#pragma unroll
                    for (int n = 0; n < 2; ++n) acc[a][b][m][n] = (f32x4){0.f, 0.f, 0.f, 0.f};
        cur = nxt; cA = nA; cB = nB; ++ui;
        if constexpr (ALIGN_EPI) { if (wr == 1) PG8_BAR; }
    }
    PG8_WAIT_V(0);
    if constexpr (!ALIGN_EPI) { if (wr == 0) PG8_BAR; }
    PG8_BAR;
    if constexpr (Epi::AFTER_DRAIN) { E.fused(acc, cur, wr, wc, fr, fq, lds, wid, lane); S.done(cur); }
#undef PG8_SA
#undef PG8_SB
#undef PG8_STAGE
#undef PG8_LDA
#undef PG8_LDB
#undef PG8_MMA
#undef PG8_WAIT_V
#undef PG8_WAIT_L
#undef PG8_BAR
#undef PG8_SCHED
}
}

constexpr int NWAVES = 8, NTHR = 512;
constexpr int DM = 1024, TSEQ = 4096, NP = 32768, NS = 128, NTOK = NP + NS, MPAD = 33024;
constexpr int INW = 9744, NPROJ = 9728, ABCOL = 6656;
constexpr float LN_EPS = 1e-5f, ALPHA = 1.189207115002721f, GLA_QSCALE = 0.08838834764831845f, NEG_BIG = -1e30f;
constexpr size_t OUT_YP = 0, OUT_YS = 33554432, OUT_KVP1 = 33685504, OUT_KVP2 = 34734080, OUT_KVP3 = 38928384, OUT_STP = 55705600,
                 OUT_KVS1 = 56754176, OUT_KVS2 = 60948480, OUT_KVS3 = 77725696, OUT_STS = 144834560, OUT_TOTAL = 149028864;
constexpr size_t MiB = 1u << 20;
constexpr size_t WS_CTL = 0, CTL_ZERO_BYTES = 1 * MiB;
constexpr size_t WS_KEYS = 1 * MiB, WS_LUT = WS_KEYS + 512 * 1024;
constexpr size_t WS_WA = 2 * MiB, WS_WB = 3 * MiB, WS_WO = 5 * MiB, WS_WQ = 7 * MiB, WS_WIN = 11 * MiB;
constexpr size_t WS_AB = 31 * MiB, WS_UT = 34 * MiB, WS_VT = 66 * MiB, WS_XB = 98 * MiB;
constexpr size_t WS_QA = 163 * MiB, WS_KA = 260 * MiB, WS_VA = 357 * MiB, WS_QB = 454 * MiB, WS_KB = 487 * MiB, WS_VB = 520 * MiB;
constexpr size_t WS_RB = 585 * MiB, WS_GA = 650 * MiB, WS_GB = 715 * MiB, WS_LSE = 780 * MiB, WS_OAM = 784 * MiB, WS_OBN = 817 * MiB, WS_H = 882 * MiB, WS_END = 1011 * MiB;
constexpr size_t WS_HB = WS_KA;
constexpr size_t WS_T1 = WS_KA, WS_MIX = WS_VA, WS_X1B = WS_QA, WS_QN = WS_RB, WS_EIDX = WS_GB, WS_GATE = WS_GB + 17 * MiB;
static_assert(WS_WIN + (size_t)NPROJ * 1024 * 2 <= WS_AB && WS_AB + (size_t)MPAD * 16 * 4 <= WS_UT && WS_XB + (size_t)MPAD * 1024 * 2 <= WS_QA, "ws map 1");
static_assert(WS_QA + (size_t)MPAD * 1536 * 2 <= WS_KA && WS_QB + (size_t)MPAD * 512 * 2 <= WS_KB && WS_VB + (size_t)MPAD * 1024 * 2 <= WS_RB, "ws map 2");
static_assert(WS_LSE + (size_t)3 * MPAD * 8 * 4 <= WS_OAM && WS_OAM + (size_t)MPAD * 512 * 2 <= WS_OBN && WS_OBN + (size_t)MPAD * 1024 * 2 <= WS_H && WS_H + (size_t)MPAD * 1024 * 4 <= WS_END, "ws map 3");
static_assert(WS_QN + (size_t)MPAD * 2048 * 2 <= WS_GB && WS_EIDX + (size_t)MPAD * 128 * 4 <= WS_GATE && WS_GATE + (size_t)MPAD * 128 * 4 <= WS_LSE, "ws map 4");
constexpr int CW_QUEUE = 64;
constexpr int CW_CPYQ = 128;
constexpr int CW_GDONE = 192;
constexpr int NCOPYWG = 10;
constexpr int CW_BAR = 4096;
constexpr int RING_BYTES = 131072, STATS_OFF = RING_BYTES, MISC_OFF = STATS_OFF + 10240 + 320, LDS_BYTES = 147456;
static_assert(MISC_OFF + 128 + 22 * 8 <= LDS_BYTES, "LDS map");

#define GAS __attribute__((address_space(1)))
#define LAS __attribute__((address_space(3)))
typedef unsigned short bf16;
typedef unsigned v4u __attribute__((ext_vector_type(4)));
typedef unsigned v2u __attribute__((ext_vector_type(2)));
typedef float f32x4 __attribute__((ext_vector_type(4)));
typedef float f32x16 __attribute__((ext_vector_type(16)));
typedef short bf16x8 __attribute__((ext_vector_type(8)));
typedef short s16x4 __attribute__((ext_vector_type(4)));
typedef GAS unsigned gu32;
#define RLX_AGENT __ATOMIC_RELAXED, __HIP_MEMORY_SCOPE_AGENT
#define LDS_WAIT() asm volatile("s_waitcnt lgkmcnt(0)" ::: "memory")
#define VM_WAIT() asm volatile("s_waitcnt vmcnt(0)" ::: "memory")
#define MFMA32(a, b, c) __builtin_amdgcn_mfma_f32_32x32x16_bf16((a), (b), (c), 0, 0, 0)
using pg8::cvt_pk_bf16; using pg8::bf_lo; using pg8::bf_hi;
__device__ __forceinline__ unsigned short f2bf(float f) { return (unsigned short)(cvt_pk_bf16(f, 0.f) & 0xffffu); }
__device__ __forceinline__ float bf2f(unsigned short h) { return __uint_as_float((unsigned)h << 16); }
__device__ __forceinline__ int crow(int reg, int hh) { return (reg & 3) + 8 * (reg >> 2) + 4 * hh; }
__device__ __forceinline__ float wave_sum(float v) {
#pragma unroll
    for (int o = 1; o < 64; o <<= 1) v += __shfl_xor(v, o);
    return v;
}
__device__ __forceinline__ float wave_max(float v) {
#pragma unroll
    for (int o = 1; o < 64; o <<= 1) v = fmaxf(v, __shfl_xor(v, o));
    return v;
}
__device__ __forceinline__ bf16x8 frag_row(const LAS unsigned char* T, int stride, int r0, int k0, int lane) {
    return *(const LAS bf16x8*)(T + (r0 + (lane & 31)) * stride + (k0 + 8 * (lane >> 5)) * 2);
}
typedef short v4i16_t __attribute__((ext_vector_type(4)));
template <bool PERM> __device__ __forceinline__ bf16x8 frag_tr(const LAS unsigned char* X, int stride, int k0, int c0, int lane) {
    const int i = lane & 15, g = (lane >> 4) & 1, hh = lane >> 5, q = i >> 2, p = i & 3;
    const int rA = PERM ? (k0 + 4 * hh + q) : (k0 + 8 * hh + q), rB = PERM ? (k0 + 8 + 4 * hh + q) : (k0 + 8 * hh + 4 + q);
    const int cb = (c0 + 16 * g + 4 * p) * 2;
    const s16x4 lo = __builtin_bit_cast(s16x4, __builtin_amdgcn_ds_read_tr16_b64_v4i16((LAS v4i16_t*)(X + rA * stride + cb)));
    const s16x4 hi = __builtin_bit_cast(s16x4, __builtin_amdgcn_ds_read_tr16_b64_v4i16((LAS v4i16_t*)(X + rB * stride + cb)));
    return __builtin_shufflevector(lo, hi, 0, 1, 2, 3, 4, 5, 6, 7);
}
__device__ __forceinline__ bf16x8 pack_acc(const f32x16& x, int s) {
    v4u p; p.x = cvt_pk_bf16(x[8 * s], x[8 * s + 1]); p.y = cvt_pk_bf16(x[8 * s + 2], x[8 * s + 3]); p.z = cvt_pk_bf16(x[8 * s + 4], x[8 * s + 5]); p.w = cvt_pk_bf16(x[8 * s + 6], x[8 * s + 7]);
    return __builtin_bit_cast(bf16x8, p);
}

#define XB_TMO      128
#define XB_XCNT(j)  (256  + 64 * (j))
#define XB_XSUB(j)  (1280 + 64 * (j))
#define XB_XGEN(j)  (2304 + 64 * (j))
#define XB_TOP      3328
#define XB_TOPGEN   3392
#define XCD_BAR_WORDS 3456
#define XB_SPIN_CAP (1u << 22)
__device__ __forceinline__ unsigned xb_ld(unsigned* p)              { return __hip_atomic_load(p, __ATOMIC_RELAXED, __HIP_MEMORY_SCOPE_AGENT); }
__device__ __forceinline__ unsigned xb_add(unsigned* p, unsigned v) { return __hip_atomic_fetch_add(p, v, __ATOMIC_RELAXED, __HIP_MEMORY_SCOPE_AGENT); }
__device__ __forceinline__ unsigned xb_xcc_id() { return (unsigned)__builtin_amdgcn_s_getreg((3 << 11) | 20) & 0xFu; }
#define XB_SPIN(cond, bar) do { unsigned _sp = 0; while (cond) { __builtin_amdgcn_s_sleep(1); \
    if ((++_sp & 255u) == 0u) { if (xb_ld(&(bar)[XB_TMO])) break; if (_sp > XB_SPIN_CAP) { atomicAdd(&(bar)[XB_TMO], 1u); break; } } } } while (0)
struct XcdBarrier { unsigned* bar; unsigned x; volatile LAS unsigned* st; };
__device__ __forceinline__ XcdBarrier xcd_barrier_post(unsigned* bar, volatile LAS unsigned* st) {
    XcdBarrier b; b.bar = bar; b.x = xb_xcc_id(); b.st = st;
    if (threadIdx.x == 0) (void)xb_add(&bar[XB_XCNT(b.x)], 1u);
    return b;
}
__device__ __forceinline__ void xcd_barrier_complete(unsigned* bar, unsigned x, unsigned& nloc, unsigned& nx) {
    const unsigned G = gridDim.x * gridDim.y * gridDim.z;
    unsigned sum, cnt, mine, sp = 0u;
    for (;;) {
        sum = 0u; cnt = 0u; mine = 0u;
#pragma unroll
        for (unsigned j = 0; j < 16; ++j) { const unsigned c = xb_ld(&bar[XB_XCNT(j)]); sum += c; cnt += (c > 0u) ? 1u : 0u; mine = (j == x) ? c : mine; }
        if (sum == G) break;
        __builtin_amdgcn_s_sleep(1);
        if ((++sp & 255u) == 0u) { if (xb_ld(&bar[XB_TMO])) break; if (sp > XB_SPIN_CAP) { atomicAdd(&bar[XB_TMO], 1u); break; } }
    }
    nloc = mine > 0u ? mine : 1u; nx = cnt > 0u ? cnt : 1u;
}
__device__ __forceinline__ void xcd_barrier(const XcdBarrier& b) {
    asm volatile("s_waitcnt vmcnt(0)" ::: "memory");
    __syncthreads();
    if (threadIdx.x == 0) {
        unsigned* bar = b.bar;
        __builtin_amdgcn_s_waitcnt(0);
        unsigned nloc = b.st[0], nx = b.st[1];
        if (nloc == 0u) { xcd_barrier_complete(bar, b.x, nloc, nx); b.st[0] = nloc; b.st[1] = nx; }
        const unsigned old = xb_add(&bar[XB_XSUB(b.x)], 1u);
        const unsigned gen = old / nloc;
        if (old + 1u == (gen + 1u) * nloc) {
            __builtin_amdgcn_fence(__ATOMIC_RELEASE, "agent");
            asm volatile("s_waitcnt vmcnt(0)" ::: "memory");
            const unsigned og = xb_add(&bar[XB_TOP], 1u);
            const unsigned tg = og / nx;
            if (og + 1u == (tg + 1u) * nx) xb_add(&bar[XB_TOPGEN], 1u);
            else XB_SPIN(xb_ld(&bar[XB_TOPGEN]) == tg, bar);
            __builtin_amdgcn_fence(__ATOMIC_ACQUIRE, "agent");
            xb_add(&bar[XB_XGEN(b.x)], 1u);
            asm volatile("s_waitcnt vmcnt(0)" ::: "memory");
        } else {
            XB_SPIN(xb_ld(&bar[XB_XGEN(b.x)]) == gen, bar);
            __builtin_amdgcn_fence(__ATOMIC_ACQUIRE, "agent");
            asm volatile("s_waitcnt vmcnt(0)" ::: "memory");
        }
    }
    __syncthreads();
}

struct Frame {
    LAS unsigned char* lds;
    volatile LAS unsigned* MISC;
    gu32* ctl;
    int tid, lane, wave, G;
    unsigned long long tp;
    float* out; unsigned char* ws;
};
#define WSP(T, off) ((T*)(F.ws + (off)))
#define WSL(T, off) ((T*)(ws_ + (off)))
#define LAUNDER_WS() unsigned char* ws_ = F.ws; asm volatile("" : "+s"(ws_))
constexpr int PTR_OFF = MISC_OFF + 128;
enum { I_XP = 0, I_XS, I_C1, I_C2, I_C3, I_ST0, I_RELB, I_WIN, I_WG2, I_BG, I_GN, I_WA, I_WB, I_WO, I_L1G, I_L1B, I_WQ, I_KEYS, I_PU, I_PV, I_L2G, I_L2B };
__device__ __forceinline__ const float* inptr(const Frame& F, int i) {
    const unsigned long long v = ((volatile LAS unsigned long long*)(F.lds + PTR_OFF))[i];
    const unsigned lo = __builtin_amdgcn_readfirstlane((unsigned)v), hi = __builtin_amdgcn_readfirstlane((unsigned)(v >> 32));
    return (const float*)(((unsigned long long)hi << 32) | lo);
}

__device__ __forceinline__ void p0_tr_load(const float* W, int N, int nsrc0, int k0, int lane, float (&v)[32]) {
#pragma unroll
    for (int i = 0; i < 32; ++i) { const int kk = 2 * i + (lane >> 5); v[i] = W[(size_t)(k0 + kk) * N + nsrc0 + (lane & 31)]; }
}
__device__ __forceinline__ void p0_tr_finish(const float (&v)[32], int K, bf16* WT, int ndst0, int k0, LAS float* scr, int lane) {
#pragma unroll
    for (int i = 0; i < 32; ++i) { const int kk = 2 * i + (lane >> 5); scr[kk * 33 + (lane & 31)] = v[i]; }
    LDS_WAIT(); asm volatile("" ::: "memory");
    const int c = lane & 7;
#pragma unroll
    for (int j = 0; j < 4; ++j) { const int n = (lane >> 3) + 8 * j; const LAS float* s = scr + (8 * c) * 33 + n;
        v4u o; o.x = cvt_pk_bf16(s[0 * 33], s[1 * 33]); o.y = cvt_pk_bf16(s[2 * 33], s[3 * 33]); o.z = cvt_pk_bf16(s[4 * 33], s[5 * 33]); o.w = cvt_pk_bf16(s[6 * 33], s[7 * 33]);
        *(GAS v4u*)(WT + (size_t)(ndst0 + n) * K + k0 + 8 * c) = o; }
    LDS_WAIT(); asm volatile("" ::: "memory");
}
__device__ __forceinline__ void p0_cvt8(const float* src, bf16* dst, size_t n8, size_t gt, size_t ngt) {
    for (size_t i = gt; i < n8; i += ngt) { const f32x4 a = *(const f32x4*)(src + i * 8), b = *(const f32x4*)(src + i * 8 + 4);
        v4u o; o.x = cvt_pk_bf16(a[0], a[1]); o.y = cvt_pk_bf16(a[2], a[3]); o.z = cvt_pk_bf16(b[0], b[1]); o.w = cvt_pk_bf16(b[2], b[3]); *(v4u*)(dst + i * 8) = o; }
}
typedef float f32x2_t __attribute__((ext_vector_type(2)));
typedef _Float16 h2_t __attribute__((ext_vector_type(2)));
constexpr float U_SCALE = 1024.0f, V_SCALE = 128.0f, X_SCALE = 16.0f;
__device__ __forceinline__ void p0_cvt_fp8(const float* src, unsigned char* dst, float scale, size_t n16, size_t gt, size_t ngt) {
    for (size_t i = gt; i < n16; i += ngt) { v4u o;
#pragma unroll
        for (int q = 0; q < 4; ++q) { const f32x4 a = *(const f32x4*)(src + i * 16 + 4 * q) * scale; int w = 0;
            w = __builtin_amdgcn_cvt_pk_fp8_f32(a[0], a[1], w, false); w = __builtin_amdgcn_cvt_pk_fp8_f32(a[2], a[3], w, true); o[q] = (unsigned)w; }
        const size_t e = i >> 6, q16 = i & 63;
        *(v4u*)(dst + (((q16 >> 3) * 16384 + e) << 7) + 16 * (q16 & 7)) = o; }
}
__device__ __forceinline__ void p0_kvshift(const float* src, float* dst, int Wb, size_t gt, size_t ngt) {
    const size_t n4 = (size_t)(Wb - 4) * 256, tot = n4 * 32;
    for (size_t i = gt; i < tot; i += ngt) { const size_t b = i / n4, r = i - b * n4;
        ((f32x4*)dst)[b * (size_t)Wb * 256 + r] = ((const f32x4*)src)[b * (size_t)Wb * 256 + 1024 + r]; }
}
__device__ __forceinline__ void p0_prologue(Frame& F) {
    const int gw = blockIdx.x * NWAVES + F.wave, NGW = F.G * NWAVES;
    const size_t gt = (size_t)blockIdx.x * NTHR + F.tid, ngt = (size_t)F.G * NTHR;
    const float* win = inptr(F, I_WIN); const float* xp = inptr(F, I_XP); const float* xs = inptr(F, I_XS);
    constexpr int WROW = 2064;
    for (int i = F.tid; i < 4096; i += NTHR) {
        const int k = i >> 2, c4 = (i & 3) * 4; const f32x4 w4 = *(const f32x4*)(win + (size_t)k * INW + ABCOL + c4);
#pragma unroll
        for (int cc = 0; cc < 4; ++cc) *(LAS unsigned short*)(F.lds + (c4 + cc) * WROW + k * 2) = f2bf(w4[cc]); }
    __syncthreads();
    bf16* XB = WSP(bf16, WS_XB); float* AB = WSP(float, WS_AB);
    {   const int lane = F.lane, r = lane & 15, kg = lane >> 4;
        typedef float f32x4a __attribute__((ext_vector_type(4)));
        for (int blk = gw; blk < MPAD / 16; blk += NGW) {
            const int m = 16 * blk + r;
            bf16* xo = XB + (size_t)m * 1024 + 8 * kg;
            if (16 * blk >= NTOK) {
#pragma unroll 8
                for (int s = 0; s < 32; ++s) *(v4u*)(xo + 32 * s) = (v4u){0u, 0u, 0u, 0u};
                if (kg == 0) { *(f32x4*)(AB + (size_t)m * 16) = (f32x4){0.f, 0.f, 0.f, 0.f}; *(f32x4*)(AB + (size_t)m * 16 + 4) = (f32x4){0.f, 0.f, 0.f, 0.f}; *(f32x4*)(AB + (size_t)m * 16 + 8) = (f32x4){0.f, 0.f, 0.f, 0.f}; *(f32x4*)(AB + (size_t)m * 16 + 12) = (f32x4){0.f, 0.f, 0.f, 0.f}; }
                continue; }
            const float* xr = (m < NP ? xp + (size_t)m * 1024 : xs + (size_t)(m - NP) * 1024) + 8 * kg;
            f32x4a acc = {0.f, 0.f, 0.f, 0.f};
#pragma unroll 1
            for (int s0 = 0; s0 < 32; s0 += 16) {
                f32x4 xa[16], xb[16];
#pragma unroll
                for (int u = 0; u < 16; ++u) { xa[u] = *(const f32x4*)(xr + 32 * (s0 + u)); xb[u] = *(const f32x4*)(xr + 32 * (s0 + u) + 4); }
#pragma unroll
                for (int u = 0; u < 16; ++u) { v4u w; w.x = cvt_pk_bf16(xa[u][0], xa[u][1]); w.y = cvt_pk_bf16(xa[u][2], xa[u][3]); w.z = cvt_pk_bf16(xb[u][0], xb[u][1]); w.w = cvt_pk_bf16(xb[u][2], xb[u][3]);
                    *(v4u*)(xo + 32 * (s0 + u)) = w;
                    const bf16x8 bfr = *(const LAS bf16x8*)(F.lds + r * WROW + (32 * (s0 + u) + 8 * kg) * 2);
                    acc = __builtin_amdgcn_mfma_f32_16x16x32_bf16(__builtin_bit_cast(bf16x8, w), bfr, acc, 0, 0, 0); }
            }
#pragma unroll
            for (int i2 = 0; i2 < 4; ++i2) AB[(size_t)(16 * blk + 4 * kg + i2) * 16 + r] = acc[i2];
        }
    }
    __syncthreads();
    LAS float* scr = (LAS float*)(F.lds + F.wave * 16384);
    const float* wa = inptr(F, I_WA); const float* wb = inptr(F, I_WB); const float* wo = inptr(F, I_WO); const float* wq = inptr(F, I_WQ);
    constexpr int I_IN = 16 * (NPROJ / 32), I_A = 8 * 32, I_B = 16 * 32, I_O = 16 * 32, I_Q = 16 * 64, NIT = I_IN + I_A + I_B + I_O + I_Q;
#define P0_TR_PARAMS(IT, W_, WT_, K_, N_, NS_, ND_, K0_) { int r = (IT); \
        if (r < I_IN) { const int nb = r % (NPROJ / 32), kb = r / (NPROJ / 32), nd = 32 * nb; W_ = win; WT_ = WSP(bf16, WS_WIN); K_ = 1024; N_ = INW; NS_ = nd + (nd >= ABCOL ? 16 : 0); ND_ = nd; K0_ = 64 * kb; } \
        else if ((r -= I_IN) < I_A) { W_ = wa; WT_ = WSP(bf16, WS_WA); K_ = 512; N_ = 1024; NS_ = ND_ = 32 * (r % 32); K0_ = 64 * (r / 32); } \
        else if ((r -= I_A) < I_B) { W_ = wb; WT_ = WSP(bf16, WS_WB); K_ = 1024; N_ = 1024; NS_ = ND_ = 32 * (r % 32); K0_ = 64 * (r / 32); } \
        else if ((r -= I_B) < I_O) { W_ = wo; WT_ = WSP(bf16, WS_WO); K_ = 1024; N_ = 1024; NS_ = ND_ = 32 * (r % 32); K0_ = 64 * (r / 32); } \
        else { r -= I_O; W_ = wq; WT_ = WSP(bf16, WS_WQ); K_ = 1024; N_ = 2048; NS_ = ND_ = 32 * (r % 64); K0_ = 64 * (r / 64); } }
    if (blockIdx.x != 0) {
        const int NW2 = NGW - NWAVES;
        for (int it = gw - NWAVES; it < NIT; it += 2 * NW2) {
            const int it2 = it + NW2; const bool has2 = it2 < NIT;
            const float* Wa; bf16* WTa; int Ka, Na, NSa, NDa, K0a; P0_TR_PARAMS(it, Wa, WTa, Ka, Na, NSa, NDa, K0a);
            const float* Wb = Wa; bf16* WTb = WTa; int Kb = Ka, Nb = Na, NSb = NSa, NDb = NDa, K0b = K0a;
            if (has2) P0_TR_PARAMS(it2, Wb, WTb, Kb, Nb, NSb, NDb, K0b);
            float va[32], vb[32];
            p0_tr_load(Wa, Na, NSa, K0a, F.lane, va);
            if (has2) p0_tr_load(Wb, Nb, NSb, K0b, F.lane, vb);
            p0_tr_finish(va, Ka, WTa, NDa, K0a, scr, F.lane);
            if (has2) p0_tr_finish(vb, Kb, WTb, NDb, K0b, scr, F.lane);
        }
    }
    p0_cvt_fp8(inptr(F, I_PU), WSP(unsigned char, WS_UT), U_SCALE, (size_t)16384 * 1024 / 16, gt, ngt);
    p0_cvt_fp8(inptr(F, I_PV), WSP(unsigned char, WS_VT), V_SCALE, (size_t)16384 * 1024 / 16, gt, ngt);
    p0_cvt8(inptr(F, I_KEYS), WSP(bf16, WS_KEYS), (size_t)8 * 2 * 128 * 128 / 8, gt, ngt);
    if (gt < 3 * 8 * 129) { const int g = (int)gt / (8 * 129), h = ((int)gt / 129) % 8, rel = (int)gt % 129; const int dil = g == 0 ? 1 : (g == 1 ? 4 : 16), dist = rel * dil;
        int bucket = dist;
        if (dist >= 16) { const float dd = (float)dist; int lg = 16 + (int)(logf(dd / 16.0f) / 4.852030263919617f * 16.0f); bucket = lg < 31 ? lg : 31; }
        WSP(float, WS_LUT)[gt] = inptr(F, I_RELB)[bucket * 24 + g * 8 + h]; }
}

constexpr size_t WS_KD = WS_OAM, WS_DEC = WS_OBN;
__device__ __forceinline__ void gla_prep_load(Frame& F, int unit, unsigned (&qv)[8], unsigned (&kv)[8], float (&abv)[2]) {
    const int d2 = F.tid & 63, ig = F.wave, h = unit & 3, n = (unit >> 2) & 63, b = unit >> 8;
    const size_t m0 = (size_t)b * TSEQ + (size_t)n * 64;
    const bf16* QB = WSP(bf16, WS_QB); const bf16* KB = WSP(bf16, WS_KB); const float* AB = WSP(float, WS_AB);
#pragma unroll
    for (int ii = 0; ii < 8; ++ii) { const size_t off = (m0 + 8 * ig + ii) * 512 + h * 128 + 2 * d2; qv[ii] = *(const unsigned*)(QB + off); kv[ii] = *(const unsigned*)(KB + off); }
    abv[0] = AB[(m0 + 8 * ig) * 16 + d2]; abv[1] = AB[(m0 + 8 * ig) * 16 + 64 + d2];
}
__device__ __forceinline__ void gla_prep_unit(Frame& F, int unit, const unsigned (&qv)[8], const unsigned (&kv)[8], const float (&abv)[2], const f32x2_t (&wg)[16], const f32x2_t bgd) {
    LAUNDER_WS();
    LAS float* GT = (LAS float*)F.lds;
    const int tid = F.tid, d2 = tid & 63, ig = F.wave;
    const int h = unit & 3, n = (unit >> 2) & 63, b = unit >> 8;
    const size_t m0 = (size_t)b * TSEQ + (size_t)n * 64;
    bf16* QB = WSL(bf16, WS_QB); bf16* KB = WSL(bf16, WS_KB); float* DEC = WSL(float, WS_DEC);
    f32x2_t c[8]; f32x2_t run = {0.f, 0.f};
#pragma unroll
    for (int ii = 0; ii < 8; ++ii) {
        f32x2_t x = bgd;
#pragma unroll
        for (int r = 0; r < 16; ++r) x += wg[r] * __uint_as_float((unsigned)__builtin_amdgcn_readlane((int)__float_as_uint(abv[ii >> 2]), 16 * (ii & 3) + r));
        f32x2_t ls; ls.x = fminf(x.x, 0.f) - __logf(1.0f + __expf(-fabsf(x.x))); ls.y = fminf(x.y, 0.f) - __logf(1.0f + __expf(-fabsf(x.y)));
        run += ls * (1.0f / 16.0f); c[ii] = run;
    }
    *(LAS f32x2_t*)(GT + ig * 128 + 2 * d2) = run;
    __syncthreads();
    f32x2_t offs = {0.f, 0.f}, bl = {0.f, 0.f};
#pragma unroll
    for (int g = 0; g < 8; ++g) { const f32x2_t t = *(const LAS f32x2_t*)(GT + g * 128 + 2 * d2); bl += t; if (g < ig) offs += t; }
    const f32x2_t ebl = {__expf(bl.x), __expf(bl.y)};
#pragma unroll
    for (int ii = 0; ii < 8; ++ii) {
        const f32x2_t bb = offs + c[ii]; const f32x2_t eb = {__expf(bb.x), __expf(bb.y)}, ieb = {__expf(-bb.x), __expf(-bb.y)};
        const f32x2_t q = {bf_lo(qv[ii]), bf_hi(qv[ii])}, k = {bf_lo(kv[ii]), bf_hi(kv[ii])};
        const f32x2_t qe = q * GLA_QSCALE * eb, ke = k * ieb;
        const size_t off = (m0 + 8 * ig + ii) * 512 + h * 128 + 2 * d2;
        *(unsigned*)(QB + off) = cvt_pk_bf16(qe.x, qe.y); *(unsigned*)(KB + off) = cvt_pk_bf16(ke.x, ke.y);
    }
    if (ig == 0) *(f32x2_t*)(DEC + ((size_t)b * 64 + n) * 512 + h * 128 + 2 * d2) = ebl;
    __syncthreads();
}
__device__ __forceinline__ void gla_prompt_unit(Frame& F, int b, int h, int sl) {
    LAUNDER_WS();
    LAS unsigned char* L = F.lds;
    constexpr int O_QE = 0, O_KE = 17408, O_KD = 34816, O_VT = 55296, O_SB = 67584, O_DEC = 92160;
    const int tid = F.tid, lane = F.lane, w = F.wave, hh = lane >> 5;
    const bf16* QB = WSL(bf16, WS_QB); const bf16* KB = WSL(bf16, WS_KB); bf16* VB = WSL(bf16, WS_VB); const float* DEC = WSL(float, WS_DEC);
    for (int i = tid; i < 128 * 192 / 4; i += NTHR) ((LAS unsigned*)(L + O_SB))[i] = 0u;
    f32x16 S;
#pragma unroll
    for (int r = 0; r < 16; ++r) S[r] = 0.f;
    const int dt = w >> 1, et = w & 1;
    const int r0 = tid >> 4, c0 = tid & 15;
    v4u tq[2], tk[2], tv; float tdec = 0.f;
#define GLA_LOAD(n_) do { const size_t m0_ = (size_t)b * TSEQ + (size_t)(n_) * 64; \
        _Pragma("unroll") for (int i_ = 0; i_ < 2; ++i_) { const size_t off_ = (m0_ + r0 + 32 * i_) * 512 + h * 128 + c0 * 8; tq[i_] = *(const v4u*)(QB + off_); tk[i_] = *(const v4u*)(KB + off_); } \
        tv = *(const v4u*)(VB + (m0_ + (tid >> 3)) * 1024 + h * 256 + sl * 64 + (tid & 7) * 8); \
        if (tid < 128) tdec = DEC[((size_t)b * 64 + (n_)) * 512 + h * 128 + tid]; } while (0)
    GLA_LOAD(0);
    for (int n = 0; n < 64; ++n) {
        const size_t m0 = (size_t)b * TSEQ + (size_t)n * 64;
#pragma unroll
        for (int i = 0; i < 2; ++i) { *(LAS v4u*)(L + O_QE + (r0 + 32 * i) * 272 + c0 * 16) = tq[i]; *(LAS v4u*)(L + O_KE + (r0 + 32 * i) * 272 + c0 * 16) = tk[i]; *(LAS v4u*)(L + O_KD + (r0 + 32 * i) * 320 + c0 * 16) = tk[i]; }
        *(LAS v4u*)(L + O_VT + (tid >> 3) * 192 + (tid & 7) * 16) = tv;
        if (tid < 128) ((LAS float*)(L + O_DEC))[tid] = tdec;
        __syncthreads();
        if (n + 1 < 64) GLA_LOAD(n + 1);
        if (w < 4) {
            const int it = w >> 1;
            f32x16 o;
#pragma unroll
            for (int r = 0; r < 16; ++r) o[r] = 0.f;
            for (int jt = 0; jt <= it; ++jt) {
                f32x16 X;
#pragma unroll
                for (int r = 0; r < 16; ++r) X[r] = 0.f;
#pragma unroll
                for (int s = 0; s < 8; ++s) X = MFMA32(frag_row(L + O_KE, 272, 32 * jt, 16 * s, lane), frag_row(L + O_QE, 272, 32 * it, 16 * s, lane), X);
                if (jt == it) {
#pragma unroll
                    for (int r = 0; r < 16; ++r) if (crow(r, hh) > (lane & 31)) X[r] = 0.f;
                }
#pragma unroll
                for (int s2 = 0; s2 < 2; ++s2) o = MFMA32(pack_acc(X, s2), frag_tr<true>(L + O_VT, 192, 32 * jt + 16 * s2, 32 * et, lane), o);
            }
#pragma unroll
            for (int s = 0; s < 8; ++s) o = MFMA32(frag_row(L + O_QE, 272, 32 * it, 16 * s, lane), frag_tr<false>(L + O_SB, 192, 16 * s, 32 * et, lane), o);
            bf16* op = VB + (m0 + 32 * it) * 1024 + h * 256 + sl * 64 + 32 * et + (lane & 31);
#pragma unroll
            for (int r = 0; r < 16; ++r) op[(size_t)crow(r, hh) * 1024] = f2bf(o[r]);
        }
        {
#pragma unroll
            for (int s = 0; s < 4; ++s) S = MFMA32(frag_tr<false>(L + O_KD, 320, 16 * s, 32 * dt, lane), frag_tr<false>(L + O_VT, 192, 16 * s, 32 * et, lane), S);
#pragma unroll
            for (int r = 0; r < 16; ++r) S[r] *= ((LAS float*)(L + O_DEC))[32 * dt + crow(r, hh)];
        }
        __syncthreads();
#pragma unroll
        for (int r = 0; r < 16; ++r) *(LAS unsigned short*)(L + O_SB + (32 * dt + crow(r, hh)) * 192 + (32 * et + (lane & 31)) * 2) = f2bf(S[r]);
    }
#undef GLA_LOAD
    float* so = F.out + OUT_STP + ((size_t)(b * 4 + h) * 128 + 32 * dt) * 256 + sl * 64 + 32 * et + (lane & 31);
#pragma unroll
    for (int r = 0; r < 16; ++r) so[(size_t)crow(r, hh) * 256] = S[r];
    __syncthreads();
}

struct AttnItem { int b, h, g, r, dil, i0, cb; size_t tok0; };
__device__ __forceinline__ AttnItem attn_decode(int item) {
    AttnItem a; const int bh = item / 48, sub = item % 48; a.b = bh >> 3; a.h = bh & 7;
    int ibg;
    if (sub < 16) { a.g = 0; a.r = 0; ibg = sub; } else if (sub < 32) { a.g = 1; a.r = (sub - 16) >> 2; ibg = (sub - 16) & 3; } else { a.g = 2; a.r = sub - 32; ibg = 0; }
    a.dil = a.g == 0 ? 1 : (a.g == 1 ? 4 : 16); a.i0 = 256 * ibg; a.tok0 = (size_t)a.b * TSEQ + a.r; a.cb = a.g * 512 + a.h * 64;
    return a;
}
__device__ __forceinline__ void attn_issue(Frame& F, int item, v4u (&kk)[6], v4u (&vv)[6], bf16x8 (&qf)[4]) {
    LAUNDER_WS();
    const AttnItem a = attn_decode(item);
    const int tid = F.tid, lane = F.lane, w = F.wave, hh = lane >> 5, il = lane & 31;
    const bf16* QA = WSL(bf16, WS_QA); const bf16* KA = WSL(bf16, WS_KA); const bf16* VA = WSL(bf16, WS_VA);
    const size_t qtok = a.tok0 + (size_t)a.dil * (a.i0 + 32 * w + il);
#pragma unroll
    for (int s = 0; s < 4; ++s) qf[s] = *(const bf16x8*)(QA + qtok * 1536 + a.cb + 16 * s + 8 * hh);
#pragma unroll
    for (int p = 0; p < 6; ++p) { const int idx = tid + NTHR * p, rr = idx >> 3, ch = idx & 7, j = a.i0 - 128 + rr;
        if (j >= 0) { const size_t so = (a.tok0 + (size_t)a.dil * j) * 1536 + a.cb + ch * 8; vv[p] = *(const v4u*)(VA + so); kk[p] = *(const v4u*)(KA + so); } }
}
__device__ __forceinline__ void attn_prompt_item(Frame& F, int item, v4u (&kk)[6], v4u (&vv)[6], const bf16x8 (&qf)[4], bool has_next, int next_item, bf16x8 (&qn)[4]) {
    LAUNDER_WS();
    LAS unsigned char* L = F.lds;
    constexpr int O_V = 0, O_K = 384 * 192, O_LUT = O_K + 384 * 144;
    static_assert(O_LUT + 129 * 4 <= RING_BYTES, "attention LDS");
    const int tid = F.tid, lane = F.lane, w = F.wave, hh = lane >> 5, il = lane & 31;
    const AttnItem a = attn_decode(item);
    const int b = a.b, h = a.h, g = a.g, dil = a.dil, i0 = a.i0, cb = a.cb; const size_t tok0 = a.tok0; (void)b;
    bf16* QA = WSL(bf16, WS_QA); float* LSE = WSL(float, WS_LSE);
    const size_t qtok = tok0 + (size_t)dil * (i0 + 32 * w + il);
#pragma unroll
    for (int p = 0; p < 6; ++p) { const int idx = tid + NTHR * p, rr = idx >> 3, ch = idx & 7, j = i0 - 128 + rr;
        if (j >= 0) { *(LAS v4u*)(L + O_V + rr * 192 + ch * 16) = vv[p]; *(LAS v4u*)(L + O_K + rr * 144 + ch * 16) = kk[p]; } }
    if (tid < 129) ((LAS float*)(L + O_LUT))[tid] = WSL(float, WS_LUT)[(g * 8 + h) * 129 + tid];
    __syncthreads();
    if (has_next) attn_issue(F, next_item, kk, vv, qn);
    float mrun = NEG_BIG, lrun = 0.f;
    f32x16 O0, O1;
#pragma unroll
    for (int x = 0; x < 16; ++x) { O0[x] = 0.f; O1[x] = 0.f; }
#pragma unroll 1
    for (int kt = 0; kt < 5; ++kt) {
        const int jb = i0 + 32 * (w + kt) - 128;
        if (jb < 0) continue;
        f32x16 ST;
#pragma unroll
        for (int x = 0; x < 16; ++x) ST[x] = 0.f;
#pragma unroll
        for (int s = 0; s < 4; ++s) ST = MFMA32(frag_row(L + O_K, 144, 32 * (w + kt), 16 * s, lane), qf[s], ST);
        const int relb = 128 - 32 * kt + il;
        float tmax = NEG_BIG;
#pragma unroll
        for (int x = 0; x < 16; ++x) { const int rel = relb - crow(x, hh); const bool ok = rel >= 0 && rel <= 128; const int rc = rel < 0 ? 0 : (rel > 128 ? 128 : rel);
            const float sc = ok ? ST[x] + ((LAS float*)(L + O_LUT))[rc] : NEG_BIG; ST[x] = sc; tmax = fmaxf(tmax, sc); }
        tmax = fmaxf(tmax, __shfl_xor(tmax, 32));
        const float mnew = fmaxf(mrun, tmax), alpha = __expf(mrun - mnew);
        float ps = 0.f;
#pragma unroll
        for (int x = 0; x < 16; ++x) { const float p = __expf(ST[x] - mnew); ST[x] = p; ps += p; }
        lrun = lrun * alpha + ps; mrun = mnew;
#pragma unroll
        for (int x = 0; x < 16; ++x) { O0[x] *= alpha; O1[x] *= alpha; }
#pragma unroll
        for (int s2 = 0; s2 < 2; ++s2) { const bf16x8 pf = pack_acc(ST, s2);
            O0 = MFMA32(frag_tr<true>(L + O_V, 192, 32 * (w + kt) + 16 * s2, 0, lane), pf, O0);
            O1 = MFMA32(frag_tr<true>(L + O_V, 192, 32 * (w + kt) + 16 * s2, 32, lane), pf, O1); }
    }
    const float ltot = lrun + __shfl_xor(lrun, 32), inv = 1.0f / ltot;
    bf16* op = QA + qtok * 1536 + cb;
#pragma unroll
    for (int k4 = 0; k4 < 4; ++k4) { v2u a, c2;
        a.x = cvt_pk_bf16(O0[4 * k4] * inv, O0[4 * k4 + 1] * inv); a.y = cvt_pk_bf16(O0[4 * k4 + 2] * inv, O0[4 * k4 + 3] * inv);
        c2.x = cvt_pk_bf16(O1[4 * k4] * inv, O1[4 * k4 + 1] * inv); c2.y = cvt_pk_bf16(O1[4 * k4 + 2] * inv, O1[4 * k4 + 3] * inv);
        *(v2u*)(op + 8 * k4 + 4 * hh) = a; *(v2u*)(op + 32 + 8 * k4 + 4 * hh) = c2; }
    if (hh == 0) LSE[((size_t)g * MPAD + qtok) * 8 + h] = mrun + __logf(ltot);
    __syncthreads();
}

#define DPP_FA(x, ctrl) __uint_as_float((unsigned)__builtin_amdgcn_mov_dpp((int)__float_as_uint(x), (ctrl), 0xf, 0xf, true))
template <int G_> __device__ __forceinline__ void attn_sample_waveitem_g(Frame& F, int wi, const float* cache) {
    LAUNDER_WS();
    int lane = F.lane; asm volatile("" : "+v"(lane));
    const int grp = lane >> 4, l16 = lane & 15;
    constexpr int g = G_; const int h = (wi / 3) & 7, s = (wi / 24) & 3, b = wi / 96;
    constexpr int dil = g == 0 ? 1 : (g == 1 ? 4 : 16), Wb = 128 * dil;
    bf16* QA = WSL(bf16, WS_QA); const bf16* KA = WSL(bf16, WS_KA); const bf16* VA = WSL(bf16, WS_VA); float* LSE = WSL(float, WS_LSE);
    const size_t qrow = (size_t)NP + b * 4 + s; const int cb = g * 512 + h * 64;
    const v2u qu = *(const v2u*)(QA + qrow * 1536 + cb + 4 * l16);
    const float q0 = bf_lo(qu.x), q1 = bf_hi(qu.x), q2 = bf_lo(qu.y), q3 = bf_hi(qu.y);
    const float* lut = WSL(float, WS_LUT) + (g * 8 + h) * 129;
    const float* kc = cache + ((size_t)b * Wb * 2) * 512 + h * 64 + 4 * l16;
    const bf16* kn = KA + ((size_t)NP + b * 4) * 1536 + cb + 4 * l16; const bf16* vn = VA + ((size_t)NP + b * 4) * 1536 + cb + 4 * l16;
    float sc[33];
#pragma unroll
    for (int i0 = 0; i0 < 33; i0 += 11) { f32x4 kv[11]; float lb[11];
#pragma unroll
        for (int u = 0; u < 11; ++u) { const int jj = 4 * (i0 + u) + grp; kv[u] = (f32x4){0.f, 0.f, 0.f, 0.f}; lb[u] = 0.f;
            if (jj <= 128) { const int idx = Wb + s - jj * dil; lb[u] = lut[jj];
                if (idx >= Wb) { const v2u w2 = *(const v2u*)(kn + (size_t)(idx - Wb) * 1536); kv[u] = (f32x4){bf_lo(w2.x), bf_hi(w2.x), bf_lo(w2.y), bf_hi(w2.y)}; }
                else kv[u] = *(const f32x4*)(kc + (size_t)idx * 1024); } }
#pragma unroll
        for (int u = 0; u < 11; ++u) { const int jj = 4 * (i0 + u) + grp;
            float a = (q0 * kv[u][0] + q1 * kv[u][1]) + (q2 * kv[u][2] + q3 * kv[u][3]);
            a += DPP_FA(a, 0xB1); a += DPP_FA(a, 0x4E); a += DPP_FA(a, 0x141); a += DPP_FA(a, 0x128);
            sc[i0 + u] = jj <= 128 ? a + lb[u] : NEG_BIG; }
    }
    float mx = sc[0];
#pragma unroll
    for (int i = 1; i < 33; ++i) mx = fmaxf(mx, sc[i]);
    mx = fmaxf(mx, __shfl_xor(mx, 16)); mx = fmaxf(mx, __shfl_xor(mx, 32));
    float ps = 0.f;
#pragma unroll
    for (int i = 0; i < 33; ++i) { sc[i] = __expf(sc[i] - mx); ps += sc[i]; }
    ps += __shfl_xor(ps, 16); ps += __shfl_xor(ps, 32);
    f32x4 o = {0.f, 0.f, 0.f, 0.f};
#pragma unroll
    for (int i0 = 0; i0 < 33; i0 += 11) { f32x4 vv[11];
#pragma unroll
        for (int u = 0; u < 11; ++u) { const int jj = 4 * (i0 + u) + grp; vv[u] = (f32x4){0.f, 0.f, 0.f, 0.f};
            if (jj <= 128) { const int idx = Wb + s - jj * dil;
                if (idx >= Wb) { const v2u w2 = *(const v2u*)(vn + (size_t)(idx - Wb) * 1536); vv[u] = (f32x4){bf_lo(w2.x), bf_hi(w2.x), bf_lo(w2.y), bf_hi(w2.y)}; }
                else vv[u] = *(const f32x4*)(kc + (size_t)idx * 1024 + 512); } }
#pragma unroll
        for (int u = 0; u < 11; ++u) o += vv[u] * sc[i0 + u];
    }
#pragma unroll
    for (int k = 0; k < 4; ++k) { o[k] += __shfl_xor(o[k], 16); o[k] += __shfl_xor(o[k], 32); }
    const float inv = 1.0f / ps;
    if (grp == 0) { v2u w2; w2.x = cvt_pk_bf16(o[0] * inv, o[1] * inv); w2.y = cvt_pk_bf16(o[2] * inv, o[3] * inv); *(v2u*)(QA + qrow * 1536 + cb + 4 * l16) = w2; }
    if (lane == 0) LSE[((size_t)g * MPAD + qrow) * 8 + h] = mx + __logf(ps);
}

__device__ __forceinline__ void attn_sample_waveitem(Frame& F, int wi) {
    const int g = wi % 3;
    if (g == 0) attn_sample_waveitem_g<0>(F, wi, inptr(F, I_C1)); else if (g == 1) attn_sample_waveitem_g<1>(F, wi, inptr(F, I_C2)); else attn_sample_waveitem_g<2>(F, wi, inptr(F, I_C3));
}
__device__ __forceinline__ void gla_sample_item(Frame& F, int item) {
    LAUNDER_WS();
    LAS float* L = (LAS float*)F.lds;
    constexpr int O_LA = 0, O_QE = 512, O_KE = 1024, O_KD = 1536, O_DEC = 2048, O_ATT = 2176, O_PART = 2304;
    const int tid = F.tid, b = item >> 2, h = item & 3;
    const bf16* QB = WSL(bf16, WS_QB); const bf16* KB = WSL(bf16, WS_KB); bf16* VB = WSL(bf16, WS_VB); const float* AB = WSL(float, WS_AB);
    const size_t row0 = (size_t)NP + b * 4;
    { const int i = tid >> 7, d = tid & 127; float x = inptr(F, I_BG)[h * 128 + d]; const float* wg2 = inptr(F, I_WG2);
#pragma unroll
      for (int r = 0; r < 16; ++r) x += AB[(row0 + i) * 16 + r] * wg2[r * 512 + h * 128 + d];
      L[O_LA + i * 128 + d] = (fminf(x, 0.f) - log1pf(expf(-fabsf(x)))) * (1.0f / 16.0f); }
    __syncthreads();
    if (tid < 128) { const int d = tid; float bb[4]; float run = 0.f;
#pragma unroll
        for (int i = 0; i < 4; ++i) { run += L[O_LA + i * 128 + d]; bb[i] = run; }
        const float ebl = expf(run); L[O_DEC + d] = ebl;
#pragma unroll
        for (int i = 0; i < 4; ++i) { const float q = bf2f(QB[(row0 + i) * 512 + h * 128 + d]), k = bf2f(KB[(row0 + i) * 512 + h * 128 + d]);
            L[O_QE + i * 128 + d] = q * GLA_QSCALE * expf(bb[i]); L[O_KE + i * 128 + d] = k * expf(-bb[i]); L[O_KD + i * 128 + d] = k * expf(run - bb[i]); } }
    __syncthreads();
    if (tid < 16) { const int i = tid >> 2, j = tid & 3; float a = 0.f;
        if (j <= i) for (int d = 0; d < 128; ++d) a += L[O_QE + i * 128 + d] * L[O_KE + j * 128 + d];
        L[O_ATT + tid] = a; }
    const int e = tid & 255, dh = tid >> 8;
    float v[4];
#pragma unroll
    for (int j = 0; j < 4; ++j) v[j] = bf2f(VB[(row0 + j) * 1024 + h * 256 + e]);
    const float* Sin = inptr(F, I_ST0) + ((size_t)(b * 4 + h) * 128) * 256 + e; float* Sout = F.out + OUT_STS + ((size_t)(b * 4 + h) * 128) * 256 + e;
    float acc[4] = {0.f, 0.f, 0.f, 0.f};
#pragma unroll 1
    for (int dd0 = 0; dd0 < 64; dd0 += 16) { float svv[16];
#pragma unroll
        for (int u = 0; u < 16; ++u) svv[u] = Sin[(size_t)(dh * 64 + dd0 + u) * 256];
#pragma unroll
        for (int u = 0; u < 16; ++u) { const int d = dh * 64 + dd0 + u; const float sv = svv[u];
#pragma unroll
            for (int i = 0; i < 4; ++i) acc[i] += L[O_QE + i * 128 + d] * sv;
            float sn = L[O_DEC + d] * sv;
#pragma unroll
            for (int j = 0; j < 4; ++j) sn += L[O_KD + j * 128 + d] * v[j];
            Sout[(size_t)d * 256] = sn; } }
#pragma unroll
    for (int i = 0; i < 4; ++i) L[O_PART + (dh * 4 + i) * 256 + e] = acc[i];
    __syncthreads();
    if (tid < 256) {
#pragma unroll
        for (int i = 0; i < 4; ++i) { float o = L[O_PART + i * 256 + e] + L[O_PART + (4 + i) * 256 + e];
#pragma unroll
            for (int j = 0; j < 4; ++j) o += L[O_ATT + i * 4 + j] * v[j];
            VB[(row0 + i) * 1024 + h * 256 + e] = f2bf(o); } }
    __syncthreads();
}

static_assert(true, "");
constexpr int P2_ATT = 3072, P2_DEC = 384, P2_GLS = 128, P2_CPY = 32 * (2 + 8 + 32), P2_ITEMS = P2_ATT + P2_DEC + P2_GLS;
__device__ __forceinline__ void kvshift_item(Frame& F, int item) {
    int g, r = item; if (r < 64) g = 0; else if (r < 64 + 256) { g = 1; r -= 64; } else { g = 2; r -= 320; }
    const int Wb = g == 0 ? 128 : (g == 1 ? 512 : 2048), npc = Wb / 64, b = r / npc, pc = r % npc;
    const float* src = inptr(F, g == 0 ? I_C1 : (g == 1 ? I_C2 : I_C3)); float* dst = F.out + (g == 0 ? OUT_KVS1 : (g == 1 ? OUT_KVS2 : OUT_KVS3));
    const int nrow = (pc == npc - 1) ? 60 : 64;
    const f32x4* s4 = (const f32x4*)src + ((size_t)b * Wb + 64 * pc + 4) * 256; f32x4* d4 = (f32x4*)dst + ((size_t)b * Wb + 64 * pc) * 256;
    { const int i = F.tid; f32x4 v[32];
#pragma unroll
        for (int u = 0; u < 32; ++u) if (u < 30 || nrow == 64) v[u] = __builtin_nontemporal_load(s4 + i + u * NTHR);
#pragma unroll
        for (int u = 0; u < 32; ++u) if (u < 30 || nrow == 64) __builtin_nontemporal_store(v[u], d4 + i + u * NTHR); }
}
template <bool STOP_ON_GDONE> __device__ __forceinline__ void kvshift_loop(Frame& F) {
    for (;;) {
        if (F.tid == 0) { unsigned t = 0xffffffffu;
            if (!STOP_ON_GDONE || __hip_atomic_load(F.ctl + CW_GDONE, RLX_AGENT) == 0u) t = __hip_atomic_fetch_add(F.ctl + CW_CPYQ, 1u, RLX_AGENT);
            F.MISC[0] = t; }
        __syncthreads();
        const unsigned t = F.MISC[0];
        __syncthreads();
        if (t >= (unsigned)P2_CPY) break;
        kvshift_item(F, (int)t);
    }
}
__device__ __forceinline__ void p2_prep(Frame& F) {
    unsigned qa[8], ka[8], qb[8], kb[8]; float aa[2], ab2[2];
    int u = blockIdx.x; if (u >= 2048) return;
    const int d2 = F.tid & 63, h = u & 3;
    const float* wg2 = inptr(F, I_WG2); const float* bgp = inptr(F, I_BG);
    f32x2_t wg[16];
#pragma unroll
    for (int r = 0; r < 16; ++r) wg[r] = *(const f32x2_t*)(wg2 + r * 512 + h * 128 + 2 * d2);
    const f32x2_t bgd = *(const f32x2_t*)(bgp + h * 128 + 2 * d2);
    gla_prep_load(F, u, qa, ka, aa);
    for (;;) {
        const int u1 = u + F.G; if (u1 < 2048) gla_prep_load(F, u1, qb, kb, ab2);
        gla_prep_unit(F, u, qa, ka, aa, wg, bgd); if (u1 >= 2048) break;
        const int u2 = u1 + F.G; if (u2 < 2048) gla_prep_load(F, u2, qa, ka, aa);
        gla_prep_unit(F, u1, qb, kb, ab2, wg, bgd); if (u2 >= 2048) break;
        u = u2;
    }
}
__device__ __forceinline__ void p2_mixers(Frame& F) {
#if defined(PROBE_PHASE) && PROBE_PHASE >= 100
    const unsigned long long tp0 = __builtin_amdgcn_s_memrealtime();
#endif
#ifndef P2_SKIP_GLAP
    if (blockIdx.x < 128) {
        const int bx = blockIdx.x, bh = (bx & 7) + 8 * (bx >> 5), sl = (bx >> 3) & 3;
        gla_prompt_unit(F, bh >> 2, bh & 3, sl); }
#endif
#if defined(PROBE_PHASE) && PROBE_PHASE == 100
    if (blockIdx.x == 0) F.tp = __builtin_amdgcn_s_memrealtime() - tp0;
#endif
    constexpr int QCHUNK = 4;
    for (int it = 0, itend = 0;; ++it) {
        if (it >= itend) {
            if (F.tid == 0) F.MISC[0] = __hip_atomic_fetch_add(F.ctl + CW_QUEUE, (unsigned)QCHUNK, RLX_AGENT);
            __syncthreads();
            it = (int)F.MISC[0]; itend = it + QCHUNK;
            __syncthreads();
        }
        if (it >= P2_ITEMS) break;
#if defined(PROBE_PHASE) && PROBE_PHASE == 101
        if (blockIdx.x == 255) F.tp = __builtin_amdgcn_s_memrealtime() - tp0;
#endif
#if defined(PROBE_PHASE) && PROBE_PHASE == 102
        if (blockIdx.x == 255 && it >= P2_GLS + P2_DEC + P2_ATT && F.tp == 0ull) F.tp = __builtin_amdgcn_s_memrealtime() - tp0;
#endif
#if defined(PROBE_PHASE) && PROBE_PHASE >= 103 && PROBE_PHASE <= 106
        const unsigned long long ti0 = __builtin_amdgcn_s_memrealtime();
        const int pcls = it < P2_GLS ? 105 : (it < P2_GLS + P2_DEC ? 104 : (it < P2_GLS + P2_DEC + P2_ATT ? 103 : 106));
#endif
        if (it < P2_GLS) {
#ifndef P2_SKIP_GLAS
            gla_sample_item(F, it);
#endif
        } else if (it < P2_GLS + P2_DEC) {
#ifndef P2_SKIP_DEC
            attn_sample_waveitem(F, (it - P2_GLS) * 8 + F.wave); __syncthreads();
#endif
        } else if (it < P2_GLS + P2_DEC + P2_ATT) {
#ifndef P2_SKIP_ATT
            const int a0 = it - P2_GLS - P2_DEC;
            v4u kk[6], vv[6]; bf16x8 qa[4], qb[4];
            attn_issue(F, a0, kk, vv, qa);
            attn_prompt_item(F, a0, kk, vv, qa, true, a0 + 1, qb);
            attn_prompt_item(F, a0 + 1, kk, vv, qb, true, a0 + 2, qa);
            attn_prompt_item(F, a0 + 2, kk, vv, qa, true, a0 + 3, qb);
            attn_prompt_item(F, a0 + 3, kk, vv, qb, false, 0, qa);
            it = itend - 1;
#endif
        }
#if defined(PROBE_PHASE) && PROBE_PHASE >= 103 && PROBE_PHASE <= 106
        if (blockIdx.x == 255 && pcls == PROBE_PHASE) F.tp += __builtin_amdgcn_s_memrealtime() - ti0;
#endif
    }
#if defined(PROBE_PHASE) && PROBE_PHASE == 107
    const unsigned long long tc0 = __builtin_amdgcn_s_memrealtime();
#endif
    kvshift_loop<false>(F);
#if defined(PROBE_PHASE) && PROBE_PHASE == 107
    if (blockIdx.x == 255) F.tp = __builtin_amdgcn_s_memrealtime() - tc0;
#endif
}

__device__ __forceinline__ void p3_kvout(const bf16* K, const bf16* V, float* dst, int g, int W, int nb, size_t rowbase, int rows_per_b, int first, int pos0, int Wdst, size_t gt, size_t ngt) {
    const size_t per_b = (size_t)W * 2 * 64, tot = per_b * nb;
    for (size_t i0 = gt; i0 < tot; i0 += 4 * ngt) { v4u u[4]; float* o[4];
#pragma unroll
        for (int k = 0; k < 4; ++k) { const size_t i = i0 + k * ngt; if (i < tot) { const size_t b = i / per_b, r = i - b * per_b; const int p = (int)(r >> 7), c = (int)(r >> 6) & 1, ch = (int)r & 63;
            u[k] = *(const v4u*)((c ? V : K) + (rowbase + b * rows_per_b + first + p) * 1536 + g * 512 + ch * 8);
            o[k] = dst + ((b * Wdst + pos0 + p) * 2 + c) * 512 + ch * 8; } }
#pragma unroll
        for (int k = 0; k < 4; ++k) if (i0 + k * ngt < tot) {
            *(f32x4*)o[k] = (f32x4){bf_lo(u[k].x), bf_hi(u[k].x), bf_lo(u[k].y), bf_hi(u[k].y)}; *(f32x4*)(o[k] + 4) = (f32x4){bf_lo(u[k].z), bf_hi(u[k].z), bf_lo(u[k].w), bf_hi(u[k].w)}; } }
}
struct MergeRow { float l0, l1, l2; v4u a, b2, c, u0, u1, r0, r1; };
__device__ __forceinline__ void p3_merge_load(const bf16* OA, const bf16* OB, const bf16* RB, const float* LSE, int m, int lane, MergeRow& R) {
    const int hd = lane >> 3, c8 = (lane & 7) * 8, c0 = lane * 16;
    R.l0 = LSE[((size_t)0 * MPAD + m) * 8 + hd]; R.l1 = LSE[((size_t)1 * MPAD + m) * 8 + hd]; R.l2 = LSE[((size_t)2 * MPAD + m) * 8 + hd];
    R.a = *(const v4u*)(OA + (size_t)m * 1536 + hd * 64 + c8); R.b2 = *(const v4u*)(OA + (size_t)m * 1536 + 512 + hd * 64 + c8); R.c = *(const v4u*)(OA + (size_t)m * 1536 + 1024 + hd * 64 + c8);
    R.u0 = *(const v4u*)(OB + (size_t)m * 1024 + c0); R.u1 = *(const v4u*)(OB + (size_t)m * 1024 + c0 + 8);
    R.r0 = *(const v4u*)(RB + (size_t)m * 1024 + c0); R.r1 = *(const v4u*)(RB + (size_t)m * 1024 + c0 + 8);
}
__device__ __forceinline__ void p3_merge(Frame& F) {
    const int gw = blockIdx.x * NWAVES + F.wave, NGW = F.G * NWAVES, lane = F.lane;
    const size_t gt = (size_t)blockIdx.x * NTHR + F.tid, ngt = (size_t)F.G * NTHR;
    const bf16* OA = WSP(bf16, WS_QA); const bf16* OB = WSP(bf16, WS_VB); const bf16* RB = WSP(bf16, WS_RB); const float* LSE = WSP(float, WS_LSE);
    bf16* OAM = WSP(bf16, WS_OAM); bf16* OBN = WSP(bf16, WS_OBN); const float* gn = inptr(F, I_GN);
    float gnv[16];
#pragma unroll
    for (int i = 0; i < 16; ++i) gnv[i] = gn[lane * 16 + i];
    for (int m = NTOK + gw; m < MPAD; m += NGW) {
        *(v4u*)(OAM + (size_t)m * 512 + lane * 8) = (v4u){0u, 0u, 0u, 0u}; *(v4u*)(OBN + (size_t)m * 1024 + lane * 16) = (v4u){0u, 0u, 0u, 0u}; *(v4u*)(OBN + (size_t)m * 1024 + lane * 16 + 8) = (v4u){0u, 0u, 0u, 0u}; }
    int m = gw;
    if (m < NTOK) {
        MergeRow R, Rn; p3_merge_load(OA, OB, RB, LSE, m, lane, R);
        for (;;) {
            const int mn = m + NGW; const bool more = mn < NTOK;
            if (more) p3_merge_load(OA, OB, RB, LSE, mn, lane, Rn);
            {
                const int hd = lane >> 3, c8 = (lane & 7) * 8;
                const float l0 = R.l0, l1 = R.l1, l2 = R.l2;
                const float mx = fmaxf(l0, fmaxf(l1, l2)); float w0 = __expf(l0 - mx), w1 = __expf(l1 - mx), w2 = __expf(l2 - mx); const float iw = 1.0f / (w0 + w1 + w2); w0 *= iw; w1 *= iw; w2 *= iw;
                const v4u a = R.a, b2 = R.b2, c = R.c;
                v4u o;
                o.x = cvt_pk_bf16(w0 * bf_lo(a.x) + w1 * bf_lo(b2.x) + w2 * bf_lo(c.x), w0 * bf_hi(a.x) + w1 * bf_hi(b2.x) + w2 * bf_hi(c.x));
                o.y = cvt_pk_bf16(w0 * bf_lo(a.y) + w1 * bf_lo(b2.y) + w2 * bf_lo(c.y), w0 * bf_hi(a.y) + w1 * bf_hi(b2.y) + w2 * bf_hi(c.y));
                o.z = cvt_pk_bf16(w0 * bf_lo(a.z) + w1 * bf_lo(b2.z) + w2 * bf_lo(c.z), w0 * bf_hi(a.z) + w1 * bf_hi(b2.z) + w2 * bf_hi(c.z));
                o.w = cvt_pk_bf16(w0 * bf_lo(a.w) + w1 * bf_lo(b2.w) + w2 * bf_lo(c.w), w0 * bf_hi(a.w) + w1 * bf_hi(b2.w) + w2 * bf_hi(c.w));
                *(v4u*)(OAM + (size_t)m * 512 + hd * 64 + c8) = o;
            }
            {
                const int c0 = lane * 16;
                const v4u u0 = R.u0, u1 = R.u1, r0 = R.r0, r1 = R.r1;
                float x[16] = {bf_lo(u0.x), bf_hi(u0.x), bf_lo(u0.y), bf_hi(u0.y), bf_lo(u0.z), bf_hi(u0.z), bf_lo(u0.w), bf_hi(u0.w), bf_lo(u1.x), bf_hi(u1.x), bf_lo(u1.y), bf_hi(u1.y), bf_lo(u1.z), bf_hi(u1.z), bf_lo(u1.w), bf_hi(u1.w)};
                float rr[16] = {bf_lo(r0.x), bf_hi(r0.x), bf_lo(r0.y), bf_hi(r0.y), bf_lo(r0.z), bf_hi(r0.z), bf_lo(r0.w), bf_hi(r0.w), bf_lo(r1.x), bf_hi(r1.x), bf_lo(r1.y), bf_hi(r1.y), bf_lo(r1.z), bf_hi(r1.z), bf_lo(r1.w), bf_hi(r1.w)};
                float ss = 0.f;
#pragma unroll
                for (int i = 0; i < 16; ++i) ss += x[i] * x[i];
                ss += __shfl_xor(ss, 1); ss += __shfl_xor(ss, 2); ss += __shfl_xor(ss, 4); ss += __shfl_xor(ss, 8);
                const float rs = 1.0f / sqrtf(ss * (1.0f / 256.0f) + LN_EPS);
                float y[16];
#pragma unroll
                for (int i = 0; i < 16; ++i) { const float gte = rr[i] * __builtin_amdgcn_rcpf(1.0f + __expf(-rr[i])); y[i] = x[i] * rs * gnv[i] * gte; }
                v4u o0, o1; o0.x = cvt_pk_bf16(y[0], y[1]); o0.y = cvt_pk_bf16(y[2], y[3]); o0.z = cvt_pk_bf16(y[4], y[5]); o0.w = cvt_pk_bf16(y[6], y[7]);
                o1.x = cvt_pk_bf16(y[8], y[9]); o1.y = cvt_pk_bf16(y[10], y[11]); o1.z = cvt_pk_bf16(y[12], y[13]); o1.w = cvt_pk_bf16(y[14], y[15]);
                *(v4u*)(OBN + (size_t)m * 1024 + c0) = o0; *(v4u*)(OBN + (size_t)m * 1024 + c0 + 8) = o1;
            }
            if (!more) break;
            R = Rn; m = mn;
        }
    }
    const bf16* KA = WSP(bf16, WS_KA); const bf16* VA = WSP(bf16, WS_VA);
    p3_kvout(KA, VA, F.out + OUT_KVP1, 0, 128, 8, 0, TSEQ, TSEQ - 128, 0, 128, gt, ngt);
    p3_kvout(KA, VA, F.out + OUT_KVP2, 1, 512, 8, 0, TSEQ, TSEQ - 512, 0, 512, gt, ngt);
    p3_kvout(KA, VA, F.out + OUT_KVP3, 2, 2048, 8, 0, TSEQ, TSEQ - 2048, 0, 2048, gt, ngt);
    p3_kvout(KA, VA, F.out + OUT_KVS1, 0, 4, 32, NP, 4, 0, 124, 128, gt, ngt);
    p3_kvout(KA, VA, F.out + OUT_KVS2, 1, 4, 32, NP, 4, 0, 508, 512, gt, ngt);
    p3_kvout(KA, VA, F.out + OUT_KVS3, 2, 4, 32, NP, 4, 0, 2044, 2048, gt, ngt);
}

__device__ __forceinline__ void p6_ln1(Frame& F) {
    const int gw = blockIdx.x * NWAVES + F.wave, NGW = F.G * NWAVES, lane = F.lane;
    const bf16* HB = WSP(bf16, WS_HB); bf16* X1B = WSP(bf16, WS_X1B); const float* l1g = inptr(F, I_L1G); const float* l1b = inptr(F, I_L1B);
    f32x4 gg[4], bb[4];
#pragma unroll
    for (int j = 0; j < 4; ++j) { gg[j] = ((const f32x4*)l1g)[lane + 64 * j]; bb[j] = ((const f32x4*)l1b)[lane + 64 * j]; }
    int m = gw; if (m >= MPAD) return;
    f32x4 v[4], vn[4];
#pragma unroll
    for (int j = 0; j < 4; ++j) { const v2u t = ((const v2u*)(HB + (size_t)m * 1024) + lane)[64 * j]; v[j] = (f32x4){bf_lo(t.x), bf_hi(t.x), bf_lo(t.y), bf_hi(t.y)}; }
    for (;;) {
        const int mn = m + NGW; const bool more = mn < MPAD;
        if (more) {
#pragma unroll
            for (int j = 0; j < 4; ++j) { const v2u t = ((const v2u*)(HB + (size_t)mn * 1024) + lane)[64 * j]; vn[j] = (f32x4){bf_lo(t.x), bf_hi(t.x), bf_lo(t.y), bf_hi(t.y)}; } }
        float s = 0.f;
#pragma unroll
        for (int j = 0; j < 4; ++j) s += (v[j][0] + v[j][1]) + (v[j][2] + v[j][3]);
        const float mean = wave_sum(s) * (1.f / 1024.f); float s2 = 0.f;
#pragma unroll
        for (int j = 0; j < 4; ++j) { v[j] = v[j] - mean; s2 += (v[j][0] * v[j][0] + v[j][1] * v[j][1]) + (v[j][2] * v[j][2] + v[j][3] * v[j][3]); }
        const float rstd = 1.f / sqrtf(wave_sum(s2) * (1.f / 1024.f) + LN_EPS);
        unsigned long long* o8 = (unsigned long long*)(X1B + (size_t)m * 1024) + lane;
#pragma unroll
        for (int j = 0; j < 4; ++j) { const f32x4 y = v[j] * rstd * gg[j] + bb[j];
            o8[64 * j] = (unsigned long long)cvt_pk_bf16(y[0], y[1]) | ((unsigned long long)cvt_pk_bf16(y[2], y[3]) << 32); }
        if (!more) break;
#pragma unroll
        for (int j = 0; j < 4; ++j) v[j] = vn[j];
        m = mn;
    }
}

__device__ __forceinline__ unsigned mono_key(float f) { const unsigned u = __float_as_uint(f); return u ^ ((unsigned)((int)u >> 31) | 0x80000000u); }
__device__ __forceinline__ float mono_inv(unsigned k) { return __uint_as_float((k & 0x80000000u) ? (k ^ 0x80000000u) : ~k); }
#define CE_DESC(a, b) do { const unsigned _mx = (a) > (b) ? (a) : (b), _mn = (a) > (b) ? (b) : (a); (a) = _mx; (b) = _mn; } while (0)
template <int J> __device__ __forceinline__ void bitonic_step_desc(unsigned (&v)[16]) {
#pragma unroll
    for (int i = 0; i < 16; ++i) if ((i & J) == 0) CE_DESC(v[i], v[i | J]);
}
template <int K, int J> __device__ __forceinline__ void bitonic_step(unsigned (&v)[16]) {
#pragma unroll
    for (int i = 0; i < 16; ++i) if ((i & J) == 0) { if ((i & K) == 0) CE_DESC(v[i], v[i | J]); else CE_DESC(v[i | J], v[i]); }
}
__device__ __forceinline__ void sort16_desc(unsigned (&v)[16]) {
    bitonic_step<2, 1>(v);
    bitonic_step<4, 2>(v); bitonic_step<4, 1>(v);
    bitonic_step<8, 4>(v); bitonic_step<8, 2>(v); bitonic_step<8, 1>(v);
    bitonic_step_desc<8>(v); bitonic_step_desc<4>(v); bitonic_step_desc<2>(v); bitonic_step_desc<1>(v);
}
__device__ __forceinline__ void merge16_desc(unsigned (&T)[16], const unsigned (&N)[16]) {
#pragma unroll
    for (int k = 0; k < 16; ++k) T[k] = T[k] > N[15 - k] ? T[k] : N[15 - k];
    bitonic_step_desc<8>(T); bitonic_step_desc<4>(T); bitonic_step_desc<2>(T); bitonic_step_desc<1>(T);
}
__device__ __forceinline__ void merge_partner16(unsigned (&T)[16]) {
    unsigned P[16];
#pragma unroll
    for (int k = 0; k < 16; ++k) P[k] = (unsigned)__shfl_xor((int)T[k], 32);
    merge16_desc(T, P);
}
__device__ __forceinline__ void p8_topk_item(Frame& F, int item) {
    const int lane = F.lane, hh = lane >> 5, il = lane & 31;
    const int tb = item >> 3, hd = item & 7; const int row = 32 * tb + il;
    const bf16* QN = WSP(bf16, WS_QN); const bf16* KEYS = WSP(bf16, WS_KEYS); int* EIDX = WSP(int, WS_EIDX); float* GATE = WSP(float, WS_GATE);
    LAS unsigned* LK = (LAS unsigned*)(F.lds + F.wave * 8192);
    unsigned T1[16], T2[16];
    bf16x8 bqh[2][8], kf[8];
#pragma unroll
    for (int half = 0; half < 2; ++half)
#pragma unroll
        for (int s = 0; s < 8; ++s) bqh[half][s] = *(const bf16x8*)(QN + (size_t)row * 2048 + hd * 256 + half * 128 + 16 * s + 8 * hh);
#pragma unroll
    for (int s = 0; s < 8; ++s) kf[s] = *(const bf16x8*)(KEYS + ((size_t)(hd * 2) * 128 + il) * 128 + 8 * hh + 16 * s);
#pragma unroll
    for (int half = 0; half < 2; ++half) {
        const bf16x8 (&bq)[8] = bqh[half];
        unsigned T[16];
#pragma unroll
        for (int k = 0; k < 16; ++k) T[k] = 0u;
        const bf16* kbase = KEYS + ((size_t)(hd * 2 + half) * 128 + il) * 128 + 8 * hh;
#pragma unroll 1
        for (int kt = 0; kt < 4; ++kt) {
            f32x16 acc;
#pragma unroll
            for (int x = 0; x < 16; ++x) acc[x] = 0.f;
#pragma unroll
            for (int s = 0; s < 8; ++s) acc = MFMA32(kf[s], bq[s], acc);
            if (kt < 3 || half == 0) {
                const bf16* kn = kt < 3 ? kbase + (size_t)(32 * (kt + 1)) * 128 : kbase + (size_t)128 * 128;
#pragma unroll
                for (int s = 0; s < 8; ++s) kf[s] = *(const bf16x8*)(kn + 16 * s); }
            unsigned N[16];
#pragma unroll
            for (int x = 0; x < 16; ++x) { const int idx = 32 * kt + crow(x, hh); N[x] = (mono_key(acc[x]) & ~127u) | (unsigned)(127 - idx); }
            sort16_desc(N);
            merge16_desc(T, N);
        }
        merge_partner16(T);
#pragma unroll
        for (int k = 0; k < 16; ++k) { LK[(half * 16 + k) * 64 + lane] = T[k]; if (half == 0) T1[k] = T[k]; else T2[k] = T[k]; }
    }
    float v1s[8], v2[16];
#pragma unroll
    for (int k = 0; k < 16; ++k) v2[k] = mono_inv(T2[k] & ~127u);
#pragma unroll
    for (int i2 = 0; i2 < 8; ++i2) v1s[i2] = mono_inv((hh ? T1[2 * i2 + 1] : T1[2 * i2]) & ~127u);
    unsigned C[16], D[16];
#pragma unroll
    for (int k = 0; k < 16; ++k) { C[k] = 0u; D[k] = 0u; }
    {   int n = 0;
#pragma unroll
        for (int i2 = 0; i2 < 8; ++i2)
#pragma unroll
            for (int c = 0; c < 16; ++c) if ((2 * i2 + 1) * (c + 1) <= 16) { const unsigned key = (mono_key(v1s[i2] + v2[c]) & ~255u) | (unsigned)(255 - (16 * (2 * i2 + hh) + c));
                if (n < 16) C[n] = key; else D[n - 16] = key; ++n; }
    }
    sort16_desc(C); sort16_desc(D); merge16_desc(C, D);
    merge_partner16(C);
    LDS_WAIT(); asm volatile("" ::: "memory");
    float sv[16]; int ex[16]; float mx = NEG_BIG;
#pragma unroll
    for (int k = 0; k < 16; ++k) { const int si = 255 - (int)(C[k] & 255u), a = si >> 4, c = si & 15;
        const unsigned k1 = LK[a * 64 + lane], k2 = LK[(16 + c) * 64 + lane];
        ex[k] = (127 - (int)(k1 & 127u)) * 128 + (127 - (int)(k2 & 127u)); sv[k] = mono_inv(k1 & ~127u) + mono_inv(k2 & ~127u); mx = fmaxf(mx, sv[k]); }
    float den = 0.f;
#pragma unroll
    for (int k = 0; k < 16; ++k) { sv[k] = __expf(sv[k] - mx); den += sv[k]; }
    const float iden = 1.0f / den;
    if (hh == 0 && row < NTOK) {
#pragma unroll
        for (int k4 = 0; k4 < 4; ++k4) { if (k4 < 2) { v4u ew; ew.x = (unsigned)ex[8 * k4] | ((unsigned)ex[8 * k4 + 1] << 16); ew.y = (unsigned)ex[8 * k4 + 2] | ((unsigned)ex[8 * k4 + 3] << 16); ew.z = (unsigned)ex[8 * k4 + 4] | ((unsigned)ex[8 * k4 + 5] << 16); ew.w = (unsigned)ex[8 * k4 + 6] | ((unsigned)ex[8 * k4 + 7] << 16);
                *(v4u*)((unsigned short*)EIDX + (size_t)row * 128 + hd * 16 + 8 * k4) = ew; }
            *(f32x4*)(GATE + (size_t)row * 128 + hd * 16 + 4 * k4) = (f32x4){sv[4 * k4] * iden, sv[4 * k4 + 1] * iden, sv[4 * k4 + 2] * iden, sv[4 * k4 + 3] * iden}; } }
    LDS_WAIT(); asm volatile("" ::: "memory");
}

constexpr size_t WS_ACTP = WS_QB, WS_COEF = WS_KA, WS_PEERO = WS_RB, WS_X1H = WS_VA;
static_assert(WS_ACTP + (size_t)8 * NTOK * 128 * 4 <= WS_RB && WS_PEERO + (size_t)NTOK * 1024 * 4 <= WS_GB, "peer buffers");
__device__ __forceinline__ float gelu_erf(float x) { return 0.5f * x * (1.0f + erff(x * 0.70710678118654752f)); }
#define DPP_F(x, ctrl) __uint_as_float((unsigned)__builtin_amdgcn_mov_dpp((int)__float_as_uint(x), (ctrl), 0xf, 0xf, true))
__device__ __forceinline__ float dot16_fp8(const float (&x)[16], const v4u u) {
    float a = 0.f;
#pragma unroll
    for (int q = 0; q < 4; ++q) { const f32x2_t lo = __builtin_amdgcn_cvt_pk_f32_fp8((int)u[q], false), hi = __builtin_amdgcn_cvt_pk_f32_fp8((int)u[q], true);
        a += x[4 * q] * lo.x + x[4 * q + 1] * lo.y + x[4 * q + 2] * hi.x + x[4 * q + 3] * hi.y; }
    return a;
}
typedef float f32x4_t __attribute__((ext_vector_type(4)));
typedef int i32x4_t __attribute__((ext_vector_type(4)));
#ifndef PEER_CVT_VIA_F32
#define PEER_CVT_VIA_F32 0
#endif
#ifndef PEER_DOT_F32
#define PEER_DOT_F32 0
#endif
#if PEER_DOT_F32
#define PEER_DOT2(d, a, b) do { const h2_t a__ = (a), b__ = (b); d += (float)a__.x * (float)b__.x + (float)a__.y * (float)b__.y; } while (0)
#else
#define PEER_DOT2(d, a, b) d = __builtin_amdgcn_fdot2((a), (b), d, false)
#endif
template <bool HI> __device__ __forceinline__ h2_t fp8x2_to_h2(int w) {
#if PEER_CVT_VIA_F32
    const f32x2_t f = __builtin_amdgcn_cvt_pk_f32_fp8(w, HI); return (h2_t){(_Float16)f.x, (_Float16)f.y};
#else
    return __builtin_amdgcn_cvt_scalef32_pk_f16_fp8(w, 1.0f, HI);
#endif
}
template <unsigned EMASK> __device__ __forceinline__ void peer_u_phase_t(Frame& F) {
    const int lane = F.lane, p = lane >> 3, q = lane & 7, c = blockIdx.x & 7, wv = (blockIdx.x >> 3) * NWAVES + F.wave, nwv = (F.G >> 3) * NWAVES;
    const unsigned short* EIDX = WSP(unsigned short, WS_EIDX) + 16 * p; bf16* ACTP = WSP(bf16, WS_ACTP) + (size_t)c * NTOK * 128 + 16 * p + 2 * q;
    const unsigned char* U8 = WSP(unsigned char, WS_UT) + ((size_t)c * 16384 << 7) + 16 * q;
#define PU_LOADE(EV, M) do { _Pragma("unroll") for (int t_ = 0; t_ < 2; ++t_) EV[t_] = *(const v4u*)(EIDX + (size_t)(M) * 128 + 8 * t_); } while (0)
#define PE_IDX(EV, g) (((g) & 1) ? (EV[(g) >> 3][((g) >> 1) & 3] >> 16) : (EV[(g) >> 3][((g) >> 1) & 3] & 0xffffu))
#define PU_ISSUE(UR, EV) do { _Pragma("unroll") for (int g = 0; g < 16; ++g) UR[g] = *(const v4u*)(U8 + ((PE_IDX(EV, g) & EMASK) << 7)); } while (0)
#define PU_BODY(UR, UN, M) do { const int m_ = (M); const int m1_ = m_ + nwv, m2_ = m_ + 2 * nwv; \
        if (m1_ < NTOK) PU_ISSUE(UN, ev); \
        if (m2_ < NTOK) PU_LOADE(ev, m2_); \
        const bf16* xf_ = (const bf16*)(F.ws + WS_X1B) + (size_t)m_ * 1024 + 128 * c + 16 * q; \
        const v4u xa_ = *(const v4u*)xf_, xb_ = *(const v4u*)(xf_ + 8); \
        const h2_t xh[8] = {(h2_t){(_Float16)bf_lo(xa_.x), (_Float16)bf_hi(xa_.x)}, (h2_t){(_Float16)bf_lo(xa_.y), (_Float16)bf_hi(xa_.y)}, (h2_t){(_Float16)bf_lo(xa_.z), (_Float16)bf_hi(xa_.z)}, (h2_t){(_Float16)bf_lo(xa_.w), (_Float16)bf_hi(xa_.w)}, \
                            (h2_t){(_Float16)bf_lo(xb_.x), (_Float16)bf_hi(xb_.x)}, (h2_t){(_Float16)bf_lo(xb_.y), (_Float16)bf_hi(xb_.y)}, (h2_t){(_Float16)bf_lo(xb_.z), (_Float16)bf_hi(xb_.z)}, (h2_t){(_Float16)bf_lo(xb_.w), (_Float16)bf_hi(xb_.w)}}; \
        float a[16]; \
        _Pragma("unroll") for (int g = 0; g < 16; ++g) { float d_ = 0.f; \
            _Pragma("unroll") for (int t_ = 0; t_ < 4; ++t_) { PEER_DOT2(d_, fp8x2_to_h2<false>((int)UR[g][t_]), xh[2 * t_]); PEER_DOT2(d_, fp8x2_to_h2<true>((int)UR[g][t_]), xh[2 * t_ + 1]); } \
            a[g] = d_; if ((g & 1) == 1 && g < 15) asm volatile("" : "+v"(a[g - 1]), "+v"(a[g]), "+v"(UR[(g + 1) & 15]), "+v"(UR[(g + 2) & 15])); } \
        float b8[8], b4[4], b2[2]; \
        { const bool up = (q & 4) != 0; _Pragma("unroll") for (int k = 0; k < 8; ++k) { const float send = up ? a[k] : a[k + 8], keep = up ? a[k + 8] : a[k]; b8[k] = keep + DPP_F(send, 0x141); } } \
        { const bool up = (q & 2) != 0; _Pragma("unroll") for (int k = 0; k < 4; ++k) { const float send = up ? b8[k] : b8[k + 4], keep = up ? b8[k + 4] : b8[k]; b4[k] = keep + DPP_F(send, 0x4E); } } \
        { const bool up = (q & 1) != 0; _Pragma("unroll") for (int k = 0; k < 2; ++k) { const float send = up ? b4[k] : b4[k + 2], keep = up ? b4[k + 2] : b4[k]; b2[k] = keep + DPP_F(send, 0xB1); } } \
        *(unsigned*)(ACTP + (size_t)m_ * 128) = cvt_pk_bf16(b2[0], b2[1]); } while (0)
    int m = wv; if (m >= NTOK) return;
    v4u ev[2];
    PU_LOADE(ev, m);
    v4u ua[16], ub[16];
    PU_ISSUE(ua, ev);
    if (m + nwv < NTOK) PU_LOADE(ev, m + nwv);
    for (;;) {
        PU_BODY(ua, ub, m); m += nwv; if (m >= NTOK) break;
        PU_BODY(ub, ua, m); m += nwv; if (m >= NTOK) break;
    }
#undef PU_LOADE
#undef PU_ISSUE
#undef PU_BODY
}
__device__ __forceinline__ void peer_u_phase(Frame& F) { peer_u_phase_t<0xffffffffu>(F); }
__device__ __forceinline__ void peer_coef_phase(Frame& F) {
    const int gw = blockIdx.x * NWAVES + F.wave, NGW = F.G * NWAVES, lane = F.lane;
    const bf16* ACTP = WSP(bf16, WS_ACTP) + 2 * lane; const float* GATE = WSP(float, WS_GATE) + 2 * lane; _Float16* COEF = WSP(_Float16, WS_COEF) + 2 * lane;
    int m = gw; if (m >= NTOK) return;
    unsigned av[8], an[8]; f32x2_t gv, gnx;
    gv = *(const f32x2_t*)(GATE + (size_t)m * 128);
#pragma unroll
    for (int c = 0; c < 8; ++c) av[c] = *(const unsigned*)(ACTP + ((size_t)c * NTOK + m) * 128);
    for (;;) {
        const int mn = m + NGW; const bool more = mn < NTOK;
        if (more) { gnx = *(const f32x2_t*)(GATE + (size_t)mn * 128);
#pragma unroll
            for (int c = 0; c < 8; ++c) an[c] = *(const unsigned*)(ACTP + ((size_t)c * NTOK + mn) * 128); }
        float a0 = 0.f, a1 = 0.f;
#pragma unroll
        for (int c = 0; c < 8; ++c) { a0 += bf_lo(av[c]); a1 += bf_hi(av[c]); }
        *(h2_t*)(COEF + (size_t)m * 128) = (h2_t){(_Float16)(gv.x * gelu_erf(a0 * (1.0f / U_SCALE))), (_Float16)(gv.y * gelu_erf(a1 * (1.0f / U_SCALE)))};
        if (!more) break;
        gv = gnx;
#pragma unroll
        for (int c = 0; c < 8; ++c) av[c] = an[c];
        m = mn;
    }
}
__device__ __forceinline__ void peer_v_phase(Frame& F) {
    const int lane = F.lane, p = lane >> 3, q = lane & 7, c = blockIdx.x & 7, wv = (blockIdx.x >> 3) * NWAVES + F.wave, nwv = (F.G >> 3) * NWAVES;
    const unsigned short* EIDX = WSP(unsigned short, WS_EIDX) + 16 * p; const _Float16* COEF = WSP(_Float16, WS_COEF) + 16 * p; bf16* PEERO = WSP(bf16, WS_PEERO) + 128 * c + 16 * q + 2 * p;
    const unsigned char* V8 = WSP(unsigned char, WS_VT) + ((size_t)c * 16384 << 7) + 16 * q;
    int m = wv; if (m >= NTOK) return;
    v4u ev[2];
#pragma unroll
    for (int t = 0; t < 2; ++t) ev[t] = *(const v4u*)(EIDX + (size_t)m * 128 + 8 * t);
    v4u vr[16];
#pragma unroll
    for (int g = 0; g < 16; ++g) vr[g] = *(const v4u*)(V8 + (PE_IDX(ev, g) << 7));
    for (;;) {
        v4u cv[2];
#pragma unroll
        for (int t = 0; t < 2; ++t) cv[t] = *(const v4u*)(COEF + (size_t)m * 128 + 8 * t);
        const int mn = m + nwv; const bool more = mn < NTOK;
        if (more) {
#pragma unroll
            for (int t = 0; t < 2; ++t) ev[t] = *(const v4u*)(EIDX + (size_t)mn * 128 + 8 * t); }
        h2_t acc[8];
#pragma unroll
        for (int i = 0; i < 8; ++i) acc[i] = (h2_t){(_Float16)0.f, (_Float16)0.f};
#pragma unroll
        for (int g = 0; g < 16; ++g) { const unsigned cw = cv[g >> 3][(g >> 1) & 3]; const h2_t cf2 = __builtin_bit_cast(h2_t, (g & 1) ? ((cw >> 16) | (cw & 0xffff0000u)) : ((cw & 0xffffu) | (cw << 16)));
#pragma unroll
            for (int t = 0; t < 4; ++t) { acc[2 * t] += fp8x2_to_h2<false>((int)vr[g][t]) * cf2; acc[2 * t + 1] += fp8x2_to_h2<true>((int)vr[g][t]) * cf2; }
            if ((g & 3) == 3 && g < 15) asm volatile("" : "+v"(acc[0]), "+v"(acc[1]), "+v"(acc[2]), "+v"(acc[3]), "+v"(acc[4]), "+v"(acc[5]), "+v"(acc[6]), "+v"(acc[7]), "+v"(vr[(g + 1) & 15]), "+v"(vr[(g + 2) & 15]), "+v"(vr[(g + 3) & 15]), "+v"(vr[(g + 4) & 15])); }
        __builtin_amdgcn_sched_barrier(0);
        if (more) {
#pragma unroll
            for (int g = 0; g < 16; ++g) vr[g] = *(const v4u*)(V8 + (PE_IDX(ev, g) << 7)); }
        __builtin_amdgcn_sched_barrier(0);
        unsigned w[8];
#pragma unroll
        for (int i = 0; i < 8; ++i) w[i] = __builtin_bit_cast(unsigned, acc[i]);
        h2_t r4[4], r2[2], r1;
        { const bool up = (lane & 32) != 0;
#pragma unroll
          for (int k = 0; k < 4; ++k) { const unsigned send = up ? w[k] : w[k + 4], keep = up ? w[k + 4] : w[k]; r4[k] = __builtin_bit_cast(h2_t, keep) + __builtin_bit_cast(h2_t, (unsigned)__shfl_xor((int)send, 32)); } }
        { const bool up = (lane & 16) != 0;
#pragma unroll
          for (int k = 0; k < 2; ++k) { const unsigned a_ = __builtin_bit_cast(unsigned, r4[k]), b_ = __builtin_bit_cast(unsigned, r4[k + 2]); const unsigned send = up ? a_ : b_, keep = up ? b_ : a_; r2[k] = __builtin_bit_cast(h2_t, keep) + __builtin_bit_cast(h2_t, (unsigned)__shfl_xor((int)send, 16)); } }
        { const bool up = (lane & 8) != 0; const unsigned a_ = __builtin_bit_cast(unsigned, r2[0]), b_ = __builtin_bit_cast(unsigned, r2[1]); const unsigned send = up ? a_ : b_, keep = up ? b_ : a_;
          r1 = __builtin_bit_cast(h2_t, keep) + __builtin_bit_cast(h2_t, (unsigned)__builtin_amdgcn_mov_dpp((int)send, 0x128, 0xf, 0xf, true)); }
        *(unsigned*)(PEERO + (size_t)m * 1024) = cvt_pk_bf16((float)r1.x * (1.0f / V_SCALE), (float)r1.y * (1.0f / V_SCALE));
        if (!more) break;
        m = mn;
    }
}
__device__ __forceinline__ void peer_ln2_phase(Frame& F) {
    const int gw = blockIdx.x * NWAVES + F.wave, NGW = F.G * NWAVES, lane = F.lane;
    const bf16* X1 = WSP(bf16, WS_X1B); const bf16* PEERO = WSP(bf16, WS_PEERO); const float* l2g = inptr(F, I_L2G); const float* l2b = inptr(F, I_L2B);
    f32x4 gg[4], bb[4];
#pragma unroll
    for (int t = 0; t < 4; ++t) { gg[t] = *(const f32x4*)(l2g + 4 * lane + 256 * t); bb[t] = *(const f32x4*)(l2b + 4 * lane + 256 * t); }
    int m = gw; if (m >= NTOK) return;
    v2u xa[4], xn[4]; v2u pa[4], pn[4];
#pragma unroll
    for (int t = 0; t < 4; ++t) { xa[t] = *(const v2u*)(X1 + (size_t)m * 1024 + 4 * lane + 256 * t); pa[t] = *(const v2u*)(PEERO + (size_t)m * 1024 + 4 * lane + 256 * t); }
    for (;;) {
        const int mn = m + NGW; const bool more = mn < NTOK;
        if (more) {
#pragma unroll
            for (int t = 0; t < 4; ++t) { xn[t] = *(const v2u*)(X1 + (size_t)mn * 1024 + 4 * lane + 256 * t); pn[t] = *(const v2u*)(PEERO + (size_t)mn * 1024 + 4 * lane + 256 * t); } }
        float acc[16]; float s = 0.f;
#pragma unroll
        for (int t = 0; t < 4; ++t) { const float pz[4] = {bf_lo(pa[t].x), bf_hi(pa[t].x), bf_lo(pa[t].y), bf_hi(pa[t].y)};
            const float xz[4] = {bf_lo(xa[t].x), bf_hi(xa[t].x), bf_lo(xa[t].y), bf_hi(xa[t].y)};
#pragma unroll
            for (int i = 0; i < 4; ++i) { acc[4 * t + i] = ALPHA * xz[i] + pz[i]; s += acc[4 * t + i]; } }
        const float mean = wave_sum(s) * (1.f / 1024.f); float s2 = 0.f;
#pragma unroll
        for (int i = 0; i < 16; ++i) { acc[i] -= mean; s2 += acc[i] * acc[i]; }
        const float rstd = 1.f / sqrtf(wave_sum(s2) * (1.f / 1024.f) + LN_EPS);
        float* yo = m < NP ? F.out + OUT_YP + (size_t)m * 1024 : F.out + OUT_YS + (size_t)(m - NP) * 1024;
#pragma unroll
        for (int t = 0; t < 4; ++t) { const int cc = 4 * lane + 256 * t;
            *(f32x4*)(yo + cc) = (f32x4){acc[4 * t] * rstd * gg[t][0] + bb[t][0], acc[4 * t + 1] * rstd * gg[t][1] + bb[t][1], acc[4 * t + 2] * rstd * gg[t][2] + bb[t][2], acc[4 * t + 3] * rstd * gg[t][3] + bb[t][3]}; }
        if (!more) break;
#pragma unroll
        for (int t = 0; t < 4; ++t) { xa[t] = xn[t]; pa[t] = pn[t]; }
        m = mn;
    }
}

template <class Epi> __device__ __forceinline__ void skinny_sample_gemm(Frame& F, const bf16* A, const bf16* Bt, int K, const Epi& epi) {
    typedef float f32x4a __attribute__((ext_vector_type(4)));
    const int lane = F.lane, r = lane & 15, kg = lane >> 4;
    for (int strip = blockIdx.x; strip < 64; strip += F.G) {
        const bf16* ap = A + (size_t)(NP + 16 * F.wave + r) * K + 8 * kg;
        const bf16* bp = Bt + (size_t)(16 * strip + r) * K + 8 * kg;
        f32x4a acc = {0.f, 0.f, 0.f, 0.f};
        for (int s0 = 0; s0 < K / 32; s0 += 16) { bf16x8 af[16], bfr[16];
#pragma unroll
            for (int u = 0; u < 16; ++u) { af[u] = *(const bf16x8*)(ap + 32 * (s0 + u)); bfr[u] = *(const bf16x8*)(bp + 32 * (s0 + u)); }
#pragma unroll
            for (int u = 0; u < 16; ++u) acc = __builtin_amdgcn_mfma_f32_16x16x32_bf16(af[u], bfr[u], acc, 0, 0, 0); }
#pragma unroll
        for (int i = 0; i < 4; ++i) epi(NP + 16 * F.wave + 4 * kg + i, 16 * strip + r, acc[i]);
    }
}

struct Args { const float* in[22]; float* out; unsigned char* ws; int ph_lo, ph_hi; };
constexpr int NPHASE = 14;
__global__ void __launch_bounds__(NTHR, 2) mk_fwd(Args args) {
    extern __shared__ __attribute__((aligned(16))) unsigned char lds[];
    Frame F;
    F.lds = (LAS unsigned char*)lds; F.MISC = (volatile LAS unsigned*)(F.lds + MISC_OFF);
    F.tid = threadIdx.x; F.lane = F.tid & 63; F.wave = __builtin_amdgcn_readfirstlane(F.tid >> 6); F.G = gridDim.x;
    F.ws = args.ws; F.out = args.out; F.ctl = (gu32*)(args.ws + WS_CTL); F.tp = 0ull;
    for (int u = F.tid; u < (LDS_BYTES - MISC_OFF) / 4; u += NTHR) ((LAS unsigned*)(F.lds + MISC_OFF))[u] = 0u;
    __syncthreads();
    if (F.tid < 22) ((LAS unsigned long long*)(F.lds + PTR_OFF))[F.tid] = (unsigned long long)args.in[F.tid];
    __syncthreads();
    const int lo = args.ph_lo, hi = args.ph_hi;
    const bool multi = (hi - lo) > 1;
    XcdBarrier bar; bar.bar = (unsigned*)(F.ctl + CW_BAR); bar.x = 0; bar.st = nullptr;
    if (multi) bar = xcd_barrier_post((unsigned*)(F.ctl + CW_BAR), F.MISC + 8);
#ifdef ONLY_PHASE
#define IN(k) ((k) == ONLY_PHASE && lo <= (k) && (k) < hi)
#else
#define IN(k) (lo <= (k) && (k) < hi)
#endif
#ifdef PROBE_PHASE
    unsigned long long t_prev = __builtin_amdgcn_s_memrealtime(), t_probe = 0ull;
#define STAMP(k) do { const unsigned long long _t = __builtin_amdgcn_s_memrealtime(); if ((k) == PROBE_PHASE && blockIdx.x == 0) t_probe = _t - t_prev; t_prev = _t; } while (0)
#else
#define STAMP(k) do { } while (0)
#endif
#define SEAM(k) do { if (IN(k) && IN((k) + 1)) xcd_barrier(bar); STAMP(k); } while (0)
    if (IN(0)) { p0_prologue(F); }
    if (IN(0) && IN(1)) { cooperative_groups::this_grid().sync(); } STAMP(0);
    if (IN(1)) {
        if ((int)blockIdx.x >= F.G - NCOPYWG) kvshift_loop<true>(F);
        else {
        pg8::Gemm g{WSP(bf16, WS_XB), WSP(bf16, WS_WIN), MPAD, NPROJ, 1024, MPAD / 256 - 1}; pg8::StaticOrder S; S.init(MPAD, NPROJ, F.G - NCOPYWG, (int)blockIdx.x);
        pg8::EpiProj E{WSP(bf16, WS_QA), WSP(bf16, WS_KA), WSP(bf16, WS_VA), WSP(bf16, WS_QB), WSP(bf16, WS_KB), WSP(bf16, WS_VB), WSP(bf16, WS_RB), WSP(bf16, WS_GA), WSP(bf16, WS_GB)};
        pg8::gemm_phase<pg8::EpiProj, pg8::StaticOrder, true, true>(F.lds, g, S, E);
        if (F.tid == 0) __hip_atomic_fetch_add(F.ctl + CW_GDONE, 1u, RLX_AGENT);
        }
    } SEAM(1);
    if (IN(2)) { p2_prep(F); } SEAM(2);
    if (IN(3)) { p2_mixers(F); } SEAM(3);
    if (IN(4)) { p3_merge(F); } SEAM(4);
    if (IN(5)) {
        bf16* T1 = WSP(bf16, WS_T1); bf16* MIXp = WSP(bf16, WS_MIX); const bf16* GAp = WSP(bf16, WS_GA); const bf16* GBp = WSP(bf16, WS_GB);
        { pg8::Gemm g{WSP(bf16, WS_OAM), WSP(bf16, WS_WA), NP, 1024, 512, -1}; pg8::StaticOrder S; S.init(NP, 1024, F.G, (int)blockIdx.x, false);
          pg8::EpiGate<false> E{WSP(bf16, WS_GA), nullptr, WSP(bf16, WS_T1)};
          pg8::gemm_phase<pg8::EpiGate<false>, pg8::StaticOrder, true, true>(F.lds, g, S, E); }
        skinny_sample_gemm(F, WSP(bf16, WS_OAM), WSP(bf16, WS_WA), 512, [=](int row, int col, float v) { const size_t o = (size_t)row * 1024 + col; T1[o] = f2bf(pg8::sigmoidf_(bf2f(GAp[o])) * v); });
        VM_WAIT(); __syncthreads();
        { pg8::Gemm g{WSP(bf16, WS_OBN), WSP(bf16, WS_WB), NP, 1024, 1024, -1}; pg8::StaticOrder S; S.init(NP, 1024, F.G, (int)blockIdx.x, false);
          pg8::EpiGate<true> E{WSP(bf16, WS_GB), WSP(bf16, WS_T1), WSP(bf16, WS_MIX)};
          pg8::gemm_phase<pg8::EpiGate<true>, pg8::StaticOrder, true, true>(F.lds, g, S, E); }
        skinny_sample_gemm(F, WSP(bf16, WS_OBN), WSP(bf16, WS_WB), 1024, [=](int row, int col, float v) { const size_t o = (size_t)row * 1024 + col; MIXp[o] = f2bf(bf2f(T1[o]) + pg8::sigmoidf_(bf2f(GBp[o])) * v); });
    } SEAM(5);
    if (IN(6)) {
        pg8::Gemm g{WSP(bf16, WS_MIX), WSP(bf16, WS_WO), NP, 1024, 1024, -1}; pg8::StaticOrder S; S.init(NP, 1024, F.G, (int)blockIdx.x, false);
        pg8::EpiOut E{WSP(bf16, WS_XB), WSP(bf16, WS_HB), ALPHA};
        pg8::gemm_phase<pg8::EpiOut, pg8::StaticOrder, true, true>(F.lds, g, S, E);
        const bf16* xbp = WSP(bf16, WS_XB); bf16* Hp = WSP(bf16, WS_HB);
        skinny_sample_gemm(F, WSP(bf16, WS_MIX), WSP(bf16, WS_WO), 1024, [=](int row, int col, float v) { const size_t o = (size_t)row * 1024 + col; Hp[o] = f2bf(ALPHA * bf2f(xbp[o]) + v); });
    } SEAM(6);
    if (IN(7)) { p6_ln1(F); } SEAM(7);
    if (IN(8)) {
        pg8::Gemm g{WSP(bf16, WS_X1B), WSP(bf16, WS_WQ), MPAD, 2048, 1024, MPAD / 256 - 1}; pg8::StaticOrder S; S.init(MPAD, 2048, F.G, (int)blockIdx.x);
        pg8::EpiHeadNorm E{WSP(bf16, WS_QN), 2048, F.lds + STATS_OFF, LN_EPS};
        pg8::gemm_phase<pg8::EpiHeadNorm, pg8::StaticOrder, true, true>(F.lds, g, S, E);
    } SEAM(8);
    if (IN(9)) {
        const int gw = blockIdx.x * NWAVES + F.wave, NGW = F.G * NWAVES;
        for (int it = gw; it < (NP / 32) * 8; it += NGW) p8_topk_item(F, it);
        for (int e = gw; e < 64 * (NS / 32) * 8; e += NGW) if ((e & 63) == 0) p8_topk_item(F, (NP / 32) * 8 + (e >> 6));
    } SEAM(9);
#if defined(PROBE_PHASE) && PROBE_PHASE >= 300 && PROBE_PHASE < 310
    if (IN(10)) { const unsigned long long td0 = __builtin_amdgcn_s_memrealtime();
        if (PROBE_PHASE == 300) peer_u_phase_t<2047u>(F); else if (PROBE_PHASE == 301) peer_u_phase_t<8191u>(F); else peer_u_phase_t<0xffffffffu>(F);
        xcd_barrier(bar); if (blockIdx.x == 0) F.tp = __builtin_amdgcn_s_memrealtime() - td0; }
#endif
    if (IN(10)) { peer_u_phase(F); } SEAM(10);
    if (IN(11)) { peer_coef_phase(F); } SEAM(11);
    if (IN(12)) { peer_v_phase(F); } SEAM(12);
    if (IN(13)) { peer_ln2_phase(F); }
#ifdef PROBE_PHASE
    if (PROBE_PHASE == 13) { xcd_barrier(bar); STAMP(13); }
    if (PROBE_PHASE == 200 || PROBE_PHASE == 201) {
        unsigned* xm = (unsigned*)(F.ws + WS_END);
        if (F.tid == 0) __hip_atomic_store(xm + blockIdx.x, xb_xcc_id() + 1u, RLX_AGENT);
        xcd_barrier(bar);
        if (blockIdx.x == 0 && F.tid == 0) { bool ok = true;
            for (int b = 0; b < (int)gridDim.x; ++b) { const unsigned a = __hip_atomic_load(xm + b, RLX_AGENT), r = __hip_atomic_load(xm + (PROBE_PHASE == 200 ? (b & 7) : (b & ~31)), RLX_AGENT); if (a != r) ok = false; }
            t_probe = ok ? 50000ull : 0ull; }
    }
    if ((PROBE_PHASE >= 100 && PROBE_PHASE < 200) || PROBE_PHASE >= 300) t_probe = F.tp;
    if (F.tid == 0 && t_probe != 0ull) { const unsigned long long t0 = __builtin_amdgcn_s_memrealtime(); while (__builtin_amdgcn_s_memrealtime() - t0 < PROBE_GAIN * t_probe) __builtin_amdgcn_s_sleep(8); }
#endif
#undef IN
#undef SEAM
}

extern "C" void kernel_launch(void* const* d_in, const int* in_sizes, int n_in, void* d_out, int out_size, void* d_ws, size_t ws_size, hipStream_t stream) {
    static int grid = 0;
    if (grid == 0) {
        if (n_in != 22 || (size_t)out_size != OUT_TOTAL || ws_size < WS_END) { fprintf(stderr, "kernel_launch: unexpected shapes: n_in %d out %d ws %zu (need >= %zu)\n", n_in, out_size, ws_size, (size_t)WS_END); grid = -1; return; }
        int dev = 0, cus = 0, per_cu = 0;
        if (hipGetDevice(&dev) != hipSuccess || hipDeviceGetAttribute(&cus, hipDeviceAttributeMultiprocessorCount, dev) != hipSuccess) { grid = -1; return; }
        if (hipFuncSetAttribute((const void*)mk_fwd, hipFuncAttributeMaxDynamicSharedMemorySize, LDS_BYTES) != hipSuccess) { fprintf(stderr, "kernel_launch: hipFuncSetAttribute failed\n"); grid = -1; return; }
        if (hipOccupancyMaxActiveBlocksPerMultiprocessor(&per_cu, (const void*)mk_fwd, NTHR, LDS_BYTES) != hipSuccess || per_cu < 1) fprintf(stderr, "kernel_launch: occupancy query reports %d blocks per CU\n", per_cu);
        (void)hipGetLastError();
        grid = cus;
    }
    if (grid < 0) return;
    (void)hipMemsetAsync((char*)d_ws + WS_CTL, 0, CTL_ZERO_BYTES, stream);
    Args a{};
    for (int i = 0; i < 22; ++i) a.in[i] = (const float*)d_in[i];
    a.out = (float*)d_out; a.ws = (unsigned char*)d_ws;
#if MK_SINGLE
    a.ph_lo = 0; a.ph_hi = NPHASE;
    void* kargs[] = {&a};
    hipError_t e = hipLaunchCooperativeKernel((const void*)mk_fwd, dim3(grid), dim3(NTHR), kargs, LDS_BYTES, stream);
    if (e != hipSuccess) fprintf(stderr, "kernel_launch: cooperative launch failed: %s\n", hipGetErrorString(e));
#else
    for (int p = 0; p < NPHASE; ++p) { a.ph_lo = p; a.ph_hi = p + 1; hipLaunchKernelGGL(mk_fwd, dim3(grid), dim3(NTHR), LDS_BYTES, stream, a); }
#endif
}
```

```cpp
#include <hip/hip_runtime.h>
#include <hip/hip_cooperative_groups.h>
#include <cstdio>
#include <cstdint>
#ifndef MK_SINGLE
#define MK_SINGLE 1
#endif
namespace pg8 {
#define PG8_LAS __attribute__((address_space(3)))
typedef unsigned short bf16_t;
typedef short bf16x8 __attribute__((ext_vector_type(8)));
typedef float f32x4 __attribute__((ext_vector_type(4)));
typedef unsigned u32x4 __attribute__((ext_vector_type(4)));
constexpr int BM = 256, BK = 64, HALF = 128, HTB = HALF * BK * 2  , STAGE_BYTES = 8 * HTB, NXCD = 8, WGM = 8;

__host__ __device__ __forceinline__ int lds_byte(int r, int c) { const int st = (r >> 4) * 2 + (c >> 5), rr = r & 15, cc = c & 31, ob = rr * 64 + cc * 2; return st * 1024 + (ob ^ (((ob >> 9) & 1) << 5)); }
__host__ __device__ __forceinline__ void stage_rc(int b, int& R, int& C) { const int st = b / 1024, sb = b % 1024, swz = sb ^ (((sb >> 9) & 1) << 5); R = (st >> 1) * 16 + swz / 64; C = (st & 1) * 32 + (swz % 64) / 2; }
__host__ __device__ __forceinline__ int perm32(int rho) { const int n = rho >> 4, i = rho & 15; return 8 * (i >> 2) + 4 * n + (i & 3); }

struct Unit { int pm, pn; };
struct Gemm { const bf16_t* A; const bf16_t* Bt; int M, N, K; int half_pm = -1; };

struct StaticOrder {
    int nM, nN, nwg, G, c, nfull;
    __host__ __device__ void init(int M, int N, int G_, int c_, bool half = true) { nM = half ? M / BM - 1 : M / BM; nN = N / BM; nfull = nM * nN; nwg = half ? nfull + nN : nfull; G = G_; c = c_; }
    __host__ __device__ bool next(int i, Unit& u) const {
        const long L = (long)i * G + c; if (L >= nwg) return false;
        if (L >= nfull) { u.pm = nM; u.pn = (int)(L - nfull); return true; }
        int wgid = (int)L; { const int q = nfull / NXCD, r = nfull % NXCD, xcd = wgid % NXCD, off = wgid / NXCD; wgid = (xcd < r ? xcd * (q + 1) : r * (q + 1) + (xcd - r) * q) + off; }
        const int nig = WGM * nN, gid = wgid / nig, fm = gid * WGM, gsz = (nM - fm) < WGM ? (nM - fm) : WGM;
        u.pm = fm + ((wgid % nig) % gsz); u.pn = (wgid % nig) / gsz; return true;
    }
    __device__ __forceinline__ void a_ready(const Unit&) const {}
    __device__ __forceinline__ void done(const Unit&) const {}
};


typedef float f32x2 __attribute__((ext_vector_type(2)));
typedef __bf16 bf16x2_t __attribute__((ext_vector_type(2)));
__device__ __forceinline__ unsigned cvt_pk_bf16(float lo, float hi) { f32x2 v = {lo, hi}; bf16x2_t b = __builtin_convertvector(v, bf16x2_t); return __builtin_bit_cast(unsigned, b); }
__device__ __forceinline__ float bf_lo(unsigned w) { return __uint_as_float(w << 16); }
__device__ __forceinline__ float bf_hi(unsigned w) { return __uint_as_float(w & 0xffff0000u); }
__device__ __forceinline__ float sigmoidf_(float x) { return __builtin_amdgcn_rcpf(1.0f + __expf(-x)); }

struct EpiProj {
    static constexpr bool PERM = true, AFTER_DRAIN = false;
    bf16_t *qa, *ka, *va, *qb, *kb, *vb, *rb, *ga, *gb;
    __device__ __forceinline__ void operator()(const f32x4 (&acc)[2][2][4][2], const Unit& u, int wr, int wc, int fr, int fq) const {
        const int pn = u.pn; bf16_t* base; int ldc, ct; float sc = 1.f;
        if (pn < 6) { base = qa; ldc = 1536; ct = pn; sc = 0.125f; }
        else if (pn < 12) { base = ka; ldc = 1536; ct = pn - 6; }
        else if (pn < 18) { base = va; ldc = 1536; ct = pn - 12; }
        else if (pn < 20) { base = qb; ldc = 512; ct = pn - 18; }
        else if (pn < 22) { base = kb; ldc = 512; ct = pn - 20; }
        else if (pn < 26) { base = vb; ldc = 1024; ct = pn - 22; }
        else if (pn < 30) { base = rb; ldc = 1024; ct = pn - 26; }
        else if (pn < 34) { base = ga; ldc = 1024; ct = pn - 30; }
        else { base = gb; ldc = 1024; ct = pn - 34; }
        const int row0 = u.pm * BM + wr * 64 + fr, col0 = ct * BM + wc * 32 + 8 * fq;
#pragma unroll
        for (int ai = 0; ai < 2; ++ai)
#pragma unroll
            for (int m = 0; m < 4; ++m) { bf16_t* rowp = base + (size_t)(row0 + ai * HALF + m * 16) * ldc + col0;
#pragma unroll
                for (int bj = 0; bj < 2; ++bj) { const f32x4 v0 = acc[ai][bj][m][0] * sc, v1 = acc[ai][bj][m][1] * sc;
                    u32x4 w; w.x = cvt_pk_bf16(v0[0], v0[1]); w.y = cvt_pk_bf16(v0[2], v0[3]); w.z = cvt_pk_bf16(v1[0], v1[1]); w.w = cvt_pk_bf16(v1[2], v1[3]);
                    __builtin_nontemporal_store(w, (u32x4*)(rowp + bj * HALF)); } }
    }
};
template <bool ADD> struct EpiGate {
    static constexpr bool PERM = true, AFTER_DRAIN = false;
    const bf16_t* G; const bf16_t* T1; bf16_t* O;
    __device__ __forceinline__ void operator()(const f32x4 (&acc)[2][2][4][2], const Unit& u, int wr, int wc, int fr, int fq) const {
        const int row0 = u.pm * BM + wr * 64 + fr, col0 = u.pn * BM + wc * 32 + 8 * fq;
#pragma unroll
        for (int ai = 0; ai < 2; ++ai) {
            u32x4 gq[4][2], tq[4][2];
#pragma unroll
            for (int m = 0; m < 4; ++m) { const size_t off = (size_t)(row0 + ai * HALF + m * 16) * 1024 + col0;
#pragma unroll
                for (int bj = 0; bj < 2; ++bj) { gq[m][bj] = *(const u32x4*)(G + off + bj * HALF); if (ADD) tq[m][bj] = *(const u32x4*)(T1 + off + bj * HALF); } }
#pragma unroll
            for (int m = 0; m < 4; ++m) { const size_t off = (size_t)(row0 + ai * HALF + m * 16) * 1024 + col0;
#pragma unroll
                for (int bj = 0; bj < 2; ++bj) {
                    const u32x4 g = gq[m][bj];
                    f32x4 v0 = acc[ai][bj][m][0], v1 = acc[ai][bj][m][1];
                    v0[0] *= sigmoidf_(bf_lo(g.x)); v0[1] *= sigmoidf_(bf_hi(g.x)); v0[2] *= sigmoidf_(bf_lo(g.y)); v0[3] *= sigmoidf_(bf_hi(g.y));
                    v1[0] *= sigmoidf_(bf_lo(g.z)); v1[1] *= sigmoidf_(bf_hi(g.z)); v1[2] *= sigmoidf_(bf_lo(g.w)); v1[3] *= sigmoidf_(bf_hi(g.w));
                    if (ADD) { const u32x4 t = tq[m][bj];
                        v0[0] += bf_lo(t.x); v0[1] += bf_hi(t.x); v0[2] += bf_lo(t.y); v0[3] += bf_hi(t.y);
                        v1[0] += bf_lo(t.z); v1[1] += bf_hi(t.z); v1[2] += bf_lo(t.w); v1[3] += bf_hi(t.w); }
                    u32x4 w; w.x = cvt_pk_bf16(v0[0], v0[1]); w.y = cvt_pk_bf16(v0[2], v0[3]); w.z = cvt_pk_bf16(v1[0], v1[1]); w.w = cvt_pk_bf16(v1[2], v1[3]);
                    *(u32x4*)(O + off + bj * HALF) = w; } } }
    }
};
struct EpiOut {
    static constexpr bool PERM = true, AFTER_DRAIN = false;
    const bf16_t* xb; bf16_t* HB; float alpha;
    __device__ __forceinline__ void operator()(const f32x4 (&acc)[2][2][4][2], const Unit& u, int wr, int wc, int fr, int fq) const {
        const int row0 = u.pm * BM + wr * 64 + fr, col0 = u.pn * BM + wc * 32 + 8 * fq;
#pragma unroll
        for (int ai = 0; ai < 2; ++ai) {
            u32x4 xq[4][2];
#pragma unroll
            for (int m = 0; m < 4; ++m) { const size_t off = (size_t)(row0 + ai * HALF + m * 16) * 1024 + col0;
#pragma unroll
                for (int bj = 0; bj < 2; ++bj) xq[m][bj] = *(const u32x4*)(xb + off + bj * HALF); }
#pragma unroll
            for (int m = 0; m < 4; ++m) { const size_t off = (size_t)(row0 + ai * HALF + m * 16) * 1024 + col0;
#pragma unroll
                for (int bj = 0; bj < 2; ++bj) { const u32x4 t = xq[m][bj]; const f32x4 a0 = acc[ai][bj][m][0], a1 = acc[ai][bj][m][1];
                    u32x4 w; w.x = cvt_pk_bf16(alpha * bf_lo(t.x) + a0[0], alpha * bf_hi(t.x) + a0[1]); w.y = cvt_pk_bf16(alpha * bf_lo(t.y) + a0[2], alpha * bf_hi(t.y) + a0[3]);
                    w.z = cvt_pk_bf16(alpha * bf_lo(t.z) + a1[0], alpha * bf_hi(t.z) + a1[1]); w.w = cvt_pk_bf16(alpha * bf_lo(t.w) + a1[2], alpha * bf_hi(t.w) + a1[3]);
                    *(u32x4*)(HB + off + bj * HALF) = w; } }
        }
    }
};
struct EpiHeadNorm {
    static constexpr bool PERM = true, AFTER_DRAIN = false;
    bf16_t* O; int ldc; PG8_LAS unsigned char* st; float eps;
    __device__ __forceinline__ void operator()(const f32x4 (&acc)[2][2][4][2], const Unit& u, int wr, int wc, int fr, int fq) const {
        PG8_LAS f32x2* P = (PG8_LAS f32x2*)st; PG8_LAS f32x2* S = (PG8_LAS f32x2*)(st + 8192);
        const int lane = fq * 16 + fr, wid = wr * 4 + wc;
#pragma unroll
        for (int ai = 0; ai < 2; ++ai)
#pragma unroll
            for (int m = 0; m < 4; ++m) {
                float s = 0.f;
#pragma unroll
                for (int bj = 0; bj < 2; ++bj)
#pragma unroll
                    for (int n = 0; n < 2; ++n) { const f32x4 x = acc[ai][bj][m][n]; s += (x[0] + x[1]) + (x[2] + x[3]); }
                s += __shfl_xor(s, 16); s += __shfl_xor(s, 32);
                const float mw = s * (1.0f / 64.0f); float q = 0.f;
#pragma unroll
                for (int bj = 0; bj < 2; ++bj)
#pragma unroll
                    for (int n = 0; n < 2; ++n) { const f32x4 d = acc[ai][bj][m][n] - mw; q += (d[0] * d[0] + d[1] * d[1]) + (d[2] * d[2] + d[3] * d[3]); }
                q += __shfl_xor(q, 16); q += __shfl_xor(q, 32);
                if (fq == 0) P[(ai * HALF + wr * 64 + m * 16 + fr) * 4 + wc] = (f32x2){mw, q};
            }
        asm volatile("s_waitcnt lgkmcnt(0)" ::: "memory"); __builtin_amdgcn_s_barrier(); asm volatile("" ::: "memory");
        const int row = wid * 32 + (lane & 31);
        if (lane < 32) {
            const f32x2 a = P[row * 4 + 0], b = P[row * 4 + 1], c = P[row * 4 + 2], d = P[row * 4 + 3];
            const float mt = (a.x + b.x + c.x + d.x) * 0.25f;
            const float da = a.x - mt, db = b.x - mt, dc = c.x - mt, dd = d.x - mt;
            const float m2 = (a.y + b.y) + (c.y + d.y) + 64.0f * ((da * da + db * db) + (dc * dc + dd * dd));
            S[row] = (f32x2){mt, 1.0f / sqrtf(m2 * (1.0f / 256.0f) + eps)};
        }
        asm volatile("s_waitcnt lgkmcnt(0)" ::: "memory"); __builtin_amdgcn_s_barrier(); asm volatile("" ::: "memory");
        const int row0 = u.pm * BM + wr * 64 + fr, col0 = u.pn * BM + wc * 32 + 8 * fq;
#pragma unroll
        for (int ai = 0; ai < 2; ++ai)
#pragma unroll
            for (int m = 0; m < 4; ++m) { const f32x2 sr = S[ai * HALF + wr * 64 + m * 16 + fr]; bf16_t* rowp = O + (size_t)(row0 + ai * HALF + m * 16) * ldc + col0;
#pragma unroll
                for (int bj = 0; bj < 2; ++bj) { const f32x4 v0 = (acc[ai][bj][m][0] - sr.x) * sr.y, v1 = (acc[ai][bj][m][1] - sr.x) * sr.y;
                    u32x4 w; w.x = cvt_pk_bf16(v0[0], v0[1]); w.y = cvt_pk_bf16(v0[2], v0[3]); w.z = cvt_pk_bf16(v1[0], v1[1]); w.w = cvt_pk_bf16(v1[2], v1[3]);
                    *(u32x4*)(rowp + bj * HALF) = w; } }
    }
};

template <class Epi, class Sched, bool ALIGN_EPI = false, bool SP2 = false>
__device__ __forceinline__ void gemm_phase(PG8_LAS unsigned char* lds, const Gemm g, const Sched& S, const Epi& E) {
    const int tid = threadIdx.x, wid = __builtin_amdgcn_readfirstlane(tid >> 6), lane = tid & 63, wr = wid >> 2, wc = wid & 3, fr = lane & 15, fq = lane >> 4;
    const int K = g.K, nt = K / BK;
    unsigned voffA[2], voffB[2];
#pragma unroll
    for (int i = 0; i < 2; ++i) { int R, C; stage_rc(tid * 16 + i * 8192, R, C); const int Rb = Epi::PERM ? ((R & ~31) + perm32(R & 31)) : R;
        voffA[i] = (unsigned)(R * K + C) * 2u; voffB[i] = (unsigned)(Rb * K + C) * 2u; }
    const size_t kstep = (size_t)(BK * 2);
    const size_t hstep = (size_t)HALF * K * 2;
    const size_t tstep = 2 * hstep;
    const unsigned ldsw = (unsigned)wid * 1024u;
    const int aoff = lds_byte(wr * 64 + fr, fq * 8), boff = lds_byte(wc * 32 + fr, fq * 8);
#define PG8_SA(b, h) (((b) * 2 + (h)) * HTB)
#define PG8_SB(b, h) ((4 + (b) * 2 + (h)) * HTB)
#define PG8_STAGE(bufoff, gbase, voff) do { _Pragma("unroll") for (int _i = 0; _i < 2; ++_i) \
        __builtin_amdgcn_global_load_lds((const unsigned*)((const char*)(gbase) + (voff)[_i]), (PG8_LAS unsigned*)(lds + (bufoff) + ldsw + _i * 8192), 16, 0, 0); } while (0)
#define PG8_LDA(dst, b, h) do { _Pragma("unroll") for (int m = 0; m < 4; ++m) _Pragma("unroll") for (int k = 0; k < 2; ++k) dst[m][k] = *(const PG8_LAS bf16x8*)(lds + PG8_SA(b, h) + aoff + m * 2048 + k * 1024); } while (0)
#define PG8_LDB(dst, b, h) do { _Pragma("unroll") for (int n = 0; n < 2; ++n) _Pragma("unroll") for (int k = 0; k < 2; ++k) dst[n][k] = *(const PG8_LAS bf16x8*)(lds + PG8_SB(b, h) + boff + n * 2048 + k * 1024); } while (0)
#define PG8_MMA(ai, bj, At, Bt) do { __builtin_amdgcn_s_setprio(1); _Pragma("unroll") for (int m = 0; m < 4; ++m) _Pragma("unroll") for (int n = 0; n < 2; ++n) _Pragma("unroll") for (int k = 0; k < 2; ++k) \
        acc[ai][bj][m][n] = __builtin_amdgcn_mfma_f32_16x16x32_bf16(Bt[n][k], At[m][k], acc[ai][bj][m][n], 0, 0, 0); __builtin_amdgcn_s_setprio(0); } while (0)
#define PG8_WAIT_V(n) asm volatile("s_waitcnt vmcnt(" #n ")" ::: "memory")
#define PG8_WAIT_L(n) asm volatile("s_waitcnt lgkmcnt(" #n ")" ::: "memory")
#define PG8_BAR __builtin_amdgcn_s_barrier()
#define PG8_SCHED __builtin_amdgcn_sched_barrier(0)
    Unit cur, nxt; int ui = 0;
    if (!S.next(0, cur)) return;
    f32x4 acc[2][2][4][2];
#pragma unroll
    for (int a = 0; a < 2; ++a)
#pragma unroll
        for (int b = 0; b < 2; ++b)
#pragma unroll
            for (int m = 0; m < 4; ++m)
#pragma unroll
                for (int n = 0; n < 2; ++n) acc[a][b][m][n] = (f32x4){0.f, 0.f, 0.f, 0.f};
    bf16x8 At[4][2], B0[2][2], B1[2][2];
    const char* cA = (const char*)g.A + (size_t)cur.pm * tstep; const char* cB = (const char*)g.Bt + (size_t)cur.pn * tstep;
    S.a_ready(cur);
    if constexpr (SP2) {
        PG8_STAGE(PG8_SB(0, 0), cB, voffB); PG8_STAGE(PG8_SB(0, 1), cB + hstep, voffB); PG8_STAGE(PG8_SA(0, 0), cA, voffA); PG8_STAGE(PG8_SA(0, 1), cA + hstep, voffA);
        if (wr == 1) PG8_BAR;
        PG8_WAIT_V(2); PG8_BAR;
        PG8_STAGE(PG8_SB(1, 0), cB + kstep, voffB); PG8_STAGE(PG8_SA(1, 0), cA + kstep, voffA); PG8_STAGE(PG8_SB(1, 1), cB + hstep + kstep, voffB);
        PG8_WAIT_V(6); PG8_BAR;
    } else {
        PG8_STAGE(PG8_SB(0, 0), cB, voffB); PG8_STAGE(PG8_SA(0, 0), cA, voffA); PG8_STAGE(PG8_SB(0, 1), cB + hstep, voffB); PG8_STAGE(PG8_SA(0, 1), cA + hstep, voffA);
        if (wr == 1) PG8_BAR;
        PG8_WAIT_V(4); PG8_BAR;
        PG8_STAGE(PG8_SB(1, 0), cB + kstep, voffB); PG8_STAGE(PG8_SA(1, 0), cA + kstep, voffA); PG8_STAGE(PG8_SB(1, 1), cB + hstep + kstep, voffB);
        PG8_WAIT_V(6); PG8_BAR;
    }
    for (;;) {
        const bool has_next = S.next(ui + 1, nxt);
        const bool skip1 = __builtin_amdgcn_readfirstlane((int)(cur.pm == g.half_pm)) != 0;
        const char* nA = has_next ? (const char*)g.A + (size_t)nxt.pm * tstep : cA; const char* nB = has_next ? (const char*)g.Bt + (size_t)nxt.pn * tstep : cB;
        for (int t = 0; t < nt; t += 2) {
            const bool last = (t == nt - 2);
            const char* a1 = cA + (size_t)(t + 1) * kstep;
            const char* a2 = last ? nA : cA + (size_t)(t + 2) * kstep; const char* b2 = last ? nB : cB + (size_t)(t + 2) * kstep;
            const char* a3 = a2 + kstep; const char* b3 = b2 + kstep;
            if (last && has_next) S.a_ready(nxt);
            if constexpr (SP2) {
            PG8_LDB(B0, 0, 0); PG8_LDB(B1, 0, 1); PG8_SCHED; PG8_LDA(At, 0, 0); PG8_STAGE(PG8_SA(1, 1), a1 + hstep, voffA);
            PG8_WAIT_V(8); PG8_WAIT_L(0); PG8_BAR; PG8_MMA(0, 0, At, B0); PG8_MMA(0, 1, At, B1); PG8_BAR; PG8_SCHED;
            PG8_LDA(At, 0, 1); PG8_STAGE(PG8_SB(0, 0), b2, voffB); PG8_STAGE(PG8_SB(0, 1), b2 + hstep, voffB); PG8_STAGE(PG8_SA(0, 0), a2, voffA);
            PG8_WAIT_V(8); PG8_WAIT_L(0); PG8_BAR; if (!skip1) { PG8_MMA(1, 0, At, B0); PG8_MMA(1, 1, At, B1); } PG8_BAR; PG8_SCHED;
            PG8_LDB(B0, 1, 0); PG8_LDB(B1, 1, 1); PG8_SCHED; PG8_LDA(At, 1, 0); PG8_STAGE(PG8_SA(0, 1), a2 + hstep, voffA);
            PG8_WAIT_V(8); PG8_WAIT_L(0); PG8_BAR; PG8_MMA(0, 0, At, B0); PG8_MMA(0, 1, At, B1); PG8_BAR; PG8_SCHED;
            PG8_LDA(At, 1, 1); PG8_STAGE(PG8_SB(1, 0), b3, voffB); PG8_STAGE(PG8_SB(1, 1), b3 + hstep, voffB); PG8_STAGE(PG8_SA(1, 0), a3, voffA);
            PG8_WAIT_V(8); PG8_WAIT_L(0); PG8_BAR; if (!skip1) { PG8_MMA(1, 0, At, B0); PG8_MMA(1, 1, At, B1); } PG8_BAR; PG8_SCHED;
            } else {
            PG8_LDB(B0, 0, 0); PG8_SCHED; PG8_LDA(At, 0, 0); PG8_STAGE(PG8_SA(1, 1), a1 + hstep, voffA);
            PG8_WAIT_L(8); PG8_BAR; PG8_WAIT_L(0); PG8_MMA(0, 0, At, B0); PG8_BAR; PG8_SCHED;
            PG8_LDB(B1, 0, 1); PG8_STAGE(PG8_SB(0, 0), b2, voffB);
            PG8_BAR; PG8_WAIT_L(0); PG8_MMA(0, 1, At, B1); PG8_BAR;
            PG8_LDA(At, 0, 1); PG8_STAGE(PG8_SA(0, 0), a2, voffA);
            PG8_BAR; PG8_WAIT_L(0); PG8_MMA(1, 0, At, B0); PG8_BAR; PG8_SCHED;
            PG8_STAGE(PG8_SB(0, 1), b2 + hstep, voffB);
            PG8_WAIT_V(6); PG8_BAR; PG8_MMA(1, 1, At, B1); PG8_BAR;
            PG8_LDB(B0, 1, 0); PG8_SCHED; PG8_LDA(At, 1, 0); PG8_STAGE(PG8_SA(0, 1), a2 + hstep, voffA);
            PG8_WAIT_L(8); PG8_BAR; PG8_WAIT_L(0); PG8_MMA(0, 0, At, B0); PG8_BAR; PG8_SCHED;
            PG8_LDB(B1, 1, 1); PG8_STAGE(PG8_SB(1, 0), b3, voffB);
            PG8_BAR; PG8_WAIT_L(0); PG8_MMA(0, 1, At, B1); PG8_BAR;
            PG8_LDA(At, 1, 1); PG8_STAGE(PG8_SA(1, 0), a3, voffA);
            PG8_BAR; PG8_WAIT_L(0); PG8_MMA(1, 0, At, B0); PG8_BAR; PG8_SCHED;
            PG8_STAGE(PG8_SB(1, 1), b3 + hstep, voffB);
            PG8_WAIT_V(6); PG8_BAR; PG8_MMA(1, 1, At, B1); PG8_BAR;
            }
        }
        if constexpr (ALIGN_EPI) { if (wr == 0) PG8_BAR; }
        if constexpr (!Epi::AFTER_DRAIN) { E(acc, cur, wr, wc, fr, fq); S.done(cur); }
        if (!has_next) break;
#pragma unroll
        for (int a = 0; a < 2; ++a)
#pragma unroll
            for (int b = 0; b < 2; ++b)
#pragma unroll
                for (int m = 0; m < 4; ++m)
#pragma unroll
                    for (int n = 0; n < 2; ++n) acc[a][b][m][n] = (f32x4){0.f, 0.f, 0.f, 0.f};
        cur = nxt; cA = nA; cB = nB; ++ui;
        if constexpr (ALIGN_EPI) { if (wr == 1) PG8_BAR; }
    }
    PG8_WAIT_V(0);
    if constexpr (!ALIGN_EPI) { if (wr == 0) PG8_BAR; }
    PG8_BAR;
    if constexpr (Epi::AFTER_DRAIN) { E.fused(acc, cur, wr, wc, fr, fq, lds, wid, lane); S.done(cur); }
#undef PG8_SA
#undef PG8_SB
#undef PG8_STAGE
#undef PG8_LDA
#undef PG8_LDB
#undef PG8_MMA
#undef PG8_WAIT_V
#undef PG8_WAIT_L
#undef PG8_BAR
#undef PG8_SCHED
}
}

constexpr int NWAVES = 8, NTHR = 512;
constexpr int DM = 1024, TSEQ = 4096, NP = 32768, NS = 128, NTOK = NP + NS, MPAD = 33024;
constexpr int INW = 9744, NPROJ = 9728, ABCOL = 6656;
constexpr float LN_EPS = 1e-5f, ALPHA = 1.189207115002721f, GLA_QSCALE = 0.08838834764831845f, NEG_BIG = -1e30f;
constexpr size_t OUT_YP = 0, OUT_YS = 33554432, OUT_KVP1 = 33685504, OUT_KVP2 = 34734080, OUT_KVP3 = 38928384, OUT_STP = 55705600,
                 OUT_KVS1 = 56754176, OUT_KVS2 = 60948480, OUT_KVS3 = 77725696, OUT_STS = 144834560, OUT_TOTAL = 149028864;
constexpr size_t MiB = 1u << 20;
constexpr size_t WS_CTL = 0, CTL_ZERO_BYTES = 1 * MiB;
constexpr size_t WS_KEYS = 1 * MiB, WS_LUT = WS_KEYS + 512 * 1024;
constexpr size_t WS_WA = 2 * MiB, WS_WB = 3 * MiB, WS_WO = 5 * MiB, WS_WQ = 7 * MiB, WS_WIN = 11 * MiB;
constexpr size_t WS_AB = 31 * MiB, WS_UT = 34 * MiB, WS_VT = 66 * MiB, WS_XB = 98 * MiB;
constexpr size_t WS_QA = 163 * MiB, WS_KA = 260 * MiB, WS_VA = 357 * MiB, WS_QB = 454 * MiB, WS_KB = 487 * MiB, WS_VB = 520 * MiB;
constexpr size_t WS_RB = 585 * MiB, WS_GA = 650 * MiB, WS_GB = 715 * MiB, WS_LSE = 780 * MiB, WS_OAM = 784 * MiB, WS_OBN = 817 * MiB, WS_H = 882 * MiB, WS_END = 1011 * MiB;
constexpr size_t WS_HB = WS_KA;
constexpr size_t WS_T1 = WS_KA, WS_MIX = WS_VA, WS_X1B = WS_QA, WS_QN = WS_RB, WS_EIDX = WS_GB, WS_GATE = WS_GB + 17 * MiB;
static_assert(WS_WIN + (size_t)NPROJ * 1024 * 2 <= WS_AB && WS_AB + (size_t)MPAD * 16 * 4 <= WS_UT && WS_XB + (size_t)MPAD * 1024 * 2 <= WS_QA, "ws map 1");
static_assert(WS_QA + (size_t)MPAD * 1536 * 2 <= WS_KA && WS_QB + (size_t)MPAD * 512 * 2 <= WS_KB && WS_VB + (size_t)MPAD * 1024 * 2 <= WS_RB, "ws map 2");
static_assert(WS_LSE + (size_t)3 * MPAD * 8 * 4 <= WS_OAM && WS_OAM + (size_t)MPAD * 512 * 2 <= WS_OBN && WS_OBN + (size_t)MPAD * 1024 * 2 <= WS_H && WS_H + (size_t)MPAD * 1024 * 4 <= WS_END, "ws map 3");
static_assert(WS_QN + (size_t)MPAD * 2048 * 2 <= WS_GB && WS_EIDX + (size_t)MPAD * 128 * 4 <= WS_GATE && WS_GATE + (size_t)MPAD * 128 * 4 <= WS_LSE, "ws map 4");
constexpr int CW_QUEUE = 64;
constexpr int CW_CPYQ = 128;
constexpr int CW_GDONE = 192;
constexpr int NCOPYWG = 10;
constexpr int CW_BAR = 4096;
constexpr int RING_BYTES = 131072, STATS_OFF = RING_BYTES, MISC_OFF = STATS_OFF + 10240 + 320, LDS_BYTES = 147456;
static_assert(MISC_OFF + 128 + 22 * 8 <= LDS_BYTES, "LDS map");

#define GAS __attribute__((address_space(1)))
#define LAS __attribute__((address_space(3)))
typedef unsigned short bf16;
typedef unsigned v4u __attribute__((ext_vector_type(4)));
typedef unsigned v2u __attribute__((ext_vector_type(2)));
typedef float f32x4 __attribute__((ext_vector_type(4)));
typedef float f32x16 __attribute__((ext_vector_type(16)));
typedef short bf16x8 __attribute__((ext_vector_type(8)));
typedef short s16x4 __attribute__((ext_vector_type(4)));
typedef GAS unsigned gu32;
#define RLX_AGENT __ATOMIC_RELAXED, __HIP_MEMORY_SCOPE_AGENT
#define LDS_WAIT() asm volatile("s_waitcnt lgkmcnt(0)" ::: "memory")
#define VM_WAIT() asm volatile("s_waitcnt vmcnt(0)" ::: "memory")
#define MFMA32(a, b, c) __builtin_amdgcn_mfma_f32_32x32x16_bf16((a), (b), (c), 0, 0, 0)
using pg8::cvt_pk_bf16; using pg8::bf_lo; using pg8::bf_hi;
__device__ __forceinline__ unsigned short f2bf(float f) { return (unsigned short)(cvt_pk_bf16(f, 0.f) & 0xffffu); }
__device__ __forceinline__ float bf2f(unsigned short h) { return __uint_as_float((unsigned)h << 16); }
__device__ __forceinline__ int crow(int reg, int hh) { return (reg & 3) + 8 * (reg >> 2) + 4 * hh; }
__device__ __forceinline__ float wave_sum(float v) {
#pragma unroll
    for (int o = 1; o < 64; o <<= 1) v += __shfl_xor(v, o);
    return v;
}
__device__ __forceinline__ float wave_max(float v) {
#pragma unroll
    for (int o = 1; o < 64; o <<= 1) v = fmaxf(v, __shfl_xor(v, o));
    return v;
}
__device__ __forceinline__ bf16x8 frag_row(const LAS unsigned char* T, int stride, int r0, int k0, int lane) {
    return *(const LAS bf16x8*)(T + (r0 + (lane & 31)) * stride + (k0 + 8 * (lane >> 5)) * 2);
}
typedef short v4i16_t __attribute__((ext_vector_type(4)));
template <bool PERM> __device__ __forceinline__ bf16x8 frag_tr(const LAS unsigned char* X, int stride, int k0, int c0, int lane) {
    const int i = lane & 15, g = (lane >> 4) & 1, hh = lane >> 5, q = i >> 2, p = i & 3;
    const int rA = PERM ? (k0 + 4 * hh + q) : (k0 + 8 * hh + q), rB = PERM ? (k0 + 8 + 4 * hh + q) : (k0 + 8 * hh + 4 + q);
    const int cb = (c0 + 16 * g + 4 * p) * 2;
    const s16x4 lo = __builtin_bit_cast(s16x4, __builtin_amdgcn_ds_read_tr16_b64_v4i16((LAS v4i16_t*)(X + rA * stride + cb)));
    const s16x4 hi = __builtin_bit_cast(s16x4, __builtin_amdgcn_ds_read_tr16_b64_v4i16((LAS v4i16_t*)(X + rB * stride + cb)));
    return __builtin_shufflevector(lo, hi, 0, 1, 2, 3, 4, 5, 6, 7);
}
__device__ __forceinline__ bf16x8 pack_acc(const f32x16& x, int s) {
    v4u p; p.x = cvt_pk_bf16(x[8 * s], x[8 * s + 1]); p.y = cvt_pk_bf16(x[8 * s + 2], x[8 * s + 3]); p.z = cvt_pk_bf16(x[8 * s + 4], x[8 * s + 5]); p.w = cvt_pk_bf16(x[8 * s + 6], x[8 * s + 7]);
    return __builtin_bit_cast(bf16x8, p);
}

#define XB_TMO      128
#define XB_XCNT(j)  (256  + 64 * (j))
#define XB_XSUB(j)  (1280 + 64 * (j))
#define XB_XGEN(j)  (2304 + 64 * (j))
#define XB_TOP      3328
#define XB_TOPGEN   3392
#define XCD_BAR_WORDS 3456
#define XB_SPIN_CAP (1u << 22)
__device__ __forceinline__ unsigned xb_ld(unsigned* p)              { return __hip_atomic_load(p, __ATOMIC_RELAXED, __HIP_MEMORY_SCOPE_AGENT); }
__device__ __forceinline__ unsigned xb_add(unsigned* p, unsigned v) { return __hip_atomic_fetch_add(p, v, __ATOMIC_RELAXED, __HIP_MEMORY_SCOPE_AGENT); }
__device__ __forceinline__ unsigned xb_xcc_id() { return (unsigned)__builtin_amdgcn_s_getreg((3 << 11) | 20) & 0xFu; }
#define XB_SPIN(cond, bar) do { unsigned _sp = 0; while (cond) { __builtin_amdgcn_s_sleep(1); \
    if ((++_sp & 255u) == 0u) { if (xb_ld(&(bar)[XB_TMO])) break; if (_sp > XB_SPIN_CAP) { atomicAdd(&(bar)[XB_TMO], 1u); break; } } } } while (0)
struct XcdBarrier { unsigned* bar; unsigned x; volatile LAS unsigned* st; };
__device__ __forceinline__ XcdBarrier xcd_barrier_post(unsigned* bar, volatile LAS unsigned* st) {
    XcdBarrier b; b.bar = bar; b.x = xb_xcc_id(); b.st = st;
    if (threadIdx.x == 0) (void)xb_add(&bar[XB_XCNT(b.x)], 1u);
    return b;
}
__device__ __forceinline__ void xcd_barrier_complete(unsigned* bar, unsigned x, unsigned& nloc, unsigned& nx) {
    const unsigned G = gridDim.x * gridDim.y * gridDim.z;
    unsigned sum, cnt, mine, sp = 0u;
    for (;;) {
        sum = 0u; cnt = 0u; mine = 0u;
#pragma unroll
        for (unsigned j = 0; j < 16; ++j) { const unsigned c = xb_ld(&bar[XB_XCNT(j)]); sum += c; cnt += (c > 0u) ? 1u : 0u; mine = (j == x) ? c : mine; }
        if (sum == G) break;
        __builtin_amdgcn_s_sleep(1);
        if ((++sp & 255u) == 0u) { if (xb_ld(&bar[XB_TMO])) break; if (sp > XB_SPIN_CAP) { atomicAdd(&bar[XB_TMO], 1u); break; } }
    }
    nloc = mine > 0u ? mine : 1u; nx = cnt > 0u ? cnt : 1u;
}
__device__ __forceinline__ void xcd_barrier(const XcdBarrier& b) {
    asm volatile("s_waitcnt vmcnt(0)" ::: "memory");
    __syncthreads();
    if (threadIdx.x == 0) {
        unsigned* bar = b.bar;
        __builtin_amdgcn_s_waitcnt(0);
        unsigned nloc = b.st[0], nx = b.st[1];
        if (nloc == 0u) { xcd_barrier_complete(bar, b.x, nloc, nx); b.st[0] = nloc; b.st[1] = nx; }
        const unsigned old = xb_add(&bar[XB_XSUB(b.x)], 1u);
        const unsigned gen = old / nloc;
        if (old + 1u == (gen + 1u) * nloc) {
            __builtin_amdgcn_fence(__ATOMIC_RELEASE, "agent");
            asm volatile("s_waitcnt vmcnt(0)" ::: "memory");
            const unsigned og = xb_add(&bar[XB_TOP], 1u);
            const unsigned tg = og / nx;
            if (og + 1u == (tg + 1u) * nx) xb_add(&bar[XB_TOPGEN], 1u);
            else XB_SPIN(xb_ld(&bar[XB_TOPGEN]) == tg, bar);
            __builtin_amdgcn_fence(__ATOMIC_ACQUIRE, "agent");
            xb_add(&bar[XB_XGEN(b.x)], 1u);
            asm volatile("s_waitcnt vmcnt(0)" ::: "memory");
        } else {
            XB_SPIN(xb_ld(&bar[XB_XGEN(b.x)]) == gen, bar);
            __builtin_amdgcn_fence(__ATOMIC_ACQUIRE, "agent");
            asm volatile("s_waitcnt vmcnt(0)" ::: "memory");
        }
    }
    __syncthreads();
}

struct Frame {
    LAS unsigned char* lds;
    volatile LAS unsigned* MISC;
    gu32* ctl;
    int tid, lane, wave, G;
    unsigned long long tp;
    float* out; unsigned char* ws;
};
#define WSP(T, off) ((T*)(F.ws + (off)))
#define WSL(T, off) ((T*)(ws_ + (off)))
#define LAUNDER_WS() unsigned char* ws_ = F.ws; asm volatile("" : "+s"(ws_))
constexpr int PTR_OFF = MISC_OFF + 128;
enum { I_XP = 0, I_XS, I_C1, I_C2, I_C3, I_ST0, I_RELB, I_WIN, I_WG2, I_BG, I_GN, I_WA, I_WB, I_WO, I_L1G, I_L1B, I_WQ, I_KEYS, I_PU, I_PV, I_L2G, I_L2B };
__device__ __forceinline__ const float* inptr(const Frame& F, int i) {
    const unsigned long long v = ((volatile LAS unsigned long long*)(F.lds + PTR_OFF))[i];
    const unsigned lo = __builtin_amdgcn_readfirstlane((unsigned)v), hi = __builtin_amdgcn_readfirstlane((unsigned)(v >> 32));
    return (const float*)(((unsigned long long)hi << 32) | lo);
}

__device__ __forceinline__ void p0_tr_load(const float* W, int N, int nsrc0, int k0, int lane, float (&v)[32]) {
#pragma unroll
    for (int i = 0; i < 32; ++i) { const int kk = 2 * i + (lane >> 5); v[i] = W[(size_t)(k0 + kk) * N + nsrc0 + (lane & 31)]; }
}
__device__ __forceinline__ void p0_tr_finish(const float (&v)[32], int K, bf16* WT, int ndst0, int k0, LAS float* scr, int lane) {
#pragma unroll
    for (int i = 0; i < 32; ++i) { const int kk = 2 * i + (lane >> 5); scr[kk * 33 + (lane & 31)] = v[i]; }
    LDS_WAIT(); asm volatile("" ::: "memory");
    const int c = lane & 7;
#pragma unroll
    for (int j = 0; j < 4; ++j) { const int n = (lane >> 3) + 8 * j; const LAS float* s = scr + (8 * c) * 33 + n;
        v4u o; o.x = cvt_pk_bf16(s[0 * 33], s[1 * 33]); o.y = cvt_pk_bf16(s[2 * 33], s[3 * 33]); o.z = cvt_pk_bf16(s[4 * 33], s[5 * 33]); o.w = cvt_pk_bf16(s[6 * 33], s[7 * 33]);
        *(GAS v4u*)(WT + (size_t)(ndst0 + n) * K + k0 + 8 * c) = o; }
    LDS_WAIT(); asm volatile("" ::: "memory");
}
__device__ __forceinline__ void p0_cvt8(const float* src, bf16* dst, size_t n8, size_t gt, size_t ngt) {
    for (size_t i = gt; i < n8; i += ngt) { const f32x4 a = *(const f32x4*)(src + i * 8), b = *(const f32x4*)(src + i * 8 + 4);
        v4u o; o.x = cvt_pk_bf16(a[0], a[1]); o.y = cvt_pk_bf16(a[2], a[3]); o.z = cvt_pk_bf16(b[0], b[1]); o.w = cvt_pk_bf16(b[2], b[3]); *(v4u*)(dst + i * 8) = o; }
}
typedef float f32x2_t __attribute__((ext_vector_type(2)));
typedef _Float16 h2_t __attribute__((ext_vector_type(2)));
constexpr float U_SCALE = 1024.0f, V_SCALE = 128.0f, X_SCALE = 16.0f;
__device__ __forceinline__ void p0_cvt_fp8(const float* src, unsigned char* dst, float scale, size_t n16, size_t gt, size_t ngt) {
    for (size_t i = gt; i < n16; i += ngt) { v4u o;
#pragma unroll
        for (int q = 0; q < 4; ++q) { const f32x4 a = *(const f32x4*)(src + i * 16 + 4 * q) * scale; int w = 0;
            w = __builtin_amdgcn_cvt_pk_fp8_f32(a[0], a[1], w, false); w = __builtin_amdgcn_cvt_pk_fp8_f32(a[2], a[3], w, true); o[q] = (unsigned)w; }
        const size_t e = i >> 6, q16 = i & 63;
        *(v4u*)(dst + (((q16 >> 3) * 16384 + e) << 7) + 16 * (q16 & 7)) = o; }
}
__device__ __forceinline__ void p0_kvshift(const float* src, float* dst, int Wb, size_t gt, size_t ngt) {
    const size_t n4 = (size_t)(Wb - 4) * 256, tot = n4 * 32;
    for (size_t i = gt; i < tot; i += ngt) { const size_t b = i / n4, r = i - b * n4;
        ((f32x4*)dst)[b * (size_t)Wb * 256 + r] = ((const f32x4*)src)[b * (size_t)Wb * 256 + 1024 + r]; }
}
__device__ __forceinline__ void p0_prologue(Frame& F) {
    const int gw = blockIdx.x * NWAVES + F.wave, NGW = F.G * NWAVES;
    const size_t gt = (size_t)blockIdx.x * NTHR + F.tid, ngt = (size_t)F.G * NTHR;
    const float* win = inptr(F, I_WIN); const float* xp = inptr(F, I_XP); const float* xs = inptr(F, I_XS);
    constexpr int WROW = 2064;
    for (int i = F.tid; i < 4096; i += NTHR) {
        const int k = i >> 2, c4 = (i & 3) * 4; const f32x4 w4 = *(const f32x4*)(win + (size_t)k * INW + ABCOL + c4);
#pragma unroll
        for (int cc = 0; cc < 4; ++cc) *(LAS unsigned short*)(F.lds + (c4 + cc) * WROW + k * 2) = f2bf(w4[cc]); }
    __syncthreads();
    bf16* XB = WSP(bf16, WS_XB); float* AB = WSP(float, WS_AB);
    {   const int lane = F.lane, r = lane & 15, kg = lane >> 4;
        typedef float f32x4a __attribute__((ext_vector_type(4)));
        for (int blk = gw; blk < MPAD / 16; blk += NGW) {
            const int m = 16 * blk + r;
            bf16* xo = XB + (size_t)m * 1024 + 8 * kg;
            if (16 * blk >= NTOK) {
#pragma unroll 8
                for (int s = 0; s < 32; ++s) *(v4u*)(xo + 32 * s) = (v4u){0u, 0u, 0u, 0u};
                if (kg == 0) { *(f32x4*)(AB + (size_t)m * 16) = (f32x4){0.f, 0.f, 0.f, 0.f}; *(f32x4*)(AB + (size_t)m * 16 + 4) = (f32x4){0.f, 0.f, 0.f, 0.f}; *(f32x4*)(AB + (size_t)m * 16 + 8) = (f32x4){0.f, 0.f, 0.f, 0.f}; *(f32x4*)(AB + (size_t)m * 16 + 12) = (f32x4){0.f, 0.f, 0.f, 0.f}; }
                continue; }
            const float* xr = (m < NP ? xp + (size_t)m * 1024 : xs + (size_t)(m - NP) * 1024) + 8 * kg;
            f32x4a acc = {0.f, 0.f, 0.f, 0.f};
#pragma unroll 1
            for (int s0 = 0; s0 < 32; s0 += 16) {
                f32x4 xa[16], xb[16];
#pragma unroll
                for (int u = 0; u < 16; ++u) { xa[u] = *(const f32x4*)(xr + 32 * (s0 + u)); xb[u] = *(const f32x4*)(xr + 32 * (s0 + u) + 4); }
#pragma unroll
                for (int u = 0; u < 16; ++u) { v4u w; w.x = cvt_pk_bf16(xa[u][0], xa[u][1]); w.y = cvt_pk_bf16(xa[u][2], xa[u][3]); w.z = cvt_pk_bf16(xb[u][0], xb[u][1]); w.w = cvt_pk_bf16(xb[u][2], xb[u][3]);
                    *(v4u*)(xo + 32 * (s0 + u)) = w;
                    const bf16x8 bfr = *(const LAS bf16x8*)(F.lds + r * WROW + (32 * (s0 + u) + 8 * kg) * 2);
                    acc = __builtin_amdgcn_mfma_f32_16x16x32_bf16(__builtin_bit_cast(bf16x8, w), bfr, acc, 0, 0, 0); }
            }
#pragma unroll
            for (int i2 = 0; i2 < 4; ++i2) AB[(size_t)(16 * blk + 4 * kg + i2) * 16 + r] = acc[i2];
        }
    }
    __syncthreads();
    LAS float* scr = (LAS float*)(F.lds + F.wave * 16384);
    const float* wa = inptr(F, I_WA); const float* wb = inptr(F, I_WB); const float* wo = inptr(F, I_WO); const float* wq = inptr(F, I_WQ);
    constexpr int I_IN = 16 * (NPROJ / 32), I_A = 8 * 32, I_B = 16 * 32, I_O = 16 * 32, I_Q = 16 * 64, NIT = I_IN + I_A + I_B + I_O + I_Q;
#define P0_TR_PARAMS(IT, W_, WT_, K_, N_, NS_, ND_, K0_) { int r = (IT); \
        if (r < I_IN) { const int nb = r % (NPROJ / 32), kb = r / (NPROJ / 32), nd = 32 * nb; W_ = win; WT_ = WSP(bf16, WS_WIN); K_ = 1024; N_ = INW; NS_ = nd + (nd >= ABCOL ? 16 : 0); ND_ = nd; K0_ = 64 * kb; } \
        else if ((r -= I_IN) < I_A) { W_ = wa; WT_ = WSP(bf16, WS_WA); K_ = 512; N_ = 1024; NS_ = ND_ = 32 * (r % 32); K0_ = 64 * (r / 32); } \
        else if ((r -= I_A) < I_B) { W_ = wb; WT_ = WSP(bf16, WS_WB); K_ = 1024; N_ = 1024; NS_ = ND_ = 32 * (r % 32); K0_ = 64 * (r / 32); } \
        else if ((r -= I_B) < I_O) { W_ = wo; WT_ = WSP(bf16, WS_WO); K_ = 1024; N_ = 1024; NS_ = ND_ = 32 * (r % 32); K0_ = 64 * (r / 32); } \
        else { r -= I_O; W_ = wq; WT_ = WSP(bf16, WS_WQ); K_ = 1024; N_ = 2048; NS_ = ND_ = 32 * (r % 64); K0_ = 64 * (r / 64); } }
    if (blockIdx.x != 0) {
        const int NW2 = NGW - NWAVES;
        for (int it = gw - NWAVES; it < NIT; it += 2 * NW2) {
            const int it2 = it + NW2; const bool has2 = it2 < NIT;
            const float* Wa; bf16* WTa; int Ka, Na, NSa, NDa, K0a; P0_TR_PARAMS(it, Wa, WTa, Ka, Na, NSa, NDa, K0a);
            const float* Wb = Wa; bf16* WTb = WTa; int Kb = Ka, Nb = Na, NSb = NSa, NDb = NDa, K0b = K0a;
            if (has2) P0_TR_PARAMS(it2, Wb, WTb, Kb, Nb, NSb, NDb, K0b);
            float va[32], vb[32];
            p0_tr_load(Wa, Na, NSa, K0a, F.lane, va);
            if (has2) p0_tr_load(Wb, Nb, NSb, K0b, F.lane, vb);
            p0_tr_finish(va, Ka, WTa, NDa, K0a, scr, F.lane);
            if (has2) p0_tr_finish(vb, Kb, WTb, NDb, K0b, scr, F.lane);
        }
    }
    p0_cvt_fp8(inptr(F, I_PU), WSP(unsigned char, WS_UT), U_SCALE, (size_t)16384 * 1024 / 16, gt, ngt);
    p0_cvt_fp8(inptr(F, I_PV), WSP(unsigned char, WS_VT), V_SCALE, (size_t)16384 * 1024 / 16, gt, ngt);
    p0_cvt8(inptr(F, I_KEYS), WSP(bf16, WS_KEYS), (size_t)8 * 2 * 128 * 128 / 8, gt, ngt);
    if (gt < 3 * 8 * 129) { const int g = (int)gt / (8 * 129), h = ((int)gt / 129) % 8, rel = (int)gt % 129; const int dil = g == 0 ? 1 : (g == 1 ? 4 : 16), dist = rel * dil;
        int bucket = dist;
        if (dist >= 16) { const float dd = (float)dist; int lg = 16 + (int)(logf(dd / 16.0f) / 4.852030263919617f * 16.0f); bucket = lg < 31 ? lg : 31; }
        WSP(float, WS_LUT)[gt] = inptr(F, I_RELB)[bucket * 24 + g * 8 + h]; }
}

constexpr size_t WS_KD = WS_OAM, WS_DEC = WS_OBN;
__device__ __forceinline__ void gla_prep_load(Frame& F, int unit, unsigned (&qv)[8], unsigned (&kv)[8], float (&abv)[2]) {
    const int d2 = F.tid & 63, ig = F.wave, h = unit & 3, n = (unit >> 2) & 63, b = unit >> 8;
    const size_t m0 = (size_t)b * TSEQ + (size_t)n * 64;
    const bf16* QB = WSP(bf16, WS_QB); const bf16* KB = WSP(bf16, WS_KB); const float* AB = WSP(float, WS_AB);
#pragma unroll
    for (int ii = 0; ii < 8; ++ii) { const size_t off = (m0 + 8 * ig + ii) * 512 + h * 128 + 2 * d2; qv[ii] = *(const unsigned*)(QB + off); kv[ii] = *(const unsigned*)(KB + off); }
    abv[0] = AB[(m0 + 8 * ig) * 16 + d2]; abv[1] = AB[(m0 + 8 * ig) * 16 + 64 + d2];
}
__device__ __forceinline__ void gla_prep_unit(Frame& F, int unit, const unsigned (&qv)[8], const unsigned (&kv)[8], const float (&abv)[2], const f32x2_t (&wg)[16], const f32x2_t bgd) {
    LAUNDER_WS();
    LAS float* GT = (LAS float*)F.lds;
    const int tid = F.tid, d2 = tid & 63, ig = F.wave;
    const int h = unit & 3, n = (unit >> 2) & 63, b = unit >> 8;
    const size_t m0 = (size_t)b * TSEQ + (size_t)n * 64;
    bf16* QB = WSL(bf16, WS_QB); bf16* KB = WSL(bf16, WS_KB); float* DEC = WSL(float, WS_DEC);
    f32x2_t c[8]; f32x2_t run = {0.f, 0.f};
#pragma unroll
    for (int ii = 0; ii < 8; ++ii) {
        f32x2_t x = bgd;
#pragma unroll
        for (int r = 0; r < 16; ++r) x += wg[r] * __uint_as_float((unsigned)__builtin_amdgcn_readlane((int)__float_as_uint(abv[ii >> 2]), 16 * (ii & 3) + r));
        f32x2_t ls; ls.x = fminf(x.x, 0.f) - __logf(1.0f + __expf(-fabsf(x.x))); ls.y = fminf(x.y, 0.f) - __logf(1.0f + __expf(-fabsf(x.y)));
        run += ls * (1.0f / 16.0f); c[ii] = run;
    }
    *(LAS f32x2_t*)(GT + ig * 128 + 2 * d2) = run;
    __syncthreads();
    f32x2_t offs = {0.f, 0.f}, bl = {0.f, 0.f};
#pragma unroll
    for (int g = 0; g < 8; ++g) { const f32x2_t t = *(const LAS f32x2_t*)(GT + g * 128 + 2 * d2); bl += t; if (g < ig) offs += t; }
    const f32x2_t ebl = {__expf(bl.x), __expf(bl.y)};
#pragma unroll
    for (int ii = 0; ii < 8; ++ii) {
        const f32x2_t bb = offs + c[ii]; const f32x2_t eb = {__expf(bb.x), __expf(bb.y)}, ieb = {__expf(-bb.x), __expf(-bb.y)};
        const f32x2_t q = {bf_lo(qv[ii]), bf_hi(qv[ii])}, k = {bf_lo(kv[ii]), bf_hi(kv[ii])};
        const f32x2_t qe = q * GLA_QSCALE * eb, ke = k * ieb;
        const size_t off = (m0 + 8 * ig + ii) * 512 + h * 128 + 2 * d2;
        *(unsigned*)(QB + off) = cvt_pk_bf16(qe.x, qe.y); *(unsigned*)(KB + off) = cvt_pk_bf16(ke.x, ke.y);
    }
    if (ig == 0) *(f32x2_t*)(DEC + ((size_t)b * 64 + n) * 512 + h * 128 + 2 * d2) = ebl;
    __syncthreads();
}
__device__ __forceinline__ void gla_prompt_unit(Frame& F, int b, int h, int sl) {
    LAUNDER_WS();
    LAS unsigned char* L = F.lds;
    constexpr int O_QE = 0, O_KE = 17408, O_KD = 34816, O_VT = 55296, O_SB = 67584, O_DEC = 92160;
    const int tid = F.tid, lane = F.lane, w = F.wave, hh = lane >> 5;
    const bf16* QB = WSL(bf16, WS_QB); const bf16* KB = WSL(bf16, WS_KB); bf16* VB = WSL(bf16, WS_VB); const float* DEC = WSL(float, WS_DEC);
    for (int i = tid; i < 128 * 192 / 4; i += NTHR) ((LAS unsigned*)(L + O_SB))[i] = 0u;
    f32x16 S;
#pragma unroll
    for (int r = 0; r < 16; ++r) S[r] = 0.f;
    const int dt = w >> 1, et = w & 1;
    const int r0 = tid >> 4, c0 = tid & 15;
    v4u tq[2], tk[2], tv; float tdec = 0.f;
#define GLA_LOAD(n_) do { const size_t m0_ = (size_t)b * TSEQ + (size_t)(n_) * 64; \
        _Pragma("unroll") for (int i_ = 0; i_ < 2; ++i_) { const size_t off_ = (m0_ + r0 + 32 * i_) * 512 + h * 128 + c0 * 8; tq[i_] = *(const v4u*)(QB + off_); tk[i_] = *(const v4u*)(KB + off_); } \
        tv = *(const v4u*)(VB + (m0_ + (tid >> 3)) * 1024 + h * 256 + sl * 64 + (tid & 7) * 8); \
        if (tid < 128) tdec = DEC[((size_t)b * 64 + (n_)) * 512 + h * 128 + tid]; } while (0)
    GLA_LOAD(0);
    for (int n = 0; n < 64; ++n) {
        const size_t m0 = (size_t)b * TSEQ + (size_t)n * 64;
#pragma unroll
        for (int i = 0; i < 2; ++i) { *(LAS v4u*)(L + O_QE + (r0 + 32 * i) * 272 + c0 * 16) = tq[i]; *(LAS v4u*)(L + O_KE + (r0 + 32 * i) * 272 + c0 * 16) = tk[i]; *(LAS v4u*)(L + O_KD + (r0 + 32 * i) * 320 + c0 * 16) = tk[i]; }
        *(LAS v4u*)(L + O_VT + (tid >> 3) * 192 + (tid & 7) * 16) = tv;
        if (tid < 128) ((LAS float*)(L + O_DEC))[tid] = tdec;
        __syncthreads();
        if (n + 1 < 64) GLA_LOAD(n + 1);
        if (w < 4) {
            const int it = w >> 1;
            f32x16 o;
#pragma unroll
            for (int r = 0; r < 16; ++r) o[r] = 0.f;
            for (int jt = 0; jt <= it; ++jt) {
                f32x16 X;
#pragma unroll
                for (int r = 0; r < 16; ++r) X[r] = 0.f;
#pragma unroll
                for (int s = 0; s < 8; ++s) X = MFMA32(frag_row(L + O_KE, 272, 32 * jt, 16 * s, lane), frag_row(L + O_QE, 272, 32 * it, 16 * s, lane), X);
                if (jt == it) {
#pragma unroll
                    for (int r = 0; r < 16; ++r) if (crow(r, hh) > (lane & 31)) X[r] = 0.f;
                }
#pragma unroll
                for (int s2 = 0; s2 < 2; ++s2) o = MFMA32(pack_acc(X, s2), frag_tr<true>(L + O_VT, 192, 32 * jt + 16 * s2, 32 * et, lane), o);
            }
#pragma unroll
            for (int s = 0; s < 8; ++s) o = MFMA32(frag_row(L + O_QE, 272, 32 * it, 16 * s, lane), frag_tr<false>(L + O_SB, 192, 16 * s, 32 * et, lane), o);
            bf16* op = VB + (m0 + 32 * it) * 1024 + h * 256 + sl * 64 + 32 * et + (lane & 31);
#pragma unroll
            for (int r = 0; r < 16; ++r) op[(size_t)crow(r, hh) * 1024] = f2bf(o[r]);
        }
        {
#pragma unroll
            for (int s = 0; s < 4; ++s) S = MFMA32(frag_tr<false>(L + O_KD, 320, 16 * s, 32 * dt, lane), frag_tr<false>(L + O_VT, 192, 16 * s, 32 * et, lane), S);
#pragma unroll
            for (int r = 0; r < 16; ++r) S[r] *= ((LAS float*)(L + O_DEC))[32 * dt + crow(r, hh)];
        }
        __syncthreads();
#pragma unroll
        for (int r = 0; r < 16; ++r) *(LAS unsigned short*)(L + O_SB + (32 * dt + crow(r, hh)) * 192 + (32 * et + (lane & 31)) * 2) = f2bf(S[r]);
    }
#undef GLA_LOAD
    float* so = F.out + OUT_STP + ((size_t)(b * 4 + h) * 128 + 32 * dt) * 256 + sl * 64 + 32 * et + (lane & 31);
#pragma unroll
    for (int r = 0; r < 16; ++r) so[(size_t)crow(r, hh) * 256] = S[r];
    __syncthreads();
}

struct AttnItem { int b, h, g, r, dil, i0, cb; size_t tok0; };
__device__ __forceinline__ AttnItem attn_decode(int item) {
    AttnItem a; const int bh = item / 48, sub = item % 48; a.b = bh >> 3; a.h = bh & 7;
    int ibg;
    if (sub < 16) { a.g = 0; a.r = 0; ibg = sub; } else if (sub < 32) { a.g = 1; a.r = (sub - 16) >> 2; ibg = (sub - 16) & 3; } else { a.g = 2; a.r = sub - 32; ibg = 0; }
    a.dil = a.g == 0 ? 1 : (a.g == 1 ? 4 : 16); a.i0 = 256 * ibg; a.tok0 = (size_t)a.b * TSEQ + a.r; a.cb = a.g * 512 + a.h * 64;
    return a;
}
__device__ __forceinline__ void attn_issue(Frame& F, int item, v4u (&kk)[6], v4u (&vv)[6], bf16x8 (&qf)[4]) {
    LAUNDER_WS();
    const AttnItem a = attn_decode(item);
    const int tid = F.tid, lane = F.lane, w = F.wave, hh = lane >> 5, il = lane & 31;
    const bf16* QA = WSL(bf16, WS_QA); const bf16* KA = WSL(bf16, WS_KA); const bf16* VA = WSL(bf16, WS_VA);
    const size_t qtok = a.tok0 + (size_t)a.dil * (a.i0 + 32 * w + il);
#pragma unroll
    for (int s = 0; s < 4; ++s) qf[s] = *(const bf16x8*)(QA + qtok * 1536 + a.cb + 16 * s + 8 * hh);
#pragma unroll
    for (int p = 0; p < 6; ++p) { const int idx = tid + NTHR * p, rr = idx >> 3, ch = idx & 7, j = a.i0 - 128 + rr;
        if (j >= 0) { const size_t so = (a.tok0 + (size_t)a.dil * j) * 1536 + a.cb + ch * 8; vv[p] = *(const v4u*)(VA + so); kk[p] = *(const v4u*)(KA + so); } }
}
template <bool LOAD_LUT> __device__ __forceinline__ void attn_prompt_item(Frame& F, int item, v4u (&kk)[6], v4u (&vv)[6], const bf16x8 (&qf)[4], bool has_next, int next_item, bf16x8 (&qn)[4]) {
    LAUNDER_WS();
    LAS unsigned char* L = F.lds;
    constexpr int O_V = 0, O_K = 384 * 192, O_LUT = O_K + 384 * 144;
    static_assert(O_LUT + 129 * 4 <= RING_BYTES, "attention LDS");
    const int tid = F.tid, lane = F.lane, w = F.wave, hh = lane >> 5, il = lane & 31;
    const AttnItem a = attn_decode(item);
    const int b = a.b, h = a.h, g = a.g, dil = a.dil, i0 = a.i0, cb = a.cb; const size_t tok0 = a.tok0; (void)b;
    bf16* QA = WSL(bf16, WS_QA); float* LSE = WSL(float, WS_LSE);
    const size_t qtok = tok0 + (size_t)dil * (i0 + 32 * w + il);
#pragma unroll
    for (int p = 0; p < 6; ++p) { const int idx = tid + NTHR * p, rr = idx >> 3, ch = idx & 7, j = i0 - 128 + rr;
        if (j >= 0) { *(LAS v4u*)(L + O_V + rr * 192 + ch * 16) = vv[p]; *(LAS v4u*)(L + O_K + rr * 144 + ch * 16) = kk[p]; } }
    if (LOAD_LUT && tid < 129) ((LAS float*)(L + O_LUT))[tid] = WSL(float, WS_LUT)[(g * 8 + h) * 129 + tid];
    __syncthreads();
    if (has_next) attn_issue(F, next_item, kk, vv, qn);
    float mrun = NEG_BIG, lrun = 0.f;
    f32x16 O0, O1;
#pragma unroll
    for (int x = 0; x < 16; ++x) { O0[x] = 0.f; O1[x] = 0.f; }
#pragma unroll 1
    for (int kt = 0; kt < 5; ++kt) {
        const int jb = i0 + 32 * (w + kt) - 128;
        if (jb < 0) continue;
        f32x16 ST;
#pragma unroll
        for (int x = 0; x < 16; ++x) ST[x] = 0.f;
#pragma unroll
        for (int s = 0; s < 4; ++s) ST = MFMA32(frag_row(L + O_K, 144, 32 * (w + kt), 16 * s, lane), qf[s], ST);
        const int relb = 128 - 32 * kt + il;
        float tmax = NEG_BIG;
#pragma unroll
        for (int x = 0; x < 16; ++x) { const int rel = relb - crow(x, hh); const bool ok = rel >= 0 && rel <= 128; const int rc = rel < 0 ? 0 : (rel > 128 ? 128 : rel);
            const float sc = ok ? ST[x] + ((LAS float*)(L + O_LUT))[rc] : NEG_BIG; ST[x] = sc; tmax = fmaxf(tmax, sc); }
        tmax = fmaxf(tmax, __shfl_xor(tmax, 32));
        const float mnew = fmaxf(mrun, tmax), alpha = __expf(mrun - mnew);
        float ps = 0.f;
#pragma unroll
        for (int x = 0; x < 16; ++x) { const float p = __expf(ST[x] - mnew); ST[x] = p; ps += p; }
        lrun = lrun * alpha + ps; mrun = mnew;
#pragma unroll
        for (int x = 0; x < 16; ++x) { O0[x] *= alpha; O1[x] *= alpha; }
#pragma unroll
        for (int s2 = 0; s2 < 2; ++s2) { const bf16x8 pf = pack_acc(ST, s2);
            O0 = MFMA32(frag_tr<true>(L + O_V, 192, 32 * (w + kt) + 16 * s2, 0, lane), pf, O0);
            O1 = MFMA32(frag_tr<true>(L + O_V, 192, 32 * (w + kt) + 16 * s2, 32, lane), pf, O1); }
    }
    const float ltot = lrun + __shfl_xor(lrun, 32), inv = 1.0f / ltot;
    bf16* op = QA + qtok * 1536 + cb;
#pragma unroll
    for (int k4 = 0; k4 < 4; ++k4) { v2u a, c2;
        a.x = cvt_pk_bf16(O0[4 * k4] * inv, O0[4 * k4 + 1] * inv); a.y = cvt_pk_bf16(O0[4 * k4 + 2] * inv, O0[4 * k4 + 3] * inv);
        c2.x = cvt_pk_bf16(O1[4 * k4] * inv, O1[4 * k4 + 1] * inv); c2.y = cvt_pk_bf16(O1[4 * k4 + 2] * inv, O1[4 * k4 + 3] * inv);
        *(v2u*)(op + 8 * k4 + 4 * hh) = a; *(v2u*)(op + 32 + 8 * k4 + 4 * hh) = c2; }
    if (hh == 0) LSE[((size_t)g * MPAD + qtok) * 8 + h] = mrun + __logf(ltot);
    __syncthreads();
}

#define DPP_FA(x, ctrl) __uint_as_float((unsigned)__builtin_amdgcn_mov_dpp((int)__float_as_uint(x), (ctrl), 0xf, 0xf, true))
template <int G_> __device__ __forceinline__ void attn_sample_waveitem_g(Frame& F, int wi, const float* cache) {
    LAUNDER_WS();
    int lane = F.lane; asm volatile("" : "+v"(lane));
    const int grp = lane >> 4, l16 = lane & 15;
    constexpr int g = G_; const int h = (wi / 3) & 7, s = (wi / 24) & 3, b = wi / 96;
    constexpr int dil = g == 0 ? 1 : (g == 1 ? 4 : 16), Wb = 128 * dil;
    bf16* QA = WSL(bf16, WS_QA); const bf16* KA = WSL(bf16, WS_KA); const bf16* VA = WSL(bf16, WS_VA); float* LSE = WSL(float, WS_LSE);
    const size_t qrow = (size_t)NP + b * 4 + s; const int cb = g * 512 + h * 64;
    const v2u qu = *(const v2u*)(QA + qrow * 1536 + cb + 4 * l16);
    const float q0 = bf_lo(qu.x), q1 = bf_hi(qu.x), q2 = bf_lo(qu.y), q3 = bf_hi(qu.y);
    const float* lut = WSL(float, WS_LUT) + (g * 8 + h) * 129;
    const float* kc = cache + ((size_t)b * Wb * 2) * 512 + h * 64 + 4 * l16;
    const bf16* kn = KA + ((size_t)NP + b * 4) * 1536 + cb + 4 * l16; const bf16* vn = VA + ((size_t)NP + b * 4) * 1536 + cb + 4 * l16;
    float sc[33];
#pragma unroll
    for (int i0 = 0; i0 < 33; i0 += 11) { f32x4 kv[11]; float lb[11];
#pragma unroll
        for (int u = 0; u < 11; ++u) { const int jj = 4 * (i0 + u) + grp; kv[u] = (f32x4){0.f, 0.f, 0.f, 0.f}; lb[u] = 0.f;
            if (jj <= 128) { const int idx = Wb + s - jj * dil; lb[u] = lut[jj];
                if (idx >= Wb) { const v2u w2 = *(const v2u*)(kn + (size_t)(idx - Wb) * 1536); kv[u] = (f32x4){bf_lo(w2.x), bf_hi(w2.x), bf_lo(w2.y), bf_hi(w2.y)}; }
                else kv[u] = *(const f32x4*)(kc + (size_t)idx * 1024); } }
#pragma unroll
        for (int u = 0; u < 11; ++u) { const int jj = 4 * (i0 + u) + grp;
            float a = (q0 * kv[u][0] + q1 * kv[u][1]) + (q2 * kv[u][2] + q3 * kv[u][3]);
            a += DPP_FA(a, 0xB1); a += DPP_FA(a, 0x4E); a += DPP_FA(a, 0x141); a += DPP_FA(a, 0x128);
            sc[i0 + u] = jj <= 128 ? a + lb[u] : NEG_BIG; }
    }
    float mx = sc[0];
#pragma unroll
    for (int i = 1; i < 33; ++i) mx = fmaxf(mx, sc[i]);
    mx = fmaxf(mx, __shfl_xor(mx, 16)); mx = fmaxf(mx, __shfl_xor(mx, 32));
    float ps = 0.f;
#pragma unroll
    for (int i = 0; i < 33; ++i) { sc[i] = __expf(sc[i] - mx); ps += sc[i]; }
    ps += __shfl_xor(ps, 16); ps += __shfl_xor(ps, 32);
    f32x4 o = {0.f, 0.f, 0.f, 0.f};
#pragma unroll
    for (int i0 = 0; i0 < 33; i0 += 11) { f32x4 vv[11];
#pragma unroll
        for (int u = 0; u < 11; ++u) { const int jj = 4 * (i0 + u) + grp; vv[u] = (f32x4){0.f, 0.f, 0.f, 0.f};
            if (jj <= 128) { const int idx = Wb + s - jj * dil;
                if (idx >= Wb) { const v2u w2 = *(const v2u*)(vn + (size_t)(idx - Wb) * 1536); vv[u] = (f32x4){bf_lo(w2.x), bf_hi(w2.x), bf_lo(w2.y), bf_hi(w2.y)}; }
                else vv[u] = *(const f32x4*)(kc + (size_t)idx * 1024 + 512); } }
#pragma unroll
        for (int u = 0; u < 11; ++u) o += vv[u] * sc[i0 + u];
    }
#pragma unroll
    for (int k = 0; k < 4; ++k) { o[k] += __shfl_xor(o[k], 16); o[k] += __shfl_xor(o[k], 32); }
    const float inv = 1.0f / ps;
    if (grp == 0) { v2u w2; w2.x = cvt_pk_bf16(o[0] * inv, o[1] * inv); w2.y = cvt_pk_bf16(o[2] * inv, o[3] * inv); *(v2u*)(QA + qrow * 1536 + cb + 4 * l16) = w2; }
    if (lane == 0) LSE[((size_t)g * MPAD + qrow) * 8 + h] = mx + __logf(ps);
}

__device__ __forceinline__ void attn_sample_waveitem(Frame& F, int wi) {
    const int g = wi % 3;
    if (g == 0) attn_sample_waveitem_g<0>(F, wi, inptr(F, I_C1)); else if (g == 1) attn_sample_waveitem_g<1>(F, wi, inptr(F, I_C2)); else attn_sample_waveitem_g<2>(F, wi, inptr(F, I_C3));
}
__device__ __forceinline__ void gla_sample_item(Frame& F, int item) {
    LAUNDER_WS();
    LAS float* L = (LAS float*)F.lds;
    constexpr int O_LA = 0, O_QE = 512, O_KE = 1024, O_KD = 1536, O_DEC = 2048, O_ATT = 2176, O_PART = 2304;
    const int tid = F.tid, b = item >> 2, h = item & 3;
    const bf16* QB = WSL(bf16, WS_QB); const bf16* KB = WSL(bf16, WS_KB); bf16* VB = WSL(bf16, WS_VB); const float* AB = WSL(float, WS_AB);
    const size_t row0 = (size_t)NP + b * 4;
    { const int i = tid >> 7, d = tid & 127; float x = inptr(F, I_BG)[h * 128 + d]; const float* wg2 = inptr(F, I_WG2);
#pragma unroll
      for (int r = 0; r < 16; ++r) x += AB[(row0 + i) * 16 + r] * wg2[r * 512 + h * 128 + d];
      L[O_LA + i * 128 + d] = (fminf(x, 0.f) - log1pf(expf(-fabsf(x)))) * (1.0f / 16.0f); }
    __syncthreads();
    if (tid < 128) { const int d = tid; float bb[4]; float run = 0.f;
#pragma unroll
        for (int i = 0; i < 4; ++i) { run += L[O_LA + i * 128 + d]; bb[i] = run; }
        const float ebl = expf(run); L[O_DEC + d] = ebl;
#pragma unroll
        for (int i = 0; i < 4; ++i) { const float q = bf2f(QB[(row0 + i) * 512 + h * 128 + d]), k = bf2f(KB[(row0 + i) * 512 + h * 128 + d]);
            L[O_QE + i * 128 + d] = q * GLA_QSCALE * expf(bb[i]); L[O_KE + i * 128 + d] = k * expf(-bb[i]); L[O_KD + i * 128 + d] = k * expf(run - bb[i]); } }
    __syncthreads();
    if (tid < 16) { const int i = tid >> 2, j = tid & 3; float a = 0.f;
        if (j <= i) for (int d = 0; d < 128; ++d) a += L[O_QE + i * 128 + d] * L[O_KE + j * 128 + d];
        L[O_ATT + tid] = a; }
    const int e = tid & 255, dh = tid >> 8;
    float v[4];
#pragma unroll
    for (int j = 0; j < 4; ++j) v[j] = bf2f(VB[(row0 + j) * 1024 + h * 256 + e]);
    const float* Sin = inptr(F, I_ST0) + ((size_t)(b * 4 + h) * 128) * 256 + e; float* Sout = F.out + OUT_STS + ((size_t)(b * 4 + h) * 128) * 256 + e;
    float acc[4] = {0.f, 0.f, 0.f, 0.f};
#pragma unroll 1
    for (int dd0 = 0; dd0 < 64; dd0 += 16) { float svv[16];
#pragma unroll
        for (int u = 0; u < 16; ++u) svv[u] = Sin[(size_t)(dh * 64 + dd0 + u) * 256];
#pragma unroll
        for (int u = 0; u < 16; ++u) { const int d = dh * 64 + dd0 + u; const float sv = svv[u];
#pragma unroll
            for (int i = 0; i < 4; ++i) acc[i] += L[O_QE + i * 128 + d] * sv;
            float sn = L[O_DEC + d] * sv;
#pragma unroll
            for (int j = 0; j < 4; ++j) sn += L[O_KD + j * 128 + d] * v[j];
            Sout[(size_t)d * 256] = sn; } }
#pragma unroll
    for (int i = 0; i < 4; ++i) L[O_PART + (dh * 4 + i) * 256 + e] = acc[i];
    __syncthreads();
    if (tid < 256) {
#pragma unroll
        for (int i = 0; i < 4; ++i) { float o = L[O_PART + i * 256 + e] + L[O_PART + (4 + i) * 256 + e];
#pragma unroll
            for (int j = 0; j < 4; ++j) o += L[O_ATT + i * 4 + j] * v[j];
            VB[(row0 + i) * 1024 + h * 256 + e] = f2bf(o); } }
    __syncthreads();
}

static_assert(true, "");
constexpr int P2_ATT = 3072, P2_DEC = 384, P2_GLS = 128, P2_CPY = 32 * (2 + 8 + 32), P2_ITEMS = P2_ATT + P2_DEC + P2_GLS;
__device__ __forceinline__ void kvshift_item(Frame& F, int item) {
    int g, r = item; if (r < 64) g = 0; else if (r < 64 + 256) { g = 1; r -= 64; } else { g = 2; r -= 320; }
    const int Wb = g == 0 ? 128 : (g == 1 ? 512 : 2048), npc = Wb / 64, b = r / npc, pc = r % npc;
    const float* src = inptr(F, g == 0 ? I_C1 : (g == 1 ? I_C2 : I_C3)); float* dst = F.out + (g == 0 ? OUT_KVS1 : (g == 1 ? OUT_KVS2 : OUT_KVS3));
    const int nrow = (pc == npc - 1) ? 60 : 64;
    const f32x4* s4 = (const f32x4*)src + ((size_t)b * Wb + 64 * pc + 4) * 256; f32x4* d4 = (f32x4*)dst + ((size_t)b * Wb + 64 * pc) * 256;
    { const int i = F.tid; f32x4 v[32];
#pragma unroll
        for (int u = 0; u < 32; ++u) if (u < 30 || nrow == 64) v[u] = __builtin_nontemporal_load(s4 + i + u * NTHR);
#pragma unroll
        for (int u = 0; u < 32; ++u) if (u < 30 || nrow == 64) __builtin_nontemporal_store(v[u], d4 + i + u * NTHR); }
}
template <bool STOP_ON_GDONE> __device__ __forceinline__ void kvshift_loop(Frame& F) {
    for (;;) {
        if (F.tid == 0) { unsigned t = 0xffffffffu;
            if (!STOP_ON_GDONE || __hip_atomic_load(F.ctl + CW_GDONE, RLX_AGENT) == 0u) t = __hip_atomic_fetch_add(F.ctl + CW_CPYQ, 1u, RLX_AGENT);
            F.MISC[0] = t; }
        __syncthreads();
        const unsigned t = F.MISC[0];
        __syncthreads();
        if (t >= (unsigned)P2_CPY) break;
        kvshift_item(F, (int)t);
    }
}
__device__ __forceinline__ void p2_prep(Frame& F) {
    unsigned qa[8], ka[8], qb[8], kb[8]; float aa[2], ab2[2];
    int u = blockIdx.x; if (u >= 2048) return;
    const int d2 = F.tid & 63, h = u & 3;
    const float* wg2 = inptr(F, I_WG2); const float* bgp = inptr(F, I_BG);
    f32x2_t wg[16];
#pragma unroll
    for (int r = 0; r < 16; ++r) wg[r] = *(const f32x2_t*)(wg2 + r * 512 + h * 128 + 2 * d2);
    const f32x2_t bgd = *(const f32x2_t*)(bgp + h * 128 + 2 * d2);
    gla_prep_load(F, u, qa, ka, aa);
    for (;;) {
        const int u1 = u + F.G; if (u1 < 2048) gla_prep_load(F, u1, qb, kb, ab2);
        gla_prep_unit(F, u, qa, ka, aa, wg, bgd); if (u1 >= 2048) break;
        const int u2 = u1 + F.G; if (u2 < 2048) gla_prep_load(F, u2, qa, ka, aa);
        gla_prep_unit(F, u1, qb, kb, ab2, wg, bgd); if (u2 >= 2048) break;
        u = u2;
    }
}
__device__ __forceinline__ void p2_mixers(Frame& F) {
#if defined(PROBE_PHASE) && PROBE_PHASE >= 100
    const unsigned long long tp0 = __builtin_amdgcn_s_memrealtime();
#endif
#ifndef P2_SKIP_GLAP
    if (blockIdx.x < 128) {
        const int bx = blockIdx.x, bh = (bx & 7) + 8 * (bx >> 5), sl = (bx >> 3) & 3;
        gla_prompt_unit(F, bh >> 2, bh & 3, sl); }
#endif
#if defined(PROBE_PHASE) && PROBE_PHASE == 100
    if (blockIdx.x == 0) F.tp = __builtin_amdgcn_s_memrealtime() - tp0;
#endif
    constexpr int QCHUNK = 4;
    for (int it = 0, itend = 0;; ++it) {
        if (it >= itend) {
            if (F.tid == 0) F.MISC[0] = __hip_atomic_fetch_add(F.ctl + CW_QUEUE, (unsigned)QCHUNK, RLX_AGENT);
            __syncthreads();
            it = (int)F.MISC[0]; itend = it + QCHUNK;
            __syncthreads();
        }
        if (it >= P2_ITEMS) break;
#if defined(PROBE_PHASE) && PROBE_PHASE == 101
        if (blockIdx.x == 255) F.tp = __builtin_amdgcn_s_memrealtime() - tp0;
#endif
#if defined(PROBE_PHASE) && PROBE_PHASE == 102
        if (blockIdx.x == 255 && it >= P2_GLS + P2_DEC + P2_ATT && F.tp == 0ull) F.tp = __builtin_amdgcn_s_memrealtime() - tp0;
#endif
#if defined(PROBE_PHASE) && PROBE_PHASE >= 103 && PROBE_PHASE <= 106
        const unsigned long long ti0 = __builtin_amdgcn_s_memrealtime();
        const int pcls = it < P2_GLS ? 105 : (it < P2_GLS + P2_DEC ? 104 : (it < P2_GLS + P2_DEC + P2_ATT ? 103 : 106));
#endif
        if (it < P2_GLS) {
#ifndef P2_SKIP_GLAS
            gla_sample_item(F, it);
#endif
        } else if (it < P2_GLS + P2_DEC) {
#ifndef P2_SKIP_DEC
            attn_sample_waveitem(F, (it - P2_GLS) * 8 + F.wave); __syncthreads();
#endif
        } else if (it < P2_GLS + P2_DEC + P2_ATT) {
#ifndef P2_SKIP_ATT
            const int a0 = it - P2_GLS - P2_DEC;
            v4u kk[6], vv[6]; bf16x8 qa[4], qb[4];
            attn_issue(F, a0, kk, vv, qa);
            attn_prompt_item<true>(F, a0, kk, vv, qa, true, a0 + 1, qb);
            attn_prompt_item<false>(F, a0 + 1, kk, vv, qb, true, a0 + 2, qa);
            attn_prompt_item<false>(F, a0 + 2, kk, vv, qa, true, a0 + 3, qb);
            attn_prompt_item<false>(F, a0 + 3, kk, vv, qb, false, 0, qa);
            it = itend - 1;
#endif
        }
#if defined(PROBE_PHASE) && PROBE_PHASE >= 103 && PROBE_PHASE <= 106
        if (blockIdx.x == 255 && pcls == PROBE_PHASE) F.tp += __builtin_amdgcn_s_memrealtime() - ti0;
#endif
    }
#if defined(PROBE_PHASE) && PROBE_PHASE == 107
    const unsigned long long tc0 = __builtin_amdgcn_s_memrealtime();
#endif
    kvshift_loop<false>(F);
#if defined(PROBE_PHASE) && PROBE_PHASE == 107
    if (blockIdx.x == 255) F.tp = __builtin_amdgcn_s_memrealtime() - tc0;
#endif
}

__device__ __forceinline__ void p3_kvout(const bf16* K, const bf16* V, float* dst, int g, int W, int nb, size_t rowbase, int rows_per_b, int first, int pos0, int Wdst, size_t gt, size_t ngt) {
    const size_t per_b = (size_t)W * 2 * 64, tot = per_b * nb;
    for (size_t i0 = gt; i0 < tot; i0 += 4 * ngt) { v4u u[4]; float* o[4];
#pragma unroll
        for (int k = 0; k < 4; ++k) { const size_t i = i0 + k * ngt; if (i < tot) { const size_t b = i / per_b, r = i - b * per_b; const int p = (int)(r >> 7), c = (int)(r >> 6) & 1, ch = (int)r & 63;
            u[k] = *(const v4u*)((c ? V : K) + (rowbase + b * rows_per_b + first + p) * 1536 + g * 512 + ch * 8);
            o[k] = dst + ((b * Wdst + pos0 + p) * 2 + c) * 512 + ch * 8; } }
#pragma unroll
        for (int k = 0; k < 4; ++k) if (i0 + k * ngt < tot) {
            *(f32x4*)o[k] = (f32x4){bf_lo(u[k].x), bf_hi(u[k].x), bf_lo(u[k].y), bf_hi(u[k].y)}; *(f32x4*)(o[k] + 4) = (f32x4){bf_lo(u[k].z), bf_hi(u[k].z), bf_lo(u[k].w), bf_hi(u[k].w)}; } }
}
struct MergeRow { float l0, l1, l2; v4u a, b2, c, u0, u1, r0, r1; };
__device__ __forceinline__ void p3_merge_load(const bf16* OA, const bf16* OB, const bf16* RB, const float* LSE, int m, int lane, MergeRow& R) {
    const int hd = lane >> 3, c8 = (lane & 7) * 8, c0 = lane * 16;
    R.l0 = LSE[((size_t)0 * MPAD + m) * 8 + hd]; R.l1 = LSE[((size_t)1 * MPAD + m) * 8 + hd]; R.l2 = LSE[((size_t)2 * MPAD + m) * 8 + hd];
    R.a = *(const v4u*)(OA + (size_t)m * 1536 + hd * 64 + c8); R.b2 = *(const v4u*)(OA + (size_t)m * 1536 + 512 + hd * 64 + c8); R.c = *(const v4u*)(OA + (size_t)m * 1536 + 1024 + hd * 64 + c8);
    R.u0 = *(const v4u*)(OB + (size_t)m * 1024 + c0); R.u1 = *(const v4u*)(OB + (size_t)m * 1024 + c0 + 8);
    R.r0 = *(const v4u*)(RB + (size_t)m * 1024 + c0); R.r1 = *(const v4u*)(RB + (size_t)m * 1024 + c0 + 8);
}
__device__ __forceinline__ void p3_merge(Frame& F) {
    const int gw = blockIdx.x * NWAVES + F.wave, NGW = F.G * NWAVES, lane = F.lane;
    const size_t gt = (size_t)blockIdx.x * NTHR + F.tid, ngt = (size_t)F.G * NTHR;
    const bf16* OA = WSP(bf16, WS_QA); const bf16* OB = WSP(bf16, WS_VB); const bf16* RB = WSP(bf16, WS_RB); const float* LSE = WSP(float, WS_LSE);
    bf16* OAM = WSP(bf16, WS_OAM); bf16* OBN = WSP(bf16, WS_OBN); const float* gn = inptr(F, I_GN);
    float gnv[16];
#pragma unroll
    for (int i = 0; i < 16; ++i) gnv[i] = gn[lane * 16 + i];
    for (int m = NTOK + gw; m < MPAD; m += NGW) {
        *(v4u*)(OAM + (size_t)m * 512 + lane * 8) = (v4u){0u, 0u, 0u, 0u}; *(v4u*)(OBN + (size_t)m * 1024 + lane * 16) = (v4u){0u, 0u, 0u, 0u}; *(v4u*)(OBN + (size_t)m * 1024 + lane * 16 + 8) = (v4u){0u, 0u, 0u, 0u}; }
    int m = gw;
    if (m < NTOK) {
        MergeRow R, Rn; p3_merge_load(OA, OB, RB, LSE, m, lane, R);
        for (;;) {
            const int mn = m + NGW; const bool more = mn < NTOK;
            if (more) p3_merge_load(OA, OB, RB, LSE, mn, lane, Rn);
            {
                const int hd = lane >> 3, c8 = (lane & 7) * 8;
                const float l0 = R.l0, l1 = R.l1, l2 = R.l2;
                const float mx = fmaxf(l0, fmaxf(l1, l2)); float w0 = __expf(l0 - mx), w1 = __expf(l1 - mx), w2 = __expf(l2 - mx); const float iw = 1.0f / (w0 + w1 + w2); w0 *= iw; w1 *= iw; w2 *= iw;
                const v4u a = R.a, b2 = R.b2, c = R.c;
                v4u o;
                o.x = cvt_pk_bf16(w0 * bf_lo(a.x) + w1 * bf_lo(b2.x) + w2 * bf_lo(c.x), w0 * bf_hi(a.x) + w1 * bf_hi(b2.x) + w2 * bf_hi(c.x));
                o.y = cvt_pk_bf16(w0 * bf_lo(a.y) + w1 * bf_lo(b2.y) + w2 * bf_lo(c.y), w0 * bf_hi(a.y) + w1 * bf_hi(b2.y) + w2 * bf_hi(c.y));
                o.z = cvt_pk_bf16(w0 * bf_lo(a.z) + w1 * bf_lo(b2.z) + w2 * bf_lo(c.z), w0 * bf_hi(a.z) + w1 * bf_hi(b2.z) + w2 * bf_hi(c.z));
                o.w = cvt_pk_bf16(w0 * bf_lo(a.w) + w1 * bf_lo(b2.w) + w2 * bf_lo(c.w), w0 * bf_hi(a.w) + w1 * bf_hi(b2.w) + w2 * bf_hi(c.w));
                *(v4u*)(OAM + (size_t)m * 512 + hd * 64 + c8) = o;
            }
            {
                const int c0 = lane * 16;
                const v4u u0 = R.u0, u1 = R.u1, r0 = R.r0, r1 = R.r1;
                float x[16] = {bf_lo(u0.x), bf_hi(u0.x), bf_lo(u0.y), bf_hi(u0.y), bf_lo(u0.z), bf_hi(u0.z), bf_lo(u0.w), bf_hi(u0.w), bf_lo(u1.x), bf_hi(u1.x), bf_lo(u1.y), bf_hi(u1.y), bf_lo(u1.z), bf_hi(u1.z), bf_lo(u1.w), bf_hi(u1.w)};
                float rr[16] = {bf_lo(r0.x), bf_hi(r0.x), bf_lo(r0.y), bf_hi(r0.y), bf_lo(r0.z), bf_hi(r0.z), bf_lo(r0.w), bf_hi(r0.w), bf_lo(r1.x), bf_hi(r1.x), bf_lo(r1.y), bf_hi(r1.y), bf_lo(r1.z), bf_hi(r1.z), bf_lo(r1.w), bf_hi(r1.w)};
                float ss = 0.f;
#pragma unroll
                for (int i = 0; i < 16; ++i) ss += x[i] * x[i];
                ss += __shfl_xor(ss, 1); ss += __shfl_xor(ss, 2); ss += __shfl_xor(ss, 4); ss += __shfl_xor(ss, 8);
                const float rs = 1.0f / sqrtf(ss * (1.0f / 256.0f) + LN_EPS);
                float y[16];
#pragma unroll
                for (int i = 0; i < 16; ++i) { const float gte = rr[i] * __builtin_amdgcn_rcpf(1.0f + __expf(-rr[i])); y[i] = x[i] * rs * gnv[i] * gte; }
                v4u o0, o1; o0.x = cvt_pk_bf16(y[0], y[1]); o0.y = cvt_pk_bf16(y[2], y[3]); o0.z = cvt_pk_bf16(y[4], y[5]); o0.w = cvt_pk_bf16(y[6], y[7]);
                o1.x = cvt_pk_bf16(y[8], y[9]); o1.y = cvt_pk_bf16(y[10], y[11]); o1.z = cvt_pk_bf16(y[12], y[13]); o1.w = cvt_pk_bf16(y[14], y[15]);
                *(v4u*)(OBN + (size_t)m * 1024 + c0) = o0; *(v4u*)(OBN + (size_t)m * 1024 + c0 + 8) = o1;
            }
            if (!more) break;
            R = Rn; m = mn;
        }
    }
    const bf16* KA = WSP(bf16, WS_KA); const bf16* VA = WSP(bf16, WS_VA);
    p3_kvout(KA, VA, F.out + OUT_KVP1, 0, 128, 8, 0, TSEQ, TSEQ - 128, 0, 128, gt, ngt);
    p3_kvout(KA, VA, F.out + OUT_KVP2, 1, 512, 8, 0, TSEQ, TSEQ - 512, 0, 512, gt, ngt);
    p3_kvout(KA, VA, F.out + OUT_KVP3, 2, 2048, 8, 0, TSEQ, TSEQ - 2048, 0, 2048, gt, ngt);
    p3_kvout(KA, VA, F.out + OUT_KVS1, 0, 4, 32, NP, 4, 0, 124, 128, gt, ngt);
    p3_kvout(KA, VA, F.out + OUT_KVS2, 1, 4, 32, NP, 4, 0, 508, 512, gt, ngt);
    p3_kvout(KA, VA, F.out + OUT_KVS3, 2, 4, 32, NP, 4, 0, 2044, 2048, gt, ngt);
}

__device__ __forceinline__ void p6_ln1(Frame& F) {
    const int gw = blockIdx.x * NWAVES + F.wave, NGW = F.G * NWAVES, lane = F.lane;
    const bf16* HB = WSP(bf16, WS_HB); bf16* X1B = WSP(bf16, WS_X1B); const float* l1g = inptr(F, I_L1G); const float* l1b = inptr(F, I_L1B);
    f32x4 gg[4], bb[4];
#pragma unroll
    for (int j = 0; j < 4; ++j) { gg[j] = ((const f32x4*)l1g)[lane + 64 * j]; bb[j] = ((const f32x4*)l1b)[lane + 64 * j]; }
    int m = gw; if (m >= MPAD) return;
    f32x4 v[4], vn[4];
#pragma unroll
    for (int j = 0; j < 4; ++j) { const v2u t = ((const v2u*)(HB + (size_t)m * 1024) + lane)[64 * j]; v[j] = (f32x4){bf_lo(t.x), bf_hi(t.x), bf_lo(t.y), bf_hi(t.y)}; }
    for (;;) {
        const int mn = m + NGW; const bool more = mn < MPAD;
        if (more) {
#pragma unroll
            for (int j = 0; j < 4; ++j) { const v2u t = ((const v2u*)(HB + (size_t)mn * 1024) + lane)[64 * j]; vn[j] = (f32x4){bf_lo(t.x), bf_hi(t.x), bf_lo(t.y), bf_hi(t.y)}; } }
        float s = 0.f;
#pragma unroll
        for (int j = 0; j < 4; ++j) s += (v[j][0] + v[j][1]) + (v[j][2] + v[j][3]);
        const float mean = wave_sum(s) * (1.f / 1024.f); float s2 = 0.f;
#pragma unroll
        for (int j = 0; j < 4; ++j) { v[j] = v[j] - mean; s2 += (v[j][0] * v[j][0] + v[j][1] * v[j][1]) + (v[j][2] * v[j][2] + v[j][3] * v[j][3]); }
        const float rstd = 1.f / sqrtf(wave_sum(s2) * (1.f / 1024.f) + LN_EPS);
        unsigned long long* o8 = (unsigned long long*)(X1B + (size_t)m * 1024) + lane;
#pragma unroll
        for (int j = 0; j < 4; ++j) { const f32x4 y = v[j] * rstd * gg[j] + bb[j];
            o8[64 * j] = (unsigned long long)cvt_pk_bf16(y[0], y[1]) | ((unsigned long long)cvt_pk_bf16(y[2], y[3]) << 32); }
        if (!more) break;
#pragma unroll
        for (int j = 0; j < 4; ++j) v[j] = vn[j];
        m = mn;
    }
}

__device__ __forceinline__ unsigned mono_key(float f) { const unsigned u = __float_as_uint(f); return u ^ ((unsigned)((int)u >> 31) | 0x80000000u); }
__device__ __forceinline__ float mono_inv(unsigned k) { return __uint_as_float((k & 0x80000000u) ? (k ^ 0x80000000u) : ~k); }
#define CE_DESC(a, b) do { const unsigned _mx = (a) > (b) ? (a) : (b), _mn = (a) > (b) ? (b) : (a); (a) = _mx; (b) = _mn; } while (0)
template <int J> __device__ __forceinline__ void bitonic_step_desc(unsigned (&v)[16]) {
#pragma unroll
    for (int i = 0; i < 16; ++i) if ((i & J) == 0) CE_DESC(v[i], v[i | J]);
}
template <int K, int J> __device__ __forceinline__ void bitonic_step(unsigned (&v)[16]) {
#pragma unroll
    for (int i = 0; i < 16; ++i) if ((i & J) == 0) { if ((i & K) == 0) CE_DESC(v[i], v[i | J]); else CE_DESC(v[i | J], v[i]); }
}
__device__ __forceinline__ void sort16_desc(unsigned (&v)[16]) {
    bitonic_step<2, 1>(v);
    bitonic_step<4, 2>(v); bitonic_step<4, 1>(v);
    bitonic_step<8, 4>(v); bitonic_step<8, 2>(v); bitonic_step<8, 1>(v);
    bitonic_step_desc<8>(v); bitonic_step_desc<4>(v); bitonic_step_desc<2>(v); bitonic_step_desc<1>(v);
}
__device__ __forceinline__ void merge16_desc(unsigned (&T)[16], const unsigned (&N)[16]) {
#pragma unroll
    for (int k = 0; k < 16; ++k) T[k] = T[k] > N[15 - k] ? T[k] : N[15 - k];
    bitonic_step_desc<8>(T); bitonic_step_desc<4>(T); bitonic_step_desc<2>(T); bitonic_step_desc<1>(T);
}
__device__ __forceinline__ void merge_partner16(unsigned (&T)[16]) {
    unsigned P[16];
#pragma unroll
    for (int k = 0; k < 16; ++k) P[k] = (unsigned)__shfl_xor((int)T[k], 32);
    merge16_desc(T, P);
}
__device__ __forceinline__ void p8_topk_item(Frame& F, int item) {
    const int lane = F.lane, hh = lane >> 5, il = lane & 31;
    const int tb = item >> 3, hd = item & 7; const int row = 32 * tb + il;
    const bf16* QN = WSP(bf16, WS_QN); const bf16* KEYS = WSP(bf16, WS_KEYS); int* EIDX = WSP(int, WS_EIDX); float* GATE = WSP(float, WS_GATE);
    LAS unsigned* LK = (LAS unsigned*)(F.lds + F.wave * 8192);
    unsigned T1[16], T2[16];
    bf16x8 bqh[2][8], kf[8];
#pragma unroll
    for (int half = 0; half < 2; ++half)
#pragma unroll
        for (int s = 0; s < 8; ++s) bqh[half][s] = *(const bf16x8*)(QN + (size_t)row * 2048 + hd * 256 + half * 128 + 16 * s + 8 * hh);
#pragma unroll
    for (int s = 0; s < 8; ++s) kf[s] = *(const bf16x8*)(KEYS + ((size_t)(hd * 2) * 128 + il) * 128 + 8 * hh + 16 * s);
#pragma unroll
    for (int half = 0; half < 2; ++half) {
        const bf16x8 (&bq)[8] = bqh[half];
        unsigned T[16];
#pragma unroll
        for (int k = 0; k < 16; ++k) T[k] = 0u;
        const bf16* kbase = KEYS + ((size_t)(hd * 2 + half) * 128 + il) * 128 + 8 * hh;
#pragma unroll 1
        for (int kt = 0; kt < 4; ++kt) {
            f32x16 acc;
#pragma unroll
            for (int x = 0; x < 16; ++x) acc[x] = 0.f;
#pragma unroll
            for (int s = 0; s < 8; ++s) acc = MFMA32(kf[s], bq[s], acc);
            if (kt < 3 || half == 0) {
                const bf16* kn = kt < 3 ? kbase + (size_t)(32 * (kt + 1)) * 128 : kbase + (size_t)128 * 128;
#pragma unroll
                for (int s = 0; s < 8; ++s) kf[s] = *(const bf16x8*)(kn + 16 * s); }
            unsigned N[16];
#pragma unroll
            for (int x = 0; x < 16; ++x) { const int idx = 32 * kt + crow(x, hh); N[x] = (mono_key(acc[x]) & ~127u) | (unsigned)(127 - idx); }
            sort16_desc(N);
            merge16_desc(T, N);
        }
        merge_partner16(T);
#pragma unroll
        for (int k = 0; k < 16; ++k) { LK[(half * 16 + k) * 64 + lane] = T[k]; if (half == 0) T1[k] = T[k]; else T2[k] = T[k]; }
    }
    float v1s[8], v2[16];
#pragma unroll
    for (int k = 0; k < 16; ++k) v2[k] = mono_inv(T2[k] & ~127u);
#pragma unroll
    for (int i2 = 0; i2 < 8; ++i2) v1s[i2] = mono_inv((hh ? T1[2 * i2 + 1] : T1[2 * i2]) & ~127u);
    unsigned C[16], D[16];
#pragma unroll
    for (int k = 0; k < 16; ++k) { C[k] = 0u; D[k] = 0u; }
    {   int n = 0;
#pragma unroll
        for (int i2 = 0; i2 < 8; ++i2)
#pragma unroll
            for (int c = 0; c < 16; ++c) if ((2 * i2 + 1) * (c + 1) <= 16) { const unsigned key = (mono_key(v1s[i2] + v2[c]) & ~255u) | (unsigned)(255 - (16 * (2 * i2 + hh) + c));
                if (n < 16) C[n] = key; else D[n - 16] = key; ++n; }
    }
    sort16_desc(C); sort16_desc(D); merge16_desc(C, D);
    merge_partner16(C);
    LDS_WAIT(); asm volatile("" ::: "memory");
    float sv[16]; int ex[16]; float mx = NEG_BIG;
#pragma unroll
    for (int k = 0; k < 16; ++k) { const int si = 255 - (int)(C[k] & 255u), a = si >> 4, c = si & 15;
        const unsigned k1 = LK[a * 64 + lane], k2 = LK[(16 + c) * 64 + lane];
        ex[k] = (127 - (int)(k1 & 127u)) * 128 + (127 - (int)(k2 & 127u)); sv[k] = mono_inv(k1 & ~127u) + mono_inv(k2 & ~127u); mx = fmaxf(mx, sv[k]); }
    float den = 0.f;
#pragma unroll
    for (int k = 0; k < 16; ++k) { sv[k] = __expf(sv[k] - mx); den += sv[k]; }
    const float iden = 1.0f / den;
    if (hh == 0 && row < NTOK) {
#pragma unroll
        for (int k4 = 0; k4 < 4; ++k4) { if (k4 < 2) { v4u ew; ew.x = (unsigned)ex[8 * k4] | ((unsigned)ex[8 * k4 + 1] << 16); ew.y = (unsigned)ex[8 * k4 + 2] | ((unsigned)ex[8 * k4 + 3] << 16); ew.z = (unsigned)ex[8 * k4 + 4] | ((unsigned)ex[8 * k4 + 5] << 16); ew.w = (unsigned)ex[8 * k4 + 6] | ((unsigned)ex[8 * k4 + 7] << 16);
                *(v4u*)((unsigned short*)EIDX + (size_t)row * 128 + hd * 16 + 8 * k4) = ew; }
            *(f32x4*)(GATE + (size_t)row * 128 + hd * 16 + 4 * k4) = (f32x4){sv[4 * k4] * iden, sv[4 * k4 + 1] * iden, sv[4 * k4 + 2] * iden, sv[4 * k4 + 3] * iden}; } }
    LDS_WAIT(); asm volatile("" ::: "memory");
}

constexpr size_t WS_ACTP = WS_QB, WS_COEF = WS_KA, WS_PEERO = WS_RB, WS_X1H = WS_VA;
static_assert(WS_ACTP + (size_t)8 * NTOK * 128 * 4 <= WS_RB && WS_PEERO + (size_t)NTOK * 1024 * 4 <= WS_GB, "peer buffers");
__device__ __forceinline__ float gelu_erf(float x) { return 0.5f * x * (1.0f + erff(x * 0.70710678118654752f)); }
#define DPP_F(x, ctrl) __uint_as_float((unsigned)__builtin_amdgcn_mov_dpp((int)__float_as_uint(x), (ctrl), 0xf, 0xf, true))
__device__ __forceinline__ float dot16_fp8(const float (&x)[16], const v4u u) {
    float a = 0.f;
#pragma unroll
    for (int q = 0; q < 4; ++q) { const f32x2_t lo = __builtin_amdgcn_cvt_pk_f32_fp8((int)u[q], false), hi = __builtin_amdgcn_cvt_pk_f32_fp8((int)u[q], true);
        a += x[4 * q] * lo.x + x[4 * q + 1] * lo.y + x[4 * q + 2] * hi.x + x[4 * q + 3] * hi.y; }
    return a;
}
typedef float f32x4_t __attribute__((ext_vector_type(4)));
typedef int i32x4_t __attribute__((ext_vector_type(4)));
#ifndef PEER_CVT_VIA_F32
#define PEER_CVT_VIA_F32 0
#endif
#ifndef PEER_DOT_F32
#define PEER_DOT_F32 0
#endif
#if PEER_DOT_F32
#define PEER_DOT2(d, a, b) do { const h2_t a__ = (a), b__ = (b); d += (float)a__.x * (float)b__.x + (float)a__.y * (float)b__.y; } while (0)
#else
#define PEER_DOT2(d, a, b) d = __builtin_amdgcn_fdot2((a), (b), d, false)
#endif
template <bool HI> __device__ __forceinline__ h2_t fp8x2_to_h2(int w) {
#if PEER_CVT_VIA_F32
    const f32x2_t f = __builtin_amdgcn_cvt_pk_f32_fp8(w, HI); return (h2_t){(_Float16)f.x, (_Float16)f.y};
#else
    return __builtin_amdgcn_cvt_scalef32_pk_f16_fp8(w, 1.0f, HI);
#endif
}
template <unsigned EMASK> __device__ __forceinline__ void peer_u_phase_t(Frame& F) {
    const int lane = F.lane, p = lane >> 3, q = lane & 7, c = blockIdx.x & 7, wv = (blockIdx.x >> 3) * NWAVES + F.wave, nwv = (F.G >> 3) * NWAVES;
    const unsigned short* EIDX = WSP(unsigned short, WS_EIDX) + 16 * p; bf16* ACTP = WSP(bf16, WS_ACTP) + (size_t)c * NTOK * 128 + 16 * p + 2 * q;
    const unsigned char* U8 = WSP(unsigned char, WS_UT) + ((size_t)c * 16384 << 7) + 16 * q;
#define PU_LOADE(EV, M) do { _Pragma("unroll") for (int t_ = 0; t_ < 2; ++t_) EV[t_] = *(const v4u*)(EIDX + (size_t)(M) * 128 + 8 * t_); } while (0)
#define PE_IDX(EV, g) (((g) & 1) ? (EV[(g) >> 3][((g) >> 1) & 3] >> 16) : (EV[(g) >> 3][((g) >> 1) & 3] & 0xffffu))
#define PU_ISSUE(UR, EV) do { _Pragma("unroll") for (int g = 0; g < 16; ++g) UR[g] = *(const v4u*)(U8 + ((PE_IDX(EV, g) & EMASK) << 7)); } while (0)
#define PU_BODY(UR, UN, M, STEADY) do { const int m_ = (M); const int m1_ = m_ + nwv, m2_ = m_ + 2 * nwv; \
        const bf16* xf_ = (const bf16*)(F.ws + WS_X1B) + (size_t)m_ * 1024 + 128 * c + 16 * q; \
        const v4u xa_ = *(const v4u*)xf_, xb_ = *(const v4u*)(xf_ + 8); \
        __builtin_amdgcn_sched_barrier(0); \
        if (STEADY) { PU_ISSUE(UN, ev); PU_LOADE(ev, m2_ < NTOK ? m2_ : NTOK - 1); } \
        __builtin_amdgcn_sched_barrier(0); \
        const h2_t xh[8] = {(h2_t){(_Float16)bf_lo(xa_.x), (_Float16)bf_hi(xa_.x)}, (h2_t){(_Float16)bf_lo(xa_.y), (_Float16)bf_hi(xa_.y)}, (h2_t){(_Float16)bf_lo(xa_.z), (_Float16)bf_hi(xa_.z)}, (h2_t){(_Float16)bf_lo(xa_.w), (_Float16)bf_hi(xa_.w)}, \
                            (h2_t){(_Float16)bf_lo(xb_.x), (_Float16)bf_hi(xb_.x)}, (h2_t){(_Float16)bf_lo(xb_.y), (_Float16)bf_hi(xb_.y)}, (h2_t){(_Float16)bf_lo(xb_.z), (_Float16)bf_hi(xb_.z)}, (h2_t){(_Float16)bf_lo(xb_.w), (_Float16)bf_hi(xb_.w)}}; \
        float a[16]; \
        _Pragma("unroll") for (int g = 0; g < 16; ++g) { float d_ = 0.f; \
            _Pragma("unroll") for (int t_ = 0; t_ < 4; ++t_) { PEER_DOT2(d_, fp8x2_to_h2<false>((int)UR[g][t_]), xh[2 * t_]); PEER_DOT2(d_, fp8x2_to_h2<true>((int)UR[g][t_]), xh[2 * t_ + 1]); } \
            a[g] = d_; if ((g & 1) == 1 && g < 15) asm volatile("" : "+v"(a[g - 1]), "+v"(a[g]), "+v"(UR[(g + 1) & 15]), "+v"(UR[(g + 2) & 15])); } \
        float b8[8], b4[4], b2[2]; \
        { const bool up = (q & 4) != 0; _Pragma("unroll") for (int k = 0; k < 8; ++k) { const float send = up ? a[k] : a[k + 8], keep = up ? a[k + 8] : a[k]; b8[k] = keep + DPP_F(send, 0x141); } } \
        { const bool up = (q & 2) != 0; _Pragma("unroll") for (int k = 0; k < 4; ++k) { const float send = up ? b8[k] : b8[k + 4], keep = up ? b8[k + 4] : b8[k]; b4[k] = keep + DPP_F(send, 0x4E); } } \
        { const bool up = (q & 1) != 0; _Pragma("unroll") for (int k = 0; k < 2; ++k) { const float send = up ? b4[k] : b4[k + 2], keep = up ? b4[k + 2] : b4[k]; b2[k] = keep + DPP_F(send, 0xB1); } } \
        *(unsigned*)(ACTP + (size_t)m_ * 128) = cvt_pk_bf16(b2[0], b2[1]); } while (0)
    int m = wv; if (m >= NTOK) return;
    v4u ev[2];
    PU_LOADE(ev, m);
    v4u ua[16], ub[16];
    PU_ISSUE(ua, ev);
    if (m + nwv < NTOK) PU_LOADE(ev, m + nwv);
    for (;;) {
        if (m + nwv >= NTOK) { PU_BODY(ua, ub, m, false); break; }
        PU_BODY(ua, ub, m, true); m += nwv;
        if (m + nwv >= NTOK) { PU_BODY(ub, ua, m, false); break; }
        PU_BODY(ub, ua, m, true); m += nwv;
    }
#undef PU_LOADE
#undef PU_ISSUE
#undef PU_BODY
}
__device__ __forceinline__ void peer_u_phase(Frame& F) { peer_u_phase_t<0xffffffffu>(F); }
__device__ __forceinline__ void peer_coef_phase(Frame& F) {
    const int gw = blockIdx.x * NWAVES + F.wave, NGW = F.G * NWAVES, lane = F.lane;
    const bf16* ACTP = WSP(bf16, WS_ACTP) + 2 * lane; const float* GATE = WSP(float, WS_GATE) + 2 * lane; _Float16* COEF = WSP(_Float16, WS_COEF) + 2 * lane;
    int m = gw; if (m >= NTOK) return;
    unsigned av[8], an[8]; f32x2_t gv, gnx;
    gv = *(const f32x2_t*)(GATE + (size_t)m * 128);
#pragma unroll
    for (int c = 0; c < 8; ++c) av[c] = *(const unsigned*)(ACTP + ((size_t)c * NTOK + m) * 128);
    for (;;) {
        const int mn = m + NGW; const bool more = mn < NTOK;
        if (more) { gnx = *(const f32x2_t*)(GATE + (size_t)mn * 128);
#pragma unroll
            for (int c = 0; c < 8; ++c) an[c] = *(const unsigned*)(ACTP + ((size_t)c * NTOK + mn) * 128); }
        float a0 = 0.f, a1 = 0.f;
#pragma unroll
        for (int c = 0; c < 8; ++c) { a0 += bf_lo(av[c]); a1 += bf_hi(av[c]); }
        *(h2_t*)(COEF + (size_t)m * 128) = (h2_t){(_Float16)(gv.x * gelu_erf(a0 * (1.0f / U_SCALE))), (_Float16)(gv.y * gelu_erf(a1 * (1.0f / U_SCALE)))};
        if (!more) break;
        gv = gnx;
#pragma unroll
        for (int c = 0; c < 8; ++c) av[c] = an[c];
        m = mn;
    }
}
__device__ __forceinline__ void peer_v_phase(Frame& F) {
    const int lane = F.lane, p = lane >> 3, q = lane & 7, c = blockIdx.x & 7, wv = (blockIdx.x >> 3) * NWAVES + F.wave, nwv = (F.G >> 3) * NWAVES;
    const unsigned short* EIDX = WSP(unsigned short, WS_EIDX) + 16 * p; const _Float16* COEF = WSP(_Float16, WS_COEF) + 16 * p; bf16* PEERO = WSP(bf16, WS_PEERO) + 128 * c + 16 * q + 2 * p;
    const unsigned char* V8 = WSP(unsigned char, WS_VT) + ((size_t)c * 16384 << 7) + 16 * q;
    int m = wv; if (m >= NTOK) return;
    v4u ev[2];
#define PV_LOADE(M) do { _Pragma("unroll") for (int t_ = 0; t_ < 2; ++t_) ev[t_] = *(const v4u*)(EIDX + (size_t)(M) * 128 + 8 * t_); } while (0)
#define PV_ISSUE(VR) do { _Pragma("unroll") for (int g_ = 0; g_ < 16; ++g_) VR[g_] = *(const v4u*)(V8 + (PE_IDX(ev, g_) << 7)); } while (0)
#define PV_BODY(VR, VN, M, STEADY) do { const int m_ = (M); const int m1_ = m_ + nwv, m2_ = m_ + 2 * nwv; (void)m1_; \
        v4u cv[2]; \
        _Pragma("unroll") for (int t = 0; t < 2; ++t) cv[t] = *(const v4u*)(COEF + (size_t)m_ * 128 + 8 * t); \
        __builtin_amdgcn_sched_barrier(0); \
        if (STEADY) { PV_ISSUE(VN); PV_LOADE(m2_ < NTOK ? m2_ : NTOK - 1); } \
        __builtin_amdgcn_sched_barrier(0); \
        h2_t acc[8]; \
        _Pragma("unroll") \
        for (int i = 0; i < 8; ++i) acc[i] = (h2_t){(_Float16)0.f, (_Float16)0.f}; \
        _Pragma("unroll") \
        for (int g = 0; g < 16; ++g) { const unsigned cw = cv[g >> 3][(g >> 1) & 3]; const h2_t cf2 = __builtin_bit_cast(h2_t, (g & 1) ? ((cw >> 16) | (cw & 0xffff0000u)) : ((cw & 0xffffu) | (cw << 16))); \
        _Pragma("unroll") \
            for (int t = 0; t < 4; ++t) { acc[2 * t] += fp8x2_to_h2<false>((int)VR[g][t]) * cf2; acc[2 * t + 1] += fp8x2_to_h2<true>((int)VR[g][t]) * cf2; } \
            if ((g & 3) == 3 && g < 15) asm volatile("" : "+v"(acc[0]), "+v"(acc[1]), "+v"(acc[2]), "+v"(acc[3]), "+v"(acc[4]), "+v"(acc[5]), "+v"(acc[6]), "+v"(acc[7]), "+v"(VR[(g + 1) & 15]), "+v"(VR[(g + 2) & 15]), "+v"(VR[(g + 3) & 15]), "+v"(VR[(g + 4) & 15])); } \
 \
        unsigned w[8]; \
        _Pragma("unroll") \
        for (int i = 0; i < 8; ++i) w[i] = __builtin_bit_cast(unsigned, acc[i]); \
        h2_t r4[4], r2[2], r1; \
        { const bool up = (lane & 32) != 0; \
        _Pragma("unroll") \
          for (int k = 0; k < 4; ++k) { const unsigned send = up ? w[k] : w[k + 4], keep = up ? w[k + 4] : w[k]; r4[k] = __builtin_bit_cast(h2_t, keep) + __builtin_bit_cast(h2_t, (unsigned)__shfl_xor((int)send, 32)); } } \
        { const bool up = (lane & 16) != 0; \
        _Pragma("unroll") \
          for (int k = 0; k < 2; ++k) { const unsigned a_ = __builtin_bit_cast(unsigned, r4[k]), b_ = __builtin_bit_cast(unsigned, r4[k + 2]); const unsigned send = up ? a_ : b_, keep = up ? b_ : a_; r2[k] = __builtin_bit_cast(h2_t, keep) + __builtin_bit_cast(h2_t, (unsigned)__shfl_xor((int)send, 16)); } } \
        { const bool up = (lane & 8) != 0; const unsigned a_ = __builtin_bit_cast(unsigned, r2[0]), b_ = __builtin_bit_cast(unsigned, r2[1]); const unsigned send = up ? a_ : b_, keep = up ? b_ : a_; \
          r1 = __builtin_bit_cast(h2_t, keep) + __builtin_bit_cast(h2_t, (unsigned)__builtin_amdgcn_mov_dpp((int)send, 0x128, 0xf, 0xf, true)); } \
        *(unsigned*)(PEERO + (size_t)m_ * 1024) = cvt_pk_bf16((float)r1.x * (1.0f / V_SCALE), (float)r1.y * (1.0f / V_SCALE)); \
        } while (0)
    PV_LOADE(m);
    v4u va[16], vb[16];
    PV_ISSUE(va);
    if (m + nwv < NTOK) PV_LOADE(m + nwv);
    for (;;) {
        if (m + nwv >= NTOK) { PV_BODY(va, vb, m, false); break; }
        PV_BODY(va, vb, m, true); m += nwv;
        if (m + nwv >= NTOK) { PV_BODY(vb, va, m, false); break; }
        PV_BODY(vb, va, m, true); m += nwv;
    }
#undef PV_LOADE
#undef PV_ISSUE
#undef PV_BODY
}
__device__ __forceinline__ void peer_ln2_phase(Frame& F) {
    const int gw = blockIdx.x * NWAVES + F.wave, NGW = F.G * NWAVES, lane = F.lane;
    const bf16* X1 = WSP(bf16, WS_X1B); const bf16* PEERO = WSP(bf16, WS_PEERO); const float* l2g = inptr(F, I_L2G); const float* l2b = inptr(F, I_L2B);
    f32x4 gg[4], bb[4];
#pragma unroll
    for (int t = 0; t < 4; ++t) { gg[t] = *(const f32x4*)(l2g + 4 * lane + 256 * t); bb[t] = *(const f32x4*)(l2b + 4 * lane + 256 * t); }
    int m = gw; if (m >= NTOK) return;
    v2u xa[4], xn[4]; v2u pa[4], pn[4];
#pragma unroll
    for (int t = 0; t < 4; ++t) { xa[t] = *(const v2u*)(X1 + (size_t)m * 1024 + 4 * lane + 256 * t); pa[t] = *(const v2u*)(PEERO + (size_t)m * 1024 + 4 * lane + 256 * t); }
    for (;;) {
        const int mn = m + NGW; const bool more = mn < NTOK;
        if (more) {
#pragma unroll
            for (int t = 0; t < 4; ++t) { xn[t] = *(const v2u*)(X1 + (size_t)mn * 1024 + 4 * lane + 256 * t); pn[t] = *(const v2u*)(PEERO + (size_t)mn * 1024 + 4 * lane + 256 * t); } }
        float acc[16]; float s = 0.f;
#pragma unroll
        for (int t = 0; t < 4; ++t) { const float pz[4] = {bf_lo(pa[t].x), bf_hi(pa[t].x), bf_lo(pa[t].y), bf_hi(pa[t].y)};
            const float xz[4] = {bf_lo(xa[t].x), bf_hi(xa[t].x), bf_lo(xa[t].y), bf_hi(xa[t].y)};
#pragma unroll
            for (int i = 0; i < 4; ++i) { acc[4 * t + i] = ALPHA * xz[i] + pz[i]; s += acc[4 * t + i]; } }
        const float mean = wave_sum(s) * (1.f / 1024.f); float s2 = 0.f;
#pragma unroll
        for (int i = 0; i < 16; ++i) { acc[i] -= mean; s2 += acc[i] * acc[i]; }
        const float rstd = 1.f / sqrtf(wave_sum(s2) * (1.f / 1024.f) + LN_EPS);
        float* yo = m < NP ? F.out + OUT_YP + (size_t)m * 1024 : F.out + OUT_YS + (size_t)(m - NP) * 1024;
#pragma unroll
        for (int t = 0; t < 4; ++t) { const int cc = 4 * lane + 256 * t;
            *(f32x4*)(yo + cc) = (f32x4){acc[4 * t] * rstd * gg[t][0] + bb[t][0], acc[4 * t + 1] * rstd * gg[t][1] + bb[t][1], acc[4 * t + 2] * rstd * gg[t][2] + bb[t][2], acc[4 * t + 3] * rstd * gg[t][3] + bb[t][3]}; }
        if (!more) break;
#pragma unroll
        for (int t = 0; t < 4; ++t) { xa[t] = xn[t]; pa[t] = pn[t]; }
        m = mn;
    }
}

template <class Epi> __device__ __forceinline__ void skinny_sample_gemm(Frame& F, const bf16* A, const bf16* Bt, int K, const Epi& epi) {
    typedef float f32x4a __attribute__((ext_vector_type(4)));
    const int lane = F.lane, r = lane & 15, kg = lane >> 4;
    for (int strip = blockIdx.x; strip < 64; strip += F.G) {
        const bf16* ap = A + (size_t)(NP + 16 * F.wave + r) * K + 8 * kg;
        const bf16* bp = Bt + (size_t)(16 * strip + r) * K + 8 * kg;
        f32x4a acc = {0.f, 0.f, 0.f, 0.f};
        for (int s0 = 0; s0 < K / 32; s0 += 16) { bf16x8 af[16], bfr[16];
#pragma unroll
            for (int u = 0; u < 16; ++u) { af[u] = *(const bf16x8*)(ap + 32 * (s0 + u)); bfr[u] = *(const bf16x8*)(bp + 32 * (s0 + u)); }
#pragma unroll
            for (int u = 0; u < 16; ++u) acc = __builtin_amdgcn_mfma_f32_16x16x32_bf16(af[u], bfr[u], acc, 0, 0, 0); }
#pragma unroll
        for (int i = 0; i < 4; ++i) epi(NP + 16 * F.wave + 4 * kg + i, 16 * strip + r, acc[i]);
    }
}

struct Args { const float* in[22]; float* out; unsigned char* ws; int ph_lo, ph_hi; };
constexpr int NPHASE = 14;
__global__ void __launch_bounds__(NTHR, 2) mk_fwd(Args args) {
    extern __shared__ __attribute__((aligned(16))) unsigned char lds[];
    Frame F;
    F.lds = (LAS unsigned char*)lds; F.MISC = (volatile LAS unsigned*)(F.lds + MISC_OFF);
    F.tid = threadIdx.x; F.lane = F.tid & 63; F.wave = __builtin_amdgcn_readfirstlane(F.tid >> 6); F.G = gridDim.x;
    F.ws = args.ws; F.out = args.out; F.ctl = (gu32*)(args.ws + WS_CTL); F.tp = 0ull;
    for (int u = F.tid; u < (LDS_BYTES - MISC_OFF) / 4; u += NTHR) ((LAS unsigned*)(F.lds + MISC_OFF))[u] = 0u;
    __syncthreads();
    if (F.tid < 22) ((LAS unsigned long long*)(F.lds + PTR_OFF))[F.tid] = (unsigned long long)args.in[F.tid];
    __syncthreads();
    const int lo = args.ph_lo, hi = args.ph_hi;
    const bool multi = (hi - lo) > 1;
    XcdBarrier bar; bar.bar = (unsigned*)(F.ctl + CW_BAR); bar.x = 0; bar.st = nullptr;
    if (multi) bar = xcd_barrier_post((unsigned*)(F.ctl + CW_BAR), F.MISC + 8);
#ifdef ONLY_PHASE
#define IN(k) ((k) == ONLY_PHASE && lo <= (k) && (k) < hi)
#else
#define IN(k) (lo <= (k) && (k) < hi)
#endif
#ifdef PROBE_PHASE
    unsigned long long t_prev = __builtin_amdgcn_s_memrealtime(), t_probe = 0ull;
#define STAMP(k) do { const unsigned long long _t = __builtin_amdgcn_s_memrealtime(); if ((k) == PROBE_PHASE && blockIdx.x == 0) t_probe = _t - t_prev; t_prev = _t; } while (0)
#else
#define STAMP(k) do { } while (0)
#endif
#define SEAM(k) do { if (IN(k) && IN((k) + 1)) xcd_barrier(bar); STAMP(k); } while (0)
    if (IN(0)) { p0_prologue(F); }
    if (IN(0) && IN(1)) { cooperative_groups::this_grid().sync(); } STAMP(0);
    if (IN(1)) {
        if ((int)blockIdx.x >= F.G - NCOPYWG) kvshift_loop<true>(F);
        else {
        pg8::Gemm g{WSP(bf16, WS_XB), WSP(bf16, WS_WIN), MPAD, NPROJ, 1024, MPAD / 256 - 1}; pg8::StaticOrder S; S.init(MPAD, NPROJ, F.G - NCOPYWG, (int)blockIdx.x);
        pg8::EpiProj E{WSP(bf16, WS_QA), WSP(bf16, WS_KA), WSP(bf16, WS_VA), WSP(bf16, WS_QB), WSP(bf16, WS_KB), WSP(bf16, WS_VB), WSP(bf16, WS_RB), WSP(bf16, WS_GA), WSP(bf16, WS_GB)};
        pg8::gemm_phase<pg8::EpiProj, pg8::StaticOrder, true, true>(F.lds, g, S, E);
        if (F.tid == 0) __hip_atomic_fetch_add(F.ctl + CW_GDONE, 1u, RLX_AGENT);
        }
    } SEAM(1);
    if (IN(2)) { p2_prep(F); } SEAM(2);
    if (IN(3)) { p2_mixers(F); } SEAM(3);
    if (IN(4)) { p3_merge(F); } SEAM(4);
    if (IN(5)) {
        bf16* T1 = WSP(bf16, WS_T1); bf16* MIXp = WSP(bf16, WS_MIX); const bf16* GAp = WSP(bf16, WS_GA); const bf16* GBp = WSP(bf16, WS_GB);
        { pg8::Gemm g{WSP(bf16, WS_OAM), WSP(bf16, WS_WA), NP, 1024, 512, -1}; pg8::StaticOrder S; S.init(NP, 1024, F.G, (int)blockIdx.x, false);
          pg8::EpiGate<false> E{WSP(bf16, WS_GA), nullptr, WSP(bf16, WS_T1)};
          pg8::gemm_phase<pg8::EpiGate<false>, pg8::StaticOrder, true, true>(F.lds, g, S, E); }
        skinny_sample_gemm(F, WSP(bf16, WS_OAM), WSP(bf16, WS_WA), 512, [=](int row, int col, float v) { const size_t o = (size_t)row * 1024 + col; T1[o] = f2bf(pg8::sigmoidf_(bf2f(GAp[o])) * v); });
        VM_WAIT(); __syncthreads();
        { pg8::Gemm g{WSP(bf16, WS_OBN), WSP(bf16, WS_WB), NP, 1024, 1024, -1}; pg8::StaticOrder S; S.init(NP, 1024, F.G, (int)blockIdx.x, false);
          pg8::EpiGate<true> E{WSP(bf16, WS_GB), WSP(bf16, WS_T1), WSP(bf16, WS_MIX)};
          pg8::gemm_phase<pg8::EpiGate<true>, pg8::StaticOrder, true, true>(F.lds, g, S, E); }
        skinny_sample_gemm(F, WSP(bf16, WS_OBN), WSP(bf16, WS_WB), 1024, [=](int row, int col, float v) { const size_t o = (size_t)row * 1024 + col; MIXp[o] = f2bf(bf2f(T1[o]) + pg8::sigmoidf_(bf2f(GBp[o])) * v); });
    } SEAM(5);
    if (IN(6)) {
        pg8::Gemm g{WSP(bf16, WS_MIX), WSP(bf16, WS_WO), NP, 1024, 1024, -1}; pg8::StaticOrder S; S.init(NP, 1024, F.G, (int)blockIdx.x, false);
        pg8::EpiOut E{WSP(bf16, WS_XB), WSP(bf16, WS_HB), ALPHA};
        pg8::gemm_phase<pg8::EpiOut, pg8::StaticOrder, true, true>(F.lds, g, S, E);
        const bf16* xbp = WSP(bf16, WS_XB); bf16* Hp = WSP(bf16, WS_HB);
        skinny_sample_gemm(F, WSP(bf16, WS_MIX), WSP(bf16, WS_WO), 1024, [=](int row, int col, float v) { const size_t o = (size_t)row * 1024 + col; Hp[o] = f2bf(ALPHA * bf2f(xbp[o]) + v); });
    } SEAM(6);
    if (IN(7)) { p6_ln1(F); } SEAM(7);
    if (IN(8)) {
        pg8::Gemm g{WSP(bf16, WS_X1B), WSP(bf16, WS_WQ), MPAD, 2048, 1024, MPAD / 256 - 1}; pg8::StaticOrder S; S.init(MPAD, 2048, F.G, (int)blockIdx.x);
        pg8::EpiHeadNorm E{WSP(bf16, WS_QN), 2048, F.lds + STATS_OFF, LN_EPS};
        pg8::gemm_phase<pg8::EpiHeadNorm, pg8::StaticOrder, true, true>(F.lds, g, S, E);
    } SEAM(8);
    if (IN(9)) {
        const int gw = blockIdx.x * NWAVES + F.wave, NGW = F.G * NWAVES;
        for (int it = gw; it < (NP / 32) * 8; it += NGW) p8_topk_item(F, it);
        for (int e = gw; e < 64 * (NS / 32) * 8; e += NGW) if ((e & 63) == 0) p8_topk_item(F, (NP / 32) * 8 + (e >> 6));
    } SEAM(9);
#if defined(PROBE_PHASE) && PROBE_PHASE >= 300 && PROBE_PHASE < 310
    if (IN(10)) { const unsigned long long td0 = __builtin_amdgcn_s_memrealtime();
        if (PROBE_PHASE == 300) peer_u_phase_t<2047u>(F); else if (PROBE_PHASE == 301) peer_u_phase_t<8191u>(F); else peer_u_phase_t<0xffffffffu>(F);
        xcd_barrier(bar); if (blockIdx.x == 0) F.tp = __builtin_amdgcn_s_memrealtime() - td0; }
#endif
    if (IN(10)) { peer_u_phase(F); } SEAM(10);
    if (IN(11)) { peer_coef_phase(F); } SEAM(11);
    if (IN(12)) { peer_v_phase(F); } SEAM(12);
    if (IN(13)) { peer_ln2_phase(F); }
#ifdef PROBE_PHASE
    if (PROBE_PHASE == 13) { xcd_barrier(bar); STAMP(13); }
    if (PROBE_PHASE == 200 || PROBE_PHASE == 201) {
        unsigned* xm = (unsigned*)(F.ws + WS_END);
        if (F.tid == 0) __hip_atomic_store(xm + blockIdx.x, xb_xcc_id() + 1u, RLX_AGENT);
        xcd_barrier(bar);
        if (blockIdx.x == 0 && F.tid == 0) { bool ok = true;
            for (int b = 0; b < (int)gridDim.x; ++b) { const unsigned a = __hip_atomic_load(xm + b, RLX_AGENT), r = __hip_atomic_load(xm + (PROBE_PHASE == 200 ? (b & 7) : (b & ~31)), RLX_AGENT); if (a != r) ok = false; }
            t_probe = ok ? 50000ull : 0ull; }
    }
    if ((PROBE_PHASE >= 100 && PROBE_PHASE < 200) || PROBE_PHASE >= 300) t_probe = F.tp;
    if (F.tid == 0 && t_probe != 0ull) { const unsigned long long t0 = __builtin_amdgcn_s_memrealtime(); while (__builtin_amdgcn_s_memrealtime() - t0 < PROBE_GAIN * t_probe) __builtin_amdgcn_s_sleep(8); }
#endif
#undef IN
#undef SEAM
}

extern "C" void kernel_launch(void* const* d_in, const int* in_sizes, int n_in, void* d_out, int out_size, void* d_ws, size_t ws_size, hipStream_t stream) {
    static int grid = 0;
    if (grid == 0) {
        if (n_in != 22 || (size_t)out_size != OUT_TOTAL || ws_size < WS_END) { fprintf(stderr, "kernel_launch: unexpected shapes: n_in %d out %d ws %zu (need >= %zu)\n", n_in, out_size, ws_size, (size_t)WS_END); grid = -1; return; }
        int dev = 0, cus = 0, per_cu = 0;
        if (hipGetDevice(&dev) != hipSuccess || hipDeviceGetAttribute(&cus, hipDeviceAttributeMultiprocessorCount, dev) != hipSuccess) { grid = -1; return; }
        if (hipFuncSetAttribute((const void*)mk_fwd, hipFuncAttributeMaxDynamicSharedMemorySize, LDS_BYTES) != hipSuccess) { fprintf(stderr, "kernel_launch: hipFuncSetAttribute failed\n"); grid = -1; return; }
        if (hipOccupancyMaxActiveBlocksPerMultiprocessor(&per_cu, (const void*)mk_fwd, NTHR, LDS_BYTES) != hipSuccess || per_cu < 1) fprintf(stderr, "kernel_launch: occupancy query reports %d blocks per CU\n", per_cu);
        (void)hipGetLastError();
        grid = cus;
    }
    if (grid < 0) return;
    (void)hipMemsetAsync((char*)d_ws + WS_CTL, 0, CTL_ZERO_BYTES, stream);
    Args a{};
    for (int i = 0; i < 22; ++i) a.in[i] = (const float*)d_in[i];
    a.out = (float*)d_out; a.ws = (unsigned char*)d_ws;
#if MK_SINGLE
    a.ph_lo = 0; a.ph_hi = NPHASE;
    void* kargs[] = {&a};
    hipError_t e = hipLaunchCooperativeKernel((const void*)mk_fwd, dim3(grid), dim3(NTHR), kargs, LDS_BYTES, stream);
    if (e != hipSuccess) fprintf(stderr, "kernel_launch: cooperative launch failed: %s\n", hipGetErrorString(e));
#else
    for (int p = 0; p < NPHASE; ++p) { a.ph_lo = p; a.ph_hi = p + 1; hipLaunchKernelGGL(mk_fwd, dim3(grid), dim3(NTHR), LDS_BYTES, stream, a); }
#endif
}
```
